# Optimizing an MI355X kernel written in HIP

```python
import math
import jax, jax.numpy as jnp
from jax import lax
import numpy as np

D_MODEL = 1024
BATCH = 4
SEQ = 8192
DEPTH = 2

GRID_W = 64
CTX_LEN = 256
EPS = 1e-6

HG_HEADS = 8
HG_DK = 64
HG_DV = 64
HG_W = HG_HEADS * HG_DV
HG_CHUNK = 64

MLA_HEADS = 8
MLA_Q_RANK = 256
MLA_KV_RANK = 128
MLA_NOPE = 64
MLA_ROPE = 32
MLA_V = 64
MLA_QK = MLA_NOPE + MLA_ROPE
MLA_W = MLA_HEADS * MLA_V
Q_BLOCK = 128
ROPE_BASE = 10000.0

LRU_W = 512
LRU_BLOCKS = 8
LRU_BD = LRU_W // LRU_BLOCKS
CONV_W = 4
LRU_C = 8.0

N_GROUPS = 4
EXP_PER_GROUP = 4
N_EXPERTS = N_GROUPS * EXP_PER_GROUP
D_EXPERT = 256
TOP_K_IN_GROUP = 2

IN_SPLITS = (HG_W, HG_W, HG_W, HG_W, HG_W, MLA_Q_RANK, MLA_KV_RANK, MLA_ROPE, LRU_W, LRU_W, D_MODEL, D_MODEL, D_MODEL)
IN_WIDTH = sum(IN_SPLITS)

kernel_name = 'hybrid_flow_backbone'


def _rmsnorm(t, g):
    tf = t.astype(jnp.float32)
    tf = tf * lax.rsqrt(jnp.mean(tf * tf, axis=-1, keepdims=True) + EPS)
    return (tf * g.astype(jnp.float32)).astype(t.dtype)


def _modulate(t, shift, scale):
    return t * (1.0 + scale) + shift


def _split_in(p):
    offsets = np.cumsum(IN_SPLITS)[:-1].tolist()
    return jnp.split(p, offsets, axis=-1)


def _axial_rope(rows):
    half = MLA_ROPE // 2
    pos_row = jnp.repeat(jnp.arange(rows, dtype=jnp.float32), GRID_W)
    pos_col = jnp.tile(jnp.arange(GRID_W, dtype=jnp.float32), rows)
    inv = ROPE_BASE ** (-jnp.arange(0, half, 2, dtype=jnp.float32) / half)
    ang = jnp.concatenate([pos_row[:, None] * inv, pos_col[:, None] * inv], axis=-1)
    return jnp.cos(ang), jnp.sin(ang)


def _apply_rope(t, cos, sin):
    half = MLA_ROPE // 2
    nope, rp = t[..., :MLA_NOPE], t[..., MLA_NOPE:]
    r1, r2 = rp[..., :half], rp[..., half:]
    cs = cos[None, :, None, :].astype(t.dtype)
    sn = sin[None, :, None, :].astype(t.dtype)
    return jnp.concatenate([nope, r1 * cs - r2 * sn, r2 * cs + r1 * sn], axis=-1)


def _gla_chunked(q, k, v, logf, s0):
    b_, h_, L, _ = q.shape
    n = L // HG_CHUNK

    def chunks(t):
        return t.reshape(b_, h_, n, HG_CHUNK, t.shape[-1]).transpose(2, 0, 1, 3, 4)

    mask = jnp.tril(jnp.ones((HG_CHUNK, HG_CHUNK), dtype=bool))[..., None]

    def step(S, inp):
        qb, kb, vb, fb = inp
        bcum = jnp.cumsum(fb, axis=2)
        diff = bcum[:, :, :, None, :] - bcum[:, :, None, :, :]
        decay = jnp.exp(jnp.where(mask, diff, -jnp.inf))
        A = jnp.einsum('bhtd,bhsd,bhtsd->bhts', qb, kb, decay)
        o = jnp.einsum('bhts,bhsv->bhtv', A, vb) + jnp.einsum('bhtd,bhdv->bhtv', qb * jnp.exp(bcum), S)
        btot = bcum[:, :, -1:, :]
        S_new = S * jnp.exp(btot[:, :, 0, :, None]) + jnp.einsum('bhsd,bhsv->bhdv', kb * jnp.exp(btot - bcum), vb)
        return S_new, o

    S_fin, oc = lax.scan(step, s0, tuple(chunks(t) for t in (q, k, v, logf)))
    o = oc.transpose(1, 2, 0, 3, 4).reshape(b_, h_, L, v.shape[-1])
    return o, S_fin


def _hgrn2_branch(px, pc, lb, gain, need_ctx):
    qx, fxf, fxb, ix, gx = px
    qc, fcf, fcb, ic, gc = pc
    dt = qx.dtype
    bsz = qx.shape[0]

    def heads(t):
        b_, L, _ = t.shape
        return t.astype(jnp.float32).reshape(b_, L, HG_HEADS, -1).transpose(0, 2, 1, 3)

    def decay(z, lbd):
        z = z.astype(jnp.float32)
        logf = jnp.logaddexp(jnp.log(lbd), jnp.log1p(-lbd) + jax.nn.log_sigmoid(z))
        key = (1.0 - lbd) * jax.nn.sigmoid(-z)
        return heads(logf), heads(key)

    qxh, vxh, qch, vch = heads(qx), heads(ix), heads(qc), heads(ic)
    s0 = jnp.zeros((bsz, HG_HEADS, HG_DK, HG_DV), jnp.float32)
    ox_dirs, oc_dirs = [], []
    for d, (zx, zc) in enumerate(((fxf, fcf), (fxb, fcb))):
        lfx, kx = decay(zx, lb[d])
        lfc, kc = decay(zc, lb[d])
        tx = (qxh, kx, vxh, lfx)
        tc = (qch, kc, vch, lfc)
        if d == 1:
            tx = tuple(jnp.flip(t, axis=2) for t in tx)
            tc = tuple(jnp.flip(t, axis=2) for t in tc)
        oc, sc = _gla_chunked(*tc, s0)
        ox, _ = _gla_chunked(*tx, sc)
        if d == 1:
            ox, oc = jnp.flip(ox, axis=2), jnp.flip(oc, axis=2)
        ox_dirs.append(ox)
        oc_dirs.append(oc)

    def readout(dirs, g):
        o = (dirs[0] + dirs[1]).transpose(0, 2, 1, 3)
        b_, L = o.shape[0], o.shape[1]
        o = _rmsnorm(o, gain).reshape(b_, L, HG_W)
        return (o * jax.nn.sigmoid(g.astype(jnp.float32))).astype(dt)

    out_x = readout(ox_dirs, gx)
    out_c = readout(oc_dirs, gc) if need_ctx else None
    return out_x, out_c


def _mla_qkv(dq, dkv, kr, q_norm, kv_norm, w_uq, w_ukv, gq, gk):
    b_, L, _ = dq.shape
    q = (_rmsnorm(dq, q_norm) @ w_uq).reshape(b_, L, MLA_HEADS, MLA_QK)
    kv = (_rmsnorm(dkv, kv_norm) @ w_ukv).reshape(b_, L, MLA_HEADS, MLA_NOPE + MLA_V)
    k_nope, v = kv[..., :MLA_NOPE], kv[..., MLA_NOPE:]
    k_rope = jnp.broadcast_to(kr[:, :, None, :], (b_, L, MLA_HEADS, MLA_ROPE))
    k = jnp.concatenate([k_nope, k_rope], axis=-1)
    return _rmsnorm(q, gq), _rmsnorm(k, gk), v


def _mla_branch(px, pc, cos, sin, q_norm, kv_norm, w_uq, w_ukv, gq, gk, need_ctx):
    dqx, dkvx, krx = px
    dqc, dkvc, krc = pc
    scale = MLA_QK ** -0.5
    qx, kx, vx = _mla_qkv(dqx, dkvx, krx, q_norm, kv_norm, w_uq, w_ukv, gq, gk)
    qx, kx = _apply_rope(qx, cos, sin), _apply_rope(kx, cos, sin)
    qc, kc, vc = _mla_qkv(dqc, dkvc, krc, q_norm, kv_norm, w_uq, w_ukv, gq, gk)
    k_all = jnp.concatenate([kx, kc], axis=1)
    v_all = jnp.concatenate([vx, vc], axis=1)
    b_, S = qx.shape[0], qx.shape[1]
    nb = S // Q_BLOCK
    qb = qx.reshape(b_, nb, Q_BLOCK, MLA_HEADS, MLA_QK).transpose(1, 0, 2, 3, 4)

    def attend(qblk):
        s = jnp.einsum('bqhd,bkhd->bhqk', qblk, k_all).astype(jnp.float32) * scale
        p = jax.nn.softmax(s, axis=-1).astype(v_all.dtype)
        return jnp.einsum('bhqk,bkhd->bqhd', p, v_all)

    ox = lax.map(attend, qb).transpose(1, 0, 2, 3, 4).reshape(b_, S, MLA_W)
    oc = None
    if need_ctx:
        s = jnp.einsum('bqhd,bkhd->bhqk', qc, kc).astype(jnp.float32) * scale
        p = jax.nn.softmax(s, axis=-1).astype(vc.dtype)
        oc = jnp.einsum('bhqk,bkhd->bqhd', p, vc).reshape(b_, qc.shape[1], MLA_W)
    return ox, oc


def _conv_centred(t, w, b):
    L = t.shape[1]
    left = CONV_W // 2
    tp = jnp.pad(t, ((0, 0), (left, CONV_W - 1 - left), (0, 0)))
    out = jnp.broadcast_to(b, t.shape).astype(t.dtype)
    for j in range(CONV_W):
        out = out + tp[:, j:j + L] * w[j]
    return out


def _rglru_gates(u, wa, ba, wx, bx, lam):
    b_, L, _ = u.shape
    ub = u.reshape(b_, L, LRU_BLOCKS, LRU_BD)
    r = jax.nn.sigmoid(jnp.einsum('blnd,nde->blne', ub, wa.astype(jnp.float32)).reshape(b_, L, LRU_W) + ba)
    ig = jax.nn.sigmoid(jnp.einsum('blnd,nde->blne', ub, wx.astype(jnp.float32)).reshape(b_, L, LRU_W) + bx)
    log_a = -LRU_C * r * jax.nn.softplus(-lam.astype(jnp.float32))
    a = jnp.exp(log_a)
    inp = jnp.sqrt(-jnp.expm1(2.0 * log_a)) * (ig * u)
    return a, inp


def _linear_scan(a, b, h0):
    def comb(l, r):
        return l[0] * r[0], r[0] * l[1] + r[1]
    A, H = lax.associative_scan(comb, (a, b), axis=1)
    return H + A * h0[:, None, :]


def _rglru_branch(px, pc, conv_w, conv_b, wa, ba, wx, bx, lam, need_ctx):
    xx, yx = px
    xc, yc = pc
    dt = xx.dtype
    ux = _conv_centred(xx, conv_w, conv_b).astype(jnp.float32)
    uc = _conv_centred(xc, conv_w, conv_b).astype(jnp.float32)
    hx_dirs, hc_dirs = [], []
    for d in range(2):
        ax, bxs = _rglru_gates(ux, wa[d], ba[d], wx[d], bx[d], lam[d])
        ac, bcs = _rglru_gates(uc, wa[d], ba[d], wx[d], bx[d], lam[d])
        if d == 1:
            ax, bxs, ac, bcs = (jnp.flip(t, axis=1) for t in (ax, bxs, ac, bcs))
        hc = _linear_scan(ac, bcs, jnp.zeros_like(uc[:, 0]))
        hx = _linear_scan(ax, bxs, hc[:, -1])
        if d == 1:
            hx, hc = jnp.flip(hx, axis=1), jnp.flip(hc, axis=1)
        hx_dirs.append(hx)
        hc_dirs.append(hc)
    out_x = ((hx_dirs[0] + hx_dirs[1]) * jax.nn.gelu(yx.astype(jnp.float32))).astype(dt)
    out_c = None
    if need_ctx:
        out_c = ((hc_dirs[0] + hc_dirs[1]) * jax.nn.gelu(yc.astype(jnp.float32))).astype(dt)
    return out_x, out_c


def _merge(o_hg, o_mla, o_lru, g_hg, g_mla, g_lru, w_br_hg, w_br_mla, w_br_lru, w_out):
    y = (jax.nn.sigmoid(g_hg) * (o_hg @ w_br_hg)
         + jax.nn.sigmoid(g_mla) * (o_mla @ w_br_mla)
         + jax.nn.sigmoid(g_lru) * (o_lru @ w_br_lru))
    return y @ w_out


def _hier_moe(h, w_rg, b_rg, w_re, b_re, w1, w3, w2):
    shp = h.shape
    t = h.reshape(-1, shp[-1])
    n = t.shape[0]
    lg = (t @ w_rg).astype(jnp.float32)
    g_sel = jnp.argmax(lg + b_rg.astype(jnp.float32), axis=-1)
    g_oh = jax.nn.one_hot(g_sel, N_GROUPS, dtype=jnp.float32)
    p_g = jnp.sum(jax.nn.softmax(lg, axis=-1) * g_oh, axis=-1, keepdims=True)
    le = (t @ w_re).astype(jnp.float32).reshape(n, N_GROUPS, EXP_PER_GROUP)
    le_g = jnp.einsum('ng,nge->ne', g_oh, le)
    bias_g = jnp.einsum('ng,ge->ne', g_oh, b_re.astype(jnp.float32).reshape(N_GROUPS, EXP_PER_GROUP))
    _, idx = lax.top_k(le_g + bias_g, TOP_K_IN_GROUP)
    w_sel = jax.nn.softmax(jnp.take_along_axis(le_g, idx, axis=1), axis=-1) * p_g
    e_sel = g_sel[:, None] * EXP_PER_GROUP + idx
    combine = jnp.einsum('nk,nke->ne', w_sel, jax.nn.one_hot(e_sel, N_EXPERTS, dtype=jnp.float32)).astype(t.dtype)
    out = jnp.zeros_like(t)
    for e in range(N_EXPERTS):
        hid = jax.nn.silu(t @ w1[e]) * (t @ w3[e])
        out = out + combine[:, e:e + 1] * (hid @ w2[e])
    return out.reshape(shp)


def setup_inputs(seed: int = 0) -> dict:
    key = jax.random.key(seed)
    ks = iter(jax.random.split(key, 48))

    def nrm(shape, scale):
        return jax.random.normal(next(ks), shape, jnp.float32) * scale

    def gain(shape):
        return 1.0 + nrm(shape, 0.02)

    L = DEPTH
    a0 = jax.random.uniform(next(ks), (L, 2, LRU_W), jnp.float32, 0.9, 0.999)
    sig = a0 ** (1.0 / LRU_C)
    return {
        'x': nrm((BATCH, SEQ, D_MODEL), 1.0),
        'c': nrm((BATCH, D_MODEL), 1.0),
        'ctx': nrm((BATCH, CTX_LEN, D_MODEL), 1.0),
        'c_ctx': nrm((D_MODEL,), 1.0),
        'w_mod': nrm((L, D_MODEL, 6 * D_MODEL), 0.5 * D_MODEL ** -0.5),
        'b_mod': nrm((L, 6 * D_MODEL), 0.02),
        'norm_mix': gain((L, D_MODEL)),
        'norm_ffn': gain((L, D_MODEL)),
        'w_in': nrm((L, D_MODEL, IN_WIDTH), D_MODEL ** -0.5),
        'hg_lb': nrm((L, 2, HG_W), 1.0),
        'hg_norm': gain((L, HG_DV)),
        'mla_q_norm': gain((L, MLA_Q_RANK)),
        'mla_kv_norm': gain((L, MLA_KV_RANK)),
        'mla_w_uq': nrm((L, MLA_Q_RANK, MLA_HEADS * MLA_QK), MLA_Q_RANK ** -0.5),
        'mla_w_ukv': nrm((L, MLA_KV_RANK, MLA_HEADS * (MLA_NOPE + MLA_V)), MLA_KV_RANK ** -0.5),
        'mla_qk_gain_q': gain((L, MLA_QK)),
        'mla_qk_gain_k': gain((L, MLA_QK)),
        'lru_conv_w': nrm((L, CONV_W, LRU_W), CONV_W ** -0.5),
        'lru_conv_b': nrm((L, LRU_W), 0.02),
        'lru_wa': nrm((L, 2, LRU_BLOCKS, LRU_BD, LRU_BD), LRU_BD ** -0.5),
        'lru_ba': nrm((L, 2, LRU_W), 0.02),
        'lru_wx': nrm((L, 2, LRU_BLOCKS, LRU_BD, LRU_BD), LRU_BD ** -0.5),
        'lru_bx': nrm((L, 2, LRU_W), 0.02),
        'lru_lambda': jnp.log(sig) - jnp.log1p(-sig),
        'w_br_hg': nrm((L, HG_W, D_MODEL), HG_W ** -0.5),
        'w_br_mla': nrm((L, MLA_W, D_MODEL), MLA_W ** -0.5),
        'w_br_lru': nrm((L, LRU_W, D_MODEL), LRU_W ** -0.5),
        'w_out': nrm((L, D_MODEL, D_MODEL), D_MODEL ** -0.5),
        'moe_w_rg': nrm((L, D_MODEL, N_GROUPS), D_MODEL ** -0.5),
        'moe_b_rg': nrm((L, N_GROUPS), 0.01),
        'moe_w_re': nrm((L, D_MODEL, N_EXPERTS), D_MODEL ** -0.5),
        'moe_b_re': nrm((L, N_EXPERTS), 0.01),
        'moe_w1': nrm((L, N_EXPERTS, D_MODEL, D_EXPERT), D_MODEL ** -0.5),
        'moe_w3': nrm((L, N_EXPERTS, D_MODEL, D_EXPERT), D_MODEL ** -0.5),
        'moe_w2': nrm((L, N_EXPERTS, D_EXPERT, D_MODEL), D_EXPERT ** -0.5),
    }


def reference(x, c, ctx, c_ctx, w_mod, b_mod, norm_mix, norm_ffn, w_in, hg_lb, hg_norm,
              mla_q_norm, mla_kv_norm, mla_w_uq, mla_w_ukv, mla_qk_gain_q, mla_qk_gain_k,
              lru_conv_w, lru_conv_b, lru_wa, lru_ba, lru_wx, lru_bx, lru_lambda,
              w_br_hg, w_br_mla, w_br_lru, w_out,
              moe_w_rg, moe_b_rg, moe_w_re, moe_b_re, moe_w1, moe_w3, moe_w2):
    rows = x.shape[1] // GRID_W
    cos, sin = _axial_rope(rows)
    lb_cs = jnp.cumsum(jax.nn.softmax(hg_lb.astype(jnp.float32), axis=0), axis=0)
    lb_all = lb_cs - lb_cs[0:1]
    xc = ctx
    for l in range(DEPTH):
        need_ctx = l < DEPTH - 1
        mx = jax.nn.silu(c) @ w_mod[l] + b_mod[l]
        mc = jax.nn.silu(c_ctx) @ w_mod[l] + b_mod[l]
        sh1x, sc1x, g1x, sh2x, sc2x, g2x = (m[:, None, :] for m in jnp.split(mx, 6, axis=-1))
        sh1c, sc1c, g1c, sh2c, sc2c, g2c = jnp.split(mc, 6, axis=-1)

        hx = _modulate(_rmsnorm(x, norm_mix[l]), sh1x, sc1x)
        hc = _modulate(_rmsnorm(xc, norm_mix[l]), sh1c, sc1c)
        px = _split_in(hx @ w_in[l])
        pc = _split_in(hc @ w_in[l])

        o_hg_x, o_hg_c = _hgrn2_branch(px[0:5], pc[0:5], lb_all[l], hg_norm[l], need_ctx)
        o_mla_x, o_mla_c = _mla_branch(px[5:8], pc[5:8], cos, sin, mla_q_norm[l], mla_kv_norm[l],
                                       mla_w_uq[l], mla_w_ukv[l], mla_qk_gain_q[l], mla_qk_gain_k[l], need_ctx)
        o_lru_x, o_lru_c = _rglru_branch(px[8:10], pc[8:10], lru_conv_w[l], lru_conv_b[l], lru_wa[l], lru_ba[l],
                                         lru_wx[l], lru_bx[l], lru_lambda[l], need_ctx)

        yx = _merge(o_hg_x, o_mla_x, o_lru_x, px[10], px[11], px[12], w_br_hg[l], w_br_mla[l], w_br_lru[l], w_out[l])
        x = x + g1x * yx
        if need_ctx:
            yc = _merge(o_hg_c, o_mla_c, o_lru_c, pc[10], pc[11], pc[12], w_br_hg[l], w_br_mla[l], w_br_lru[l], w_out[l])
            xc = xc + g1c * yc

        hx = _modulate(_rmsnorm(x, norm_ffn[l]), sh2x, sc2x)
        x = x + g2x * _hier_moe(hx, moe_w_rg[l], moe_b_rg[l], moe_w_re[l], moe_b_re[l], moe_w1[l], moe_w3[l], moe_w2[l])
        if need_ctx:
            hc = _modulate(_rmsnorm(xc, norm_ffn[l]), sh2c, sc2c)
            xc = xc + g2c * _hier_moe(hc, moe_w_rg[l], moe_b_rg[l], moe_w_re[l], moe_b_re[l], moe_w1[l], moe_w3[l], moe_w2[l])
    return x
```

```cpp
#include <hip/hip_runtime.h>
#include <stdint.h>
#include <stdio.h>
#include <string.h>

#define LAS __attribute__((address_space(3)))
#define DEVI __device__ __forceinline__
typedef unsigned short bf16_t;
typedef short bf16x8 __attribute__((ext_vector_type(8)));
typedef float f32x4 __attribute__((ext_vector_type(4)));
typedef float f32x16 __attribute__((ext_vector_type(16)));
typedef unsigned u32x4 __attribute__((ext_vector_type(4)));
typedef unsigned u32x2 __attribute__((ext_vector_type(2)));

constexpr int NB = 4, SEQ = 8192, CTX = 256, DM = 1024, DEPTH = 2;
constexpr int RB = SEQ + CTX;
constexpr int TT = NB * RB;
constexpr int HR = 2 * RB;
constexpr int NCH = RB / 64;
constexpr int INW = 7072;
constexpr int PA_W = 4096;
constexpr int PG_W = 3072;
constexpr int C_Q = 0, C_ZF = 512, C_ZB = 1024, C_I = 1536, C_G = 2048, C_DQ = 2560, C_DKV = 2816, C_KR = 2944, C_LX = 3072, C_LY = 3584;
constexpr int UPW = 1792;
constexpr int OCW = 1536;
constexpr int KVT_BYTES = 22016;
constexpr int KT_BYTES = 13312;
constexpr int NEXP = 16, DEXP = 256;
constexpr float EPSF = 1e-6f;
constexpr int LDS_TOTAL = 160 * 1024;

DEVI float bf2f(bf16_t b) { return __uint_as_float(((unsigned)b) << 16); }
DEVI bf16_t f2bf(float f) { return __builtin_bit_cast(bf16_t, (__bf16)f); }
typedef float f32x2_t __attribute__((ext_vector_type(2)));
typedef __bf16 bf16x2_t __attribute__((ext_vector_type(2)));
DEVI unsigned cvt_pk_bf16(float lo, float hi) { const f32x2_t v = {lo, hi}; return __builtin_bit_cast(unsigned, __builtin_convertvector(v, bf16x2_t)); }
DEVI float fast_exp2(float x) { return __builtin_amdgcn_exp2f(x); }
DEVI float fast_rcp(float x) { return __builtin_amdgcn_rcpf(x); }
DEVI float sigmoidf_(float x) { return fast_rcp(1.0f + fast_exp2(-1.44269504f * x)); }
DEVI float wave_sum(float v) { for (int o = 32; o >= 1; o >>= 1) v += __shfl_xor(v, o); return v; }
DEVI float wave_max(float v) { for (int o = 32; o >= 1; o >>= 1) v = fmaxf(v, __shfl_xor(v, o)); return v; }

DEVI int opq_tid() { int t = threadIdx.x; asm volatile("" : "+v"(t)); return t; }
DEVI int opq_bid() { int b = blockIdx.x; asm volatile("" : "+s"(b)); return b; }

DEVI int vzero() { int z = 0; asm volatile("" : "+v"(z)); return z; }

#define XB_TMO      128
#define XB_XCNT(j)  (256  + 64 * (j))
#define XB_XSUB(j)  (1280 + 64 * (j))
#define XB_XGEN(j)  (2304 + 64 * (j))
#define XB_TOP      3328
#define XB_TOPGEN   3392
#define XCD_BAR_WORDS 3456
#define XB_SPIN_CAP (1u << 18)

__device__ __forceinline__ unsigned xb_ld(unsigned* p)              { return __hip_atomic_load(p, __ATOMIC_RELAXED, __HIP_MEMORY_SCOPE_AGENT); }
__device__ __forceinline__ unsigned xb_add(unsigned* p, unsigned v) { return __hip_atomic_fetch_add(p, v, __ATOMIC_RELAXED, __HIP_MEMORY_SCOPE_AGENT); }
__device__ __forceinline__ unsigned xb_xcc_id() { return (unsigned)__builtin_amdgcn_s_getreg((3 << 11) | 20) & 0xFu; }
#define XB_SPIN(cond, bar) do { unsigned _sp = 0; while (cond) { __builtin_amdgcn_s_sleep(1); \
    if ((++_sp & 255u) == 0u) { if (xb_ld(&(bar)[XB_TMO])) break; if (_sp > XB_SPIN_CAP) { atomicAdd(&(bar)[XB_TMO], 1u); break; } } } } while (0)

struct XcdBarrier { unsigned* bar; unsigned x; volatile LAS unsigned* st; };

__device__ __forceinline__ XcdBarrier xcd_barrier_post(unsigned* bar, volatile LAS unsigned* st) {
    XcdBarrier b; b.bar = bar; b.x = xb_xcc_id(); b.st = st;
    if (threadIdx.x == 0) (void)xb_add(&bar[XB_XCNT(b.x)], 1u);
    return b;
}
__device__ __forceinline__ void xcd_barrier_complete(unsigned* bar, unsigned x, unsigned& nloc, unsigned& nx) {
    const unsigned G = gridDim.x * gridDim.y * gridDim.z;
    unsigned sum, cnt, mine, sp = 0u;
    for (;;) {
        sum = 0u; cnt = 0u; mine = 0u;
#pragma unroll
        for (unsigned j = 0; j < 16; ++j) { const unsigned c = xb_ld(&bar[XB_XCNT(j)]); sum += c; cnt += (c > 0u) ? 1u : 0u; mine = (j == x) ? c : mine; }
        if (sum == G) break;
        __builtin_amdgcn_s_sleep(1);
        if ((++sp & 255u) == 0u) { if (xb_ld(&bar[XB_TMO])) break; if (sp > XB_SPIN_CAP) { atomicAdd(&bar[XB_TMO], 1u); break; } }
    }
    nloc = mine > 0u ? mine : 1u; nx = cnt > 0u ? cnt : 1u;
}
__device__ __forceinline__ void xcd_barrier(const XcdBarrier& b) {
    asm volatile("s_waitcnt vmcnt(0)" ::: "memory");
    __syncthreads();
    if (threadIdx.x == 0) {
        unsigned* bar = b.bar;
        __builtin_amdgcn_s_waitcnt(0);
        unsigned nloc = b.st[0], nx = b.st[1];
        if (nloc == 0u) { xcd_barrier_complete(bar, b.x, nloc, nx); b.st[0] = nloc; b.st[1] = nx; }
        const unsigned old = xb_add(&bar[XB_XSUB(b.x)], 1u);
        const unsigned gen = old / nloc;
        if (old + 1u == (gen + 1u) * nloc) {
            __builtin_amdgcn_fence(__ATOMIC_RELEASE, "agent");
            asm volatile("s_waitcnt vmcnt(0)" ::: "memory");
            const unsigned og = xb_add(&bar[XB_TOP], 1u);
            const unsigned tg = og / nx;
            if (og + 1u == (tg + 1u) * nx) xb_add(&bar[XB_TOPGEN], 1u);
            else XB_SPIN(xb_ld(&bar[XB_TOPGEN]) == tg, bar);
            __builtin_amdgcn_fence(__ATOMIC_ACQUIRE, "agent");
            xb_add(&bar[XB_XGEN(b.x)], 1u);
            asm volatile("s_waitcnt vmcnt(0)" ::: "memory");
        } else {
            XB_SPIN(xb_ld(&bar[XB_XGEN(b.x)]) == gen, bar);
            __builtin_amdgcn_fence(__ATOMIC_ACQUIRE, "agent");
            asm volatile("s_waitcnt vmcnt(0)" ::: "memory");
        }
    }
    __syncthreads();
}

struct Params {
    const float* in[35];
    float* out;
    unsigned* ctrl;
    float* modv;
    float* lbv;
    float* xc;
    float* lrula;
    float* rope;
    bf16_t* winA; bf16_t* winG; bf16_t* wup; bf16_t* wcat; bf16_t* wout; bf16_t* w13; bf16_t* w2; bf16_t* wlru;
    bf16_t* hx;
    bf16_t* pa;
    bf16_t* up;
    bf16_t* q; bf16_t* qc; unsigned char* kv;
    bf16_t* st; float* stb;
    float* lsum; float* lin;
    bf16_t* ocat;
    bf16_t* y;
    bf16_t* h2; bf16_t* h2p; bf16_t* hid; bf16_t* yo;
    int* tok_e; int* tok_s; float* tok_w; int* lst; float* rww; int* rmr;
    unsigned long long pad_;
};

typedef LAS Params PL;

#define CTRL_CNT(l) (4096 + 64 * (l))
#define CTRL_WORDS 8192

namespace g8 {
constexpr int BM = 256, BK = 64, HALF = 128, HTB = HALF * BK * 2, STAGE_BYTES = 8 * HTB, NXCD = 8, WGM = 8;
__host__ __device__ __forceinline__ int lds_byte(int r, int c) { const int st = (r >> 4) * 2 + (c >> 5), rr = r & 15, cc = c & 31, ob = rr * 64 + cc * 2; return st * 1024 + (ob ^ (((ob >> 9) & 1) << 5)); }
__host__ __device__ __forceinline__ void stage_rc(int b, int& R, int& C) { const int st = b / 1024, sb = b % 1024, swz = sb ^ (((sb >> 9) & 1) << 5); R = (st >> 1) * 16 + swz / 64; C = (st & 1) * 32 + (swz % 64) / 2; }
__host__ __device__ __forceinline__ int perm32(int rho) { const int n = rho >> 4, i = rho & 15; return 8 * (i >> 2) + 4 * n + (i & 3); }

struct Unit { int pm, pn, tag; const char* a; const char* b; };

__device__ __forceinline__ bool static_order(int i, int G, int c, int nM, int nN, int& pm, int& pn) {
    const int nwg = nM * nN; const long L = (long)i * G + c; if (L >= nwg) return false;
    int wgid = (int)L; { const int q = nwg / NXCD, r = nwg % NXCD, xcd = wgid % NXCD, off = wgid / NXCD; wgid = (xcd < r ? xcd * (q + 1) : r * (q + 1) + (xcd - r) * q) + off; }
    const int nig = WGM * nN, gid = wgid / nig, fm = gid * WGM, gsz = (nM - fm) < WGM ? (nM - fm) : WGM;
    pm = fm + ((wgid % nig) % gsz); pn = (wgid % nig) / gsz; return true;
}

template <class Epi, class Sched>
__device__ __forceinline__ void gemm_phase(LAS unsigned char* lds, const int lda, const int ldb, const int K, const Sched& S, const Epi& E) {
    const int tid = opq_tid(), wid = __builtin_amdgcn_readfirstlane(tid >> 6), lane = tid & 63, wr = wid >> 2, wc = wid & 3, fr = lane & 15, fq = lane >> 4;
    const int nt = K / BK;
    unsigned voffB[2]; int RA[2], CA[2];
#pragma unroll
    for (int i = 0; i < 2; ++i) { int R, C; stage_rc(tid * 16 + i * 8192, R, C); const int Rb = Epi::PERM ? ((R & ~31) + perm32(R & 31)) : R;
        RA[i] = R; CA[i] = C; voffB[i] = (unsigned)(Rb * ldb + C) * 2u; }
    auto set_voff = [&](const Unit& u, unsigned (&v)[2][2]) {
#pragma unroll
        for (int h = 0; h < 2; ++h)
#pragma unroll
            for (int i = 0; i < 2; ++i) { if constexpr (Sched::GATHER) v[h][i] = (unsigned)S.row_of(u, h * HALF + RA[i]) * (unsigned)(lda * 2) + (unsigned)CA[i] * 2u;
                else v[h][i] = (unsigned)((h * HALF + RA[i]) * lda + CA[i]) * 2u; } };
    const size_t kstep = (size_t)(BK * 2);
    const size_t hstepB = (size_t)HALF * ldb * 2;
    const unsigned ldsw = (unsigned)wid * 1024u;
    const int aoff = lds_byte(wr * 64 + fr, fq * 8), boff = lds_byte(wc * 32 + fr, fq * 8);
#define G8_SA(b, h) (((b) * 2 + (h)) * HTB)
#define G8_SB(b, h) ((4 + (b) * 2 + (h)) * HTB)
#define G8_STAGE(bufoff, gbase, voff) do { _Pragma("unroll") for (int _i = 0; _i < 2; ++_i) \
        __builtin_amdgcn_global_load_lds((const unsigned*)((const char*)(gbase) + (voff)[_i]), (LAS unsigned*)(lds + (bufoff) + ldsw + _i * 8192), 16, 0, 0); } while (0)
#define G8_LDA(dst, b, h) do { _Pragma("unroll") for (int m = 0; m < 4; ++m) _Pragma("unroll") for (int k = 0; k < 2; ++k) dst[m][k] = *(const LAS bf16x8*)(lds + G8_SA(b, h) + aoff + m * 2048 + k * 1024); } while (0)
#define G8_LDB(dst, b, h) do { _Pragma("unroll") for (int n = 0; n < 2; ++n) _Pragma("unroll") for (int k = 0; k < 2; ++k) dst[n][k] = *(const LAS bf16x8*)(lds + G8_SB(b, h) + boff + n * 2048 + k * 1024); } while (0)
#define G8_MMA(ai, bj, At, Bt) do { __builtin_amdgcn_s_setprio(1); _Pragma("unroll") for (int m = 0; m < 4; ++m) _Pragma("unroll") for (int n = 0; n < 2; ++n) _Pragma("unroll") for (int k = 0; k < 2; ++k) \
        acc[ai][bj][m][n] = __builtin_amdgcn_mfma_f32_16x16x32_bf16(Bt[n][k], At[m][k], acc[ai][bj][m][n], 0, 0, 0); __builtin_amdgcn_s_setprio(0); } while (0)
#define G8_WAIT_V(n) asm volatile("s_waitcnt vmcnt(" #n ")" ::: "memory")
#define G8_WAIT_L(n) asm volatile("s_waitcnt lgkmcnt(" #n ")" ::: "memory")
#define G8_BAR __builtin_amdgcn_s_barrier()
#define G8_SCHED __builtin_amdgcn_sched_barrier(0)
    Unit cur, nxt; int ui = 0;
    if (!S.next(0, cur)) return;
    f32x4 acc[2][2][4][2];
#pragma unroll
    for (int a = 0; a < 2; ++a)
#pragma unroll
        for (int b = 0; b < 2; ++b)
#pragma unroll
            for (int m = 0; m < 4; ++m)
#pragma unroll
                for (int n = 0; n < 2; ++n) acc[a][b][m][n] = (f32x4){0.f, 0.f, 0.f, 0.f};
    bf16x8 At[4][2], B0[2][2], B1[2][2];
    const char* cA = cur.a; const char* cB = cur.b;
    unsigned vcur[2][2], vnxt[2][2]; set_voff(cur, vcur);
    asm volatile("s_waitcnt lgkmcnt(0)" ::: "memory");
    if constexpr (Sched::GATHER) asm volatile("s_waitcnt vmcnt(0)" ::: "memory");
    G8_STAGE(G8_SB(0, 0), cB, voffB); G8_STAGE(G8_SA(0, 0), cA, vcur[0]); G8_STAGE(G8_SB(0, 1), cB + hstepB, voffB); G8_STAGE(G8_SA(0, 1), cA, vcur[1]);
    if (wr == 1) G8_BAR;
    G8_WAIT_V(4); G8_BAR;
    G8_STAGE(G8_SB(1, 0), cB + kstep, voffB); G8_STAGE(G8_SA(1, 0), cA + kstep, vcur[0]); G8_STAGE(G8_SB(1, 1), cB + hstepB + kstep, voffB);
    G8_WAIT_V(6); G8_BAR;
    for (;;) {
        const bool has_next = S.next(ui + 1, nxt);
        const char* nA = has_next ? nxt.a : cA; const char* nB = has_next ? nxt.b : cB;
        if (has_next) set_voff(nxt, vnxt); else {
#pragma unroll
            for (int h = 0; h < 2; ++h) { vnxt[h][0] = vcur[h][0]; vnxt[h][1] = vcur[h][1]; } }
        asm volatile("s_waitcnt lgkmcnt(0)" ::: "memory");
        const int tseg = nt / Epi::NSEG;
#pragma unroll 1
        for (int sg = 0; sg < Epi::NSEG; ++sg) {
#pragma unroll 1
        for (int t = sg * tseg; t < (sg + 1) * tseg; t += 2) {
            const bool last = (t == nt - 2);
            const char* a1 = cA + (size_t)(t + 1) * kstep;
            const char* a2 = last ? nA : cA + (size_t)(t + 2) * kstep; const char* b2 = last ? nB : cB + (size_t)(t + 2) * kstep;
            const char* a3 = a2 + kstep; const char* b3 = b2 + kstep;
            unsigned v20[2], v21[2];
#pragma unroll
            for (int i = 0; i < 2; ++i) { v20[i] = last ? vnxt[0][i] : vcur[0][i]; v21[i] = last ? vnxt[1][i] : vcur[1][i]; }
            G8_LDB(B0, 0, 0); G8_SCHED; G8_LDA(At, 0, 0); G8_STAGE(G8_SA(1, 1), a1, vcur[1]);
            G8_WAIT_L(8); G8_BAR; G8_WAIT_L(0); G8_MMA(0, 0, At, B0); G8_BAR; G8_SCHED;
            G8_LDB(B1, 0, 1); G8_STAGE(G8_SB(0, 0), b2, voffB);
            G8_BAR; G8_WAIT_L(0); G8_MMA(0, 1, At, B1); G8_BAR;
            G8_LDA(At, 0, 1); G8_STAGE(G8_SA(0, 0), a2, v20);
            G8_BAR; G8_WAIT_L(0); G8_MMA(1, 0, At, B0); G8_BAR; G8_SCHED;
            G8_STAGE(G8_SB(0, 1), b2 + hstepB, voffB);
            G8_WAIT_V(6); G8_BAR; G8_MMA(1, 1, At, B1); G8_BAR;
            G8_LDB(B0, 1, 0); G8_SCHED; G8_LDA(At, 1, 0); G8_STAGE(G8_SA(0, 1), a2, v21);
            G8_WAIT_L(8); G8_BAR; G8_WAIT_L(0); G8_MMA(0, 0, At, B0); G8_BAR; G8_SCHED;
            G8_LDB(B1, 1, 1); G8_STAGE(G8_SB(1, 0), b3, voffB);
            G8_BAR; G8_WAIT_L(0); G8_MMA(0, 1, At, B1); G8_BAR;
            G8_LDA(At, 1, 1); G8_STAGE(G8_SA(1, 0), a3, v20);
            G8_BAR; G8_WAIT_L(0); G8_MMA(1, 0, At, B0); G8_BAR; G8_SCHED;
            G8_STAGE(G8_SB(1, 1), b3 + hstepB, voffB);
            G8_WAIT_V(6); G8_BAR; G8_MMA(1, 1, At, B1); G8_BAR;
        }
        if constexpr (Epi::NSEG > 1) { if (sg + 1 < Epi::NSEG) E.mid(sg, acc, cur, wr, wc, fr, fq); }
        }
        E(acc, cur, wr, wc, fr, fq);
        if (!has_next) break;
#pragma unroll
        for (int a = 0; a < 2; ++a)
#pragma unroll
            for (int b = 0; b < 2; ++b)
#pragma unroll
                for (int m = 0; m < 4; ++m)
#pragma unroll
                    for (int n = 0; n < 2; ++n) acc[a][b][m][n] = (f32x4){0.f, 0.f, 0.f, 0.f};
        cur = nxt; cA = nA; cB = nB; ++ui;
#pragma unroll
        for (int h = 0; h < 2; ++h) { vcur[h][0] = vnxt[h][0]; vcur[h][1] = vnxt[h][1]; }
    }
    G8_WAIT_V(0);
    if (wr == 0) G8_BAR;
    G8_BAR;
#undef G8_SA
#undef G8_SB
#undef G8_STAGE
#undef G8_LDA
#undef G8_LDB
#undef G8_MMA
#undef G8_WAIT_V
#undef G8_WAIT_L
#undef G8_BAR
#undef G8_SCHED
}
}

enum { I_X = 0, I_C, I_CTX, I_CCTX, I_WMOD, I_BMOD, I_NMIX, I_NFFN, I_WIN, I_HGLB, I_HGNORM, I_QNORM, I_KVNORM, I_WUQ, I_WUKV, I_GQ, I_GK,
       I_CONVW, I_CONVB, I_LWA, I_LBA, I_LWX, I_LBX, I_LAM, I_BRHG, I_BRMLA, I_BRLRU, I_WOUT, I_WRG, I_BRG, I_WRE, I_BRE, I_W1, I_W3, I_W2 };

DEVI const float* xin_row_l0(const Params& p, int r) { const int b = r / RB, pos = r - b * RB;
    return pos < SEQ ? p.in[I_X] + ((size_t)b * SEQ + pos) * DM : p.in[I_CTX] + ((size_t)b * CTX + (pos - SEQ)) * DM; }
DEVI float* xbuf_row(const Params& p, int r) { const int b = r / RB, pos = r - b * RB;
    return pos < SEQ ? p.out + ((size_t)b * SEQ + pos) * DM : p.xc + ((size_t)b * CTX + (pos - SEQ)) * DM; }
DEVI int mod_row(int r) { const int b = r / RB, pos = r - b * RB; return pos < SEQ ? b : 4; }

struct TrJob { const float* src; int ld; int K; int ncols; bf16_t* dst; int dld; const float* ks; };

DEVI int tr_job_count() { return DEPTH * (11 + 16 * 5 + 32); }
template <class P> DEVI TrJob tr_job(const P& p, int j) {
    const int per = 11 + 16 * 5 + 32; const int l = j / per; int q = j - l * per; TrJob t; t.ks = nullptr; t.src = nullptr;
    const float* win = p.in[I_WIN] + (size_t)l * DM * INW;
    bf16_t* winA = p.winA + (size_t)l * PA_W * DM; bf16_t* wup = p.wup + (size_t)l * UPW * 256; bf16_t* wcat = p.wcat + (size_t)l * DM * OCW;
    if (q == 0) { t.src = win; t.ld = INW; t.K = DM; t.ncols = 2976; t.dst = winA; t.dld = DM; return t; }
    if (q == 1) { t.src = nullptr; t.ld = 0; t.K = DM; t.ncols = 96; t.dst = winA + (size_t)2976 * DM; t.dld = DM; return t; }
    if (q == 2) { t.src = win + 2976; t.ld = INW; t.K = DM; t.ncols = 1024; t.dst = winA + (size_t)3072 * DM; t.dld = DM; return t; }
    if (q == 3) { t.src = win + 4000; t.ld = INW; t.K = DM; t.ncols = PG_W; t.dst = p.winG + (size_t)l * PG_W * DM; t.dld = DM; return t; }
    if (q == 4) { t.src = p.in[I_WUQ] + (size_t)l * 256 * 768; t.ld = 768; t.K = 256; t.ncols = 768; t.dst = wup; t.dld = 256; t.ks = p.in[I_QNORM] + l * 256; return t; }
    if (q == 5) { t.src = p.in[I_WUKV] + (size_t)l * 128 * 1024; t.ld = 1024; t.K = 128; t.ncols = 1024; t.dst = wup + (size_t)768 * 256; t.dld = 256; t.ks = p.in[I_KVNORM] + l * 128; return t; }
    if (q == 6) { t.src = nullptr; t.ld = 0; t.K = 128; t.ncols = 1024; t.dst = wup + (size_t)768 * 256 + 128; t.dld = 256; return t; }
    if (q >= 7 && q <= 9) { const int i = q - 7; const float* s = (i == 0 ? p.in[I_BRHG] : i == 1 ? p.in[I_BRMLA] : p.in[I_BRLRU]) + (size_t)l * 512 * DM;
        t.src = s; t.ld = DM; t.K = 512; t.ncols = DM; t.dst = wcat + i * 512; t.dld = OCW; return t; }
    if (q == 10) { t.src = p.in[I_WOUT] + (size_t)l * DM * DM; t.ld = DM; t.K = DM; t.ncols = DM; t.dst = p.wout + (size_t)l * DM * DM; t.dld = DM; return t; }
    q -= 11;
    if (q < 80) { const int e = q / 5, s = q % 5; const size_t le = (size_t)l * NEXP + e;
        if (s < 4) { const int pn = s >> 1, which = s & 1;
            t.src = (which ? p.in[I_W3] : p.in[I_W1]) + le * DM * DEXP + pn * 128; t.ld = DEXP; t.K = DM; t.ncols = 128;
            t.dst = p.w13 + le * 512 * DM + (size_t)(pn * 256 + which * 128) * DM; t.dld = DM; return t; }
        t.src = p.in[I_W2] + le * DEXP * DM; t.ld = DM; t.K = DEXP; t.ncols = DM; t.dst = p.w2 + le * DM * DEXP; t.dld = DEXP; return t; }
    q -= 80;
    { const int d = q >> 4, n = (q >> 1) & 7, which = q & 1;
      const size_t blk = (((size_t)l * 2 + d) * 8 + n);
      t.src = (which ? p.in[I_LWX] : p.in[I_LWA]) + blk * 64 * 64; t.ld = 64; t.K = 64; t.ncols = 64;
      t.dst = p.wlru + (blk * 2 + which) * 64 * 64; t.dld = 64; return t; }
}

template <class P> DEVI void phase_prep(const P& p, LAS unsigned char* lds) {
    const int tid = opq_tid(), G = gridDim.x;
    LAS float* tl = (LAS float*)lds;
    int rot = 0; const int nj = tr_job_count();
    for (int j = 0; j < nj; ++j) {
        const TrJob t = tr_job(p, j);
        const int tk = t.K / 64, ntile = tk * (t.ncols / 32);
        const int first = (int)((opq_bid() + (unsigned)G - (unsigned)(rot % G)) % (unsigned)G);
        for (int tile0 = first; tile0 < ntile; tile0 += 8 * G) {
            float v[8][4];
#pragma unroll
            for (int q = 0; q < 8; ++q) { const int tile = tile0 + q * G; const int k0 = (tile % tk) * 64, n0 = (tile / tk) * 32; const int n = tid & 31, kr = tid >> 5;
#pragma unroll
                for (int i = 0; i < 4; ++i) { const int k = kr + 16 * i; float x = 0.f;
                    if (tile < ntile && t.src) { x = t.src[(size_t)(k0 + k) * t.ld + n0 + n]; if (t.ks) x *= t.ks[k0 + k]; }
                    v[q][i] = x; } }
#pragma unroll
            for (int q = 0; q < 8; ++q) { const int n = tid & 31, kr = tid >> 5;
#pragma unroll
                for (int i = 0; i < 4; ++i) tl[q * 2112 + (kr + 16 * i) * 33 + n] = v[q][i]; }
            __syncthreads();
#pragma unroll
            for (int q = 0; q < 8; ++q) { const int tile = tile0 + q * G; if (tile < ntile) { const int k0 = (tile % tk) * 64, n0 = (tile / tk) * 32; const int k = tid & 63, nn = tid >> 6;
#pragma unroll
                for (int i = 0; i < 4; ++i) { const int n = nn + 8 * i; t.dst[(size_t)(n0 + n) * t.dld + k0 + k] = f2bf(tl[q * 2112 + k * 33 + n]); } } }
            __syncthreads();
        }
        rot += ntile;
    }
    {
        LAS float* sl = (LAS float*)lds;
        LAS float* red = sl + 5 * 1024;
        for (int i = tid; i < 5 * 1024; i += 512) { const int r = i >> 10, k = i & 1023; const float v = r < 4 ? p.in[I_C][r * DM + k] : p.in[I_CCTX][k]; sl[i] = v * sigmoidf_(v); }
        __syncthreads();
        for (int u = opq_bid(); u < DEPTH * 96; u += G) {
            const int l = u / 96, n0 = (u % 96) * 64, col = tid & 63, ks = tid >> 6;
            const float* w = p.in[I_WMOD] + (size_t)l * DM * 6144 + n0 + col;
            float a0 = 0.f, a1 = 0.f, a2 = 0.f, a3 = 0.f, a4 = 0.f;
#pragma unroll 8
            for (int k = ks * 128; k < ks * 128 + 128; ++k) { const float wv = w[(size_t)k * 6144];
                a0 += sl[k] * wv; a1 += sl[1024 + k] * wv; a2 += sl[2048 + k] * wv; a3 += sl[3072 + k] * wv; a4 += sl[4096 + k] * wv; }
            red[(ks * 5 + 0) * 64 + col] = a0; red[(ks * 5 + 1) * 64 + col] = a1; red[(ks * 5 + 2) * 64 + col] = a2; red[(ks * 5 + 3) * 64 + col] = a3; red[(ks * 5 + 4) * 64 + col] = a4;
            __syncthreads();
            if (tid < 320) { const int r = tid >> 6, c2 = tid & 63; float s = p.in[I_BMOD][l * 6144 + n0 + c2];
#pragma unroll
                for (int q = 0; q < 8; ++q) s += red[(q * 5 + r) * 64 + c2];
                p.modv[((size_t)l * 5 + r) * 6144 + n0 + c2] = s; }
            __syncthreads();
        }
    }
    for (int i = opq_bid() * 512 + tid; i < SEQ * 16; i += G * 512) { const int pos = i >> 4, a = i & 15;
        const float inv = exp2f(-(float)(a & 7) * (13.287712379549449f / 8.0f)); const float ang = (float)((a < 8) ? (pos >> 6) : (pos & 63)) * inv;
        float sn, cs; sincosf(ang, &sn, &cs); p.rope[(size_t)pos * 32 + a] = cs; p.rope[(size_t)pos * 32 + 16 + a] = sn; }
    if (opq_bid() == 1) { for (int i = tid; i < DEPTH * 2 * 512; i += 512) p.lrula[i] = -8.0f * 1.44269504f * log1pf(__expf(-p.in[I_LAM][i])); }
    if (opq_bid() == 0) {
        for (int i = tid; i < 2 * 512; i += 512) { const float a0 = p.in[I_HGLB][i], a1 = p.in[I_HGLB][1024 + i]; const float m = fmaxf(a0, a1);
            const float e0 = __expf(a0 - m), e1 = __expf(a1 - m); p.lbv[i] = 0.f; p.lbv[1024 + i] = e1 / (e0 + e1); }
    }
}

DEVI void phase_norm1(const Params& p, int l, int hb) {
    const int lane = opq_tid() & 63, wv = opq_tid() >> 6;
    const float* gm = p.in[I_NMIX] + l * DM;
    for (int rl = opq_bid() * 8 + wv; rl < HR; rl += gridDim.x * 8) {
        const int r = hb * HR + rl;
        const float* src = (l == 0) ? xin_row_l0(p, r) : (const float*)xbuf_row(p, r);
        f32x4 v[4]; float ss = 0.f;
#pragma unroll
        for (int i = 0; i < 4; ++i) { v[i] = *(const f32x4*)(src + i * 256 + lane * 4); ss += v[i][0] * v[i][0] + v[i][1] * v[i][1] + v[i][2] * v[i][2] + v[i][3] * v[i][3]; }
        ss = wave_sum(ss);
        const float rstd = rsqrtf(ss * (1.0f / DM) + EPSF);
        const float* mv = p.modv + ((size_t)l * 5 + mod_row(r)) * 6144;
#pragma unroll
        for (int i = 0; i < 4; ++i) { const int c = i * 256 + lane * 4;
            const f32x4 g = *(const f32x4*)(gm + c), sh = *(const f32x4*)(mv + c), sc = *(const f32x4*)(mv + 1024 + c);
            f32x4 h;
#pragma unroll
            for (int e = 0; e < 4; ++e) h[e] = v[i][e] * rstd * g[e] * (1.0f + sc[e]) + sh[e];
            u32x2 w; w.x = cvt_pk_bf16(h[0], h[1]); w.y = cvt_pk_bf16(h[2], h[3]);
            *(u32x2*)(p.hx + (size_t)rl * DM + c) = w; }
    }
}

struct TileSched {
    static constexpr bool GATHER = false;
    int nM, nN, G, c, skipctx; const char* A; const char* B; size_t atile, btile; size_t acol_bytes;
    DEVI bool next(int i, g8::Unit& u) const {
        int pm, pn; if (!g8::static_order(i, G, c, nM, nN, pm, pn)) return false;
        const int pma = skipctx ? pm + pm / 32 : pm;
        u.pm = pma; u.pn = pn; u.tag = 0; u.a = A + (size_t)pma * atile + acol_bytes; u.b = B + (size_t)pn * btile; return true; }
};

template <int ACT> struct EpiBf16 {
    static constexpr bool PERM = true, HAS_MID = false; static constexpr int NSEG = 1;
    bf16_t* O; int ldc;
    DEVI void operator()(const f32x4 (&acc)[2][2][4][2], const g8::Unit& u, int wr, int wc, int fr, int fq) const {
        const int row0 = u.pm * 256 + wr * 64 + fr, col0 = u.pn * 256 + wc * 32 + 8 * fq;
#pragma unroll
        for (int ai = 0; ai < 2; ++ai)
#pragma unroll
            for (int m = 0; m < 4; ++m) { bf16_t* rowp = O + (size_t)(row0 + ai * 128 + m * 16) * ldc + col0;
#pragma unroll
                for (int bj = 0; bj < 2; ++bj) { f32x4 v0 = acc[ai][bj][m][0], v1 = acc[ai][bj][m][1];
                    if (ACT == 1) {
#pragma unroll
                        for (int e = 0; e < 4; ++e) { v0[e] = sigmoidf_(v0[e]); v1[e] = sigmoidf_(v1[e]); } }
                    u32x4 w; w.x = cvt_pk_bf16(v0[0], v0[1]); w.y = cvt_pk_bf16(v0[2], v0[3]); w.z = cvt_pk_bf16(v1[0], v1[1]); w.w = cvt_pk_bf16(v1[2], v1[3]);
                    *(u32x4*)(rowp + bj * 128) = w; } }
    }
};

DEVI void phase_inproj_a(const Params& p, int l, LAS unsigned char* lds) {
    TileSched S; S.nM = HR / 256; S.nN = PA_W / 256; S.G = gridDim.x; S.c = opq_bid(); S.skipctx = 0;
    S.A = (const char*)p.hx; S.B = (const char*)(p.winA + (size_t)l * PA_W * DM); S.atile = (size_t)256 * DM * 2; S.btile = (size_t)256 * DM * 2; S.acol_bytes = 0;
    EpiBf16<0> E; E.O = p.pa; E.ldc = PA_W;
    g8::gemm_phase(lds, DM, DM, DM, S, E);
}

struct UpSched { static constexpr bool GATHER = false; int G, c; const char* A; const char* B;
    DEVI bool next(int i, g8::Unit& u) const { const long L = (long)i * G + c; if (L >= (HR / 256) * 7) return false;
        const int pm = (int)(L / 7), j = (int)(L % 7); u.pm = pm; u.pn = j; u.tag = 0;
        u.a = A + (size_t)pm * 256 * PA_W * 2 + (size_t)(j < 3 ? C_DQ : C_DKV) * 2; u.b = B + (size_t)j * 256 * 256 * 2; return true; } };
DEVI void phase_mla_up(const Params& p, int l, LAS unsigned char* lds) {
    UpSched S; S.G = gridDim.x; S.c = opq_bid(); S.A = (const char*)p.pa; S.B = (const char*)(p.wup + (size_t)l * UPW * 256);
    EpiBf16<0> E; E.O = p.up; E.ldc = UPW;
    g8::gemm_phase(lds, PA_W, 256, 256, S, E);
}

DEVI void phase_inproj_g(const Params& p, int l, LAS unsigned char* lds) {
    const int skip = (l == DEPTH - 1);
    TileSched S; S.nM = skip ? 64 : HR / 256; S.nN = PG_W / 256; S.G = gridDim.x; S.c = opq_bid(); S.skipctx = skip;
    S.A = (const char*)p.hx; S.B = (const char*)(p.winG + (size_t)l * PG_W * DM); S.atile = (size_t)256 * DM * 2; S.btile = (size_t)256 * DM * 2; S.acol_bytes = 0;
    EpiBf16<1> E; E.O = p.pa; E.ldc = PG_W;
    g8::gemm_phase(lds, DM, DM, DM, S, E);
}

struct EpiMerge {
    static constexpr bool PERM = false; static constexpr int NSEG = 3;
    const bf16_t* pg; bf16_t* Y;
    DEVI void mid(int sg, f32x4 (&acc)[2][2][4][2], const g8::Unit& u, int wr, int wc, int fr, int fq) const {
        const int row0 = u.pm * 256 + wr * 64 + fr, col0 = u.pn * 256 + wc * 32 + 4 * fq;
        const bf16_t* gbase = pg + (size_t)row0 * PG_W + col0 + sg * 1024;
#pragma unroll
        for (int ai = 0; ai < 2; ++ai)
#pragma unroll
            for (int m = 0; m < 4; ++m) { const bf16_t* gp = gbase + (size_t)(ai * 128 + m * 16) * PG_W;
#pragma unroll
                for (int bj = 0; bj < 2; ++bj)
#pragma unroll
                    for (int n = 0; n < 2; ++n) { const int co = bj * 128 + n * 16;
                        const u32x2 a = *(const u32x2*)(gp + co), b = *(const u32x2*)(gp + 1024 + co);
                        const float a0 = __uint_as_float(a.x << 16), a1 = __uint_as_float(a.x & 0xffff0000u), a2 = __uint_as_float(a.y << 16), a3 = __uint_as_float(a.y & 0xffff0000u);
                        const float b0 = __uint_as_float(b.x << 16), b1 = __uint_as_float(b.x & 0xffff0000u), b2 = __uint_as_float(b.y << 16), b3 = __uint_as_float(b.y & 0xffff0000u);
                        f32x4& v = acc[ai][bj][m][n];
                        v[0] *= a0 * fast_rcp(fmaxf(b0, 1e-30f)); v[1] *= a1 * fast_rcp(fmaxf(b1, 1e-30f)); v[2] *= a2 * fast_rcp(fmaxf(b2, 1e-30f)); v[3] *= a3 * fast_rcp(fmaxf(b3, 1e-30f)); }
                asm volatile("" : "+v"(acc[ai][0][m][0]), "+v"(acc[ai][0][m][1]), "+v"(acc[ai][1][m][0]), "+v"(acc[ai][1][m][1]) :: "memory"); }
    }
    DEVI void operator()(f32x4 (&acc)[2][2][4][2], const g8::Unit& u, int wr, int wc, int fr, int fq) const {
        const int row0 = u.pm * 256 + wr * 64 + fr, col0 = u.pn * 256 + wc * 32 + 4 * fq;
#pragma unroll
        for (int ai = 0; ai < 2; ++ai)
#pragma unroll
            for (int m = 0; m < 4; ++m) { const bf16_t* gp = pg + (size_t)(row0 + ai * 128 + m * 16) * PG_W + col0 + 2048;
#pragma unroll
                for (int bj = 0; bj < 2; ++bj)
#pragma unroll
                    for (int n = 0; n < 2; ++n) { const int co = bj * 128 + n * 16;
                        const u32x2 a = *(const u32x2*)(gp + co);
                        const float a0 = __uint_as_float(a.x << 16), a1 = __uint_as_float(a.x & 0xffff0000u), a2 = __uint_as_float(a.y << 16), a3 = __uint_as_float(a.y & 0xffff0000u);
                        const f32x4 v = acc[ai][bj][m][n];
                        u32x2 w; w.x = cvt_pk_bf16(v[0] * a0, v[1] * a1); w.y = cvt_pk_bf16(v[2] * a2, v[3] * a3);
                        *(u32x2*)(Y + (size_t)(row0 + ai * 128 + m * 16) * DM + col0 + co) = w; }
                asm volatile("" ::: "memory"); }
    }
};
DEVI void phase_merge(const Params& p, int l, LAS unsigned char* lds) {
    const int skip = (l == DEPTH - 1);
    TileSched S; S.nM = skip ? 64 : HR / 256; S.nN = DM / 256; S.G = gridDim.x; S.c = opq_bid(); S.skipctx = skip;
    S.A = (const char*)p.ocat; S.B = (const char*)(p.wcat + (size_t)l * DM * OCW); S.atile = (size_t)256 * OCW * 2; S.btile = (size_t)256 * OCW * 2; S.acol_bytes = 0;
    EpiMerge E; E.pg = p.pa; E.Y = p.y;
    g8::gemm_phase(lds, OCW, OCW, OCW, S, E);
}

struct EpiOut {
    static constexpr bool PERM = false, HAS_MID = false; static constexpr int NSEG = 1;
    const float* x0; const float* c0; float* xo_; float* xc_; const float* modv; int l, hb;
    DEVI void operator()(const f32x4 (&acc)[2][2][4][2], const g8::Unit& u, int wr, int wc, int fr, int fq) const {
        const int row0 = u.pm * 256 + wr * 64 + fr, col0 = u.pn * 256 + wc * 32 + 4 * fq;
#pragma unroll
        for (int ai = 0; ai < 2; ++ai)
#pragma unroll
            for (int m = 0; m < 4; ++m) { const int r = hb * HR + row0 + ai * 128 + m * 16;
                const int b = r / RB, pos = r - b * RB; const bool lat = pos < SEQ;
                const size_t xoff = lat ? ((size_t)b * SEQ + pos) * DM : ((size_t)b * CTX + (pos - SEQ)) * DM;
                float* xo = (lat ? xo_ : xc_) + xoff; const float* xi = (l == 0) ? (lat ? x0 : c0) + xoff : (const float*)xo;
                const float* g1 = modv + ((size_t)l * 5 + (lat ? b : 4)) * 6144 + 2048;
#pragma unroll
                for (int bj = 0; bj < 2; ++bj)
#pragma unroll
                    for (int n = 0; n < 2; ++n) { const int c = col0 + bj * 128 + n * 16;
                        const f32x4 xv = *(const f32x4*)(xi + c), gv = *(const f32x4*)(g1 + c);
                        *(f32x4*)(xo + c) = xv + gv * acc[ai][bj][m][n]; } }
    }
};
DEVI void phase_outproj(const Params& p, int l, int hb, LAS unsigned char* lds) {
    const int skip = (l == DEPTH - 1);
    TileSched S; S.nM = skip ? 64 : HR / 256; S.nN = DM / 256; S.G = gridDim.x; S.c = opq_bid(); S.skipctx = skip;
    S.A = (const char*)p.y; S.B = (const char*)(p.wout + (size_t)l * DM * DM); S.atile = (size_t)256 * DM * 2; S.btile = (size_t)256 * DM * 2; S.acol_bytes = 0;
    EpiOut E; E.x0 = p.in[I_X]; E.c0 = p.in[I_CTX]; E.xo_ = p.out; E.xc_ = p.xc; E.modv = p.modv; E.l = l; E.hb = hb;
    g8::gemm_phase(lds, DM, DM, DM, S, E);
}

DEVI void phase_qkv(const Params& p, int l, LAS unsigned char* lds) {
    const int tid = opq_tid(), lane = tid & 63, wv = tid >> 6, h = lane >> 3, sub = lane & 7;
    LAS bf16_t* vt = (LAS bf16_t*)lds;
    const float* gq = p.in[I_GQ] + l * 96; const float* gk = p.in[I_GK] + l * 96;
    float gqn[8], gkn[8], gqr[4], gkr[4];
#pragma unroll
    for (int e = 0; e < 8; ++e) { gqn[e] = gq[sub * 8 + e]; gkn[e] = gk[sub * 8 + e]; }
#pragma unroll
    for (int e = 0; e < 4; ++e) { gqr[e] = gq[64 + sub * 4 + e]; gkr[e] = gk[64 + sub * 4 + e]; }
    const float qscale = 0.10206207261596577f * 1.4426950408889634f;
    const bool need_ctx_q = (l < DEPTH - 1);
    const bool upper = (sub & 4) != 0;
    for (int u = opq_bid(); u < 2 * NCH * 4; u += gridDim.x) {
        const int bl = u / (NCH * 4), tile = (u >> 2) % NCH, qtr = u & 3;
#pragma unroll
        for (int it = 0; it < 2; ++it) {
            const int r16 = wv * 2 + it, rr = qtr * 16 + r16, pos = tile * 64 + rr, rl = bl * RB + pos;
            const bool lat = pos < SEQ;
            const bf16_t* prow = p.pa + (size_t)rl * PA_W; const bf16_t* urow = p.up + (size_t)rl * UPW;
            const u32x2 dqw = *(const u32x2*)(prow + C_DQ + lane * 4);
            const unsigned dkw = *(const unsigned*)(prow + C_DKV + lane * 2);
            const u32x2 krw = *(const u32x2*)(prow + C_KR + sub * 4);
            const u32x4 qnw = *(const u32x4*)(urow + h * 96 + sub * 8); const u32x2 qrw = *(const u32x2*)(urow + h * 96 + 64 + sub * 4);
            const u32x4 knw = *(const u32x4*)(urow + 768 + h * 128 + sub * 8); const u32x4 vw = *(const u32x4*)(urow + 768 + h * 128 + 64 + sub * 8);
            f32x4 cs4 = {1.f, 1.f, 1.f, 1.f}, sn4 = {0.f, 0.f, 0.f, 0.f};
            if (lat) { const float* rt = p.rope + (size_t)pos * 32 + (sub & 3) * 4; cs4 = *(const f32x4*)rt; sn4 = *(const f32x4*)(rt + 16); }
            float sq, skv;
            { const float a0 = __uint_as_float(dqw.x << 16), a1 = __uint_as_float(dqw.x & 0xffff0000u), a2 = __uint_as_float(dqw.y << 16), a3 = __uint_as_float(dqw.y & 0xffff0000u);
              sq = a0 * a0 + a1 * a1 + a2 * a2 + a3 * a3;
              const float b0 = __uint_as_float(dkw << 16), b1 = __uint_as_float(dkw & 0xffff0000u); skv = b0 * b0 + b1 * b1; }
            sq = wave_sum(sq); skv = wave_sum(skv);
            const float rq = rsqrtf(sq * (1.0f / 256.0f) + EPSF), rkv = rsqrtf(skv * (1.0f / 128.0f) + EPSF);
            float qn[8], qr[4], kn[8], kr[4];
#pragma unroll
            for (int e = 0; e < 8; ++e) { const unsigned a = qnw[e >> 1], b = knw[e >> 1];
                qn[e] = ((e & 1) ? __uint_as_float(a & 0xffff0000u) : __uint_as_float(a << 16)) * rq;
                kn[e] = ((e & 1) ? __uint_as_float(b & 0xffff0000u) : __uint_as_float(b << 16)) * rkv; }
#pragma unroll
            for (int e = 0; e < 4; ++e) { const unsigned a = (e < 2) ? qrw.x : qrw.y, b = (e < 2) ? krw.x : krw.y;
                qr[e] = ((e & 1) ? __uint_as_float(a & 0xffff0000u) : __uint_as_float(a << 16)) * rq;
                kr[e] = ((e & 1) ? __uint_as_float(b & 0xffff0000u) : __uint_as_float(b << 16)); }
            float sqq = 0.f, skk = 0.f;
#pragma unroll
            for (int e = 0; e < 8; ++e) { sqq += qn[e] * qn[e]; skk += kn[e] * kn[e]; }
#pragma unroll
            for (int e = 0; e < 4; ++e) { sqq += qr[e] * qr[e]; skk += kr[e] * kr[e]; }
            sqq += __shfl_xor(sqq, 1); sqq += __shfl_xor(sqq, 2); sqq += __shfl_xor(sqq, 4);
            skk += __shfl_xor(skk, 1); skk += __shfl_xor(skk, 2); skk += __shfl_xor(skk, 4);
            const float rnq = rsqrtf(sqq * (1.0f / 96.0f) + EPSF) * qscale, rnk = rsqrtf(skk * (1.0f / 96.0f) + EPSF);
            float qo[12], ko[12];
#pragma unroll
            for (int e = 0; e < 8; ++e) { qo[e] = qn[e] * rnq * gqn[e]; ko[e] = kn[e] * rnk * gkn[e]; }
#pragma unroll
            for (int e = 0; e < 4; ++e) { const float a = qr[e] * rnq * gqr[e], b = kr[e] * rnk * gkr[e];
                const float pa_ = __shfl_xor(a, 4), pb_ = __shfl_xor(b, 4);
                qo[8 + e] = upper ? (a * cs4[e] + pa_ * sn4[e]) : (a * cs4[e] - pa_ * sn4[e]);
                ko[8 + e] = upper ? (b * cs4[e] + pb_ * sn4[e]) : (b * cs4[e] - pb_ * sn4[e]); }
            if (lat || need_ctx_q) {
                bf16_t* qd = lat ? p.q + (((size_t)(bl * 8 + h) * SEQ + pos) * 96) : p.qc + (((size_t)(bl * 8 + h) * CTX + (pos - SEQ)) * 96);
                u32x4 w; w.x = cvt_pk_bf16(qo[0], qo[1]); w.y = cvt_pk_bf16(qo[2], qo[3]); w.z = cvt_pk_bf16(qo[4], qo[5]); w.w = cvt_pk_bf16(qo[6], qo[7]);
                *(u32x4*)(qd + sub * 8) = w;
                u32x2 w2; w2.x = cvt_pk_bf16(qo[8], qo[9]); w2.y = cvt_pk_bf16(qo[10], qo[11]);
                *(u32x2*)(qd + 64 + sub * 4) = w2; }
            { bf16_t* kd = (bf16_t*)(p.kv + ((size_t)(bl * 8 + h) * NCH + tile) * KVT_BYTES + rr * 208);
              u32x4 w; w.x = cvt_pk_bf16(ko[0], ko[1]); w.y = cvt_pk_bf16(ko[2], ko[3]); w.z = cvt_pk_bf16(ko[4], ko[5]); w.w = cvt_pk_bf16(ko[6], ko[7]);
              *(u32x4*)(kd + sub * 8) = w;
              u32x2 w2; w2.x = cvt_pk_bf16(ko[8], ko[9]); w2.y = cvt_pk_bf16(ko[10], ko[11]);
              *(u32x2*)(kd + 64 + sub * 4) = w2; }
#pragma unroll
            for (int e = 0; e < 8; ++e) { const unsigned a = vw[e >> 1]; const float v = ((e & 1) ? __uint_as_float(a & 0xffff0000u) : __uint_as_float(a << 16)) * rkv;
                vt[(h * 64 + sub * 8 + e) * 20 + r16] = f2bf(v); }
        }
        __syncthreads();
        for (int i = tid; i < 8 * 64 * 4; i += 512) { const int hh = i >> 8, rem = i & 255, vc = rem >> 2, pc = rem & 3;
            const u32x2 w = *(const LAS u32x2*)(vt + (hh * 64 + vc) * 20 + pc * 4);
            *(u32x2*)(p.kv + ((size_t)(bl * 8 + hh) * NCH + tile) * KVT_BYTES + KT_BYTES + vc * 136 + qtr * 32 + pc * 8) = w; }
        __syncthreads();
    }
}

DEVI void attn_unit(const Params& p, LAS unsigned char* lds, const bf16_t* Qb, int nq, const unsigned char* kvb, int ntile, bf16_t* orow, float accinit) {
    const int tid = opq_tid(), lane = tid & 63, wv = __builtin_amdgcn_readfirstlane(tid >> 6), l31 = lane & 31, hh = lane >> 5;
    const bool active = wv * 64 < nq;
    bf16x8 qf[2][6];
#pragma unroll
    for (int qt = 0; qt < 2; ++qt)
#pragma unroll
        for (int ks = 0; ks < 6; ++ks) {
            if (active) qf[qt][ks] = *(const bf16x8*)(Qb + (size_t)(wv * 64 + qt * 32 + l31) * 96 + ks * 16 + hh * 8);
            else qf[qt][ks] = (bf16x8){0, 0, 0, 0, 0, 0, 0, 0}; }
    f32x16 O[2][2];
#pragma unroll
    for (int a = 0; a < 2; ++a)
#pragma unroll
        for (int b = 0; b < 2; ++b)
#pragma unroll
            for (int i = 0; i < 16; ++i) O[a][b][i] = 0.f;
    float lsum[2] = {0.f, 0.f};
    constexpr int STG = 2 * KVT_BYTES;
    const int nstage = ntile >> 1;
    auto stage_in = [&](int sidx, int bsel) {
        const unsigned char* g = kvb + (size_t)sidx * STG + lane * 16;
        for (int pc = wv; pc < 43; pc += 8)
            __builtin_amdgcn_global_load_lds((const unsigned*)(g + pc * 1024), (LAS unsigned*)(lds + bsel * STG + pc * 1024), 16, 0, 0);
    };
    stage_in(0, 0);
    __syncthreads();
    if (wv >= 4) __builtin_amdgcn_s_setprio(1);
    for (int sg = 0; sg < nstage; ++sg) {
        if (sg + 1 < nstage) stage_in(sg + 1, (sg + 1) & 1);
        if (active) {
#pragma unroll 1
            for (int kt = 0; kt < 4; ++kt) {
                const LAS unsigned char* kb = lds + (sg & 1) * STG + (kt >> 1) * KVT_BYTES; const LAS unsigned char* vb = kb + KT_BYTES; const int ks2 = kt & 1;
                bf16x8 kf[6];
#pragma unroll
                for (int ks = 0; ks < 6; ++ks) kf[ks] = *(const LAS bf16x8*)(kb + (ks2 * 32 + l31) * 208 + ks * 32 + hh * 16);
                bf16x8 vf[2][2];
#pragma unroll
                for (int vtile = 0; vtile < 2; ++vtile)
#pragma unroll
                    for (int s2 = 0; s2 < 2; ++s2) { const LAS unsigned char* a = vb + (vtile * 32 + l31) * 136 + (ks2 * 32 + s2 * 16 + 4 * hh) * 2;
                        const u32x2 lo = *(const LAS u32x2*)a, hi = *(const LAS u32x2*)(a + 16);
                        u32x4 w; w.x = lo.x; w.y = lo.y; w.z = hi.x; w.w = hi.y; vf[vtile][s2] = __builtin_bit_cast(bf16x8, w); }
                f32x16 S0, S1;
#pragma unroll
                for (int i = 0; i < 16; ++i) { S0[i] = accinit; S1[i] = accinit; }
#pragma unroll
                for (int ks = 0; ks < 6; ++ks) S0 = __builtin_amdgcn_mfma_f32_32x32x16_bf16(kf[ks], qf[0][ks], S0, 0, 0, 0);
                __builtin_amdgcn_sched_barrier(0);
#pragma unroll
                for (int ks = 0; ks < 6; ++ks) S1 = __builtin_amdgcn_mfma_f32_32x32x16_bf16(kf[ks], qf[1][ks], S1, 0, 0, 0);
                bf16x8 pb0[2], pb1[2];
                { float ls = 0.f;
#pragma unroll
                  for (int i = 0; i < 16; ++i) { S0[i] = fast_exp2(S0[i]); ls += S0[i]; }
                  lsum[0] += ls;
#pragma unroll
                  for (int s2 = 0; s2 < 2; ++s2) { u32x4 w; w.x = cvt_pk_bf16(S0[8 * s2 + 0], S0[8 * s2 + 1]); w.y = cvt_pk_bf16(S0[8 * s2 + 2], S0[8 * s2 + 3]);
                      w.z = cvt_pk_bf16(S0[8 * s2 + 4], S0[8 * s2 + 5]); w.w = cvt_pk_bf16(S0[8 * s2 + 6], S0[8 * s2 + 7]); pb0[s2] = __builtin_bit_cast(bf16x8, w); } }
                __builtin_amdgcn_sched_barrier(0);
#pragma unroll
                for (int s2 = 0; s2 < 2; ++s2)
#pragma unroll
                    for (int vtile = 0; vtile < 2; ++vtile) O[0][vtile] = __builtin_amdgcn_mfma_f32_32x32x16_bf16(vf[vtile][s2], pb0[s2], O[0][vtile], 0, 0, 0);
                { float ls = 0.f;
#pragma unroll
                  for (int i = 0; i < 16; ++i) { S1[i] = fast_exp2(S1[i]); ls += S1[i]; }
                  lsum[1] += ls;
#pragma unroll
                  for (int s2 = 0; s2 < 2; ++s2) { u32x4 w; w.x = cvt_pk_bf16(S1[8 * s2 + 0], S1[8 * s2 + 1]); w.y = cvt_pk_bf16(S1[8 * s2 + 2], S1[8 * s2 + 3]);
                      w.z = cvt_pk_bf16(S1[8 * s2 + 4], S1[8 * s2 + 5]); w.w = cvt_pk_bf16(S1[8 * s2 + 6], S1[8 * s2 + 7]); pb1[s2] = __builtin_bit_cast(bf16x8, w); } }
                __builtin_amdgcn_sched_barrier(0);
#pragma unroll
                for (int s2 = 0; s2 < 2; ++s2)
#pragma unroll
                    for (int vtile = 0; vtile < 2; ++vtile) O[1][vtile] = __builtin_amdgcn_mfma_f32_32x32x16_bf16(vf[vtile][s2], pb1[s2], O[1][vtile], 0, 0, 0);
            }
        }
        __syncthreads();
    }
    __builtin_amdgcn_s_setprio(0);
    if (active) {
#pragma unroll
        for (int qt = 0; qt < 2; ++qt) {
            const float tot = lsum[qt] + __shfl_xor(lsum[qt], 32); const float inv = 1.0f / tot;
            bf16_t* orw = orow + (size_t)(wv * 64 + qt * 32 + l31) * OCW;
#pragma unroll
            for (int vtile = 0; vtile < 2; ++vtile)
#pragma unroll
                for (int g4 = 0; g4 < 4; ++g4) { u32x2 w; w.x = cvt_pk_bf16(O[qt][vtile][4 * g4 + 0] * inv, O[qt][vtile][4 * g4 + 1] * inv);
                    w.y = cvt_pk_bf16(O[qt][vtile][4 * g4 + 2] * inv, O[qt][vtile][4 * g4 + 3] * inv);
                    *(u32x2*)(orw + vtile * 32 + 8 * g4 + 4 * hh) = w; }
        }
    }
}

DEVI float attn_offset(const Params& p, int l) {
    const int lane = opq_tid() & 63;
    const float* gq = p.in[I_GQ] + l * 96; const float* gk = p.in[I_GK] + l * 96;
    float a = fmaxf(fabsf(gq[lane]), lane < 32 ? fabsf(gq[64 + lane]) : 0.f), b = fmaxf(fabsf(gk[lane]), lane < 32 ? fabsf(gk[64 + lane]) : 0.f);
    a = wave_max(a); b = wave_max(b);
    return -(9.797958971132712f * 1.4426950408889634f * a * b * 1.001f);
}

constexpr int HGP = 72;
constexpr int ZP = 68;
constexpr int HG_ZT0 = 0, HG_ZT1 = 17408, HG_KEY0 = 34816, HG_KEY1 = 52224, HG_VT = 69632, HG_KRM0 = 78848, HG_KRM1 = 88064, HG_QRM0 = 97280, HG_QRM1 = 106496,
              HG_S2T0 = 115712, HG_S2T1 = 124928, HG_A20 = 134144, HG_A21 = 143360, HG_GT = 152576  , HG_REF = 156672  , HG_BT = 157184  ,
              HG_O = HG_ZT0  ;
DEVI bf16x8 hg_frag_tr(const LAS unsigned char* tile, int k0, int c0, int lane) {
    const unsigned g = lane >> 4, q = (lane & 15) >> 2, pp = lane & 3;
    const unsigned a0 = (unsigned)(size_t)tile + (unsigned)((k0 + 8 * g + q) * (HGP * 2) + (c0 + 4 * pp) * 2), a1 = a0 + 4 * HGP * 2;
    u32x2 r0, r1;
    asm volatile("ds_read_b64_tr_b16 %0, %2\n\tds_read_b64_tr_b16 %1, %3\n\ts_waitcnt lgkmcnt(0)" : "=&v"(r0), "=&v"(r1) : "v"(a0), "v"(a1) : "memory");
    u32x4 w; w.x = r0.x; w.y = r0.y; w.z = r1.x; w.w = r1.y; return __builtin_bit_cast(bf16x8, w);
}

DEVI int hg_pos0(int tc) { return tc < 128 ? tc * 64 : SEQ + (tc - 128) * 64; }
DEVI int hg_chain_pos(int tc, int dir) { return dir ? (NCH - 1 - tc) : (tc < 128 ? tc + 4 : tc - 128); }

struct HgIn { u32x4 q, zf, zb, v, g, sf, sb; };
template <bool PASS3> DEVI void hg_load(const Params& p, int u, HgIn& r) {
    const int tid = opq_tid(), tk = tid >> 3, pc = tid & 7; const int tc = u % NCH, h = (u / NCH) & 7, bl = u / (NCH * 8);
    const bf16_t* prow = p.pa + (size_t)(bl * RB + hg_pos0(tc) + tk) * PA_W + h * 64 + pc * 8;
    r.zf = *(const u32x4*)(prow + C_ZF); r.zb = *(const u32x4*)(prow + C_ZB); r.v = *(const u32x4*)(prow + C_I);
    if (PASS3) { r.q = *(const u32x4*)(prow + C_Q); r.g = *(const u32x4*)(prow + C_G);
        const size_t uf = ((size_t)((bl * 2 + 0) * 8 + h)) * NCH + hg_chain_pos(tc, 0), ub = ((size_t)((bl * 2 + 1) * 8 + h)) * NCH + hg_chain_pos(tc, 1);
        r.sf = *(const u32x4*)(p.st + uf * 4096 + tk * 64 + pc * 8); r.sb = *(const u32x4*)(p.st + ub * 4096 + tk * 64 + pc * 8); }
}
DEVI float bfw(const u32x4& w, int e) { const unsigned x = w[e >> 1]; return (e & 1) ? __uint_as_float(x & 0xffff0000u) : __uint_as_float(x << 16); }

template <bool PASS3> DEVI void hg_prepare(const Params& p, int l, LAS unsigned char* lds, int h, const HgIn& r) {
    const int tid = opq_tid(), tk = tid >> 3, pc = tid & 7;
    LAS float* gt = (LAS float*)(lds + HG_GT); LAS float* refv = (LAS float*)(lds + HG_REF); LAS float* btv = (LAS float*)(lds + HG_BT);
    {
#pragma unroll
        for (int dir = 0; dir < 2; ++dir) {
            LAS float* zt = (LAS float*)(lds + (dir ? HG_ZT1 : HG_ZT0)); LAS float* keyt = (LAS float*)(lds + (dir ? HG_KEY1 : HG_KEY0));
            const float* lbp = p.lbv + ((size_t)l * 2 + dir) * 512 + h * 64 + pc * 8;
            float lf[8], ky[8];
#pragma unroll
            for (int e = 0; e < 8; ++e) { const float z = bfw(dir ? r.zb : r.zf, e); const float lb = lbp[e];
                const float ez = fast_exp2(-1.44269504f * fabsf(z)), opl = 1.0f + ez, rc = fast_rcp(opl);
                const float logsig = -(fmaxf(-z, 0.f) + 0.69314718f * __builtin_amdgcn_logf(opl));
                const float sigp = (z >= 0.f) ? rc : ez * rc;
                lf[e] = (lb > 0.f) ? 0.69314718f * __builtin_amdgcn_logf(lb + (1.0f - lb) * sigp) : logsig;
                ky[e] = (1.0f - lb) * (1.0f - sigp); }
            *(LAS f32x4*)(zt + tk * ZP + pc * 8) = (f32x4){lf[0], lf[1], lf[2], lf[3]}; *(LAS f32x4*)(zt + tk * ZP + pc * 8 + 4) = (f32x4){lf[4], lf[5], lf[6], lf[7]};
            *(LAS f32x4*)(keyt + tk * ZP + pc * 8) = (f32x4){ky[0], ky[1], ky[2], ky[3]}; *(LAS f32x4*)(keyt + tk * ZP + pc * 8 + 4) = (f32x4){ky[4], ky[5], ky[6], ky[7]}; }
        *(LAS u32x4*)(lds + HG_VT + (tk * HGP + pc * 8) * 2) = r.v;
    }
    __syncthreads();
    {
        const int d = tid & 63, jg = tid >> 6; float c0[8], c1[8]; float run = 0.f;
        LAS float* zt0 = (LAS float*)(lds + HG_ZT0); LAS float* zt1 = (LAS float*)(lds + HG_ZT1);
#pragma unroll
        for (int i = 0; i < 8; ++i) { run += zt0[(jg * 8 + i) * ZP + d]; c0[i] = run; }
        gt[jg * 64 + d] = run; run = 0.f;
#pragma unroll
        for (int i = 7; i >= 0; --i) { run += zt1[(jg * 8 + i) * ZP + d]; c1[i] = run; }
        gt[512 + jg * 64 + d] = run;
        __syncthreads();
        float off0 = 0.f, off1 = 0.f;
#pragma unroll
        for (int g2 = 0; g2 < 8; ++g2) { off0 += (g2 < jg) ? gt[g2 * 64 + d] : 0.f; off1 += (g2 > jg) ? gt[512 + g2 * 64 + d] : 0.f; }
#pragma unroll
        for (int i = 0; i < 8; ++i) { zt0[(jg * 8 + i) * ZP + d] = c0[i] + off0; zt1[(jg * 8 + i) * ZP + d] = c1[i] + off1; }
        if (jg == 3) refv[d] = c0[7] + off0;
        if (jg == 7) btv[d] = c0[7] + off0;
        if (jg == 4) refv[64 + d] = c1[0] + off1;
        if (jg == 0) btv[64 + d] = c1[0] + off1;
    }
    __syncthreads();
    {
#pragma unroll
        for (int dir = 0; dir < 2; ++dir) {
            const LAS float* zt = (const LAS float*)(lds + (dir ? HG_ZT1 : HG_ZT0)); const LAS float* keyt = (const LAS float*)(lds + (dir ? HG_KEY1 : HG_KEY0));
            float kt[8], qt[8];
            const f32x4 z0 = *(const LAS f32x4*)(zt + tk * ZP + pc * 8), z1 = *(const LAS f32x4*)(zt + tk * ZP + pc * 8 + 4);
            const f32x4 k0 = *(const LAS f32x4*)(keyt + tk * ZP + pc * 8), k1 = *(const LAS f32x4*)(keyt + tk * ZP + pc * 8 + 4);
            const f32x4 r0 = *(const LAS f32x4*)(refv + dir * 64 + pc * 8), r1 = *(const LAS f32x4*)(refv + dir * 64 + pc * 8 + 4);
#pragma unroll
            for (int e = 0; e < 8; ++e) { const float bc = e < 4 ? z0[e & 3] : z1[e & 3], rf = e < 4 ? r0[e & 3] : r1[e & 3], ke = e < 4 ? k0[e & 3] : k1[e & 3];
                kt[e] = ke * fast_exp2(1.44269504f * fminf(rf - bc, 80.f)); if (PASS3) qt[e] = bfw(r.q, e) * fast_exp2(1.44269504f * fminf(bc - rf, 80.f)); }
            { u32x4 w; w.x = cvt_pk_bf16(kt[0], kt[1]); w.y = cvt_pk_bf16(kt[2], kt[3]); w.z = cvt_pk_bf16(kt[4], kt[5]); w.w = cvt_pk_bf16(kt[6], kt[7]);
              *(LAS u32x4*)(lds + (dir ? HG_KRM1 : HG_KRM0) + (tk * HGP + pc * 8) * 2) = w; }
            if (PASS3) {
                u32x4 w; w.x = cvt_pk_bf16(qt[0], qt[1]); w.y = cvt_pk_bf16(qt[2], qt[3]); w.z = cvt_pk_bf16(qt[4], qt[5]); w.w = cvt_pk_bf16(qt[6], qt[7]);
                *(LAS u32x4*)(lds + (dir ? HG_QRM1 : HG_QRM0) + (tk * HGP + pc * 8) * 2) = w;
                const float er = fast_exp2(1.44269504f * refv[dir * 64 + tk]); float sv[8];
#pragma unroll
                for (int e = 0; e < 8; ++e) sv[e] = bfw(dir ? r.sb : r.sf, e) * er;
                w.x = cvt_pk_bf16(sv[0], sv[1]); w.y = cvt_pk_bf16(sv[2], sv[3]); w.z = cvt_pk_bf16(sv[4], sv[5]); w.w = cvt_pk_bf16(sv[6], sv[7]);
                *(LAS u32x4*)(lds + (dir ? HG_S2T1 : HG_S2T0) + (tk * HGP + pc * 8) * 2) = w;
            }
        }
    }
    __syncthreads();
}
DEVI bf16x8 hg_frag(const LAS unsigned char* base, int r, int c0) { return *(const LAS bf16x8*)(base + (size_t)(r * HGP + c0) * 2); }

DEVI void hg_pass1_unit(const Params& p, int l, LAS unsigned char* lds, int u, const HgIn& r) {
    const int tc = u % NCH, h = (u / NCH) & 7, bl = u / (NCH * 8);
    hg_prepare<false>(p, l, lds, h, r);
    const int tid = opq_tid(), lane = tid & 63, wv = tid >> 6, l15 = lane & 15, g = lane >> 4;
    const LAS float* refv = (const LAS float*)(lds + HG_REF); const LAS float* btv = (const LAS float*)(lds + HG_BT);
    const int dt = wv >> 1, ct0 = (wv & 1) * 2;
#pragma unroll
    for (int dir = 0; dir < 2; ++dir) {
        const size_t unit = ((size_t)((bl * 2 + dir) * 8 + h)) * NCH + hg_chain_pos(tc, dir);
        bf16_t* so = p.st + unit * 4096;
        const LAS unsigned char* krm = lds + (dir ? HG_KRM1 : HG_KRM0);
        bf16x8 af[2];
#pragma unroll
        for (int ks = 0; ks < 2; ++ks) af[ks] = hg_frag_tr(krm, 32 * ks, 16 * dt, lane);
#pragma unroll
        for (int ci = 0; ci < 2; ++ci) { const int ct = ct0 + ci; f32x4 acc = {0.f, 0.f, 0.f, 0.f};
#pragma unroll
            for (int ks = 0; ks < 2; ++ks) acc = __builtin_amdgcn_mfma_f32_16x16x32_bf16(af[ks], hg_frag_tr(lds + HG_VT, 32 * ks, 16 * ct, lane), acc, 0, 0, 0);
#pragma unroll
            for (int rr = 0; rr < 4; ++rr) { const int d = 16 * dt + 4 * g + rr; so[d * 64 + 16 * ct + l15] = f2bf(acc[rr] * fast_exp2(1.44269504f * (btv[dir * 64 + d] - refv[dir * 64 + d]))); } }
        if (tid < 64) p.stb[unit * 64 + tid] = btv[dir * 64 + tid];
    }
    __syncthreads();
}

DEVI void hg_pass3_unit(const Params& p, int l, LAS unsigned char* lds, int u, const HgIn& r) {
    const int tc = u % NCH, h = (u / NCH) & 7, bl = u / (NCH * 8);
    const int tid = opq_tid(), lane = tid & 63, wv = tid >> 6, l15 = lane & 15, g = lane >> 4;
    hg_prepare<true>(p, l, lds, h, r);
    { const int tt = wv >> 1, st0 = (wv & 1) * 2;
#pragma unroll
      for (int dir = 0; dir < 2; ++dir) {
          const LAS unsigned char* qrm = lds + (dir ? HG_QRM1 : HG_QRM0); const LAS unsigned char* krm = lds + (dir ? HG_KRM1 : HG_KRM0); LAS bf16_t* a2 = (LAS bf16_t*)(lds + (dir ? HG_A21 : HG_A20));
          bf16x8 bq[2];
#pragma unroll
          for (int ks = 0; ks < 2; ++ks) bq[ks] = hg_frag(qrm, 16 * tt + l15, 32 * ks + 8 * g);
#pragma unroll
          for (int si = 0; si < 2; ++si) { const int st = st0 + si; f32x4 acc = {0.f, 0.f, 0.f, 0.f};
#pragma unroll
              for (int ks = 0; ks < 2; ++ks) acc = __builtin_amdgcn_mfma_f32_16x16x32_bf16(hg_frag(krm, 16 * st + l15, 32 * ks + 8 * g), bq[ks], acc, 0, 0, 0);
              const int t = 16 * tt + l15, s0 = 16 * st + 4 * g; float v[4];
#pragma unroll
              for (int e = 0; e < 4; ++e) v[e] = (dir == 0 ? (s0 + e <= t) : (s0 + e >= t)) ? acc[e] : 0.f;
              u32x2 w; w.x = cvt_pk_bf16(v[0], v[1]); w.y = cvt_pk_bf16(v[2], v[3]);
              *(LAS u32x2*)(a2 + t * HGP + s0) = w; } } }
    __syncthreads();
    { const int tt = wv >> 1, ct0 = (wv & 1) * 2; LAS float* olds = (LAS float*)(lds + HG_O);
      f32x4 acc[2] = {{0.f, 0.f, 0.f, 0.f}, {0.f, 0.f, 0.f, 0.f}};
#pragma unroll
      for (int dir = 0; dir < 2; ++dir) {
          const LAS unsigned char* qrm = lds + (dir ? HG_QRM1 : HG_QRM0); const LAS unsigned char* a2 = lds + (dir ? HG_A21 : HG_A20); const LAS unsigned char* s2t = lds + (dir ? HG_S2T1 : HG_S2T0);
          bf16x8 aa[2], aq[2];
#pragma unroll
          for (int ks = 0; ks < 2; ++ks) { aa[ks] = hg_frag(a2, 16 * tt + l15, 32 * ks + 8 * g); aq[ks] = hg_frag(qrm, 16 * tt + l15, 32 * ks + 8 * g); }
#pragma unroll
          for (int ci = 0; ci < 2; ++ci) { const int ct = ct0 + ci;
#pragma unroll
              for (int ks = 0; ks < 2; ++ks) acc[ci] = __builtin_amdgcn_mfma_f32_16x16x32_bf16(aa[ks], hg_frag_tr(lds + HG_VT, 32 * ks, 16 * ct, lane), acc[ci], 0, 0, 0);
#pragma unroll
              for (int ks = 0; ks < 2; ++ks) acc[ci] = __builtin_amdgcn_mfma_f32_16x16x32_bf16(aq[ks], hg_frag_tr(s2t, 32 * ks, 16 * ct, lane), acc[ci], 0, 0, 0); } }
#pragma unroll
      for (int ci = 0; ci < 2; ++ci)
#pragma unroll
          for (int rr = 0; rr < 4; ++rr) olds[(16 * tt + 4 * g + rr) * 65 + 16 * (ct0 + ci) + l15] = acc[ci][rr]; }
    __syncthreads();
    { const int tok = tid >> 3, pc = tid & 7; const int row = bl * RB + hg_pos0(tc) + tok; const LAS float* olds = (const LAS float*)(lds + HG_O);
      float o[8]; float ss = 0.f;
#pragma unroll
      for (int e = 0; e < 8; ++e) { o[e] = olds[tok * 65 + pc * 8 + e]; ss += o[e] * o[e]; }
      ss += __shfl_xor(ss, 1); ss += __shfl_xor(ss, 2); ss += __shfl_xor(ss, 4);
      const float rstd = rsqrtf(ss * (1.0f / 64.0f) + EPSF);
      const float* gn = p.in[I_HGNORM] + l * 64 + pc * 8;
      float rr[8];
#pragma unroll
      for (int e = 0; e < 8; ++e) rr[e] = o[e] * rstd * gn[e] * sigmoidf_(bfw(r.g, e));
      u32x4 w; w.x = cvt_pk_bf16(rr[0], rr[1]); w.y = cvt_pk_bf16(rr[2], rr[3]); w.z = cvt_pk_bf16(rr[4], rr[5]); w.w = cvt_pk_bf16(rr[6], rr[7]);
      *(u32x4*)(p.ocat + (size_t)row * OCW + h * 64 + pc * 8) = w; }
    __syncthreads();
}

DEVI void hg_prefix(const Params& p, bool dry = false) {
    const int total = 2 * 2 * 8 * 4096;
    for (int gidx = opq_bid() * 512 + opq_tid(); gidx < total; gidx += gridDim.x * 512) {
        const int chain = gidx >> 12, e = gidx & 4095, d = e >> 6;
        bf16_t* s = p.st + (size_t)chain * NCH * 4096 + e; const float* bt = p.stb + (size_t)chain * NCH * 64 + d;
        float S = 0.f;
#pragma unroll 1
        for (int q0 = 0; q0 < NCH; q0 += 12) { float loc[12], b[12];
#pragma unroll
            for (int i = 0; i < 12; ++i) { loc[i] = bf2f(s[(size_t)(q0 + i) * 4096]); b[i] = bt[(q0 + i) * 64]; }
#pragma unroll
            for (int i = 0; i < 12; ++i) { if (!dry) s[(size_t)(q0 + i) * 4096] = f2bf(S); S = S * fast_exp2(1.44269504f * b[i]) + loc[i]; } }
        if (dry && S == 123.456f) s[0] = 0;
    }
}

constexpr int LR_UB = 0, LR_UP = 520, LR_AF = 16640, LR_IF = LR_AF + 32768, LR_AB = LR_IF + 32768, LR_IB = LR_AB + 32768;
constexpr int NT16 = RB / 16;

DEVI int lr_pos0(int tt) { return tt * 16; }
DEVI int lr_chain_pos(int tt, int dir) { return dir ? (NT16 - 1 - tt) : (tt < 512 ? tt + 16 : tt - 512); }

struct LruW { bf16x8 b[2][4][2]; float ba[4], bx[4], la[4]; };
DEVI void lru_load_w(const Params& p, int l, int dir, int n, int l15, int g, LruW& w) {
#pragma unroll
    for (int which = 0; which < 2; ++which)
#pragma unroll
        for (int ct = 0; ct < 4; ++ct)
#pragma unroll
            for (int ks = 0; ks < 2; ++ks)
                w.b[which][ct][ks] = *(const bf16x8*)(p.wlru + ((((size_t)(l * 2 + dir) * 8 + n) * 2 + which) * 64 + 16 * ct + l15) * 64 + 32 * ks + 8 * g);
#pragma unroll
    for (int ct = 0; ct < 4; ++ct) { const int c = (l * 2 + dir) * 512 + n * 64 + 16 * ct + l15;
        w.ba[ct] = p.in[I_LBA][c]; w.bx[ct] = p.in[I_LBX][c]; w.la[ct] = p.lrula[c]; }
}
struct LrIn { bf16_t x[19]; bf16_t y[16]; float h_in; };
template <int MODE> DEVI void lru_load(const Params& p, int u, LrIn& r) {
    const int bl = u / NT16, tt = u % NT16, c = opq_tid();
    const int pos0 = tt * 16, seg0 = tt < 512 ? 0 : SEQ, seg1 = tt < 512 ? SEQ : RB;
    const bf16_t* xx = p.pa + (size_t)bl * RB * PA_W + C_LX + c;
#pragma unroll
    for (int i = 0; i < 19; ++i) { const int pos = pos0 - 2 + i; r.x[i] = (pos >= seg0 && pos < seg1) ? xx[(size_t)pos * PA_W] : (bf16_t)0; }
    if (MODE == 2) { const bf16_t* yy = p.pa + ((size_t)bl * RB + pos0) * PA_W + C_LY + c;
#pragma unroll
        for (int t = 0; t < 16; ++t) r.y[t] = yy[(size_t)t * PA_W]; }
    if (MODE == 1) r.h_in = p.lin[((size_t)(bl * 2 + 0) * NT16 + lr_chain_pos(tt, 0)) * 512 + c];
    if (MODE == 2) r.h_in = p.lin[((size_t)(bl * 2 + 1) * NT16 + lr_chain_pos(tt, 1)) * 512 + c];
}
#define LR_WAVE_SYNC() do { asm volatile("s_waitcnt lgkmcnt(0)" ::: "memory"); __builtin_amdgcn_wave_barrier(); } while (0)
DEVI void lru_tile_gates(const Params& p, int l, LAS unsigned char* lds, const LrIn& in, const LruW& w) {
    const int tid = opq_tid(), lane = tid & 63, n = tid >> 6, l15 = lane & 15, g = lane >> 4;
    LAS bf16_t* ub = (LAS bf16_t*)(lds + LR_UB);
    {
        const int c = tid;
        const float* cw = p.in[I_CONVW] + (size_t)l * 4 * 512; const float w0 = cw[c], w1 = cw[512 + c], w2 = cw[1024 + c], w3 = cw[1536 + c], cb = p.in[I_CONVB][l * 512 + c];
        float x[19];
#pragma unroll
        for (int i = 0; i < 19; ++i) x[i] = bf2f(in.x[i]);
#pragma unroll
        for (int t = 0; t < 16; ++t) ub[t * LR_UP + c] = f2bf(cb + w0 * x[t] + w1 * x[t + 1] + w2 * x[t + 2] + w3 * x[t + 3]);
    }
    LR_WAVE_SYNC();
    bf16x8 af[2];
#pragma unroll
    for (int ks = 0; ks < 2; ++ks) af[ks] = *(const LAS bf16x8*)(ub + l15 * LR_UP + n * 64 + 32 * ks + 8 * g);
    LAS float* aL = (LAS float*)(lds + LR_AF); LAS float* iL = (LAS float*)(lds + LR_IF);
#pragma unroll
    for (int ct = 0; ct < 4; ++ct) {
        f32x4 ra = {0.f, 0.f, 0.f, 0.f}, xa = {0.f, 0.f, 0.f, 0.f};
#pragma unroll
        for (int ks = 0; ks < 2; ++ks) { ra = __builtin_amdgcn_mfma_f32_16x16x32_bf16(af[ks], w.b[0][ct][ks], ra, 0, 0, 0); xa = __builtin_amdgcn_mfma_f32_16x16x32_bf16(af[ks], w.b[1][ct][ks], xa, 0, 0, 0); }
        const int c = n * 64 + 16 * ct + l15;
#pragma unroll
        for (int r = 0; r < 4; ++r) { const int t = 4 * g + r;
            const float rg = sigmoidf_(ra[r] + w.ba[ct]), ig = sigmoidf_(xa[r] + w.bx[ct]);
            const float a = fast_exp2(rg * w.la[ct]); const float uu = bf2f(ub[t * LR_UP + c]);
            aL[t * 512 + c] = a; iL[t * 512 + c] = __builtin_amdgcn_sqrtf(fmaxf(1.0f - a * a, 0.f)) * ig * uu; }
    }
    LR_WAVE_SYNC();
}
template <int MODE> DEVI void lru_sweep(const Params& p, int l, LAS unsigned char* lds, int dir, int u0, int uend, int ubase, bool skipc) {
    const int tid = opq_tid(), lane = tid & 63, n = tid >> 6, l15 = lane & 15, g = lane >> 4, G = gridDim.x;
    if (u0 >= uend) return;
    LruW w; lru_load_w(p, l, dir, n, l15, g, w);
    const LAS float* aL = (const LAS float*)(lds + LR_AF); const LAS float* iL = (const LAS float*)(lds + LR_IF);
    LrIn cur, nxt; lru_load<MODE>(p, u0 - ubase, cur);
    for (int u = u0; u < uend; u += G) {
        const bool more = u + G < uend; if (more) lru_load<MODE>(p, u + G - ubase, nxt);
        const int uu = u - ubase, bl = uu / NT16, tt = uu % NT16;
        if (!(skipc && tt >= 512)) {
            lru_tile_gates(p, l, lds, cur, w);
            if (MODE == 0) { float A = 1.f, H = 0.f;
#pragma unroll
                for (int t = 0; t < 16; ++t) { const float a = aL[t * 512 + tid], b = iL[t * 512 + tid]; if (dir == 0) { H = a * H + b; A *= a; } else { H += b * A; A *= a; } }
                *((f32x2_t*)p.lsum + ((size_t)(bl * 2 + dir) * NT16 + lr_chain_pos(tt, dir)) * 512 + tid) = (f32x2_t){A, H};
            } else { bf16_t* ocol = p.ocat + ((size_t)bl * RB + lr_pos0(tt)) * OCW + 1024 + tid; float h = cur.h_in;
                if (MODE == 1) {
#pragma unroll
                    for (int t = 0; t < 16; ++t) { h = aL[t * 512 + tid] * h + iL[t * 512 + tid]; ocol[(size_t)t * OCW] = f2bf(h); }
                } else {
                    float hfv[16];
#pragma unroll
                    for (int t = 0; t < 16; ++t) hfv[t] = bf2f(ocol[(size_t)t * OCW]);
#pragma unroll
                    for (int t = 15; t >= 0; --t) { h = aL[t * 512 + tid] * h + iL[t * 512 + tid];
                        const float y = bf2f(cur.y[t]); const float x3 = 0.7978845608028654f * (y + 0.044715f * y * y * y);
                        const float th = 1.0f - 2.0f * fast_rcp(1.0f + fast_exp2(2.88539008f * x3));
                        ocol[(size_t)t * OCW] = f2bf((hfv[t] + h) * 0.5f * y * (1.0f + th)); } }
            }
            LR_WAVE_SYNC();
        }
        if (more) cur = nxt;
    }
}
DEVI void lru_prefix(const Params& p, bool dry = false) {
    const int lane = opq_tid() & 63, wv = opq_tid() >> 6;
    for (int chain = opq_bid() * 8 + wv; chain < 2 * 2 * 512; chain += gridDim.x * 8) {
        const int c = chain & 511, bd = chain >> 9;
        const f32x2_t* src = (const f32x2_t*)p.lsum + (size_t)bd * NT16 * 512 + c; float* dst = p.lin + (size_t)bd * NT16 * 512 + c;
        f32x2_t v[9]; float A = 1.f, H = 0.f;
#pragma unroll
        for (int i = 0; i < 9; ++i) { const int q = lane * 9 + i; v[i] = (q < NT16) ? src[(size_t)q * 512] : (f32x2_t){1.f, 0.f}; H = v[i].x * H + v[i].y; A *= v[i].x; }
#pragma unroll
        for (int o = 1; o < 64; o <<= 1) { const float Ap = __shfl_up(A, o), Hp = __shfl_up(H, o); if (lane >= o) { H = A * Hp + H; A = A * Ap; } }
        float h = __shfl_up(H, 1); if (lane == 0) h = 0.f;
#pragma unroll
        for (int i = 0; i < 9; ++i) { const int q = lane * 9 + i; if (q < NT16 && !dry) dst[(size_t)q * 512] = h; h = v[i].x * h + v[i].y; }
        if (dry && h == 123.456f) dst[0] = 0.f;
    }
}
DEVI void phase_attn_scan1(const Params& p, int l, LAS unsigned char* lds, int parts = 7) {
    const int nA = 2 * 8 * 16 + (l == 0 ? 16 : 0), nH = 2 * 8 * NCH, nL = 2 * NT16, G = gridDim.x;
    const float accinit = attn_offset(p, l);
    int u = opq_bid();
    for (; u < 256; u += G) { const int bl = u >> 7, h = (u >> 4) & 7, qb = u & 15; if (!(parts & 1)) continue;
        attn_unit(p, lds, p.q + ((size_t)(bl * 8 + h) * SEQ + qb * 512) * 96, 512, p.kv + (size_t)(bl * 8 + h) * NCH * KVT_BYTES, NCH,
                  p.ocat + (size_t)(bl * RB + qb * 512) * OCW + 512 + h * 64, accinit); }
    for (; u < nA; u += G) { const int uu = u - 256, bl = uu >> 3, h = uu & 7; if (!(parts & 1)) continue;
        attn_unit(p, lds, p.qc + ((size_t)(bl * 8 + h) * CTX) * 96, 256, p.kv + ((size_t)(bl * 8 + h) * NCH + 128) * KVT_BYTES, 4,
                  p.ocat + (size_t)(bl * RB + SEQ) * OCW + 512 + h * 64, accinit); }
    if (parts & 2) { HgIn cur, nxt; if (u < nA + nH) hg_load<false>(p, u - nA, cur);
        for (; u < nA + nH; u += G) { const bool more = u + G < nA + nH; if (more) hg_load<false>(p, u + G - nA, nxt); hg_pass1_unit(p, l, lds, u - nA, cur); if (more) cur = nxt; } }
    else { for (; u < nA + nH; u += G) {} }
    if (parts & 4) { lru_sweep<0>(p, l, lds, 0, u, nA + nH + nL, nA + nH, false); lru_sweep<0>(p, l, lds, 1, u, nA + nH + nL, nA + nH, false); }
}
DEVI void phase_prefix(const Params& p, LAS unsigned char* lds, bool dry = false) { (void)lds; hg_prefix(p, dry); lru_prefix(p, dry); }
DEVI void phase_scan3(const Params& p, int l, LAS unsigned char* lds, int parts = 3) {
    const int nH = 2 * 8 * NCH, nL = 2 * NT16, G = gridDim.x; const bool skipc = (l == DEPTH - 1);
    int u = opq_bid();
    if (parts & 1) { HgIn cur, nxt; if (u < nH) hg_load<true>(p, u, cur);
        for (; u < nH; u += G) { const bool more = u + G < nH; if (more) hg_load<true>(p, u + G, nxt);
            if (!(skipc && (u % NCH) >= 128)) hg_pass3_unit(p, l, lds, u, cur);
            if (more) cur = nxt; } }
    else { for (; u < nH; u += G) {} }
    if (parts & 2) { lru_sweep<1>(p, l, lds, 0, u, nH + nL, nH, skipc); lru_sweep<2>(p, l, lds, 1, u, nH + nL, nH, skipc); }
}

constexpr int RP = 2 * TT + 4096;

DEVI void phase_norm2_route(const Params& p, int l, bool dry = false) {
    const int lane = opq_tid() & 63, wv = opq_tid() >> 6; const bool skipc = (l == DEPTH - 1);
    const float* gm = p.in[I_NFFN] + l * DM;
    const float* wrg = p.in[I_WRG] + (size_t)l * DM * 4; const float* wre = p.in[I_WRE] + (size_t)l * DM * 16;
    for (int r = opq_bid() * 8 + wv; r < TT; r += gridDim.x * 8) {
        const int pos = r % RB; if (skipc && pos >= SEQ) continue;
        const float* src = xbuf_row(p, r);
        f32x4 v[4]; float ss = 0.f;
#pragma unroll
        for (int i = 0; i < 4; ++i) { v[i] = *(const f32x4*)(src + i * 256 + lane * 4); ss += v[i][0] * v[i][0] + v[i][1] * v[i][1] + v[i][2] * v[i][2] + v[i][3] * v[i][3]; }
        ss = wave_sum(ss);
        const float rstd = rsqrtf(ss * (1.0f / DM) + EPSF);
        const float* mv = p.modv + ((size_t)l * 5 + mod_row(r)) * 6144;
        f32x4 lg = {0.f, 0.f, 0.f, 0.f}, le0 = lg, le1 = lg, le2 = lg, le3 = lg;
#pragma unroll
        for (int i = 0; i < 4; ++i) { const int c = i * 256 + lane * 4;
            const f32x4 g = *(const f32x4*)(gm + c), sh = *(const f32x4*)(mv + 3072 + c), sc = *(const f32x4*)(mv + 4096 + c);
            f32x4 h;
#pragma unroll
            for (int e = 0; e < 4; ++e) h[e] = v[i][e] * rstd * g[e] * (1.0f + sc[e]) + sh[e];
            u32x2 w; w.x = cvt_pk_bf16(h[0], h[1]); w.y = cvt_pk_bf16(h[2], h[3]);
            *(u32x2*)(p.h2 + (size_t)r * DM + c) = w;
#pragma unroll
            for (int e = 0; e < 4; ++e) { const float* wr_ = wre + (size_t)(c + e) * 16;
                lg += h[e] * *(const f32x4*)(wrg + (size_t)(c + e) * 4);
                le0 += h[e] * *(const f32x4*)(wr_); le1 += h[e] * *(const f32x4*)(wr_ + 4); le2 += h[e] * *(const f32x4*)(wr_ + 8); le3 += h[e] * *(const f32x4*)(wr_ + 12); } }
#pragma unroll
        for (int e = 0; e < 4; ++e) { lg[e] = wave_sum(lg[e]); le0[e] = wave_sum(le0[e]); le1[e] = wave_sum(le1[e]); le2[e] = wave_sum(le2[e]); le3[e] = wave_sum(le3[e]); }
        if (lane == 0 && !dry) {
            const float* brg = p.in[I_BRG] + l * 4; const float* bre = p.in[I_BRE] + l * 16;
            int gs = 0; float best = lg[0] + brg[0];
#pragma unroll
            for (int e = 1; e < 4; ++e) { const float t = lg[e] + brg[e]; if (t > best) { best = t; gs = e; } }
            const float m = fmaxf(fmaxf(lg[0], lg[1]), fmaxf(lg[2], lg[3]));
            const float e0 = __expf(lg[0] - m), e1 = __expf(lg[1] - m), e2 = __expf(lg[2] - m), e3 = __expf(lg[3] - m);
            const float pg = (gs == 0 ? e0 : gs == 1 ? e1 : gs == 2 ? e2 : e3) / (e0 + e1 + e2 + e3);
            const f32x4 lv = (gs == 0) ? le0 : (gs == 1) ? le1 : (gs == 2) ? le2 : le3;
            const f32x4 bv = lv + *(const f32x4*)(bre + gs * 4);
            int i0 = 0; float m0 = bv[0], l0 = lv[0];
#pragma unroll
            for (int e = 1; e < 4; ++e) if (bv[e] > m0) { m0 = bv[e]; i0 = e; l0 = lv[e]; }
            int i1 = -1; float m1 = -3.0e38f, l1 = 0.f;
#pragma unroll
            for (int e = 0; e < 4; ++e) if (e != i0 && bv[e] > m1) { m1 = bv[e]; i1 = e; l1 = lv[e]; }
            const float mm = fmaxf(l0, l1), x0 = __expf(l0 - mm), x1 = __expf(l1 - mm);
            const float w0 = x0 / (x0 + x1) * pg, w1 = x1 / (x0 + x1) * pg;
            const int ea = gs * 4 + i0, eb = gs * 4 + i1;
            const int sa = (int)atomicAdd(&p.ctrl[CTRL_CNT(l) + ea], 1u), sb = (int)atomicAdd(&p.ctrl[CTRL_CNT(l) + eb], 1u);
            p.tok_e[r * 2] = ea; p.tok_e[r * 2 + 1] = eb; p.tok_s[r * 2] = sa; p.tok_s[r * 2 + 1] = sb;
            p.lst[(size_t)ea * TT + sa] = r; p.lst[(size_t)eb * TT + sb] = r; p.tok_w[(size_t)ea * TT + sa] = w0; p.tok_w[(size_t)eb * TT + sb] = w1;
        }
    }
}

DEVI void moe_offsets(const Params& p, int l, LAS int* offs) {
    if (opq_tid() == 0) { int o = 0;
        for (int e = 0; e < NEXP; ++e) { offs[e] = o; const int c = (int)__hip_atomic_load(&p.ctrl[CTRL_CNT(l) + e], __ATOMIC_RELAXED, __HIP_MEMORY_SCOPE_AGENT); offs[32 + e] = c; o += (c + 255) & ~255; }
        offs[NEXP] = o; }
    __syncthreads();
}
DEVI int moe_expert_of(const LAS int* offs, int row) { int e = 0;
#pragma unroll
    for (int q = 1; q < NEXP; ++q) e += (row >= offs[q]) ? 1 : 0;
    return e; }

DEVI void phase_moe_permute(const Params& p, int l, const LAS int* offs) {
    const int lane = opq_tid() & 63, wv = opq_tid() >> 6; const int R = offs[NEXP];
    for (int pr = opq_bid() * 8 + wv; pr < R; pr += gridDim.x * 8) {
        const int e = moe_expert_of(offs, pr), s = pr - offs[e]; const bool valid = s < offs[32 + e];
        u32x4 a = {0u, 0u, 0u, 0u}, b = {0u, 0u, 0u, 0u}; int r = 0; float w = 0.f;
        const int vz = vzero();
        if (valid) { r = p.lst[(size_t)e * TT + s + vz]; w = p.tok_w[(size_t)e * TT + s + vz];
            const u32x4* src = (const u32x4*)(p.h2 + (size_t)r * DM); a = src[lane]; b = src[64 + lane]; }
        u32x4* dst = (u32x4*)(p.h2p + (size_t)pr * DM); dst[lane] = a; dst[64 + lane] = b;
        if (lane == 0) { p.rww[pr] = w; p.rmr[pr] = valid ? mod_row(r) : 0; }
    }
}

template <bool GATH> struct MoeSched { static constexpr bool GATHER = GATH; const int* lst; int cnt[NEXP]; int G, c, nN; int o[NEXP + 1]; const char* A; const char* B; size_t atile, bexp, btile;
    DEVI void load(const LAS int* offs) {
#pragma unroll
        for (int q = 0; q <= NEXP; ++q) o[q] = __builtin_amdgcn_readfirstlane(offs[q]);
#pragma unroll
        for (int q = 0; q < NEXP; ++q) cnt[q] = __builtin_amdgcn_readfirstlane(offs[32 + q]); }
    DEVI int row_of(const g8::Unit& u, int r) const { int base = 0, n = 0;
#pragma unroll
        for (int q = 0; q < NEXP; ++q) { base = (u.tag == q) ? o[q] : base; n = (u.tag == q) ? cnt[q] : n; }
        const int s2 = u.pm * 256 + r - base; return (s2 < n) ? lst[(size_t)u.tag * TT + s2] : 0; }
    DEVI bool next(int i, g8::Unit& u) const { const long L = (long)i * G + c; const int R = o[NEXP]; if (L >= (long)(R / 256) * nN) return false;
        const int ti = (int)(L / nN), pn = (int)(L % nN); int e = 0;
#pragma unroll
        for (int q = 1; q < NEXP; ++q) e += (ti * 256 >= o[q]) ? 1 : 0;
        u.pm = ti; u.pn = pn; u.tag = e; u.a = A + (size_t)ti * atile; u.b = B + (size_t)e * bexp + (size_t)pn * btile; return true; } };
struct EpiSwiglu {
    static constexpr bool PERM = false, HAS_MID = false; static constexpr int NSEG = 1;
    bf16_t* hid;
    DEVI void operator()(const f32x4 (&acc)[2][2][4][2], const g8::Unit& u, int wr, int wc, int fr, int fq) const {
        const int row0 = u.pm * 256 + wr * 64 + fr, col0 = u.pn * 128 + wc * 32 + 4 * fq;
#pragma unroll
        for (int ai = 0; ai < 2; ++ai)
#pragma unroll
            for (int m = 0; m < 4; ++m)
#pragma unroll
                for (int n = 0; n < 2; ++n) { const f32x4 a = acc[ai][0][m][n], b = acc[ai][1][m][n]; float h[4];
#pragma unroll
                    for (int e = 0; e < 4; ++e) h[e] = a[e] * sigmoidf_(a[e]) * b[e];
                    u32x2 w; w.x = cvt_pk_bf16(h[0], h[1]); w.y = cvt_pk_bf16(h[2], h[3]);
                    *(u32x2*)(hid + (size_t)(row0 + ai * 128 + m * 16) * DEXP + col0 + n * 16) = w; }
    }
};
DEVI void phase_moe_up(const Params& p, int l, const LAS int* offs, LAS unsigned char* lds) {
    MoeSched<true> S; S.lst = p.lst; S.G = gridDim.x; S.c = opq_bid(); S.nN = 2; S.load(offs); S.A = (const char*)p.h2; S.B = (const char*)(p.w13 + (size_t)l * NEXP * 512 * DM);
    S.atile = 0; S.bexp = (size_t)512 * DM * 2; S.btile = (size_t)256 * DM * 2;
    EpiSwiglu E; E.hid = p.hid;
    g8::gemm_phase(lds, DM, DM, DM, S, E);
}
struct EpiDown {
    static constexpr bool PERM = true, HAS_MID = false; static constexpr int NSEG = 1;
    bf16_t* yo; const float* tokw; const int* lst; const LAS int* offs; const float* g2base;
    DEVI void operator()(const f32x4 (&acc)[2][2][4][2], const g8::Unit& u, int wr, int wc, int fr, int fq) const {
        const int row0 = u.pm * 256 + wr * 64 + fr, col0 = u.pn * 256 + wc * 32 + 8 * fq;
#pragma unroll
        for (int ai = 0; ai < 2; ++ai)
#pragma unroll
            for (int m = 0; m < 4; ++m) { const int row = row0 + ai * 128 + m * 16; const int e = u.tag, s2 = row - offs[e]; const bool valid = s2 < offs[32 + e];
                const float w = valid ? tokw[(size_t)e * TT + s2] : 0.f; const int mr = valid ? mod_row(lst[(size_t)e * TT + s2]) : 0; const float* g2 = g2base + (size_t)mr * 6144 + col0;
#pragma unroll
                for (int bj = 0; bj < 2; ++bj) { const f32x4 ga = *(const f32x4*)(g2 + bj * 128), gb = *(const f32x4*)(g2 + bj * 128 + 4);
                    const f32x4 v0 = acc[ai][bj][m][0] * ga * w, v1 = acc[ai][bj][m][1] * gb * w;
                    u32x4 o; o.x = cvt_pk_bf16(v0[0], v0[1]); o.y = cvt_pk_bf16(v0[2], v0[3]); o.z = cvt_pk_bf16(v1[0], v1[1]); o.w = cvt_pk_bf16(v1[2], v1[3]);
                    *(u32x4*)(yo + (size_t)row * DM + col0 + bj * 128) = o; } }
    }
};
DEVI void phase_moe_down(const Params& p, int l, const LAS int* offs, LAS unsigned char* lds) {
    MoeSched<false> S; S.lst = p.lst; S.G = gridDim.x; S.c = opq_bid(); S.nN = 4; S.load(offs); S.A = (const char*)p.hid; S.B = (const char*)(p.w2 + (size_t)l * NEXP * DM * DEXP);
    S.atile = (size_t)256 * DEXP * 2; S.bexp = (size_t)DM * DEXP * 2; S.btile = (size_t)256 * DEXP * 2;
    EpiDown E; E.yo = p.yo; E.tokw = p.tok_w; E.lst = p.lst; E.offs = offs; E.g2base = p.modv + (size_t)l * 5 * 6144 + 5120;
    g8::gemm_phase(lds, DEXP, DEXP, DEXP, S, E);
}
DEVI void phase_moe_combine(const Params& p, int l, const LAS int* offs, bool dry = false) {
    const int lane = opq_tid() & 63, wv = opq_tid() >> 6; const bool skipc = (l == DEPTH - 1);
    for (int r = opq_bid() * 8 + wv; r < TT; r += gridDim.x * 8) {
        const int pos = r % RB; if (skipc && pos >= SEQ) continue;
        float* x = xbuf_row(p, r);
        const int vz = vzero();
        const int pr0 = offs[p.tok_e[r * 2 + vz]] + p.tok_s[r * 2 + vz], pr1 = offs[p.tok_e[r * 2 + 1 + vz]] + p.tok_s[r * 2 + 1 + vz];
        const bf16_t* y0 = p.yo + (size_t)pr0 * DM; const bf16_t* y1 = p.yo + (size_t)pr1 * DM;
#pragma unroll
        for (int i = 0; i < 4; ++i) { const int c = i * 256 + lane * 4; f32x4 v = *(const f32x4*)(x + c);
            const u32x2 a = *(const u32x2*)(y0 + c), b = *(const u32x2*)(y1 + c);
            v[0] += __uint_as_float(a.x << 16) + __uint_as_float(b.x << 16); v[1] += __uint_as_float(a.x & 0xffff0000u) + __uint_as_float(b.x & 0xffff0000u);
            v[2] += __uint_as_float(a.y << 16) + __uint_as_float(b.y << 16); v[3] += __uint_as_float(a.y & 0xffff0000u) + __uint_as_float(b.y & 0xffff0000u);
            if (!dry || v[0] == 123.456f) *(f32x4*)(x + c) = v; }
    }
}

#ifndef MK_PHASE_KERNELS
#define MK_PHASE_KERNELS 0
#endif
constexpr int LDS_SCRATCH = 1024;

template <class T> DEVI T* uni_ptr(T* x) { const unsigned long long v = (unsigned long long)x;
    const unsigned lo = __builtin_amdgcn_readfirstlane((unsigned)v), hi = __builtin_amdgcn_readfirstlane((unsigned)(v >> 32));
    return (T*)(((unsigned long long)hi << 32) | lo); }
DEVI Params ldparams(const PL& s) {
    Params q;
#pragma unroll
    for (int i = 0; i < 35; ++i) q.in[i] = uni_ptr(s.in[i]);
#define LDP(f) q.f = uni_ptr(s.f)
    LDP(out); LDP(ctrl); LDP(modv); LDP(lbv); LDP(xc); LDP(rope); LDP(lrula); LDP(winA); LDP(winG); LDP(wup); LDP(wcat); LDP(wout); LDP(w13); LDP(w2); LDP(wlru);
    LDP(hx); LDP(pa); LDP(up); LDP(q); LDP(qc); LDP(kv); LDP(st); LDP(stb); LDP(lsum); LDP(lin); LDP(ocat); LDP(y); LDP(h2); LDP(h2p); LDP(hid); LDP(yo);
    LDP(tok_e); LDP(tok_s); LDP(tok_w); LDP(lst); LDP(rww); LDP(rmr);
#undef LDP
    q.pad_ = 0ull;
    return q;
}
DEVI void grid_sync(const PL& s, LAS unsigned char* smem) {
    XcdBarrier b; b.bar = uni_ptr(s.ctrl); b.x = xb_xcc_id(); b.st = (volatile LAS unsigned*)smem;
    xcd_barrier(b);
}
DEVI void probe_dump(const Params& p, const bf16_t* src, size_t n) {
    const size_t NOUT = (size_t)NB * SEQ * DM;
    for (size_t i = (size_t)opq_bid() * 512 + opq_tid(); i < NOUT; i += (size_t)gridDim.x * 512) { float s = 0.f;
        for (size_t k = i; k < n; k += NOUT) s += (float)src[k];
        p.out[i] = s; }
}
#define PROBE_AT(id, buf, n) if (PROBE_STOP == (id) && l == 0 && hb == 0) { { const Params p = ldparams(pl); probe_dump(p, (const bf16_t*)(buf), (n)); } return; }
#ifndef PROBE_STOP
#define PROBE_STOP 0
#endif
#ifndef DUP_MASK
#define DUP_MASK 0
#endif
#define PHASE_D(bit, call, dupcall) PHASE(call); if ((DUP_MASK >> (bit)) & 1) { PHASE(dupcall); }
#define PHASE(call) do { const Params p = ldparams(pl); call; } while (0); grid_sync(pl, smem); if ((DUP_MASK >> 21) & 1) grid_sync(pl, smem)

#ifndef SELFCHECK
#define SELFCHECK 0
#endif
DEVI void chk_sum(const Params& p, int id, int rep, const void* buf, size_t nbytes) {
    const unsigned* w = (const unsigned*)buf; const size_t n = nbytes / 4; unsigned long long s = 0ull;
    for (size_t i = (size_t)opq_bid() * 512 + opq_tid(); i < n; i += (size_t)gridDim.x * 512) s += (unsigned long long)w[i] * (unsigned long long)((i & 1023) + 1);
    unsigned lo = (unsigned)s, hi = (unsigned)(s >> 32);
    for (int o = 32; o >= 1; o >>= 1) { const unsigned l2 = __shfl_xor(lo, o), h2 = __shfl_xor(hi, o); const unsigned long long t = (((unsigned long long)hi << 32) | lo) + (((unsigned long long)h2 << 32) | l2); lo = (unsigned)t; hi = (unsigned)(t >> 32); }
    if ((opq_tid() & 63) == 0) atomicAdd((unsigned long long*)(p.ctrl + 6144) + (rep * 32 + id), (((unsigned long long)hi << 32) | lo));
}
#define CHK(id, buf, nbytes) do { const Params p = ldparams(pl); chk_sum(p, id, rep, buf, nbytes); } while (0); grid_sync(pl, smem)

__global__ void __launch_bounds__(512, 2) hybrid_flow_backbone_kernel(Params pk) {
    extern __shared__ __attribute__((aligned(16))) unsigned char smem_raw[];
    LAS unsigned char* smem = (LAS unsigned char*)smem_raw;
    LAS unsigned char* lds = smem + LDS_SCRATCH; LAS int* offs = (LAS int*)(smem + 64);
    static_assert(sizeof(Params) % 8 == 0 && sizeof(Params) <= LDS_SCRATCH - 256, "Params must fit its LDS slot");
    { (void)pk;
      const __attribute__((address_space(4))) unsigned long long* src = (const __attribute__((address_space(4))) unsigned long long*)__builtin_amdgcn_kernarg_segment_ptr();
      LAS unsigned long long* dst = (LAS unsigned long long*)(smem + 256);
      if (threadIdx.x < sizeof(Params) / 8) dst[threadIdx.x] = src[threadIdx.x]; }
    if (threadIdx.x == 0) *(LAS u32x4*)smem = (u32x4){0u, 0u, 0u, 0u};
    __syncthreads();
    const PL& pl = *(const PL*)(smem + 256);
    (void)xcd_barrier_post(uni_ptr(pl.ctrl), (volatile LAS unsigned*)smem);
    phase_prep(pl, lds); grid_sync(pl, smem);
    if ((DUP_MASK >> 16) & 1) { phase_prep(pl, lds); grid_sync(pl, smem); }
#if SELFCHECK
    for (int rep = 0; rep < SELFCHECK; ++rep) {
        const int l = 0, hb = 0;
        PHASE(phase_norm1(p, l, hb));          CHK(1, p.hx, (size_t)HR * DM * 2);
        PHASE(phase_inproj_a(p, l, lds));      CHK(2, p.pa, (size_t)HR * PA_W * 2);
        PHASE(phase_mla_up(p, l, lds));        CHK(3, p.up, (size_t)HR * UPW * 2);
        PHASE(phase_qkv(p, l, lds));           CHK(4, p.q, (size_t)2 * 8 * SEQ * 96 * 2); CHK(5, p.qc, (size_t)2 * 8 * CTX * 96 * 2);
        PHASE(phase_attn_scan1(p, l, lds));    CHK(6, p.st, (size_t)2 * 2 * 8 * NCH * 4096 * 2); CHK(7, p.stb, (size_t)2 * 2 * 8 * NCH * 64 * 4); CHK(8, p.lsum, (size_t)2 * 2 * NT16 * 512 * 2 * 4);
        PHASE(phase_prefix(p, lds));                CHK(9, p.st, (size_t)2 * 2 * 8 * NCH * 4096 * 2); CHK(10, p.lin, (size_t)2 * 2 * NT16 * 512 * 4);
        PHASE(phase_scan3(p, l, lds));         CHK(11, p.ocat, (size_t)HR * OCW * 2);
        PHASE(phase_inproj_g(p, l, lds));      CHK(12, p.pa, (size_t)HR * PG_W * 2);
        PHASE(phase_merge(p, l, lds));         CHK(13, p.y, (size_t)HR * DM * 2);
        PHASE(phase_outproj(p, l, hb, lds));   CHK(14, p.out, (size_t)2 * SEQ * DM * 4); CHK(15, p.xc, (size_t)2 * CTX * DM * 4);
    }
    {   const Params p = ldparams(pl);
        const size_t NOUT = (size_t)NB * SEQ * DM;
        for (size_t i = (size_t)opq_bid() * 512 + opq_tid(); i < NOUT; i += (size_t)gridDim.x * 512) p.out[i] = 0.f;
        __syncthreads();
        if (opq_bid() == 0 && opq_tid() == 0) { int first = 0; const unsigned long long* c = (const unsigned long long*)(p.ctrl + 6144);
            for (int id = 15; id >= 1; --id) for (int rep = 1; rep < SELFCHECK; ++rep)
                if (__hip_atomic_load(c + rep * 32 + id, __ATOMIC_RELAXED, __HIP_MEMORY_SCOPE_AGENT) != __hip_atomic_load(c + id, __ATOMIC_RELAXED, __HIP_MEMORY_SCOPE_AGENT)) first = id;
            p.out[0] = 1000.0f * (float)first; }
    }
    return;
#endif
    for (int l = 0; l < DEPTH; ++l) {
        for (int hb = 0; hb < 2; ++hb) {
            if (l == 0 && hb == 0) { PHASE_D(0, phase_norm1(p, l, hb), phase_norm1(p, l, hb)); }
            PHASE_D(1, phase_inproj_a(p, l, lds), phase_inproj_a(p, l, lds));
            PHASE_D(2, phase_mla_up(p, l, lds), phase_mla_up(p, l, lds));
            PHASE_D(3, phase_qkv(p, l, lds), phase_qkv(p, l, lds));
            PHASE(phase_attn_scan1(p, l, lds));
            if ((DUP_MASK >> 4) & 1) { PHASE(phase_attn_scan1(p, l, lds, 1)); }
            if ((DUP_MASK >> 5) & 1) { PHASE(phase_attn_scan1(p, l, lds, 2)); }
            if ((DUP_MASK >> 6) & 1) { PHASE(phase_attn_scan1(p, l, lds, 4)); }
            PHASE(phase_prefix(p, lds));
            if ((DUP_MASK >> 17) & 1) { PHASE(phase_prefix(p, lds, true)); }
            PHASE(phase_scan3(p, l, lds));
            if ((DUP_MASK >> 7) & 1) { PHASE(phase_scan3(p, l, lds, 1)); }
            if ((DUP_MASK >> 8) & 1) { PHASE(phase_scan3(p, l, lds, 2)); }
            PHASE_D(9, phase_inproj_g(p, l, lds), phase_inproj_g(p, l, lds));
            PHASE_D(10, phase_merge(p, l, lds), phase_merge(p, l, lds));
            PHASE(phase_outproj(p, l, hb, lds); if (hb == 0) phase_norm1(p, l, 1));
            if (((DUP_MASK >> 11) & 1) && l == 0) { PHASE(phase_outproj(p, l, hb, lds)); }
            if ((DUP_MASK >> 15) & 1) { for (int z = 0; z < 10; ++z) grid_sync(pl, smem); }
        }
        PHASE(phase_norm2_route(p, l));
        if ((DUP_MASK >> 18) & 1) { PHASE(phase_norm2_route(p, l, true)); }
        PHASE_D(13, moe_offsets(p, l, offs); phase_moe_up(p, l, offs, lds), phase_moe_up(p, l, offs, lds));
        PHASE_D(14, phase_moe_down(p, l, offs, lds), phase_moe_down(p, l, offs, lds));
        PHASE(phase_moe_combine(p, l, offs); if (l + 1 < DEPTH) phase_norm1(p, l + 1, 0));
        if ((DUP_MASK >> 19) & 1) { PHASE(phase_moe_combine(p, l, offs, true)); }
    }
}

static size_t align_up(size_t x, size_t a) { return (x + a - 1) / a * a; }

extern "C" void kernel_launch(void* const* d_in, const int* in_sizes, int n_in, void* d_out, int out_size, void* d_ws, size_t ws_size, hipStream_t stream) {
    (void)in_sizes; (void)n_in; (void)out_size;
    Params p; memset(&p, 0, sizeof(p));
    for (int i = 0; i < 35; ++i) p.in[i] = (const float*)d_in[i];
    p.out = (float*)d_out;
    char* w = (char*)d_ws; size_t o = 0;
    auto take = [&](size_t bytes) { char* r = w + o; o = align_up(o + bytes, 256); return r; };
    p.ctrl = (unsigned*)take(CTRL_WORDS * 4);
    p.modv = (float*)take((size_t)DEPTH * 5 * 6144 * 4);
    p.lbv = (float*)take((size_t)DEPTH * 2 * 512 * 4);
    p.xc = (float*)take((size_t)NB * CTX * DM * 4);
    p.rope = (float*)take((size_t)SEQ * 32 * 4);
    p.lrula = (float*)take((size_t)DEPTH * 2 * 512 * 4);
    p.winA = (bf16_t*)take((size_t)DEPTH * PA_W * DM * 2);
    p.winG = (bf16_t*)take((size_t)DEPTH * PG_W * DM * 2);
    p.wup = (bf16_t*)take((size_t)DEPTH * UPW * 256 * 2);
    p.wcat = (bf16_t*)take((size_t)DEPTH * DM * OCW * 2);
    p.wout = (bf16_t*)take((size_t)DEPTH * DM * DM * 2);
    p.w13 = (bf16_t*)take((size_t)DEPTH * NEXP * 512 * DM * 2);
    p.w2 = (bf16_t*)take((size_t)DEPTH * NEXP * DM * DEXP * 2);
    p.wlru = (bf16_t*)take((size_t)DEPTH * 2 * 8 * 2 * 64 * 64 * 2);
    p.tok_e = (int*)take((size_t)TT * 2 * 4); p.tok_s = (int*)take((size_t)TT * 2 * 4);
    p.lst = (int*)take((size_t)NEXP * TT * 4); p.tok_w = (float*)take((size_t)NEXP * TT * 4);
    p.rww = (float*)take((size_t)RP * 4); p.rmr = (int*)take((size_t)RP * 4);
    const size_t region = o;
    p.hx = (bf16_t*)take((size_t)HR * DM * 2);
    p.pa = (bf16_t*)take((size_t)HR * PA_W * 2);
    p.ocat = (bf16_t*)take((size_t)HR * OCW * 2);
    p.lsum = (float*)take((size_t)2 * 2 * NT16 * 512 * 2 * 4); p.lin = (float*)take((size_t)2 * 2 * NT16 * 512 * 4);
    const size_t alias1 = o;
    p.up = (bf16_t*)take((size_t)HR * UPW * 2);
    const size_t after_up = o; o = alias1;
    p.st = (bf16_t*)take((size_t)2 * 2 * 8 * NCH * 4096 * 2); p.stb = (float*)take((size_t)2 * 2 * 8 * NCH * 64 * 4);
    if (o < after_up) o = after_up;
    const size_t alias2 = o;
    p.q = (bf16_t*)take((size_t)2 * 8 * SEQ * 96 * 2); p.qc = (bf16_t*)take((size_t)2 * 8 * CTX * 96 * 2); p.kv = (unsigned char*)take((size_t)2 * 8 * NCH * KVT_BYTES);
    const size_t mixer_end = o; o = alias2;
    p.y = (bf16_t*)take((size_t)HR * DM * 2);
    size_t end1 = mixer_end > o ? mixer_end : o;
    o = region;
    p.h2 = (bf16_t*)take((size_t)TT * DM * 2);
    p.h2p = (bf16_t*)take((size_t)RP * DM * 2);
    p.hid = (bf16_t*)take((size_t)RP * DEXP * 2);
    p.yo = (bf16_t*)take((size_t)RP * DM * 2);
    const size_t need = end1 > o ? end1 : o;
    static int grid = 0;
    if (!grid) {
        int dev = 0, cus = 0, per_cu = 0; hipGetDevice(&dev); hipDeviceGetAttribute(&cus, hipDeviceAttributeMultiprocessorCount, dev);
        hipFuncSetAttribute((const void*)hybrid_flow_backbone_kernel, hipFuncAttributeMaxDynamicSharedMemorySize, LDS_TOTAL);
        hipOccupancyMaxActiveBlocksPerMultiprocessor(&per_cu, (const void*)hybrid_flow_backbone_kernel, 512, LDS_TOTAL);
        if (per_cu < 1) fprintf(stderr, "kernel_launch: occupancy query returned %d\n", per_cu);
        grid = cus * (per_cu < 1 ? 0 : 1); if (grid > 256) grid = 256;
    }
    if (need > ws_size) { fprintf(stderr, "kernel_launch: workspace too small: need %zu have %zu\n", need, ws_size); return; }
    if (grid < 8) { fprintf(stderr, "kernel_launch: grid %d too small\n", grid); return; }
    hipMemsetAsync(p.ctrl, 0, CTRL_WORDS * 4, stream);
    hipLaunchKernelGGL(hybrid_flow_backbone_kernel, dim3(grid), dim3(512), LDS_TOTAL, stream, p);
}
```

```cpp
#include <hip/hip_runtime.h>
#include <stdint.h>
#include <stdio.h>
#include <string.h>

#define LAS __attribute__((address_space(3)))
#define DEVI __device__ __forceinline__
typedef unsigned short bf16_t;
typedef short bf16x8 __attribute__((ext_vector_type(8)));
typedef float f32x4 __attribute__((ext_vector_type(4)));
typedef float f32x16 __attribute__((ext_vector_type(16)));
typedef unsigned u32x4 __attribute__((ext_vector_type(4)));
typedef unsigned u32x2 __attribute__((ext_vector_type(2)));

constexpr int NB = 4, SEQ = 8192, CTX = 256, DM = 1024, DEPTH = 2;
constexpr int RB = SEQ + CTX;
constexpr int TT = NB * RB;
constexpr int HR = 2 * RB;
constexpr int NCH = RB / 64;
constexpr int INW = 7072;
constexpr int PA_W = 4096;
constexpr int PG_W = 3072;
constexpr int C_Q = 0, C_ZF = 512, C_ZB = 1024, C_I = 1536, C_G = 2048, C_DQ = 2560, C_DKV = 2816, C_KR = 2944, C_LX = 3072, C_LY = 3584;
constexpr int UPW = 1792;
constexpr int OCW = 1536;
constexpr int KVT_BYTES = 22016;
constexpr int KT_BYTES = 13312;
constexpr int NEXP = 16, DEXP = 256;
constexpr float EPSF = 1e-6f;
constexpr int LDS_TOTAL = 160 * 1024;

DEVI float bf2f(bf16_t b) { return __uint_as_float(((unsigned)b) << 16); }
DEVI bf16_t f2bf(float f) { return __builtin_bit_cast(bf16_t, (__bf16)f); }
typedef float f32x2_t __attribute__((ext_vector_type(2)));
typedef __bf16 bf16x2_t __attribute__((ext_vector_type(2)));
DEVI unsigned cvt_pk_bf16(float lo, float hi) { const f32x2_t v = {lo, hi}; return __builtin_bit_cast(unsigned, __builtin_convertvector(v, bf16x2_t)); }
DEVI float fast_exp2(float x) { return __builtin_amdgcn_exp2f(x); }
DEVI float fast_rcp(float x) { return __builtin_amdgcn_rcpf(x); }
DEVI float sigmoidf_(float x) { return fast_rcp(1.0f + fast_exp2(-1.44269504f * x)); }
DEVI float wave_sum(float v) { for (int o = 32; o >= 1; o >>= 1) v += __shfl_xor(v, o); return v; }
DEVI float wave_max(float v) { for (int o = 32; o >= 1; o >>= 1) v = fmaxf(v, __shfl_xor(v, o)); return v; }

DEVI int opq_tid() { int t = threadIdx.x; asm volatile("" : "+v"(t)); return t; }
DEVI int opq_bid() { int b = blockIdx.x; asm volatile("" : "+s"(b)); return b; }

DEVI int vzero() { int z = 0; asm volatile("" : "+v"(z)); return z; }

#define XB_TMO      128
#define XB_XCNT(j)  (256  + 64 * (j))
#define XB_XSUB(j)  (1280 + 64 * (j))
#define XB_XGEN(j)  (2304 + 64 * (j))
#define XB_TOP      3328
#define XB_TOPGEN   3392
#define XCD_BAR_WORDS 3456
#define XB_SPIN_CAP (1u << 18)

__device__ __forceinline__ unsigned xb_ld(unsigned* p)              { return __hip_atomic_load(p, __ATOMIC_RELAXED, __HIP_MEMORY_SCOPE_AGENT); }
__device__ __forceinline__ unsigned xb_add(unsigned* p, unsigned v) { return __hip_atomic_fetch_add(p, v, __ATOMIC_RELAXED, __HIP_MEMORY_SCOPE_AGENT); }
__device__ __forceinline__ unsigned xb_xcc_id() { return (unsigned)__builtin_amdgcn_s_getreg((3 << 11) | 20) & 0xFu; }
#define XB_SPIN(cond, bar) do { unsigned _sp = 0; while (cond) { __builtin_amdgcn_s_sleep(1); \
    if ((++_sp & 255u) == 0u) { if (xb_ld(&(bar)[XB_TMO])) break; if (_sp > XB_SPIN_CAP) { atomicAdd(&(bar)[XB_TMO], 1u); break; } } } } while (0)

struct XcdBarrier { unsigned* bar; unsigned x; volatile LAS unsigned* st; };

__device__ __forceinline__ XcdBarrier xcd_barrier_post(unsigned* bar, volatile LAS unsigned* st) {
    XcdBarrier b; b.bar = bar; b.x = xb_xcc_id(); b.st = st;
    if (threadIdx.x == 0) (void)xb_add(&bar[XB_XCNT(b.x)], 1u);
    return b;
}
__device__ __forceinline__ void xcd_barrier_complete(unsigned* bar, unsigned x, unsigned& nloc, unsigned& nx) {
    const unsigned G = gridDim.x * gridDim.y * gridDim.z;
    unsigned sum, cnt, mine, sp = 0u;
    for (;;) {
        sum = 0u; cnt = 0u; mine = 0u;
#pragma unroll
        for (unsigned j = 0; j < 16; ++j) { const unsigned c = xb_ld(&bar[XB_XCNT(j)]); sum += c; cnt += (c > 0u) ? 1u : 0u; mine = (j == x) ? c : mine; }
        if (sum == G) break;
        __builtin_amdgcn_s_sleep(1);
        if ((++sp & 255u) == 0u) { if (xb_ld(&bar[XB_TMO])) break; if (sp > XB_SPIN_CAP) { atomicAdd(&bar[XB_TMO], 1u); break; } }
    }
    nloc = mine > 0u ? mine : 1u; nx = cnt > 0u ? cnt : 1u;
}
__device__ __forceinline__ void xcd_barrier(const XcdBarrier& b) {
    asm volatile("s_waitcnt vmcnt(0)" ::: "memory");
    __syncthreads();
    if (threadIdx.x == 0) {
        unsigned* bar = b.bar;
        __builtin_amdgcn_s_waitcnt(0);
        unsigned nloc = b.st[0], nx = b.st[1];
        if (nloc == 0u) { xcd_barrier_complete(bar, b.x, nloc, nx); b.st[0] = nloc; b.st[1] = nx; }
        const unsigned old = xb_add(&bar[XB_XSUB(b.x)], 1u);
        const unsigned gen = old / nloc;
        if (old + 1u == (gen + 1u) * nloc) {
            __builtin_amdgcn_fence(__ATOMIC_RELEASE, "agent");
            asm volatile("s_waitcnt vmcnt(0)" ::: "memory");
            const unsigned og = xb_add(&bar[XB_TOP], 1u);
            const unsigned tg = og / nx;
            if (og + 1u == (tg + 1u) * nx) xb_add(&bar[XB_TOPGEN], 1u);
            else XB_SPIN(xb_ld(&bar[XB_TOPGEN]) == tg, bar);
            __builtin_amdgcn_fence(__ATOMIC_ACQUIRE, "agent");
            xb_add(&bar[XB_XGEN(b.x)], 1u);
            asm volatile("s_waitcnt vmcnt(0)" ::: "memory");
        } else {
            XB_SPIN(xb_ld(&bar[XB_XGEN(b.x)]) == gen, bar);
            __builtin_amdgcn_fence(__ATOMIC_ACQUIRE, "agent");
            asm volatile("s_waitcnt vmcnt(0)" ::: "memory");
        }
    }
    __syncthreads();
}

struct Params {
    const float* in[35];
    float* out;
    unsigned* ctrl;
    float* modv;
    float* lbv;
    float* xc;
    float* lrula;
    float* rope;
    bf16_t* winA; bf16_t* winG; bf16_t* wup; bf16_t* wcat; bf16_t* wout; bf16_t* w13; bf16_t* w2; bf16_t* wlru;
    bf16_t* hx;
    bf16_t* pa;
    bf16_t* up;
    bf16_t* q; bf16_t* qc; unsigned char* kv;
    bf16_t* st; float* stb;
    float* lsum; float* lin;
    bf16_t* ocat;
    bf16_t* y;
    bf16_t* h2; bf16_t* h2p; bf16_t* hid; bf16_t* yo;
    int* tok_e; int* tok_s; float* tok_w; int* lst; float* rww; int* rmr;
    unsigned long long pad_;
};

typedef LAS Params PL;

#define CTRL_CNT(l) (4096 + 64 * (l))
#define CTRL_WORDS 8192

namespace g8 {
constexpr int BM = 256, BK = 64, HALF = 128, HTB = HALF * BK * 2, STAGE_BYTES = 8 * HTB, NXCD = 8, WGM = 8;
__host__ __device__ __forceinline__ int lds_byte(int r, int c) { const int st = (r >> 4) * 2 + (c >> 5), rr = r & 15, cc = c & 31, ob = rr * 64 + cc * 2; return st * 1024 + (ob ^ (((ob >> 9) & 1) << 5)); }
__host__ __device__ __forceinline__ void stage_rc(int b, int& R, int& C) { const int st = b / 1024, sb = b % 1024, swz = sb ^ (((sb >> 9) & 1) << 5); R = (st >> 1) * 16 + swz / 64; C = (st & 1) * 32 + (swz % 64) / 2; }
__host__ __device__ __forceinline__ int perm32(int rho) { const int n = rho >> 4, i = rho & 15; return 8 * (i >> 2) + 4 * n + (i & 3); }

struct Unit { int pm, pn, tag; const char* a; const char* b; };

__device__ __forceinline__ bool static_order(int i, int G, int c, int nM, int nN, int& pm, int& pn) {
    const int nwg = nM * nN; const long L = (long)i * G + c; if (L >= nwg) return false;
    int wgid = (int)L; { const int q = nwg / NXCD, r = nwg % NXCD, xcd = wgid % NXCD, off = wgid / NXCD; wgid = (xcd < r ? xcd * (q + 1) : r * (q + 1) + (xcd - r) * q) + off; }
    const int nig = WGM * nN, gid = wgid / nig, fm = gid * WGM, gsz = (nM - fm) < WGM ? (nM - fm) : WGM;
    pm = fm + ((wgid % nig) % gsz); pn = (wgid % nig) / gsz; return true;
}

template <class Epi, class Sched>
__device__ __forceinline__ void gemm_phase(LAS unsigned char* lds, const int lda, const int ldb, const int K, const Sched& S, const Epi& E) {
    const int tid = opq_tid(), wid = __builtin_amdgcn_readfirstlane(tid >> 6), lane = tid & 63, wr = wid >> 2, wc = wid & 3, fr = lane & 15, fq = lane >> 4;
    const int nt = K / BK;
    unsigned voffB[2]; int RA[2], CA[2];
#pragma unroll
    for (int i = 0; i < 2; ++i) { int R, C; stage_rc(tid * 16 + i * 8192, R, C); const int Rb = Epi::PERM ? ((R & ~31) + perm32(R & 31)) : R;
        RA[i] = R; CA[i] = C; voffB[i] = (unsigned)(Rb * ldb + C) * 2u; }
    auto set_voff = [&](const Unit& u, unsigned (&v)[2][2]) {
#pragma unroll
        for (int h = 0; h < 2; ++h)
#pragma unroll
            for (int i = 0; i < 2; ++i) { if constexpr (Sched::GATHER) v[h][i] = (unsigned)S.row_of(u, h * HALF + RA[i]) * (unsigned)(lda * 2) + (unsigned)CA[i] * 2u;
                else v[h][i] = (unsigned)((h * HALF + RA[i]) * lda + CA[i]) * 2u; } };
    const size_t kstep = (size_t)(BK * 2);
    const size_t hstepB = (size_t)HALF * ldb * 2;
    const unsigned ldsw = (unsigned)wid * 1024u;
    const int aoff = lds_byte(wr * 64 + fr, fq * 8), boff = lds_byte(wc * 32 + fr, fq * 8);
#define G8_SA(b, h) (((b) * 2 + (h)) * HTB)
#define G8_SB(b, h) ((4 + (b) * 2 + (h)) * HTB)
#define G8_STAGE(bufoff, gbase, voff) do { _Pragma("unroll") for (int _i = 0; _i < 2; ++_i) \
        __builtin_amdgcn_global_load_lds((const unsigned*)((const char*)(gbase) + (voff)[_i]), (LAS unsigned*)(lds + (bufoff) + ldsw + _i * 8192), 16, 0, 0); } while (0)
#define G8_LDA(dst, b, h) do { _Pragma("unroll") for (int m = 0; m < 4; ++m) _Pragma("unroll") for (int k = 0; k < 2; ++k) dst[m][k] = *(const LAS bf16x8*)(lds + G8_SA(b, h) + aoff + m * 2048 + k * 1024); } while (0)
#define G8_LDB(dst, b, h) do { _Pragma("unroll") for (int n = 0; n < 2; ++n) _Pragma("unroll") for (int k = 0; k < 2; ++k) dst[n][k] = *(const LAS bf16x8*)(lds + G8_SB(b, h) + boff + n * 2048 + k * 1024); } while (0)
#define G8_MMA(ai, bj, At, Bt) do { __builtin_amdgcn_s_setprio(1); _Pragma("unroll") for (int m = 0; m < 4; ++m) _Pragma("unroll") for (int n = 0; n < 2; ++n) _Pragma("unroll") for (int k = 0; k < 2; ++k) \
        acc[ai][bj][m][n] = __builtin_amdgcn_mfma_f32_16x16x32_bf16(Bt[n][k], At[m][k], acc[ai][bj][m][n], 0, 0, 0); __builtin_amdgcn_s_setprio(0); } while (0)
#define G8_WAIT_V(n) asm volatile("s_waitcnt vmcnt(" #n ")" ::: "memory")
#define G8_WAIT_L(n) asm volatile("s_waitcnt lgkmcnt(" #n ")" ::: "memory")
#define G8_BAR __builtin_amdgcn_s_barrier()
#define G8_SCHED __builtin_amdgcn_sched_barrier(0)
    Unit cur, nxt; int ui = 0;
    if (!S.next(0, cur)) return;
    f32x4 acc[2][2][4][2];
#pragma unroll
    for (int a = 0; a < 2; ++a)
#pragma unroll
        for (int b = 0; b < 2; ++b)
#pragma unroll
            for (int m = 0; m < 4; ++m)
#pragma unroll
                for (int n = 0; n < 2; ++n) acc[a][b][m][n] = (f32x4){0.f, 0.f, 0.f, 0.f};
    bf16x8 At[4][2], B0[2][2], B1[2][2];
    const char* cA = cur.a; const char* cB = cur.b;
    unsigned vcur[2][2], vnxt[2][2]; set_voff(cur, vcur);
    asm volatile("s_waitcnt lgkmcnt(0)" ::: "memory");
    if constexpr (Sched::GATHER) asm volatile("s_waitcnt vmcnt(0)" ::: "memory");
    G8_STAGE(G8_SB(0, 0), cB, voffB); G8_STAGE(G8_SA(0, 0), cA, vcur[0]); G8_STAGE(G8_SB(0, 1), cB + hstepB, voffB); G8_STAGE(G8_SA(0, 1), cA, vcur[1]);
    if (wr == 1) G8_BAR;
    G8_WAIT_V(4); G8_BAR;
    G8_STAGE(G8_SB(1, 0), cB + kstep, voffB); G8_STAGE(G8_SA(1, 0), cA + kstep, vcur[0]); G8_STAGE(G8_SB(1, 1), cB + hstepB + kstep, voffB);
    G8_WAIT_V(6); G8_BAR;
    for (;;) {
        const bool has_next = S.next(ui + 1, nxt);
        const char* nA = has_next ? nxt.a : cA; const char* nB = has_next ? nxt.b : cB;
        if (has_next) set_voff(nxt, vnxt); else {
#pragma unroll
            for (int h = 0; h < 2; ++h) { vnxt[h][0] = vcur[h][0]; vnxt[h][1] = vcur[h][1]; } }
        asm volatile("s_waitcnt lgkmcnt(0)" ::: "memory");
        const int tseg = nt / Epi::NSEG;
#pragma unroll 1
        for (int sg = 0; sg < Epi::NSEG; ++sg) {
#pragma unroll 1
        for (int t = sg * tseg; t < (sg + 1) * tseg; t += 2) {
            const bool last = (t == nt - 2);
            const char* a1 = cA + (size_t)(t + 1) * kstep;
            const char* a2 = last ? nA : cA + (size_t)(t + 2) * kstep; const char* b2 = last ? nB : cB + (size_t)(t + 2) * kstep;
            const char* a3 = a2 + kstep; const char* b3 = b2 + kstep;
            unsigned v20[2], v21[2];
#pragma unroll
            for (int i = 0; i < 2; ++i) { v20[i] = last ? vnxt[0][i] : vcur[0][i]; v21[i] = last ? vnxt[1][i] : vcur[1][i]; }
            G8_LDB(B0, 0, 0); G8_SCHED; G8_LDA(At, 0, 0); G8_STAGE(G8_SA(1, 1), a1, vcur[1]);
            G8_WAIT_L(8); G8_BAR; G8_WAIT_L(0); G8_MMA(0, 0, At, B0); G8_BAR; G8_SCHED;
            G8_LDB(B1, 0, 1); G8_STAGE(G8_SB(0, 0), b2, voffB);
            G8_BAR; G8_WAIT_L(0); G8_MMA(0, 1, At, B1); G8_BAR;
            G8_LDA(At, 0, 1); G8_STAGE(G8_SA(0, 0), a2, v20);
            G8_BAR; G8_WAIT_L(0); G8_MMA(1, 0, At, B0); G8_BAR; G8_SCHED;
            G8_STAGE(G8_SB(0, 1), b2 + hstepB, voffB);
            G8_WAIT_V(6); G8_BAR; G8_MMA(1, 1, At, B1); G8_BAR;
            G8_LDB(B0, 1, 0); G8_SCHED; G8_LDA(At, 1, 0); G8_STAGE(G8_SA(0, 1), a2, v21);
            G8_WAIT_L(8); G8_BAR; G8_WAIT_L(0); G8_MMA(0, 0, At, B0); G8_BAR; G8_SCHED;
            G8_LDB(B1, 1, 1); G8_STAGE(G8_SB(1, 0), b3, voffB);
            G8_BAR; G8_WAIT_L(0); G8_MMA(0, 1, At, B1); G8_BAR;
            G8_LDA(At, 1, 1); G8_STAGE(G8_SA(1, 0), a3, v20);
            G8_BAR; G8_WAIT_L(0); G8_MMA(1, 0, At, B0); G8_BAR; G8_SCHED;
            G8_STAGE(G8_SB(1, 1), b3 + hstepB, voffB);
            G8_WAIT_V(6); G8_BAR; G8_MMA(1, 1, At, B1); G8_BAR;
        }
        if constexpr (Epi::NSEG > 1) { if (sg + 1 < Epi::NSEG) E.mid(sg, acc, cur, wr, wc, fr, fq); }
        }
        E(acc, cur, wr, wc, fr, fq);
        if (!has_next) break;
#pragma unroll
        for (int a = 0; a < 2; ++a)
#pragma unroll
            for (int b = 0; b < 2; ++b)
#pragma unroll
                for (int m = 0; m < 4; ++m)
#pragma unroll
                    for (int n = 0; n < 2; ++n) acc[a][b][m][n] = (f32x4){0.f, 0.f, 0.f, 0.f};
        cur = nxt; cA = nA; cB = nB; ++ui;
#pragma unroll
        for (int h = 0; h < 2; ++h) { vcur[h][0] = vnxt[h][0]; vcur[h][1] = vnxt[h][1]; }
    }
    G8_WAIT_V(0);
    if (wr == 0) G8_BAR;
    G8_BAR;
#undef G8_SA
#undef G8_SB
#undef G8_STAGE
#undef G8_LDA
#undef G8_LDB
#undef G8_MMA
#undef G8_WAIT_V
#undef G8_WAIT_L
#undef G8_BAR
#undef G8_SCHED
}
}

enum { I_X = 0, I_C, I_CTX, I_CCTX, I_WMOD, I_BMOD, I_NMIX, I_NFFN, I_WIN, I_HGLB, I_HGNORM, I_QNORM, I_KVNORM, I_WUQ, I_WUKV, I_GQ, I_GK,
       I_CONVW, I_CONVB, I_LWA, I_LBA, I_LWX, I_LBX, I_LAM, I_BRHG, I_BRMLA, I_BRLRU, I_WOUT, I_WRG, I_BRG, I_WRE, I_BRE, I_W1, I_W3, I_W2 };

DEVI const float* xin_row_l0(const Params& p, int r) { const int b = r / RB, pos = r - b * RB;
    return pos < SEQ ? p.in[I_X] + ((size_t)b * SEQ + pos) * DM : p.in[I_CTX] + ((size_t)b * CTX + (pos - SEQ)) * DM; }
DEVI float* xbuf_row(const Params& p, int r) { const int b = r / RB, pos = r - b * RB;
    return pos < SEQ ? p.out + ((size_t)b * SEQ + pos) * DM : p.xc + ((size_t)b * CTX + (pos - SEQ)) * DM; }
DEVI int mod_row(int r) { const int b = r / RB, pos = r - b * RB; return pos < SEQ ? b : 4; }

struct TrJob { const float* src; int ld; int K; int ncols; bf16_t* dst; int dld; const float* ks; };

DEVI int tr_job_count() { return DEPTH * (12 + 16 * 5 + 32); }
template <class P> DEVI TrJob tr_job(const P& p, int j) {
    const int per = 12 + 16 * 5 + 32; const int l = j / per; int q = j - l * per; TrJob t; t.ks = nullptr; t.src = nullptr;
    const float* win = p.in[I_WIN] + (size_t)l * DM * INW;
    bf16_t* winA = p.winA + (size_t)l * PA_W * DM; bf16_t* wup = p.wup + (size_t)l * UPW * 256; bf16_t* wcat = p.wcat + (size_t)l * DM * OCW;
    if (q == 0) { t.src = win; t.ld = INW; t.K = DM; t.ncols = 2944; t.dst = winA; t.dld = DM; return t; }
    if (q == 11) { t.src = win + 2944; t.ld = INW; t.K = DM; t.ncols = 32; t.dst = winA + (size_t)2944 * DM; t.dld = DM; return t; }
    if (q == 1) { t.src = nullptr; t.ld = 0; t.K = DM; t.ncols = 96; t.dst = winA + (size_t)2976 * DM; t.dld = DM; return t; }
    if (q == 2) { t.src = win + 2976; t.ld = INW; t.K = DM; t.ncols = 1024; t.dst = winA + (size_t)3072 * DM; t.dld = DM; return t; }
    if (q == 3) { t.src = win + 4000; t.ld = INW; t.K = DM; t.ncols = PG_W; t.dst = p.winG + (size_t)l * PG_W * DM; t.dld = DM; return t; }
    if (q == 4) { t.src = p.in[I_WUQ] + (size_t)l * 256 * 768; t.ld = 768; t.K = 256; t.ncols = 768; t.dst = wup; t.dld = 256; t.ks = p.in[I_QNORM] + l * 256; return t; }
    if (q == 5) { t.src = p.in[I_WUKV] + (size_t)l * 128 * 1024; t.ld = 1024; t.K = 128; t.ncols = 1024; t.dst = wup + (size_t)768 * 256; t.dld = 256; t.ks = p.in[I_KVNORM] + l * 128; return t; }
    if (q == 6) { t.src = nullptr; t.ld = 0; t.K = 128; t.ncols = 1024; t.dst = wup + (size_t)768 * 256 + 128; t.dld = 256; return t; }
    if (q >= 7 && q <= 9) { const int i = q - 7; const float* s = (i == 0 ? p.in[I_BRHG] : i == 1 ? p.in[I_BRMLA] : p.in[I_BRLRU]) + (size_t)l * 512 * DM;
        t.src = s; t.ld = DM; t.K = 512; t.ncols = DM; t.dst = wcat + i * 512; t.dld = OCW; return t; }
    if (q == 10) { t.src = p.in[I_WOUT] + (size_t)l * DM * DM; t.ld = DM; t.K = DM; t.ncols = DM; t.dst = p.wout + (size_t)l * DM * DM; t.dld = DM; return t; }
    q -= 12;
    if (q < 80) { const int e = q / 5, s = q % 5; const size_t le = (size_t)l * NEXP + e;
        if (s < 4) { const int pn = s >> 1, which = s & 1;
            t.src = (which ? p.in[I_W3] : p.in[I_W1]) + le * DM * DEXP + pn * 128; t.ld = DEXP; t.K = DM; t.ncols = 128;
            t.dst = p.w13 + le * 512 * DM + (size_t)(pn * 256 + which * 128) * DM; t.dld = DM; return t; }
        t.src = p.in[I_W2] + le * DEXP * DM; t.ld = DM; t.K = DEXP; t.ncols = DM; t.dst = p.w2 + le * DM * DEXP; t.dld = DEXP; return t; }
    q -= 80;
    { const int d = q >> 4, n = (q >> 1) & 7, which = q & 1;
      const size_t blk = (((size_t)l * 2 + d) * 8 + n);
      t.src = (which ? p.in[I_LWX] : p.in[I_LWA]) + blk * 64 * 64; t.ld = 64; t.K = 64; t.ncols = 64;
      t.dst = p.wlru + (blk * 2 + which) * 64 * 64; t.dld = 64; return t; }
}

template <class P> DEVI void phase_prep(const P& p, LAS unsigned char* lds) {
    const int tid = opq_tid(), G = gridDim.x;
    LAS float* tl = (LAS float*)lds;
    int rot = 0; const int nj = tr_job_count();
    for (int j = 0; j < nj; ++j) {
        const TrJob t = tr_job(p, j);
        const bool wide = (t.ncols & 63) == 0;
        const int tw = wide ? 64 : 32, tk = t.K / 64, ntile = tk * (t.ncols / tw);
        const int first = (int)((opq_bid() + (unsigned)G - (unsigned)(rot % G)) % (unsigned)G);
        if (wide) {
            for (int tile0 = first; tile0 < ntile; tile0 += 4 * G) {
                float v[4][8];
#pragma unroll
                for (int q = 0; q < 4; ++q) { const int tile = tile0 + q * G; const int k0 = (tile % tk) * 64, n0 = (tile / tk) * 64; const int n = tid & 63, kr = tid >> 6;
#pragma unroll
                    for (int i = 0; i < 8; ++i) { const int k = kr + 8 * i; float x = 0.f;
                        if (tile < ntile && t.src) { x = t.src[(size_t)(k0 + k) * t.ld + n0 + n]; if (t.ks) x *= t.ks[k0 + k]; }
                        v[q][i] = x; } }
#pragma unroll
                for (int q = 0; q < 4; ++q) { const int n = tid & 63, kr = tid >> 6;
#pragma unroll
                    for (int i = 0; i < 8; ++i) tl[q * 4160 + (kr + 8 * i) * 65 + n] = v[q][i]; }
                __syncthreads();
#pragma unroll
                for (int q = 0; q < 4; ++q) { const int tile = tile0 + q * G; if (tile < ntile) { const int k0 = (tile % tk) * 64, n0 = (tile / tk) * 64; const int k = tid & 63, nn = tid >> 6;
#pragma unroll
                    for (int i = 0; i < 8; ++i) { const int n = nn + 8 * i; t.dst[(size_t)(n0 + n) * t.dld + k0 + k] = f2bf(tl[q * 4160 + k * 65 + n]); } } }
                __syncthreads();
            }
        } else {
            for (int tile0 = first; tile0 < ntile; tile0 += 8 * G) {
                float v[8][4];
#pragma unroll
                for (int q = 0; q < 8; ++q) { const int tile = tile0 + q * G; const int k0 = (tile % tk) * 64, n0 = (tile / tk) * 32; const int n = tid & 31, kr = tid >> 5;
#pragma unroll
                    for (int i = 0; i < 4; ++i) { const int k = kr + 16 * i; float x = 0.f;
                        if (tile < ntile && t.src) { x = t.src[(size_t)(k0 + k) * t.ld + n0 + n]; if (t.ks) x *= t.ks[k0 + k]; }
                        v[q][i] = x; } }
#pragma unroll
                for (int q = 0; q < 8; ++q) { const int n = tid & 31, kr = tid >> 5;
#pragma unroll
                    for (int i = 0; i < 4; ++i) tl[q * 2112 + (kr + 16 * i) * 33 + n] = v[q][i]; }
                __syncthreads();
#pragma unroll
                for (int q = 0; q < 8; ++q) { const int tile = tile0 + q * G; if (tile < ntile) { const int k0 = (tile % tk) * 64, n0 = (tile / tk) * 32; const int k = tid & 63, nn = tid >> 6;
#pragma unroll
                    for (int i = 0; i < 4; ++i) { const int n = nn + 8 * i; t.dst[(size_t)(n0 + n) * t.dld + k0 + k] = f2bf(tl[q * 2112 + k * 33 + n]); } } }
                __syncthreads();
            }
        }
        rot += ntile;
    }
    {
        LAS float* sl = (LAS float*)lds;
        LAS float* red = sl + 5 * 1024;
        for (int i = tid; i < 5 * 1024; i += 512) { const int r = i >> 10, k = i & 1023; const float v = r < 4 ? p.in[I_C][r * DM + k] : p.in[I_CCTX][k]; sl[i] = v * sigmoidf_(v); }
        __syncthreads();
        for (int u = opq_bid(); u < DEPTH * 96; u += G) {
            const int l = u / 96, n0 = (u % 96) * 64, col = tid & 63, ks = tid >> 6;
            const float* w = p.in[I_WMOD] + (size_t)l * DM * 6144 + n0 + col;
            float a0 = 0.f, a1 = 0.f, a2 = 0.f, a3 = 0.f, a4 = 0.f;
#pragma unroll 8
            for (int k = ks * 128; k < ks * 128 + 128; ++k) { const float wv = w[(size_t)k * 6144];
                a0 += sl[k] * wv; a1 += sl[1024 + k] * wv; a2 += sl[2048 + k] * wv; a3 += sl[3072 + k] * wv; a4 += sl[4096 + k] * wv; }
            red[(ks * 5 + 0) * 64 + col] = a0; red[(ks * 5 + 1) * 64 + col] = a1; red[(ks * 5 + 2) * 64 + col] = a2; red[(ks * 5 + 3) * 64 + col] = a3; red[(ks * 5 + 4) * 64 + col] = a4;
            __syncthreads();
            if (tid < 320) { const int r = tid >> 6, c2 = tid & 63; float s = p.in[I_BMOD][l * 6144 + n0 + c2];
#pragma unroll
                for (int q = 0; q < 8; ++q) s += red[(q * 5 + r) * 64 + c2];
                p.modv[((size_t)l * 5 + r) * 6144 + n0 + c2] = s; }
            __syncthreads();
        }
    }
    for (int i = opq_bid() * 512 + tid; i < SEQ * 16; i += G * 512) { const int pos = i >> 4, a = i & 15;
        const float inv = exp2f(-(float)(a & 7) * (13.287712379549449f / 8.0f)); const float ang = (float)((a < 8) ? (pos >> 6) : (pos & 63)) * inv;
        float sn, cs; sincosf(ang, &sn, &cs); p.rope[(size_t)pos * 32 + a] = cs; p.rope[(size_t)pos * 32 + 16 + a] = sn; }
    if (opq_bid() == 1) { for (int i = tid; i < DEPTH * 2 * 512; i += 512) p.lrula[i] = -8.0f * 1.44269504f * log1pf(__expf(-p.in[I_LAM][i])); }
    if (opq_bid() == 0) {
        for (int i = tid; i < 2 * 512; i += 512) { const float a0 = p.in[I_HGLB][i], a1 = p.in[I_HGLB][1024 + i]; const float m = fmaxf(a0, a1);
            const float e0 = __expf(a0 - m), e1 = __expf(a1 - m); p.lbv[i] = 0.f; p.lbv[1024 + i] = e1 / (e0 + e1); }
    }
}

DEVI void phase_norm1(const Params& p, int l, int hb) {
    const int lane = opq_tid() & 63, wv = opq_tid() >> 6;
    const float* gm = p.in[I_NMIX] + l * DM;
    for (int rl = opq_bid() * 8 + wv; rl < HR; rl += gridDim.x * 8) {
        const int r = hb * HR + rl;
        const float* src = (l == 0) ? xin_row_l0(p, r) : (const float*)xbuf_row(p, r);
        f32x4 v[4]; float ss = 0.f;
#pragma unroll
        for (int i = 0; i < 4; ++i) { v[i] = *(const f32x4*)(src + i * 256 + lane * 4); ss += v[i][0] * v[i][0] + v[i][1] * v[i][1] + v[i][2] * v[i][2] + v[i][3] * v[i][3]; }
        ss = wave_sum(ss);
        const float rstd = rsqrtf(ss * (1.0f / DM) + EPSF);
        const float* mv = p.modv + ((size_t)l * 5 + mod_row(r)) * 6144;
#pragma unroll
        for (int i = 0; i < 4; ++i) { const int c = i * 256 + lane * 4;
            const f32x4 g = *(const f32x4*)(gm + c), sh = *(const f32x4*)(mv + c), sc = *(const f32x4*)(mv + 1024 + c);
            f32x4 h;
#pragma unroll
            for (int e = 0; e < 4; ++e) h[e] = v[i][e] * rstd * g[e] * (1.0f + sc[e]) + sh[e];
            u32x2 w; w.x = cvt_pk_bf16(h[0], h[1]); w.y = cvt_pk_bf16(h[2], h[3]);
            *(u32x2*)(p.hx + (size_t)rl * DM + c) = w; }
    }
}

struct TileSched {
    static constexpr bool GATHER = false;
    int nM, nN, G, c, skipctx; const char* A; const char* B; size_t atile, btile; size_t acol_bytes;
    DEVI bool next(int i, g8::Unit& u) const {
        int pm, pn; if (!g8::static_order(i, G, c, nM, nN, pm, pn)) return false;
        const int pma = skipctx ? pm + pm / 32 : pm;
        u.pm = pma; u.pn = pn; u.tag = 0; u.a = A + (size_t)pma * atile + acol_bytes; u.b = B + (size_t)pn * btile; return true; }
};

template <int ACT> struct EpiBf16 {
    static constexpr bool PERM = true, HAS_MID = false; static constexpr int NSEG = 1;
    bf16_t* O; int ldc;
    DEVI void operator()(const f32x4 (&acc)[2][2][4][2], const g8::Unit& u, int wr, int wc, int fr, int fq) const {
        const int row0 = u.pm * 256 + wr * 64 + fr, col0 = u.pn * 256 + wc * 32 + 8 * fq;
#pragma unroll
        for (int ai = 0; ai < 2; ++ai)
#pragma unroll
            for (int m = 0; m < 4; ++m) { bf16_t* rowp = O + (size_t)(row0 + ai * 128 + m * 16) * ldc + col0;
#pragma unroll
                for (int bj = 0; bj < 2; ++bj) { f32x4 v0 = acc[ai][bj][m][0], v1 = acc[ai][bj][m][1];
                    if (ACT == 1) {
#pragma unroll
                        for (int e = 0; e < 4; ++e) { v0[e] = sigmoidf_(v0[e]); v1[e] = sigmoidf_(v1[e]); } }
                    u32x4 w; w.x = cvt_pk_bf16(v0[0], v0[1]); w.y = cvt_pk_bf16(v0[2], v0[3]); w.z = cvt_pk_bf16(v1[0], v1[1]); w.w = cvt_pk_bf16(v1[2], v1[3]);
                    *(u32x4*)(rowp + bj * 128) = w; } }
    }
};

DEVI void phase_inproj_a(const Params& p, int l, LAS unsigned char* lds) {
    TileSched S; S.nM = HR / 256; S.nN = PA_W / 256; S.G = gridDim.x; S.c = opq_bid(); S.skipctx = 0;
    S.A = (const char*)p.hx; S.B = (const char*)(p.winA + (size_t)l * PA_W * DM); S.atile = (size_t)256 * DM * 2; S.btile = (size_t)256 * DM * 2; S.acol_bytes = 0;
    EpiBf16<0> E; E.O = p.pa; E.ldc = PA_W;
    g8::gemm_phase(lds, DM, DM, DM, S, E);
}

struct UpSched { static constexpr bool GATHER = false; int G, c; const char* A; const char* B;
    DEVI bool next(int i, g8::Unit& u) const { const long L = (long)i * G + c; if (L >= (HR / 256) * 7) return false;
        const int pm = (int)(L / 7), j = (int)(L % 7); u.pm = pm; u.pn = j; u.tag = 0;
        u.a = A + (size_t)pm * 256 * PA_W * 2 + (size_t)(j < 3 ? C_DQ : C_DKV) * 2; u.b = B + (size_t)j * 256 * 256 * 2; return true; } };
DEVI void phase_mla_up(const Params& p, int l, LAS unsigned char* lds) {
    UpSched S; S.G = gridDim.x; S.c = opq_bid(); S.A = (const char*)p.pa; S.B = (const char*)(p.wup + (size_t)l * UPW * 256);
    EpiBf16<0> E; E.O = p.up; E.ldc = UPW;
    g8::gemm_phase(lds, PA_W, 256, 256, S, E);
}

DEVI void phase_inproj_g(const Params& p, int l, LAS unsigned char* lds) {
    const int skip = (l == DEPTH - 1);
    TileSched S; S.nM = skip ? 64 : HR / 256; S.nN = PG_W / 256; S.G = gridDim.x; S.c = opq_bid(); S.skipctx = skip;
    S.A = (const char*)p.hx; S.B = (const char*)(p.winG + (size_t)l * PG_W * DM); S.atile = (size_t)256 * DM * 2; S.btile = (size_t)256 * DM * 2; S.acol_bytes = 0;
    EpiBf16<1> E; E.O = p.pa; E.ldc = PG_W;
    g8::gemm_phase(lds, DM, DM, DM, S, E);
}

struct EpiMerge {
    static constexpr bool PERM = false; static constexpr int NSEG = 3;
    const bf16_t* pg; bf16_t* Y;
    DEVI void mid(int sg, f32x4 (&acc)[2][2][4][2], const g8::Unit& u, int wr, int wc, int fr, int fq) const {
        const int row0 = u.pm * 256 + wr * 64 + fr, col0 = u.pn * 256 + wc * 32 + 4 * fq;
        const bf16_t* gbase = pg + (size_t)row0 * PG_W + col0 + sg * 1024;
#pragma unroll
        for (int ai = 0; ai < 2; ++ai)
#pragma unroll
            for (int m = 0; m < 4; ++m) { const bf16_t* gp = gbase + (size_t)(ai * 128 + m * 16) * PG_W;
#pragma unroll
                for (int bj = 0; bj < 2; ++bj)
#pragma unroll
                    for (int n = 0; n < 2; ++n) { const int co = bj * 128 + n * 16;
                        const u32x2 a = *(const u32x2*)(gp + co), b = *(const u32x2*)(gp + 1024 + co);
                        const float a0 = __uint_as_float(a.x << 16), a1 = __uint_as_float(a.x & 0xffff0000u), a2 = __uint_as_float(a.y << 16), a3 = __uint_as_float(a.y & 0xffff0000u);
                        const float b0 = __uint_as_float(b.x << 16), b1 = __uint_as_float(b.x & 0xffff0000u), b2 = __uint_as_float(b.y << 16), b3 = __uint_as_float(b.y & 0xffff0000u);
                        f32x4& v = acc[ai][bj][m][n];
                        v[0] *= a0 * fast_rcp(fmaxf(b0, 1e-30f)); v[1] *= a1 * fast_rcp(fmaxf(b1, 1e-30f)); v[2] *= a2 * fast_rcp(fmaxf(b2, 1e-30f)); v[3] *= a3 * fast_rcp(fmaxf(b3, 1e-30f)); }
                asm volatile("" : "+v"(acc[ai][0][m][0]), "+v"(acc[ai][0][m][1]), "+v"(acc[ai][1][m][0]), "+v"(acc[ai][1][m][1]) :: "memory"); }
    }
    DEVI void operator()(f32x4 (&acc)[2][2][4][2], const g8::Unit& u, int wr, int wc, int fr, int fq) const {
        const int row0 = u.pm * 256 + wr * 64 + fr, col0 = u.pn * 256 + wc * 32 + 4 * fq;
#pragma unroll
        for (int ai = 0; ai < 2; ++ai)
#pragma unroll
            for (int m = 0; m < 4; ++m) { const bf16_t* gp = pg + (size_t)(row0 + ai * 128 + m * 16) * PG_W + col0 + 2048;
#pragma unroll
                for (int bj = 0; bj < 2; ++bj)
#pragma unroll
                    for (int n = 0; n < 2; ++n) { const int co = bj * 128 + n * 16;
                        const u32x2 a = *(const u32x2*)(gp + co);
                        const float a0 = __uint_as_float(a.x << 16), a1 = __uint_as_float(a.x & 0xffff0000u), a2 = __uint_as_float(a.y << 16), a3 = __uint_as_float(a.y & 0xffff0000u);
                        const f32x4 v = acc[ai][bj][m][n];
                        u32x2 w; w.x = cvt_pk_bf16(v[0] * a0, v[1] * a1); w.y = cvt_pk_bf16(v[2] * a2, v[3] * a3);
                        *(u32x2*)(Y + (size_t)(row0 + ai * 128 + m * 16) * DM + col0 + co) = w; }
                asm volatile("" ::: "memory"); }
    }
};
DEVI void phase_merge(const Params& p, int l, LAS unsigned char* lds) {
    const int skip = (l == DEPTH - 1);
    TileSched S; S.nM = skip ? 64 : HR / 256; S.nN = DM / 256; S.G = gridDim.x; S.c = opq_bid(); S.skipctx = skip;
    S.A = (const char*)p.ocat; S.B = (const char*)(p.wcat + (size_t)l * DM * OCW); S.atile = (size_t)256 * OCW * 2; S.btile = (size_t)256 * OCW * 2; S.acol_bytes = 0;
    EpiMerge E; E.pg = p.pa; E.Y = p.y;
    g8::gemm_phase(lds, OCW, OCW, OCW, S, E);
}

struct EpiOut {
    static constexpr bool PERM = false, HAS_MID = false; static constexpr int NSEG = 1;
    const float* x0; const float* c0; float* xo_; float* xc_; const float* modv; int l, hb;
    DEVI void operator()(const f32x4 (&acc)[2][2][4][2], const g8::Unit& u, int wr, int wc, int fr, int fq) const {
        const int row0 = u.pm * 256 + wr * 64 + fr, col0 = u.pn * 256 + wc * 32 + 4 * fq;
#pragma unroll
        for (int ai = 0; ai < 2; ++ai)
#pragma unroll
            for (int m = 0; m < 4; ++m) { const int r = hb * HR + row0 + ai * 128 + m * 16;
                const int b = r / RB, pos = r - b * RB; const bool lat = pos < SEQ;
                const size_t xoff = lat ? ((size_t)b * SEQ + pos) * DM : ((size_t)b * CTX + (pos - SEQ)) * DM;
                float* xo = (lat ? xo_ : xc_) + xoff; const float* xi = (l == 0) ? (lat ? x0 : c0) + xoff : (const float*)xo;
                const float* g1 = modv + ((size_t)l * 5 + (lat ? b : 4)) * 6144 + 2048;
#pragma unroll
                for (int bj = 0; bj < 2; ++bj)
#pragma unroll
                    for (int n = 0; n < 2; ++n) { const int c = col0 + bj * 128 + n * 16;
                        const f32x4 xv = *(const f32x4*)(xi + c), gv = *(const f32x4*)(g1 + c);
                        *(f32x4*)(xo + c) = xv + gv * acc[ai][bj][m][n]; } }
    }
};
DEVI void phase_outproj(const Params& p, int l, int hb, LAS unsigned char* lds) {
    const int skip = (l == DEPTH - 1);
    TileSched S; S.nM = skip ? 64 : HR / 256; S.nN = DM / 256; S.G = gridDim.x; S.c = opq_bid(); S.skipctx = skip;
    S.A = (const char*)p.y; S.B = (const char*)(p.wout + (size_t)l * DM * DM); S.atile = (size_t)256 * DM * 2; S.btile = (size_t)256 * DM * 2; S.acol_bytes = 0;
    EpiOut E; E.x0 = p.in[I_X]; E.c0 = p.in[I_CTX]; E.xo_ = p.out; E.xc_ = p.xc; E.modv = p.modv; E.l = l; E.hb = hb;
    g8::gemm_phase(lds, DM, DM, DM, S, E);
}

DEVI void phase_qkv(const Params& p, int l, LAS unsigned char* lds) {
    const int tid = opq_tid(), lane = tid & 63, wv = tid >> 6, h = lane >> 3, sub = lane & 7;
    LAS bf16_t* vt = (LAS bf16_t*)lds;
    const float* gq = p.in[I_GQ] + l * 96; const float* gk = p.in[I_GK] + l * 96;
    float gqn[8], gkn[8], gqr[4], gkr[4];
#pragma unroll
    for (int e = 0; e < 8; ++e) { gqn[e] = gq[sub * 8 + e]; gkn[e] = gk[sub * 8 + e]; }
#pragma unroll
    for (int e = 0; e < 4; ++e) { gqr[e] = gq[64 + sub * 4 + e]; gkr[e] = gk[64 + sub * 4 + e]; }
    const float qscale = 0.10206207261596577f * 1.4426950408889634f;
    const bool need_ctx_q = (l < DEPTH - 1);
    const bool upper = (sub & 4) != 0;
    struct QkIn { u32x2 dqw; unsigned dkw; u32x2 krw; u32x4 qnw; u32x2 qrw; u32x4 knw, vw; f32x4 cs4, sn4; };
    auto load_rows = [&](int u, QkIn (&r)[2]) {
        const int bl = u / (NCH * 4), tile = (u >> 2) % NCH, qtr = u & 3;
#pragma unroll
        for (int it = 0; it < 2; ++it) { const int pos = tile * 64 + qtr * 16 + wv * 2 + it, rl = bl * RB + pos;
            const bf16_t* prow = p.pa + (size_t)rl * PA_W; const bf16_t* urow = p.up + (size_t)rl * UPW;
            r[it].dqw = *(const u32x2*)(prow + C_DQ + lane * 4); r[it].dkw = *(const unsigned*)(prow + C_DKV + lane * 2); r[it].krw = *(const u32x2*)(prow + C_KR + sub * 4);
            r[it].qnw = *(const u32x4*)(urow + h * 96 + sub * 8); r[it].qrw = *(const u32x2*)(urow + h * 96 + 64 + sub * 4);
            r[it].knw = *(const u32x4*)(urow + 768 + h * 128 + sub * 8); r[it].vw = *(const u32x4*)(urow + 768 + h * 128 + 64 + sub * 8);
            r[it].cs4 = (f32x4){1.f, 1.f, 1.f, 1.f}; r[it].sn4 = (f32x4){0.f, 0.f, 0.f, 0.f};
            if (pos < SEQ) { const float* rt = p.rope + (size_t)pos * 32 + (sub & 3) * 4; r[it].cs4 = *(const f32x4*)rt; r[it].sn4 = *(const f32x4*)(rt + 16); } } };
    QkIn cur[2], nxt[2];
    const int nunit = 2 * NCH * 4, G = gridDim.x;
    if ((int)opq_bid() < nunit) load_rows(opq_bid(), cur);
    for (int u = opq_bid(); u < nunit; u += G) {
        const int bl = u / (NCH * 4), tile = (u >> 2) % NCH, qtr = u & 3;
        const bool more = u + G < nunit; if (more) load_rows(u + G, nxt);
#pragma unroll
        for (int it = 0; it < 2; ++it) {
            const int r16 = wv * 2 + it, rr = qtr * 16 + r16, pos = tile * 64 + rr;
            const bool lat = pos < SEQ;
            const u32x2 dqw = cur[it].dqw; const unsigned dkw = cur[it].dkw; const u32x2 krw = cur[it].krw; const u32x4 qnw = cur[it].qnw; const u32x2 qrw = cur[it].qrw;
            const u32x4 knw = cur[it].knw, vw = cur[it].vw; const f32x4 cs4 = cur[it].cs4, sn4 = cur[it].sn4;
            float sq, skv;
            { const float a0 = __uint_as_float(dqw.x << 16), a1 = __uint_as_float(dqw.x & 0xffff0000u), a2 = __uint_as_float(dqw.y << 16), a3 = __uint_as_float(dqw.y & 0xffff0000u);
              sq = a0 * a0 + a1 * a1 + a2 * a2 + a3 * a3;
              const float b0 = __uint_as_float(dkw << 16), b1 = __uint_as_float(dkw & 0xffff0000u); skv = b0 * b0 + b1 * b1; }
            sq = wave_sum(sq); skv = wave_sum(skv);
            const float rq = rsqrtf(sq * (1.0f / 256.0f) + EPSF), rkv = rsqrtf(skv * (1.0f / 128.0f) + EPSF);
            float qn[8], qr[4], kn[8], kr[4];
#pragma unroll
            for (int e = 0; e < 8; ++e) { const unsigned a = qnw[e >> 1], b = knw[e >> 1];
                qn[e] = ((e & 1) ? __uint_as_float(a & 0xffff0000u) : __uint_as_float(a << 16)) * rq;
                kn[e] = ((e & 1) ? __uint_as_float(b & 0xffff0000u) : __uint_as_float(b << 16)) * rkv; }
#pragma unroll
            for (int e = 0; e < 4; ++e) { const unsigned a = (e < 2) ? qrw.x : qrw.y, b = (e < 2) ? krw.x : krw.y;
                qr[e] = ((e & 1) ? __uint_as_float(a & 0xffff0000u) : __uint_as_float(a << 16)) * rq;
                kr[e] = ((e & 1) ? __uint_as_float(b & 0xffff0000u) : __uint_as_float(b << 16)); }
            float sqq = 0.f, skk = 0.f;
#pragma unroll
            for (int e = 0; e < 8; ++e) { sqq += qn[e] * qn[e]; skk += kn[e] * kn[e]; }
#pragma unroll
            for (int e = 0; e < 4; ++e) { sqq += qr[e] * qr[e]; skk += kr[e] * kr[e]; }
            sqq += __shfl_xor(sqq, 1); sqq += __shfl_xor(sqq, 2); sqq += __shfl_xor(sqq, 4);
            skk += __shfl_xor(skk, 1); skk += __shfl_xor(skk, 2); skk += __shfl_xor(skk, 4);
            const float rnq = rsqrtf(sqq * (1.0f / 96.0f) + EPSF) * qscale, rnk = rsqrtf(skk * (1.0f / 96.0f) + EPSF);
            float qo[12], ko[12];
#pragma unroll
            for (int e = 0; e < 8; ++e) { qo[e] = qn[e] * rnq * gqn[e]; ko[e] = kn[e] * rnk * gkn[e]; }
#pragma unroll
            for (int e = 0; e < 4; ++e) { const float a = qr[e] * rnq * gqr[e], b = kr[e] * rnk * gkr[e];
                const float pa_ = __shfl_xor(a, 4), pb_ = __shfl_xor(b, 4);
                qo[8 + e] = upper ? (a * cs4[e] + pa_ * sn4[e]) : (a * cs4[e] - pa_ * sn4[e]);
                ko[8 + e] = upper ? (b * cs4[e] + pb_ * sn4[e]) : (b * cs4[e] - pb_ * sn4[e]); }
            if (lat || need_ctx_q) {
                bf16_t* qd = lat ? p.q + (((size_t)(bl * 8 + h) * SEQ + pos) * 96) : p.qc + (((size_t)(bl * 8 + h) * CTX + (pos - SEQ)) * 96);
                u32x4 w; w.x = cvt_pk_bf16(qo[0], qo[1]); w.y = cvt_pk_bf16(qo[2], qo[3]); w.z = cvt_pk_bf16(qo[4], qo[5]); w.w = cvt_pk_bf16(qo[6], qo[7]);
                *(u32x4*)(qd + sub * 8) = w;
                u32x2 w2; w2.x = cvt_pk_bf16(qo[8], qo[9]); w2.y = cvt_pk_bf16(qo[10], qo[11]);
                *(u32x2*)(qd + 64 + sub * 4) = w2; }
            { bf16_t* kd = (bf16_t*)(p.kv + ((size_t)(bl * 8 + h) * NCH + tile) * KVT_BYTES + rr * 208);
              u32x4 w; w.x = cvt_pk_bf16(ko[0], ko[1]); w.y = cvt_pk_bf16(ko[2], ko[3]); w.z = cvt_pk_bf16(ko[4], ko[5]); w.w = cvt_pk_bf16(ko[6], ko[7]);
              *(u32x4*)(kd + sub * 8) = w;
              u32x2 w2; w2.x = cvt_pk_bf16(ko[8], ko[9]); w2.y = cvt_pk_bf16(ko[10], ko[11]);
              *(u32x2*)(kd + 64 + sub * 4) = w2; }
#pragma unroll
            for (int e = 0; e < 8; ++e) { const unsigned a = vw[e >> 1]; const float v = ((e & 1) ? __uint_as_float(a & 0xffff0000u) : __uint_as_float(a << 16)) * rkv;
                vt[(h * 64 + sub * 8 + e) * 20 + r16] = f2bf(v); }
        }
        __syncthreads();
        for (int i = tid; i < 8 * 64 * 4; i += 512) { const int hh = i >> 8, rem = i & 255, vc = rem >> 2, pc = rem & 3;
            const u32x2 w = *(const LAS u32x2*)(vt + (hh * 64 + vc) * 20 + pc * 4);
            *(u32x2*)(p.kv + ((size_t)(bl * 8 + hh) * NCH + tile) * KVT_BYTES + KT_BYTES + vc * 136 + qtr * 32 + pc * 8) = w; }
        __syncthreads();
        if (more) { cur[0] = nxt[0]; cur[1] = nxt[1]; }
    }
}

DEVI void attn_unit(const Params& p, LAS unsigned char* lds, const bf16_t* Qb, int nq, const unsigned char* kvb, int ntile, bf16_t* orow, float accinit) {
    const int tid = opq_tid(), lane = tid & 63, wv = __builtin_amdgcn_readfirstlane(tid >> 6), l31 = lane & 31, hh = lane >> 5;
    const bool active = wv * 64 < nq;
    bf16x8 qf[2][6];
#pragma unroll
    for (int qt = 0; qt < 2; ++qt)
#pragma unroll
        for (int ks = 0; ks < 6; ++ks) {
            if (active) qf[qt][ks] = *(const bf16x8*)(Qb + (size_t)(wv * 64 + qt * 32 + l31) * 96 + ks * 16 + hh * 8);
            else qf[qt][ks] = (bf16x8){0, 0, 0, 0, 0, 0, 0, 0}; }
    f32x16 O[2][2];
#pragma unroll
    for (int a = 0; a < 2; ++a)
#pragma unroll
        for (int b = 0; b < 2; ++b)
#pragma unroll
            for (int i = 0; i < 16; ++i) O[a][b][i] = 0.f;
    float lsum[2] = {0.f, 0.f};
    constexpr int STG = 2 * KVT_BYTES;
    const int nstage = ntile >> 1;
    auto stage_in = [&](int sidx, int bsel) {
        const unsigned char* g = kvb + (size_t)sidx * STG + lane * 16;
        for (int pc = wv; pc < 43; pc += 8)
            __builtin_amdgcn_global_load_lds((const unsigned*)(g + pc * 1024), (LAS unsigned*)(lds + bsel * STG + pc * 1024), 16, 0, 0);
    };
    stage_in(0, 0);
    __syncthreads();
    if (wv >= 4) __builtin_amdgcn_s_setprio(1);
    for (int sg = 0; sg < nstage; ++sg) {
        if (sg + 1 < nstage) stage_in(sg + 1, (sg + 1) & 1);
        if (active) {
#pragma unroll 1
            for (int kt = 0; kt < 4; ++kt) {
                const LAS unsigned char* kb = lds + (sg & 1) * STG + (kt >> 1) * KVT_BYTES; const LAS unsigned char* vb = kb + KT_BYTES; const int ks2 = kt & 1;
                bf16x8 kf[6];
#pragma unroll
                for (int ks = 0; ks < 6; ++ks) kf[ks] = *(const LAS bf16x8*)(kb + (ks2 * 32 + l31) * 208 + ks * 32 + hh * 16);
                bf16x8 vf[2][2];
#pragma unroll
                for (int vtile = 0; vtile < 2; ++vtile)
#pragma unroll
                    for (int s2 = 0; s2 < 2; ++s2) { const LAS unsigned char* a = vb + (vtile * 32 + l31) * 136 + (ks2 * 32 + s2 * 16 + 4 * hh) * 2;
                        const u32x2 lo = *(const LAS u32x2*)a, hi = *(const LAS u32x2*)(a + 16);
                        u32x4 w; w.x = lo.x; w.y = lo.y; w.z = hi.x; w.w = hi.y; vf[vtile][s2] = __builtin_bit_cast(bf16x8, w); }
                f32x16 S0, S1;
#pragma unroll
                for (int i = 0; i < 16; ++i) { S0[i] = accinit; S1[i] = accinit; }
#pragma unroll
                for (int ks = 0; ks < 6; ++ks) S0 = __builtin_amdgcn_mfma_f32_32x32x16_bf16(kf[ks], qf[0][ks], S0, 0, 0, 0);

#pragma unroll
                for (int ks = 0; ks < 6; ++ks) S1 = __builtin_amdgcn_mfma_f32_32x32x16_bf16(kf[ks], qf[1][ks], S1, 0, 0, 0);
                bf16x8 pb0[2], pb1[2];
                { float ls = 0.f;
#pragma unroll
                  for (int i = 0; i < 16; ++i) { S0[i] = fast_exp2(S0[i]); ls += S0[i]; }
                  lsum[0] += ls;
#pragma unroll
                  for (int s2 = 0; s2 < 2; ++s2) { u32x4 w; w.x = cvt_pk_bf16(S0[8 * s2 + 0], S0[8 * s2 + 1]); w.y = cvt_pk_bf16(S0[8 * s2 + 2], S0[8 * s2 + 3]);
                      w.z = cvt_pk_bf16(S0[8 * s2 + 4], S0[8 * s2 + 5]); w.w = cvt_pk_bf16(S0[8 * s2 + 6], S0[8 * s2 + 7]); pb0[s2] = __builtin_bit_cast(bf16x8, w); } }

#pragma unroll
                for (int s2 = 0; s2 < 2; ++s2)
#pragma unroll
                    for (int vtile = 0; vtile < 2; ++vtile) O[0][vtile] = __builtin_amdgcn_mfma_f32_32x32x16_bf16(vf[vtile][s2], pb0[s2], O[0][vtile], 0, 0, 0);
                { float ls = 0.f;
#pragma unroll
                  for (int i = 0; i < 16; ++i) { S1[i] = fast_exp2(S1[i]); ls += S1[i]; }
                  lsum[1] += ls;
#pragma unroll
                  for (int s2 = 0; s2 < 2; ++s2) { u32x4 w; w.x = cvt_pk_bf16(S1[8 * s2 + 0], S1[8 * s2 + 1]); w.y = cvt_pk_bf16(S1[8 * s2 + 2], S1[8 * s2 + 3]);
                      w.z = cvt_pk_bf16(S1[8 * s2 + 4], S1[8 * s2 + 5]); w.w = cvt_pk_bf16(S1[8 * s2 + 6], S1[8 * s2 + 7]); pb1[s2] = __builtin_bit_cast(bf16x8, w); } }

#pragma unroll
                for (int s2 = 0; s2 < 2; ++s2)
#pragma unroll
                    for (int vtile = 0; vtile < 2; ++vtile) O[1][vtile] = __builtin_amdgcn_mfma_f32_32x32x16_bf16(vf[vtile][s2], pb1[s2], O[1][vtile], 0, 0, 0);
            }
        }
        __syncthreads();
    }
    __builtin_amdgcn_s_setprio(0);
    if (active) {
#pragma unroll
        for (int qt = 0; qt < 2; ++qt) {
            const float tot = lsum[qt] + __shfl_xor(lsum[qt], 32); const float inv = 1.0f / tot;
            bf16_t* orw = orow + (size_t)(wv * 64 + qt * 32 + l31) * OCW;
#pragma unroll
            for (int vtile = 0; vtile < 2; ++vtile)
#pragma unroll
                for (int g4 = 0; g4 < 4; ++g4) { u32x2 w; w.x = cvt_pk_bf16(O[qt][vtile][4 * g4 + 0] * inv, O[qt][vtile][4 * g4 + 1] * inv);
                    w.y = cvt_pk_bf16(O[qt][vtile][4 * g4 + 2] * inv, O[qt][vtile][4 * g4 + 3] * inv);
                    *(u32x2*)(orw + vtile * 32 + 8 * g4 + 4 * hh) = w; }
        }
    }
}

DEVI float attn_offset(const Params& p, int l) {
    const int lane = opq_tid() & 63;
    const float* gq = p.in[I_GQ] + l * 96; const float* gk = p.in[I_GK] + l * 96;
    float a = fmaxf(fabsf(gq[lane]), lane < 32 ? fabsf(gq[64 + lane]) : 0.f), b = fmaxf(fabsf(gk[lane]), lane < 32 ? fabsf(gk[64 + lane]) : 0.f);
    a = wave_max(a); b = wave_max(b);
    return -(9.797958971132712f * 1.4426950408889634f * a * b * 1.001f);
}

constexpr int HGP = 72;
constexpr int ZP = 68;
constexpr int HG_ZT0 = 0, HG_ZT1 = 17408, HG_KEY0 = 34816, HG_KEY1 = 52224, HG_VT = 69632, HG_KRM0 = 78848, HG_KRM1 = 88064, HG_QRM0 = 97280, HG_QRM1 = 106496,
              HG_S2T0 = 115712, HG_S2T1 = 124928, HG_A20 = 134144, HG_A21 = 143360, HG_GT = 152576  , HG_REF = 156672  , HG_BT = 157184  ,
              HG_O = HG_ZT0  ;
DEVI bf16x8 hg_frag_tr(const LAS unsigned char* tile, int k0, int c0, int lane) {
    const unsigned g = lane >> 4, q = (lane & 15) >> 2, pp = lane & 3;
    const unsigned a0 = (unsigned)(size_t)tile + (unsigned)((k0 + 8 * g + q) * (HGP * 2) + (c0 + 4 * pp) * 2), a1 = a0 + 4 * HGP * 2;
    u32x2 r0, r1;
    asm volatile("ds_read_b64_tr_b16 %0, %2\n\tds_read_b64_tr_b16 %1, %3\n\ts_waitcnt lgkmcnt(0)" : "=&v"(r0), "=&v"(r1) : "v"(a0), "v"(a1) : "memory");
    u32x4 w; w.x = r0.x; w.y = r0.y; w.z = r1.x; w.w = r1.y; return __builtin_bit_cast(bf16x8, w);
}

DEVI int hg_pos0(int tc) { return tc < 128 ? tc * 64 : SEQ + (tc - 128) * 64; }
DEVI int hg_chain_pos(int tc, int dir) { return dir ? (NCH - 1 - tc) : (tc < 128 ? tc + 4 : tc - 128); }

struct HgIn { u32x4 q, zf, zb, v, g, sf, sb; };
template <bool PASS3> DEVI void hg_load(const Params& p, int u, HgIn& r) {
    const int tid = opq_tid(), tk = tid >> 3, pc = tid & 7; const int tc = u % NCH, h = (u / NCH) & 7, bl = u / (NCH * 8);
    const bf16_t* prow = p.pa + (size_t)(bl * RB + hg_pos0(tc) + tk) * PA_W + h * 64 + pc * 8;
    r.zf = *(const u32x4*)(prow + C_ZF); r.zb = *(const u32x4*)(prow + C_ZB); r.v = *(const u32x4*)(prow + C_I);
    if (PASS3) { r.q = *(const u32x4*)(prow + C_Q); r.g = *(const u32x4*)(prow + C_G);
        const size_t uf = ((size_t)((bl * 2 + 0) * 8 + h)) * NCH + hg_chain_pos(tc, 0), ub = ((size_t)((bl * 2 + 1) * 8 + h)) * NCH + hg_chain_pos(tc, 1);
        r.sf = *(const u32x4*)(p.st + uf * 4096 + tk * 64 + pc * 8); r.sb = *(const u32x4*)(p.st + ub * 4096 + tk * 64 + pc * 8); }
}
DEVI float bfw(const u32x4& w, int e) { const unsigned x = w[e >> 1]; return (e & 1) ? __uint_as_float(x & 0xffff0000u) : __uint_as_float(x << 16); }

template <bool PASS3> DEVI void hg_prepare(const Params& p, int l, LAS unsigned char* lds, int h, const HgIn& r) {
    const int tid = opq_tid(), tk = tid >> 3, pc = tid & 7;
    LAS float* gt = (LAS float*)(lds + HG_GT); LAS float* refv = (LAS float*)(lds + HG_REF); LAS float* btv = (LAS float*)(lds + HG_BT);
    {
#pragma unroll
        for (int dir = 0; dir < 2; ++dir) {
            LAS float* zt = (LAS float*)(lds + (dir ? HG_ZT1 : HG_ZT0)); LAS float* keyt = (LAS float*)(lds + (dir ? HG_KEY1 : HG_KEY0));
            const float* lbp = p.lbv + ((size_t)l * 2 + dir) * 512 + h * 64 + pc * 8;
            float lf[8], ky[8];
#pragma unroll
            for (int e = 0; e < 8; ++e) { const float z = bfw(dir ? r.zb : r.zf, e); const float lb = lbp[e];
                const float ez = fast_exp2(-1.44269504f * fabsf(z)), opl = 1.0f + ez, rc = fast_rcp(opl);
                const float logsig = -(fmaxf(-z, 0.f) + 0.69314718f * __builtin_amdgcn_logf(opl));
                const float sigp = (z >= 0.f) ? rc : ez * rc;
                lf[e] = (lb > 0.f) ? 0.69314718f * __builtin_amdgcn_logf(lb + (1.0f - lb) * sigp) : logsig;
                ky[e] = (1.0f - lb) * (1.0f - sigp); }
            *(LAS f32x4*)(zt + tk * ZP + pc * 8) = (f32x4){lf[0], lf[1], lf[2], lf[3]}; *(LAS f32x4*)(zt + tk * ZP + pc * 8 + 4) = (f32x4){lf[4], lf[5], lf[6], lf[7]};
            *(LAS f32x4*)(keyt + tk * ZP + pc * 8) = (f32x4){ky[0], ky[1], ky[2], ky[3]}; *(LAS f32x4*)(keyt + tk * ZP + pc * 8 + 4) = (f32x4){ky[4], ky[5], ky[6], ky[7]}; }
        *(LAS u32x4*)(lds + HG_VT + (tk * HGP + pc * 8) * 2) = r.v;
    }
    __syncthreads();
    {
        const int d = tid & 63, jg = tid >> 6; float c0[8], c1[8]; float run = 0.f;
        LAS float* zt0 = (LAS float*)(lds + HG_ZT0); LAS float* zt1 = (LAS float*)(lds + HG_ZT1);
#pragma unroll
        for (int i = 0; i < 8; ++i) { run += zt0[(jg * 8 + i) * ZP + d]; c0[i] = run; }
        gt[jg * 64 + d] = run; run = 0.f;
#pragma unroll
        for (int i = 7; i >= 0; --i) { run += zt1[(jg * 8 + i) * ZP + d]; c1[i] = run; }
        gt[512 + jg * 64 + d] = run;
        __syncthreads();
        float off0 = 0.f, off1 = 0.f;
#pragma unroll
        for (int g2 = 0; g2 < 8; ++g2) { off0 += (g2 < jg) ? gt[g2 * 64 + d] : 0.f; off1 += (g2 > jg) ? gt[512 + g2 * 64 + d] : 0.f; }
#pragma unroll
        for (int i = 0; i < 8; ++i) { zt0[(jg * 8 + i) * ZP + d] = c0[i] + off0; zt1[(jg * 8 + i) * ZP + d] = c1[i] + off1; }
        if (jg == 3) refv[d] = c0[7] + off0;
        if (jg == 7) btv[d] = c0[7] + off0;
        if (jg == 4) refv[64 + d] = c1[0] + off1;
        if (jg == 0) btv[64 + d] = c1[0] + off1;
    }
    __syncthreads();
    {
#pragma unroll
        for (int dir = 0; dir < 2; ++dir) {
            const LAS float* zt = (const LAS float*)(lds + (dir ? HG_ZT1 : HG_ZT0)); const LAS float* keyt = (const LAS float*)(lds + (dir ? HG_KEY1 : HG_KEY0));
            float kt[8], qt[8];
            const f32x4 z0 = *(const LAS f32x4*)(zt + tk * ZP + pc * 8), z1 = *(const LAS f32x4*)(zt + tk * ZP + pc * 8 + 4);
            const f32x4 k0 = *(const LAS f32x4*)(keyt + tk * ZP + pc * 8), k1 = *(const LAS f32x4*)(keyt + tk * ZP + pc * 8 + 4);
            const f32x4 r0 = *(const LAS f32x4*)(refv + dir * 64 + pc * 8), r1 = *(const LAS f32x4*)(refv + dir * 64 + pc * 8 + 4);
#pragma unroll
            for (int e = 0; e < 8; ++e) { const float bc = e < 4 ? z0[e & 3] : z1[e & 3], rf = e < 4 ? r0[e & 3] : r1[e & 3], ke = e < 4 ? k0[e & 3] : k1[e & 3];
                kt[e] = ke * fast_exp2(1.44269504f * fminf(rf - bc, 80.f)); if (PASS3) qt[e] = bfw(r.q, e) * fast_exp2(1.44269504f * fminf(bc - rf, 80.f)); }
            { u32x4 w; w.x = cvt_pk_bf16(kt[0], kt[1]); w.y = cvt_pk_bf16(kt[2], kt[3]); w.z = cvt_pk_bf16(kt[4], kt[5]); w.w = cvt_pk_bf16(kt[6], kt[7]);
              *(LAS u32x4*)(lds + (dir ? HG_KRM1 : HG_KRM0) + (tk * HGP + pc * 8) * 2) = w; }
            if (PASS3) {
                u32x4 w; w.x = cvt_pk_bf16(qt[0], qt[1]); w.y = cvt_pk_bf16(qt[2], qt[3]); w.z = cvt_pk_bf16(qt[4], qt[5]); w.w = cvt_pk_bf16(qt[6], qt[7]);
                *(LAS u32x4*)(lds + (dir ? HG_QRM1 : HG_QRM0) + (tk * HGP + pc * 8) * 2) = w;
                const float er = fast_exp2(1.44269504f * refv[dir * 64 + tk]); float sv[8];
#pragma unroll
                for (int e = 0; e < 8; ++e) sv[e] = bfw(dir ? r.sb : r.sf, e) * er;
                w.x = cvt_pk_bf16(sv[0], sv[1]); w.y = cvt_pk_bf16(sv[2], sv[3]); w.z = cvt_pk_bf16(sv[4], sv[5]); w.w = cvt_pk_bf16(sv[6], sv[7]);
                *(LAS u32x4*)(lds + (dir ? HG_S2T1 : HG_S2T0) + (tk * HGP + pc * 8) * 2) = w;
            }
        }
    }
    __syncthreads();
}
DEVI bf16x8 hg_frag(const LAS unsigned char* base, int r, int c0) { return *(const LAS bf16x8*)(base + (size_t)(r * HGP + c0) * 2); }

DEVI void hg_pass1_unit(const Params& p, int l, LAS unsigned char* lds, int u, const HgIn& r) {
    const int tc = u % NCH, h = (u / NCH) & 7, bl = u / (NCH * 8);
    hg_prepare<false>(p, l, lds, h, r);
    const int tid = opq_tid(), lane = tid & 63, wv = tid >> 6, l15 = lane & 15, g = lane >> 4;
    const LAS float* refv = (const LAS float*)(lds + HG_REF); const LAS float* btv = (const LAS float*)(lds + HG_BT);
    const int dt = wv >> 1, ct0 = (wv & 1) * 2;
#pragma unroll
    for (int dir = 0; dir < 2; ++dir) {
        const size_t unit = ((size_t)((bl * 2 + dir) * 8 + h)) * NCH + hg_chain_pos(tc, dir);
        bf16_t* so = p.st + unit * 4096;
        const LAS unsigned char* krm = lds + (dir ? HG_KRM1 : HG_KRM0);
        bf16x8 af[2];
#pragma unroll
        for (int ks = 0; ks < 2; ++ks) af[ks] = hg_frag_tr(krm, 32 * ks, 16 * dt, lane);
#pragma unroll
        for (int ci = 0; ci < 2; ++ci) { const int ct = ct0 + ci; f32x4 acc = {0.f, 0.f, 0.f, 0.f};
#pragma unroll
            for (int ks = 0; ks < 2; ++ks) acc = __builtin_amdgcn_mfma_f32_16x16x32_bf16(af[ks], hg_frag_tr(lds + HG_VT, 32 * ks, 16 * ct, lane), acc, 0, 0, 0);
#pragma unroll
            for (int rr = 0; rr < 4; ++rr) { const int d = 16 * dt + 4 * g + rr; so[d * 64 + 16 * ct + l15] = f2bf(acc[rr] * fast_exp2(1.44269504f * (btv[dir * 64 + d] - refv[dir * 64 + d]))); } }
        if (tid < 64) p.stb[unit * 64 + tid] = btv[dir * 64 + tid];
    }
    __syncthreads();
}

DEVI void hg_pass3_unit(const Params& p, int l, LAS unsigned char* lds, int u, const HgIn& r) {
    const int tc = u % NCH, h = (u / NCH) & 7, bl = u / (NCH * 8);
    const int tid = opq_tid(), lane = tid & 63, wv = tid >> 6, l15 = lane & 15, g = lane >> 4;
    hg_prepare<true>(p, l, lds, h, r);
    { const int tt = wv >> 1, st0 = (wv & 1) * 2;
#pragma unroll
      for (int dir = 0; dir < 2; ++dir) {
          const LAS unsigned char* qrm = lds + (dir ? HG_QRM1 : HG_QRM0); const LAS unsigned char* krm = lds + (dir ? HG_KRM1 : HG_KRM0); LAS bf16_t* a2 = (LAS bf16_t*)(lds + (dir ? HG_A21 : HG_A20));
          bf16x8 bq[2];
#pragma unroll
          for (int ks = 0; ks < 2; ++ks) bq[ks] = hg_frag(qrm, 16 * tt + l15, 32 * ks + 8 * g);
#pragma unroll
          for (int si = 0; si < 2; ++si) { const int st = st0 + si; f32x4 acc = {0.f, 0.f, 0.f, 0.f};
#pragma unroll
              for (int ks = 0; ks < 2; ++ks) acc = __builtin_amdgcn_mfma_f32_16x16x32_bf16(hg_frag(krm, 16 * st + l15, 32 * ks + 8 * g), bq[ks], acc, 0, 0, 0);
              const int t = 16 * tt + l15, s0 = 16 * st + 4 * g; float v[4];
#pragma unroll
              for (int e = 0; e < 4; ++e) v[e] = (dir == 0 ? (s0 + e <= t) : (s0 + e >= t)) ? acc[e] : 0.f;
              u32x2 w; w.x = cvt_pk_bf16(v[0], v[1]); w.y = cvt_pk_bf16(v[2], v[3]);
              *(LAS u32x2*)(a2 + t * HGP + s0) = w; } } }
    __syncthreads();
    { const int tt = wv >> 1, ct0 = (wv & 1) * 2; LAS float* olds = (LAS float*)(lds + HG_O);
      f32x4 acc[2] = {{0.f, 0.f, 0.f, 0.f}, {0.f, 0.f, 0.f, 0.f}};
#pragma unroll
      for (int dir = 0; dir < 2; ++dir) {
          const LAS unsigned char* qrm = lds + (dir ? HG_QRM1 : HG_QRM0); const LAS unsigned char* a2 = lds + (dir ? HG_A21 : HG_A20); const LAS unsigned char* s2t = lds + (dir ? HG_S2T1 : HG_S2T0);
          bf16x8 aa[2], aq[2];
#pragma unroll
          for (int ks = 0; ks < 2; ++ks) { aa[ks] = hg_frag(a2, 16 * tt + l15, 32 * ks + 8 * g); aq[ks] = hg_frag(qrm, 16 * tt + l15, 32 * ks + 8 * g); }
#pragma unroll
          for (int ci = 0; ci < 2; ++ci) { const int ct = ct0 + ci;
#pragma unroll
              for (int ks = 0; ks < 2; ++ks) acc[ci] = __builtin_amdgcn_mfma_f32_16x16x32_bf16(aa[ks], hg_frag_tr(lds + HG_VT, 32 * ks, 16 * ct, lane), acc[ci], 0, 0, 0);
#pragma unroll
              for (int ks = 0; ks < 2; ++ks) acc[ci] = __builtin_amdgcn_mfma_f32_16x16x32_bf16(aq[ks], hg_frag_tr(s2t, 32 * ks, 16 * ct, lane), acc[ci], 0, 0, 0); } }
#pragma unroll
      for (int ci = 0; ci < 2; ++ci)
#pragma unroll
          for (int rr = 0; rr < 4; ++rr) olds[(16 * tt + 4 * g + rr) * 65 + 16 * (ct0 + ci) + l15] = acc[ci][rr]; }
    __syncthreads();
    { const int tok = tid >> 3, pc = tid & 7; const int row = bl * RB + hg_pos0(tc) + tok; const LAS float* olds = (const LAS float*)(lds + HG_O);
      float o[8]; float ss = 0.f;
#pragma unroll
      for (int e = 0; e < 8; ++e) { o[e] = olds[tok * 65 + pc * 8 + e]; ss += o[e] * o[e]; }
      ss += __shfl_xor(ss, 1); ss += __shfl_xor(ss, 2); ss += __shfl_xor(ss, 4);
      const float rstd = rsqrtf(ss * (1.0f / 64.0f) + EPSF);
      const float* gn = p.in[I_HGNORM] + l * 64 + pc * 8;
      float rr[8];
#pragma unroll
      for (int e = 0; e < 8; ++e) rr[e] = o[e] * rstd * gn[e] * sigmoidf_(bfw(r.g, e));
      u32x4 w; w.x = cvt_pk_bf16(rr[0], rr[1]); w.y = cvt_pk_bf16(rr[2], rr[3]); w.z = cvt_pk_bf16(rr[4], rr[5]); w.w = cvt_pk_bf16(rr[6], rr[7]);
      *(u32x4*)(p.ocat + (size_t)row * OCW + h * 64 + pc * 8) = w; }
    __syncthreads();
}

DEVI void hg_prefix(const Params& p, bool dry = false) {
    const int total = 2 * 2 * 8 * 4096;
    for (int gidx = opq_bid() * 512 + opq_tid(); gidx < total; gidx += gridDim.x * 512) {
        const int chain = gidx >> 12, e = gidx & 4095, d = e >> 6;
        bf16_t* s = p.st + (size_t)chain * NCH * 4096 + e; const float* bt = p.stb + (size_t)chain * NCH * 64 + d;
        float S = 0.f;
#pragma unroll 1
        for (int q0 = 0; q0 < NCH; q0 += 12) { float loc[12], b[12];
#pragma unroll
            for (int i = 0; i < 12; ++i) { loc[i] = bf2f(s[(size_t)(q0 + i) * 4096]); b[i] = bt[(q0 + i) * 64]; }
#pragma unroll
            for (int i = 0; i < 12; ++i) { if (!dry) s[(size_t)(q0 + i) * 4096] = f2bf(S); S = S * fast_exp2(1.44269504f * b[i]) + loc[i]; } }
        if (dry && S == 123.456f) s[0] = 0;
    }
}

constexpr int LR_UB = 0, LR_UP = 520, LR_AF = 16640, LR_IF = LR_AF + 32768, LR_AB = LR_IF + 32768, LR_IB = LR_AB + 32768;
constexpr int NT16 = RB / 16;

DEVI int lr_pos0(int tt) { return tt * 16; }
DEVI int lr_chain_pos(int tt, int dir) { return dir ? (NT16 - 1 - tt) : (tt < 512 ? tt + 16 : tt - 512); }

struct LruW { bf16x8 b[2][4][2]; float ba[4], bx[4], la[4]; };
DEVI void lru_load_w(const Params& p, int l, int dir, int n, int l15, int g, LruW& w) {
#pragma unroll
    for (int which = 0; which < 2; ++which)
#pragma unroll
        for (int ct = 0; ct < 4; ++ct)
#pragma unroll
            for (int ks = 0; ks < 2; ++ks)
                w.b[which][ct][ks] = *(const bf16x8*)(p.wlru + ((((size_t)(l * 2 + dir) * 8 + n) * 2 + which) * 64 + 16 * ct + l15) * 64 + 32 * ks + 8 * g);
#pragma unroll
    for (int ct = 0; ct < 4; ++ct) { const int c = (l * 2 + dir) * 512 + n * 64 + 16 * ct + l15;
        w.ba[ct] = p.in[I_LBA][c]; w.bx[ct] = p.in[I_LBX][c]; w.la[ct] = p.lrula[c]; }
}
struct LrIn { bf16_t x[19]; bf16_t y[16]; float h_in; };
template <int MODE> DEVI void lru_load(const Params& p, int u, LrIn& r) {
    const int bl = u / NT16, tt = u % NT16, c = opq_tid();
    const int pos0 = tt * 16, seg0 = tt < 512 ? 0 : SEQ, seg1 = tt < 512 ? SEQ : RB;
    const bf16_t* xx = p.pa + (size_t)bl * RB * PA_W + C_LX + c;
#pragma unroll
    for (int i = 0; i < 19; ++i) { const int pos = pos0 - 2 + i; r.x[i] = (pos >= seg0 && pos < seg1) ? xx[(size_t)pos * PA_W] : (bf16_t)0; }
    if (MODE == 2) { const bf16_t* yy = p.pa + ((size_t)bl * RB + pos0) * PA_W + C_LY + c;
#pragma unroll
        for (int t = 0; t < 16; ++t) r.y[t] = yy[(size_t)t * PA_W]; }
    if (MODE == 1) r.h_in = p.lin[((size_t)(bl * 2 + 0) * NT16 + lr_chain_pos(tt, 0)) * 512 + c];
    if (MODE == 2) r.h_in = p.lin[((size_t)(bl * 2 + 1) * NT16 + lr_chain_pos(tt, 1)) * 512 + c];
}
#define LR_WAVE_SYNC() do { asm volatile("s_waitcnt lgkmcnt(0)" ::: "memory"); __builtin_amdgcn_wave_barrier(); } while (0)
DEVI void lru_tile_gates(const Params& p, int l, LAS unsigned char* lds, const LrIn& in, const LruW& w) {
    const int tid = opq_tid(), lane = tid & 63, n = tid >> 6, l15 = lane & 15, g = lane >> 4;
    LAS bf16_t* ub = (LAS bf16_t*)(lds + LR_UB);
    {
        const int c = tid;
        const float* cw = p.in[I_CONVW] + (size_t)l * 4 * 512; const float w0 = cw[c], w1 = cw[512 + c], w2 = cw[1024 + c], w3 = cw[1536 + c], cb = p.in[I_CONVB][l * 512 + c];
        float x[19];
#pragma unroll
        for (int i = 0; i < 19; ++i) x[i] = bf2f(in.x[i]);
#pragma unroll
        for (int t = 0; t < 16; ++t) ub[t * LR_UP + c] = f2bf(cb + w0 * x[t] + w1 * x[t + 1] + w2 * x[t + 2] + w3 * x[t + 3]);
    }
    LR_WAVE_SYNC();
    bf16x8 af[2];
#pragma unroll
    for (int ks = 0; ks < 2; ++ks) af[ks] = *(const LAS bf16x8*)(ub + l15 * LR_UP + n * 64 + 32 * ks + 8 * g);
    LAS float* aL = (LAS float*)(lds + LR_AF); LAS float* iL = (LAS float*)(lds + LR_IF);
#pragma unroll
    for (int ct = 0; ct < 4; ++ct) {
        f32x4 ra = {0.f, 0.f, 0.f, 0.f}, xa = {0.f, 0.f, 0.f, 0.f};
#pragma unroll
        for (int ks = 0; ks < 2; ++ks) { ra = __builtin_amdgcn_mfma_f32_16x16x32_bf16(af[ks], w.b[0][ct][ks], ra, 0, 0, 0); xa = __builtin_amdgcn_mfma_f32_16x16x32_bf16(af[ks], w.b[1][ct][ks], xa, 0, 0, 0); }
        const int c = n * 64 + 16 * ct + l15;
#pragma unroll
        for (int r = 0; r < 4; ++r) { const int t = 4 * g + r;
            const float rg = sigmoidf_(ra[r] + w.ba[ct]), ig = sigmoidf_(xa[r] + w.bx[ct]);
            const float a = fast_exp2(rg * w.la[ct]); const float uu = bf2f(ub[t * LR_UP + c]);
            aL[t * 512 + c] = a; iL[t * 512 + c] = __builtin_amdgcn_sqrtf(fmaxf(1.0f - a * a, 0.f)) * ig * uu; }
    }
    LR_WAVE_SYNC();
}
template <int MODE> DEVI void lru_sweep(const Params& p, int l, LAS unsigned char* lds, int dir, int u0, int uend, int ubase, bool skipc) {
    const int tid = opq_tid(), lane = tid & 63, n = tid >> 6, l15 = lane & 15, g = lane >> 4, G = gridDim.x;
    if (u0 >= uend) return;
    LruW w; lru_load_w(p, l, dir, n, l15, g, w);
    const LAS float* aL = (const LAS float*)(lds + LR_AF); const LAS float* iL = (const LAS float*)(lds + LR_IF);
    LrIn cur, nxt; lru_load<MODE>(p, u0 - ubase, cur);
    for (int u = u0; u < uend; u += G) {
        const bool more = u + G < uend; if (more) lru_load<MODE>(p, u + G - ubase, nxt);
        const int uu = u - ubase, bl = uu / NT16, tt = uu % NT16;
        if (!(skipc && tt >= 512)) {
            lru_tile_gates(p, l, lds, cur, w);
            if (MODE == 0) { float A = 1.f, H = 0.f;
#pragma unroll
                for (int t = 0; t < 16; ++t) { const float a = aL[t * 512 + tid], b = iL[t * 512 + tid]; if (dir == 0) { H = a * H + b; A *= a; } else { H += b * A; A *= a; } }
                *((f32x2_t*)p.lsum + ((size_t)(bl * 2 + dir) * NT16 + lr_chain_pos(tt, dir)) * 512 + tid) = (f32x2_t){A, H};
            } else { bf16_t* ocol = p.ocat + ((size_t)bl * RB + lr_pos0(tt)) * OCW + 1024 + tid; float h = cur.h_in;
                if (MODE == 1) {
#pragma unroll
                    for (int t = 0; t < 16; ++t) { h = aL[t * 512 + tid] * h + iL[t * 512 + tid]; ocol[(size_t)t * OCW] = f2bf(h); }
                } else {
                    float hfv[16];
#pragma unroll
                    for (int t = 0; t < 16; ++t) hfv[t] = bf2f(ocol[(size_t)t * OCW]);
#pragma unroll
                    for (int t = 15; t >= 0; --t) { h = aL[t * 512 + tid] * h + iL[t * 512 + tid];
                        const float y = bf2f(cur.y[t]); const float x3 = 0.7978845608028654f * (y + 0.044715f * y * y * y);
                        const float th = 1.0f - 2.0f * fast_rcp(1.0f + fast_exp2(2.88539008f * x3));
                        ocol[(size_t)t * OCW] = f2bf((hfv[t] + h) * 0.5f * y * (1.0f + th)); } }
            }
            LR_WAVE_SYNC();
        }
        if (more) cur = nxt;
    }
}
DEVI void lru_prefix(const Params& p, bool dry = false) {
    const int lane = opq_tid() & 63, wv = opq_tid() >> 6;
    for (int chain = opq_bid() * 8 + wv; chain < 2 * 2 * 512; chain += gridDim.x * 8) {
        const int c = chain & 511, bd = chain >> 9;
        const f32x2_t* src = (const f32x2_t*)p.lsum + (size_t)bd * NT16 * 512 + c; float* dst = p.lin + (size_t)bd * NT16 * 512 + c;
        f32x2_t v[9]; float A = 1.f, H = 0.f;
#pragma unroll
        for (int i = 0; i < 9; ++i) { const int q = lane * 9 + i; v[i] = (q < NT16) ? src[(size_t)q * 512] : (f32x2_t){1.f, 0.f}; H = v[i].x * H + v[i].y; A *= v[i].x; }
#pragma unroll
        for (int o = 1; o < 64; o <<= 1) { const float Ap = __shfl_up(A, o), Hp = __shfl_up(H, o); if (lane >= o) { H = A * Hp + H; A = A * Ap; } }
        float h = __shfl_up(H, 1); if (lane == 0) h = 0.f;
#pragma unroll
        for (int i = 0; i < 9; ++i) { const int q = lane * 9 + i; if (q < NT16 && !dry) dst[(size_t)q * 512] = h; h = v[i].x * h + v[i].y; }
        if (dry && h == 123.456f) dst[0] = 0.f;
    }
}
DEVI void phase_attn_scan1(const Params& p, int l, LAS unsigned char* lds, int parts = 7) {
    const int nA = 2 * 8 * 16 + (l == 0 ? 16 : 0), nH = 2 * 8 * NCH, nL = 2 * NT16, G = gridDim.x;
    const float accinit = attn_offset(p, l);
    int u = opq_bid();
    for (; u < 256; u += G) { const int bl = u >> 7, h = (u >> 4) & 7, qb = u & 15; if (!(parts & 1)) continue;
        attn_unit(p, lds, p.q + ((size_t)(bl * 8 + h) * SEQ + qb * 512) * 96, 512, p.kv + (size_t)(bl * 8 + h) * NCH * KVT_BYTES, NCH,
                  p.ocat + (size_t)(bl * RB + qb * 512) * OCW + 512 + h * 64, accinit); }
    for (; u < nA; u += G) { const int uu = u - 256, bl = uu >> 3, h = uu & 7; if (!(parts & 1)) continue;
        attn_unit(p, lds, p.qc + ((size_t)(bl * 8 + h) * CTX) * 96, 256, p.kv + ((size_t)(bl * 8 + h) * NCH + 128) * KVT_BYTES, 4,
                  p.ocat + (size_t)(bl * RB + SEQ) * OCW + 512 + h * 64, accinit); }
    if (parts & 2) { HgIn cur, nxt; if (u < nA + nH) hg_load<false>(p, u - nA, cur);
        for (; u < nA + nH; u += G) { const bool more = u + G < nA + nH; if (more) hg_load<false>(p, u + G - nA, nxt); hg_pass1_unit(p, l, lds, u - nA, cur); if (more) cur = nxt; } }
    else { for (; u < nA + nH; u += G) {} }
    if (parts & 4) { lru_sweep<0>(p, l, lds, 0, u, nA + nH + nL, nA + nH, false); lru_sweep<0>(p, l, lds, 1, u, nA + nH + nL, nA + nH, false); }
}
DEVI void phase_prefix(const Params& p, LAS unsigned char* lds, bool dry = false) { (void)lds; hg_prefix(p, dry); lru_prefix(p, dry); }
DEVI void phase_scan3(const Params& p, int l, LAS unsigned char* lds, int parts = 3) {
    const int nH = 2 * 8 * NCH, nL = 2 * NT16, G = gridDim.x; const bool skipc = (l == DEPTH - 1);
    int u = opq_bid();
    if (parts & 1) { HgIn cur, nxt; if (u < nH) hg_load<true>(p, u, cur);
        for (; u < nH; u += G) { const bool more = u + G < nH; if (more) hg_load<true>(p, u + G, nxt);
            if (!(skipc && (u % NCH) >= 128)) hg_pass3_unit(p, l, lds, u, cur);
            if (more) cur = nxt; } }
    else { for (; u < nH; u += G) {} }
    if (parts & 2) { lru_sweep<1>(p, l, lds, 0, u, nH + nL, nH, skipc); lru_sweep<2>(p, l, lds, 1, u, nH + nL, nH, skipc); }
}

constexpr int RP = 2 * TT + 4096;

DEVI void phase_norm2_route(const Params& p, int l, bool dry = false) {
    const int lane = opq_tid() & 63, wv = opq_tid() >> 6; const bool skipc = (l == DEPTH - 1);
    const float* gm = p.in[I_NFFN] + l * DM;
    const float* wrg = p.in[I_WRG] + (size_t)l * DM * 4; const float* wre = p.in[I_WRE] + (size_t)l * DM * 16;
    for (int r = opq_bid() * 8 + wv; r < TT; r += gridDim.x * 8) {
        const int pos = r % RB; if (skipc && pos >= SEQ) continue;
        const float* src = xbuf_row(p, r);
        f32x4 v[4]; float ss = 0.f;
#pragma unroll
        for (int i = 0; i < 4; ++i) { v[i] = *(const f32x4*)(src + i * 256 + lane * 4); ss += v[i][0] * v[i][0] + v[i][1] * v[i][1] + v[i][2] * v[i][2] + v[i][3] * v[i][3]; }
        ss = wave_sum(ss);
        const float rstd = rsqrtf(ss * (1.0f / DM) + EPSF);
        const float* mv = p.modv + ((size_t)l * 5 + mod_row(r)) * 6144;
        f32x4 lg = {0.f, 0.f, 0.f, 0.f}, le0 = lg, le1 = lg, le2 = lg, le3 = lg;
#pragma unroll
        for (int i = 0; i < 4; ++i) { const int c = i * 256 + lane * 4;
            const f32x4 g = *(const f32x4*)(gm + c), sh = *(const f32x4*)(mv + 3072 + c), sc = *(const f32x4*)(mv + 4096 + c);
            f32x4 h;
#pragma unroll
            for (int e = 0; e < 4; ++e) h[e] = v[i][e] * rstd * g[e] * (1.0f + sc[e]) + sh[e];
            u32x2 w; w.x = cvt_pk_bf16(h[0], h[1]); w.y = cvt_pk_bf16(h[2], h[3]);
            *(u32x2*)(p.h2 + (size_t)r * DM + c) = w;
#pragma unroll
            for (int e = 0; e < 4; ++e) { const float* wr_ = wre + (size_t)(c + e) * 16;
                lg += h[e] * *(const f32x4*)(wrg + (size_t)(c + e) * 4);
                le0 += h[e] * *(const f32x4*)(wr_); le1 += h[e] * *(const f32x4*)(wr_ + 4); le2 += h[e] * *(const f32x4*)(wr_ + 8); le3 += h[e] * *(const f32x4*)(wr_ + 12); } }
#pragma unroll
        for (int e = 0; e < 4; ++e) { lg[e] = wave_sum(lg[e]); le0[e] = wave_sum(le0[e]); le1[e] = wave_sum(le1[e]); le2[e] = wave_sum(le2[e]); le3[e] = wave_sum(le3[e]); }
        if (lane == 0 && !dry) {
            const float* brg = p.in[I_BRG] + l * 4; const float* bre = p.in[I_BRE] + l * 16;
            int gs = 0; float best = lg[0] + brg[0];
#pragma unroll
            for (int e = 1; e < 4; ++e) { const float t = lg[e] + brg[e]; if (t > best) { best = t; gs = e; } }
            const float m = fmaxf(fmaxf(lg[0], lg[1]), fmaxf(lg[2], lg[3]));
            const float e0 = __expf(lg[0] - m), e1 = __expf(lg[1] - m), e2 = __expf(lg[2] - m), e3 = __expf(lg[3] - m);
            const float pg = (gs == 0 ? e0 : gs == 1 ? e1 : gs == 2 ? e2 : e3) / (e0 + e1 + e2 + e3);
            const f32x4 lv = (gs == 0) ? le0 : (gs == 1) ? le1 : (gs == 2) ? le2 : le3;
            const f32x4 bv = lv + *(const f32x4*)(bre + gs * 4);
            int i0 = 0; float m0 = bv[0], l0 = lv[0];
#pragma unroll
            for (int e = 1; e < 4; ++e) if (bv[e] > m0) { m0 = bv[e]; i0 = e; l0 = lv[e]; }
            int i1 = -1; float m1 = -3.0e38f, l1 = 0.f;
#pragma unroll
            for (int e = 0; e < 4; ++e) if (e != i0 && bv[e] > m1) { m1 = bv[e]; i1 = e; l1 = lv[e]; }
            const float mm = fmaxf(l0, l1), x0 = __expf(l0 - mm), x1 = __expf(l1 - mm);
            const float w0 = x0 / (x0 + x1) * pg, w1 = x1 / (x0 + x1) * pg;
            const int ea = gs * 4 + i0, eb = gs * 4 + i1;
            const int sa = (int)atomicAdd(&p.ctrl[CTRL_CNT(l) + ea], 1u), sb = (int)atomicAdd(&p.ctrl[CTRL_CNT(l) + eb], 1u);
            p.tok_e[r * 2] = ea; p.tok_e[r * 2 + 1] = eb; p.tok_s[r * 2] = sa; p.tok_s[r * 2 + 1] = sb;
            p.lst[(size_t)ea * TT + sa] = r; p.lst[(size_t)eb * TT + sb] = r; p.tok_w[(size_t)ea * TT + sa] = w0; p.tok_w[(size_t)eb * TT + sb] = w1;
        }
    }
}

DEVI void moe_offsets(const Params& p, int l, LAS int* offs) {
    if (opq_tid() == 0) { int o = 0;
        for (int e = 0; e < NEXP; ++e) { offs[e] = o; const int c = (int)__hip_atomic_load(&p.ctrl[CTRL_CNT(l) + e], __ATOMIC_RELAXED, __HIP_MEMORY_SCOPE_AGENT); offs[32 + e] = c; o += (c + 255) & ~255; }
        offs[NEXP] = o; }
    __syncthreads();
}
DEVI int moe_expert_of(const LAS int* offs, int row) { int e = 0;
#pragma unroll
    for (int q = 1; q < NEXP; ++q) e += (row >= offs[q]) ? 1 : 0;
    return e; }

DEVI void phase_moe_permute(const Params& p, int l, const LAS int* offs) {
    const int lane = opq_tid() & 63, wv = opq_tid() >> 6; const int R = offs[NEXP];
    for (int pr = opq_bid() * 8 + wv; pr < R; pr += gridDim.x * 8) {
        const int e = moe_expert_of(offs, pr), s = pr - offs[e]; const bool valid = s < offs[32 + e];
        u32x4 a = {0u, 0u, 0u, 0u}, b = {0u, 0u, 0u, 0u}; int r = 0; float w = 0.f;
        const int vz = vzero();
        if (valid) { r = p.lst[(size_t)e * TT + s + vz]; w = p.tok_w[(size_t)e * TT + s + vz];
            const u32x4* src = (const u32x4*)(p.h2 + (size_t)r * DM); a = src[lane]; b = src[64 + lane]; }
        u32x4* dst = (u32x4*)(p.h2p + (size_t)pr * DM); dst[lane] = a; dst[64 + lane] = b;
        if (lane == 0) { p.rww[pr] = w; p.rmr[pr] = valid ? mod_row(r) : 0; }
    }
}

template <bool GATH> struct MoeSched { static constexpr bool GATHER = GATH; const int* lst; int cnt[NEXP]; int G, c, nN; int o[NEXP + 1]; const char* A; const char* B; size_t atile, bexp, btile;
    DEVI void load(const LAS int* offs) {
#pragma unroll
        for (int q = 0; q <= NEXP; ++q) o[q] = __builtin_amdgcn_readfirstlane(offs[q]);
#pragma unroll
        for (int q = 0; q < NEXP; ++q) cnt[q] = __builtin_amdgcn_readfirstlane(offs[32 + q]); }
    DEVI int row_of(const g8::Unit& u, int r) const { int base = 0, n = 0;
#pragma unroll
        for (int q = 0; q < NEXP; ++q) { base = (u.tag == q) ? o[q] : base; n = (u.tag == q) ? cnt[q] : n; }
        const int s2 = u.pm * 256 + r - base; return (s2 < n) ? lst[(size_t)u.tag * TT + s2] : 0; }
    DEVI bool next(int i, g8::Unit& u) const { const long L = (long)i * G + c; const int R = o[NEXP]; if (L >= (long)(R / 256) * nN) return false;
        const int ti = (int)(L / nN), pn = (int)(L % nN); int e = 0;
#pragma unroll
        for (int q = 1; q < NEXP; ++q) e += (ti * 256 >= o[q]) ? 1 : 0;
        u.pm = ti; u.pn = pn; u.tag = e; u.a = A + (size_t)ti * atile; u.b = B + (size_t)e * bexp + (size_t)pn * btile; return true; } };
struct EpiSwiglu {
    static constexpr bool PERM = false, HAS_MID = false; static constexpr int NSEG = 1;
    bf16_t* hid;
    DEVI void operator()(const f32x4 (&acc)[2][2][4][2], const g8::Unit& u, int wr, int wc, int fr, int fq) const {
        const int row0 = u.pm * 256 + wr * 64 + fr, col0 = u.pn * 128 + wc * 32 + 4 * fq;
#pragma unroll
        for (int ai = 0; ai < 2; ++ai)
#pragma unroll
            for (int m = 0; m < 4; ++m)
#pragma unroll
                for (int n = 0; n < 2; ++n) { const f32x4 a = acc[ai][0][m][n], b = acc[ai][1][m][n]; float h[4];
#pragma unroll
                    for (int e = 0; e < 4; ++e) h[e] = a[e] * sigmoidf_(a[e]) * b[e];
                    u32x2 w; w.x = cvt_pk_bf16(h[0], h[1]); w.y = cvt_pk_bf16(h[2], h[3]);
                    *(u32x2*)(hid + (size_t)(row0 + ai * 128 + m * 16) * DEXP + col0 + n * 16) = w; }
    }
};
DEVI void phase_moe_up(const Params& p, int l, const LAS int* offs, LAS unsigned char* lds) {
    MoeSched<true> S; S.lst = p.lst; S.G = gridDim.x; S.c = opq_bid(); S.nN = 2; S.load(offs); S.A = (const char*)p.h2; S.B = (const char*)(p.w13 + (size_t)l * NEXP * 512 * DM);
    S.atile = 0; S.bexp = (size_t)512 * DM * 2; S.btile = (size_t)256 * DM * 2;
    EpiSwiglu E; E.hid = p.hid;
    g8::gemm_phase(lds, DM, DM, DM, S, E);
}
struct EpiDown {
    static constexpr bool PERM = true, HAS_MID = false; static constexpr int NSEG = 1;
    bf16_t* yo; const float* tokw; const int* lst; const LAS int* offs; const float* g2base;
    DEVI void operator()(const f32x4 (&acc)[2][2][4][2], const g8::Unit& u, int wr, int wc, int fr, int fq) const {
        const int row0 = u.pm * 256 + wr * 64 + fr, col0 = u.pn * 256 + wc * 32 + 8 * fq;
#pragma unroll
        for (int ai = 0; ai < 2; ++ai)
#pragma unroll
            for (int m = 0; m < 4; ++m) { const int row = row0 + ai * 128 + m * 16; const int e = u.tag, s2 = row - offs[e]; const bool valid = s2 < offs[32 + e];
                const float w = valid ? tokw[(size_t)e * TT + s2] : 0.f; const int mr = valid ? mod_row(lst[(size_t)e * TT + s2]) : 0; const float* g2 = g2base + (size_t)mr * 6144 + col0;
#pragma unroll
                for (int bj = 0; bj < 2; ++bj) { const f32x4 ga = *(const f32x4*)(g2 + bj * 128), gb = *(const f32x4*)(g2 + bj * 128 + 4);
                    const f32x4 v0 = acc[ai][bj][m][0] * ga * w, v1 = acc[ai][bj][m][1] * gb * w;
                    u32x4 o; o.x = cvt_pk_bf16(v0[0], v0[1]); o.y = cvt_pk_bf16(v0[2], v0[3]); o.z = cvt_pk_bf16(v1[0], v1[1]); o.w = cvt_pk_bf16(v1[2], v1[3]);
                    *(u32x4*)(yo + (size_t)row * DM + col0 + bj * 128) = o; } }
    }
};
DEVI void phase_moe_down(const Params& p, int l, const LAS int* offs, LAS unsigned char* lds) {
    MoeSched<false> S; S.lst = p.lst; S.G = gridDim.x; S.c = opq_bid(); S.nN = 4; S.load(offs); S.A = (const char*)p.hid; S.B = (const char*)(p.w2 + (size_t)l * NEXP * DM * DEXP);
    S.atile = (size_t)256 * DEXP * 2; S.bexp = (size_t)DM * DEXP * 2; S.btile = (size_t)256 * DEXP * 2;
    EpiDown E; E.yo = p.yo; E.tokw = p.tok_w; E.lst = p.lst; E.offs = offs; E.g2base = p.modv + (size_t)l * 5 * 6144 + 5120;
    g8::gemm_phase(lds, DEXP, DEXP, DEXP, S, E);
}
DEVI void phase_moe_combine(const Params& p, int l, const LAS int* offs, bool dry = false) {
    const int lane = opq_tid() & 63, wv = opq_tid() >> 6; const bool skipc = (l == DEPTH - 1);
    for (int r = opq_bid() * 8 + wv; r < TT; r += gridDim.x * 8) {
        const int pos = r % RB; if (skipc && pos >= SEQ) continue;
        float* x = xbuf_row(p, r);
        const int vz = vzero();
        const int pr0 = offs[p.tok_e[r * 2 + vz]] + p.tok_s[r * 2 + vz], pr1 = offs[p.tok_e[r * 2 + 1 + vz]] + p.tok_s[r * 2 + 1 + vz];
        const bf16_t* y0 = p.yo + (size_t)pr0 * DM; const bf16_t* y1 = p.yo + (size_t)pr1 * DM;
#pragma unroll
        for (int i = 0; i < 4; ++i) { const int c = i * 256 + lane * 4; f32x4 v = *(const f32x4*)(x + c);
            const u32x2 a = *(const u32x2*)(y0 + c), b = *(const u32x2*)(y1 + c);
            v[0] += __uint_as_float(a.x << 16) + __uint_as_float(b.x << 16); v[1] += __uint_as_float(a.x & 0xffff0000u) + __uint_as_float(b.x & 0xffff0000u);
            v[2] += __uint_as_float(a.y << 16) + __uint_as_float(b.y << 16); v[3] += __uint_as_float(a.y & 0xffff0000u) + __uint_as_float(b.y & 0xffff0000u);
            if (!dry || v[0] == 123.456f) *(f32x4*)(x + c) = v; }
    }
}

#ifndef MK_PHASE_KERNELS
#define MK_PHASE_KERNELS 0
#endif
constexpr int LDS_SCRATCH = 1024;

template <class T> DEVI T* uni_ptr(T* x) { const unsigned long long v = (unsigned long long)x;
    const unsigned lo = __builtin_amdgcn_readfirstlane((unsigned)v), hi = __builtin_amdgcn_readfirstlane((unsigned)(v >> 32));
    return (T*)(((unsigned long long)hi << 32) | lo); }
DEVI Params ldparams(const PL& s) {
    Params q;
#pragma unroll
    for (int i = 0; i < 35; ++i) q.in[i] = uni_ptr(s.in[i]);
#define LDP(f) q.f = uni_ptr(s.f)
    LDP(out); LDP(ctrl); LDP(modv); LDP(lbv); LDP(xc); LDP(rope); LDP(lrula); LDP(winA); LDP(winG); LDP(wup); LDP(wcat); LDP(wout); LDP(w13); LDP(w2); LDP(wlru);
    LDP(hx); LDP(pa); LDP(up); LDP(q); LDP(qc); LDP(kv); LDP(st); LDP(stb); LDP(lsum); LDP(lin); LDP(ocat); LDP(y); LDP(h2); LDP(h2p); LDP(hid); LDP(yo);
    LDP(tok_e); LDP(tok_s); LDP(tok_w); LDP(lst); LDP(rww); LDP(rmr);
#undef LDP
    q.pad_ = 0ull;
    return q;
}
DEVI void grid_sync(const PL& s, LAS unsigned char* smem) {
    XcdBarrier b; b.bar = uni_ptr(s.ctrl); b.x = xb_xcc_id(); b.st = (volatile LAS unsigned*)smem;
    xcd_barrier(b);
}
DEVI void probe_dump(const Params& p, const bf16_t* src, size_t n) {
    const size_t NOUT = (size_t)NB * SEQ * DM;
    for (size_t i = (size_t)opq_bid() * 512 + opq_tid(); i < NOUT; i += (size_t)gridDim.x * 512) { float s = 0.f;
        for (size_t k = i; k < n; k += NOUT) s += (float)src[k];
        p.out[i] = s; }
}
#define PROBE_AT(id, buf, n) if (PROBE_STOP == (id) && l == 0 && hb == 0) { { const Params p = ldparams(pl); probe_dump(p, (const bf16_t*)(buf), (n)); } return; }
#ifndef PROBE_STOP
#define PROBE_STOP 0
#endif
#ifndef DUP_MASK
#define DUP_MASK 0
#endif
#define PHASE_D(bit, call, dupcall) PHASE(call); if ((DUP_MASK >> (bit)) & 1) { PHASE(dupcall); }
#define PHASE(call) do { const Params p = ldparams(pl); call; } while (0); grid_sync(pl, smem); if ((DUP_MASK >> 21) & 1) grid_sync(pl, smem)

#ifndef SELFCHECK
#define SELFCHECK 0
#endif
DEVI void chk_sum(const Params& p, int id, int rep, const void* buf, size_t nbytes) {
    const unsigned* w = (const unsigned*)buf; const size_t n = nbytes / 4; unsigned long long s = 0ull;
    for (size_t i = (size_t)opq_bid() * 512 + opq_tid(); i < n; i += (size_t)gridDim.x * 512) s += (unsigned long long)w[i] * (unsigned long long)((i & 1023) + 1);
    unsigned lo = (unsigned)s, hi = (unsigned)(s >> 32);
    for (int o = 32; o >= 1; o >>= 1) { const unsigned l2 = __shfl_xor(lo, o), h2 = __shfl_xor(hi, o); const unsigned long long t = (((unsigned long long)hi << 32) | lo) + (((unsigned long long)h2 << 32) | l2); lo = (unsigned)t; hi = (unsigned)(t >> 32); }
    if ((opq_tid() & 63) == 0) atomicAdd((unsigned long long*)(p.ctrl + 6144) + (rep * 32 + id), (((unsigned long long)hi << 32) | lo));
}
#define CHK(id, buf, nbytes) do { const Params p = ldparams(pl); chk_sum(p, id, rep, buf, nbytes); } while (0); grid_sync(pl, smem)

__global__ void __launch_bounds__(512, 2) hybrid_flow_backbone_kernel(Params pk) {
    extern __shared__ __attribute__((aligned(16))) unsigned char smem_raw[];
    LAS unsigned char* smem = (LAS unsigned char*)smem_raw;
    LAS unsigned char* lds = smem + LDS_SCRATCH; LAS int* offs = (LAS int*)(smem + 64);
    static_assert(sizeof(Params) % 8 == 0 && sizeof(Params) <= LDS_SCRATCH - 256, "Params must fit its LDS slot");
    { (void)pk;
      const __attribute__((address_space(4))) unsigned long long* src = (const __attribute__((address_space(4))) unsigned long long*)__builtin_amdgcn_kernarg_segment_ptr();
      LAS unsigned long long* dst = (LAS unsigned long long*)(smem + 256);
      if (threadIdx.x < sizeof(Params) / 8) dst[threadIdx.x] = src[threadIdx.x]; }
    if (threadIdx.x == 0) *(LAS u32x4*)smem = (u32x4){0u, 0u, 0u, 0u};
    __syncthreads();
    const PL& pl = *(const PL*)(smem + 256);
    (void)xcd_barrier_post(uni_ptr(pl.ctrl), (volatile LAS unsigned*)smem);
    phase_prep(pl, lds); grid_sync(pl, smem);
    if ((DUP_MASK >> 16) & 1) { phase_prep(pl, lds); grid_sync(pl, smem); }
#if SELFCHECK
    for (int rep = 0; rep < SELFCHECK; ++rep) {
        const int l = 0, hb = 0;
        PHASE(phase_norm1(p, l, hb));          CHK(1, p.hx, (size_t)HR * DM * 2);
        PHASE(phase_inproj_a(p, l, lds));      CHK(2, p.pa, (size_t)HR * PA_W * 2);
        PHASE(phase_mla_up(p, l, lds));        CHK(3, p.up, (size_t)HR * UPW * 2);
        PHASE(phase_qkv(p, l, lds));           CHK(4, p.q, (size_t)2 * 8 * SEQ * 96 * 2); CHK(5, p.qc, (size_t)2 * 8 * CTX * 96 * 2);
        PHASE(phase_attn_scan1(p, l, lds));    CHK(6, p.st, (size_t)2 * 2 * 8 * NCH * 4096 * 2); CHK(7, p.stb, (size_t)2 * 2 * 8 * NCH * 64 * 4); CHK(8, p.lsum, (size_t)2 * 2 * NT16 * 512 * 2 * 4);
        PHASE(phase_prefix(p, lds));                CHK(9, p.st, (size_t)2 * 2 * 8 * NCH * 4096 * 2); CHK(10, p.lin, (size_t)2 * 2 * NT16 * 512 * 4);
        PHASE(phase_scan3(p, l, lds));         CHK(11, p.ocat, (size_t)HR * OCW * 2);
        PHASE(phase_inproj_g(p, l, lds));      CHK(12, p.pa, (size_t)HR * PG_W * 2);
        PHASE(phase_merge(p, l, lds));         CHK(13, p.y, (size_t)HR * DM * 2);
        PHASE(phase_outproj(p, l, hb, lds));   CHK(14, p.out, (size_t)2 * SEQ * DM * 4); CHK(15, p.xc, (size_t)2 * CTX * DM * 4);
    }
    {   const Params p = ldparams(pl);
        const size_t NOUT = (size_t)NB * SEQ * DM;
        for (size_t i = (size_t)opq_bid() * 512 + opq_tid(); i < NOUT; i += (size_t)gridDim.x * 512) p.out[i] = 0.f;
        __syncthreads();
        if (opq_bid() == 0 && opq_tid() == 0) { int first = 0; const unsigned long long* c = (const unsigned long long*)(p.ctrl + 6144);
            for (int id = 15; id >= 1; --id) for (int rep = 1; rep < SELFCHECK; ++rep)
                if (__hip_atomic_load(c + rep * 32 + id, __ATOMIC_RELAXED, __HIP_MEMORY_SCOPE_AGENT) != __hip_atomic_load(c + id, __ATOMIC_RELAXED, __HIP_MEMORY_SCOPE_AGENT)) first = id;
            p.out[0] = 1000.0f * (float)first; }
    }
    return;
#endif
    for (int l = 0; l < DEPTH; ++l) {
        for (int hb = 0; hb < 2; ++hb) {
            if (l == 0 && hb == 0) { PHASE_D(0, phase_norm1(p, l, hb), phase_norm1(p, l, hb)); }
            PHASE_D(1, phase_inproj_a(p, l, lds), phase_inproj_a(p, l, lds));
            PHASE_D(2, phase_mla_up(p, l, lds), phase_mla_up(p, l, lds));
            PHASE_D(3, phase_qkv(p, l, lds), phase_qkv(p, l, lds));
            PHASE(phase_attn_scan1(p, l, lds));
            if ((DUP_MASK >> 4) & 1) { PHASE(phase_attn_scan1(p, l, lds, 1)); }
            if ((DUP_MASK >> 5) & 1) { PHASE(phase_attn_scan1(p, l, lds, 2)); }
            if ((DUP_MASK >> 6) & 1) { PHASE(phase_attn_scan1(p, l, lds, 4)); }
            PHASE(phase_prefix(p, lds));
            if ((DUP_MASK >> 17) & 1) { PHASE(phase_prefix(p, lds, true)); }
            PHASE(phase_scan3(p, l, lds));
            if ((DUP_MASK >> 7) & 1) { PHASE(phase_scan3(p, l, lds, 1)); }
            if ((DUP_MASK >> 8) & 1) { PHASE(phase_scan3(p, l, lds, 2)); }
            PHASE_D(9, phase_inproj_g(p, l, lds), phase_inproj_g(p, l, lds));
            PHASE_D(10, phase_merge(p, l, lds), phase_merge(p, l, lds));
            PHASE(phase_outproj(p, l, hb, lds); if (hb == 0) phase_norm1(p, l, 1));
            if (((DUP_MASK >> 11) & 1) && l == 0) { PHASE(phase_outproj(p, l, hb, lds)); }
            if ((DUP_MASK >> 15) & 1) { for (int z = 0; z < 10; ++z) grid_sync(pl, smem); }
        }
        PHASE(phase_norm2_route(p, l));
        if ((DUP_MASK >> 18) & 1) { PHASE(phase_norm2_route(p, l, true)); }
        PHASE_D(13, moe_offsets(p, l, offs); phase_moe_up(p, l, offs, lds), phase_moe_up(p, l, offs, lds));
        PHASE_D(14, phase_moe_down(p, l, offs, lds), phase_moe_down(p, l, offs, lds));
        PHASE(phase_moe_combine(p, l, offs); if (l + 1 < DEPTH) phase_norm1(p, l + 1, 0));
        if ((DUP_MASK >> 19) & 1) { PHASE(phase_moe_combine(p, l, offs, true)); }
    }
}

static size_t align_up(size_t x, size_t a) { return (x + a - 1) / a * a; }

extern "C" void kernel_launch(void* const* d_in, const int* in_sizes, int n_in, void* d_out, int out_size, void* d_ws, size_t ws_size, hipStream_t stream) {
    (void)in_sizes; (void)n_in; (void)out_size;
    Params p; memset(&p, 0, sizeof(p));
    for (int i = 0; i < 35; ++i) p.in[i] = (const float*)d_in[i];
    p.out = (float*)d_out;
    char* w = (char*)d_ws; size_t o = 0;
    auto take = [&](size_t bytes) { char* r = w + o; o = align_up(o + bytes, 256); return r; };
    p.ctrl = (unsigned*)take(CTRL_WORDS * 4);
    p.modv = (float*)take((size_t)DEPTH * 5 * 6144 * 4);
    p.lbv = (float*)take((size_t)DEPTH * 2 * 512 * 4);
    p.xc = (float*)take((size_t)NB * CTX * DM * 4);
    p.rope = (float*)take((size_t)SEQ * 32 * 4);
    p.lrula = (float*)take((size_t)DEPTH * 2 * 512 * 4);
    p.winA = (bf16_t*)take((size_t)DEPTH * PA_W * DM * 2);
    p.winG = (bf16_t*)take((size_t)DEPTH * PG_W * DM * 2);
    p.wup = (bf16_t*)take((size_t)DEPTH * UPW * 256 * 2);
    p.wcat = (bf16_t*)take((size_t)DEPTH * DM * OCW * 2);
    p.wout = (bf16_t*)take((size_t)DEPTH * DM * DM * 2);
    p.w13 = (bf16_t*)take((size_t)DEPTH * NEXP * 512 * DM * 2);
    p.w2 = (bf16_t*)take((size_t)DEPTH * NEXP * DM * DEXP * 2);
    p.wlru = (bf16_t*)take((size_t)DEPTH * 2 * 8 * 2 * 64 * 64 * 2);
    p.tok_e = (int*)take((size_t)TT * 2 * 4); p.tok_s = (int*)take((size_t)TT * 2 * 4);
    p.lst = (int*)take((size_t)NEXP * TT * 4); p.tok_w = (float*)take((size_t)NEXP * TT * 4);
    p.rww = (float*)take((size_t)RP * 4); p.rmr = (int*)take((size_t)RP * 4);
    const size_t region = o;
    p.hx = (bf16_t*)take((size_t)HR * DM * 2);
    p.pa = (bf16_t*)take((size_t)HR * PA_W * 2);
    p.ocat = (bf16_t*)take((size_t)HR * OCW * 2);
    p.lsum = (float*)take((size_t)2 * 2 * NT16 * 512 * 2 * 4); p.lin = (float*)take((size_t)2 * 2 * NT16 * 512 * 4);
    const size_t alias1 = o;
    p.up = (bf16_t*)take((size_t)HR * UPW * 2);
    const size_t after_up = o; o = alias1;
    p.st = (bf16_t*)take((size_t)2 * 2 * 8 * NCH * 4096 * 2); p.stb = (float*)take((size_t)2 * 2 * 8 * NCH * 64 * 4);
    if (o < after_up) o = after_up;
    const size_t alias2 = o;
    p.q = (bf16_t*)take((size_t)2 * 8 * SEQ * 96 * 2); p.qc = (bf16_t*)take((size_t)2 * 8 * CTX * 96 * 2); p.kv = (unsigned char*)take((size_t)2 * 8 * NCH * KVT_BYTES);
    const size_t mixer_end = o; o = alias2;
    p.y = (bf16_t*)take((size_t)HR * DM * 2);
    size_t end1 = mixer_end > o ? mixer_end : o;
    o = region;
    p.h2 = (bf16_t*)take((size_t)TT * DM * 2);
    p.h2p = (bf16_t*)take((size_t)RP * DM * 2);
    p.hid = (bf16_t*)take((size_t)RP * DEXP * 2);
    p.yo = (bf16_t*)take((size_t)RP * DM * 2);
    const size_t need = end1 > o ? end1 : o;
    static int grid = 0;
    if (!grid) {
        int dev = 0, cus = 0, per_cu = 0; hipGetDevice(&dev); hipDeviceGetAttribute(&cus, hipDeviceAttributeMultiprocessorCount, dev);
        hipFuncSetAttribute((const void*)hybrid_flow_backbone_kernel, hipFuncAttributeMaxDynamicSharedMemorySize, LDS_TOTAL);
        hipOccupancyMaxActiveBlocksPerMultiprocessor(&per_cu, (const void*)hybrid_flow_backbone_kernel, 512, LDS_TOTAL);
        if (per_cu < 1) fprintf(stderr, "kernel_launch: occupancy query returned %d\n", per_cu);
        grid = cus * (per_cu < 1 ? 0 : 1); if (grid > 256) grid = 256;
    }
    if (need > ws_size) { fprintf(stderr, "kernel_launch: workspace too small: need %zu have %zu\n", need, ws_size); return; }
    if (grid < 8) { fprintf(stderr, "kernel_launch: grid %d too small\n", grid); return; }
    hipMemsetAsync(p.ctrl, 0, CTRL_WORDS * 4, stream);
    hipLaunchKernelGGL(hybrid_flow_backbone_kernel, dim3(grid), dim3(512), LDS_TOTAL, stream, p);
}
```

```cpp
#include <hip/hip_runtime.h>
#include <stdint.h>
#include <stdio.h>
#include <string.h>

#define LAS __attribute__((address_space(3)))
#define DEVI __device__ __forceinline__
typedef unsigned short bf16_t;
typedef short bf16x8 __attribute__((ext_vector_type(8)));
typedef float f32x4 __attribute__((ext_vector_type(4)));
typedef float f32x16 __attribute__((ext_vector_type(16)));
typedef unsigned u32x4 __attribute__((ext_vector_type(4)));
typedef unsigned u32x2 __attribute__((ext_vector_type(2)));

constexpr int NB = 4, SEQ = 8192, CTX = 256, DM = 1024, DEPTH = 2;
constexpr int RB = SEQ + CTX;
constexpr int TT = NB * RB;
constexpr int HR = 2 * RB;
constexpr int NCH = RB / 64;
constexpr int INW = 7072;
constexpr int PA_W = 4096;
constexpr int PG_W = 3072;
constexpr int C_Q = 0, C_ZF = 512, C_ZB = 1024, C_I = 1536, C_G = 2048, C_DQ = 2560, C_DKV = 2816, C_KR = 2944, C_LX = 3072, C_LY = 3584;
constexpr int UPW = 1792;
constexpr int OCW = 1536;
constexpr int KVT_BYTES = 22016;
constexpr int KT_BYTES = 13312;
constexpr int NEXP = 16, DEXP = 256;
constexpr float EPSF = 1e-6f;
constexpr int LDS_TOTAL = 160 * 1024;

DEVI float bf2f(bf16_t b) { return __uint_as_float(((unsigned)b) << 16); }
DEVI bf16_t f2bf(float f) { return __builtin_bit_cast(bf16_t, (__bf16)f); }
typedef float f32x2_t __attribute__((ext_vector_type(2)));
typedef __bf16 bf16x2_t __attribute__((ext_vector_type(2)));
DEVI unsigned cvt_pk_bf16(float lo, float hi) { const f32x2_t v = {lo, hi}; return __builtin_bit_cast(unsigned, __builtin_convertvector(v, bf16x2_t)); }
DEVI float fast_exp2(float x) { return __builtin_amdgcn_exp2f(x); }
DEVI float fast_rcp(float x) { return __builtin_amdgcn_rcpf(x); }
DEVI float sigmoidf_(float x) { return fast_rcp(1.0f + fast_exp2(-1.44269504f * x)); }
DEVI float wave_sum(float v) { for (int o = 32; o >= 1; o >>= 1) v += __shfl_xor(v, o); return v; }
DEVI float wave_max(float v) { for (int o = 32; o >= 1; o >>= 1) v = fmaxf(v, __shfl_xor(v, o)); return v; }

DEVI int opq_tid() { int t = threadIdx.x; asm volatile("" : "+v"(t)); return t; }
DEVI int opq_bid() { int b = blockIdx.x; asm volatile("" : "+s"(b)); return b; }

DEVI int vzero() { int z = 0; asm volatile("" : "+v"(z)); return z; }

#define XB_TMO      128
#define XB_XCNT(j)  (256  + 64 * (j))
#define XB_XSUB(j)  (1280 + 64 * (j))
#define XB_XGEN(j)  (2304 + 64 * (j))
#define XB_TOP      3328
#define XB_TOPGEN   3392
#define XCD_BAR_WORDS 3456
#define XB_SPIN_CAP (1u << 18)

__device__ __forceinline__ unsigned xb_ld(unsigned* p)              { return __hip_atomic_load(p, __ATOMIC_RELAXED, __HIP_MEMORY_SCOPE_AGENT); }
__device__ __forceinline__ unsigned xb_add(unsigned* p, unsigned v) { return __hip_atomic_fetch_add(p, v, __ATOMIC_RELAXED, __HIP_MEMORY_SCOPE_AGENT); }
__device__ __forceinline__ unsigned xb_xcc_id() { return (unsigned)__builtin_amdgcn_s_getreg((3 << 11) | 20) & 0xFu; }
#define XB_SPIN(cond, bar) do { unsigned _sp = 0; while (cond) { __builtin_amdgcn_s_sleep(1); \
    if ((++_sp & 255u) == 0u) { if (xb_ld(&(bar)[XB_TMO])) break; if (_sp > XB_SPIN_CAP) { atomicAdd(&(bar)[XB_TMO], 1u); break; } } } } while (0)

struct XcdBarrier { unsigned* bar; unsigned x; volatile LAS unsigned* st; };

__device__ __forceinline__ XcdBarrier xcd_barrier_post(unsigned* bar, volatile LAS unsigned* st) {
    XcdBarrier b; b.bar = bar; b.x = xb_xcc_id(); b.st = st;
    if (threadIdx.x == 0) (void)xb_add(&bar[XB_XCNT(b.x)], 1u);
    return b;
}
__device__ __forceinline__ void xcd_barrier_complete(unsigned* bar, unsigned x, unsigned& nloc, unsigned& nx) {
    const unsigned G = gridDim.x * gridDim.y * gridDim.z;
    unsigned sum, cnt, mine, sp = 0u;
    for (;;) {
        sum = 0u; cnt = 0u; mine = 0u;
#pragma unroll
        for (unsigned j = 0; j < 16; ++j) { const unsigned c = xb_ld(&bar[XB_XCNT(j)]); sum += c; cnt += (c > 0u) ? 1u : 0u; mine = (j == x) ? c : mine; }
        if (sum == G) break;
        __builtin_amdgcn_s_sleep(1);
        if ((++sp & 255u) == 0u) { if (xb_ld(&bar[XB_TMO])) break; if (sp > XB_SPIN_CAP) { atomicAdd(&bar[XB_TMO], 1u); break; } }
    }
    nloc = mine > 0u ? mine : 1u; nx = cnt > 0u ? cnt : 1u;
}
__device__ __forceinline__ void xcd_barrier(const XcdBarrier& b) {
    asm volatile("s_waitcnt vmcnt(0)" ::: "memory");
    __syncthreads();
    if (threadIdx.x == 0) {
        unsigned* bar = b.bar;
        __builtin_amdgcn_s_waitcnt(0);
        unsigned nloc = b.st[0], nx = b.st[1];
        if (nloc == 0u) { xcd_barrier_complete(bar, b.x, nloc, nx); b.st[0] = nloc; b.st[1] = nx; }
        const unsigned old = xb_add(&bar[XB_XSUB(b.x)], 1u);
        const unsigned gen = old / nloc;
        if (old + 1u == (gen + 1u) * nloc) {
            __builtin_amdgcn_fence(__ATOMIC_RELEASE, "agent");
            asm volatile("s_waitcnt vmcnt(0)" ::: "memory");
            const unsigned og = xb_add(&bar[XB_TOP], 1u);
            const unsigned tg = og / nx;
            if (og + 1u == (tg + 1u) * nx) xb_add(&bar[XB_TOPGEN], 1u);
            else XB_SPIN(xb_ld(&bar[XB_TOPGEN]) == tg, bar);
            __builtin_amdgcn_fence(__ATOMIC_ACQUIRE, "agent");
            xb_add(&bar[XB_XGEN(b.x)], 1u);
            asm volatile("s_waitcnt vmcnt(0)" ::: "memory");
        } else {
            XB_SPIN(xb_ld(&bar[XB_XGEN(b.x)]) == gen, bar);
            __builtin_amdgcn_fence(__ATOMIC_ACQUIRE, "agent");
            asm volatile("s_waitcnt vmcnt(0)" ::: "memory");
        }
    }
    __syncthreads();
}

struct Params {
    const float* in[35];
    float* out;
    unsigned* ctrl;
    float* modv;
    float* lbv;
    float* xc;
    float* lrula;
    float* rope;
    bf16_t* winA; bf16_t* winG; bf16_t* wup; bf16_t* wcat; bf16_t* wout; bf16_t* w13; bf16_t* w2; bf16_t* wlru;
    bf16_t* hx;
    bf16_t* pa;
    bf16_t* up;
    bf16_t* q; bf16_t* qc; unsigned char* kv;
    bf16_t* st; float* stb;
    float* lsum; float* lin;
    bf16_t* ocat;
    bf16_t* y;
    bf16_t* h2; bf16_t* h2p; bf16_t* hid; bf16_t* yo;
    int* tok_e; int* tok_s; float* tok_w; int* lst; float* rww; int* rmr;
    unsigned long long pad_;
};

typedef LAS Params PL;

#define CTRL_CNT(l) (4096 + 64 * (l))
#define CTRL_WORDS 8192

namespace g8 {
constexpr int BM = 256, BK = 64, HALF = 128, HTB = HALF * BK * 2, STAGE_BYTES = 8 * HTB, NXCD = 8, WGM = 8;
__host__ __device__ __forceinline__ int lds_byte(int r, int c) { const int st = (r >> 4) * 2 + (c >> 5), rr = r & 15, cc = c & 31, ob = rr * 64 + cc * 2; return st * 1024 + (ob ^ (((ob >> 9) & 1) << 5)); }
__host__ __device__ __forceinline__ void stage_rc(int b, int& R, int& C) { const int st = b / 1024, sb = b % 1024, swz = sb ^ (((sb >> 9) & 1) << 5); R = (st >> 1) * 16 + swz / 64; C = (st & 1) * 32 + (swz % 64) / 2; }
__host__ __device__ __forceinline__ int perm32(int rho) { const int n = rho >> 4, i = rho & 15; return 8 * (i >> 2) + 4 * n + (i & 3); }

struct Unit { int pm, pn, tag; const char* a; const char* b; };

__device__ __forceinline__ bool static_order(int i, int G, int c, int nM, int nN, int& pm, int& pn) {
    const int nwg = nM * nN; const long L = (long)i * G + c; if (L >= nwg) return false;
    int wgid = (int)L; { const int q = nwg / NXCD, r = nwg % NXCD, xcd = wgid % NXCD, off = wgid / NXCD; wgid = (xcd < r ? xcd * (q + 1) : r * (q + 1) + (xcd - r) * q) + off; }
    const int nig = WGM * nN, gid = wgid / nig, fm = gid * WGM, gsz = (nM - fm) < WGM ? (nM - fm) : WGM;
    pm = fm + ((wgid % nig) % gsz); pn = (wgid % nig) / gsz; return true;
}

template <class Epi, class Sched>
__device__ __forceinline__ void gemm_phase(LAS unsigned char* lds, const int lda, const int ldb, const int K, const Sched& S, const Epi& E) {
    const int tid = opq_tid(), wid = __builtin_amdgcn_readfirstlane(tid >> 6), lane = tid & 63, wr = wid >> 2, wc = wid & 3, fr = lane & 15, fq = lane >> 4;
    const int nt = K / BK;
    unsigned voffB[2]; int RA[2], CA[2];
#pragma unroll
    for (int i = 0; i < 2; ++i) { int R, C; stage_rc(tid * 16 + i * 8192, R, C); const int Rb = Epi::PERM ? ((R & ~31) + perm32(R & 31)) : R;
        RA[i] = R; CA[i] = C; voffB[i] = (unsigned)(Rb * ldb + C) * 2u; }
    auto set_voff = [&](const Unit& u, unsigned (&v)[2][2]) {
#pragma unroll
        for (int h = 0; h < 2; ++h)
#pragma unroll
            for (int i = 0; i < 2; ++i) { if constexpr (Sched::GATHER) v[h][i] = (unsigned)S.row_of(u, h * HALF + RA[i]) * (unsigned)(lda * 2) + (unsigned)CA[i] * 2u;
                else v[h][i] = (unsigned)((h * HALF + RA[i]) * lda + CA[i]) * 2u; } };
    const size_t kstep = (size_t)(BK * 2);
    const size_t hstepB = (size_t)HALF * ldb * 2;
    const unsigned ldsw = (unsigned)wid * 1024u;
    const int aoff = lds_byte(wr * 64 + fr, fq * 8), boff = lds_byte(wc * 32 + fr, fq * 8);
#define G8_SA(b, h) (((b) * 2 + (h)) * HTB)
#define G8_SB(b, h) ((4 + (b) * 2 + (h)) * HTB)
#define G8_STAGE(bufoff, gbase, voff) do { _Pragma("unroll") for (int _i = 0; _i < 2; ++_i) \
        __builtin_amdgcn_global_load_lds((const unsigned*)((const char*)(gbase) + (voff)[_i]), (LAS unsigned*)(lds + (bufoff) + ldsw + _i * 8192), 16, 0, 0); } while (0)
#define G8_LDA(dst, b, h) do { _Pragma("unroll") for (int m = 0; m < 4; ++m) _Pragma("unroll") for (int k = 0; k < 2; ++k) dst[m][k] = *(const LAS bf16x8*)(lds + G8_SA(b, h) + aoff + m * 2048 + k * 1024); } while (0)
#define G8_LDB(dst, b, h) do { _Pragma("unroll") for (int n = 0; n < 2; ++n) _Pragma("unroll") for (int k = 0; k < 2; ++k) dst[n][k] = *(const LAS bf16x8*)(lds + G8_SB(b, h) + boff + n * 2048 + k * 1024); } while (0)
#define G8_MMA(ai, bj, At, Bt) do { __builtin_amdgcn_s_setprio(1); _Pragma("unroll") for (int m = 0; m < 4; ++m) _Pragma("unroll") for (int n = 0; n < 2; ++n) _Pragma("unroll") for (int k = 0; k < 2; ++k) \
        acc[ai][bj][m][n] = __builtin_amdgcn_mfma_f32_16x16x32_bf16(Bt[n][k], At[m][k], acc[ai][bj][m][n], 0, 0, 0); __builtin_amdgcn_s_setprio(0); } while (0)
#define G8_WAIT_V(n) asm volatile("s_waitcnt vmcnt(" #n ")" ::: "memory")
#define G8_WAIT_L(n) asm volatile("s_waitcnt lgkmcnt(" #n ")" ::: "memory")
#define G8_BAR __builtin_amdgcn_s_barrier()
#define G8_SCHED __builtin_amdgcn_sched_barrier(0)
    Unit cur, nxt; int ui = 0;
    if (!S.next(0, cur)) return;
    f32x4 acc[2][2][4][2];
#pragma unroll
    for (int a = 0; a < 2; ++a)
#pragma unroll
        for (int b = 0; b < 2; ++b)
#pragma unroll
            for (int m = 0; m < 4; ++m)
#pragma unroll
                for (int n = 0; n < 2; ++n) acc[a][b][m][n] = (f32x4){0.f, 0.f, 0.f, 0.f};
    bf16x8 At[4][2], B0[2][2], B1[2][2];
    const char* cA = cur.a; const char* cB = cur.b;
    unsigned vcur[2][2], vnxt[2][2]; set_voff(cur, vcur);
    asm volatile("s_waitcnt lgkmcnt(0)" ::: "memory");
    if constexpr (Sched::GATHER) asm volatile("s_waitcnt vmcnt(0)" ::: "memory");
    G8_STAGE(G8_SB(0, 0), cB, voffB); G8_STAGE(G8_SA(0, 0), cA, vcur[0]); G8_STAGE(G8_SB(0, 1), cB + hstepB, voffB); G8_STAGE(G8_SA(0, 1), cA, vcur[1]);
    if (wr == 1) G8_BAR;
    G8_WAIT_V(4); G8_BAR;
    G8_STAGE(G8_SB(1, 0), cB + kstep, voffB); G8_STAGE(G8_SA(1, 0), cA + kstep, vcur[0]); G8_STAGE(G8_SB(1, 1), cB + hstepB + kstep, voffB);
    G8_WAIT_V(6); G8_BAR;
    for (;;) {
        const bool has_next = S.next(ui + 1, nxt);
        const char* nA = has_next ? nxt.a : cA; const char* nB = has_next ? nxt.b : cB;
        if (has_next) set_voff(nxt, vnxt); else {
#pragma unroll
            for (int h = 0; h < 2; ++h) { vnxt[h][0] = vcur[h][0]; vnxt[h][1] = vcur[h][1]; } }
        asm volatile("s_waitcnt lgkmcnt(0)" ::: "memory");
        const int tseg = nt / Epi::NSEG;
#pragma unroll 1
        for (int sg = 0; sg < Epi::NSEG; ++sg) {
#pragma unroll 1
        for (int t = sg * tseg; t < (sg + 1) * tseg; t += 2) {
            const bool last = (t == nt - 2);
            const char* a1 = cA + (size_t)(t + 1) * kstep;
            const char* a2 = last ? nA : cA + (size_t)(t + 2) * kstep; const char* b2 = last ? nB : cB + (size_t)(t + 2) * kstep;
            const char* a3 = a2 + kstep; const char* b3 = b2 + kstep;
            unsigned v20[2], v21[2];
#pragma unroll
            for (int i = 0; i < 2; ++i) { v20[i] = last ? vnxt[0][i] : vcur[0][i]; v21[i] = last ? vnxt[1][i] : vcur[1][i]; }
            G8_LDB(B0, 0, 0); G8_SCHED; G8_LDA(At, 0, 0); G8_STAGE(G8_SA(1, 1), a1, vcur[1]);
            G8_WAIT_L(8); G8_BAR; G8_WAIT_L(0); G8_MMA(0, 0, At, B0); G8_BAR; G8_SCHED;
            G8_LDB(B1, 0, 1); G8_STAGE(G8_SB(0, 0), b2, voffB);
            G8_BAR; G8_WAIT_L(0); G8_MMA(0, 1, At, B1); G8_BAR;
            G8_LDA(At, 0, 1); G8_STAGE(G8_SA(0, 0), a2, v20);
            G8_BAR; G8_WAIT_L(0); G8_MMA(1, 0, At, B0); G8_BAR; G8_SCHED;
            G8_STAGE(G8_SB(0, 1), b2 + hstepB, voffB);
            G8_WAIT_V(6); G8_BAR; G8_MMA(1, 1, At, B1); G8_BAR;
            G8_LDB(B0, 1, 0); G8_SCHED; G8_LDA(At, 1, 0); G8_STAGE(G8_SA(0, 1), a2, v21);
            G8_WAIT_L(8); G8_BAR; G8_WAIT_L(0); G8_MMA(0, 0, At, B0); G8_BAR; G8_SCHED;
            G8_LDB(B1, 1, 1); G8_STAGE(G8_SB(1, 0), b3, voffB);
            G8_BAR; G8_WAIT_L(0); G8_MMA(0, 1, At, B1); G8_BAR;
            G8_LDA(At, 1, 1); G8_STAGE(G8_SA(1, 0), a3, v20);
            G8_BAR; G8_WAIT_L(0); G8_MMA(1, 0, At, B0); G8_BAR; G8_SCHED;
            G8_STAGE(G8_SB(1, 1), b3 + hstepB, voffB);
            G8_WAIT_V(6); G8_BAR; G8_MMA(1, 1, At, B1); G8_BAR;
        }
        if constexpr (Epi::NSEG > 1) { if (sg + 1 < Epi::NSEG) E.mid(sg, acc, cur, wr, wc, fr, fq); }
        }
        E(acc, cur, wr, wc, fr, fq);
        if (!has_next) break;
#pragma unroll
        for (int a = 0; a < 2; ++a)
#pragma unroll
            for (int b = 0; b < 2; ++b)
#pragma unroll
                for (int m = 0; m < 4; ++m)
#pragma unroll
                    for (int n = 0; n < 2; ++n) acc[a][b][m][n] = (f32x4){0.f, 0.f, 0.f, 0.f};
        cur = nxt; cA = nA; cB = nB; ++ui;
#pragma unroll
        for (int h = 0; h < 2; ++h) { vcur[h][0] = vnxt[h][0]; vcur[h][1] = vnxt[h][1]; }
    }
    G8_WAIT_V(0);
    if (wr == 0) G8_BAR;
    G8_BAR;
#undef G8_SA
#undef G8_SB
#undef G8_STAGE
#undef G8_LDA
#undef G8_LDB
#undef G8_MMA
#undef G8_WAIT_V
#undef G8_WAIT_L
#undef G8_BAR
#undef G8_SCHED
}
}

enum { I_X = 0, I_C, I_CTX, I_CCTX, I_WMOD, I_BMOD, I_NMIX, I_NFFN, I_WIN, I_HGLB, I_HGNORM, I_QNORM, I_KVNORM, I_WUQ, I_WUKV, I_GQ, I_GK,
       I_CONVW, I_CONVB, I_LWA, I_LBA, I_LWX, I_LBX, I_LAM, I_BRHG, I_BRMLA, I_BRLRU, I_WOUT, I_WRG, I_BRG, I_WRE, I_BRE, I_W1, I_W3, I_W2 };

DEVI const float* xin_row_l0(const Params& p, int r) { const int b = r / RB, pos = r - b * RB;
    return pos < SEQ ? p.in[I_X] + ((size_t)b * SEQ + pos) * DM : p.in[I_CTX] + ((size_t)b * CTX + (pos - SEQ)) * DM; }
DEVI float* xbuf_row(const Params& p, int r) { const int b = r / RB, pos = r - b * RB;
    return pos < SEQ ? p.out + ((size_t)b * SEQ + pos) * DM : p.xc + ((size_t)b * CTX + (pos - SEQ)) * DM; }
DEVI int mod_row(int r) { const int b = r / RB, pos = r - b * RB; return pos < SEQ ? b : 4; }

struct TrJob { const float* src; int ld; int K; int ncols; bf16_t* dst; int dld; const float* ks; };

DEVI int tr_job_count() { return DEPTH * (12 + 16 * 5 + 32); }
template <class P> DEVI TrJob tr_job(const P& p, int j) {
    const int per = 12 + 16 * 5 + 32; const int l = j / per; int q = j - l * per; TrJob t; t.ks = nullptr; t.src = nullptr;
    const float* win = p.in[I_WIN] + (size_t)l * DM * INW;
    bf16_t* winA = p.winA + (size_t)l * PA_W * DM; bf16_t* wup = p.wup + (size_t)l * UPW * 256; bf16_t* wcat = p.wcat + (size_t)l * DM * OCW;
    if (q == 0) { t.src = win; t.ld = INW; t.K = DM; t.ncols = 2944; t.dst = winA; t.dld = DM; return t; }
    if (q == 11) { t.src = win + 2944; t.ld = INW; t.K = DM; t.ncols = 32; t.dst = winA + (size_t)2944 * DM; t.dld = DM; return t; }
    if (q == 1) { t.src = nullptr; t.ld = 0; t.K = DM; t.ncols = 96; t.dst = winA + (size_t)2976 * DM; t.dld = DM; return t; }
    if (q == 2) { t.src = win + 2976; t.ld = INW; t.K = DM; t.ncols = 1024; t.dst = winA + (size_t)3072 * DM; t.dld = DM; return t; }
    if (q == 3) { t.src = win + 4000; t.ld = INW; t.K = DM; t.ncols = PG_W; t.dst = p.winG + (size_t)l * PG_W * DM; t.dld = DM; return t; }
    if (q == 4) { t.src = p.in[I_WUQ] + (size_t)l * 256 * 768; t.ld = 768; t.K = 256; t.ncols = 768; t.dst = wup; t.dld = 256; t.ks = p.in[I_QNORM] + l * 256; return t; }
    if (q == 5) { t.src = p.in[I_WUKV] + (size_t)l * 128 * 1024; t.ld = 1024; t.K = 128; t.ncols = 1024; t.dst = wup + (size_t)768 * 256; t.dld = 256; t.ks = p.in[I_KVNORM] + l * 128; return t; }
    if (q == 6) { t.src = nullptr; t.ld = 0; t.K = 128; t.ncols = 1024; t.dst = wup + (size_t)768 * 256 + 128; t.dld = 256; return t; }
    if (q >= 7 && q <= 9) { const int i = q - 7; const float* s = (i == 0 ? p.in[I_BRHG] : i == 1 ? p.in[I_BRMLA] : p.in[I_BRLRU]) + (size_t)l * 512 * DM;
        t.src = s; t.ld = DM; t.K = 512; t.ncols = DM; t.dst = wcat + i * 512; t.dld = OCW; return t; }
    if (q == 10) { t.src = p.in[I_WOUT] + (size_t)l * DM * DM; t.ld = DM; t.K = DM; t.ncols = DM; t.dst = p.wout + (size_t)l * DM * DM; t.dld = DM; return t; }
    q -= 12;
    if (q < 80) { const int e = q / 5, s = q % 5; const size_t le = (size_t)l * NEXP + e;
        if (s < 4) { const int pn = s >> 1, which = s & 1;
            t.src = (which ? p.in[I_W3] : p.in[I_W1]) + le * DM * DEXP + pn * 128; t.ld = DEXP; t.K = DM; t.ncols = 128;
            t.dst = p.w13 + le * 512 * DM + (size_t)(pn * 256 + which * 128) * DM; t.dld = DM; return t; }
        t.src = p.in[I_W2] + le * DEXP * DM; t.ld = DM; t.K = DEXP; t.ncols = DM; t.dst = p.w2 + le * DM * DEXP; t.dld = DEXP; return t; }
    q -= 80;
    { const int d = q >> 4, n = (q >> 1) & 7, which = q & 1;
      const size_t blk = (((size_t)l * 2 + d) * 8 + n);
      t.src = (which ? p.in[I_LWX] : p.in[I_LWA]) + blk * 64 * 64; t.ld = 64; t.K = 64; t.ncols = 64;
      t.dst = p.wlru + (blk * 2 + which) * 64 * 64; t.dld = 64; return t; }
}

template <class P> DEVI void phase_prep(const P& p, LAS unsigned char* lds) {
    const int tid = opq_tid(), G = gridDim.x;
    LAS float* tl = (LAS float*)lds;
    int rot = 0; const int nj = tr_job_count();
    for (int j = 0; j < nj; ++j) {
        const TrJob t = tr_job(p, j);
        const bool wide = (t.ncols & 63) == 0;
        const int tw = wide ? 64 : 32, tk = t.K / 64, ntile = tk * (t.ncols / tw);
        const int first = (int)((opq_bid() + (unsigned)G - (unsigned)(rot % G)) % (unsigned)G);
        if (wide) {
            for (int tile0 = first; tile0 < ntile; tile0 += 4 * G) {
                f32x4 v[4][2];
#pragma unroll
                for (int q = 0; q < 4; ++q) { const int tile = tile0 + q * G; const int k0 = (tile % tk) * 64, n0 = (tile / tk) * 64; const int n4 = tid & 15, kr = tid >> 4;
#pragma unroll
                    for (int i = 0; i < 2; ++i) { const int k = kr + 32 * i; f32x4 x = {0.f, 0.f, 0.f, 0.f};
                        if (tile < ntile && t.src) { x = *(const f32x4*)(t.src + (size_t)(k0 + k) * t.ld + n0 + n4 * 4); if (t.ks) x *= t.ks[k0 + k]; }
                        v[q][i] = x; } }
#pragma unroll
                for (int q = 0; q < 4; ++q) { const int n4 = tid & 15, kr = tid >> 4;
#pragma unroll
                    for (int i = 0; i < 2; ++i) { LAS float* d = tl + q * 4160 + (kr + 32 * i) * 65 + n4 * 4; d[0] = v[q][i][0]; d[1] = v[q][i][1]; d[2] = v[q][i][2]; d[3] = v[q][i][3]; } }
                __syncthreads();
#pragma unroll
                for (int q = 0; q < 4; ++q) { const int tile = tile0 + q * G; if (tile < ntile) { const int k0 = (tile % tk) * 64, n0 = (tile / tk) * 64; const int n = tid >> 3, k8 = (tid & 7) * 8;
                    const LAS float* sp = tl + q * 4160 + k8 * 65 + n;
                    u32x4 w; w.x = cvt_pk_bf16(sp[0], sp[65]); w.y = cvt_pk_bf16(sp[130], sp[195]); w.z = cvt_pk_bf16(sp[260], sp[325]); w.w = cvt_pk_bf16(sp[390], sp[455]);
                    *(u32x4*)(t.dst + (size_t)(n0 + n) * t.dld + k0 + k8) = w; } }
                __syncthreads();
            }
        } else {
            for (int tile0 = first; tile0 < ntile; tile0 += 8 * G) {
                float v[8][4];
#pragma unroll
                for (int q = 0; q < 8; ++q) { const int tile = tile0 + q * G; const int k0 = (tile % tk) * 64, n0 = (tile / tk) * 32; const int n = tid & 31, kr = tid >> 5;
#pragma unroll
                    for (int i = 0; i < 4; ++i) { const int k = kr + 16 * i; float x = 0.f;
                        if (tile < ntile && t.src) { x = t.src[(size_t)(k0 + k) * t.ld + n0 + n]; if (t.ks) x *= t.ks[k0 + k]; }
                        v[q][i] = x; } }
#pragma unroll
                for (int q = 0; q < 8; ++q) { const int n = tid & 31, kr = tid >> 5;
#pragma unroll
                    for (int i = 0; i < 4; ++i) tl[q * 2112 + (kr + 16 * i) * 33 + n] = v[q][i]; }
                __syncthreads();
#pragma unroll
                for (int q = 0; q < 8; ++q) { const int tile = tile0 + q * G; if (tile < ntile) { const int k0 = (tile % tk) * 64, n0 = (tile / tk) * 32; const int k = tid & 63, nn = tid >> 6;
#pragma unroll
                    for (int i = 0; i < 4; ++i) { const int n = nn + 8 * i; t.dst[(size_t)(n0 + n) * t.dld + k0 + k] = f2bf(tl[q * 2112 + k * 33 + n]); } } }
                __syncthreads();
            }
        }
        rot += ntile;
    }
    {
        LAS float* sl = (LAS float*)lds;
        LAS float* red = sl + 5 * 1024;
        for (int i = tid; i < 5 * 1024; i += 512) { const int r = i >> 10, k = i & 1023; const float v = r < 4 ? p.in[I_C][r * DM + k] : p.in[I_CCTX][k]; sl[i] = v * sigmoidf_(v); }
        __syncthreads();
        for (int u = opq_bid(); u < DEPTH * 96; u += G) {
            const int l = u / 96, n0 = (u % 96) * 64, col = tid & 63, ks = tid >> 6;
            const float* w = p.in[I_WMOD] + (size_t)l * DM * 6144 + n0 + col;
            float a0 = 0.f, a1 = 0.f, a2 = 0.f, a3 = 0.f, a4 = 0.f;
#pragma unroll 8
            for (int k = ks * 128; k < ks * 128 + 128; ++k) { const float wv = w[(size_t)k * 6144];
                a0 += sl[k] * wv; a1 += sl[1024 + k] * wv; a2 += sl[2048 + k] * wv; a3 += sl[3072 + k] * wv; a4 += sl[4096 + k] * wv; }
            red[(ks * 5 + 0) * 64 + col] = a0; red[(ks * 5 + 1) * 64 + col] = a1; red[(ks * 5 + 2) * 64 + col] = a2; red[(ks * 5 + 3) * 64 + col] = a3; red[(ks * 5 + 4) * 64 + col] = a4;
            __syncthreads();
            if (tid < 320) { const int r = tid >> 6, c2 = tid & 63; float s = p.in[I_BMOD][l * 6144 + n0 + c2];
#pragma unroll
                for (int q = 0; q < 8; ++q) s += red[(q * 5 + r) * 64 + c2];
                p.modv[((size_t)l * 5 + r) * 6144 + n0 + c2] = s; }
            __syncthreads();
        }
    }
    for (int i = opq_bid() * 512 + tid; i < SEQ * 16; i += G * 512) { const int pos = i >> 4, a = i & 15;
        const float inv = exp2f(-(float)(a & 7) * (13.287712379549449f / 8.0f)); const float ang = (float)((a < 8) ? (pos >> 6) : (pos & 63)) * inv;
        float sn, cs; sincosf(ang, &sn, &cs); p.rope[(size_t)pos * 32 + a] = cs; p.rope[(size_t)pos * 32 + 16 + a] = sn; }
    if (opq_bid() == 1) { for (int i = tid; i < DEPTH * 2 * 512; i += 512) p.lrula[i] = -8.0f * 1.44269504f * log1pf(__expf(-p.in[I_LAM][i])); }
    if (opq_bid() == 0) {
        for (int i = tid; i < 2 * 512; i += 512) { const float a0 = p.in[I_HGLB][i], a1 = p.in[I_HGLB][1024 + i]; const float m = fmaxf(a0, a1);
            const float e0 = __expf(a0 - m), e1 = __expf(a1 - m); p.lbv[i] = 0.f; p.lbv[1024 + i] = e1 / (e0 + e1); }
    }
}

DEVI void phase_norm1(const Params& p, int l, int hb) {
    const int lane = opq_tid() & 63, wv = opq_tid() >> 6;
    const float* gm = p.in[I_NMIX] + l * DM;
    for (int rl = opq_bid() * 8 + wv; rl < HR; rl += gridDim.x * 8) {
        const int r = hb * HR + rl;
        const float* src = (l == 0) ? xin_row_l0(p, r) : (const float*)xbuf_row(p, r);
        f32x4 v[4]; float ss = 0.f;
#pragma unroll
        for (int i = 0; i < 4; ++i) { v[i] = *(const f32x4*)(src + i * 256 + lane * 4); ss += v[i][0] * v[i][0] + v[i][1] * v[i][1] + v[i][2] * v[i][2] + v[i][3] * v[i][3]; }
        ss = wave_sum(ss);
        const float rstd = rsqrtf(ss * (1.0f / DM) + EPSF);
        const float* mv = p.modv + ((size_t)l * 5 + mod_row(r)) * 6144;
#pragma unroll
        for (int i = 0; i < 4; ++i) { const int c = i * 256 + lane * 4;
            const f32x4 g = *(const f32x4*)(gm + c), sh = *(const f32x4*)(mv + c), sc = *(const f32x4*)(mv + 1024 + c);
            f32x4 h;
#pragma unroll
            for (int e = 0; e < 4; ++e) h[e] = v[i][e] * rstd * g[e] * (1.0f + sc[e]) + sh[e];
            u32x2 w; w.x = cvt_pk_bf16(h[0], h[1]); w.y = cvt_pk_bf16(h[2], h[3]);
            *(u32x2*)(p.hx + (size_t)rl * DM + c) = w; }
    }
}

struct TileSched {
    static constexpr bool GATHER = false;
    int nM, nN, G, c, skipctx; const char* A; const char* B; size_t atile, btile; size_t acol_bytes;
    DEVI bool next(int i, g8::Unit& u) const {
        int pm, pn; if (!g8::static_order(i, G, c, nM, nN, pm, pn)) return false;
        const int pma = skipctx ? pm + pm / 32 : pm;
        u.pm = pma; u.pn = pn; u.tag = 0; u.a = A + (size_t)pma * atile + acol_bytes; u.b = B + (size_t)pn * btile; return true; }
};

template <int ACT> struct EpiBf16 {
    static constexpr bool PERM = true, HAS_MID = false; static constexpr int NSEG = 1;
    bf16_t* O; int ldc;
    DEVI void operator()(const f32x4 (&acc)[2][2][4][2], const g8::Unit& u, int wr, int wc, int fr, int fq) const {
        const int row0 = u.pm * 256 + wr * 64 + fr, col0 = u.pn * 256 + wc * 32 + 8 * fq;
#pragma unroll
        for (int ai = 0; ai < 2; ++ai)
#pragma unroll
            for (int m = 0; m < 4; ++m) { bf16_t* rowp = O + (size_t)(row0 + ai * 128 + m * 16) * ldc + col0;
#pragma unroll
                for (int bj = 0; bj < 2; ++bj) { f32x4 v0 = acc[ai][bj][m][0], v1 = acc[ai][bj][m][1];
                    if (ACT == 1) {
#pragma unroll
                        for (int e = 0; e < 4; ++e) { v0[e] = sigmoidf_(v0[e]); v1[e] = sigmoidf_(v1[e]); } }
                    u32x4 w; w.x = cvt_pk_bf16(v0[0], v0[1]); w.y = cvt_pk_bf16(v0[2], v0[3]); w.z = cvt_pk_bf16(v1[0], v1[1]); w.w = cvt_pk_bf16(v1[2], v1[3]);
                    *(u32x4*)(rowp + bj * 128) = w; } }
    }
};

DEVI void phase_inproj_a(const Params& p, int l, LAS unsigned char* lds) {
    TileSched S; S.nM = HR / 256; S.nN = PA_W / 256; S.G = gridDim.x; S.c = opq_bid(); S.skipctx = 0;
    S.A = (const char*)p.hx; S.B = (const char*)(p.winA + (size_t)l * PA_W * DM); S.atile = (size_t)256 * DM * 2; S.btile = (size_t)256 * DM * 2; S.acol_bytes = 0;
    EpiBf16<0> E; E.O = p.pa; E.ldc = PA_W;
    g8::gemm_phase(lds, DM, DM, DM, S, E);
}

struct UpSched { static constexpr bool GATHER = false; int G, c; const char* A; const char* B;
    DEVI bool next(int i, g8::Unit& u) const { const long L = (long)i * G + c; if (L >= (HR / 256) * 7) return false;
        const int pm = (int)(L / 7), j = (int)(L % 7); u.pm = pm; u.pn = j; u.tag = 0;
        u.a = A + (size_t)pm * 256 * PA_W * 2 + (size_t)(j < 3 ? C_DQ : C_DKV) * 2; u.b = B + (size_t)j * 256 * 256 * 2; return true; } };
DEVI void phase_mla_up(const Params& p, int l, LAS unsigned char* lds) {
    UpSched S; S.G = gridDim.x; S.c = opq_bid(); S.A = (const char*)p.pa; S.B = (const char*)(p.wup + (size_t)l * UPW * 256);
    EpiBf16<0> E; E.O = p.up; E.ldc = UPW;
    g8::gemm_phase(lds, PA_W, 256, 256, S, E);
}

DEVI void phase_inproj_g(const Params& p, int l, LAS unsigned char* lds) {
    const int skip = (l == DEPTH - 1);
    TileSched S; S.nM = skip ? 64 : HR / 256; S.nN = PG_W / 256; S.G = gridDim.x; S.c = opq_bid(); S.skipctx = skip;
    S.A = (const char*)p.hx; S.B = (const char*)(p.winG + (size_t)l * PG_W * DM); S.atile = (size_t)256 * DM * 2; S.btile = (size_t)256 * DM * 2; S.acol_bytes = 0;
    EpiBf16<1> E; E.O = p.pa; E.ldc = PG_W;
    g8::gemm_phase(lds, DM, DM, DM, S, E);
}

struct EpiMerge {
    static constexpr bool PERM = false; static constexpr int NSEG = 3;
    const bf16_t* pg; bf16_t* Y;
    DEVI void mid(int sg, f32x4 (&acc)[2][2][4][2], const g8::Unit& u, int wr, int wc, int fr, int fq) const {
        const int row0 = u.pm * 256 + wr * 64 + fr, col0 = u.pn * 256 + wc * 32 + 4 * fq;
        const bf16_t* gbase = pg + (size_t)row0 * PG_W + col0 + sg * 1024;
#pragma unroll
        for (int ai = 0; ai < 2; ++ai)
#pragma unroll
            for (int m = 0; m < 4; ++m) { const bf16_t* gp = gbase + (size_t)(ai * 128 + m * 16) * PG_W;
#pragma unroll
                for (int bj = 0; bj < 2; ++bj)
#pragma unroll
                    for (int n = 0; n < 2; ++n) { const int co = bj * 128 + n * 16;
                        const u32x2 a = *(const u32x2*)(gp + co), b = *(const u32x2*)(gp + 1024 + co);
                        const float a0 = __uint_as_float(a.x << 16), a1 = __uint_as_float(a.x & 0xffff0000u), a2 = __uint_as_float(a.y << 16), a3 = __uint_as_float(a.y & 0xffff0000u);
                        const float b0 = __uint_as_float(b.x << 16), b1 = __uint_as_float(b.x & 0xffff0000u), b2 = __uint_as_float(b.y << 16), b3 = __uint_as_float(b.y & 0xffff0000u);
                        f32x4& v = acc[ai][bj][m][n];
                        v[0] *= a0 * fast_rcp(fmaxf(b0, 1e-30f)); v[1] *= a1 * fast_rcp(fmaxf(b1, 1e-30f)); v[2] *= a2 * fast_rcp(fmaxf(b2, 1e-30f)); v[3] *= a3 * fast_rcp(fmaxf(b3, 1e-30f)); }
                asm volatile("" : "+v"(acc[ai][0][m][0]), "+v"(acc[ai][0][m][1]), "+v"(acc[ai][1][m][0]), "+v"(acc[ai][1][m][1]) :: "memory"); }
    }
    DEVI void operator()(f32x4 (&acc)[2][2][4][2], const g8::Unit& u, int wr, int wc, int fr, int fq) const {
        const int row0 = u.pm * 256 + wr * 64 + fr, col0 = u.pn * 256 + wc * 32 + 4 * fq;
#pragma unroll
        for (int ai = 0; ai < 2; ++ai)
#pragma unroll
            for (int m = 0; m < 4; ++m) { const bf16_t* gp = pg + (size_t)(row0 + ai * 128 + m * 16) * PG_W + col0 + 2048;
#pragma unroll
                for (int bj = 0; bj < 2; ++bj)
#pragma unroll
                    for (int n = 0; n < 2; ++n) { const int co = bj * 128 + n * 16;
                        const u32x2 a = *(const u32x2*)(gp + co);
                        const float a0 = __uint_as_float(a.x << 16), a1 = __uint_as_float(a.x & 0xffff0000u), a2 = __uint_as_float(a.y << 16), a3 = __uint_as_float(a.y & 0xffff0000u);
                        const f32x4 v = acc[ai][bj][m][n];
                        u32x2 w; w.x = cvt_pk_bf16(v[0] * a0, v[1] * a1); w.y = cvt_pk_bf16(v[2] * a2, v[3] * a3);
                        *(u32x2*)(Y + (size_t)(row0 + ai * 128 + m * 16) * DM + col0 + co) = w; }
                asm volatile("" ::: "memory"); }
    }
};
DEVI void phase_merge(const Params& p, int l, LAS unsigned char* lds) {
    const int skip = (l == DEPTH - 1);
    TileSched S; S.nM = skip ? 64 : HR / 256; S.nN = DM / 256; S.G = gridDim.x; S.c = opq_bid(); S.skipctx = skip;
    S.A = (const char*)p.ocat; S.B = (const char*)(p.wcat + (size_t)l * DM * OCW); S.atile = (size_t)256 * OCW * 2; S.btile = (size_t)256 * OCW * 2; S.acol_bytes = 0;
    EpiMerge E; E.pg = p.pa; E.Y = p.y;
    g8::gemm_phase(lds, OCW, OCW, OCW, S, E);
}

struct EpiOut {
    static constexpr bool PERM = false, HAS_MID = false; static constexpr int NSEG = 1;
    const float* x0; const float* c0; float* xo_; float* xc_; const float* modv; int l, hb;
    DEVI void operator()(const f32x4 (&acc)[2][2][4][2], const g8::Unit& u, int wr, int wc, int fr, int fq) const {
        const int row0 = u.pm * 256 + wr * 64 + fr, col0 = u.pn * 256 + wc * 32 + 4 * fq;
#pragma unroll
        for (int ai = 0; ai < 2; ++ai)
#pragma unroll
            for (int m = 0; m < 4; ++m) { const int r = hb * HR + row0 + ai * 128 + m * 16;
                const int b = r / RB, pos = r - b * RB; const bool lat = pos < SEQ;
                const size_t xoff = lat ? ((size_t)b * SEQ + pos) * DM : ((size_t)b * CTX + (pos - SEQ)) * DM;
                float* xo = (lat ? xo_ : xc_) + xoff; const float* xi = (l == 0) ? (lat ? x0 : c0) + xoff : (const float*)xo;
                const float* g1 = modv + ((size_t)l * 5 + (lat ? b : 4)) * 6144 + 2048;
#pragma unroll
                for (int bj = 0; bj < 2; ++bj)
#pragma unroll
                    for (int n = 0; n < 2; ++n) { const int c = col0 + bj * 128 + n * 16;
                        const f32x4 xv = *(const f32x4*)(xi + c), gv = *(const f32x4*)(g1 + c);
                        *(f32x4*)(xo + c) = xv + gv * acc[ai][bj][m][n]; } }
    }
};
DEVI void phase_outproj(const Params& p, int l, int hb, LAS unsigned char* lds) {
    const int skip = (l == DEPTH - 1);
    TileSched S; S.nM = skip ? 64 : HR / 256; S.nN = DM / 256; S.G = gridDim.x; S.c = opq_bid(); S.skipctx = skip;
    S.A = (const char*)p.y; S.B = (const char*)(p.wout + (size_t)l * DM * DM); S.atile = (size_t)256 * DM * 2; S.btile = (size_t)256 * DM * 2; S.acol_bytes = 0;
    EpiOut E; E.x0 = p.in[I_X]; E.c0 = p.in[I_CTX]; E.xo_ = p.out; E.xc_ = p.xc; E.modv = p.modv; E.l = l; E.hb = hb;
    g8::gemm_phase(lds, DM, DM, DM, S, E);
}

DEVI void phase_qkv(const Params& p, int l, LAS unsigned char* lds) {
    const int tid = opq_tid(), lane = tid & 63, wv = tid >> 6, h = lane >> 3, sub = lane & 7;
    LAS bf16_t* vt = (LAS bf16_t*)lds;
    const float* gq = p.in[I_GQ] + l * 96; const float* gk = p.in[I_GK] + l * 96;
    float gqn[8], gkn[8], gqr[4], gkr[4];
#pragma unroll
    for (int e = 0; e < 8; ++e) { gqn[e] = gq[sub * 8 + e]; gkn[e] = gk[sub * 8 + e]; }
#pragma unroll
    for (int e = 0; e < 4; ++e) { gqr[e] = gq[64 + sub * 4 + e]; gkr[e] = gk[64 + sub * 4 + e]; }
    const float qscale = 0.10206207261596577f * 1.4426950408889634f;
    const bool need_ctx_q = (l < DEPTH - 1);
    const bool upper = (sub & 4) != 0;
    struct QkIn { u32x2 dqw; unsigned dkw; u32x2 krw; u32x4 qnw; u32x2 qrw; u32x4 knw, vw; f32x4 cs4, sn4; };
    auto load_rows = [&](int u, QkIn (&r)[2]) {
        const int bl = u / (NCH * 4), tile = (u >> 2) % NCH, qtr = u & 3;
#pragma unroll
        for (int it = 0; it < 2; ++it) { const int pos = tile * 64 + qtr * 16 + wv * 2 + it, rl = bl * RB + pos;
            const bf16_t* prow = p.pa + (size_t)rl * PA_W; const bf16_t* urow = p.up + (size_t)rl * UPW;
            r[it].dqw = *(const u32x2*)(prow + C_DQ + lane * 4); r[it].dkw = *(const unsigned*)(prow + C_DKV + lane * 2); r[it].krw = *(const u32x2*)(prow + C_KR + sub * 4);
            r[it].qnw = *(const u32x4*)(urow + h * 96 + sub * 8); r[it].qrw = *(const u32x2*)(urow + h * 96 + 64 + sub * 4);
            r[it].knw = *(const u32x4*)(urow + 768 + h * 128 + sub * 8); r[it].vw = *(const u32x4*)(urow + 768 + h * 128 + 64 + sub * 8);
            r[it].cs4 = (f32x4){1.f, 1.f, 1.f, 1.f}; r[it].sn4 = (f32x4){0.f, 0.f, 0.f, 0.f};
            if (pos < SEQ) { const float* rt = p.rope + (size_t)pos * 32 + (sub & 3) * 4; r[it].cs4 = *(const f32x4*)rt; r[it].sn4 = *(const f32x4*)(rt + 16); } } };
    QkIn cur[2], nxt[2];
    const int nunit = 2 * NCH * 4, G = gridDim.x;
    if ((int)opq_bid() < nunit) load_rows(opq_bid(), cur);
    for (int u = opq_bid(); u < nunit; u += G) {
        const int bl = u / (NCH * 4), tile = (u >> 2) % NCH, qtr = u & 3;
        const bool more = u + G < nunit; if (more) load_rows(u + G, nxt);
#pragma unroll
        for (int it = 0; it < 2; ++it) {
            const int r16 = wv * 2 + it, rr = qtr * 16 + r16, pos = tile * 64 + rr;
            const bool lat = pos < SEQ;
            const u32x2 dqw = cur[it].dqw; const unsigned dkw = cur[it].dkw; const u32x2 krw = cur[it].krw; const u32x4 qnw = cur[it].qnw; const u32x2 qrw = cur[it].qrw;
            const u32x4 knw = cur[it].knw, vw = cur[it].vw; const f32x4 cs4 = cur[it].cs4, sn4 = cur[it].sn4;
            float sq, skv;
            { const float a0 = __uint_as_float(dqw.x << 16), a1 = __uint_as_float(dqw.x & 0xffff0000u), a2 = __uint_as_float(dqw.y << 16), a3 = __uint_as_float(dqw.y & 0xffff0000u);
              sq = a0 * a0 + a1 * a1 + a2 * a2 + a3 * a3;
              const float b0 = __uint_as_float(dkw << 16), b1 = __uint_as_float(dkw & 0xffff0000u); skv = b0 * b0 + b1 * b1; }
            sq = wave_sum(sq); skv = wave_sum(skv);
            const float rq = rsqrtf(sq * (1.0f / 256.0f) + EPSF), rkv = rsqrtf(skv * (1.0f / 128.0f) + EPSF);
            float qn[8], qr[4], kn[8], kr[4];
#pragma unroll
            for (int e = 0; e < 8; ++e) { const unsigned a = qnw[e >> 1], b = knw[e >> 1];
                qn[e] = ((e & 1) ? __uint_as_float(a & 0xffff0000u) : __uint_as_float(a << 16)) * rq;
                kn[e] = ((e & 1) ? __uint_as_float(b & 0xffff0000u) : __uint_as_float(b << 16)) * rkv; }
#pragma unroll
            for (int e = 0; e < 4; ++e) { const unsigned a = (e < 2) ? qrw.x : qrw.y, b = (e < 2) ? krw.x : krw.y;
                qr[e] = ((e & 1) ? __uint_as_float(a & 0xffff0000u) : __uint_as_float(a << 16)) * rq;
                kr[e] = ((e & 1) ? __uint_as_float(b & 0xffff0000u) : __uint_as_float(b << 16)); }
            float sqq = 0.f, skk = 0.f;
#pragma unroll
            for (int e = 0; e < 8; ++e) { sqq += qn[e] * qn[e]; skk += kn[e] * kn[e]; }
#pragma unroll
            for (int e = 0; e < 4; ++e) { sqq += qr[e] * qr[e]; skk += kr[e] * kr[e]; }
            sqq += __shfl_xor(sqq, 1); sqq += __shfl_xor(sqq, 2); sqq += __shfl_xor(sqq, 4);
            skk += __shfl_xor(skk, 1); skk += __shfl_xor(skk, 2); skk += __shfl_xor(skk, 4);
            const float rnq = rsqrtf(sqq * (1.0f / 96.0f) + EPSF) * qscale, rnk = rsqrtf(skk * (1.0f / 96.0f) + EPSF);
            float qo[12], ko[12];
#pragma unroll
            for (int e = 0; e < 8; ++e) { qo[e] = qn[e] * rnq * gqn[e]; ko[e] = kn[e] * rnk * gkn[e]; }
#pragma unroll
            for (int e = 0; e < 4; ++e) { const float a = qr[e] * rnq * gqr[e], b = kr[e] * rnk * gkr[e];
                const float pa_ = __shfl_xor(a, 4), pb_ = __shfl_xor(b, 4);
                qo[8 + e] = upper ? (a * cs4[e] + pa_ * sn4[e]) : (a * cs4[e] - pa_ * sn4[e]);
                ko[8 + e] = upper ? (b * cs4[e] + pb_ * sn4[e]) : (b * cs4[e] - pb_ * sn4[e]); }
            if (lat || need_ctx_q) {
                bf16_t* qd = lat ? p.q + (((size_t)(bl * 8 + h) * SEQ + pos) * 96) : p.qc + (((size_t)(bl * 8 + h) * CTX + (pos - SEQ)) * 96);
                u32x4 w; w.x = cvt_pk_bf16(qo[0], qo[1]); w.y = cvt_pk_bf16(qo[2], qo[3]); w.z = cvt_pk_bf16(qo[4], qo[5]); w.w = cvt_pk_bf16(qo[6], qo[7]);
                *(u32x4*)(qd + sub * 8) = w;
                u32x2 w2; w2.x = cvt_pk_bf16(qo[8], qo[9]); w2.y = cvt_pk_bf16(qo[10], qo[11]);
                *(u32x2*)(qd + 64 + sub * 4) = w2; }
            { bf16_t* kd = (bf16_t*)(p.kv + ((size_t)(bl * 8 + h) * NCH + tile) * KVT_BYTES + rr * 208);
              u32x4 w; w.x = cvt_pk_bf16(ko[0], ko[1]); w.y = cvt_pk_bf16(ko[2], ko[3]); w.z = cvt_pk_bf16(ko[4], ko[5]); w.w = cvt_pk_bf16(ko[6], ko[7]);
              *(u32x4*)(kd + sub * 8) = w;
              u32x2 w2; w2.x = cvt_pk_bf16(ko[8], ko[9]); w2.y = cvt_pk_bf16(ko[10], ko[11]);
              *(u32x2*)(kd + 64 + sub * 4) = w2; }
#pragma unroll
            for (int e = 0; e < 8; ++e) { const unsigned a = vw[e >> 1]; const float v = ((e & 1) ? __uint_as_float(a & 0xffff0000u) : __uint_as_float(a << 16)) * rkv;
                vt[(h * 64 + sub * 8 + e) * 20 + r16] = f2bf(v); }
        }
        __syncthreads();
        for (int i = tid; i < 8 * 64 * 4; i += 512) { const int hh = i >> 8, rem = i & 255, vc = rem >> 2, pc = rem & 3;
            const u32x2 w = *(const LAS u32x2*)(vt + (hh * 64 + vc) * 20 + pc * 4);
            *(u32x2*)(p.kv + ((size_t)(bl * 8 + hh) * NCH + tile) * KVT_BYTES + KT_BYTES + vc * 136 + qtr * 32 + pc * 8) = w; }
        __syncthreads();
        if (more) { cur[0] = nxt[0]; cur[1] = nxt[1]; }
    }
}

DEVI void attn_unit(const Params& p, LAS unsigned char* lds, const bf16_t* Qb, int nq, const unsigned char* kvb, int ntile, bf16_t* orow, float accinit) {
    const int tid = opq_tid(), lane = tid & 63, wv = __builtin_amdgcn_readfirstlane(tid >> 6), l31 = lane & 31, hh = lane >> 5;
    const bool active = wv * 64 < nq;
    bf16x8 qf[2][6];
#pragma unroll
    for (int qt = 0; qt < 2; ++qt)
#pragma unroll
        for (int ks = 0; ks < 6; ++ks) {
            if (active) qf[qt][ks] = *(const bf16x8*)(Qb + (size_t)(wv * 64 + qt * 32 + l31) * 96 + ks * 16 + hh * 8);
            else qf[qt][ks] = (bf16x8){0, 0, 0, 0, 0, 0, 0, 0}; }
    f32x16 O[2][2];
#pragma unroll
    for (int a = 0; a < 2; ++a)
#pragma unroll
        for (int b = 0; b < 2; ++b)
#pragma unroll
            for (int i = 0; i < 16; ++i) O[a][b][i] = 0.f;
    float lsum[2] = {0.f, 0.f};
    constexpr int STG = 2 * KVT_BYTES;
    const int nstage = ntile >> 1;
    auto stage_in = [&](int sidx, int bsel) {
        const unsigned char* g = kvb + (size_t)sidx * STG + lane * 16;
        for (int pc = wv; pc < 43; pc += 8)
            __builtin_amdgcn_global_load_lds((const unsigned*)(g + pc * 1024), (LAS unsigned*)(lds + bsel * STG + pc * 1024), 16, 0, 0);
    };
    stage_in(0, 0);
    __syncthreads();
    if (wv >= 4) __builtin_amdgcn_s_setprio(1);
    for (int sg = 0; sg < nstage; ++sg) {
        if (sg + 1 < nstage) stage_in(sg + 1, (sg + 1) & 1);
        if (active) {
#pragma unroll 1
            for (int kt = 0; kt < 4; ++kt) {
                const LAS unsigned char* kb = lds + (sg & 1) * STG + (kt >> 1) * KVT_BYTES; const LAS unsigned char* vb = kb + KT_BYTES; const int ks2 = kt & 1;
                bf16x8 kf[6];
#pragma unroll
                for (int ks = 0; ks < 6; ++ks) kf[ks] = *(const LAS bf16x8*)(kb + (ks2 * 32 + l31) * 208 + ks * 32 + hh * 16);
                bf16x8 vf[2][2];
#pragma unroll
                for (int vtile = 0; vtile < 2; ++vtile)
#pragma unroll
                    for (int s2 = 0; s2 < 2; ++s2) { const LAS unsigned char* a = vb + (vtile * 32 + l31) * 136 + (ks2 * 32 + s2 * 16 + 4 * hh) * 2;
                        const u32x2 lo = *(const LAS u32x2*)a, hi = *(const LAS u32x2*)(a + 16);
                        u32x4 w; w.x = lo.x; w.y = lo.y; w.z = hi.x; w.w = hi.y; vf[vtile][s2] = __builtin_bit_cast(bf16x8, w); }
                f32x16 S0, S1;
#pragma unroll
                for (int i = 0; i < 16; ++i) { S0[i] = accinit; S1[i] = accinit; }
#pragma unroll
                for (int ks = 0; ks < 6; ++ks) S0 = __builtin_amdgcn_mfma_f32_32x32x16_bf16(kf[ks], qf[0][ks], S0, 0, 0, 0);

#pragma unroll
                for (int ks = 0; ks < 6; ++ks) S1 = __builtin_amdgcn_mfma_f32_32x32x16_bf16(kf[ks], qf[1][ks], S1, 0, 0, 0);
                bf16x8 pb0[2], pb1[2];
                { float ls = 0.f;
#pragma unroll
                  for (int i = 0; i < 16; ++i) { S0[i] = fast_exp2(S0[i]); ls += S0[i]; }
                  lsum[0] += ls;
#pragma unroll
                  for (int s2 = 0; s2 < 2; ++s2) { u32x4 w; w.x = cvt_pk_bf16(S0[8 * s2 + 0], S0[8 * s2 + 1]); w.y = cvt_pk_bf16(S0[8 * s2 + 2], S0[8 * s2 + 3]);
                      w.z = cvt_pk_bf16(S0[8 * s2 + 4], S0[8 * s2 + 5]); w.w = cvt_pk_bf16(S0[8 * s2 + 6], S0[8 * s2 + 7]); pb0[s2] = __builtin_bit_cast(bf16x8, w); } }

#pragma unroll
                for (int s2 = 0; s2 < 2; ++s2)
#pragma unroll
                    for (int vtile = 0; vtile < 2; ++vtile) O[0][vtile] = __builtin_amdgcn_mfma_f32_32x32x16_bf16(vf[vtile][s2], pb0[s2], O[0][vtile], 0, 0, 0);
                { float ls = 0.f;
#pragma unroll
                  for (int i = 0; i < 16; ++i) { S1[i] = fast_exp2(S1[i]); ls += S1[i]; }
                  lsum[1] += ls;
#pragma unroll
                  for (int s2 = 0; s2 < 2; ++s2) { u32x4 w; w.x = cvt_pk_bf16(S1[8 * s2 + 0], S1[8 * s2 + 1]); w.y = cvt_pk_bf16(S1[8 * s2 + 2], S1[8 * s2 + 3]);
                      w.z = cvt_pk_bf16(S1[8 * s2 + 4], S1[8 * s2 + 5]); w.w = cvt_pk_bf16(S1[8 * s2 + 6], S1[8 * s2 + 7]); pb1[s2] = __builtin_bit_cast(bf16x8, w); } }

#pragma unroll
                for (int s2 = 0; s2 < 2; ++s2)
#pragma unroll
                    for (int vtile = 0; vtile < 2; ++vtile) O[1][vtile] = __builtin_amdgcn_mfma_f32_32x32x16_bf16(vf[vtile][s2], pb1[s2], O[1][vtile], 0, 0, 0);
            }
        }
        __syncthreads();
    }
    __builtin_amdgcn_s_setprio(0);
    if (active) {
#pragma unroll
        for (int qt = 0; qt < 2; ++qt) {
            const float tot = lsum[qt] + __shfl_xor(lsum[qt], 32); const float inv = 1.0f / tot;
            bf16_t* orw = orow + (size_t)(wv * 64 + qt * 32 + l31) * OCW;
#pragma unroll
            for (int vtile = 0; vtile < 2; ++vtile)
#pragma unroll
                for (int g4 = 0; g4 < 4; ++g4) { u32x2 w; w.x = cvt_pk_bf16(O[qt][vtile][4 * g4 + 0] * inv, O[qt][vtile][4 * g4 + 1] * inv);
                    w.y = cvt_pk_bf16(O[qt][vtile][4 * g4 + 2] * inv, O[qt][vtile][4 * g4 + 3] * inv);
                    *(u32x2*)(orw + vtile * 32 + 8 * g4 + 4 * hh) = w; }
        }
    }
}

DEVI float attn_offset(const Params& p, int l) {
    const int lane = opq_tid() & 63;
    const float* gq = p.in[I_GQ] + l * 96; const float* gk = p.in[I_GK] + l * 96;
    float a = fmaxf(fabsf(gq[lane]), lane < 32 ? fabsf(gq[64 + lane]) : 0.f), b = fmaxf(fabsf(gk[lane]), lane < 32 ? fabsf(gk[64 + lane]) : 0.f);
    a = wave_max(a); b = wave_max(b);
    return -(9.797958971132712f * 1.4426950408889634f * a * b * 1.001f);
}

constexpr int HGP = 72;
constexpr int ZP = 68;
constexpr int HG_ZT0 = 0, HG_ZT1 = 17408, HG_KEY0 = 34816, HG_KEY1 = 52224, HG_VT = 69632, HG_KRM0 = 78848, HG_KRM1 = 88064, HG_QRM0 = 97280, HG_QRM1 = 106496,
              HG_S2T0 = 115712, HG_S2T1 = 124928, HG_A20 = 134144, HG_A21 = 143360, HG_GT = 152576  , HG_REF = 156672  , HG_BT = 157184  ,
              HG_O = HG_ZT0  ;
DEVI bf16x8 hg_frag_tr(const LAS unsigned char* tile, int k0, int c0, int lane) {
    const unsigned g = lane >> 4, q = (lane & 15) >> 2, pp = lane & 3;
    const unsigned a0 = (unsigned)(size_t)tile + (unsigned)((k0 + 8 * g + q) * (HGP * 2) + (c0 + 4 * pp) * 2), a1 = a0 + 4 * HGP * 2;
    u32x2 r0, r1;
    asm volatile("ds_read_b64_tr_b16 %0, %2\n\tds_read_b64_tr_b16 %1, %3\n\ts_waitcnt lgkmcnt(0)" : "=&v"(r0), "=&v"(r1) : "v"(a0), "v"(a1) : "memory");
    u32x4 w; w.x = r0.x; w.y = r0.y; w.z = r1.x; w.w = r1.y; return __builtin_bit_cast(bf16x8, w);
}

DEVI int hg_pos0(int tc) { return tc < 128 ? tc * 64 : SEQ + (tc - 128) * 64; }
DEVI int hg_chain_pos(int tc, int dir) { return dir ? (NCH - 1 - tc) : (tc < 128 ? tc + 4 : tc - 128); }

struct HgIn { u32x4 q, zf, zb, v, g, sf, sb; };
template <bool PASS3> DEVI void hg_load(const Params& p, int u, HgIn& r) {
    const int tid = opq_tid(), tk = tid >> 3, pc = tid & 7; const int tc = u % NCH, h = (u / NCH) & 7, bl = u / (NCH * 8);
    const bf16_t* prow = p.pa + (size_t)(bl * RB + hg_pos0(tc) + tk) * PA_W + h * 64 + pc * 8;
    r.zf = *(const u32x4*)(prow + C_ZF); r.zb = *(const u32x4*)(prow + C_ZB); r.v = *(const u32x4*)(prow + C_I);
    if (PASS3) { r.q = *(const u32x4*)(prow + C_Q); r.g = *(const u32x4*)(prow + C_G);
        const size_t uf = ((size_t)((bl * 2 + 0) * 8 + h)) * NCH + hg_chain_pos(tc, 0), ub = ((size_t)((bl * 2 + 1) * 8 + h)) * NCH + hg_chain_pos(tc, 1);
        r.sf = *(const u32x4*)(p.st + uf * 4096 + tk * 64 + pc * 8); r.sb = *(const u32x4*)(p.st + ub * 4096 + tk * 64 + pc * 8); }
}
DEVI float bfw(const u32x4& w, int e) { const unsigned x = w[e >> 1]; return (e & 1) ? __uint_as_float(x & 0xffff0000u) : __uint_as_float(x << 16); }

template <bool PASS3> DEVI void hg_prepare(const Params& p, int l, LAS unsigned char* lds, int h, const HgIn& r) {
    const int tid = opq_tid(), tk = tid >> 3, pc = tid & 7;
    LAS float* gt = (LAS float*)(lds + HG_GT); LAS float* refv = (LAS float*)(lds + HG_REF); LAS float* btv = (LAS float*)(lds + HG_BT);
    {
#pragma unroll
        for (int dir = 0; dir < 2; ++dir) {
            LAS float* zt = (LAS float*)(lds + (dir ? HG_ZT1 : HG_ZT0)); LAS float* keyt = (LAS float*)(lds + (dir ? HG_KEY1 : HG_KEY0));
            const float* lbp = p.lbv + ((size_t)l * 2 + dir) * 512 + h * 64 + pc * 8;
            float lf[8], ky[8];
#pragma unroll
            for (int e = 0; e < 8; ++e) { const float z = bfw(dir ? r.zb : r.zf, e); const float lb = lbp[e];
                const float ez = fast_exp2(-1.44269504f * fabsf(z)), opl = 1.0f + ez, rc = fast_rcp(opl);
                const float logsig = -(fmaxf(-z, 0.f) + 0.69314718f * __builtin_amdgcn_logf(opl));
                const float sigp = (z >= 0.f) ? rc : ez * rc;
                lf[e] = (lb > 0.f) ? 0.69314718f * __builtin_amdgcn_logf(lb + (1.0f - lb) * sigp) : logsig;
                ky[e] = (1.0f - lb) * (1.0f - sigp); }
            *(LAS f32x4*)(zt + tk * ZP + pc * 8) = (f32x4){lf[0], lf[1], lf[2], lf[3]}; *(LAS f32x4*)(zt + tk * ZP + pc * 8 + 4) = (f32x4){lf[4], lf[5], lf[6], lf[7]};
            *(LAS f32x4*)(keyt + tk * ZP + pc * 8) = (f32x4){ky[0], ky[1], ky[2], ky[3]}; *(LAS f32x4*)(keyt + tk * ZP + pc * 8 + 4) = (f32x4){ky[4], ky[5], ky[6], ky[7]}; }
        *(LAS u32x4*)(lds + HG_VT + (tk * HGP + pc * 8) * 2) = r.v;
    }
    __syncthreads();
    {
        const int d = tid & 63, jg = tid >> 6; float c0[8], c1[8]; float run = 0.f;
        LAS float* zt0 = (LAS float*)(lds + HG_ZT0); LAS float* zt1 = (LAS float*)(lds + HG_ZT1);
#pragma unroll
        for (int i = 0; i < 8; ++i) { run += zt0[(jg * 8 + i) * ZP + d]; c0[i] = run; }
        gt[jg * 64 + d] = run; run = 0.f;
#pragma unroll
        for (int i = 7; i >= 0; --i) { run += zt1[(jg * 8 + i) * ZP + d]; c1[i] = run; }
        gt[512 + jg * 64 + d] = run;
        __syncthreads();
        float off0 = 0.f, off1 = 0.f;
#pragma unroll
        for (int g2 = 0; g2 < 8; ++g2) { off0 += (g2 < jg) ? gt[g2 * 64 + d] : 0.f; off1 += (g2 > jg) ? gt[512 + g2 * 64 + d] : 0.f; }
#pragma unroll
        for (int i = 0; i < 8; ++i) { zt0[(jg * 8 + i) * ZP + d] = c0[i] + off0; zt1[(jg * 8 + i) * ZP + d] = c1[i] + off1; }
        if (jg == 3) refv[d] = c0[7] + off0;
        if (jg == 7) btv[d] = c0[7] + off0;
        if (jg == 4) refv[64 + d] = c1[0] + off1;
        if (jg == 0) btv[64 + d] = c1[0] + off1;
    }
    __syncthreads();
    {
#pragma unroll
        for (int dir = 0; dir < 2; ++dir) {
            const LAS float* zt = (const LAS float*)(lds + (dir ? HG_ZT1 : HG_ZT0)); const LAS float* keyt = (const LAS float*)(lds + (dir ? HG_KEY1 : HG_KEY0));
            float kt[8], qt[8];
            const f32x4 z0 = *(const LAS f32x4*)(zt + tk * ZP + pc * 8), z1 = *(const LAS f32x4*)(zt + tk * ZP + pc * 8 + 4);
            const f32x4 k0 = *(const LAS f32x4*)(keyt + tk * ZP + pc * 8), k1 = *(const LAS f32x4*)(keyt + tk * ZP + pc * 8 + 4);
            const f32x4 r0 = *(const LAS f32x4*)(refv + dir * 64 + pc * 8), r1 = *(const LAS f32x4*)(refv + dir * 64 + pc * 8 + 4);
#pragma unroll
            for (int e = 0; e < 8; ++e) { const float bc = e < 4 ? z0[e & 3] : z1[e & 3], rf = e < 4 ? r0[e & 3] : r1[e & 3], ke = e < 4 ? k0[e & 3] : k1[e & 3];
                kt[e] = ke * fast_exp2(1.44269504f * fminf(rf - bc, 80.f)); if (PASS3) qt[e] = bfw(r.q, e) * fast_exp2(1.44269504f * fminf(bc - rf, 80.f)); }
            { u32x4 w; w.x = cvt_pk_bf16(kt[0], kt[1]); w.y = cvt_pk_bf16(kt[2], kt[3]); w.z = cvt_pk_bf16(kt[4], kt[5]); w.w = cvt_pk_bf16(kt[6], kt[7]);
              *(LAS u32x4*)(lds + (dir ? HG_KRM1 : HG_KRM0) + (tk * HGP + pc * 8) * 2) = w; }
            if (PASS3) {
                u32x4 w; w.x = cvt_pk_bf16(qt[0], qt[1]); w.y = cvt_pk_bf16(qt[2], qt[3]); w.z = cvt_pk_bf16(qt[4], qt[5]); w.w = cvt_pk_bf16(qt[6], qt[7]);
                *(LAS u32x4*)(lds + (dir ? HG_QRM1 : HG_QRM0) + (tk * HGP + pc * 8) * 2) = w;
                const float er = fast_exp2(1.44269504f * refv[dir * 64 + tk]); float sv[8];
#pragma unroll
                for (int e = 0; e < 8; ++e) sv[e] = bfw(dir ? r.sb : r.sf, e) * er;
                w.x = cvt_pk_bf16(sv[0], sv[1]); w.y = cvt_pk_bf16(sv[2], sv[3]); w.z = cvt_pk_bf16(sv[4], sv[5]); w.w = cvt_pk_bf16(sv[6], sv[7]);
                *(LAS u32x4*)(lds + (dir ? HG_S2T1 : HG_S2T0) + (tk * HGP + pc * 8) * 2) = w;
            }
        }
    }
    __syncthreads();
}
DEVI bf16x8 hg_frag(const LAS unsigned char* base, int r, int c0) { return *(const LAS bf16x8*)(base + (size_t)(r * HGP + c0) * 2); }

DEVI void hg_pass1_unit(const Params& p, int l, LAS unsigned char* lds, int u, const HgIn& r) {
    const int tc = u % NCH, h = (u / NCH) & 7, bl = u / (NCH * 8);
    hg_prepare<false>(p, l, lds, h, r);
    const int tid = opq_tid(), lane = tid & 63, wv = tid >> 6, l15 = lane & 15, g = lane >> 4;
    const LAS float* refv = (const LAS float*)(lds + HG_REF); const LAS float* btv = (const LAS float*)(lds + HG_BT);
    const int dt = wv >> 1, ct0 = (wv & 1) * 2;
#pragma unroll
    for (int dir = 0; dir < 2; ++dir) {
        const size_t unit = ((size_t)((bl * 2 + dir) * 8 + h)) * NCH + hg_chain_pos(tc, dir);
        bf16_t* so = p.st + unit * 4096;
        const LAS unsigned char* krm = lds + (dir ? HG_KRM1 : HG_KRM0);
        bf16x8 af[2];
#pragma unroll
        for (int ks = 0; ks < 2; ++ks) af[ks] = hg_frag_tr(krm, 32 * ks, 16 * dt, lane);
#pragma unroll
        for (int ci = 0; ci < 2; ++ci) { const int ct = ct0 + ci; f32x4 acc = {0.f, 0.f, 0.f, 0.f};
#pragma unroll
            for (int ks = 0; ks < 2; ++ks) acc = __builtin_amdgcn_mfma_f32_16x16x32_bf16(af[ks], hg_frag_tr(lds + HG_VT, 32 * ks, 16 * ct, lane), acc, 0, 0, 0);
#pragma unroll
            for (int rr = 0; rr < 4; ++rr) { const int d = 16 * dt + 4 * g + rr; so[d * 64 + 16 * ct + l15] = f2bf(acc[rr] * fast_exp2(1.44269504f * (btv[dir * 64 + d] - refv[dir * 64 + d]))); } }
        if (tid < 64) p.stb[unit * 64 + tid] = btv[dir * 64 + tid];
    }
    __syncthreads();
}

DEVI void hg_pass3_unit(const Params& p, int l, LAS unsigned char* lds, int u, const HgIn& r) {
    const int tc = u % NCH, h = (u / NCH) & 7, bl = u / (NCH * 8);
    const int tid = opq_tid(), lane = tid & 63, wv = tid >> 6, l15 = lane & 15, g = lane >> 4;
    hg_prepare<true>(p, l, lds, h, r);
    { const int tt = wv >> 1, st0 = (wv & 1) * 2;
#pragma unroll
      for (int dir = 0; dir < 2; ++dir) {
          const LAS unsigned char* qrm = lds + (dir ? HG_QRM1 : HG_QRM0); const LAS unsigned char* krm = lds + (dir ? HG_KRM1 : HG_KRM0); LAS bf16_t* a2 = (LAS bf16_t*)(lds + (dir ? HG_A21 : HG_A20));
          bf16x8 bq[2];
#pragma unroll
          for (int ks = 0; ks < 2; ++ks) bq[ks] = hg_frag(qrm, 16 * tt + l15, 32 * ks + 8 * g);
#pragma unroll
          for (int si = 0; si < 2; ++si) { const int st = st0 + si; f32x4 acc = {0.f, 0.f, 0.f, 0.f};
#pragma unroll
              for (int ks = 0; ks < 2; ++ks) acc = __builtin_amdgcn_mfma_f32_16x16x32_bf16(hg_frag(krm, 16 * st + l15, 32 * ks + 8 * g), bq[ks], acc, 0, 0, 0);
              const int t = 16 * tt + l15, s0 = 16 * st + 4 * g; float v[4];
#pragma unroll
              for (int e = 0; e < 4; ++e) v[e] = (dir == 0 ? (s0 + e <= t) : (s0 + e >= t)) ? acc[e] : 0.f;
              u32x2 w; w.x = cvt_pk_bf16(v[0], v[1]); w.y = cvt_pk_bf16(v[2], v[3]);
              *(LAS u32x2*)(a2 + t * HGP + s0) = w; } } }
    __syncthreads();
    { const int tt = wv >> 1, ct0 = (wv & 1) * 2; LAS float* olds = (LAS float*)(lds + HG_O);
      f32x4 acc[2] = {{0.f, 0.f, 0.f, 0.f}, {0.f, 0.f, 0.f, 0.f}};
#pragma unroll
      for (int dir = 0; dir < 2; ++dir) {
          const LAS unsigned char* qrm = lds + (dir ? HG_QRM1 : HG_QRM0); const LAS unsigned char* a2 = lds + (dir ? HG_A21 : HG_A20); const LAS unsigned char* s2t = lds + (dir ? HG_S2T1 : HG_S2T0);
          bf16x8 aa[2], aq[2];
#pragma unroll
          for (int ks = 0; ks < 2; ++ks) { aa[ks] = hg_frag(a2, 16 * tt + l15, 32 * ks + 8 * g); aq[ks] = hg_frag(qrm, 16 * tt + l15, 32 * ks + 8 * g); }
#pragma unroll
          for (int ci = 0; ci < 2; ++ci) { const int ct = ct0 + ci;
#pragma unroll
              for (int ks = 0; ks < 2; ++ks) acc[ci] = __builtin_amdgcn_mfma_f32_16x16x32_bf16(aa[ks], hg_frag_tr(lds + HG_VT, 32 * ks, 16 * ct, lane), acc[ci], 0, 0, 0);
#pragma unroll
              for (int ks = 0; ks < 2; ++ks) acc[ci] = __builtin_amdgcn_mfma_f32_16x16x32_bf16(aq[ks], hg_frag_tr(s2t, 32 * ks, 16 * ct, lane), acc[ci], 0, 0, 0); } }
#pragma unroll
      for (int ci = 0; ci < 2; ++ci)
#pragma unroll
          for (int rr = 0; rr < 4; ++rr) olds[(16 * tt + 4 * g + rr) * 65 + 16 * (ct0 + ci) + l15] = acc[ci][rr]; }
    __syncthreads();
    { const int tok = tid >> 3, pc = tid & 7; const int row = bl * RB + hg_pos0(tc) + tok; const LAS float* olds = (const LAS float*)(lds + HG_O);
      float o[8]; float ss = 0.f;
#pragma unroll
      for (int e = 0; e < 8; ++e) { o[e] = olds[tok * 65 + pc * 8 + e]; ss += o[e] * o[e]; }
      ss += __shfl_xor(ss, 1); ss += __shfl_xor(ss, 2); ss += __shfl_xor(ss, 4);
      const float rstd = rsqrtf(ss * (1.0f / 64.0f) + EPSF);
      const float* gn = p.in[I_HGNORM] + l * 64 + pc * 8;
      float rr[8];
#pragma unroll
      for (int e = 0; e < 8; ++e) rr[e] = o[e] * rstd * gn[e] * sigmoidf_(bfw(r.g, e));
      u32x4 w; w.x = cvt_pk_bf16(rr[0], rr[1]); w.y = cvt_pk_bf16(rr[2], rr[3]); w.z = cvt_pk_bf16(rr[4], rr[5]); w.w = cvt_pk_bf16(rr[6], rr[7]);
      *(u32x4*)(p.ocat + (size_t)row * OCW + h * 64 + pc * 8) = w; }
    __syncthreads();
}

DEVI void hg_prefix(const Params& p, bool dry = false) {
    const int total = 2 * 2 * 8 * 4096;
    for (int gidx = opq_bid() * 512 + opq_tid(); gidx < total; gidx += gridDim.x * 512) {
        const int chain = gidx >> 12, e = gidx & 4095, d = e >> 6;
        bf16_t* s = p.st + (size_t)chain * NCH * 4096 + e; const float* bt = p.stb + (size_t)chain * NCH * 64 + d;
        float S = 0.f;
#pragma unroll 1
        for (int q0 = 0; q0 < NCH; q0 += 12) { float loc[12], b[12];
#pragma unroll
            for (int i = 0; i < 12; ++i) { loc[i] = bf2f(s[(size_t)(q0 + i) * 4096]); b[i] = bt[(q0 + i) * 64]; }
#pragma unroll
            for (int i = 0; i < 12; ++i) { if (!dry) s[(size_t)(q0 + i) * 4096] = f2bf(S); S = S * fast_exp2(1.44269504f * b[i]) + loc[i]; } }
        if (dry && S == 123.456f) s[0] = 0;
    }
}

constexpr int LR_UB = 0, LR_UP = 520, LR_AF = 16640, LR_IF = LR_AF + 32768, LR_AB = LR_IF + 32768, LR_IB = LR_AB + 32768;
constexpr int NT16 = RB / 16;

DEVI int lr_pos0(int tt) { return tt * 16; }
DEVI int lr_chain_pos(int tt, int dir) { return dir ? (NT16 - 1 - tt) : (tt < 512 ? tt + 16 : tt - 512); }

struct LruW { bf16x8 b[2][4][2]; float ba[4], bx[4], la[4]; };
DEVI void lru_load_w(const Params& p, int l, int dir, int n, int l15, int g, LruW& w) {
#pragma unroll
    for (int which = 0; which < 2; ++which)
#pragma unroll
        for (int ct = 0; ct < 4; ++ct)
#pragma unroll
            for (int ks = 0; ks < 2; ++ks)
                w.b[which][ct][ks] = *(const bf16x8*)(p.wlru + ((((size_t)(l * 2 + dir) * 8 + n) * 2 + which) * 64 + 16 * ct + l15) * 64 + 32 * ks + 8 * g);
#pragma unroll
    for (int ct = 0; ct < 4; ++ct) { const int c = (l * 2 + dir) * 512 + n * 64 + 16 * ct + l15;
        w.ba[ct] = p.in[I_LBA][c]; w.bx[ct] = p.in[I_LBX][c]; w.la[ct] = p.lrula[c]; }
}
struct LrIn { bf16_t x[19]; bf16_t y[16]; float h_in; };
template <int MODE> DEVI void lru_load(const Params& p, int u, LrIn& r) {
    const int bl = u / NT16, tt = u % NT16, c = opq_tid();
    const int pos0 = tt * 16, seg0 = tt < 512 ? 0 : SEQ, seg1 = tt < 512 ? SEQ : RB;
    const bf16_t* xx = p.pa + (size_t)bl * RB * PA_W + C_LX + c;
#pragma unroll
    for (int i = 0; i < 19; ++i) { const int pos = pos0 - 2 + i; r.x[i] = (pos >= seg0 && pos < seg1) ? xx[(size_t)pos * PA_W] : (bf16_t)0; }
    if (MODE == 2) { const bf16_t* yy = p.pa + ((size_t)bl * RB + pos0) * PA_W + C_LY + c;
#pragma unroll
        for (int t = 0; t < 16; ++t) r.y[t] = yy[(size_t)t * PA_W]; }
    if (MODE == 1) r.h_in = p.lin[((size_t)(bl * 2 + 0) * NT16 + lr_chain_pos(tt, 0)) * 512 + c];
    if (MODE == 2) r.h_in = p.lin[((size_t)(bl * 2 + 1) * NT16 + lr_chain_pos(tt, 1)) * 512 + c];
}
#define LR_WAVE_SYNC() do { asm volatile("s_waitcnt lgkmcnt(0)" ::: "memory"); __builtin_amdgcn_wave_barrier(); } while (0)
DEVI void lru_tile_gates(const Params& p, int l, LAS unsigned char* lds, const LrIn& in, const LruW& w) {
    const int tid = opq_tid(), lane = tid & 63, n = tid >> 6, l15 = lane & 15, g = lane >> 4;
    LAS bf16_t* ub = (LAS bf16_t*)(lds + LR_UB);
    {
        const int c = tid;
        const float* cw = p.in[I_CONVW] + (size_t)l * 4 * 512; const float w0 = cw[c], w1 = cw[512 + c], w2 = cw[1024 + c], w3 = cw[1536 + c], cb = p.in[I_CONVB][l * 512 + c];
        float x[19];
#pragma unroll
        for (int i = 0; i < 19; ++i) x[i] = bf2f(in.x[i]);
#pragma unroll
        for (int t = 0; t < 16; ++t) ub[t * LR_UP + c] = f2bf(cb + w0 * x[t] + w1 * x[t + 1] + w2 * x[t + 2] + w3 * x[t + 3]);
    }
    LR_WAVE_SYNC();
    bf16x8 af[2];
#pragma unroll
    for (int ks = 0; ks < 2; ++ks) af[ks] = *(const LAS bf16x8*)(ub + l15 * LR_UP + n * 64 + 32 * ks + 8 * g);
    LAS float* aL = (LAS float*)(lds + LR_AF); LAS float* iL = (LAS float*)(lds + LR_IF);
#pragma unroll
    for (int ct = 0; ct < 4; ++ct) {
        f32x4 ra = {0.f, 0.f, 0.f, 0.f}, xa = {0.f, 0.f, 0.f, 0.f};
#pragma unroll
        for (int ks = 0; ks < 2; ++ks) { ra = __builtin_amdgcn_mfma_f32_16x16x32_bf16(af[ks], w.b[0][ct][ks], ra, 0, 0, 0); xa = __builtin_amdgcn_mfma_f32_16x16x32_bf16(af[ks], w.b[1][ct][ks], xa, 0, 0, 0); }
        const int c = n * 64 + 16 * ct + l15;
#pragma unroll
        for (int r = 0; r < 4; ++r) { const int t = 4 * g + r;
            const float rg = sigmoidf_(ra[r] + w.ba[ct]), ig = sigmoidf_(xa[r] + w.bx[ct]);
            const float a = fast_exp2(rg * w.la[ct]); const float uu = bf2f(ub[t * LR_UP + c]);
            aL[t * 512 + c] = a; iL[t * 512 + c] = __builtin_amdgcn_sqrtf(fmaxf(1.0f - a * a, 0.f)) * ig * uu; }
    }
    LR_WAVE_SYNC();
}
template <int MODE> DEVI void lru_sweep(const Params& p, int l, LAS unsigned char* lds, int dir, int u0, int uend, int ubase, bool skipc) {
    const int tid = opq_tid(), lane = tid & 63, n = tid >> 6, l15 = lane & 15, g = lane >> 4, G = gridDim.x;
    if (u0 >= uend) return;
    LruW w; lru_load_w(p, l, dir, n, l15, g, w);
    const LAS float* aL = (const LAS float*)(lds + LR_AF); const LAS float* iL = (const LAS float*)(lds + LR_IF);
    LrIn cur, nxt; lru_load<MODE>(p, u0 - ubase, cur);
    for (int u = u0; u < uend; u += G) {
        const bool more = u + G < uend; if (more) lru_load<MODE>(p, u + G - ubase, nxt);
        const int uu = u - ubase, bl = uu / NT16, tt = uu % NT16;
        if (!(skipc && tt >= 512)) {
            lru_tile_gates(p, l, lds, cur, w);
            if (MODE == 0) { float A = 1.f, H = 0.f;
#pragma unroll
                for (int t = 0; t < 16; ++t) { const float a = aL[t * 512 + tid], b = iL[t * 512 + tid]; if (dir == 0) { H = a * H + b; A *= a; } else { H += b * A; A *= a; } }
                *((f32x2_t*)p.lsum + ((size_t)(bl * 2 + dir) * NT16 + lr_chain_pos(tt, dir)) * 512 + tid) = (f32x2_t){A, H};
            } else { bf16_t* ocol = p.ocat + ((size_t)bl * RB + lr_pos0(tt)) * OCW + 1024 + tid; float h = cur.h_in;
                if (MODE == 1) {
#pragma unroll
                    for (int t = 0; t < 16; ++t) { h = aL[t * 512 + tid] * h + iL[t * 512 + tid]; ocol[(size_t)t * OCW] = f2bf(h); }
                } else {
                    float hfv[16];
#pragma unroll
                    for (int t = 0; t < 16; ++t) hfv[t] = bf2f(ocol[(size_t)t * OCW]);
#pragma unroll
                    for (int t = 15; t >= 0; --t) { h = aL[t * 512 + tid] * h + iL[t * 512 + tid];
                        const float y = bf2f(cur.y[t]); const float x3 = 0.7978845608028654f * (y + 0.044715f * y * y * y);
                        const float th = 1.0f - 2.0f * fast_rcp(1.0f + fast_exp2(2.88539008f * x3));
                        ocol[(size_t)t * OCW] = f2bf((hfv[t] + h) * 0.5f * y * (1.0f + th)); } }
            }
            LR_WAVE_SYNC();
        }
        if (more) cur = nxt;
    }
}
DEVI void lru_prefix(const Params& p, bool dry = false) {
    const int lane = opq_tid() & 63, wv = opq_tid() >> 6;
    for (int chain = opq_bid() * 8 + wv; chain < 2 * 2 * 512; chain += gridDim.x * 8) {
        const int c = chain & 511, bd = chain >> 9;
        const f32x2_t* src = (const f32x2_t*)p.lsum + (size_t)bd * NT16 * 512 + c; float* dst = p.lin + (size_t)bd * NT16 * 512 + c;
        f32x2_t v[9]; float A = 1.f, H = 0.f;
#pragma unroll
        for (int i = 0; i < 9; ++i) { const int q = lane * 9 + i; v[i] = (q < NT16) ? src[(size_t)q * 512] : (f32x2_t){1.f, 0.f}; H = v[i].x * H + v[i].y; A *= v[i].x; }
#pragma unroll
        for (int o = 1; o < 64; o <<= 1) { const float Ap = __shfl_up(A, o), Hp = __shfl_up(H, o); if (lane >= o) { H = A * Hp + H; A = A * Ap; } }
        float h = __shfl_up(H, 1); if (lane == 0) h = 0.f;
#pragma unroll
        for (int i = 0; i < 9; ++i) { const int q = lane * 9 + i; if (q < NT16 && !dry) dst[(size_t)q * 512] = h; h = v[i].x * h + v[i].y; }
        if (dry && h == 123.456f) dst[0] = 0.f;
    }
}
DEVI void phase_attn_scan1(const Params& p, int l, LAS unsigned char* lds, int parts = 7) {
    const int nA = 2 * 8 * 16 + (l == 0 ? 16 : 0), nH = 2 * 8 * NCH, nL = 2 * NT16, G = gridDim.x;
    const float accinit = attn_offset(p, l);
    int u = opq_bid();
    for (; u < 256; u += G) { const int bl = u >> 7, h = (u >> 4) & 7, qb = u & 15; if (!(parts & 1)) continue;
        attn_unit(p, lds, p.q + ((size_t)(bl * 8 + h) * SEQ + qb * 512) * 96, 512, p.kv + (size_t)(bl * 8 + h) * NCH * KVT_BYTES, NCH,
                  p.ocat + (size_t)(bl * RB + qb * 512) * OCW + 512 + h * 64, accinit); }
    for (; u < nA; u += G) { const int uu = u - 256, bl = uu >> 3, h = uu & 7; if (!(parts & 1)) continue;
        attn_unit(p, lds, p.qc + ((size_t)(bl * 8 + h) * CTX) * 96, 256, p.kv + ((size_t)(bl * 8 + h) * NCH + 128) * KVT_BYTES, 4,
                  p.ocat + (size_t)(bl * RB + SEQ) * OCW + 512 + h * 64, accinit); }
    if (parts & 2) { HgIn cur, nxt; if (u < nA + nH) hg_load<false>(p, u - nA, cur);
        for (; u < nA + nH; u += G) { const bool more = u + G < nA + nH; if (more) hg_load<false>(p, u + G - nA, nxt); hg_pass1_unit(p, l, lds, u - nA, cur); if (more) cur = nxt; } }
    else { for (; u < nA + nH; u += G) {} }
    if (parts & 4) { lru_sweep<0>(p, l, lds, 0, u, nA + nH + nL, nA + nH, false); lru_sweep<0>(p, l, lds, 1, u, nA + nH + nL, nA + nH, false); }
}
DEVI void phase_prefix(const Params& p, LAS unsigned char* lds, bool dry = false) { (void)lds; hg_prefix(p, dry); lru_prefix(p, dry); }
DEVI void phase_scan3(const Params& p, int l, LAS unsigned char* lds, int parts = 3) {
    const int nH = 2 * 8 * NCH, nL = 2 * NT16, G = gridDim.x; const bool skipc = (l == DEPTH - 1);
    int u = opq_bid();
    if (parts & 1) { HgIn cur, nxt; if (u < nH) hg_load<true>(p, u, cur);
        for (; u < nH; u += G) { const bool more = u + G < nH; if (more) hg_load<true>(p, u + G, nxt);
            if (!(skipc && (u % NCH) >= 128)) hg_pass3_unit(p, l, lds, u, cur);
            if (more) cur = nxt; } }
    else { for (; u < nH; u += G) {} }
    if (parts & 2) { lru_sweep<1>(p, l, lds, 0, u, nH + nL, nH, skipc); lru_sweep<2>(p, l, lds, 1, u, nH + nL, nH, skipc); }
}

constexpr int RP = 2 * TT + 4096;

DEVI void phase_norm2_route(const Params& p, int l, LAS unsigned char* lds) {
    const int tid = opq_tid(), lane = tid & 63, wv = tid >> 6; const bool skipc = (l == DEPTH - 1);
    LAS int* cntl = (LAS int*)lds;
    LAS int* basel = cntl + 16;
    LAS int* rinfo = cntl + 64;
    LAS float* rw = (LAS float*)(rinfo + 4 * 8 * 20);
    if (tid < 16) cntl[tid] = 0;
    __syncthreads();
    const float* gm = p.in[I_NFFN] + l * DM;
    const float* wrg = p.in[I_WRG] + (size_t)l * DM * 4; const float* wre = p.in[I_WRE] + (size_t)l * DM * 16;
    int it = 0;
    for (int r = opq_bid() * 8 + wv; r < TT; r += gridDim.x * 8, ++it) {
        const int pos = r % RB; const bool skip = skipc && pos >= SEQ;
        if (skip) { if (lane == 0) rinfo[(it * 8 + wv) * 4] = -1; continue; }
        const float* src = xbuf_row(p, r);
        f32x4 v[4]; float ss = 0.f;
#pragma unroll
        for (int i = 0; i < 4; ++i) { v[i] = *(const f32x4*)(src + i * 256 + lane * 4); ss += v[i][0] * v[i][0] + v[i][1] * v[i][1] + v[i][2] * v[i][2] + v[i][3] * v[i][3]; }
        ss = wave_sum(ss);
        const float rstd = rsqrtf(ss * (1.0f / DM) + EPSF);
        const float* mv = p.modv + ((size_t)l * 5 + mod_row(r)) * 6144;
        f32x4 lg = {0.f, 0.f, 0.f, 0.f}, le0 = lg, le1 = lg, le2 = lg, le3 = lg;
#pragma unroll
        for (int i = 0; i < 4; ++i) { const int c = i * 256 + lane * 4;
            const f32x4 g = *(const f32x4*)(gm + c), sh = *(const f32x4*)(mv + 3072 + c), sc = *(const f32x4*)(mv + 4096 + c);
            f32x4 h;
#pragma unroll
            for (int e = 0; e < 4; ++e) h[e] = v[i][e] * rstd * g[e] * (1.0f + sc[e]) + sh[e];
            u32x2 w; w.x = cvt_pk_bf16(h[0], h[1]); w.y = cvt_pk_bf16(h[2], h[3]);
            *(u32x2*)(p.h2 + (size_t)r * DM + c) = w;
#pragma unroll
            for (int e = 0; e < 4; ++e) { const float* wr_ = wre + (size_t)(c + e) * 16;
                lg += h[e] * *(const f32x4*)(wrg + (size_t)(c + e) * 4);
                le0 += h[e] * *(const f32x4*)(wr_); le1 += h[e] * *(const f32x4*)(wr_ + 4); le2 += h[e] * *(const f32x4*)(wr_ + 8); le3 += h[e] * *(const f32x4*)(wr_ + 12); } }
#pragma unroll
        for (int e = 0; e < 4; ++e) { lg[e] = wave_sum(lg[e]); le0[e] = wave_sum(le0[e]); le1[e] = wave_sum(le1[e]); le2[e] = wave_sum(le2[e]); le3[e] = wave_sum(le3[e]); }
        if (lane == 0) {
            const float* brg = p.in[I_BRG] + l * 4; const float* bre = p.in[I_BRE] + l * 16;
            int gs = 0; float best = lg[0] + brg[0];
#pragma unroll
            for (int e = 1; e < 4; ++e) { const float t = lg[e] + brg[e]; if (t > best) { best = t; gs = e; } }
            const float m = fmaxf(fmaxf(lg[0], lg[1]), fmaxf(lg[2], lg[3]));
            const float e0 = __expf(lg[0] - m), e1 = __expf(lg[1] - m), e2 = __expf(lg[2] - m), e3 = __expf(lg[3] - m);
            const float pg = (gs == 0 ? e0 : gs == 1 ? e1 : gs == 2 ? e2 : e3) / (e0 + e1 + e2 + e3);
            const f32x4 lv = (gs == 0) ? le0 : (gs == 1) ? le1 : (gs == 2) ? le2 : le3;
            const f32x4 bv = lv + *(const f32x4*)(bre + gs * 4);
            int i0 = 0; float m0 = bv[0], l0 = lv[0];
#pragma unroll
            for (int e = 1; e < 4; ++e) if (bv[e] > m0) { m0 = bv[e]; i0 = e; l0 = lv[e]; }
            int i1 = -1; float m1 = -3.0e38f, l1 = 0.f;
#pragma unroll
            for (int e = 0; e < 4; ++e) if (e != i0 && bv[e] > m1) { m1 = bv[e]; i1 = e; l1 = lv[e]; }
            const float mm = fmaxf(l0, l1), x0 = __expf(l0 - mm), x1 = __expf(l1 - mm);
            const float w0 = x0 / (x0 + x1) * pg, w1 = x1 / (x0 + x1) * pg;
            const int ea = gs * 4 + i0, eb = gs * 4 + i1;
            const int sa = __hip_atomic_fetch_add(&cntl[ea], 1, __ATOMIC_RELAXED, __HIP_MEMORY_SCOPE_WORKGROUP), sb = __hip_atomic_fetch_add(&cntl[eb], 1, __ATOMIC_RELAXED, __HIP_MEMORY_SCOPE_WORKGROUP);
            const int q = (it * 8 + wv) * 4; rinfo[q] = ea; rinfo[q + 1] = eb; rinfo[q + 2] = sa; rinfo[q + 3] = sb;
            rw[(it * 8 + wv) * 2] = w0; rw[(it * 8 + wv) * 2 + 1] = w1;
        }
    }
    __syncthreads();
    if (tid < 16) basel[tid] = (int)atomicAdd(&p.ctrl[CTRL_CNT(l) + tid], (unsigned)cntl[tid]);
    __syncthreads();
    it = 0;
    for (int r = opq_bid() * 8 + wv; r < TT; r += gridDim.x * 8, ++it) {
        if (lane == 0) { const int q = (it * 8 + wv) * 4; const int ea = rinfo[q];
            if (ea >= 0) { const int eb = rinfo[q + 1], sa = basel[ea] + rinfo[q + 2], sb = basel[eb] + rinfo[q + 3];
                p.tok_e[r * 2] = ea; p.tok_e[r * 2 + 1] = eb; p.tok_s[r * 2] = sa; p.tok_s[r * 2 + 1] = sb;
                p.lst[(size_t)ea * TT + sa] = r; p.lst[(size_t)eb * TT + sb] = r; p.tok_w[(size_t)ea * TT + sa] = rw[(it * 8 + wv) * 2]; p.tok_w[(size_t)eb * TT + sb] = rw[(it * 8 + wv) * 2 + 1]; } }
    }
    __syncthreads();
}

DEVI void moe_offsets(const Params& p, int l, LAS int* offs) {
    if (opq_tid() == 0) { int o = 0;
        for (int e = 0; e < NEXP; ++e) { offs[e] = o; const int c = (int)__hip_atomic_load(&p.ctrl[CTRL_CNT(l) + e], __ATOMIC_RELAXED, __HIP_MEMORY_SCOPE_AGENT); offs[32 + e] = c; o += (c + 255) & ~255; }
        offs[NEXP] = o; }
    __syncthreads();
}
DEVI int moe_expert_of(const LAS int* offs, int row) { int e = 0;
#pragma unroll
    for (int q = 1; q < NEXP; ++q) e += (row >= offs[q]) ? 1 : 0;
    return e; }

DEVI void phase_moe_permute(const Params& p, int l, const LAS int* offs) {
    const int lane = opq_tid() & 63, wv = opq_tid() >> 6; const int R = offs[NEXP];
    for (int pr = opq_bid() * 8 + wv; pr < R; pr += gridDim.x * 8) {
        const int e = moe_expert_of(offs, pr), s = pr - offs[e]; const bool valid = s < offs[32 + e];
        u32x4 a = {0u, 0u, 0u, 0u}, b = {0u, 0u, 0u, 0u}; int r = 0; float w = 0.f;
        const int vz = vzero();
        if (valid) { r = p.lst[(size_t)e * TT + s + vz]; w = p.tok_w[(size_t)e * TT + s + vz];
            const u32x4* src = (const u32x4*)(p.h2 + (size_t)r * DM); a = src[lane]; b = src[64 + lane]; }
        u32x4* dst = (u32x4*)(p.h2p + (size_t)pr * DM); dst[lane] = a; dst[64 + lane] = b;
        if (lane == 0) { p.rww[pr] = w; p.rmr[pr] = valid ? mod_row(r) : 0; }
    }
}

template <bool GATH> struct MoeSched { static constexpr bool GATHER = GATH; const int* lst; int cnt[NEXP]; int G, c, nN; int o[NEXP + 1]; const char* A; const char* B; size_t atile, bexp, btile;
    DEVI void load(const LAS int* offs) {
#pragma unroll
        for (int q = 0; q <= NEXP; ++q) o[q] = __builtin_amdgcn_readfirstlane(offs[q]);
#pragma unroll
        for (int q = 0; q < NEXP; ++q) cnt[q] = __builtin_amdgcn_readfirstlane(offs[32 + q]); }
    DEVI int row_of(const g8::Unit& u, int r) const { int base = 0, n = 0;
#pragma unroll
        for (int q = 0; q < NEXP; ++q) { base = (u.tag == q) ? o[q] : base; n = (u.tag == q) ? cnt[q] : n; }
        const int s2 = u.pm * 256 + r - base; return (s2 < n) ? lst[(size_t)u.tag * TT + s2] : 0; }
    DEVI bool next(int i, g8::Unit& u) const { const long L = (long)i * G + c; const int R = o[NEXP]; if (L >= (long)(R / 256) * nN) return false;
        const int ti = (int)(L / nN), pn = (int)(L % nN); int e = 0;
#pragma unroll
        for (int q = 1; q < NEXP; ++q) e += (ti * 256 >= o[q]) ? 1 : 0;
        u.pm = ti; u.pn = pn; u.tag = e; u.a = A + (size_t)ti * atile; u.b = B + (size_t)e * bexp + (size_t)pn * btile; return true; } };
struct EpiSwiglu {
    static constexpr bool PERM = false, HAS_MID = false; static constexpr int NSEG = 1;
    bf16_t* hid;
    DEVI void operator()(const f32x4 (&acc)[2][2][4][2], const g8::Unit& u, int wr, int wc, int fr, int fq) const {
        const int row0 = u.pm * 256 + wr * 64 + fr, col0 = u.pn * 128 + wc * 32 + 4 * fq;
#pragma unroll
        for (int ai = 0; ai < 2; ++ai)
#pragma unroll
            for (int m = 0; m < 4; ++m)
#pragma unroll
                for (int n = 0; n < 2; ++n) { const f32x4 a = acc[ai][0][m][n], b = acc[ai][1][m][n]; float h[4];
#pragma unroll
                    for (int e = 0; e < 4; ++e) h[e] = a[e] * sigmoidf_(a[e]) * b[e];
                    u32x2 w; w.x = cvt_pk_bf16(h[0], h[1]); w.y = cvt_pk_bf16(h[2], h[3]);
                    *(u32x2*)(hid + (size_t)(row0 + ai * 128 + m * 16) * DEXP + col0 + n * 16) = w; }
    }
};
DEVI void phase_moe_up(const Params& p, int l, const LAS int* offs, LAS unsigned char* lds) {
    MoeSched<true> S; S.lst = p.lst; S.G = gridDim.x; S.c = opq_bid(); S.nN = 2; S.load(offs); S.A = (const char*)p.h2; S.B = (const char*)(p.w13 + (size_t)l * NEXP * 512 * DM);
    S.atile = 0; S.bexp = (size_t)512 * DM * 2; S.btile = (size_t)256 * DM * 2;
    EpiSwiglu E; E.hid = p.hid;
    g8::gemm_phase(lds, DM, DM, DM, S, E);
}
struct EpiDown {
    static constexpr bool PERM = true, HAS_MID = false; static constexpr int NSEG = 1;
    bf16_t* yo; const float* tokw; const int* lst; const LAS int* offs; const float* g2base;
    DEVI void operator()(const f32x4 (&acc)[2][2][4][2], const g8::Unit& u, int wr, int wc, int fr, int fq) const {
        const int row0 = u.pm * 256 + wr * 64 + fr, col0 = u.pn * 256 + wc * 32 + 8 * fq;
#pragma unroll
        for (int ai = 0; ai < 2; ++ai)
#pragma unroll
            for (int m = 0; m < 4; ++m) { const int row = row0 + ai * 128 + m * 16; const int e = u.tag, s2 = row - offs[e]; const bool valid = s2 < offs[32 + e];
                const float w = valid ? tokw[(size_t)e * TT + s2] : 0.f; const int mr = valid ? mod_row(lst[(size_t)e * TT + s2]) : 0; const float* g2 = g2base + (size_t)mr * 6144 + col0;
#pragma unroll
                for (int bj = 0; bj < 2; ++bj) { const f32x4 ga = *(const f32x4*)(g2 + bj * 128), gb = *(const f32x4*)(g2 + bj * 128 + 4);
                    const f32x4 v0 = acc[ai][bj][m][0] * ga * w, v1 = acc[ai][bj][m][1] * gb * w;
                    u32x4 o; o.x = cvt_pk_bf16(v0[0], v0[1]); o.y = cvt_pk_bf16(v0[2], v0[3]); o.z = cvt_pk_bf16(v1[0], v1[1]); o.w = cvt_pk_bf16(v1[2], v1[3]);
                    *(u32x4*)(yo + (size_t)row * DM + col0 + bj * 128) = o; } }
    }
};
DEVI void phase_moe_down(const Params& p, int l, const LAS int* offs, LAS unsigned char* lds) {
    MoeSched<false> S; S.lst = p.lst; S.G = gridDim.x; S.c = opq_bid(); S.nN = 4; S.load(offs); S.A = (const char*)p.hid; S.B = (const char*)(p.w2 + (size_t)l * NEXP * DM * DEXP);
    S.atile = (size_t)256 * DEXP * 2; S.bexp = (size_t)DM * DEXP * 2; S.btile = (size_t)256 * DEXP * 2;
    EpiDown E; E.yo = p.yo; E.tokw = p.tok_w; E.lst = p.lst; E.offs = offs; E.g2base = p.modv + (size_t)l * 5 * 6144 + 5120;
    g8::gemm_phase(lds, DEXP, DEXP, DEXP, S, E);
}
DEVI void phase_moe_combine(const Params& p, int l, const LAS int* offs, bool dry = false) {
    const int lane = opq_tid() & 63, wv = opq_tid() >> 6; const bool skipc = (l == DEPTH - 1);
    for (int r = opq_bid() * 8 + wv; r < TT; r += gridDim.x * 8) {
        const int pos = r % RB; if (skipc && pos >= SEQ) continue;
        float* x = xbuf_row(p, r);
        const int vz = vzero();
        const int pr0 = offs[p.tok_e[r * 2 + vz]] + p.tok_s[r * 2 + vz], pr1 = offs[p.tok_e[r * 2 + 1 + vz]] + p.tok_s[r * 2 + 1 + vz];
        const bf16_t* y0 = p.yo + (size_t)pr0 * DM; const bf16_t* y1 = p.yo + (size_t)pr1 * DM;
#pragma unroll
        for (int i = 0; i < 4; ++i) { const int c = i * 256 + lane * 4; f32x4 v = *(const f32x4*)(x + c);
            const u32x2 a = *(const u32x2*)(y0 + c), b = *(const u32x2*)(y1 + c);
            v[0] += __uint_as_float(a.x << 16) + __uint_as_float(b.x << 16); v[1] += __uint_as_float(a.x & 0xffff0000u) + __uint_as_float(b.x & 0xffff0000u);
            v[2] += __uint_as_float(a.y << 16) + __uint_as_float(b.y << 16); v[3] += __uint_as_float(a.y & 0xffff0000u) + __uint_as_float(b.y & 0xffff0000u);
            if (!dry || v[0] == 123.456f) *(f32x4*)(x + c) = v; }
    }
}

#ifndef MK_PHASE_KERNELS
#define MK_PHASE_KERNELS 0
#endif
constexpr int LDS_SCRATCH = 1024;

template <class T> DEVI T* uni_ptr(T* x) { const unsigned long long v = (unsigned long long)x;
    const unsigned lo = __builtin_amdgcn_readfirstlane((unsigned)v), hi = __builtin_amdgcn_readfirstlane((unsigned)(v >> 32));
    return (T*)(((unsigned long long)hi << 32) | lo); }
DEVI Params ldparams(const PL& s) {
    Params q;
#pragma unroll
    for (int i = 0; i < 35; ++i) q.in[i] = uni_ptr(s.in[i]);
#define LDP(f) q.f = uni_ptr(s.f)
    LDP(out); LDP(ctrl); LDP(modv); LDP(lbv); LDP(xc); LDP(rope); LDP(lrula); LDP(winA); LDP(winG); LDP(wup); LDP(wcat); LDP(wout); LDP(w13); LDP(w2); LDP(wlru);
    LDP(hx); LDP(pa); LDP(up); LDP(q); LDP(qc); LDP(kv); LDP(st); LDP(stb); LDP(lsum); LDP(lin); LDP(ocat); LDP(y); LDP(h2); LDP(h2p); LDP(hid); LDP(yo);
    LDP(tok_e); LDP(tok_s); LDP(tok_w); LDP(lst); LDP(rww); LDP(rmr);
#undef LDP
    q.pad_ = 0ull;
    return q;
}
#ifndef WAITPROBE
#define WAITPROBE (-1)
#endif
DEVI void grid_sync(const PL& s, LAS unsigned char* smem) {
    XcdBarrier b; b.bar = uni_ptr(s.ctrl); b.x = xb_xcc_id(); b.st = (volatile LAS unsigned*)smem;
#if WAITPROBE >= 0
    unsigned long long t0 = 0; if (threadIdx.x == 0) t0 = __builtin_amdgcn_s_memrealtime();
    xcd_barrier(b);
    if (threadIdx.x == 0) { LAS unsigned long long* acc = (LAS unsigned long long*)(smem + 32); *acc += __builtin_amdgcn_s_memrealtime() - t0; }
#else
    xcd_barrier(b);
#endif
}
DEVI void probe_dump(const Params& p, const bf16_t* src, size_t n) {
    const size_t NOUT = (size_t)NB * SEQ * DM;
    for (size_t i = (size_t)opq_bid() * 512 + opq_tid(); i < NOUT; i += (size_t)gridDim.x * 512) { float s = 0.f;
        for (size_t k = i; k < n; k += NOUT) s += (float)src[k];
        p.out[i] = s; }
}
#define PROBE_AT(id, buf, n) if (PROBE_STOP == (id) && l == 0 && hb == 0) { { const Params p = ldparams(pl); probe_dump(p, (const bf16_t*)(buf), (n)); } return; }
#ifndef PROBE_STOP
#define PROBE_STOP 0
#endif
#ifndef DUP_MASK
#define DUP_MASK 0
#endif
#define PHASE_D(bit, call, dupcall) PHASE(call); if ((DUP_MASK >> (bit)) & 1) { PHASE(dupcall); }
#define PHASE(call) do { const Params p = ldparams(pl); call; } while (0); grid_sync(pl, smem); if ((DUP_MASK >> 21) & 1) grid_sync(pl, smem)

#ifndef SELFCHECK
#define SELFCHECK 0
#endif
DEVI void chk_sum(const Params& p, int id, int rep, const void* buf, size_t nbytes) {
    const unsigned* w = (const unsigned*)buf; const size_t n = nbytes / 4; unsigned long long s = 0ull;
    for (size_t i = (size_t)opq_bid() * 512 + opq_tid(); i < n; i += (size_t)gridDim.x * 512) s += (unsigned long long)w[i] * (unsigned long long)((i & 1023) + 1);
    unsigned lo = (unsigned)s, hi = (unsigned)(s >> 32);
    for (int o = 32; o >= 1; o >>= 1) { const unsigned l2 = __shfl_xor(lo, o), h2 = __shfl_xor(hi, o); const unsigned long long t = (((unsigned long long)hi << 32) | lo) + (((unsigned long long)h2 << 32) | l2); lo = (unsigned)t; hi = (unsigned)(t >> 32); }
    if ((opq_tid() & 63) == 0) atomicAdd((unsigned long long*)(p.ctrl + 6144) + (rep * 32 + id), (((unsigned long long)hi << 32) | lo));
}
#define CHK(id, buf, nbytes) do { const Params p = ldparams(pl); chk_sum(p, id, rep, buf, nbytes); } while (0); grid_sync(pl, smem)

__global__ void __launch_bounds__(512, 2) hybrid_flow_backbone_kernel(Params pk) {
    extern __shared__ __attribute__((aligned(16))) unsigned char smem_raw[];
    LAS unsigned char* smem = (LAS unsigned char*)smem_raw;
    LAS unsigned char* lds = smem + LDS_SCRATCH; LAS int* offs = (LAS int*)(smem + 64);
    static_assert(sizeof(Params) % 8 == 0 && sizeof(Params) <= LDS_SCRATCH - 256, "Params must fit its LDS slot");
    { (void)pk;
      const __attribute__((address_space(4))) unsigned long long* src = (const __attribute__((address_space(4))) unsigned long long*)__builtin_amdgcn_kernarg_segment_ptr();
      LAS unsigned long long* dst = (LAS unsigned long long*)(smem + 256);
      if (threadIdx.x < sizeof(Params) / 8) dst[threadIdx.x] = src[threadIdx.x]; }
    if (threadIdx.x == 0) { *(LAS u32x4*)smem = (u32x4){0u, 0u, 0u, 0u}; *(LAS unsigned long long*)(smem + 32) = 0ull; }
    __syncthreads();
    const PL& pl = *(const PL*)(smem + 256);
    (void)xcd_barrier_post(uni_ptr(pl.ctrl), (volatile LAS unsigned*)smem);
    phase_prep(pl, lds); grid_sync(pl, smem);
    if ((DUP_MASK >> 16) & 1) { phase_prep(pl, lds); grid_sync(pl, smem); }
#if SELFCHECK
    for (int rep = 0; rep < SELFCHECK; ++rep) {
        const int l = 0, hb = 0;
        PHASE(phase_norm1(p, l, hb));          CHK(1, p.hx, (size_t)HR * DM * 2);
        PHASE(phase_inproj_a(p, l, lds));      CHK(2, p.pa, (size_t)HR * PA_W * 2);
        PHASE(phase_mla_up(p, l, lds));        CHK(3, p.up, (size_t)HR * UPW * 2);
        PHASE(phase_qkv(p, l, lds));           CHK(4, p.q, (size_t)2 * 8 * SEQ * 96 * 2); CHK(5, p.qc, (size_t)2 * 8 * CTX * 96 * 2);
        PHASE(phase_attn_scan1(p, l, lds));    CHK(6, p.st, (size_t)2 * 2 * 8 * NCH * 4096 * 2); CHK(7, p.stb, (size_t)2 * 2 * 8 * NCH * 64 * 4); CHK(8, p.lsum, (size_t)2 * 2 * NT16 * 512 * 2 * 4);
        PHASE(phase_prefix(p, lds));                CHK(9, p.st, (size_t)2 * 2 * 8 * NCH * 4096 * 2); CHK(10, p.lin, (size_t)2 * 2 * NT16 * 512 * 4);
        PHASE(phase_scan3(p, l, lds));         CHK(11, p.ocat, (size_t)HR * OCW * 2);
        PHASE(phase_inproj_g(p, l, lds));      CHK(12, p.pa, (size_t)HR * PG_W * 2);
        PHASE(phase_merge(p, l, lds));         CHK(13, p.y, (size_t)HR * DM * 2);
        PHASE(phase_outproj(p, l, hb, lds));   CHK(14, p.out, (size_t)2 * SEQ * DM * 4); CHK(15, p.xc, (size_t)2 * CTX * DM * 4);
    }
    {   const Params p = ldparams(pl);
        const size_t NOUT = (size_t)NB * SEQ * DM;
        for (size_t i = (size_t)opq_bid() * 512 + opq_tid(); i < NOUT; i += (size_t)gridDim.x * 512) p.out[i] = 0.f;
        __syncthreads();
        if (opq_bid() == 0 && opq_tid() == 0) { int first = 0; const unsigned long long* c = (const unsigned long long*)(p.ctrl + 6144);
            for (int id = 15; id >= 1; --id) for (int rep = 1; rep < SELFCHECK; ++rep)
                if (__hip_atomic_load(c + rep * 32 + id, __ATOMIC_RELAXED, __HIP_MEMORY_SCOPE_AGENT) != __hip_atomic_load(c + id, __ATOMIC_RELAXED, __HIP_MEMORY_SCOPE_AGENT)) first = id;
            p.out[0] = 1000.0f * (float)first; }
    }
    return;
#endif
    for (int l = 0; l < DEPTH; ++l) {
        for (int hb = 0; hb < 2; ++hb) {
            if (l == 0 && hb == 0) { PHASE_D(0, phase_norm1(p, l, hb), phase_norm1(p, l, hb)); }
            PHASE_D(1, phase_inproj_a(p, l, lds), phase_inproj_a(p, l, lds));
            PHASE_D(2, phase_mla_up(p, l, lds), phase_mla_up(p, l, lds));
            PHASE_D(3, phase_qkv(p, l, lds), phase_qkv(p, l, lds));
            PHASE(phase_attn_scan1(p, l, lds));
            if ((DUP_MASK >> 4) & 1) { PHASE(phase_attn_scan1(p, l, lds, 1)); }
            if ((DUP_MASK >> 5) & 1) { PHASE(phase_attn_scan1(p, l, lds, 2)); }
            if ((DUP_MASK >> 6) & 1) { PHASE(phase_attn_scan1(p, l, lds, 4)); }
            PHASE(phase_prefix(p, lds));
            if ((DUP_MASK >> 17) & 1) { PHASE(phase_prefix(p, lds, true)); }
            PHASE(phase_scan3(p, l, lds));
            if ((DUP_MASK >> 7) & 1) { PHASE(phase_scan3(p, l, lds, 1)); }
            if ((DUP_MASK >> 8) & 1) { PHASE(phase_scan3(p, l, lds, 2)); }
            PHASE_D(9, phase_inproj_g(p, l, lds), phase_inproj_g(p, l, lds));
            PHASE_D(10, phase_merge(p, l, lds), phase_merge(p, l, lds));
            PHASE(phase_outproj(p, l, hb, lds); if (hb == 0) phase_norm1(p, l, 1));
            if (((DUP_MASK >> 11) & 1) && l == 0) { PHASE(phase_outproj(p, l, hb, lds)); }
            if ((DUP_MASK >> 15) & 1) { for (int z = 0; z < 10; ++z) grid_sync(pl, smem); }
        }
        PHASE(phase_norm2_route(p, l, lds));
        PHASE_D(13, moe_offsets(p, l, offs); phase_moe_up(p, l, offs, lds), phase_moe_up(p, l, offs, lds));
        PHASE_D(14, phase_moe_down(p, l, offs, lds), phase_moe_down(p, l, offs, lds));
        PHASE(phase_moe_combine(p, l, offs); if (l + 1 < DEPTH) phase_norm1(p, l + 1, 0));
        if ((DUP_MASK >> 19) & 1) { PHASE(phase_moe_combine(p, l, offs, true)); }
    }
#if WAITPROBE >= 0
    if (blockIdx.x == WAITPROBE && threadIdx.x == 0) {
        const unsigned long long w = *(LAS unsigned long long*)(smem + 32), t0 = __builtin_amdgcn_s_memrealtime();
        while (__builtin_amdgcn_s_memrealtime() - t0 < w) __builtin_amdgcn_s_sleep(8); }
#endif
}

static size_t align_up(size_t x, size_t a) { return (x + a - 1) / a * a; }

extern "C" void kernel_launch(void* const* d_in, const int* in_sizes, int n_in, void* d_out, int out_size, void* d_ws, size_t ws_size, hipStream_t stream) {
    (void)in_sizes; (void)n_in; (void)out_size;
    Params p; memset(&p, 0, sizeof(p));
    for (int i = 0; i < 35; ++i) p.in[i] = (const float*)d_in[i];
    p.out = (float*)d_out;
    char* w = (char*)d_ws; size_t o = 0;
    auto take = [&](size_t bytes) { char* r = w + o; o = align_up(o + bytes, 256); return r; };
    p.ctrl = (unsigned*)take(CTRL_WORDS * 4);
    p.modv = (float*)take((size_t)DEPTH * 5 * 6144 * 4);
    p.lbv = (float*)take((size_t)DEPTH * 2 * 512 * 4);
    p.xc = (float*)take((size_t)NB * CTX * DM * 4);
    p.rope = (float*)take((size_t)SEQ * 32 * 4);
    p.lrula = (float*)take((size_t)DEPTH * 2 * 512 * 4);
    p.winA = (bf16_t*)take((size_t)DEPTH * PA_W * DM * 2);
    p.winG = (bf16_t*)take((size_t)DEPTH * PG_W * DM * 2);
    p.wup = (bf16_t*)take((size_t)DEPTH * UPW * 256 * 2);
    p.wcat = (bf16_t*)take((size_t)DEPTH * DM * OCW * 2);
    p.wout = (bf16_t*)take((size_t)DEPTH * DM * DM * 2);
    p.w13 = (bf16_t*)take((size_t)DEPTH * NEXP * 512 * DM * 2);
    p.w2 = (bf16_t*)take((size_t)DEPTH * NEXP * DM * DEXP * 2);
    p.wlru = (bf16_t*)take((size_t)DEPTH * 2 * 8 * 2 * 64 * 64 * 2);
    p.tok_e = (int*)take((size_t)TT * 2 * 4); p.tok_s = (int*)take((size_t)TT * 2 * 4);
    p.lst = (int*)take((size_t)NEXP * TT * 4); p.tok_w = (float*)take((size_t)NEXP * TT * 4);
    p.rww = (float*)take((size_t)RP * 4); p.rmr = (int*)take((size_t)RP * 4);
    const size_t region = o;
    p.hx = (bf16_t*)take((size_t)HR * DM * 2);
    p.pa = (bf16_t*)take((size_t)HR * PA_W * 2);
    p.ocat = (bf16_t*)take((size_t)HR * OCW * 2);
    p.lsum = (float*)take((size_t)2 * 2 * NT16 * 512 * 2 * 4); p.lin = (float*)take((size_t)2 * 2 * NT16 * 512 * 4);
    const size_t alias1 = o;
    p.up = (bf16_t*)take((size_t)HR * UPW * 2);
    const size_t after_up = o; o = alias1;
    p.st = (bf16_t*)take((size_t)2 * 2 * 8 * NCH * 4096 * 2); p.stb = (float*)take((size_t)2 * 2 * 8 * NCH * 64 * 4);
    if (o < after_up) o = after_up;
    const size_t alias2 = o;
    p.q = (bf16_t*)take((size_t)2 * 8 * SEQ * 96 * 2); p.qc = (bf16_t*)take((size_t)2 * 8 * CTX * 96 * 2); p.kv = (unsigned char*)take((size_t)2 * 8 * NCH * KVT_BYTES);
    const size_t mixer_end = o; o = alias2;
    p.y = (bf16_t*)take((size_t)HR * DM * 2);
    size_t end1 = mixer_end > o ? mixer_end : o;
    o = region;
    p.h2 = (bf16_t*)take((size_t)TT * DM * 2);
    p.h2p = (bf16_t*)take((size_t)RP * DM * 2);
    p.hid = (bf16_t*)take((size_t)RP * DEXP * 2);
    p.yo = (bf16_t*)take((size_t)RP * DM * 2);
    const size_t need = end1 > o ? end1 : o;
    static int grid = 0;
    if (!grid) {
        int dev = 0, cus = 0, per_cu = 0; hipGetDevice(&dev); hipDeviceGetAttribute(&cus, hipDeviceAttributeMultiprocessorCount, dev);
        hipFuncSetAttribute((const void*)hybrid_flow_backbone_kernel, hipFuncAttributeMaxDynamicSharedMemorySize, LDS_TOTAL);
        hipOccupancyMaxActiveBlocksPerMultiprocessor(&per_cu, (const void*)hybrid_flow_backbone_kernel, 512, LDS_TOTAL);
        if (per_cu < 1) fprintf(stderr, "kernel_launch: occupancy query returned %d\n", per_cu);
        grid = cus * (per_cu < 1 ? 0 : 1); if (grid > 256) grid = 256;
    }
    if (need > ws_size) { fprintf(stderr, "kernel_launch: workspace too small: need %zu have %zu\n", need, ws_size); return; }
    if (grid < 8) { fprintf(stderr, "kernel_launch: grid %d too small\n", grid); return; }
    hipMemsetAsync(p.ctrl, 0, CTRL_WORDS * 4, stream);
    hipLaunchKernelGGL(hybrid_flow_backbone_kernel, dim3(grid), dim3(512), LDS_TOTAL, stream, p);
}
```

```cpp
#include <hip/hip_runtime.h>
#include <stdint.h>
#include <stdio.h>
#include <string.h>

#define LAS __attribute__((address_space(3)))
#define DEVI __device__ __forceinline__
typedef unsigned short bf16_t;
typedef short bf16x8 __attribute__((ext_vector_type(8)));
typedef float f32x4 __attribute__((ext_vector_type(4)));
typedef float f32x16 __attribute__((ext_vector_type(16)));
typedef unsigned u32x4 __attribute__((ext_vector_type(4)));
typedef unsigned u32x2 __attribute__((ext_vector_type(2)));

constexpr int NB = 4, SEQ = 8192, CTX = 256, DM = 1024, DEPTH = 2;
constexpr int RB = SEQ + CTX;
constexpr int TT = NB * RB;
constexpr int HR = 2 * RB;
constexpr int NCH = RB / 64;
constexpr int INW = 7072;
constexpr int PA_W = 4096;
constexpr int PG_W = 3072;
constexpr int C_Q = 0, C_ZF = 512, C_ZB = 1024, C_I = 1536, C_G = 2048, C_DQ = 2560, C_DKV = 2816, C_KR = 2944, C_LX = 3072, C_LY = 3584;
constexpr int UPW = 1792;
constexpr int OCW = 1536;
constexpr int KVT_BYTES = 22016;
constexpr int KT_BYTES = 13312;
constexpr int NEXP = 16, DEXP = 256;
constexpr float EPSF = 1e-6f;
constexpr int LDS_TOTAL = 160 * 1024;

DEVI float bf2f(bf16_t b) { return __uint_as_float(((unsigned)b) << 16); }
DEVI bf16_t f2bf(float f) { return __builtin_bit_cast(bf16_t, (__bf16)f); }
typedef float f32x2_t __attribute__((ext_vector_type(2)));
typedef __bf16 bf16x2_t __attribute__((ext_vector_type(2)));
DEVI unsigned cvt_pk_bf16(float lo, float hi) { const f32x2_t v = {lo, hi}; return __builtin_bit_cast(unsigned, __builtin_convertvector(v, bf16x2_t)); }
DEVI float fast_exp2(float x) { return __builtin_amdgcn_exp2f(x); }
DEVI float fast_rcp(float x) { return __builtin_amdgcn_rcpf(x); }
DEVI float sigmoidf_(float x) { return fast_rcp(1.0f + fast_exp2(-1.44269504f * x)); }
DEVI float wave_sum(float v) { for (int o = 32; o >= 1; o >>= 1) v += __shfl_xor(v, o); return v; }
DEVI float wave_max(float v) { for (int o = 32; o >= 1; o >>= 1) v = fmaxf(v, __shfl_xor(v, o)); return v; }

DEVI int opq_tid() { int t = threadIdx.x; asm volatile("" : "+v"(t)); return t; }
DEVI int opq_bid() { int b = blockIdx.x; asm volatile("" : "+s"(b)); return b; }

DEVI int vzero() { int z = 0; asm volatile("" : "+v"(z)); return z; }

#define XB_TMO      128
#define XB_XCNT(j)  (256  + 64 * (j))
#define XB_XSUB(j)  (1280 + 64 * (j))
#define XB_XGEN(j)  (2304 + 64 * (j))
#define XB_TOP      3328
#define XB_TOPGEN   3392
#define XCD_BAR_WORDS 3456
#define XB_SPIN_CAP (1u << 18)

__device__ __forceinline__ unsigned xb_ld(unsigned* p)              { return __hip_atomic_load(p, __ATOMIC_RELAXED, __HIP_MEMORY_SCOPE_AGENT); }
__device__ __forceinline__ unsigned xb_add(unsigned* p, unsigned v) { return __hip_atomic_fetch_add(p, v, __ATOMIC_RELAXED, __HIP_MEMORY_SCOPE_AGENT); }
__device__ __forceinline__ unsigned xb_xcc_id() { return (unsigned)__builtin_amdgcn_s_getreg((3 << 11) | 20) & 0xFu; }
#define XB_SPIN(cond, bar) do { unsigned _sp = 0; while (cond) { __builtin_amdgcn_s_sleep(1); \
    if ((++_sp & 255u) == 0u) { if (xb_ld(&(bar)[XB_TMO])) break; if (_sp > XB_SPIN_CAP) { atomicAdd(&(bar)[XB_TMO], 1u); break; } } } } while (0)

struct XcdBarrier { unsigned* bar; unsigned x; volatile LAS unsigned* st; };

__device__ __forceinline__ XcdBarrier xcd_barrier_post(unsigned* bar, volatile LAS unsigned* st) {
    XcdBarrier b; b.bar = bar; b.x = xb_xcc_id(); b.st = st;
    if (threadIdx.x == 0) (void)xb_add(&bar[XB_XCNT(b.x)], 1u);
    return b;
}
__device__ __forceinline__ void xcd_barrier_complete(unsigned* bar, unsigned x, unsigned& nloc, unsigned& nx) {
    const unsigned G = gridDim.x * gridDim.y * gridDim.z;
    unsigned sum, cnt, mine, sp = 0u;
    for (;;) {
        sum = 0u; cnt = 0u; mine = 0u;
#pragma unroll
        for (unsigned j = 0; j < 16; ++j) { const unsigned c = xb_ld(&bar[XB_XCNT(j)]); sum += c; cnt += (c > 0u) ? 1u : 0u; mine = (j == x) ? c : mine; }
        if (sum == G) break;
        __builtin_amdgcn_s_sleep(1);
        if ((++sp & 255u) == 0u) { if (xb_ld(&bar[XB_TMO])) break; if (sp > XB_SPIN_CAP) { atomicAdd(&bar[XB_TMO], 1u); break; } }
    }
    nloc = mine > 0u ? mine : 1u; nx = cnt > 0u ? cnt : 1u;
}
__device__ __forceinline__ void xcd_barrier(const XcdBarrier& b) {
    asm volatile("s_waitcnt vmcnt(0)" ::: "memory");
    __syncthreads();
    if (threadIdx.x == 0) {
        unsigned* bar = b.bar;
        __builtin_amdgcn_s_waitcnt(0);
        unsigned nloc = b.st[0], nx = b.st[1];
        if (nloc == 0u) { xcd_barrier_complete(bar, b.x, nloc, nx); b.st[0] = nloc; b.st[1] = nx; }
        const unsigned old = xb_add(&bar[XB_XSUB(b.x)], 1u);
        const unsigned gen = old / nloc;
        if (old + 1u == (gen + 1u) * nloc) {
            __builtin_amdgcn_fence(__ATOMIC_RELEASE, "agent");
            asm volatile("s_waitcnt vmcnt(0)" ::: "memory");
            const unsigned og = xb_add(&bar[XB_TOP], 1u);
            const unsigned tg = og / nx;
            if (og + 1u == (tg + 1u) * nx) xb_add(&bar[XB_TOPGEN], 1u);
            else XB_SPIN(xb_ld(&bar[XB_TOPGEN]) == tg, bar);
            __builtin_amdgcn_fence(__ATOMIC_ACQUIRE, "agent");
            xb_add(&bar[XB_XGEN(b.x)], 1u);
            asm volatile("s_waitcnt vmcnt(0)" ::: "memory");
        } else {
            XB_SPIN(xb_ld(&bar[XB_XGEN(b.x)]) == gen, bar);
            __builtin_amdgcn_fence(__ATOMIC_ACQUIRE, "agent");
            asm volatile("s_waitcnt vmcnt(0)" ::: "memory");
        }
    }
    __syncthreads();
}

struct Params {
    const float* in[35];
    float* out;
    unsigned* ctrl;
    float* modv;
    float* lbv;
    float* xc;
    float* lrula;
    float* rope;
    bf16_t* winA; bf16_t* winG; bf16_t* wup; bf16_t* wcat; bf16_t* wout; bf16_t* w13; bf16_t* w2; bf16_t* wlru;
    bf16_t* hx;
    bf16_t* pa;
    bf16_t* up;
    bf16_t* q; bf16_t* qc; unsigned char* kv;
    bf16_t* st; float* stb;
    float* lsum; float* lin;
    bf16_t* ocat;
    bf16_t* y;
    bf16_t* h2; bf16_t* h2p; bf16_t* hid; bf16_t* yo;
    int* tok_e; int* tok_s; float* tok_w; int* lst; float* rww; int* rmr;
    unsigned long long pad_;
};

typedef LAS Params PL;

#define CTRL_CNT(l, e) (4096 + 512 * (l) + 16 * (e))
#define CTRL_WORDS 8192

namespace g8 {
constexpr int BM = 256, BK = 64, HALF = 128, HTB = HALF * BK * 2, STAGE_BYTES = 8 * HTB, NXCD = 8, WGM = 8;
__host__ __device__ __forceinline__ int lds_byte(int r, int c) { const int st = (r >> 4) * 2 + (c >> 5), rr = r & 15, cc = c & 31, ob = rr * 64 + cc * 2; return st * 1024 + (ob ^ (((ob >> 9) & 1) << 5)); }
__host__ __device__ __forceinline__ void stage_rc(int b, int& R, int& C) { const int st = b / 1024, sb = b % 1024, swz = sb ^ (((sb >> 9) & 1) << 5); R = (st >> 1) * 16 + swz / 64; C = (st & 1) * 32 + (swz % 64) / 2; }
__host__ __device__ __forceinline__ int perm32(int rho) { const int n = rho >> 4, i = rho & 15; return 8 * (i >> 2) + 4 * n + (i & 3); }

struct Unit { int pm, pn, tag; const char* a; const char* b; };

__device__ __forceinline__ bool static_order(int i, int G, int c, int nM, int nN, int& pm, int& pn) {
    const int nwg = nM * nN; const long L = (long)i * G + c; if (L >= nwg) return false;
    int wgid = (int)L; { const int q = nwg / NXCD, r = nwg % NXCD, xcd = wgid % NXCD, off = wgid / NXCD; wgid = (xcd < r ? xcd * (q + 1) : r * (q + 1) + (xcd - r) * q) + off; }
    const int nig = WGM * nN, gid = wgid / nig, fm = gid * WGM, gsz = (nM - fm) < WGM ? (nM - fm) : WGM;
    pm = fm + ((wgid % nig) % gsz); pn = (wgid % nig) / gsz; return true;
}

template <class Epi, class Sched>
__device__ __forceinline__ void gemm_phase(LAS unsigned char* lds, const int lda, const int ldb, const int K, const Sched& S, const Epi& E) {
    const int tid = opq_tid(), wid = __builtin_amdgcn_readfirstlane(tid >> 6), lane = tid & 63, wr = wid >> 2, wc = wid & 3, fr = lane & 15, fq = lane >> 4;
    const int nt = K / BK;
    unsigned voffB[2]; int RA[2], CA[2];
#pragma unroll
    for (int i = 0; i < 2; ++i) { int R, C; stage_rc(tid * 16 + i * 8192, R, C); const int Rb = Epi::PERM ? ((R & ~31) + perm32(R & 31)) : R;
        RA[i] = R; CA[i] = C; voffB[i] = (unsigned)(Rb * ldb + C) * 2u; }
    auto set_voff = [&](const Unit& u, unsigned (&v)[2][2]) {
#pragma unroll
        for (int h = 0; h < 2; ++h)
#pragma unroll
            for (int i = 0; i < 2; ++i) { if constexpr (Sched::GATHER) v[h][i] = (unsigned)S.row_of(u, h * HALF + RA[i]) * (unsigned)(lda * 2) + (unsigned)CA[i] * 2u;
                else v[h][i] = (unsigned)((h * HALF + RA[i]) * lda + CA[i]) * 2u; } };
    const size_t kstep = (size_t)(BK * 2);
    const size_t hstepB = (size_t)HALF * ldb * 2;
    const unsigned ldsw = (unsigned)wid * 1024u;
    const int aoff = lds_byte(wr * 64 + fr, fq * 8), boff = lds_byte(wc * 32 + fr, fq * 8);
#define G8_SA(b, h) (((b) * 2 + (h)) * HTB)
#define G8_SB(b, h) ((4 + (b) * 2 + (h)) * HTB)
#define G8_STAGE(bufoff, gbase, voff) do { _Pragma("unroll") for (int _i = 0; _i < 2; ++_i) \
        __builtin_amdgcn_global_load_lds((const unsigned*)((const char*)(gbase) + (voff)[_i]), (LAS unsigned*)(lds + (bufoff) + ldsw + _i * 8192), 16, 0, 0); } while (0)
#define G8_LDA(dst, b, h) do { _Pragma("unroll") for (int m = 0; m < 4; ++m) _Pragma("unroll") for (int k = 0; k < 2; ++k) dst[m][k] = *(const LAS bf16x8*)(lds + G8_SA(b, h) + aoff + m * 2048 + k * 1024); } while (0)
#define G8_LDB(dst, b, h) do { _Pragma("unroll") for (int n = 0; n < 2; ++n) _Pragma("unroll") for (int k = 0; k < 2; ++k) dst[n][k] = *(const LAS bf16x8*)(lds + G8_SB(b, h) + boff + n * 2048 + k * 1024); } while (0)
#define G8_MMA(ai, bj, At, Bt) do { __builtin_amdgcn_s_setprio(1); _Pragma("unroll") for (int m = 0; m < 4; ++m) _Pragma("unroll") for (int n = 0; n < 2; ++n) _Pragma("unroll") for (int k = 0; k < 2; ++k) \
        acc[ai][bj][m][n] = __builtin_amdgcn_mfma_f32_16x16x32_bf16(Bt[n][k], At[m][k], acc[ai][bj][m][n], 0, 0, 0); __builtin_amdgcn_s_setprio(0); } while (0)
#define G8_WAIT_V(n) asm volatile("s_waitcnt vmcnt(" #n ")" ::: "memory")
#define G8_WAIT_L(n) asm volatile("s_waitcnt lgkmcnt(" #n ")" ::: "memory")
#define G8_BAR __builtin_amdgcn_s_barrier()
#define G8_SCHED __builtin_amdgcn_sched_barrier(0)
    Unit cur, nxt; int ui = 0;
    if (!S.next(0, cur)) return;
    f32x4 acc[2][2][4][2];
#pragma unroll
    for (int a = 0; a < 2; ++a)
#pragma unroll
        for (int b = 0; b < 2; ++b)
#pragma unroll
            for (int m = 0; m < 4; ++m)
#pragma unroll
                for (int n = 0; n < 2; ++n) acc[a][b][m][n] = (f32x4){0.f, 0.f, 0.f, 0.f};
    bf16x8 At[4][2], B0[2][2], B1[2][2];
    const char* cA = cur.a; const char* cB = cur.b;
    unsigned vcur[2][2], vnxt[2][2]; set_voff(cur, vcur);
    asm volatile("s_waitcnt lgkmcnt(0)" ::: "memory");
    if constexpr (Sched::GATHER) asm volatile("s_waitcnt vmcnt(0)" ::: "memory");
    G8_STAGE(G8_SB(0, 0), cB, voffB); G8_STAGE(G8_SA(0, 0), cA, vcur[0]); G8_STAGE(G8_SB(0, 1), cB + hstepB, voffB); G8_STAGE(G8_SA(0, 1), cA, vcur[1]);
    if (wr == 1) G8_BAR;
    G8_WAIT_V(4); G8_BAR;
    G8_STAGE(G8_SB(1, 0), cB + kstep, voffB); G8_STAGE(G8_SA(1, 0), cA + kstep, vcur[0]); G8_STAGE(G8_SB(1, 1), cB + hstepB + kstep, voffB);
    G8_WAIT_V(6); G8_BAR;
    for (;;) {
        const bool has_next = S.next(ui + 1, nxt);
        const char* nA = has_next ? nxt.a : cA; const char* nB = has_next ? nxt.b : cB;
        if (has_next) set_voff(nxt, vnxt); else {
#pragma unroll
            for (int h = 0; h < 2; ++h) { vnxt[h][0] = vcur[h][0]; vnxt[h][1] = vcur[h][1]; } }
        asm volatile("s_waitcnt lgkmcnt(0)" ::: "memory");
        const int tseg = nt / Epi::NSEG;
#pragma unroll 1
        for (int sg = 0; sg < Epi::NSEG; ++sg) {
#pragma unroll 1
        for (int t = sg * tseg; t < (sg + 1) * tseg; t += 2) {
            const bool last = (t == nt - 2);
            const char* a1 = cA + (size_t)(t + 1) * kstep;
            const char* a2 = last ? nA : cA + (size_t)(t + 2) * kstep; const char* b2 = last ? nB : cB + (size_t)(t + 2) * kstep;
            const char* a3 = a2 + kstep; const char* b3 = b2 + kstep;
            unsigned v20[2], v21[2];
#pragma unroll
            for (int i = 0; i < 2; ++i) { v20[i] = last ? vnxt[0][i] : vcur[0][i]; v21[i] = last ? vnxt[1][i] : vcur[1][i]; }
            G8_LDB(B0, 0, 0); G8_SCHED; G8_LDA(At, 0, 0); G8_STAGE(G8_SA(1, 1), a1, vcur[1]);
            G8_WAIT_L(8); G8_BAR; G8_WAIT_L(0); G8_MMA(0, 0, At, B0); G8_BAR; G8_SCHED;
            G8_LDB(B1, 0, 1); G8_STAGE(G8_SB(0, 0), b2, voffB);
            G8_BAR; G8_WAIT_L(0); G8_MMA(0, 1, At, B1); G8_BAR;
            G8_LDA(At, 0, 1); G8_STAGE(G8_SA(0, 0), a2, v20);
            G8_BAR; G8_WAIT_L(0); G8_MMA(1, 0, At, B0); G8_BAR; G8_SCHED;
            G8_STAGE(G8_SB(0, 1), b2 + hstepB, voffB);
            G8_WAIT_V(6); G8_BAR; G8_MMA(1, 1, At, B1); G8_BAR;
            G8_LDB(B0, 1, 0); G8_SCHED; G8_LDA(At, 1, 0); G8_STAGE(G8_SA(0, 1), a2, v21);
            G8_WAIT_L(8); G8_BAR; G8_WAIT_L(0); G8_MMA(0, 0, At, B0); G8_BAR; G8_SCHED;
            G8_LDB(B1, 1, 1); G8_STAGE(G8_SB(1, 0), b3, voffB);
            G8_BAR; G8_WAIT_L(0); G8_MMA(0, 1, At, B1); G8_BAR;
            G8_LDA(At, 1, 1); G8_STAGE(G8_SA(1, 0), a3, v20);
            G8_BAR; G8_WAIT_L(0); G8_MMA(1, 0, At, B0); G8_BAR; G8_SCHED;
            G8_STAGE(G8_SB(1, 1), b3 + hstepB, voffB);
            G8_WAIT_V(6); G8_BAR; G8_MMA(1, 1, At, B1); G8_BAR;
        }
        if constexpr (Epi::NSEG > 1) { if (sg + 1 < Epi::NSEG) E.mid(sg, acc, cur, wr, wc, fr, fq); }
        }
        E(acc, cur, wr, wc, fr, fq);
        if (!has_next) break;
#pragma unroll
        for (int a = 0; a < 2; ++a)
#pragma unroll
            for (int b = 0; b < 2; ++b)
#pragma unroll
                for (int m = 0; m < 4; ++m)
#pragma unroll
                    for (int n = 0; n < 2; ++n) acc[a][b][m][n] = (f32x4){0.f, 0.f, 0.f, 0.f};
        cur = nxt; cA = nA; cB = nB; ++ui;
#pragma unroll
        for (int h = 0; h < 2; ++h) { vcur[h][0] = vnxt[h][0]; vcur[h][1] = vnxt[h][1]; }
    }
    G8_WAIT_V(0);
    if (wr == 0) G8_BAR;
    G8_BAR;
#undef G8_SA
#undef G8_SB
#undef G8_STAGE
#undef G8_LDA
#undef G8_LDB
#undef G8_MMA
#undef G8_WAIT_V
#undef G8_WAIT_L
#undef G8_BAR
#undef G8_SCHED
}
}

enum { I_X = 0, I_C, I_CTX, I_CCTX, I_WMOD, I_BMOD, I_NMIX, I_NFFN, I_WIN, I_HGLB, I_HGNORM, I_QNORM, I_KVNORM, I_WUQ, I_WUKV, I_GQ, I_GK,
       I_CONVW, I_CONVB, I_LWA, I_LBA, I_LWX, I_LBX, I_LAM, I_BRHG, I_BRMLA, I_BRLRU, I_WOUT, I_WRG, I_BRG, I_WRE, I_BRE, I_W1, I_W3, I_W2 };

DEVI const float* xin_row_l0(const Params& p, int r) { const int b = r / RB, pos = r - b * RB;
    return pos < SEQ ? p.in[I_X] + ((size_t)b * SEQ + pos) * DM : p.in[I_CTX] + ((size_t)b * CTX + (pos - SEQ)) * DM; }
DEVI float* xbuf_row(const Params& p, int r) { const int b = r / RB, pos = r - b * RB;
    return pos < SEQ ? p.out + ((size_t)b * SEQ + pos) * DM : p.xc + ((size_t)b * CTX + (pos - SEQ)) * DM; }
DEVI int mod_row(int r) { const int b = r / RB, pos = r - b * RB; return pos < SEQ ? b : 4; }

struct TrJob { const float* src; int ld; int K; int ncols; bf16_t* dst; int dld; const float* ks; };

DEVI int tr_job_count() { return DEPTH * (12 + 16 * 5 + 32); }
template <class P> DEVI TrJob tr_job(const P& p, int j) {
    const int per = 12 + 16 * 5 + 32; const int l = j / per; int q = j - l * per; TrJob t; t.ks = nullptr; t.src = nullptr;
    const float* win = p.in[I_WIN] + (size_t)l * DM * INW;
    bf16_t* winA = p.winA + (size_t)l * PA_W * DM; bf16_t* wup = p.wup + (size_t)l * UPW * 256; bf16_t* wcat = p.wcat + (size_t)l * DM * OCW;
    if (q == 0) { t.src = win; t.ld = INW; t.K = DM; t.ncols = 2944; t.dst = winA; t.dld = DM; return t; }
    if (q == 11) { t.src = win + 2944; t.ld = INW; t.K = DM; t.ncols = 32; t.dst = winA + (size_t)2944 * DM; t.dld = DM; return t; }
    if (q == 1) { t.src = nullptr; t.ld = 0; t.K = DM; t.ncols = 96; t.dst = winA + (size_t)2976 * DM; t.dld = DM; return t; }
    if (q == 2) { t.src = win + 2976; t.ld = INW; t.K = DM; t.ncols = 1024; t.dst = winA + (size_t)3072 * DM; t.dld = DM; return t; }
    if (q == 3) { t.src = win + 4000; t.ld = INW; t.K = DM; t.ncols = PG_W; t.dst = p.winG + (size_t)l * PG_W * DM; t.dld = DM; return t; }
    if (q == 4) { t.src = p.in[I_WUQ] + (size_t)l * 256 * 768; t.ld = 768; t.K = 256; t.ncols = 768; t.dst = wup; t.dld = 256; t.ks = p.in[I_QNORM] + l * 256; return t; }
    if (q == 5) { t.src = p.in[I_WUKV] + (size_t)l * 128 * 1024; t.ld = 1024; t.K = 128; t.ncols = 1024; t.dst = wup + (size_t)768 * 256; t.dld = 256; t.ks = p.in[I_KVNORM] + l * 128; return t; }
    if (q == 6) { t.src = nullptr; t.ld = 0; t.K = 128; t.ncols = 1024; t.dst = wup + (size_t)768 * 256 + 128; t.dld = 256; return t; }
    if (q >= 7 && q <= 9) { const int i = q - 7; const float* s = (i == 0 ? p.in[I_BRHG] : i == 1 ? p.in[I_BRMLA] : p.in[I_BRLRU]) + (size_t)l * 512 * DM;
        t.src = s; t.ld = DM; t.K = 512; t.ncols = DM; t.dst = wcat + i * 512; t.dld = OCW; return t; }
    if (q == 10) { t.src = p.in[I_WOUT] + (size_t)l * DM * DM; t.ld = DM; t.K = DM; t.ncols = DM; t.dst = p.wout + (size_t)l * DM * DM; t.dld = DM; return t; }
    q -= 12;
    if (q < 80) { const int e = q / 5, s = q % 5; const size_t le = (size_t)l * NEXP + e;
        if (s < 4) { const int pn = s >> 1, which = s & 1;
            t.src = (which ? p.in[I_W3] : p.in[I_W1]) + le * DM * DEXP + pn * 128; t.ld = DEXP; t.K = DM; t.ncols = 128;
            t.dst = p.w13 + le * 512 * DM + (size_t)(pn * 256 + which * 128) * DM; t.dld = DM; return t; }
        t.src = p.in[I_W2] + le * DEXP * DM; t.ld = DM; t.K = DEXP; t.ncols = DM; t.dst = p.w2 + le * DM * DEXP; t.dld = DEXP; return t; }
    q -= 80;
    { const int d = q >> 4, n = (q >> 1) & 7, which = q & 1;
      const size_t blk = (((size_t)l * 2 + d) * 8 + n);
      t.src = (which ? p.in[I_LWX] : p.in[I_LWA]) + blk * 64 * 64; t.ld = 64; t.K = 64; t.ncols = 64;
      t.dst = p.wlru + (blk * 2 + which) * 64 * 64; t.dld = 64; return t; }
}

template <class P> DEVI void phase_prep(const P& p, LAS unsigned char* lds) {
    const int tid = opq_tid(), G = gridDim.x;
    LAS float* tl = (LAS float*)lds;
    int rot = 0; const int nj = tr_job_count();
    for (int j = 0; j < nj; ++j) {
        const TrJob t = tr_job(p, j);
        const bool wide = (t.ncols & 63) == 0;
        const int tw = wide ? 64 : 32, tk = t.K / 64, ntile = tk * (t.ncols / tw);
        const int first = (int)((opq_bid() + (unsigned)G - (unsigned)(rot % G)) % (unsigned)G);
        if (wide) {
            for (int tile0 = first; tile0 < ntile; tile0 += 4 * G) {
                f32x4 v[4][2];
#pragma unroll
                for (int q = 0; q < 4; ++q) { const int tile = tile0 + q * G; const int k0 = (tile % tk) * 64, n0 = (tile / tk) * 64; const int n4 = tid & 15, kr = tid >> 4;
#pragma unroll
                    for (int i = 0; i < 2; ++i) { const int k = kr + 32 * i; f32x4 x = {0.f, 0.f, 0.f, 0.f};
                        if (tile < ntile && t.src) { x = *(const f32x4*)(t.src + (size_t)(k0 + k) * t.ld + n0 + n4 * 4); if (t.ks) x *= t.ks[k0 + k]; }
                        v[q][i] = x; } }
#pragma unroll
                for (int q = 0; q < 4; ++q) { const int n4 = tid & 15, kr = tid >> 4;
#pragma unroll
                    for (int i = 0; i < 2; ++i) { LAS float* d = tl + q * 4160 + (kr + 32 * i) * 65 + n4 * 4; d[0] = v[q][i][0]; d[1] = v[q][i][1]; d[2] = v[q][i][2]; d[3] = v[q][i][3]; } }
                __syncthreads();
#pragma unroll
                for (int q = 0; q < 4; ++q) { const int tile = tile0 + q * G; if (tile < ntile) { const int k0 = (tile % tk) * 64, n0 = (tile / tk) * 64; const int n = tid >> 3, k8 = (tid & 7) * 8;
                    const LAS float* sp = tl + q * 4160 + k8 * 65 + n;
                    u32x4 w; w.x = cvt_pk_bf16(sp[0], sp[65]); w.y = cvt_pk_bf16(sp[130], sp[195]); w.z = cvt_pk_bf16(sp[260], sp[325]); w.w = cvt_pk_bf16(sp[390], sp[455]);
                    *(u32x4*)(t.dst + (size_t)(n0 + n) * t.dld + k0 + k8) = w; } }
                __syncthreads();
            }
        } else {
            for (int tile0 = first; tile0 < ntile; tile0 += 8 * G) {
                float v[8][4];
#pragma unroll
                for (int q = 0; q < 8; ++q) { const int tile = tile0 + q * G; const int k0 = (tile % tk) * 64, n0 = (tile / tk) * 32; const int n = tid & 31, kr = tid >> 5;
#pragma unroll
                    for (int i = 0; i < 4; ++i) { const int k = kr + 16 * i; float x = 0.f;
                        if (tile < ntile && t.src) { x = t.src[(size_t)(k0 + k) * t.ld + n0 + n]; if (t.ks) x *= t.ks[k0 + k]; }
                        v[q][i] = x; } }
#pragma unroll
                for (int q = 0; q < 8; ++q) { const int n = tid & 31, kr = tid >> 5;
#pragma unroll
                    for (int i = 0; i < 4; ++i) tl[q * 2112 + (kr + 16 * i) * 33 + n] = v[q][i]; }
                __syncthreads();
#pragma unroll
                for (int q = 0; q < 8; ++q) { const int tile = tile0 + q * G; if (tile < ntile) { const int k0 = (tile % tk) * 64, n0 = (tile / tk) * 32; const int k = tid & 63, nn = tid >> 6;
#pragma unroll
                    for (int i = 0; i < 4; ++i) { const int n = nn + 8 * i; t.dst[(size_t)(n0 + n) * t.dld + k0 + k] = f2bf(tl[q * 2112 + k * 33 + n]); } } }
                __syncthreads();
            }
        }
        rot += ntile;
    }
    {
        LAS float* sl = (LAS float*)lds;
        LAS float* red = sl + 5 * 1024;
        for (int i = tid; i < 5 * 1024; i += 512) { const int r = i >> 10, k = i & 1023; const float v = r < 4 ? p.in[I_C][r * DM + k] : p.in[I_CCTX][k]; sl[i] = v * sigmoidf_(v); }
        __syncthreads();
        for (int u = opq_bid(); u < DEPTH * 96; u += G) {
            const int l = u / 96, n0 = (u % 96) * 64, col = tid & 63, ks = tid >> 6;
            const float* w = p.in[I_WMOD] + (size_t)l * DM * 6144 + n0 + col;
            float a0 = 0.f, a1 = 0.f, a2 = 0.f, a3 = 0.f, a4 = 0.f;
#pragma unroll 8
            for (int k = ks * 128; k < ks * 128 + 128; ++k) { const float wv = w[(size_t)k * 6144];
                a0 += sl[k] * wv; a1 += sl[1024 + k] * wv; a2 += sl[2048 + k] * wv; a3 += sl[3072 + k] * wv; a4 += sl[4096 + k] * wv; }
            red[(ks * 5 + 0) * 64 + col] = a0; red[(ks * 5 + 1) * 64 + col] = a1; red[(ks * 5 + 2) * 64 + col] = a2; red[(ks * 5 + 3) * 64 + col] = a3; red[(ks * 5 + 4) * 64 + col] = a4;
            __syncthreads();
            if (tid < 320) { const int r = tid >> 6, c2 = tid & 63; float s = p.in[I_BMOD][l * 6144 + n0 + c2];
#pragma unroll
                for (int q = 0; q < 8; ++q) s += red[(q * 5 + r) * 64 + c2];
                p.modv[((size_t)l * 5 + r) * 6144 + n0 + c2] = s; }
            __syncthreads();
        }
    }
    for (int i = opq_bid() * 512 + tid; i < SEQ * 16; i += G * 512) { const int pos = i >> 4, a = i & 15;
        const float inv = exp2f(-(float)(a & 7) * (13.287712379549449f / 8.0f)); const float ang = (float)((a < 8) ? (pos >> 6) : (pos & 63)) * inv;
        float sn, cs; sincosf(ang, &sn, &cs); p.rope[(size_t)pos * 32 + a] = cs; p.rope[(size_t)pos * 32 + 16 + a] = sn; }
    if (opq_bid() == 1) { for (int i = tid; i < DEPTH * 2 * 512; i += 512) p.lrula[i] = -8.0f * 1.44269504f * log1pf(__expf(-p.in[I_LAM][i])); }
    if (opq_bid() == 0) {
        for (int i = tid; i < 2 * 512; i += 512) { const float a0 = p.in[I_HGLB][i], a1 = p.in[I_HGLB][1024 + i]; const float m = fmaxf(a0, a1);
            const float e0 = __expf(a0 - m), e1 = __expf(a1 - m); p.lbv[i] = 0.f; p.lbv[1024 + i] = e1 / (e0 + e1); }
    }
}

DEVI void phase_norm1(const Params& p, int l, int hb) {
    const int lane = opq_tid() & 63, wv = opq_tid() >> 6;
    const float* gm = p.in[I_NMIX] + l * DM;
    for (int rl = opq_bid() * 8 + wv; rl < HR; rl += gridDim.x * 8) {
        const int r = hb * HR + rl;
        const float* src = (l == 0) ? xin_row_l0(p, r) : (const float*)xbuf_row(p, r);
        f32x4 v[4]; float ss = 0.f;
#pragma unroll
        for (int i = 0; i < 4; ++i) { v[i] = *(const f32x4*)(src + i * 256 + lane * 4); ss += v[i][0] * v[i][0] + v[i][1] * v[i][1] + v[i][2] * v[i][2] + v[i][3] * v[i][3]; }
        ss = wave_sum(ss);
        const float rstd = rsqrtf(ss * (1.0f / DM) + EPSF);
        const float* mv = p.modv + ((size_t)l * 5 + mod_row(r)) * 6144;
#pragma unroll
        for (int i = 0; i < 4; ++i) { const int c = i * 256 + lane * 4;
            const f32x4 g = *(const f32x4*)(gm + c), sh = *(const f32x4*)(mv + c), sc = *(const f32x4*)(mv + 1024 + c);
            f32x4 h;
#pragma unroll
            for (int e = 0; e < 4; ++e) h[e] = v[i][e] * rstd * g[e] * (1.0f + sc[e]) + sh[e];
            u32x2 w; w.x = cvt_pk_bf16(h[0], h[1]); w.y = cvt_pk_bf16(h[2], h[3]);
            *(u32x2*)(p.hx + (size_t)rl * DM + c) = w; }
    }
}

struct TileSched {
    static constexpr bool GATHER = false;
    int nM, nN, G, c, skipctx; const char* A; const char* B; size_t atile, btile; size_t acol_bytes;
    DEVI bool next(int i, g8::Unit& u) const {
        int pm, pn; if (!g8::static_order(i, G, c, nM, nN, pm, pn)) return false;
        const int pma = skipctx ? pm + pm / 32 : pm;
        u.pm = pma; u.pn = pn; u.tag = 0; u.a = A + (size_t)pma * atile + acol_bytes; u.b = B + (size_t)pn * btile; return true; }
};

template <int ACT> struct EpiBf16 {
    static constexpr bool PERM = true, HAS_MID = false; static constexpr int NSEG = 1;
    bf16_t* O; int ldc;
    DEVI void operator()(const f32x4 (&acc)[2][2][4][2], const g8::Unit& u, int wr, int wc, int fr, int fq) const {
        const int row0 = u.pm * 256 + wr * 64 + fr, col0 = u.pn * 256 + wc * 32 + 8 * fq;
#pragma unroll
        for (int ai = 0; ai < 2; ++ai)
#pragma unroll
            for (int m = 0; m < 4; ++m) { bf16_t* rowp = O + (size_t)(row0 + ai * 128 + m * 16) * ldc + col0;
#pragma unroll
                for (int bj = 0; bj < 2; ++bj) { f32x4 v0 = acc[ai][bj][m][0], v1 = acc[ai][bj][m][1];
                    if (ACT == 1) {
#pragma unroll
                        for (int e = 0; e < 4; ++e) { v0[e] = sigmoidf_(v0[e]); v1[e] = sigmoidf_(v1[e]); } }
                    u32x4 w; w.x = cvt_pk_bf16(v0[0], v0[1]); w.y = cvt_pk_bf16(v0[2], v0[3]); w.z = cvt_pk_bf16(v1[0], v1[1]); w.w = cvt_pk_bf16(v1[2], v1[3]);
                    *(u32x4*)(rowp + bj * 128) = w; } }
    }
};

DEVI void phase_inproj_a(const Params& p, int l, LAS unsigned char* lds) {
    TileSched S; S.nM = HR / 256; S.nN = PA_W / 256; S.G = gridDim.x; S.c = opq_bid(); S.skipctx = 0;
    S.A = (const char*)p.hx; S.B = (const char*)(p.winA + (size_t)l * PA_W * DM); S.atile = (size_t)256 * DM * 2; S.btile = (size_t)256 * DM * 2; S.acol_bytes = 0;
    EpiBf16<0> E; E.O = p.pa; E.ldc = PA_W;
    g8::gemm_phase(lds, DM, DM, DM, S, E);
}

struct UpSched { static constexpr bool GATHER = false; int G, c; const char* A; const char* B;
    DEVI bool next(int i, g8::Unit& u) const { const long L = (long)i * G + c; if (L >= (HR / 256) * 7) return false;
        const int pm = (int)(L / 7), j = (int)(L % 7); u.pm = pm; u.pn = j; u.tag = 0;
        u.a = A + (size_t)pm * 256 * PA_W * 2 + (size_t)(j < 3 ? C_DQ : C_DKV) * 2; u.b = B + (size_t)j * 256 * 256 * 2; return true; } };
DEVI void phase_mla_up(const Params& p, int l, LAS unsigned char* lds) {
    UpSched S; S.G = gridDim.x; S.c = opq_bid(); S.A = (const char*)p.pa; S.B = (const char*)(p.wup + (size_t)l * UPW * 256);
    EpiBf16<0> E; E.O = p.up; E.ldc = UPW;
    g8::gemm_phase(lds, PA_W, 256, 256, S, E);
}

DEVI void phase_inproj_g(const Params& p, int l, LAS unsigned char* lds) {
    const int skip = (l == DEPTH - 1);
    TileSched S; S.nM = skip ? 64 : HR / 256; S.nN = PG_W / 256; S.G = gridDim.x; S.c = opq_bid(); S.skipctx = skip;
    S.A = (const char*)p.hx; S.B = (const char*)(p.winG + (size_t)l * PG_W * DM); S.atile = (size_t)256 * DM * 2; S.btile = (size_t)256 * DM * 2; S.acol_bytes = 0;
    EpiBf16<1> E; E.O = p.pa; E.ldc = PG_W;
    g8::gemm_phase(lds, DM, DM, DM, S, E);
}

struct EpiMerge {
    static constexpr bool PERM = false; static constexpr int NSEG = 3;
    const bf16_t* pg; bf16_t* Y;
    DEVI void mid(int sg, f32x4 (&acc)[2][2][4][2], const g8::Unit& u, int wr, int wc, int fr, int fq) const {
        const int row0 = u.pm * 256 + wr * 64 + fr, col0 = u.pn * 256 + wc * 32 + 4 * fq;
        const bf16_t* gbase = pg + (size_t)row0 * PG_W + col0 + sg * 1024;
#pragma unroll
        for (int ai = 0; ai < 2; ++ai)
#pragma unroll
            for (int m = 0; m < 4; ++m) { const bf16_t* gp = gbase + (size_t)(ai * 128 + m * 16) * PG_W;
#pragma unroll
                for (int bj = 0; bj < 2; ++bj)
#pragma unroll
                    for (int n = 0; n < 2; ++n) { const int co = bj * 128 + n * 16;
                        const u32x2 a = *(const u32x2*)(gp + co), b = *(const u32x2*)(gp + 1024 + co);
                        const float a0 = __uint_as_float(a.x << 16), a1 = __uint_as_float(a.x & 0xffff0000u), a2 = __uint_as_float(a.y << 16), a3 = __uint_as_float(a.y & 0xffff0000u);
                        const float b0 = __uint_as_float(b.x << 16), b1 = __uint_as_float(b.x & 0xffff0000u), b2 = __uint_as_float(b.y << 16), b3 = __uint_as_float(b.y & 0xffff0000u);
                        f32x4& v = acc[ai][bj][m][n];
                        v[0] *= a0 * fast_rcp(fmaxf(b0, 1e-30f)); v[1] *= a1 * fast_rcp(fmaxf(b1, 1e-30f)); v[2] *= a2 * fast_rcp(fmaxf(b2, 1e-30f)); v[3] *= a3 * fast_rcp(fmaxf(b3, 1e-30f)); }
                asm volatile("" : "+v"(acc[ai][0][m][0]), "+v"(acc[ai][0][m][1]), "+v"(acc[ai][1][m][0]), "+v"(acc[ai][1][m][1]) :: "memory"); }
    }
    DEVI void operator()(f32x4 (&acc)[2][2][4][2], const g8::Unit& u, int wr, int wc, int fr, int fq) const {
        const int row0 = u.pm * 256 + wr * 64 + fr, col0 = u.pn * 256 + wc * 32 + 4 * fq;
#pragma unroll
        for (int ai = 0; ai < 2; ++ai)
#pragma unroll
            for (int m = 0; m < 4; ++m) { const bf16_t* gp = pg + (size_t)(row0 + ai * 128 + m * 16) * PG_W + col0 + 2048;
#pragma unroll
                for (int bj = 0; bj < 2; ++bj)
#pragma unroll
                    for (int n = 0; n < 2; ++n) { const int co = bj * 128 + n * 16;
                        const u32x2 a = *(const u32x2*)(gp + co);
                        const float a0 = __uint_as_float(a.x << 16), a1 = __uint_as_float(a.x & 0xffff0000u), a2 = __uint_as_float(a.y << 16), a3 = __uint_as_float(a.y & 0xffff0000u);
                        const f32x4 v = acc[ai][bj][m][n];
                        u32x2 w; w.x = cvt_pk_bf16(v[0] * a0, v[1] * a1); w.y = cvt_pk_bf16(v[2] * a2, v[3] * a3);
                        *(u32x2*)(Y + (size_t)(row0 + ai * 128 + m * 16) * DM + col0 + co) = w; }
                asm volatile("" ::: "memory"); }
    }
};
DEVI void phase_merge(const Params& p, int l, LAS unsigned char* lds) {
    const int skip = (l == DEPTH - 1);
    TileSched S; S.nM = skip ? 64 : HR / 256; S.nN = DM / 256; S.G = gridDim.x; S.c = opq_bid(); S.skipctx = skip;
    S.A = (const char*)p.ocat; S.B = (const char*)(p.wcat + (size_t)l * DM * OCW); S.atile = (size_t)256 * OCW * 2; S.btile = (size_t)256 * OCW * 2; S.acol_bytes = 0;
    EpiMerge E; E.pg = p.pa; E.Y = p.y;
    g8::gemm_phase(lds, OCW, OCW, OCW, S, E);
}

struct EpiOut {
    static constexpr bool PERM = false, HAS_MID = false; static constexpr int NSEG = 1;
    const float* x0; const float* c0; float* xo_; float* xc_; const float* modv; int l, hb;
    DEVI void operator()(const f32x4 (&acc)[2][2][4][2], const g8::Unit& u, int wr, int wc, int fr, int fq) const {
        const int row0 = u.pm * 256 + wr * 64 + fr, col0 = u.pn * 256 + wc * 32 + 4 * fq;
#pragma unroll
        for (int ai = 0; ai < 2; ++ai)
#pragma unroll
            for (int m = 0; m < 4; ++m) { const int r = hb * HR + row0 + ai * 128 + m * 16;
                const int b = r / RB, pos = r - b * RB; const bool lat = pos < SEQ;
                const size_t xoff = lat ? ((size_t)b * SEQ + pos) * DM : ((size_t)b * CTX + (pos - SEQ)) * DM;
                float* xo = (lat ? xo_ : xc_) + xoff; const float* xi = (l == 0) ? (lat ? x0 : c0) + xoff : (const float*)xo;
                const float* g1 = modv + ((size_t)l * 5 + (lat ? b : 4)) * 6144 + 2048;
#pragma unroll
                for (int bj = 0; bj < 2; ++bj)
#pragma unroll
                    for (int n = 0; n < 2; ++n) { const int c = col0 + bj * 128 + n * 16;
                        const f32x4 xv = *(const f32x4*)(xi + c), gv = *(const f32x4*)(g1 + c);
                        *(f32x4*)(xo + c) = xv + gv * acc[ai][bj][m][n]; } }
    }
};
DEVI void phase_outproj(const Params& p, int l, int hb, LAS unsigned char* lds) {
    const int skip = (l == DEPTH - 1);
    TileSched S; S.nM = skip ? 64 : HR / 256; S.nN = DM / 256; S.G = gridDim.x; S.c = opq_bid(); S.skipctx = skip;
    S.A = (const char*)p.y; S.B = (const char*)(p.wout + (size_t)l * DM * DM); S.atile = (size_t)256 * DM * 2; S.btile = (size_t)256 * DM * 2; S.acol_bytes = 0;
    EpiOut E; E.x0 = p.in[I_X]; E.c0 = p.in[I_CTX]; E.xo_ = p.out; E.xc_ = p.xc; E.modv = p.modv; E.l = l; E.hb = hb;
    g8::gemm_phase(lds, DM, DM, DM, S, E);
}

DEVI void phase_qkv(const Params& p, int l, LAS unsigned char* lds) {
    const int tid = opq_tid(), lane = tid & 63, wv = tid >> 6, h = lane >> 3, sub = lane & 7;
    LAS bf16_t* vt = (LAS bf16_t*)lds;
    const float* gq = p.in[I_GQ] + l * 96; const float* gk = p.in[I_GK] + l * 96;
    float gqn[8], gkn[8], gqr[4], gkr[4];
#pragma unroll
    for (int e = 0; e < 8; ++e) { gqn[e] = gq[sub * 8 + e]; gkn[e] = gk[sub * 8 + e]; }
#pragma unroll
    for (int e = 0; e < 4; ++e) { gqr[e] = gq[64 + sub * 4 + e]; gkr[e] = gk[64 + sub * 4 + e]; }
    const float qscale = 0.10206207261596577f * 1.4426950408889634f;
    const bool need_ctx_q = (l < DEPTH - 1);
    const bool upper = (sub & 4) != 0;
    struct QkIn { u32x2 dqw; unsigned dkw; u32x2 krw; u32x4 qnw; u32x2 qrw; u32x4 knw, vw; f32x4 cs4, sn4; };
    auto load_rows = [&](int u, QkIn (&r)[2]) {
        const int bl = u / (NCH * 4), tile = (u >> 2) % NCH, qtr = u & 3;
#pragma unroll
        for (int it = 0; it < 2; ++it) { const int pos = tile * 64 + qtr * 16 + wv * 2 + it, rl = bl * RB + pos;
            const bf16_t* prow = p.pa + (size_t)rl * PA_W; const bf16_t* urow = p.up + (size_t)rl * UPW;
            r[it].dqw = *(const u32x2*)(prow + C_DQ + lane * 4); r[it].dkw = *(const unsigned*)(prow + C_DKV + lane * 2); r[it].krw = *(const u32x2*)(prow + C_KR + sub * 4);
            r[it].qnw = *(const u32x4*)(urow + h * 96 + sub * 8); r[it].qrw = *(const u32x2*)(urow + h * 96 + 64 + sub * 4);
            r[it].knw = *(const u32x4*)(urow + 768 + h * 128 + sub * 8); r[it].vw = *(const u32x4*)(urow + 768 + h * 128 + 64 + sub * 8);
            r[it].cs4 = (f32x4){1.f, 1.f, 1.f, 1.f}; r[it].sn4 = (f32x4){0.f, 0.f, 0.f, 0.f};
            if (pos < SEQ) { const float* rt = p.rope + (size_t)pos * 32 + (sub & 3) * 4; r[it].cs4 = *(const f32x4*)rt; r[it].sn4 = *(const f32x4*)(rt + 16); } } };
    QkIn cur[2], nxt[2];
    const int nunit = 2 * NCH * 4, G = gridDim.x;
    if ((int)opq_bid() < nunit) load_rows(opq_bid(), cur);
    for (int u = opq_bid(); u < nunit; u += G) {
        const int bl = u / (NCH * 4), tile = (u >> 2) % NCH, qtr = u & 3;
        const bool more = u + G < nunit; if (more) load_rows(u + G, nxt);
#pragma unroll
        for (int it = 0; it < 2; ++it) {
            const int r16 = wv * 2 + it, rr = qtr * 16 + r16, pos = tile * 64 + rr;
            const bool lat = pos < SEQ;
            const u32x2 dqw = cur[it].dqw; const unsigned dkw = cur[it].dkw; const u32x2 krw = cur[it].krw; const u32x4 qnw = cur[it].qnw; const u32x2 qrw = cur[it].qrw;
            const u32x4 knw = cur[it].knw, vw = cur[it].vw; const f32x4 cs4 = cur[it].cs4, sn4 = cur[it].sn4;
            float sq, skv;
            { const float a0 = __uint_as_float(dqw.x << 16), a1 = __uint_as_float(dqw.x & 0xffff0000u), a2 = __uint_as_float(dqw.y << 16), a3 = __uint_as_float(dqw.y & 0xffff0000u);
              sq = a0 * a0 + a1 * a1 + a2 * a2 + a3 * a3;
              const float b0 = __uint_as_float(dkw << 16), b1 = __uint_as_float(dkw & 0xffff0000u); skv = b0 * b0 + b1 * b1; }
            sq = wave_sum(sq); skv = wave_sum(skv);
            const float rq = rsqrtf(sq * (1.0f / 256.0f) + EPSF), rkv = rsqrtf(skv * (1.0f / 128.0f) + EPSF);
            float qn[8], qr[4], kn[8], kr[4];
#pragma unroll
            for (int e = 0; e < 8; ++e) { const unsigned a = qnw[e >> 1], b = knw[e >> 1];
                qn[e] = ((e & 1) ? __uint_as_float(a & 0xffff0000u) : __uint_as_float(a << 16)) * rq;
                kn[e] = ((e & 1) ? __uint_as_float(b & 0xffff0000u) : __uint_as_float(b << 16)) * rkv; }
#pragma unroll
            for (int e = 0; e < 4; ++e) { const unsigned a = (e < 2) ? qrw.x : qrw.y, b = (e < 2) ? krw.x : krw.y;
                qr[e] = ((e & 1) ? __uint_as_float(a & 0xffff0000u) : __uint_as_float(a << 16)) * rq;
                kr[e] = ((e & 1) ? __uint_as_float(b & 0xffff0000u) : __uint_as_float(b << 16)); }
            float sqq = 0.f, skk = 0.f;
#pragma unroll
            for (int e = 0; e < 8; ++e) { sqq += qn[e] * qn[e]; skk += kn[e] * kn[e]; }
#pragma unroll
            for (int e = 0; e < 4; ++e) { sqq += qr[e] * qr[e]; skk += kr[e] * kr[e]; }
            sqq += __shfl_xor(sqq, 1); sqq += __shfl_xor(sqq, 2); sqq += __shfl_xor(sqq, 4);
            skk += __shfl_xor(skk, 1); skk += __shfl_xor(skk, 2); skk += __shfl_xor(skk, 4);
            const float rnq = rsqrtf(sqq * (1.0f / 96.0f) + EPSF) * qscale, rnk = rsqrtf(skk * (1.0f / 96.0f) + EPSF);
            float qo[12], ko[12];
#pragma unroll
            for (int e = 0; e < 8; ++e) { qo[e] = qn[e] * rnq * gqn[e]; ko[e] = kn[e] * rnk * gkn[e]; }
#pragma unroll
            for (int e = 0; e < 4; ++e) { const float a = qr[e] * rnq * gqr[e], b = kr[e] * rnk * gkr[e];
                const float pa_ = __shfl_xor(a, 4), pb_ = __shfl_xor(b, 4);
                qo[8 + e] = upper ? (a * cs4[e] + pa_ * sn4[e]) : (a * cs4[e] - pa_ * sn4[e]);
                ko[8 + e] = upper ? (b * cs4[e] + pb_ * sn4[e]) : (b * cs4[e] - pb_ * sn4[e]); }
            if (lat || need_ctx_q) {
                bf16_t* qd = lat ? p.q + (((size_t)(bl * 8 + h) * SEQ + pos) * 96) : p.qc + (((size_t)(bl * 8 + h) * CTX + (pos - SEQ)) * 96);
                u32x4 w; w.x = cvt_pk_bf16(qo[0], qo[1]); w.y = cvt_pk_bf16(qo[2], qo[3]); w.z = cvt_pk_bf16(qo[4], qo[5]); w.w = cvt_pk_bf16(qo[6], qo[7]);
                *(u32x4*)(qd + sub * 8) = w;
                u32x2 w2; w2.x = cvt_pk_bf16(qo[8], qo[9]); w2.y = cvt_pk_bf16(qo[10], qo[11]);
                *(u32x2*)(qd + 64 + sub * 4) = w2; }
            { bf16_t* kd = (bf16_t*)(p.kv + ((size_t)(bl * 8 + h) * NCH + tile) * KVT_BYTES + rr * 208);
              u32x4 w; w.x = cvt_pk_bf16(ko[0], ko[1]); w.y = cvt_pk_bf16(ko[2], ko[3]); w.z = cvt_pk_bf16(ko[4], ko[5]); w.w = cvt_pk_bf16(ko[6], ko[7]);
              *(u32x4*)(kd + sub * 8) = w;
              u32x2 w2; w2.x = cvt_pk_bf16(ko[8], ko[9]); w2.y = cvt_pk_bf16(ko[10], ko[11]);
              *(u32x2*)(kd + 64 + sub * 4) = w2; }
#pragma unroll
            for (int e = 0; e < 8; ++e) { const unsigned a = vw[e >> 1]; const float v = ((e & 1) ? __uint_as_float(a & 0xffff0000u) : __uint_as_float(a << 16)) * rkv;
                vt[(h * 64 + sub * 8 + e) * 20 + r16] = f2bf(v); }
        }
        __syncthreads();
        for (int i = tid; i < 8 * 64 * 4; i += 512) { const int hh = i >> 8, rem = i & 255, vc = rem >> 2, pc = rem & 3;
            const u32x2 w = *(const LAS u32x2*)(vt + (hh * 64 + vc) * 20 + pc * 4);
            *(u32x2*)(p.kv + ((size_t)(bl * 8 + hh) * NCH + tile) * KVT_BYTES + KT_BYTES + vc * 136 + qtr * 32 + pc * 8) = w; }
        __syncthreads();
        if (more) { cur[0] = nxt[0]; cur[1] = nxt[1]; }
    }
}

DEVI void attn_unit(const Params& p, LAS unsigned char* lds, const bf16_t* Qb, int nq, const unsigned char* kvb, int ntile, bf16_t* orow, float accinit) {
    const int tid = opq_tid(), lane = tid & 63, wv = __builtin_amdgcn_readfirstlane(tid >> 6), l31 = lane & 31, hh = lane >> 5;
    const bool active = wv * 64 < nq;
    bf16x8 qf[2][6];
#pragma unroll
    for (int qt = 0; qt < 2; ++qt)
#pragma unroll
        for (int ks = 0; ks < 6; ++ks) {
            if (active) qf[qt][ks] = *(const bf16x8*)(Qb + (size_t)(wv * 64 + qt * 32 + l31) * 96 + ks * 16 + hh * 8);
            else qf[qt][ks] = (bf16x8){0, 0, 0, 0, 0, 0, 0, 0}; }
    f32x16 O[2][2];
#pragma unroll
    for (int a = 0; a < 2; ++a)
#pragma unroll
        for (int b = 0; b < 2; ++b)
#pragma unroll
            for (int i = 0; i < 16; ++i) O[a][b][i] = 0.f;
    float lsum[2] = {0.f, 0.f};
    constexpr int STG = 2 * KVT_BYTES;
    const int nstage = ntile >> 1;
    auto stage_in = [&](int sidx, int bsel) {
        const unsigned char* g = kvb + (size_t)sidx * STG + lane * 16;
        for (int pc = wv; pc < 43; pc += 8)
            __builtin_amdgcn_global_load_lds((const unsigned*)(g + pc * 1024), (LAS unsigned*)(lds + bsel * STG + pc * 1024), 16, 0, 0);
    };
    stage_in(0, 0);
    __syncthreads();
    if (wv >= 4) __builtin_amdgcn_s_setprio(1);
    for (int sg = 0; sg < nstage; ++sg) {
        if (sg + 1 < nstage) stage_in(sg + 1, (sg + 1) & 1);
        if (active) {
#pragma unroll 1
            for (int kt = 0; kt < 4; ++kt) {
                const LAS unsigned char* kb = lds + (sg & 1) * STG + (kt >> 1) * KVT_BYTES; const LAS unsigned char* vb = kb + KT_BYTES; const int ks2 = kt & 1;
                bf16x8 kf[6];
#pragma unroll
                for (int ks = 0; ks < 6; ++ks) kf[ks] = *(const LAS bf16x8*)(kb + (ks2 * 32 + l31) * 208 + ks * 32 + hh * 16);
                bf16x8 vf[2][2];
#pragma unroll
                for (int vtile = 0; vtile < 2; ++vtile)
#pragma unroll
                    for (int s2 = 0; s2 < 2; ++s2) { const LAS unsigned char* a = vb + (vtile * 32 + l31) * 136 + (ks2 * 32 + s2 * 16 + 4 * hh) * 2;
                        const u32x2 lo = *(const LAS u32x2*)a, hi = *(const LAS u32x2*)(a + 16);
                        u32x4 w; w.x = lo.x; w.y = lo.y; w.z = hi.x; w.w = hi.y; vf[vtile][s2] = __builtin_bit_cast(bf16x8, w); }
                f32x16 S0, S1;
#pragma unroll
                for (int i = 0; i < 16; ++i) { S0[i] = accinit; S1[i] = accinit; }
#pragma unroll
                for (int ks = 0; ks < 6; ++ks) S0 = __builtin_amdgcn_mfma_f32_32x32x16_bf16(kf[ks], qf[0][ks], S0, 0, 0, 0);

#pragma unroll
                for (int ks = 0; ks < 6; ++ks) S1 = __builtin_amdgcn_mfma_f32_32x32x16_bf16(kf[ks], qf[1][ks], S1, 0, 0, 0);
                bf16x8 pb0[2], pb1[2];
                { float ls = 0.f;
#pragma unroll
                  for (int i = 0; i < 16; ++i) { S0[i] = fast_exp2(S0[i]); ls += S0[i]; }
                  lsum[0] += ls;
#pragma unroll
                  for (int s2 = 0; s2 < 2; ++s2) { u32x4 w; w.x = cvt_pk_bf16(S0[8 * s2 + 0], S0[8 * s2 + 1]); w.y = cvt_pk_bf16(S0[8 * s2 + 2], S0[8 * s2 + 3]);
                      w.z = cvt_pk_bf16(S0[8 * s2 + 4], S0[8 * s2 + 5]); w.w = cvt_pk_bf16(S0[8 * s2 + 6], S0[8 * s2 + 7]); pb0[s2] = __builtin_bit_cast(bf16x8, w); } }

#pragma unroll
                for (int s2 = 0; s2 < 2; ++s2)
#pragma unroll
                    for (int vtile = 0; vtile < 2; ++vtile) O[0][vtile] = __builtin_amdgcn_mfma_f32_32x32x16_bf16(vf[vtile][s2], pb0[s2], O[0][vtile], 0, 0, 0);
                { float ls = 0.f;
#pragma unroll
                  for (int i = 0; i < 16; ++i) { S1[i] = fast_exp2(S1[i]); ls += S1[i]; }
                  lsum[1] += ls;
#pragma unroll
                  for (int s2 = 0; s2 < 2; ++s2) { u32x4 w; w.x = cvt_pk_bf16(S1[8 * s2 + 0], S1[8 * s2 + 1]); w.y = cvt_pk_bf16(S1[8 * s2 + 2], S1[8 * s2 + 3]);
                      w.z = cvt_pk_bf16(S1[8 * s2 + 4], S1[8 * s2 + 5]); w.w = cvt_pk_bf16(S1[8 * s2 + 6], S1[8 * s2 + 7]); pb1[s2] = __builtin_bit_cast(bf16x8, w); } }

#pragma unroll
                for (int s2 = 0; s2 < 2; ++s2)
#pragma unroll
                    for (int vtile = 0; vtile < 2; ++vtile) O[1][vtile] = __builtin_amdgcn_mfma_f32_32x32x16_bf16(vf[vtile][s2], pb1[s2], O[1][vtile], 0, 0, 0);
            }
        }
        __syncthreads();
    }
    __builtin_amdgcn_s_setprio(0);
    if (active) {
#pragma unroll
        for (int qt = 0; qt < 2; ++qt) {
            const float tot = lsum[qt] + __shfl_xor(lsum[qt], 32); const float inv = 1.0f / tot;
            bf16_t* orw = orow + (size_t)(wv * 64 + qt * 32 + l31) * OCW;
#pragma unroll
            for (int vtile = 0; vtile < 2; ++vtile)
#pragma unroll
                for (int g4 = 0; g4 < 4; ++g4) { u32x2 w; w.x = cvt_pk_bf16(O[qt][vtile][4 * g4 + 0] * inv, O[qt][vtile][4 * g4 + 1] * inv);
                    w.y = cvt_pk_bf16(O[qt][vtile][4 * g4 + 2] * inv, O[qt][vtile][4 * g4 + 3] * inv);
                    *(u32x2*)(orw + vtile * 32 + 8 * g4 + 4 * hh) = w; }
        }
    }
}

DEVI float attn_offset(const Params& p, int l) {
    const int lane = opq_tid() & 63;
    const float* gq = p.in[I_GQ] + l * 96; const float* gk = p.in[I_GK] + l * 96;
    float a = fmaxf(fabsf(gq[lane]), lane < 32 ? fabsf(gq[64 + lane]) : 0.f), b = fmaxf(fabsf(gk[lane]), lane < 32 ? fabsf(gk[64 + lane]) : 0.f);
    a = wave_max(a); b = wave_max(b);
    return -(9.797958971132712f * 1.4426950408889634f * a * b * 1.001f);
}

constexpr int HGP = 72;
constexpr int ZP = 68;
constexpr int HG_ZT0 = 0, HG_ZT1 = 17408, HG_KEY0 = 34816, HG_KEY1 = 52224, HG_VT = 69632, HG_KRM0 = 78848, HG_KRM1 = 88064, HG_QRM0 = 97280, HG_QRM1 = 106496,
              HG_S2T0 = 115712, HG_S2T1 = 124928, HG_A20 = 134144, HG_A21 = 143360, HG_GT = 152576  , HG_REF = 156672  , HG_BT = 157184  ,
              HG_O = HG_ZT0  ;
DEVI bf16x8 hg_frag_tr(const LAS unsigned char* tile, int k0, int c0, int lane) {
    const unsigned g = lane >> 4, q = (lane & 15) >> 2, pp = lane & 3;
    const unsigned a0 = (unsigned)(size_t)tile + (unsigned)((k0 + 8 * g + q) * (HGP * 2) + (c0 + 4 * pp) * 2), a1 = a0 + 4 * HGP * 2;
    u32x2 r0, r1;
    asm volatile("ds_read_b64_tr_b16 %0, %2\n\tds_read_b64_tr_b16 %1, %3\n\ts_waitcnt lgkmcnt(0)" : "=&v"(r0), "=&v"(r1) : "v"(a0), "v"(a1) : "memory");
    u32x4 w; w.x = r0.x; w.y = r0.y; w.z = r1.x; w.w = r1.y; return __builtin_bit_cast(bf16x8, w);
}

DEVI int hg_pos0(int tc) { return tc < 128 ? tc * 64 : SEQ + (tc - 128) * 64; }
DEVI int hg_chain_pos(int tc, int dir) { return dir ? (NCH - 1 - tc) : (tc < 128 ? tc + 4 : tc - 128); }

struct HgIn { u32x4 q, zf, zb, v, g, sf, sb; };
template <bool PASS3> DEVI void hg_load(const Params& p, int u, HgIn& r) {
    const int tid = opq_tid(), tk = tid >> 3, pc = tid & 7; const int tc = u % NCH, h = (u / NCH) & 7, bl = u / (NCH * 8);
    const bf16_t* prow = p.pa + (size_t)(bl * RB + hg_pos0(tc) + tk) * PA_W + h * 64 + pc * 8;
    r.zf = *(const u32x4*)(prow + C_ZF); r.zb = *(const u32x4*)(prow + C_ZB); r.v = *(const u32x4*)(prow + C_I);
    if (PASS3) { r.q = *(const u32x4*)(prow + C_Q); r.g = *(const u32x4*)(prow + C_G);
        const size_t uf = ((size_t)((bl * 2 + 0) * 8 + h)) * NCH + hg_chain_pos(tc, 0), ub = ((size_t)((bl * 2 + 1) * 8 + h)) * NCH + hg_chain_pos(tc, 1);
        r.sf = *(const u32x4*)(p.st + uf * 4096 + tk * 64 + pc * 8); r.sb = *(const u32x4*)(p.st + ub * 4096 + tk * 64 + pc * 8); }
}
DEVI float bfw(const u32x4& w, int e) { const unsigned x = w[e >> 1]; return (e & 1) ? __uint_as_float(x & 0xffff0000u) : __uint_as_float(x << 16); }

template <bool PASS3> DEVI void hg_prepare(const Params& p, int l, LAS unsigned char* lds, int h, const HgIn& r) {
    const int tid = opq_tid(), tk = tid >> 3, pc = tid & 7;
    LAS float* gt = (LAS float*)(lds + HG_GT); LAS float* refv = (LAS float*)(lds + HG_REF); LAS float* btv = (LAS float*)(lds + HG_BT);
    {
#pragma unroll
        for (int dir = 0; dir < 2; ++dir) {
            LAS float* zt = (LAS float*)(lds + (dir ? HG_ZT1 : HG_ZT0)); LAS float* keyt = (LAS float*)(lds + (dir ? HG_KEY1 : HG_KEY0));
            const float* lbp = p.lbv + ((size_t)l * 2 + dir) * 512 + h * 64 + pc * 8;
            float lf[8], ky[8];
#pragma unroll
            for (int e = 0; e < 8; ++e) { const float z = bfw(dir ? r.zb : r.zf, e); const float lb = lbp[e];
                const float ez = fast_exp2(-1.44269504f * fabsf(z)), opl = 1.0f + ez, rc = fast_rcp(opl);
                const float logsig = -(fmaxf(-z, 0.f) + 0.69314718f * __builtin_amdgcn_logf(opl));
                const float sigp = (z >= 0.f) ? rc : ez * rc;
                lf[e] = (lb > 0.f) ? 0.69314718f * __builtin_amdgcn_logf(lb + (1.0f - lb) * sigp) : logsig;
                ky[e] = (1.0f - lb) * (1.0f - sigp); }
            *(LAS f32x4*)(zt + tk * ZP + pc * 8) = (f32x4){lf[0], lf[1], lf[2], lf[3]}; *(LAS f32x4*)(zt + tk * ZP + pc * 8 + 4) = (f32x4){lf[4], lf[5], lf[6], lf[7]};
            *(LAS f32x4*)(keyt + tk * ZP + pc * 8) = (f32x4){ky[0], ky[1], ky[2], ky[3]}; *(LAS f32x4*)(keyt + tk * ZP + pc * 8 + 4) = (f32x4){ky[4], ky[5], ky[6], ky[7]}; }
        *(LAS u32x4*)(lds + HG_VT + (tk * HGP + pc * 8) * 2) = r.v;
    }
    __syncthreads();
    {
        const int d = tid & 63, jg = tid >> 6; float c0[8], c1[8]; float run = 0.f;
        LAS float* zt0 = (LAS float*)(lds + HG_ZT0); LAS float* zt1 = (LAS float*)(lds + HG_ZT1);
#pragma unroll
        for (int i = 0; i < 8; ++i) { run += zt0[(jg * 8 + i) * ZP + d]; c0[i] = run; }
        gt[jg * 64 + d] = run; run = 0.f;
#pragma unroll
        for (int i = 7; i >= 0; --i) { run += zt1[(jg * 8 + i) * ZP + d]; c1[i] = run; }
        gt[512 + jg * 64 + d] = run;
        __syncthreads();
        float off0 = 0.f, off1 = 0.f;
#pragma unroll
        for (int g2 = 0; g2 < 8; ++g2) { off0 += (g2 < jg) ? gt[g2 * 64 + d] : 0.f; off1 += (g2 > jg) ? gt[512 + g2 * 64 + d] : 0.f; }
#pragma unroll
        for (int i = 0; i < 8; ++i) { zt0[(jg * 8 + i) * ZP + d] = c0[i] + off0; zt1[(jg * 8 + i) * ZP + d] = c1[i] + off1; }
        if (jg == 3) refv[d] = c0[7] + off0;
        if (jg == 7) btv[d] = c0[7] + off0;
        if (jg == 4) refv[64 + d] = c1[0] + off1;
        if (jg == 0) btv[64 + d] = c1[0] + off1;
    }
    __syncthreads();
    {
#pragma unroll
        for (int dir = 0; dir < 2; ++dir) {
            const LAS float* zt = (const LAS float*)(lds + (dir ? HG_ZT1 : HG_ZT0)); const LAS float* keyt = (const LAS float*)(lds + (dir ? HG_KEY1 : HG_KEY0));
            float kt[8], qt[8];
            const f32x4 z0 = *(const LAS f32x4*)(zt + tk * ZP + pc * 8), z1 = *(const LAS f32x4*)(zt + tk * ZP + pc * 8 + 4);
            const f32x4 k0 = *(const LAS f32x4*)(keyt + tk * ZP + pc * 8), k1 = *(const LAS f32x4*)(keyt + tk * ZP + pc * 8 + 4);
            const f32x4 r0 = *(const LAS f32x4*)(refv + dir * 64 + pc * 8), r1 = *(const LAS f32x4*)(refv + dir * 64 + pc * 8 + 4);
#pragma unroll
            for (int e = 0; e < 8; ++e) { const float bc = e < 4 ? z0[e & 3] : z1[e & 3], rf = e < 4 ? r0[e & 3] : r1[e & 3], ke = e < 4 ? k0[e & 3] : k1[e & 3];
                kt[e] = ke * fast_exp2(1.44269504f * fminf(rf - bc, 80.f)); if (PASS3) qt[e] = bfw(r.q, e) * fast_exp2(1.44269504f * fminf(bc - rf, 80.f)); }
            { u32x4 w; w.x = cvt_pk_bf16(kt[0], kt[1]); w.y = cvt_pk_bf16(kt[2], kt[3]); w.z = cvt_pk_bf16(kt[4], kt[5]); w.w = cvt_pk_bf16(kt[6], kt[7]);
              *(LAS u32x4*)(lds + (dir ? HG_KRM1 : HG_KRM0) + (tk * HGP + pc * 8) * 2) = w; }
            if (PASS3) {
                u32x4 w; w.x = cvt_pk_bf16(qt[0], qt[1]); w.y = cvt_pk_bf16(qt[2], qt[3]); w.z = cvt_pk_bf16(qt[4], qt[5]); w.w = cvt_pk_bf16(qt[6], qt[7]);
                *(LAS u32x4*)(lds + (dir ? HG_QRM1 : HG_QRM0) + (tk * HGP + pc * 8) * 2) = w;
                const float er = fast_exp2(1.44269504f * refv[dir * 64 + tk]); float sv[8];
#pragma unroll
                for (int e = 0; e < 8; ++e) sv[e] = bfw(dir ? r.sb : r.sf, e) * er;
                w.x = cvt_pk_bf16(sv[0], sv[1]); w.y = cvt_pk_bf16(sv[2], sv[3]); w.z = cvt_pk_bf16(sv[4], sv[5]); w.w = cvt_pk_bf16(sv[6], sv[7]);
                *(LAS u32x4*)(lds + (dir ? HG_S2T1 : HG_S2T0) + (tk * HGP + pc * 8) * 2) = w;
            }
        }
    }
    __syncthreads();
}
DEVI bf16x8 hg_frag(const LAS unsigned char* base, int r, int c0) { return *(const LAS bf16x8*)(base + (size_t)(r * HGP + c0) * 2); }

DEVI void hg_pass1_unit(const Params& p, int l, LAS unsigned char* lds, int u, const HgIn& r) {
    const int tc = u % NCH, h = (u / NCH) & 7, bl = u / (NCH * 8);
    hg_prepare<false>(p, l, lds, h, r);
    const int tid = opq_tid(), lane = tid & 63, wv = tid >> 6, l15 = lane & 15, g = lane >> 4;
    const LAS float* refv = (const LAS float*)(lds + HG_REF); const LAS float* btv = (const LAS float*)(lds + HG_BT);
    const int dt = wv >> 1, ct0 = (wv & 1) * 2;
#pragma unroll
    for (int dir = 0; dir < 2; ++dir) {
        const size_t unit = ((size_t)((bl * 2 + dir) * 8 + h)) * NCH + hg_chain_pos(tc, dir);
        bf16_t* so = p.st + unit * 4096;
        const LAS unsigned char* krm = lds + (dir ? HG_KRM1 : HG_KRM0);
        bf16x8 af[2];
#pragma unroll
        for (int ks = 0; ks < 2; ++ks) af[ks] = hg_frag_tr(krm, 32 * ks, 16 * dt, lane);
#pragma unroll
        for (int ci = 0; ci < 2; ++ci) { const int ct = ct0 + ci; f32x4 acc = {0.f, 0.f, 0.f, 0.f};
#pragma unroll
            for (int ks = 0; ks < 2; ++ks) acc = __builtin_amdgcn_mfma_f32_16x16x32_bf16(af[ks], hg_frag_tr(lds + HG_VT, 32 * ks, 16 * ct, lane), acc, 0, 0, 0);
#pragma unroll
            for (int rr = 0; rr < 4; ++rr) { const int d = 16 * dt + 4 * g + rr; so[d * 64 + 16 * ct + l15] = f2bf(acc[rr] * fast_exp2(1.44269504f * (btv[dir * 64 + d] - refv[dir * 64 + d]))); } }
        if (tid < 64) p.stb[unit * 64 + tid] = btv[dir * 64 + tid];
    }
    __syncthreads();
}

DEVI void hg_pass3_unit(const Params& p, int l, LAS unsigned char* lds, int u, const HgIn& r) {
    const int tc = u % NCH, h = (u / NCH) & 7, bl = u / (NCH * 8);
    const int tid = opq_tid(), lane = tid & 63, wv = tid >> 6, l15 = lane & 15, g = lane >> 4;
    hg_prepare<true>(p, l, lds, h, r);
    { const int tt = wv >> 1, st0 = (wv & 1) * 2;
#pragma unroll
      for (int dir = 0; dir < 2; ++dir) {
          const LAS unsigned char* qrm = lds + (dir ? HG_QRM1 : HG_QRM0); const LAS unsigned char* krm = lds + (dir ? HG_KRM1 : HG_KRM0); LAS bf16_t* a2 = (LAS bf16_t*)(lds + (dir ? HG_A21 : HG_A20));
          bf16x8 bq[2];
#pragma unroll
          for (int ks = 0; ks < 2; ++ks) bq[ks] = hg_frag(qrm, 16 * tt + l15, 32 * ks + 8 * g);
#pragma unroll
          for (int si = 0; si < 2; ++si) { const int st = st0 + si; f32x4 acc = {0.f, 0.f, 0.f, 0.f};
#pragma unroll
              for (int ks = 0; ks < 2; ++ks) acc = __builtin_amdgcn_mfma_f32_16x16x32_bf16(hg_frag(krm, 16 * st + l15, 32 * ks + 8 * g), bq[ks], acc, 0, 0, 0);
              const int t = 16 * tt + l15, s0 = 16 * st + 4 * g; float v[4];
#pragma unroll
              for (int e = 0; e < 4; ++e) v[e] = (dir == 0 ? (s0 + e <= t) : (s0 + e >= t)) ? acc[e] : 0.f;
              u32x2 w; w.x = cvt_pk_bf16(v[0], v[1]); w.y = cvt_pk_bf16(v[2], v[3]);
              *(LAS u32x2*)(a2 + t * HGP + s0) = w; } } }
    __syncthreads();
    { const int tt = wv >> 1, ct0 = (wv & 1) * 2; LAS float* olds = (LAS float*)(lds + HG_O);
      f32x4 acc[2] = {{0.f, 0.f, 0.f, 0.f}, {0.f, 0.f, 0.f, 0.f}};
#pragma unroll
      for (int dir = 0; dir < 2; ++dir) {
          const LAS unsigned char* qrm = lds + (dir ? HG_QRM1 : HG_QRM0); const LAS unsigned char* a2 = lds + (dir ? HG_A21 : HG_A20); const LAS unsigned char* s2t = lds + (dir ? HG_S2T1 : HG_S2T0);
          bf16x8 aa[2], aq[2];
#pragma unroll
          for (int ks = 0; ks < 2; ++ks) { aa[ks] = hg_frag(a2, 16 * tt + l15, 32 * ks + 8 * g); aq[ks] = hg_frag(qrm, 16 * tt + l15, 32 * ks + 8 * g); }
#pragma unroll
          for (int ci = 0; ci < 2; ++ci) { const int ct = ct0 + ci;
#pragma unroll
              for (int ks = 0; ks < 2; ++ks) acc[ci] = __builtin_amdgcn_mfma_f32_16x16x32_bf16(aa[ks], hg_frag_tr(lds + HG_VT, 32 * ks, 16 * ct, lane), acc[ci], 0, 0, 0);
#pragma unroll
              for (int ks = 0; ks < 2; ++ks) acc[ci] = __builtin_amdgcn_mfma_f32_16x16x32_bf16(aq[ks], hg_frag_tr(s2t, 32 * ks, 16 * ct, lane), acc[ci], 0, 0, 0); } }
#pragma unroll
      for (int ci = 0; ci < 2; ++ci)
#pragma unroll
          for (int rr = 0; rr < 4; ++rr) olds[(16 * tt + 4 * g + rr) * 65 + 16 * (ct0 + ci) + l15] = acc[ci][rr]; }
    __syncthreads();
    { const int tok = tid >> 3, pc = tid & 7; const int row = bl * RB + hg_pos0(tc) + tok; const LAS float* olds = (const LAS float*)(lds + HG_O);
      float o[8]; float ss = 0.f;
#pragma unroll
      for (int e = 0; e < 8; ++e) { o[e] = olds[tok * 65 + pc * 8 + e]; ss += o[e] * o[e]; }
      ss += __shfl_xor(ss, 1); ss += __shfl_xor(ss, 2); ss += __shfl_xor(ss, 4);
      const float rstd = rsqrtf(ss * (1.0f / 64.0f) + EPSF);
      const float* gn = p.in[I_HGNORM] + l * 64 + pc * 8;
      float rr[8];
#pragma unroll
      for (int e = 0; e < 8; ++e) rr[e] = o[e] * rstd * gn[e] * sigmoidf_(bfw(r.g, e));
      u32x4 w; w.x = cvt_pk_bf16(rr[0], rr[1]); w.y = cvt_pk_bf16(rr[2], rr[3]); w.z = cvt_pk_bf16(rr[4], rr[5]); w.w = cvt_pk_bf16(rr[6], rr[7]);
      *(u32x4*)(p.ocat + (size_t)row * OCW + h * 64 + pc * 8) = w; }
    __syncthreads();
}

DEVI void hg_prefix(const Params& p, bool dry = false) {
    const int total = 2 * 2 * 8 * 4096;
    for (int gidx = opq_bid() * 512 + opq_tid(); gidx < total; gidx += gridDim.x * 512) {
        const int chain = gidx >> 12, e = gidx & 4095, d = e >> 6;
        bf16_t* s = p.st + (size_t)chain * NCH * 4096 + e; const float* bt = p.stb + (size_t)chain * NCH * 64 + d;
        float S = 0.f;
#pragma unroll 1
        for (int q0 = 0; q0 < NCH; q0 += 12) { float loc[12], b[12];
#pragma unroll
            for (int i = 0; i < 12; ++i) { loc[i] = bf2f(s[(size_t)(q0 + i) * 4096]); b[i] = bt[(q0 + i) * 64]; }
#pragma unroll
            for (int i = 0; i < 12; ++i) { if (!dry) s[(size_t)(q0 + i) * 4096] = f2bf(S); S = S * fast_exp2(1.44269504f * b[i]) + loc[i]; } }
        if (dry && S == 123.456f) s[0] = 0;
    }
}

constexpr int LR_UB = 0, LR_UP = 520, LR_AF = 16640, LR_IF = LR_AF + 32768, LR_AB = LR_IF + 32768, LR_IB = LR_AB + 32768;
constexpr int NT16 = RB / 16;

DEVI int lr_pos0(int tt) { return tt * 16; }
DEVI int lr_chain_pos(int tt, int dir) { return dir ? (NT16 - 1 - tt) : (tt < 512 ? tt + 16 : tt - 512); }

struct LruW { bf16x8 b[2][4][2]; float ba[4], bx[4], la[4]; };
DEVI void lru_load_w(const Params& p, int l, int dir, int n, int l15, int g, LruW& w) {
#pragma unroll
    for (int which = 0; which < 2; ++which)
#pragma unroll
        for (int ct = 0; ct < 4; ++ct)
#pragma unroll
            for (int ks = 0; ks < 2; ++ks)
                w.b[which][ct][ks] = *(const bf16x8*)(p.wlru + ((((size_t)(l * 2 + dir) * 8 + n) * 2 + which) * 64 + 16 * ct + l15) * 64 + 32 * ks + 8 * g);
#pragma unroll
    for (int ct = 0; ct < 4; ++ct) { const int c = (l * 2 + dir) * 512 + n * 64 + 16 * ct + l15;
        w.ba[ct] = p.in[I_LBA][c]; w.bx[ct] = p.in[I_LBX][c]; w.la[ct] = p.lrula[c]; }
}
struct LrIn { bf16_t x[19]; bf16_t y[16]; float h_in; };
template <int MODE> DEVI void lru_load(const Params& p, int u, LrIn& r) {
    const int bl = u / NT16, tt = u % NT16, c = opq_tid();
    const int pos0 = tt * 16, seg0 = tt < 512 ? 0 : SEQ, seg1 = tt < 512 ? SEQ : RB;
    const bf16_t* xx = p.pa + (size_t)bl * RB * PA_W + C_LX + c;
#pragma unroll
    for (int i = 0; i < 19; ++i) { const int pos = pos0 - 2 + i; r.x[i] = (pos >= seg0 && pos < seg1) ? xx[(size_t)pos * PA_W] : (bf16_t)0; }
    if (MODE == 2) { const bf16_t* yy = p.pa + ((size_t)bl * RB + pos0) * PA_W + C_LY + c;
#pragma unroll
        for (int t = 0; t < 16; ++t) r.y[t] = yy[(size_t)t * PA_W]; }
    if (MODE == 1) r.h_in = p.lin[((size_t)(bl * 2 + 0) * NT16 + lr_chain_pos(tt, 0)) * 512 + c];
    if (MODE == 2) r.h_in = p.lin[((size_t)(bl * 2 + 1) * NT16 + lr_chain_pos(tt, 1)) * 512 + c];
}
#define LR_WAVE_SYNC() do { asm volatile("s_waitcnt lgkmcnt(0)" ::: "memory"); __builtin_amdgcn_wave_barrier(); } while (0)
DEVI void lru_tile_gates(const Params& p, int l, LAS unsigned char* lds, const LrIn& in, const LruW& w) {
    const int tid = opq_tid(), lane = tid & 63, n = tid >> 6, l15 = lane & 15, g = lane >> 4;
    LAS bf16_t* ub = (LAS bf16_t*)(lds + LR_UB);
    {
        const int c = tid;
        const float* cw = p.in[I_CONVW] + (size_t)l * 4 * 512; const float w0 = cw[c], w1 = cw[512 + c], w2 = cw[1024 + c], w3 = cw[1536 + c], cb = p.in[I_CONVB][l * 512 + c];
        float x[19];
#pragma unroll
        for (int i = 0; i < 19; ++i) x[i] = bf2f(in.x[i]);
#pragma unroll
        for (int t = 0; t < 16; ++t) ub[t * LR_UP + c] = f2bf(cb + w0 * x[t] + w1 * x[t + 1] + w2 * x[t + 2] + w3 * x[t + 3]);
    }
    LR_WAVE_SYNC();
    bf16x8 af[2];
#pragma unroll
    for (int ks = 0; ks < 2; ++ks) af[ks] = *(const LAS bf16x8*)(ub + l15 * LR_UP + n * 64 + 32 * ks + 8 * g);
    LAS float* aL = (LAS float*)(lds + LR_AF); LAS float* iL = (LAS float*)(lds + LR_IF);
#pragma unroll
    for (int ct = 0; ct < 4; ++ct) {
        f32x4 ra = {0.f, 0.f, 0.f, 0.f}, xa = {0.f, 0.f, 0.f, 0.f};
#pragma unroll
        for (int ks = 0; ks < 2; ++ks) { ra = __builtin_amdgcn_mfma_f32_16x16x32_bf16(af[ks], w.b[0][ct][ks], ra, 0, 0, 0); xa = __builtin_amdgcn_mfma_f32_16x16x32_bf16(af[ks], w.b[1][ct][ks], xa, 0, 0, 0); }
        const int c = n * 64 + 16 * ct + l15;
#pragma unroll
        for (int r = 0; r < 4; ++r) { const int t = 4 * g + r;
            const float rg = sigmoidf_(ra[r] + w.ba[ct]), ig = sigmoidf_(xa[r] + w.bx[ct]);
            const float a = fast_exp2(rg * w.la[ct]); const float uu = bf2f(ub[t * LR_UP + c]);
            aL[t * 512 + c] = a; iL[t * 512 + c] = __builtin_amdgcn_sqrtf(fmaxf(1.0f - a * a, 0.f)) * ig * uu; }
    }
    LR_WAVE_SYNC();
}
template <int MODE> DEVI void lru_sweep(const Params& p, int l, LAS unsigned char* lds, int dir, int u0, int uend, int ubase, bool skipc) {
    const int tid = opq_tid(), lane = tid & 63, n = tid >> 6, l15 = lane & 15, g = lane >> 4, G = gridDim.x;
    if (u0 >= uend) return;
    LruW w; lru_load_w(p, l, dir, n, l15, g, w);
    const LAS float* aL = (const LAS float*)(lds + LR_AF); const LAS float* iL = (const LAS float*)(lds + LR_IF);
    LrIn cur, nxt; lru_load<MODE>(p, u0 - ubase, cur);
    for (int u = u0; u < uend; u += G) {
        const bool more = u + G < uend; if (more) lru_load<MODE>(p, u + G - ubase, nxt);
        const int uu = u - ubase, bl = uu / NT16, tt = uu % NT16;
        if (!(skipc && tt >= 512)) {
            lru_tile_gates(p, l, lds, cur, w);
            if (MODE == 0) { float A = 1.f, H = 0.f;
#pragma unroll
                for (int t = 0; t < 16; ++t) { const float a = aL[t * 512 + tid], b = iL[t * 512 + tid]; if (dir == 0) { H = a * H + b; A *= a; } else { H += b * A; A *= a; } }
                *((f32x2_t*)p.lsum + ((size_t)(bl * 2 + dir) * NT16 + lr_chain_pos(tt, dir)) * 512 + tid) = (f32x2_t){A, H};
            } else { bf16_t* ocol = p.ocat + ((size_t)bl * RB + lr_pos0(tt)) * OCW + 1024 + tid; float h = cur.h_in;
                if (MODE == 1) {
#pragma unroll
                    for (int t = 0; t < 16; ++t) { h = aL[t * 512 + tid] * h + iL[t * 512 + tid]; ocol[(size_t)t * OCW] = f2bf(h); }
                } else {
                    float hfv[16];
#pragma unroll
                    for (int t = 0; t < 16; ++t) hfv[t] = bf2f(ocol[(size_t)t * OCW]);
#pragma unroll
                    for (int t = 15; t >= 0; --t) { h = aL[t * 512 + tid] * h + iL[t * 512 + tid];
                        const float y = bf2f(cur.y[t]); const float x3 = 0.7978845608028654f * (y + 0.044715f * y * y * y);
                        const float th = 1.0f - 2.0f * fast_rcp(1.0f + fast_exp2(2.88539008f * x3));
                        ocol[(size_t)t * OCW] = f2bf((hfv[t] + h) * 0.5f * y * (1.0f + th)); } }
            }
            LR_WAVE_SYNC();
        }
        if (more) cur = nxt;
    }
}
DEVI void lru_prefix(const Params& p, bool dry = false) {
    const int lane = opq_tid() & 63, wv = opq_tid() >> 6;
    for (int chain = opq_bid() * 8 + wv; chain < 2 * 2 * 512; chain += gridDim.x * 8) {
        const int c = chain & 511, bd = chain >> 9;
        const f32x2_t* src = (const f32x2_t*)p.lsum + (size_t)bd * NT16 * 512 + c; float* dst = p.lin + (size_t)bd * NT16 * 512 + c;
        f32x2_t v[9]; float A = 1.f, H = 0.f;
#pragma unroll
        for (int i = 0; i < 9; ++i) { const int q = lane * 9 + i; v[i] = (q < NT16) ? src[(size_t)q * 512] : (f32x2_t){1.f, 0.f}; H = v[i].x * H + v[i].y; A *= v[i].x; }
#pragma unroll
        for (int o = 1; o < 64; o <<= 1) { const float Ap = __shfl_up(A, o), Hp = __shfl_up(H, o); if (lane >= o) { H = A * Hp + H; A = A * Ap; } }
        float h = __shfl_up(H, 1); if (lane == 0) h = 0.f;
#pragma unroll
        for (int i = 0; i < 9; ++i) { const int q = lane * 9 + i; if (q < NT16 && !dry) dst[(size_t)q * 512] = h; h = v[i].x * h + v[i].y; }
        if (dry && h == 123.456f) dst[0] = 0.f;
    }
}
DEVI void phase_attn_scan1(const Params& p, int l, LAS unsigned char* lds, int parts = 7) {
    const int nA = 2 * 8 * 16 + (l == 0 ? 16 : 0), nH = 2 * 8 * NCH, nL = 2 * NT16, G = gridDim.x;
    const float accinit = attn_offset(p, l);
    int u = opq_bid();
    for (; u < 256; u += G) { const int bl = u >> 7, h = (u >> 4) & 7, qb = u & 15; if (!(parts & 1)) continue;
        attn_unit(p, lds, p.q + ((size_t)(bl * 8 + h) * SEQ + qb * 512) * 96, 512, p.kv + (size_t)(bl * 8 + h) * NCH * KVT_BYTES, NCH,
                  p.ocat + (size_t)(bl * RB + qb * 512) * OCW + 512 + h * 64, accinit); }
    for (; u < nA; u += G) { const int uu = u - 256, bl = uu >> 3, h = uu & 7; if (!(parts & 1)) continue;
        attn_unit(p, lds, p.qc + ((size_t)(bl * 8 + h) * CTX) * 96, 256, p.kv + ((size_t)(bl * 8 + h) * NCH + 128) * KVT_BYTES, 4,
                  p.ocat + (size_t)(bl * RB + SEQ) * OCW + 512 + h * 64, accinit); }
    if (parts & 2) { HgIn cur, nxt; if (u < nA + nH) hg_load<false>(p, u - nA, cur);
        for (; u < nA + nH; u += G) { const bool more = u + G < nA + nH; if (more) hg_load<false>(p, u + G - nA, nxt); hg_pass1_unit(p, l, lds, u - nA, cur); if (more) cur = nxt; } }
    else { for (; u < nA + nH; u += G) {} }
    if (parts & 4) { lru_sweep<0>(p, l, lds, 0, u, nA + nH + nL, nA + nH, false); lru_sweep<0>(p, l, lds, 1, u, nA + nH + nL, nA + nH, false); }
}
DEVI void phase_prefix(const Params& p, LAS unsigned char* lds, bool dry = false) { (void)lds; hg_prefix(p, dry); lru_prefix(p, dry); }
DEVI void phase_scan3(const Params& p, int l, LAS unsigned char* lds, int parts = 3) {
    const int nH = 2 * 8 * NCH, nL = 2 * NT16, G = gridDim.x; const bool skipc = (l == DEPTH - 1);
    int u = opq_bid();
    if (parts & 1) { HgIn cur, nxt; if (u < nH) hg_load<true>(p, u, cur);
        for (; u < nH; u += G) { const bool more = u + G < nH; if (more) hg_load<true>(p, u + G, nxt);
            if (!(skipc && (u % NCH) >= 128)) hg_pass3_unit(p, l, lds, u, cur);
            if (more) cur = nxt; } }
    else { for (; u < nH; u += G) {} }
    if (parts & 2) { lru_sweep<1>(p, l, lds, 0, u, nH + nL, nH, skipc); lru_sweep<2>(p, l, lds, 1, u, nH + nL, nH, skipc); }
}

constexpr int RP = 2 * TT + 4096;

DEVI void phase_norm2_route(const Params& p, int l, LAS unsigned char* lds) {
    const int tid = opq_tid(), lane = tid & 63, wv = tid >> 6; const bool skipc = (l == DEPTH - 1);
    LAS int* cntl = (LAS int*)lds;
    LAS int* basel = cntl + 16;
    LAS int* rinfo = cntl + 64;
    LAS float* rw = (LAS float*)(rinfo + 4 * 8 * 20);
    if (tid < 16) cntl[tid] = 0;
    __syncthreads();
    const float* gm = p.in[I_NFFN] + l * DM;
    const float* wrg = p.in[I_WRG] + (size_t)l * DM * 4; const float* wre = p.in[I_WRE] + (size_t)l * DM * 16;
    int it = 0;
    for (int r = opq_bid() * 8 + wv; r < TT; r += gridDim.x * 8, ++it) {
        const int pos = r % RB; const bool skip = skipc && pos >= SEQ;
        if (skip) { if (lane == 0) rinfo[(it * 8 + wv) * 4] = -1; continue; }
        const float* src = xbuf_row(p, r);
        f32x4 v[4]; float ss = 0.f;
#pragma unroll
        for (int i = 0; i < 4; ++i) { v[i] = *(const f32x4*)(src + i * 256 + lane * 4); ss += v[i][0] * v[i][0] + v[i][1] * v[i][1] + v[i][2] * v[i][2] + v[i][3] * v[i][3]; }
        ss = wave_sum(ss);
        const float rstd = rsqrtf(ss * (1.0f / DM) + EPSF);
        const float* mv = p.modv + ((size_t)l * 5 + mod_row(r)) * 6144;
        f32x4 lg = {0.f, 0.f, 0.f, 0.f}, le0 = lg, le1 = lg, le2 = lg, le3 = lg;
#pragma unroll
        for (int i = 0; i < 4; ++i) { const int c = i * 256 + lane * 4;
            const f32x4 g = *(const f32x4*)(gm + c), sh = *(const f32x4*)(mv + 3072 + c), sc = *(const f32x4*)(mv + 4096 + c);
            f32x4 h;
#pragma unroll
            for (int e = 0; e < 4; ++e) h[e] = v[i][e] * rstd * g[e] * (1.0f + sc[e]) + sh[e];
            u32x2 w; w.x = cvt_pk_bf16(h[0], h[1]); w.y = cvt_pk_bf16(h[2], h[3]);
            *(u32x2*)(p.h2 + (size_t)r * DM + c) = w;
#pragma unroll
            for (int e = 0; e < 4; ++e) { const float* wr_ = wre + (size_t)(c + e) * 16;
                lg += h[e] * *(const f32x4*)(wrg + (size_t)(c + e) * 4);
                le0 += h[e] * *(const f32x4*)(wr_); le1 += h[e] * *(const f32x4*)(wr_ + 4); le2 += h[e] * *(const f32x4*)(wr_ + 8); le3 += h[e] * *(const f32x4*)(wr_ + 12); } }
#pragma unroll
        for (int e = 0; e < 4; ++e) { lg[e] = wave_sum(lg[e]); le0[e] = wave_sum(le0[e]); le1[e] = wave_sum(le1[e]); le2[e] = wave_sum(le2[e]); le3[e] = wave_sum(le3[e]); }
        if (lane == 0) {
            const float* brg = p.in[I_BRG] + l * 4; const float* bre = p.in[I_BRE] + l * 16;
            int gs = 0; float best = lg[0] + brg[0];
#pragma unroll
            for (int e = 1; e < 4; ++e) { const float t = lg[e] + brg[e]; if (t > best) { best = t; gs = e; } }
            const float m = fmaxf(fmaxf(lg[0], lg[1]), fmaxf(lg[2], lg[3]));
            const float e0 = __expf(lg[0] - m), e1 = __expf(lg[1] - m), e2 = __expf(lg[2] - m), e3 = __expf(lg[3] - m);
            const float pg = (gs == 0 ? e0 : gs == 1 ? e1 : gs == 2 ? e2 : e3) / (e0 + e1 + e2 + e3);
            const f32x4 lv = (gs == 0) ? le0 : (gs == 1) ? le1 : (gs == 2) ? le2 : le3;
            const f32x4 bv = lv + *(const f32x4*)(bre + gs * 4);
            int i0 = 0; float m0 = bv[0], l0 = lv[0];
#pragma unroll
            for (int e = 1; e < 4; ++e) if (bv[e] > m0) { m0 = bv[e]; i0 = e; l0 = lv[e]; }
            int i1 = -1; float m1 = -3.0e38f, l1 = 0.f;
#pragma unroll
            for (int e = 0; e < 4; ++e) if (e != i0 && bv[e] > m1) { m1 = bv[e]; i1 = e; l1 = lv[e]; }
            const float mm = fmaxf(l0, l1), x0 = __expf(l0 - mm), x1 = __expf(l1 - mm);
            const float w0 = x0 / (x0 + x1) * pg, w1 = x1 / (x0 + x1) * pg;
            const int ea = gs * 4 + i0, eb = gs * 4 + i1;
            const int sa = __hip_atomic_fetch_add(&cntl[ea], 1, __ATOMIC_RELAXED, __HIP_MEMORY_SCOPE_WORKGROUP), sb = __hip_atomic_fetch_add(&cntl[eb], 1, __ATOMIC_RELAXED, __HIP_MEMORY_SCOPE_WORKGROUP);
            const int q = (it * 8 + wv) * 4; rinfo[q] = ea; rinfo[q + 1] = eb; rinfo[q + 2] = sa; rinfo[q + 3] = sb;
            rw[(it * 8 + wv) * 2] = w0; rw[(it * 8 + wv) * 2 + 1] = w1;
        }
    }
    __syncthreads();
    if (tid < 16) basel[tid] = (int)atomicAdd(&p.ctrl[CTRL_CNT(l, tid)], (unsigned)cntl[tid]);
    __syncthreads();
    it = 0;
    for (int r = opq_bid() * 8 + wv; r < TT; r += gridDim.x * 8, ++it) {
        if (lane == 0) { const int q = (it * 8 + wv) * 4; const int ea = rinfo[q];
            if (ea >= 0) { const int eb = rinfo[q + 1], sa = basel[ea] + rinfo[q + 2], sb = basel[eb] + rinfo[q + 3];
                p.tok_e[r * 2] = ea; p.tok_e[r * 2 + 1] = eb; p.tok_s[r * 2] = sa; p.tok_s[r * 2 + 1] = sb;
                p.lst[(size_t)ea * TT + sa] = r; p.lst[(size_t)eb * TT + sb] = r; p.tok_w[(size_t)ea * TT + sa] = rw[(it * 8 + wv) * 2]; p.tok_w[(size_t)eb * TT + sb] = rw[(it * 8 + wv) * 2 + 1]; } }
    }
    __syncthreads();
}

DEVI void moe_offsets(const Params& p, int l, LAS int* offs) {
    if (opq_tid() == 0) { int o = 0;
        for (int e = 0; e < NEXP; ++e) { offs[e] = o; const int c = (int)__hip_atomic_load(&p.ctrl[CTRL_CNT(l, e)], __ATOMIC_RELAXED, __HIP_MEMORY_SCOPE_AGENT); offs[32 + e] = c; o += (c + 255) & ~255; }
        offs[NEXP] = o; }
    __syncthreads();
}
DEVI int moe_expert_of(const LAS int* offs, int row) { int e = 0;
#pragma unroll
    for (int q = 1; q < NEXP; ++q) e += (row >= offs[q]) ? 1 : 0;
    return e; }

DEVI void phase_moe_permute(const Params& p, int l, const LAS int* offs) {
    const int lane = opq_tid() & 63, wv = opq_tid() >> 6; const int R = offs[NEXP];
    for (int pr = opq_bid() * 8 + wv; pr < R; pr += gridDim.x * 8) {
        const int e = moe_expert_of(offs, pr), s = pr - offs[e]; const bool valid = s < offs[32 + e];
        u32x4 a = {0u, 0u, 0u, 0u}, b = {0u, 0u, 0u, 0u}; int r = 0; float w = 0.f;
        const int vz = vzero();
        if (valid) { r = p.lst[(size_t)e * TT + s + vz]; w = p.tok_w[(size_t)e * TT + s + vz];
            const u32x4* src = (const u32x4*)(p.h2 + (size_t)r * DM); a = src[lane]; b = src[64 + lane]; }
        u32x4* dst = (u32x4*)(p.h2p + (size_t)pr * DM); dst[lane] = a; dst[64 + lane] = b;
        if (lane == 0) { p.rww[pr] = w; p.rmr[pr] = valid ? mod_row(r) : 0; }
    }
}

template <bool GATH> struct MoeSched { static constexpr bool GATHER = GATH; const int* lst; int cnt[NEXP]; int G, c, nN; int o[NEXP + 1]; const char* A; const char* B; size_t atile, bexp, btile;
    DEVI void load(const LAS int* offs) {
#pragma unroll
        for (int q = 0; q <= NEXP; ++q) o[q] = __builtin_amdgcn_readfirstlane(offs[q]);
#pragma unroll
        for (int q = 0; q < NEXP; ++q) cnt[q] = __builtin_amdgcn_readfirstlane(offs[32 + q]); }
    DEVI int row_of(const g8::Unit& u, int r) const { int base = 0, n = 0;
#pragma unroll
        for (int q = 0; q < NEXP; ++q) { base = (u.tag == q) ? o[q] : base; n = (u.tag == q) ? cnt[q] : n; }
        const int s2 = u.pm * 256 + r - base; return (s2 < n) ? lst[(size_t)u.tag * TT + s2] : 0; }
    DEVI bool next(int i, g8::Unit& u) const { const long L = (long)i * G + c; const int R = o[NEXP]; if (L >= (long)(R / 256) * nN) return false;
        const int ti = (int)(L / nN), pn = (int)(L % nN); int e = 0;
#pragma unroll
        for (int q = 1; q < NEXP; ++q) e += (ti * 256 >= o[q]) ? 1 : 0;
        u.pm = ti; u.pn = pn; u.tag = e; u.a = A + (size_t)ti * atile; u.b = B + (size_t)e * bexp + (size_t)pn * btile; return true; } };
struct EpiSwiglu {
    static constexpr bool PERM = false, HAS_MID = false; static constexpr int NSEG = 1;
    bf16_t* hid;
    DEVI void operator()(const f32x4 (&acc)[2][2][4][2], const g8::Unit& u, int wr, int wc, int fr, int fq) const {
        const int row0 = u.pm * 256 + wr * 64 + fr, col0 = u.pn * 128 + wc * 32 + 4 * fq;
#pragma unroll
        for (int ai = 0; ai < 2; ++ai)
#pragma unroll
            for (int m = 0; m < 4; ++m)
#pragma unroll
                for (int n = 0; n < 2; ++n) { const f32x4 a = acc[ai][0][m][n], b = acc[ai][1][m][n]; float h[4];
#pragma unroll
                    for (int e = 0; e < 4; ++e) h[e] = a[e] * sigmoidf_(a[e]) * b[e];
                    u32x2 w; w.x = cvt_pk_bf16(h[0], h[1]); w.y = cvt_pk_bf16(h[2], h[3]);
                    *(u32x2*)(hid + (size_t)(row0 + ai * 128 + m * 16) * DEXP + col0 + n * 16) = w; }
    }
};
DEVI void phase_moe_up(const Params& p, int l, const LAS int* offs, LAS unsigned char* lds) {
    MoeSched<true> S; S.lst = p.lst; S.G = gridDim.x; S.c = opq_bid(); S.nN = 2; S.load(offs); S.A = (const char*)p.h2; S.B = (const char*)(p.w13 + (size_t)l * NEXP * 512 * DM);
    S.atile = 0; S.bexp = (size_t)512 * DM * 2; S.btile = (size_t)256 * DM * 2;
    EpiSwiglu E; E.hid = p.hid;
    g8::gemm_phase(lds, DM, DM, DM, S, E);
}
struct EpiDown {
    static constexpr bool PERM = true, HAS_MID = false; static constexpr int NSEG = 1;
    bf16_t* yo; const float* tokw; const int* lst; const LAS int* offs; const float* g2base;
    DEVI void operator()(const f32x4 (&acc)[2][2][4][2], const g8::Unit& u, int wr, int wc, int fr, int fq) const {
        const int row0 = u.pm * 256 + wr * 64 + fr, col0 = u.pn * 256 + wc * 32 + 8 * fq;
#pragma unroll
        for (int ai = 0; ai < 2; ++ai)
#pragma unroll
            for (int m = 0; m < 4; ++m) { const int row = row0 + ai * 128 + m * 16; const int e = u.tag, s2 = row - offs[e]; const bool valid = s2 < offs[32 + e];
                const float w = valid ? tokw[(size_t)e * TT + s2] : 0.f; const int mr = valid ? mod_row(lst[(size_t)e * TT + s2]) : 0; const float* g2 = g2base + (size_t)mr * 6144 + col0;
#pragma unroll
                for (int bj = 0; bj < 2; ++bj) { const f32x4 ga = *(const f32x4*)(g2 + bj * 128), gb = *(const f32x4*)(g2 + bj * 128 + 4);
                    const f32x4 v0 = acc[ai][bj][m][0] * ga * w, v1 = acc[ai][bj][m][1] * gb * w;
                    u32x4 o; o.x = cvt_pk_bf16(v0[0], v0[1]); o.y = cvt_pk_bf16(v0[2], v0[3]); o.z = cvt_pk_bf16(v1[0], v1[1]); o.w = cvt_pk_bf16(v1[2], v1[3]);
                    *(u32x4*)(yo + (size_t)row * DM + col0 + bj * 128) = o; } }
    }
};
DEVI void phase_moe_down(const Params& p, int l, const LAS int* offs, LAS unsigned char* lds) {
    MoeSched<false> S; S.lst = p.lst; S.G = gridDim.x; S.c = opq_bid(); S.nN = 4; S.load(offs); S.A = (const char*)p.hid; S.B = (const char*)(p.w2 + (size_t)l * NEXP * DM * DEXP);
    S.atile = (size_t)256 * DEXP * 2; S.bexp = (size_t)DM * DEXP * 2; S.btile = (size_t)256 * DEXP * 2;
    EpiDown E; E.yo = p.yo; E.tokw = p.tok_w; E.lst = p.lst; E.offs = offs; E.g2base = p.modv + (size_t)l * 5 * 6144 + 5120;
    g8::gemm_phase(lds, DEXP, DEXP, DEXP, S, E);
}
DEVI void phase_moe_combine(const Params& p, int l, const LAS int* offs, bool dry = false) {
    const int lane = opq_tid() & 63, wv = opq_tid() >> 6; const bool skipc = (l == DEPTH - 1);
    for (int r = opq_bid() * 8 + wv; r < TT; r += gridDim.x * 8) {
        const int pos = r % RB; if (skipc && pos >= SEQ) continue;
        float* x = xbuf_row(p, r);
        const int vz = vzero();
        const int pr0 = offs[p.tok_e[r * 2 + vz]] + p.tok_s[r * 2 + vz], pr1 = offs[p.tok_e[r * 2 + 1 + vz]] + p.tok_s[r * 2 + 1 + vz];
        const bf16_t* y0 = p.yo + (size_t)pr0 * DM; const bf16_t* y1 = p.yo + (size_t)pr1 * DM;
#pragma unroll
        for (int i = 0; i < 4; ++i) { const int c = i * 256 + lane * 4; f32x4 v = *(const f32x4*)(x + c);
            const u32x2 a = *(const u32x2*)(y0 + c), b = *(const u32x2*)(y1 + c);
            v[0] += __uint_as_float(a.x << 16) + __uint_as_float(b.x << 16); v[1] += __uint_as_float(a.x & 0xffff0000u) + __uint_as_float(b.x & 0xffff0000u);
            v[2] += __uint_as_float(a.y << 16) + __uint_as_float(b.y << 16); v[3] += __uint_as_float(a.y & 0xffff0000u) + __uint_as_float(b.y & 0xffff0000u);
            if (!dry || v[0] == 123.456f) *(f32x4*)(x + c) = v; }
    }
}

#ifndef MK_PHASE_KERNELS
#define MK_PHASE_KERNELS 0
#endif
constexpr int LDS_SCRATCH = 1024;

template <class T> DEVI T* uni_ptr(T* x) { const unsigned long long v = (unsigned long long)x;
    const unsigned lo = __builtin_amdgcn_readfirstlane((unsigned)v), hi = __builtin_amdgcn_readfirstlane((unsigned)(v >> 32));
    return (T*)(((unsigned long long)hi << 32) | lo); }
DEVI Params ldparams(const PL& s) {
    Params q;
#pragma unroll
    for (int i = 0; i < 35; ++i) q.in[i] = uni_ptr(s.in[i]);
#define LDP(f) q.f = uni_ptr(s.f)
    LDP(out); LDP(ctrl); LDP(modv); LDP(lbv); LDP(xc); LDP(rope); LDP(lrula); LDP(winA); LDP(winG); LDP(wup); LDP(wcat); LDP(wout); LDP(w13); LDP(w2); LDP(wlru);
    LDP(hx); LDP(pa); LDP(up); LDP(q); LDP(qc); LDP(kv); LDP(st); LDP(stb); LDP(lsum); LDP(lin); LDP(ocat); LDP(y); LDP(h2); LDP(h2p); LDP(hid); LDP(yo);
    LDP(tok_e); LDP(tok_s); LDP(tok_w); LDP(lst); LDP(rww); LDP(rmr);
#undef LDP
    q.pad_ = 0ull;
    return q;
}
#ifndef WAITPROBE
#define WAITPROBE (-1)
#endif
DEVI void grid_sync(const PL& s, LAS unsigned char* smem) {
    XcdBarrier b; b.bar = uni_ptr(s.ctrl); b.x = xb_xcc_id(); b.st = (volatile LAS unsigned*)smem;
#if WAITPROBE >= 0
    unsigned long long t0 = 0; if (threadIdx.x == 0) t0 = __builtin_amdgcn_s_memrealtime();
    xcd_barrier(b);
    if (threadIdx.x == 0) { LAS unsigned long long* acc = (LAS unsigned long long*)(smem + 32); *acc += __builtin_amdgcn_s_memrealtime() - t0; }
#else
    xcd_barrier(b);
#endif
}
DEVI void probe_dump(const Params& p, const bf16_t* src, size_t n) {
    const size_t NOUT = (size_t)NB * SEQ * DM;
    for (size_t i = (size_t)opq_bid() * 512 + opq_tid(); i < NOUT; i += (size_t)gridDim.x * 512) { float s = 0.f;
        for (size_t k = i; k < n; k += NOUT) s += (float)src[k];
        p.out[i] = s; }
}
#define PROBE_AT(id, buf, n) if (PROBE_STOP == (id) && l == 0 && hb == 0) { { const Params p = ldparams(pl); probe_dump(p, (const bf16_t*)(buf), (n)); } return; }
#ifndef PROBE_STOP
#define PROBE_STOP 0
#endif
#ifndef DUP_MASK
#define DUP_MASK 0
#endif
#define PHASE_D(bit, call, dupcall) PHASE(call); if ((DUP_MASK >> (bit)) & 1) { PHASE(dupcall); }
#define PHASE(call) do { const Params p = ldparams(pl); call; } while (0); grid_sync(pl, smem); if ((DUP_MASK >> 21) & 1) grid_sync(pl, smem)

#ifndef SELFCHECK
#define SELFCHECK 0
#endif
DEVI void chk_sum(const Params& p, int id, int rep, const void* buf, size_t nbytes) {
    const unsigned* w = (const unsigned*)buf; const size_t n = nbytes / 4; unsigned long long s = 0ull;
    for (size_t i = (size_t)opq_bid() * 512 + opq_tid(); i < n; i += (size_t)gridDim.x * 512) s += (unsigned long long)w[i] * (unsigned long long)((i & 1023) + 1);
    unsigned lo = (unsigned)s, hi = (unsigned)(s >> 32);
    for (int o = 32; o >= 1; o >>= 1) { const unsigned l2 = __shfl_xor(lo, o), h2 = __shfl_xor(hi, o); const unsigned long long t = (((unsigned long long)hi << 32) | lo) + (((unsigned long long)h2 << 32) | l2); lo = (unsigned)t; hi = (unsigned)(t >> 32); }
    if ((opq_tid() & 63) == 0) atomicAdd((unsigned long long*)(p.ctrl + 6144) + (rep * 32 + id), (((unsigned long long)hi << 32) | lo));
}
#define CHK(id, buf, nbytes) do { const Params p = ldparams(pl); chk_sum(p, id, rep, buf, nbytes); } while (0); grid_sync(pl, smem)

__global__ void __launch_bounds__(512, 2) hybrid_flow_backbone_kernel(Params pk) {
    extern __shared__ __attribute__((aligned(16))) unsigned char smem_raw[];
    LAS unsigned char* smem = (LAS unsigned char*)smem_raw;
    LAS unsigned char* lds = smem + LDS_SCRATCH; LAS int* offs = (LAS int*)(smem + 64);
    static_assert(sizeof(Params) % 8 == 0 && sizeof(Params) <= LDS_SCRATCH - 256, "Params must fit its LDS slot");
    { (void)pk;
      const __attribute__((address_space(4))) unsigned long long* src = (const __attribute__((address_space(4))) unsigned long long*)__builtin_amdgcn_kernarg_segment_ptr();
      LAS unsigned long long* dst = (LAS unsigned long long*)(smem + 256);
      if (threadIdx.x < sizeof(Params) / 8) dst[threadIdx.x] = src[threadIdx.x]; }
    if (threadIdx.x == 0) { *(LAS u32x4*)smem = (u32x4){0u, 0u, 0u, 0u}; *(LAS unsigned long long*)(smem + 32) = 0ull; }
    __syncthreads();
    const PL& pl = *(const PL*)(smem + 256);
    (void)xcd_barrier_post(uni_ptr(pl.ctrl), (volatile LAS unsigned*)smem);
    phase_prep(pl, lds); grid_sync(pl, smem);
    if ((DUP_MASK >> 16) & 1) { phase_prep(pl, lds); grid_sync(pl, smem); }
#if SELFCHECK
    for (int rep = 0; rep < SELFCHECK; ++rep) {
        const int l = 0, hb = 0;
        PHASE(phase_norm1(p, l, hb));          CHK(1, p.hx, (size_t)HR * DM * 2);
        PHASE(phase_inproj_a(p, l, lds));      CHK(2, p.pa, (size_t)HR * PA_W * 2);
        PHASE(phase_mla_up(p, l, lds));        CHK(3, p.up, (size_t)HR * UPW * 2);
        PHASE(phase_qkv(p, l, lds));           CHK(4, p.q, (size_t)2 * 8 * SEQ * 96 * 2); CHK(5, p.qc, (size_t)2 * 8 * CTX * 96 * 2);
        PHASE(phase_attn_scan1(p, l, lds));    CHK(6, p.st, (size_t)2 * 2 * 8 * NCH * 4096 * 2); CHK(7, p.stb, (size_t)2 * 2 * 8 * NCH * 64 * 4); CHK(8, p.lsum, (size_t)2 * 2 * NT16 * 512 * 2 * 4);
        PHASE(phase_prefix(p, lds));                CHK(9, p.st, (size_t)2 * 2 * 8 * NCH * 4096 * 2); CHK(10, p.lin, (size_t)2 * 2 * NT16 * 512 * 4);
        PHASE(phase_scan3(p, l, lds));         CHK(11, p.ocat, (size_t)HR * OCW * 2);
        PHASE(phase_inproj_g(p, l, lds));      CHK(12, p.pa, (size_t)HR * PG_W * 2);
        PHASE(phase_merge(p, l, lds));         CHK(13, p.y, (size_t)HR * DM * 2);
        PHASE(phase_outproj(p, l, hb, lds));   CHK(14, p.out, (size_t)2 * SEQ * DM * 4); CHK(15, p.xc, (size_t)2 * CTX * DM * 4);
    }
    {   const Params p = ldparams(pl);
        const size_t NOUT = (size_t)NB * SEQ * DM;
        for (size_t i = (size_t)opq_bid() * 512 + opq_tid(); i < NOUT; i += (size_t)gridDim.x * 512) p.out[i] = 0.f;
        __syncthreads();
        if (opq_bid() == 0 && opq_tid() == 0) { int first = 0; const unsigned long long* c = (const unsigned long long*)(p.ctrl + 6144);
            for (int id = 15; id >= 1; --id) for (int rep = 1; rep < SELFCHECK; ++rep)
                if (__hip_atomic_load(c + rep * 32 + id, __ATOMIC_RELAXED, __HIP_MEMORY_SCOPE_AGENT) != __hip_atomic_load(c + id, __ATOMIC_RELAXED, __HIP_MEMORY_SCOPE_AGENT)) first = id;
            p.out[0] = 1000.0f * (float)first; }
    }
    return;
#endif
    for (int l = 0; l < DEPTH; ++l) {
        for (int hb = 0; hb < 2; ++hb) {
            if (l == 0 && hb == 0) { PHASE_D(0, phase_norm1(p, l, hb), phase_norm1(p, l, hb)); }
            PHASE_D(1, phase_inproj_a(p, l, lds), phase_inproj_a(p, l, lds));
            PHASE_D(2, phase_mla_up(p, l, lds), phase_mla_up(p, l, lds));
            PHASE_D(3, phase_qkv(p, l, lds), phase_qkv(p, l, lds));
            PHASE(phase_attn_scan1(p, l, lds));
            if ((DUP_MASK >> 4) & 1) { PHASE(phase_attn_scan1(p, l, lds, 1)); }
            if ((DUP_MASK >> 5) & 1) { PHASE(phase_attn_scan1(p, l, lds, 2)); }
            if ((DUP_MASK >> 6) & 1) { PHASE(phase_attn_scan1(p, l, lds, 4)); }
            PHASE(phase_prefix(p, lds));
            if ((DUP_MASK >> 17) & 1) { PHASE(phase_prefix(p, lds, true)); }
            PHASE(phase_scan3(p, l, lds));
            if ((DUP_MASK >> 7) & 1) { PHASE(phase_scan3(p, l, lds, 1)); }
            if ((DUP_MASK >> 8) & 1) { PHASE(phase_scan3(p, l, lds, 2)); }
            PHASE_D(9, phase_inproj_g(p, l, lds), phase_inproj_g(p, l, lds));
            PHASE_D(10, phase_merge(p, l, lds), phase_merge(p, l, lds));
            PHASE(phase_outproj(p, l, hb, lds); if (hb == 0) phase_norm1(p, l, 1));
            if (((DUP_MASK >> 11) & 1) && l == 0) { PHASE(phase_outproj(p, l, hb, lds)); }
            if ((DUP_MASK >> 15) & 1) { for (int z = 0; z < 10; ++z) grid_sync(pl, smem); }
        }
        PHASE(phase_norm2_route(p, l, lds));
        PHASE_D(13, moe_offsets(p, l, offs); phase_moe_up(p, l, offs, lds), phase_moe_up(p, l, offs, lds));
        PHASE_D(14, phase_moe_down(p, l, offs, lds), phase_moe_down(p, l, offs, lds));
        PHASE(phase_moe_combine(p, l, offs); if (l + 1 < DEPTH) phase_norm1(p, l + 1, 0));
        if ((DUP_MASK >> 19) & 1) { PHASE(phase_moe_combine(p, l, offs, true)); }
    }
#if WAITPROBE >= 0
    if (blockIdx.x == WAITPROBE && threadIdx.x == 0) {
        const unsigned long long w = *(LAS unsigned long long*)(smem + 32), t0 = __builtin_amdgcn_s_memrealtime();
        while (__builtin_amdgcn_s_memrealtime() - t0 < w) __builtin_amdgcn_s_sleep(8); }
#endif
}

static size_t align_up(size_t x, size_t a) { return (x + a - 1) / a * a; }

extern "C" void kernel_launch(void* const* d_in, const int* in_sizes, int n_in, void* d_out, int out_size, void* d_ws, size_t ws_size, hipStream_t stream) {
    (void)in_sizes; (void)n_in; (void)out_size;
    Params p; memset(&p, 0, sizeof(p));
    for (int i = 0; i < 35; ++i) p.in[i] = (const float*)d_in[i];
    p.out = (float*)d_out;
    char* w = (char*)d_ws; size_t o = 0;
    auto take = [&](size_t bytes) { char* r = w + o; o = align_up(o + bytes, 256); return r; };
    p.ctrl = (unsigned*)take(CTRL_WORDS * 4);
    p.modv = (float*)take((size_t)DEPTH * 5 * 6144 * 4);
    p.lbv = (float*)take((size_t)DEPTH * 2 * 512 * 4);
    p.xc = (float*)take((size_t)NB * CTX * DM * 4);
    p.rope = (float*)take((size_t)SEQ * 32 * 4);
    p.lrula = (float*)take((size_t)DEPTH * 2 * 512 * 4);
    p.winA = (bf16_t*)take((size_t)DEPTH * PA_W * DM * 2);
    p.winG = (bf16_t*)take((size_t)DEPTH * PG_W * DM * 2);
    p.wup = (bf16_t*)take((size_t)DEPTH * UPW * 256 * 2);
    p.wcat = (bf16_t*)take((size_t)DEPTH * DM * OCW * 2);
    p.wout = (bf16_t*)take((size_t)DEPTH * DM * DM * 2);
    p.w13 = (bf16_t*)take((size_t)DEPTH * NEXP * 512 * DM * 2);
    p.w2 = (bf16_t*)take((size_t)DEPTH * NEXP * DM * DEXP * 2);
    p.wlru = (bf16_t*)take((size_t)DEPTH * 2 * 8 * 2 * 64 * 64 * 2);
    p.tok_e = (int*)take((size_t)TT * 2 * 4); p.tok_s = (int*)take((size_t)TT * 2 * 4);
    p.lst = (int*)take((size_t)NEXP * TT * 4); p.tok_w = (float*)take((size_t)NEXP * TT * 4);
    p.rww = (float*)take((size_t)RP * 4); p.rmr = (int*)take((size_t)RP * 4);
    const size_t region = o;
    p.hx = (bf16_t*)take((size_t)HR * DM * 2);
    p.pa = (bf16_t*)take((size_t)HR * PA_W * 2);
    p.ocat = (bf16_t*)take((size_t)HR * OCW * 2);
    p.lsum = (float*)take((size_t)2 * 2 * NT16 * 512 * 2 * 4); p.lin = (float*)take((size_t)2 * 2 * NT16 * 512 * 4);
    const size_t alias1 = o;
    p.up = (bf16_t*)take((size_t)HR * UPW * 2);
    const size_t after_up = o; o = alias1;
    p.st = (bf16_t*)take((size_t)2 * 2 * 8 * NCH * 4096 * 2); p.stb = (float*)take((size_t)2 * 2 * 8 * NCH * 64 * 4);
    if (o < after_up) o = after_up;
    const size_t alias2 = o;
    p.q = (bf16_t*)take((size_t)2 * 8 * SEQ * 96 * 2); p.qc = (bf16_t*)take((size_t)2 * 8 * CTX * 96 * 2); p.kv = (unsigned char*)take((size_t)2 * 8 * NCH * KVT_BYTES);
    const size_t mixer_end = o; o = alias2;
    p.y = (bf16_t*)take((size_t)HR * DM * 2);
    size_t end1 = mixer_end > o ? mixer_end : o;
    o = region;
    p.h2 = (bf16_t*)take((size_t)TT * DM * 2);
    p.h2p = (bf16_t*)take((size_t)RP * DM * 2);
    p.hid = (bf16_t*)take((size_t)RP * DEXP * 2);
    p.yo = (bf16_t*)take((size_t)RP * DM * 2);
    const size_t need = end1 > o ? end1 : o;
    static int grid = 0;
    if (!grid) {
        int dev = 0, cus = 0, per_cu = 0; hipGetDevice(&dev); hipDeviceGetAttribute(&cus, hipDeviceAttributeMultiprocessorCount, dev);
        hipFuncSetAttribute((const void*)hybrid_flow_backbone_kernel, hipFuncAttributeMaxDynamicSharedMemorySize, LDS_TOTAL);
        hipOccupancyMaxActiveBlocksPerMultiprocessor(&per_cu, (const void*)hybrid_flow_backbone_kernel, 512, LDS_TOTAL);
        if (per_cu < 1) fprintf(stderr, "kernel_launch: occupancy query returned %d\n", per_cu);
        grid = cus * (per_cu < 1 ? 0 : 1); if (grid > 256) grid = 256;
    }
    if (need > ws_size) { fprintf(stderr, "kernel_launch: workspace too small: need %zu have %zu\n", need, ws_size); return; }
    if (grid < 8) { fprintf(stderr, "kernel_launch: grid %d too small\n", grid); return; }
    hipMemsetAsync(p.ctrl, 0, CTRL_WORDS * 4, stream);
    hipLaunchKernelGGL(hybrid_flow_backbone_kernel, dim3(grid), dim3(512), LDS_TOTAL, stream, p);
}
```

```cpp
#include <hip/hip_runtime.h>
#include <stdint.h>
#include <stdio.h>
#include <string.h>

#define LAS __attribute__((address_space(3)))
#define DEVI __device__ __forceinline__
typedef unsigned short bf16_t;
typedef short bf16x8 __attribute__((ext_vector_type(8)));
typedef float f32x4 __attribute__((ext_vector_type(4)));
typedef float f32x16 __attribute__((ext_vector_type(16)));
typedef unsigned u32x4 __attribute__((ext_vector_type(4)));
typedef unsigned u32x2 __attribute__((ext_vector_type(2)));

constexpr int NB = 4, SEQ = 8192, CTX = 256, DM = 1024, DEPTH = 2;
constexpr int RB = SEQ + CTX;
constexpr int TT = NB * RB;
constexpr int HR = 2 * RB;
constexpr int NCH = RB / 64;
constexpr int INW = 7072;
constexpr int PA_W = 4096;
constexpr int PG_W = 3072;
constexpr int C_Q = 0, C_ZF = 512, C_ZB = 1024, C_I = 1536, C_G = 2048, C_DQ = 2560, C_DKV = 2816, C_KR = 2944, C_LX = 3072, C_LY = 3584;
constexpr int UPW = 1792;
constexpr int OCW = 1536;
constexpr int KVT_BYTES = 22016;
constexpr int KT_BYTES = 13312;
constexpr int NEXP = 16, DEXP = 256;
constexpr float EPSF = 1e-6f;
constexpr int LDS_TOTAL = 160 * 1024;

DEVI float bf2f(bf16_t b) { return __uint_as_float(((unsigned)b) << 16); }
DEVI bf16_t f2bf(float f) { return __builtin_bit_cast(bf16_t, (__bf16)f); }
typedef float f32x2_t __attribute__((ext_vector_type(2)));
typedef __bf16 bf16x2_t __attribute__((ext_vector_type(2)));
DEVI unsigned cvt_pk_bf16(float lo, float hi) { const f32x2_t v = {lo, hi}; return __builtin_bit_cast(unsigned, __builtin_convertvector(v, bf16x2_t)); }
DEVI float fast_exp2(float x) { return __builtin_amdgcn_exp2f(x); }
DEVI float fast_rcp(float x) { return __builtin_amdgcn_rcpf(x); }
DEVI float sigmoidf_(float x) { return fast_rcp(1.0f + fast_exp2(-1.44269504f * x)); }
DEVI float wave_sum(float v) { for (int o = 32; o >= 1; o >>= 1) v += __shfl_xor(v, o); return v; }
DEVI float wave_max(float v) { for (int o = 32; o >= 1; o >>= 1) v = fmaxf(v, __shfl_xor(v, o)); return v; }

DEVI int opq_tid() { int t = threadIdx.x; asm volatile("" : "+v"(t)); return t; }
DEVI int opq_bid() { int b = blockIdx.x; asm volatile("" : "+s"(b)); return b; }

DEVI int vzero() { int z = 0; asm volatile("" : "+v"(z)); return z; }

#define XB_TMO      128
#define XB_XCNT(j)  (256  + 64 * (j))
#define XB_XSUB(j)  (1280 + 64 * (j))
#define XB_XGEN(j)  (2304 + 64 * (j))
#define XB_TOP      3328
#define XB_TOPGEN   3392
#define XCD_BAR_WORDS 3456
#define XB_SPIN_CAP (1u << 18)

__device__ __forceinline__ unsigned xb_ld(unsigned* p)              { return __hip_atomic_load(p, __ATOMIC_RELAXED, __HIP_MEMORY_SCOPE_AGENT); }
__device__ __forceinline__ unsigned xb_add(unsigned* p, unsigned v) { return __hip_atomic_fetch_add(p, v, __ATOMIC_RELAXED, __HIP_MEMORY_SCOPE_AGENT); }
__device__ __forceinline__ unsigned xb_xcc_id() { return (unsigned)__builtin_amdgcn_s_getreg((3 << 11) | 20) & 0xFu; }
#define XB_SPIN(cond, bar) do { unsigned _sp = 0; while (cond) { __builtin_amdgcn_s_sleep(1); \
    if ((++_sp & 255u) == 0u) { if (xb_ld(&(bar)[XB_TMO])) break; if (_sp > XB_SPIN_CAP) { atomicAdd(&(bar)[XB_TMO], 1u); break; } } } } while (0)

struct XcdBarrier { unsigned* bar; unsigned x; volatile LAS unsigned* st; };

__device__ __forceinline__ XcdBarrier xcd_barrier_post(unsigned* bar, volatile LAS unsigned* st) {
    XcdBarrier b; b.bar = bar; b.x = xb_xcc_id(); b.st = st;
    if (threadIdx.x == 0) (void)xb_add(&bar[XB_XCNT(b.x)], 1u);
    return b;
}
__device__ __forceinline__ void xcd_barrier_complete(unsigned* bar, unsigned x, unsigned& nloc, unsigned& nx) {
    const unsigned G = gridDim.x * gridDim.y * gridDim.z;
    unsigned sum, cnt, mine, sp = 0u;
    for (;;) {
        sum = 0u; cnt = 0u; mine = 0u;
#pragma unroll
        for (unsigned j = 0; j < 16; ++j) { const unsigned c = xb_ld(&bar[XB_XCNT(j)]); sum += c; cnt += (c > 0u) ? 1u : 0u; mine = (j == x) ? c : mine; }
        if (sum == G) break;
        __builtin_amdgcn_s_sleep(1);
        if ((++sp & 255u) == 0u) { if (xb_ld(&bar[XB_TMO])) break; if (sp > XB_SPIN_CAP) { atomicAdd(&bar[XB_TMO], 1u); break; } }
    }
    nloc = mine > 0u ? mine : 1u; nx = cnt > 0u ? cnt : 1u;
}
__device__ __forceinline__ void xcd_barrier(const XcdBarrier& b) {
    asm volatile("s_waitcnt vmcnt(0)" ::: "memory");
    __syncthreads();
    if (threadIdx.x == 0) {
        unsigned* bar = b.bar;
        __builtin_amdgcn_s_waitcnt(0);
        unsigned nloc = b.st[0], nx = b.st[1];
        if (nloc == 0u) { xcd_barrier_complete(bar, b.x, nloc, nx); b.st[0] = nloc; b.st[1] = nx; }
        const unsigned old = xb_add(&bar[XB_XSUB(b.x)], 1u);
        const unsigned gen = old / nloc;
        if (old + 1u == (gen + 1u) * nloc) {
            __builtin_amdgcn_fence(__ATOMIC_RELEASE, "agent");
            asm volatile("s_waitcnt vmcnt(0)" ::: "memory");
            const unsigned og = xb_add(&bar[XB_TOP], 1u);
            const unsigned tg = og / nx;
            if (og + 1u == (tg + 1u) * nx) xb_add(&bar[XB_TOPGEN], 1u);
            else XB_SPIN(xb_ld(&bar[XB_TOPGEN]) == tg, bar);
            __builtin_amdgcn_fence(__ATOMIC_ACQUIRE, "agent");
            xb_add(&bar[XB_XGEN(b.x)], 1u);
            asm volatile("s_waitcnt vmcnt(0)" ::: "memory");
        } else {
            XB_SPIN(xb_ld(&bar[XB_XGEN(b.x)]) == gen, bar);
            __builtin_amdgcn_fence(__ATOMIC_ACQUIRE, "agent");
            asm volatile("s_waitcnt vmcnt(0)" ::: "memory");
        }
    }
    __syncthreads();
}

struct Params {
    const float* in[35];
    float* out;
    unsigned* ctrl;
    float* modv;
    float* lbv;
    float* xc;
    float* lrula;
    float* rope;
    bf16_t* winA; bf16_t* winG; bf16_t* wup; bf16_t* wcat; bf16_t* wout; bf16_t* w13; bf16_t* w2; bf16_t* wlru;
    bf16_t* hx;
    bf16_t* pa;
    bf16_t* up;
    bf16_t* q; bf16_t* qc; unsigned char* kv;
    bf16_t* st; float* stb;
    float* lsum; float* lin;
    bf16_t* ocat;
    bf16_t* y;
    bf16_t* h2; bf16_t* h2p; bf16_t* hid; bf16_t* yo;
    int* tok_e; int* tok_s; float* tok_w; int* lst; float* rww; int* rmr;
    unsigned long long pad_;
};

typedef LAS Params PL;

#define CTRL_CNT(l, e) (4096 + 512 * (l) + 16 * (e))
#define CTRL_WORDS 8192

namespace g8 {
constexpr int BM = 256, BK = 64, HALF = 128, HTB = HALF * BK * 2, STAGE_BYTES = 8 * HTB, NXCD = 8, WGM = 8;
__host__ __device__ __forceinline__ int lds_byte(int r, int c) { const int st = (r >> 4) * 2 + (c >> 5), rr = r & 15, cc = c & 31, ob = rr * 64 + cc * 2; return st * 1024 + (ob ^ (((ob >> 9) & 1) << 5)); }
__host__ __device__ __forceinline__ void stage_rc(int b, int& R, int& C) { const int st = b / 1024, sb = b % 1024, swz = sb ^ (((sb >> 9) & 1) << 5); R = (st >> 1) * 16 + swz / 64; C = (st & 1) * 32 + (swz % 64) / 2; }
__host__ __device__ __forceinline__ int perm32(int rho) { const int n = rho >> 4, i = rho & 15; return 8 * (i >> 2) + 4 * n + (i & 3); }

struct Unit { int pm, pn, tag; const char* a; const char* b; };

__device__ __forceinline__ bool static_order(int i, int G, int c, int nM, int nN, int& pm, int& pn) {
    const int nwg = nM * nN; const long L = (long)i * G + c; if (L >= nwg) return false;
    int wgid = (int)L; { const int q = nwg / NXCD, r = nwg % NXCD, xcd = wgid % NXCD, off = wgid / NXCD; wgid = (xcd < r ? xcd * (q + 1) : r * (q + 1) + (xcd - r) * q) + off; }
    const int nig = WGM * nN, gid = wgid / nig, fm = gid * WGM, gsz = (nM - fm) < WGM ? (nM - fm) : WGM;
    pm = fm + ((wgid % nig) % gsz); pn = (wgid % nig) / gsz; return true;
}

template <class Epi, class Sched>
__device__ __forceinline__ void gemm_phase(LAS unsigned char* lds, const int lda, const int ldb, const int K, const Sched& S, const Epi& E) {
    const int tid = opq_tid(), wid = __builtin_amdgcn_readfirstlane(tid >> 6), lane = tid & 63, wr = wid >> 2, wc = wid & 3, fr = lane & 15, fq = lane >> 4;
    const int nt = K / BK;
    unsigned voffB[2]; int RA[2], CA[2];
#pragma unroll
    for (int i = 0; i < 2; ++i) { int R, C; stage_rc(tid * 16 + i * 8192, R, C); const int Rb = Epi::PERM ? ((R & ~31) + perm32(R & 31)) : R;
        RA[i] = R; CA[i] = C; voffB[i] = (unsigned)(Rb * ldb + C) * 2u; }
    auto set_voff = [&](const Unit& u, unsigned (&v)[2][2]) {
#pragma unroll
        for (int h = 0; h < 2; ++h)
#pragma unroll
            for (int i = 0; i < 2; ++i) { if constexpr (Sched::GATHER) v[h][i] = (unsigned)S.row_of(u, h * HALF + RA[i]) * (unsigned)(lda * 2) + (unsigned)CA[i] * 2u;
                else v[h][i] = (unsigned)((h * HALF + RA[i]) * lda + CA[i]) * 2u; } };
    const size_t kstep = (size_t)(BK * 2);
    const size_t hstepB = (size_t)HALF * ldb * 2;
    const unsigned ldsw = (unsigned)wid * 1024u;
    const int aoff = lds_byte(wr * 64 + fr, fq * 8), boff = lds_byte(wc * 32 + fr, fq * 8);
#define G8_SA(b, h) (((b) * 2 + (h)) * HTB)
#define G8_SB(b, h) ((4 + (b) * 2 + (h)) * HTB)
#define G8_STAGE(bufoff, gbase, voff) do { _Pragma("unroll") for (int _i = 0; _i < 2; ++_i) \
        __builtin_amdgcn_global_load_lds((const unsigned*)((const char*)(gbase) + (voff)[_i]), (LAS unsigned*)(lds + (bufoff) + ldsw + _i * 8192), 16, 0, 0); } while (0)
#define G8_LDA(dst, b, h) do { _Pragma("unroll") for (int m = 0; m < 4; ++m) _Pragma("unroll") for (int k = 0; k < 2; ++k) dst[m][k] = *(const LAS bf16x8*)(lds + G8_SA(b, h) + aoff + m * 2048 + k * 1024); } while (0)
#define G8_LDB(dst, b, h) do { _Pragma("unroll") for (int n = 0; n < 2; ++n) _Pragma("unroll") for (int k = 0; k < 2; ++k) dst[n][k] = *(const LAS bf16x8*)(lds + G8_SB(b, h) + boff + n * 2048 + k * 1024); } while (0)
#define G8_MMA(ai, bj, At, Bt) do { __builtin_amdgcn_s_setprio(1); _Pragma("unroll") for (int m = 0; m < 4; ++m) _Pragma("unroll") for (int n = 0; n < 2; ++n) _Pragma("unroll") for (int k = 0; k < 2; ++k) \
        acc[ai][bj][m][n] = __builtin_amdgcn_mfma_f32_16x16x32_bf16(Bt[n][k], At[m][k], acc[ai][bj][m][n], 0, 0, 0); __builtin_amdgcn_s_setprio(0); } while (0)
#define G8_WAIT_V(n) asm volatile("s_waitcnt vmcnt(" #n ")" ::: "memory")
#define G8_WAIT_L(n) asm volatile("s_waitcnt lgkmcnt(" #n ")" ::: "memory")
#define G8_BAR __builtin_amdgcn_s_barrier()
#define G8_SCHED __builtin_amdgcn_sched_barrier(0)
    Unit cur, nxt; int ui = 0;
    if (!S.next(0, cur)) return;
    f32x4 acc[2][2][4][2];
#pragma unroll
    for (int a = 0; a < 2; ++a)
#pragma unroll
        for (int b = 0; b < 2; ++b)
#pragma unroll
            for (int m = 0; m < 4; ++m)
#pragma unroll
                for (int n = 0; n < 2; ++n) acc[a][b][m][n] = (f32x4){0.f, 0.f, 0.f, 0.f};
    bf16x8 At[4][2], B0[2][2], B1[2][2];
    const char* cA = cur.a; const char* cB = cur.b;
    unsigned vcur[2][2], vnxt[2][2]; set_voff(cur, vcur);
    asm volatile("s_waitcnt lgkmcnt(0)" ::: "memory");
    if constexpr (Sched::GATHER) asm volatile("s_waitcnt vmcnt(0)" ::: "memory");
    G8_STAGE(G8_SB(0, 0), cB, voffB); G8_STAGE(G8_SA(0, 0), cA, vcur[0]); G8_STAGE(G8_SB(0, 1), cB + hstepB, voffB); G8_STAGE(G8_SA(0, 1), cA, vcur[1]);
    if (wr == 1) G8_BAR;
    G8_WAIT_V(4); G8_BAR;
    G8_STAGE(G8_SB(1, 0), cB + kstep, voffB); G8_STAGE(G8_SA(1, 0), cA + kstep, vcur[0]); G8_STAGE(G8_SB(1, 1), cB + hstepB + kstep, voffB);
    G8_WAIT_V(6); G8_BAR;
    for (;;) {
        const bool has_next = S.next(ui + 1, nxt);
        const char* nA = has_next ? nxt.a : cA; const char* nB = has_next ? nxt.b : cB;
        if (has_next) set_voff(nxt, vnxt); else {
#pragma unroll
            for (int h = 0; h < 2; ++h) { vnxt[h][0] = vcur[h][0]; vnxt[h][1] = vcur[h][1]; } }
        asm volatile("s_waitcnt lgkmcnt(0)" ::: "memory");
        const int tseg = nt / Epi::NSEG;
#pragma unroll 1
        for (int sg = 0; sg < Epi::NSEG; ++sg) {
#pragma unroll 1
        for (int t = sg * tseg; t < (sg + 1) * tseg; t += 2) {
            const bool last = (t == nt - 2);
            const char* a1 = cA + (size_t)(t + 1) * kstep;
            const char* a2 = last ? nA : cA + (size_t)(t + 2) * kstep; const char* b2 = last ? nB : cB + (size_t)(t + 2) * kstep;
            const char* a3 = a2 + kstep; const char* b3 = b2 + kstep;
            unsigned v20[2], v21[2];
#pragma unroll
            for (int i = 0; i < 2; ++i) { v20[i] = last ? vnxt[0][i] : vcur[0][i]; v21[i] = last ? vnxt[1][i] : vcur[1][i]; }
            G8_LDB(B0, 0, 0); G8_SCHED; G8_LDA(At, 0, 0); G8_STAGE(G8_SA(1, 1), a1, vcur[1]);
            G8_WAIT_L(8); G8_BAR; G8_WAIT_L(0); G8_MMA(0, 0, At, B0); G8_BAR; G8_SCHED;
            G8_LDB(B1, 0, 1); G8_STAGE(G8_SB(0, 0), b2, voffB);
            G8_BAR; G8_WAIT_L(0); G8_MMA(0, 1, At, B1); G8_BAR;
            G8_LDA(At, 0, 1); G8_STAGE(G8_SA(0, 0), a2, v20);
            G8_BAR; G8_WAIT_L(0); G8_MMA(1, 0, At, B0); G8_BAR; G8_SCHED;
            G8_STAGE(G8_SB(0, 1), b2 + hstepB, voffB);
            G8_WAIT_V(6); G8_BAR; G8_MMA(1, 1, At, B1); G8_BAR;
            G8_LDB(B0, 1, 0); G8_SCHED; G8_LDA(At, 1, 0); G8_STAGE(G8_SA(0, 1), a2, v21);
            G8_WAIT_L(8); G8_BAR; G8_WAIT_L(0); G8_MMA(0, 0, At, B0); G8_BAR; G8_SCHED;
            G8_LDB(B1, 1, 1); G8_STAGE(G8_SB(1, 0), b3, voffB);
            G8_BAR; G8_WAIT_L(0); G8_MMA(0, 1, At, B1); G8_BAR;
            G8_LDA(At, 1, 1); G8_STAGE(G8_SA(1, 0), a3, v20);
            G8_BAR; G8_WAIT_L(0); G8_MMA(1, 0, At, B0); G8_BAR; G8_SCHED;
            G8_STAGE(G8_SB(1, 1), b3 + hstepB, voffB);
            G8_WAIT_V(6); G8_BAR; G8_MMA(1, 1, At, B1); G8_BAR;
        }
        if constexpr (Epi::NSEG > 1) { if (sg + 1 < Epi::NSEG) E.mid(sg, acc, cur, wr, wc, fr, fq); }
        }
        E(acc, cur, wr, wc, fr, fq);
        if (!has_next) break;
#pragma unroll
        for (int a = 0; a < 2; ++a)
#pragma unroll
            for (int b = 0; b < 2; ++b)
#pragma unroll
                for (int m = 0; m < 4; ++m)
#pragma unroll
                    for (int n = 0; n < 2; ++n) acc[a][b][m][n] = (f32x4){0.f, 0.f, 0.f, 0.f};
        cur = nxt; cA = nA; cB = nB; ++ui;
#pragma unroll
        for (int h = 0; h < 2; ++h) { vcur[h][0] = vnxt[h][0]; vcur[h][1] = vnxt[h][1]; }
    }
    G8_WAIT_V(0);
    if (wr == 0) G8_BAR;
    G8_BAR;
#undef G8_SA
#undef G8_SB
#undef G8_STAGE
#undef G8_LDA
#undef G8_LDB
#undef G8_MMA
#undef G8_WAIT_V
#undef G8_WAIT_L
#undef G8_BAR
#undef G8_SCHED
}
}

enum { I_X = 0, I_C, I_CTX, I_CCTX, I_WMOD, I_BMOD, I_NMIX, I_NFFN, I_WIN, I_HGLB, I_HGNORM, I_QNORM, I_KVNORM, I_WUQ, I_WUKV, I_GQ, I_GK,
       I_CONVW, I_CONVB, I_LWA, I_LBA, I_LWX, I_LBX, I_LAM, I_BRHG, I_BRMLA, I_BRLRU, I_WOUT, I_WRG, I_BRG, I_WRE, I_BRE, I_W1, I_W3, I_W2 };

DEVI const float* xin_row_l0(const Params& p, int r) { const int b = r / RB, pos = r - b * RB;
    return pos < SEQ ? p.in[I_X] + ((size_t)b * SEQ + pos) * DM : p.in[I_CTX] + ((size_t)b * CTX + (pos - SEQ)) * DM; }
DEVI float* xbuf_row(const Params& p, int r) { const int b = r / RB, pos = r - b * RB;
    return pos < SEQ ? p.out + ((size_t)b * SEQ + pos) * DM : p.xc + ((size_t)b * CTX + (pos - SEQ)) * DM; }
DEVI int mod_row(int r) { const int b = r / RB, pos = r - b * RB; return pos < SEQ ? b : 4; }

struct TrJob { const float* src; int ld; int K; int ncols; bf16_t* dst; int dld; const float* ks; };

DEVI int tr_job_count() { return DEPTH * (12 + 16 * 5 + 32); }
template <class P> DEVI TrJob tr_job(const P& p, int j) {
    const int per = 12 + 16 * 5 + 32; const int l = j / per; int q = j - l * per; TrJob t; t.ks = nullptr; t.src = nullptr;
    const float* win = p.in[I_WIN] + (size_t)l * DM * INW;
    bf16_t* winA = p.winA + (size_t)l * PA_W * DM; bf16_t* wup = p.wup + (size_t)l * UPW * 256; bf16_t* wcat = p.wcat + (size_t)l * DM * OCW;
    if (q == 0) { t.src = win; t.ld = INW; t.K = DM; t.ncols = 2944; t.dst = winA; t.dld = DM; return t; }
    if (q == 11) { t.src = win + 2944; t.ld = INW; t.K = DM; t.ncols = 32; t.dst = winA + (size_t)2944 * DM; t.dld = DM; return t; }
    if (q == 1) { t.src = nullptr; t.ld = 0; t.K = DM; t.ncols = 96; t.dst = winA + (size_t)2976 * DM; t.dld = DM; return t; }
    if (q == 2) { t.src = win + 2976; t.ld = INW; t.K = DM; t.ncols = 1024; t.dst = winA + (size_t)3072 * DM; t.dld = DM; return t; }
    if (q == 3) { t.src = win + 4000; t.ld = INW; t.K = DM; t.ncols = PG_W; t.dst = p.winG + (size_t)l * PG_W * DM; t.dld = DM; return t; }
    if (q == 4) { t.src = p.in[I_WUQ] + (size_t)l * 256 * 768; t.ld = 768; t.K = 256; t.ncols = 768; t.dst = wup; t.dld = 256; t.ks = p.in[I_QNORM] + l * 256; return t; }
    if (q == 5) { t.src = p.in[I_WUKV] + (size_t)l * 128 * 1024; t.ld = 1024; t.K = 128; t.ncols = 1024; t.dst = wup + (size_t)768 * 256; t.dld = 256; t.ks = p.in[I_KVNORM] + l * 128; return t; }
    if (q == 6) { t.src = nullptr; t.ld = 0; t.K = 128; t.ncols = 1024; t.dst = wup + (size_t)768 * 256 + 128; t.dld = 256; return t; }
    if (q >= 7 && q <= 9) { const int i = q - 7; const float* s = (i == 0 ? p.in[I_BRHG] : i == 1 ? p.in[I_BRMLA] : p.in[I_BRLRU]) + (size_t)l * 512 * DM;
        t.src = s; t.ld = DM; t.K = 512; t.ncols = DM; t.dst = wcat + i * 512; t.dld = OCW; return t; }
    if (q == 10) { t.src = p.in[I_WOUT] + (size_t)l * DM * DM; t.ld = DM; t.K = DM; t.ncols = DM; t.dst = p.wout + (size_t)l * DM * DM; t.dld = DM; return t; }
    q -= 12;
    if (q < 80) { const int e = q / 5, s = q % 5; const size_t le = (size_t)l * NEXP + e;
        if (s < 4) { const int pn = s >> 1, which = s & 1;
            t.src = (which ? p.in[I_W3] : p.in[I_W1]) + le * DM * DEXP + pn * 128; t.ld = DEXP; t.K = DM; t.ncols = 128;
            t.dst = p.w13 + le * 512 * DM + (size_t)(pn * 256 + which * 128) * DM; t.dld = DM; return t; }
        t.src = p.in[I_W2] + le * DEXP * DM; t.ld = DM; t.K = DEXP; t.ncols = DM; t.dst = p.w2 + le * DM * DEXP; t.dld = DEXP; return t; }
    q -= 80;
    { const int d = q >> 4, n = (q >> 1) & 7, which = q & 1;
      const size_t blk = (((size_t)l * 2 + d) * 8 + n);
      t.src = (which ? p.in[I_LWX] : p.in[I_LWA]) + blk * 64 * 64; t.ld = 64; t.K = 64; t.ncols = 64;
      t.dst = p.wlru + (blk * 2 + which) * 64 * 64; t.dld = 64; return t; }
}

template <class P> DEVI void phase_prep(const P& p, LAS unsigned char* lds) {
    const int tid = opq_tid(), G = gridDim.x;
    LAS float* tl = (LAS float*)lds;
    int rot = 0; const int nj = tr_job_count();
    for (int j = 0; j < nj; ++j) {
        const TrJob t = tr_job(p, j);
        const bool wide = (t.ncols & 63) == 0;
        const int tw = wide ? 64 : 32, tk = t.K / 64, ntile = tk * (t.ncols / tw);
        const int first = (int)((opq_bid() + (unsigned)G - (unsigned)(rot % G)) % (unsigned)G);
        if (wide) {
            for (int tile0 = first; tile0 < ntile; tile0 += 4 * G) {
                f32x4 v[4][2];
#pragma unroll
                for (int q = 0; q < 4; ++q) { const int tile = tile0 + q * G; const int k0 = (tile % tk) * 64, n0 = (tile / tk) * 64; const int n4 = tid & 15, kr = tid >> 4;
#pragma unroll
                    for (int i = 0; i < 2; ++i) { const int k = kr + 32 * i; f32x4 x = {0.f, 0.f, 0.f, 0.f};
                        if (tile < ntile && t.src) { x = *(const f32x4*)(t.src + (size_t)(k0 + k) * t.ld + n0 + n4 * 4); if (t.ks) x *= t.ks[k0 + k]; }
                        v[q][i] = x; } }
#pragma unroll
                for (int q = 0; q < 4; ++q) { const int n4 = tid & 15, kr = tid >> 4;
#pragma unroll
                    for (int i = 0; i < 2; ++i) { LAS float* d = tl + q * 4160 + (kr + 32 * i) * 65 + n4 * 4; d[0] = v[q][i][0]; d[1] = v[q][i][1]; d[2] = v[q][i][2]; d[3] = v[q][i][3]; } }
                __syncthreads();
#pragma unroll
                for (int q = 0; q < 4; ++q) { const int tile = tile0 + q * G; if (tile < ntile) { const int k0 = (tile % tk) * 64, n0 = (tile / tk) * 64; const int n = tid >> 3, k8 = (tid & 7) * 8;
                    const LAS float* sp = tl + q * 4160 + k8 * 65 + n;
                    u32x4 w; w.x = cvt_pk_bf16(sp[0], sp[65]); w.y = cvt_pk_bf16(sp[130], sp[195]); w.z = cvt_pk_bf16(sp[260], sp[325]); w.w = cvt_pk_bf16(sp[390], sp[455]);
                    *(u32x4*)(t.dst + (size_t)(n0 + n) * t.dld + k0 + k8) = w; } }
                __syncthreads();
            }
        } else {
            for (int tile0 = first; tile0 < ntile; tile0 += 8 * G) {
                float v[8][4];
#pragma unroll
                for (int q = 0; q < 8; ++q) { const int tile = tile0 + q * G; const int k0 = (tile % tk) * 64, n0 = (tile / tk) * 32; const int n = tid & 31, kr = tid >> 5;
#pragma unroll
                    for (int i = 0; i < 4; ++i) { const int k = kr + 16 * i; float x = 0.f;
                        if (tile < ntile && t.src) { x = t.src[(size_t)(k0 + k) * t.ld + n0 + n]; if (t.ks) x *= t.ks[k0 + k]; }
                        v[q][i] = x; } }
#pragma unroll
                for (int q = 0; q < 8; ++q) { const int n = tid & 31, kr = tid >> 5;
#pragma unroll
                    for (int i = 0; i < 4; ++i) tl[q * 2112 + (kr + 16 * i) * 33 + n] = v[q][i]; }
                __syncthreads();
#pragma unroll
                for (int q = 0; q < 8; ++q) { const int tile = tile0 + q * G; if (tile < ntile) { const int k0 = (tile % tk) * 64, n0 = (tile / tk) * 32; const int k = tid & 63, nn = tid >> 6;
#pragma unroll
                    for (int i = 0; i < 4; ++i) { const int n = nn + 8 * i; t.dst[(size_t)(n0 + n) * t.dld + k0 + k] = f2bf(tl[q * 2112 + k * 33 + n]); } } }
                __syncthreads();
            }
        }
        rot += ntile;
    }
    {
        LAS float* sl = (LAS float*)lds;
        LAS float* red = sl + 5 * 1024;
        for (int i = tid; i < 5 * 1024; i += 512) { const int r = i >> 10, k = i & 1023; const float v = r < 4 ? p.in[I_C][r * DM + k] : p.in[I_CCTX][k]; sl[i] = v * sigmoidf_(v); }
        __syncthreads();
        for (int u = opq_bid(); u < DEPTH * 96; u += G) {
            const int l = u / 96, n0 = (u % 96) * 64, col = tid & 63, ks = tid >> 6;
            const float* w = p.in[I_WMOD] + (size_t)l * DM * 6144 + n0 + col;
            float a0 = 0.f, a1 = 0.f, a2 = 0.f, a3 = 0.f, a4 = 0.f;
#pragma unroll 8
            for (int k = ks * 128; k < ks * 128 + 128; ++k) { const float wv = w[(size_t)k * 6144];
                a0 += sl[k] * wv; a1 += sl[1024 + k] * wv; a2 += sl[2048 + k] * wv; a3 += sl[3072 + k] * wv; a4 += sl[4096 + k] * wv; }
            red[(ks * 5 + 0) * 64 + col] = a0; red[(ks * 5 + 1) * 64 + col] = a1; red[(ks * 5 + 2) * 64 + col] = a2; red[(ks * 5 + 3) * 64 + col] = a3; red[(ks * 5 + 4) * 64 + col] = a4;
            __syncthreads();
            if (tid < 320) { const int r = tid >> 6, c2 = tid & 63; float s = p.in[I_BMOD][l * 6144 + n0 + c2];
#pragma unroll
                for (int q = 0; q < 8; ++q) s += red[(q * 5 + r) * 64 + c2];
                p.modv[((size_t)l * 5 + r) * 6144 + n0 + c2] = s; }
            __syncthreads();
        }
    }
    for (int i = opq_bid() * 512 + tid; i < SEQ * 16; i += G * 512) { const int pos = i >> 4, a = i & 15;
        const float inv = exp2f(-(float)(a & 7) * (13.287712379549449f / 8.0f)); const float ang = (float)((a < 8) ? (pos >> 6) : (pos & 63)) * inv;
        float sn, cs; sincosf(ang, &sn, &cs); p.rope[(size_t)pos * 32 + a] = cs; p.rope[(size_t)pos * 32 + 16 + a] = sn; }
    if (opq_bid() == 1) { for (int i = tid; i < DEPTH * 2 * 512; i += 512) p.lrula[i] = -8.0f * 1.44269504f * log1pf(__expf(-p.in[I_LAM][i])); }
    if (opq_bid() == 0) {
        for (int i = tid; i < 2 * 512; i += 512) { const float a0 = p.in[I_HGLB][i], a1 = p.in[I_HGLB][1024 + i]; const float m = fmaxf(a0, a1);
            const float e0 = __expf(a0 - m), e1 = __expf(a1 - m); p.lbv[i] = 0.f; p.lbv[1024 + i] = e1 / (e0 + e1); }
    }
}

DEVI void phase_norm1(const Params& p, int l, int hb) {
    const int lane = opq_tid() & 63, wv = opq_tid() >> 6;
    const float* gm = p.in[I_NMIX] + l * DM;
    for (int rl = opq_bid() * 8 + wv; rl < HR; rl += gridDim.x * 8) {
        const int r = hb * HR + rl;
        const float* src = (l == 0) ? xin_row_l0(p, r) : (const float*)xbuf_row(p, r);
        f32x4 v[4]; float ss = 0.f;
#pragma unroll
        for (int i = 0; i < 4; ++i) { v[i] = *(const f32x4*)(src + i * 256 + lane * 4); ss += v[i][0] * v[i][0] + v[i][1] * v[i][1] + v[i][2] * v[i][2] + v[i][3] * v[i][3]; }
        ss = wave_sum(ss);
        const float rstd = rsqrtf(ss * (1.0f / DM) + EPSF);
        const float* mv = p.modv + ((size_t)l * 5 + mod_row(r)) * 6144;
#pragma unroll
        for (int i = 0; i < 4; ++i) { const int c = i * 256 + lane * 4;
            const f32x4 g = *(const f32x4*)(gm + c), sh = *(const f32x4*)(mv + c), sc = *(const f32x4*)(mv + 1024 + c);
            f32x4 h;
#pragma unroll
            for (int e = 0; e < 4; ++e) h[e] = v[i][e] * rstd * g[e] * (1.0f + sc[e]) + sh[e];
            u32x2 w; w.x = cvt_pk_bf16(h[0], h[1]); w.y = cvt_pk_bf16(h[2], h[3]);
            *(u32x2*)(p.hx + (size_t)rl * DM + c) = w; }
    }
}

struct TileSched {
    static constexpr bool GATHER = false;
    int nM, nN, G, c, skipctx; const char* A; const char* B; size_t atile, btile; size_t acol_bytes;
    DEVI bool next(int i, g8::Unit& u) const {
        int pm, pn; if (!g8::static_order(i, G, c, nM, nN, pm, pn)) return false;
        const int pma = skipctx ? pm + pm / 32 : pm;
        u.pm = pma; u.pn = pn; u.tag = 0; u.a = A + (size_t)pma * atile + acol_bytes; u.b = B + (size_t)pn * btile; return true; }
};

template <int ACT> struct EpiBf16 {
    static constexpr bool PERM = true, HAS_MID = false; static constexpr int NSEG = 1;
    bf16_t* O; int ldc;
    DEVI void operator()(const f32x4 (&acc)[2][2][4][2], const g8::Unit& u, int wr, int wc, int fr, int fq) const {
        const int row0 = u.pm * 256 + wr * 64 + fr, col0 = u.pn * 256 + wc * 32 + 8 * fq;
#pragma unroll
        for (int ai = 0; ai < 2; ++ai)
#pragma unroll
            for (int m = 0; m < 4; ++m) { bf16_t* rowp = O + (size_t)(row0 + ai * 128 + m * 16) * ldc + col0;
#pragma unroll
                for (int bj = 0; bj < 2; ++bj) { f32x4 v0 = acc[ai][bj][m][0], v1 = acc[ai][bj][m][1];
                    if (ACT == 1) {
#pragma unroll
                        for (int e = 0; e < 4; ++e) { v0[e] = sigmoidf_(v0[e]); v1[e] = sigmoidf_(v1[e]); } }
                    u32x4 w; w.x = cvt_pk_bf16(v0[0], v0[1]); w.y = cvt_pk_bf16(v0[2], v0[3]); w.z = cvt_pk_bf16(v1[0], v1[1]); w.w = cvt_pk_bf16(v1[2], v1[3]);
                    *(u32x4*)(rowp + bj * 128) = w; } }
    }
};

DEVI void phase_inproj_a(const Params& p, int l, LAS unsigned char* lds) {
    TileSched S; S.nM = HR / 256; S.nN = PA_W / 256; S.G = gridDim.x; S.c = opq_bid(); S.skipctx = 0;
    S.A = (const char*)p.hx; S.B = (const char*)(p.winA + (size_t)l * PA_W * DM); S.atile = (size_t)256 * DM * 2; S.btile = (size_t)256 * DM * 2; S.acol_bytes = 0;
    EpiBf16<0> E; E.O = p.pa; E.ldc = PA_W;
    g8::gemm_phase(lds, DM, DM, DM, S, E);
}

struct UpSched { static constexpr bool GATHER = false; int G, c; const char* A; const char* B;
    DEVI bool next(int i, g8::Unit& u) const { const long L = (long)i * G + c; if (L >= (HR / 256) * 7) return false;
        const int pm = (int)(L / 7), j = (int)(L % 7); u.pm = pm; u.pn = j; u.tag = 0;
        u.a = A + (size_t)pm * 256 * PA_W * 2 + (size_t)(j < 3 ? C_DQ : C_DKV) * 2; u.b = B + (size_t)j * 256 * 256 * 2; return true; } };
DEVI void phase_mla_up(const Params& p, int l, LAS unsigned char* lds) {
    UpSched S; S.G = gridDim.x; S.c = opq_bid(); S.A = (const char*)p.pa; S.B = (const char*)(p.wup + (size_t)l * UPW * 256);
    EpiBf16<0> E; E.O = p.up; E.ldc = UPW;
    g8::gemm_phase(lds, PA_W, 256, 256, S, E);
}

DEVI void phase_inproj_g(const Params& p, int l, LAS unsigned char* lds) {
    const int skip = (l == DEPTH - 1);
    TileSched S; S.nM = skip ? 64 : HR / 256; S.nN = PG_W / 256; S.G = gridDim.x; S.c = opq_bid(); S.skipctx = skip;
    S.A = (const char*)p.hx; S.B = (const char*)(p.winG + (size_t)l * PG_W * DM); S.atile = (size_t)256 * DM * 2; S.btile = (size_t)256 * DM * 2; S.acol_bytes = 0;
    EpiBf16<1> E; E.O = p.pa; E.ldc = PG_W;
    g8::gemm_phase(lds, DM, DM, DM, S, E);
}

struct EpiMerge {
    static constexpr bool PERM = true; static constexpr int NSEG = 3;
    const bf16_t* pg; bf16_t* Y;
    static DEVI void unpack8(const u32x4& w, float (&f)[8]) {
#pragma unroll
        for (int e = 0; e < 8; ++e) { const unsigned x = w[e >> 1]; f[e] = (e & 1) ? __uint_as_float(x & 0xffff0000u) : __uint_as_float(x << 16); } }
    DEVI void mid(int sg, f32x4 (&acc)[2][2][4][2], const g8::Unit& u, int wr, int wc, int fr, int fq) const {
        const int row0 = u.pm * 256 + wr * 64 + fr, col0 = u.pn * 256 + wc * 32 + 8 * fq;
        const bf16_t* gbase = pg + (size_t)row0 * PG_W + col0 + sg * 1024;
#pragma unroll
        for (int ai = 0; ai < 2; ++ai)
#pragma unroll
            for (int mp = 0; mp < 2; ++mp) {
#pragma unroll
                for (int mi = 0; mi < 2; ++mi) { const int m = mp * 2 + mi; const bf16_t* gp = gbase + (size_t)(ai * 128 + m * 16) * PG_W;
#pragma unroll
                    for (int bj = 0; bj < 2; ++bj) { const u32x4 a = *(const u32x4*)(gp + bj * 128), b = *(const u32x4*)(gp + 1024 + bj * 128);
                        float fa[8], fb[8]; unpack8(a, fa); unpack8(b, fb);
#pragma unroll
                        for (int e = 0; e < 8; ++e) acc[ai][bj][m][e >> 2][e & 3] *= fa[e] * fast_rcp(fmaxf(fb[e], 1e-30f)); } }
                asm volatile("" : "+v"(acc[ai][0][mp * 2][0]), "+v"(acc[ai][0][mp * 2][1]), "+v"(acc[ai][1][mp * 2][0]), "+v"(acc[ai][1][mp * 2][1]),
                                  "+v"(acc[ai][0][mp * 2 + 1][0]), "+v"(acc[ai][0][mp * 2 + 1][1]), "+v"(acc[ai][1][mp * 2 + 1][0]), "+v"(acc[ai][1][mp * 2 + 1][1]) :: "memory"); }
    }
    DEVI void operator()(f32x4 (&acc)[2][2][4][2], const g8::Unit& u, int wr, int wc, int fr, int fq) const {
        const int row0 = u.pm * 256 + wr * 64 + fr, col0 = u.pn * 256 + wc * 32 + 8 * fq;
#pragma unroll
        for (int ai = 0; ai < 2; ++ai)
#pragma unroll
            for (int mp = 0; mp < 2; ++mp) {
#pragma unroll
                for (int mi = 0; mi < 2; ++mi) { const int m = mp * 2 + mi; const size_t row = (size_t)(row0 + ai * 128 + m * 16); const bf16_t* gp = pg + row * PG_W + col0 + 2048;
#pragma unroll
                    for (int bj = 0; bj < 2; ++bj) { const u32x4 a = *(const u32x4*)(gp + bj * 128); float fa[8]; unpack8(a, fa);
                        const f32x4 v0 = acc[ai][bj][m][0], v1 = acc[ai][bj][m][1];
                        u32x4 w; w.x = cvt_pk_bf16(v0[0] * fa[0], v0[1] * fa[1]); w.y = cvt_pk_bf16(v0[2] * fa[2], v0[3] * fa[3]);
                        w.z = cvt_pk_bf16(v1[0] * fa[4], v1[1] * fa[5]); w.w = cvt_pk_bf16(v1[2] * fa[6], v1[3] * fa[7]);
                        *(u32x4*)(Y + row * DM + col0 + bj * 128) = w; } }
                asm volatile("" ::: "memory"); }
    }
};
DEVI void phase_merge(const Params& p, int l, LAS unsigned char* lds) {
    const int skip = (l == DEPTH - 1);
    TileSched S; S.nM = skip ? 64 : HR / 256; S.nN = DM / 256; S.G = gridDim.x; S.c = opq_bid(); S.skipctx = skip;
    S.A = (const char*)p.ocat; S.B = (const char*)(p.wcat + (size_t)l * DM * OCW); S.atile = (size_t)256 * OCW * 2; S.btile = (size_t)256 * OCW * 2; S.acol_bytes = 0;
    EpiMerge E; E.pg = p.pa; E.Y = p.y;
    g8::gemm_phase(lds, OCW, OCW, OCW, S, E);
}

struct EpiOut {
    static constexpr bool PERM = false, HAS_MID = false; static constexpr int NSEG = 1;
    const float* x0; const float* c0; float* xo_; float* xc_; const float* modv; int l, hb;
    DEVI void operator()(const f32x4 (&acc)[2][2][4][2], const g8::Unit& u, int wr, int wc, int fr, int fq) const {
        const int row0 = u.pm * 256 + wr * 64 + fr, col0 = u.pn * 256 + wc * 32 + 4 * fq;
#pragma unroll
        for (int ai = 0; ai < 2; ++ai)
#pragma unroll
            for (int m = 0; m < 4; ++m) { const int r = hb * HR + row0 + ai * 128 + m * 16;
                const int b = r / RB, pos = r - b * RB; const bool lat = pos < SEQ;
                const size_t xoff = lat ? ((size_t)b * SEQ + pos) * DM : ((size_t)b * CTX + (pos - SEQ)) * DM;
                float* xo = (lat ? xo_ : xc_) + xoff; const float* xi = (l == 0) ? (lat ? x0 : c0) + xoff : (const float*)xo;
                const float* g1 = modv + ((size_t)l * 5 + (lat ? b : 4)) * 6144 + 2048;
#pragma unroll
                for (int bj = 0; bj < 2; ++bj)
#pragma unroll
                    for (int n = 0; n < 2; ++n) { const int c = col0 + bj * 128 + n * 16;
                        const f32x4 xv = *(const f32x4*)(xi + c), gv = *(const f32x4*)(g1 + c);
                        *(f32x4*)(xo + c) = xv + gv * acc[ai][bj][m][n]; } }
    }
};
DEVI void phase_outproj(const Params& p, int l, int hb, LAS unsigned char* lds) {
    const int skip = (l == DEPTH - 1);
    TileSched S; S.nM = skip ? 64 : HR / 256; S.nN = DM / 256; S.G = gridDim.x; S.c = opq_bid(); S.skipctx = skip;
    S.A = (const char*)p.y; S.B = (const char*)(p.wout + (size_t)l * DM * DM); S.atile = (size_t)256 * DM * 2; S.btile = (size_t)256 * DM * 2; S.acol_bytes = 0;
    EpiOut E; E.x0 = p.in[I_X]; E.c0 = p.in[I_CTX]; E.xo_ = p.out; E.xc_ = p.xc; E.modv = p.modv; E.l = l; E.hb = hb;
    g8::gemm_phase(lds, DM, DM, DM, S, E);
}

DEVI void phase_qkv(const Params& p, int l, LAS unsigned char* lds) {
    const int tid = opq_tid(), lane = tid & 63, wv = tid >> 6, h = lane >> 3, sub = lane & 7;
    LAS bf16_t* vt = (LAS bf16_t*)lds;
    const float* gq = p.in[I_GQ] + l * 96; const float* gk = p.in[I_GK] + l * 96;
    float gqn[8], gkn[8], gqr[4], gkr[4];
#pragma unroll
    for (int e = 0; e < 8; ++e) { gqn[e] = gq[sub * 8 + e]; gkn[e] = gk[sub * 8 + e]; }
#pragma unroll
    for (int e = 0; e < 4; ++e) { gqr[e] = gq[64 + sub * 4 + e]; gkr[e] = gk[64 + sub * 4 + e]; }
    const float qscale = 0.10206207261596577f * 1.4426950408889634f;
    const bool need_ctx_q = (l < DEPTH - 1);
    const bool upper = (sub & 4) != 0;
    struct QkIn { u32x2 dqw; unsigned dkw; u32x2 krw; u32x4 qnw; u32x2 qrw; u32x4 knw, vw; f32x4 cs4, sn4; };
    auto load_rows = [&](int u, QkIn (&r)[2]) {
        const int bl = u / (NCH * 4), tile = (u >> 2) % NCH, qtr = u & 3;
#pragma unroll
        for (int it = 0; it < 2; ++it) { const int pos = tile * 64 + qtr * 16 + wv * 2 + it, rl = bl * RB + pos;
            const bf16_t* prow = p.pa + (size_t)rl * PA_W; const bf16_t* urow = p.up + (size_t)rl * UPW;
            r[it].dqw = *(const u32x2*)(prow + C_DQ + lane * 4); r[it].dkw = *(const unsigned*)(prow + C_DKV + lane * 2); r[it].krw = *(const u32x2*)(prow + C_KR + sub * 4);
            r[it].qnw = *(const u32x4*)(urow + h * 96 + sub * 8); r[it].qrw = *(const u32x2*)(urow + h * 96 + 64 + sub * 4);
            r[it].knw = *(const u32x4*)(urow + 768 + h * 128 + sub * 8); r[it].vw = *(const u32x4*)(urow + 768 + h * 128 + 64 + sub * 8);
            r[it].cs4 = (f32x4){1.f, 1.f, 1.f, 1.f}; r[it].sn4 = (f32x4){0.f, 0.f, 0.f, 0.f};
            if (pos < SEQ) { const float* rt = p.rope + (size_t)pos * 32 + (sub & 3) * 4; r[it].cs4 = *(const f32x4*)rt; r[it].sn4 = *(const f32x4*)(rt + 16); } } };
    QkIn cur[2], nxt[2];
    const int nunit = 2 * NCH * 4, G = gridDim.x;
    if ((int)opq_bid() < nunit) load_rows(opq_bid(), cur);
    for (int u = opq_bid(); u < nunit; u += G) {
        const int bl = u / (NCH * 4), tile = (u >> 2) % NCH, qtr = u & 3;
        const bool more = u + G < nunit; if (more) load_rows(u + G, nxt);
#pragma unroll
        for (int it = 0; it < 2; ++it) {
            const int r16 = wv * 2 + it, rr = qtr * 16 + r16, pos = tile * 64 + rr;
            const bool lat = pos < SEQ;
            const u32x2 dqw = cur[it].dqw; const unsigned dkw = cur[it].dkw; const u32x2 krw = cur[it].krw; const u32x4 qnw = cur[it].qnw; const u32x2 qrw = cur[it].qrw;
            const u32x4 knw = cur[it].knw, vw = cur[it].vw; const f32x4 cs4 = cur[it].cs4, sn4 = cur[it].sn4;
            float sq, skv;
            { const float a0 = __uint_as_float(dqw.x << 16), a1 = __uint_as_float(dqw.x & 0xffff0000u), a2 = __uint_as_float(dqw.y << 16), a3 = __uint_as_float(dqw.y & 0xffff0000u);
              sq = a0 * a0 + a1 * a1 + a2 * a2 + a3 * a3;
              const float b0 = __uint_as_float(dkw << 16), b1 = __uint_as_float(dkw & 0xffff0000u); skv = b0 * b0 + b1 * b1; }
            sq = wave_sum(sq); skv = wave_sum(skv);
            const float rq = rsqrtf(sq * (1.0f / 256.0f) + EPSF), rkv = rsqrtf(skv * (1.0f / 128.0f) + EPSF);
            float qn[8], qr[4], kn[8], kr[4];
#pragma unroll
            for (int e = 0; e < 8; ++e) { const unsigned a = qnw[e >> 1], b = knw[e >> 1];
                qn[e] = ((e & 1) ? __uint_as_float(a & 0xffff0000u) : __uint_as_float(a << 16)) * rq;
                kn[e] = ((e & 1) ? __uint_as_float(b & 0xffff0000u) : __uint_as_float(b << 16)) * rkv; }
#pragma unroll
            for (int e = 0; e < 4; ++e) { const unsigned a = (e < 2) ? qrw.x : qrw.y, b = (e < 2) ? krw.x : krw.y;
                qr[e] = ((e & 1) ? __uint_as_float(a & 0xffff0000u) : __uint_as_float(a << 16)) * rq;
                kr[e] = ((e & 1) ? __uint_as_float(b & 0xffff0000u) : __uint_as_float(b << 16)); }
            float sqq = 0.f, skk = 0.f;
#pragma unroll
            for (int e = 0; e < 8; ++e) { sqq += qn[e] * qn[e]; skk += kn[e] * kn[e]; }
#pragma unroll
            for (int e = 0; e < 4; ++e) { sqq += qr[e] * qr[e]; skk += kr[e] * kr[e]; }
            sqq += __shfl_xor(sqq, 1); sqq += __shfl_xor(sqq, 2); sqq += __shfl_xor(sqq, 4);
            skk += __shfl_xor(skk, 1); skk += __shfl_xor(skk, 2); skk += __shfl_xor(skk, 4);
            const float rnq = rsqrtf(sqq * (1.0f / 96.0f) + EPSF) * qscale, rnk = rsqrtf(skk * (1.0f / 96.0f) + EPSF);
            float qo[12], ko[12];
#pragma unroll
            for (int e = 0; e < 8; ++e) { qo[e] = qn[e] * rnq * gqn[e]; ko[e] = kn[e] * rnk * gkn[e]; }
#pragma unroll
            for (int e = 0; e < 4; ++e) { const float a = qr[e] * rnq * gqr[e], b = kr[e] * rnk * gkr[e];
                const float pa_ = __shfl_xor(a, 4), pb_ = __shfl_xor(b, 4);
                qo[8 + e] = upper ? (a * cs4[e] + pa_ * sn4[e]) : (a * cs4[e] - pa_ * sn4[e]);
                ko[8 + e] = upper ? (b * cs4[e] + pb_ * sn4[e]) : (b * cs4[e] - pb_ * sn4[e]); }
            if (lat || need_ctx_q) {
                bf16_t* qd = lat ? p.q + (((size_t)(bl * 8 + h) * SEQ + pos) * 96) : p.qc + (((size_t)(bl * 8 + h) * CTX + (pos - SEQ)) * 96);
                u32x4 w; w.x = cvt_pk_bf16(qo[0], qo[1]); w.y = cvt_pk_bf16(qo[2], qo[3]); w.z = cvt_pk_bf16(qo[4], qo[5]); w.w = cvt_pk_bf16(qo[6], qo[7]);
                *(u32x4*)(qd + sub * 8) = w;
                u32x2 w2; w2.x = cvt_pk_bf16(qo[8], qo[9]); w2.y = cvt_pk_bf16(qo[10], qo[11]);
                *(u32x2*)(qd + 64 + sub * 4) = w2; }
            { bf16_t* kd = (bf16_t*)(p.kv + ((size_t)(bl * 8 + h) * NCH + tile) * KVT_BYTES + rr * 208);
              u32x4 w; w.x = cvt_pk_bf16(ko[0], ko[1]); w.y = cvt_pk_bf16(ko[2], ko[3]); w.z = cvt_pk_bf16(ko[4], ko[5]); w.w = cvt_pk_bf16(ko[6], ko[7]);
              *(u32x4*)(kd + sub * 8) = w;
              u32x2 w2; w2.x = cvt_pk_bf16(ko[8], ko[9]); w2.y = cvt_pk_bf16(ko[10], ko[11]);
              *(u32x2*)(kd + 64 + sub * 4) = w2; }
#pragma unroll
            for (int e = 0; e < 8; ++e) { const unsigned a = vw[e >> 1]; const float v = ((e & 1) ? __uint_as_float(a & 0xffff0000u) : __uint_as_float(a << 16)) * rkv;
                vt[(h * 64 + sub * 8 + e) * 20 + r16] = f2bf(v); }
        }
        __syncthreads();
        for (int i = tid; i < 8 * 64 * 4; i += 512) { const int hh = i >> 8, rem = i & 255, vc = rem >> 2, pc = rem & 3;
            const u32x2 w = *(const LAS u32x2*)(vt + (hh * 64 + vc) * 20 + pc * 4);
            *(u32x2*)(p.kv + ((size_t)(bl * 8 + hh) * NCH + tile) * KVT_BYTES + KT_BYTES + vc * 136 + qtr * 32 + pc * 8) = w; }
        __syncthreads();
        if (more) { cur[0] = nxt[0]; cur[1] = nxt[1]; }
    }
}

DEVI void attn_unit(const Params& p, LAS unsigned char* lds, const bf16_t* Qb, int nq, const unsigned char* kvb, int ntile, bf16_t* orow, float accinit) {
    const int tid = opq_tid(), lane = tid & 63, wv = __builtin_amdgcn_readfirstlane(tid >> 6), l31 = lane & 31, hh = lane >> 5;
    const bool active = wv * 64 < nq;
    bf16x8 qf[2][6];
#pragma unroll
    for (int qt = 0; qt < 2; ++qt)
#pragma unroll
        for (int ks = 0; ks < 6; ++ks) {
            if (active) qf[qt][ks] = *(const bf16x8*)(Qb + (size_t)(wv * 64 + qt * 32 + l31) * 96 + ks * 16 + hh * 8);
            else qf[qt][ks] = (bf16x8){0, 0, 0, 0, 0, 0, 0, 0}; }
    f32x16 O[2][2];
#pragma unroll
    for (int a = 0; a < 2; ++a)
#pragma unroll
        for (int b = 0; b < 2; ++b)
#pragma unroll
            for (int i = 0; i < 16; ++i) O[a][b][i] = 0.f;
    float lsum[2] = {0.f, 0.f};
    constexpr int STG = 2 * KVT_BYTES;
    const int nstage = ntile >> 1;
    auto stage_in = [&](int sidx, int bsel) {
        const unsigned char* g = kvb + (size_t)sidx * STG + lane * 16;
        for (int pc = wv; pc < 43; pc += 8)
            __builtin_amdgcn_global_load_lds((const unsigned*)(g + pc * 1024), (LAS unsigned*)(lds + bsel * STG + pc * 1024), 16, 0, 0);
    };
    stage_in(0, 0);
    __syncthreads();
    if (wv >= 4) __builtin_amdgcn_s_setprio(1);
    for (int sg = 0; sg < nstage; ++sg) {
        if (sg + 1 < nstage) stage_in(sg + 1, (sg + 1) & 1);
        if (active) {
#pragma unroll 1
            for (int kt = 0; kt < 4; ++kt) {
                const LAS unsigned char* kb = lds + (sg & 1) * STG + (kt >> 1) * KVT_BYTES; const LAS unsigned char* vb = kb + KT_BYTES; const int ks2 = kt & 1;
                bf16x8 kf[6];
#pragma unroll
                for (int ks = 0; ks < 6; ++ks) kf[ks] = *(const LAS bf16x8*)(kb + (ks2 * 32 + l31) * 208 + ks * 32 + hh * 16);
                bf16x8 vf[2][2];
#pragma unroll
                for (int vtile = 0; vtile < 2; ++vtile)
#pragma unroll
                    for (int s2 = 0; s2 < 2; ++s2) { const LAS unsigned char* a = vb + (vtile * 32 + l31) * 136 + (ks2 * 32 + s2 * 16 + 4 * hh) * 2;
                        const u32x2 lo = *(const LAS u32x2*)a, hi = *(const LAS u32x2*)(a + 16);
                        u32x4 w; w.x = lo.x; w.y = lo.y; w.z = hi.x; w.w = hi.y; vf[vtile][s2] = __builtin_bit_cast(bf16x8, w); }
                f32x16 S0, S1;
#pragma unroll
                for (int i = 0; i < 16; ++i) { S0[i] = accinit; S1[i] = accinit; }
#pragma unroll
                for (int ks = 0; ks < 6; ++ks) S0 = __builtin_amdgcn_mfma_f32_32x32x16_bf16(kf[ks], qf[0][ks], S0, 0, 0, 0);

#pragma unroll
                for (int ks = 0; ks < 6; ++ks) S1 = __builtin_amdgcn_mfma_f32_32x32x16_bf16(kf[ks], qf[1][ks], S1, 0, 0, 0);
                bf16x8 pb0[2], pb1[2];
                { float ls = 0.f;
#pragma unroll
                  for (int i = 0; i < 16; ++i) { S0[i] = fast_exp2(S0[i]); ls += S0[i]; }
                  lsum[0] += ls;
#pragma unroll
                  for (int s2 = 0; s2 < 2; ++s2) { u32x4 w; w.x = cvt_pk_bf16(S0[8 * s2 + 0], S0[8 * s2 + 1]); w.y = cvt_pk_bf16(S0[8 * s2 + 2], S0[8 * s2 + 3]);
                      w.z = cvt_pk_bf16(S0[8 * s2 + 4], S0[8 * s2 + 5]); w.w = cvt_pk_bf16(S0[8 * s2 + 6], S0[8 * s2 + 7]); pb0[s2] = __builtin_bit_cast(bf16x8, w); } }

#pragma unroll
                for (int s2 = 0; s2 < 2; ++s2)
#pragma unroll
                    for (int vtile = 0; vtile < 2; ++vtile) O[0][vtile] = __builtin_amdgcn_mfma_f32_32x32x16_bf16(vf[vtile][s2], pb0[s2], O[0][vtile], 0, 0, 0);
                { float ls = 0.f;
#pragma unroll
                  for (int i = 0; i < 16; ++i) { S1[i] = fast_exp2(S1[i]); ls += S1[i]; }
                  lsum[1] += ls;
#pragma unroll
                  for (int s2 = 0; s2 < 2; ++s2) { u32x4 w; w.x = cvt_pk_bf16(S1[8 * s2 + 0], S1[8 * s2 + 1]); w.y = cvt_pk_bf16(S1[8 * s2 + 2], S1[8 * s2 + 3]);
                      w.z = cvt_pk_bf16(S1[8 * s2 + 4], S1[8 * s2 + 5]); w.w = cvt_pk_bf16(S1[8 * s2 + 6], S1[8 * s2 + 7]); pb1[s2] = __builtin_bit_cast(bf16x8, w); } }

#pragma unroll
                for (int s2 = 0; s2 < 2; ++s2)
#pragma unroll
                    for (int vtile = 0; vtile < 2; ++vtile) O[1][vtile] = __builtin_amdgcn_mfma_f32_32x32x16_bf16(vf[vtile][s2], pb1[s2], O[1][vtile], 0, 0, 0);
            }
        }
        __syncthreads();
    }
    __builtin_amdgcn_s_setprio(0);
    if (active) {
#pragma unroll
        for (int qt = 0; qt < 2; ++qt) {
            const float tot = lsum[qt] + __shfl_xor(lsum[qt], 32); const float inv = 1.0f / tot;
            bf16_t* orw = orow + (size_t)(wv * 64 + qt * 32 + l31) * OCW;
#pragma unroll
            for (int vtile = 0; vtile < 2; ++vtile)
#pragma unroll
                for (int g4 = 0; g4 < 4; ++g4) { u32x2 w; w.x = cvt_pk_bf16(O[qt][vtile][4 * g4 + 0] * inv, O[qt][vtile][4 * g4 + 1] * inv);
                    w.y = cvt_pk_bf16(O[qt][vtile][4 * g4 + 2] * inv, O[qt][vtile][4 * g4 + 3] * inv);
                    *(u32x2*)(orw + vtile * 32 + 8 * g4 + 4 * hh) = w; }
        }
    }
}

DEVI float attn_offset(const Params& p, int l) {
    const int lane = opq_tid() & 63;
    const float* gq = p.in[I_GQ] + l * 96; const float* gk = p.in[I_GK] + l * 96;
    float a = fmaxf(fabsf(gq[lane]), lane < 32 ? fabsf(gq[64 + lane]) : 0.f), b = fmaxf(fabsf(gk[lane]), lane < 32 ? fabsf(gk[64 + lane]) : 0.f);
    a = wave_max(a); b = wave_max(b);
    return -(9.797958971132712f * 1.4426950408889634f * a * b * 1.001f);
}

constexpr int HGP = 72;
constexpr int ZP = 68;
constexpr int HG_ZT0 = 0, HG_ZT1 = 17408, HG_KEY0 = 34816, HG_KEY1 = 52224, HG_VT = 69632, HG_KRM0 = 78848, HG_KRM1 = 88064, HG_QRM0 = 97280, HG_QRM1 = 106496,
              HG_S2T0 = 115712, HG_S2T1 = 124928, HG_A20 = 134144, HG_A21 = 143360, HG_GT = 152576  , HG_REF = 156672  , HG_BT = 157184  ,
              HG_O = HG_ZT0  ;
DEVI bf16x8 hg_frag_tr(const LAS unsigned char* tile, int k0, int c0, int lane) {
    const unsigned g = lane >> 4, q = (lane & 15) >> 2, pp = lane & 3;
    const unsigned a0 = (unsigned)(size_t)tile + (unsigned)((k0 + 8 * g + q) * (HGP * 2) + (c0 + 4 * pp) * 2), a1 = a0 + 4 * HGP * 2;
    u32x2 r0, r1;
    asm volatile("ds_read_b64_tr_b16 %0, %2\n\tds_read_b64_tr_b16 %1, %3\n\ts_waitcnt lgkmcnt(0)" : "=&v"(r0), "=&v"(r1) : "v"(a0), "v"(a1) : "memory");
    u32x4 w; w.x = r0.x; w.y = r0.y; w.z = r1.x; w.w = r1.y; return __builtin_bit_cast(bf16x8, w);
}

DEVI int hg_pos0(int tc) { return tc < 128 ? tc * 64 : SEQ + (tc - 128) * 64; }
DEVI int hg_chain_pos(int tc, int dir) { return dir ? (NCH - 1 - tc) : (tc < 128 ? tc + 4 : tc - 128); }

struct HgIn { u32x4 q, zf, zb, v, g, sf, sb; };
template <bool PASS3> DEVI void hg_load(const Params& p, int u, HgIn& r) {
    const int tid = opq_tid(), tk = tid >> 3, pc = tid & 7; const int tc = u % NCH, h = (u / NCH) & 7, bl = u / (NCH * 8);
    const bf16_t* prow = p.pa + (size_t)(bl * RB + hg_pos0(tc) + tk) * PA_W + h * 64 + pc * 8;
    r.zf = *(const u32x4*)(prow + C_ZF); r.zb = *(const u32x4*)(prow + C_ZB); r.v = *(const u32x4*)(prow + C_I);
    if (PASS3) { r.q = *(const u32x4*)(prow + C_Q); r.g = *(const u32x4*)(prow + C_G);
        const size_t uf = ((size_t)((bl * 2 + 0) * 8 + h)) * NCH + hg_chain_pos(tc, 0), ub = ((size_t)((bl * 2 + 1) * 8 + h)) * NCH + hg_chain_pos(tc, 1);
        r.sf = *(const u32x4*)(p.st + uf * 4096 + tk * 64 + pc * 8); r.sb = *(const u32x4*)(p.st + ub * 4096 + tk * 64 + pc * 8); }
}
DEVI float bfw(const u32x4& w, int e) { const unsigned x = w[e >> 1]; return (e & 1) ? __uint_as_float(x & 0xffff0000u) : __uint_as_float(x << 16); }

template <bool PASS3> DEVI void hg_prepare(const Params& p, int l, LAS unsigned char* lds, int h, const HgIn& r) {
    const int tid = opq_tid(), tk = tid >> 3, pc = tid & 7;
    LAS float* gt = (LAS float*)(lds + HG_GT); LAS float* refv = (LAS float*)(lds + HG_REF); LAS float* btv = (LAS float*)(lds + HG_BT);
    {
#pragma unroll
        for (int dir = 0; dir < 2; ++dir) {
            LAS float* zt = (LAS float*)(lds + (dir ? HG_ZT1 : HG_ZT0)); LAS float* keyt = (LAS float*)(lds + (dir ? HG_KEY1 : HG_KEY0));
            const float* lbp = p.lbv + ((size_t)l * 2 + dir) * 512 + h * 64 + pc * 8;
            float lf[8], ky[8];
#pragma unroll
            for (int e = 0; e < 8; ++e) { const float z = bfw(dir ? r.zb : r.zf, e); const float lb = lbp[e];
                const float ez = fast_exp2(-1.44269504f * fabsf(z)), opl = 1.0f + ez, rc = fast_rcp(opl);
                const float logsig = -(fmaxf(-z, 0.f) + 0.69314718f * __builtin_amdgcn_logf(opl));
                const float sigp = (z >= 0.f) ? rc : ez * rc;
                lf[e] = (lb > 0.f) ? 0.69314718f * __builtin_amdgcn_logf(lb + (1.0f - lb) * sigp) : logsig;
                ky[e] = (1.0f - lb) * (1.0f - sigp); }
            *(LAS f32x4*)(zt + tk * ZP + pc * 8) = (f32x4){lf[0], lf[1], lf[2], lf[3]}; *(LAS f32x4*)(zt + tk * ZP + pc * 8 + 4) = (f32x4){lf[4], lf[5], lf[6], lf[7]};
            *(LAS f32x4*)(keyt + tk * ZP + pc * 8) = (f32x4){ky[0], ky[1], ky[2], ky[3]}; *(LAS f32x4*)(keyt + tk * ZP + pc * 8 + 4) = (f32x4){ky[4], ky[5], ky[6], ky[7]}; }
        *(LAS u32x4*)(lds + HG_VT + (tk * HGP + pc * 8) * 2) = r.v;
    }
    __syncthreads();
    {
        const int d = tid & 63, jg = tid >> 6; float c0[8], c1[8]; float run = 0.f;
        LAS float* zt0 = (LAS float*)(lds + HG_ZT0); LAS float* zt1 = (LAS float*)(lds + HG_ZT1);
#pragma unroll
        for (int i = 0; i < 8; ++i) { run += zt0[(jg * 8 + i) * ZP + d]; c0[i] = run; }
        gt[jg * 64 + d] = run; run = 0.f;
#pragma unroll
        for (int i = 7; i >= 0; --i) { run += zt1[(jg * 8 + i) * ZP + d]; c1[i] = run; }
        gt[512 + jg * 64 + d] = run;
        __syncthreads();
        float off0 = 0.f, off1 = 0.f;
#pragma unroll
        for (int g2 = 0; g2 < 8; ++g2) { off0 += (g2 < jg) ? gt[g2 * 64 + d] : 0.f; off1 += (g2 > jg) ? gt[512 + g2 * 64 + d] : 0.f; }
#pragma unroll
        for (int i = 0; i < 8; ++i) { zt0[(jg * 8 + i) * ZP + d] = c0[i] + off0; zt1[(jg * 8 + i) * ZP + d] = c1[i] + off1; }
        if (jg == 3) refv[d] = c0[7] + off0;
        if (jg == 7) btv[d] = c0[7] + off0;
        if (jg == 4) refv[64 + d] = c1[0] + off1;
        if (jg == 0) btv[64 + d] = c1[0] + off1;
    }
    __syncthreads();
    {
#pragma unroll
        for (int dir = 0; dir < 2; ++dir) {
            const LAS float* zt = (const LAS float*)(lds + (dir ? HG_ZT1 : HG_ZT0)); const LAS float* keyt = (const LAS float*)(lds + (dir ? HG_KEY1 : HG_KEY0));
            float kt[8], qt[8];
            const f32x4 z0 = *(const LAS f32x4*)(zt + tk * ZP + pc * 8), z1 = *(const LAS f32x4*)(zt + tk * ZP + pc * 8 + 4);
            const f32x4 k0 = *(const LAS f32x4*)(keyt + tk * ZP + pc * 8), k1 = *(const LAS f32x4*)(keyt + tk * ZP + pc * 8 + 4);
            const f32x4 r0 = *(const LAS f32x4*)(refv + dir * 64 + pc * 8), r1 = *(const LAS f32x4*)(refv + dir * 64 + pc * 8 + 4);
#pragma unroll
            for (int e = 0; e < 8; ++e) { const float bc = e < 4 ? z0[e & 3] : z1[e & 3], rf = e < 4 ? r0[e & 3] : r1[e & 3], ke = e < 4 ? k0[e & 3] : k1[e & 3];
                kt[e] = ke * fast_exp2(1.44269504f * fminf(rf - bc, 80.f)); if (PASS3) qt[e] = bfw(r.q, e) * fast_exp2(1.44269504f * fminf(bc - rf, 80.f)); }
            { u32x4 w; w.x = cvt_pk_bf16(kt[0], kt[1]); w.y = cvt_pk_bf16(kt[2], kt[3]); w.z = cvt_pk_bf16(kt[4], kt[5]); w.w = cvt_pk_bf16(kt[6], kt[7]);
              *(LAS u32x4*)(lds + (dir ? HG_KRM1 : HG_KRM0) + (tk * HGP + pc * 8) * 2) = w; }
            if (PASS3) {
                u32x4 w; w.x = cvt_pk_bf16(qt[0], qt[1]); w.y = cvt_pk_bf16(qt[2], qt[3]); w.z = cvt_pk_bf16(qt[4], qt[5]); w.w = cvt_pk_bf16(qt[6], qt[7]);
                *(LAS u32x4*)(lds + (dir ? HG_QRM1 : HG_QRM0) + (tk * HGP + pc * 8) * 2) = w;
                const float er = fast_exp2(1.44269504f * refv[dir * 64 + tk]); float sv[8];
#pragma unroll
                for (int e = 0; e < 8; ++e) sv[e] = bfw(dir ? r.sb : r.sf, e) * er;
                w.x = cvt_pk_bf16(sv[0], sv[1]); w.y = cvt_pk_bf16(sv[2], sv[3]); w.z = cvt_pk_bf16(sv[4], sv[5]); w.w = cvt_pk_bf16(sv[6], sv[7]);
                *(LAS u32x4*)(lds + (dir ? HG_S2T1 : HG_S2T0) + (tk * HGP + pc * 8) * 2) = w;
            }
        }
    }
    __syncthreads();
}
DEVI bf16x8 hg_frag(const LAS unsigned char* base, int r, int c0) { return *(const LAS bf16x8*)(base + (size_t)(r * HGP + c0) * 2); }

DEVI void hg_pass1_unit(const Params& p, int l, LAS unsigned char* lds, int u, const HgIn& r) {
    const int tc = u % NCH, h = (u / NCH) & 7, bl = u / (NCH * 8);
    hg_prepare<false>(p, l, lds, h, r);
    const int tid = opq_tid(), lane = tid & 63, wv = tid >> 6, l15 = lane & 15, g = lane >> 4;
    const LAS float* refv = (const LAS float*)(lds + HG_REF); const LAS float* btv = (const LAS float*)(lds + HG_BT);
    const int dt = wv >> 1, ct0 = (wv & 1) * 2;
#pragma unroll
    for (int dir = 0; dir < 2; ++dir) {
        const size_t unit = ((size_t)((bl * 2 + dir) * 8 + h)) * NCH + hg_chain_pos(tc, dir);
        bf16_t* so = p.st + unit * 4096;
        const LAS unsigned char* krm = lds + (dir ? HG_KRM1 : HG_KRM0);
        bf16x8 af[2];
#pragma unroll
        for (int ks = 0; ks < 2; ++ks) af[ks] = hg_frag_tr(krm, 32 * ks, 16 * dt, lane);
#pragma unroll
        for (int ci = 0; ci < 2; ++ci) { const int ct = ct0 + ci; f32x4 acc = {0.f, 0.f, 0.f, 0.f};
#pragma unroll
            for (int ks = 0; ks < 2; ++ks) acc = __builtin_amdgcn_mfma_f32_16x16x32_bf16(af[ks], hg_frag_tr(lds + HG_VT, 32 * ks, 16 * ct, lane), acc, 0, 0, 0);
#pragma unroll
            for (int rr = 0; rr < 4; ++rr) { const int d = 16 * dt + 4 * g + rr; so[d * 64 + 16 * ct + l15] = f2bf(acc[rr] * fast_exp2(1.44269504f * (btv[dir * 64 + d] - refv[dir * 64 + d]))); } }
        if (tid < 64) p.stb[unit * 64 + tid] = btv[dir * 64 + tid];
    }
    __syncthreads();
}

DEVI void hg_pass3_unit(const Params& p, int l, LAS unsigned char* lds, int u, const HgIn& r) {
    const int tc = u % NCH, h = (u / NCH) & 7, bl = u / (NCH * 8);
    const int tid = opq_tid(), lane = tid & 63, wv = tid >> 6, l15 = lane & 15, g = lane >> 4;
    hg_prepare<true>(p, l, lds, h, r);
    { const int tt = wv >> 1, st0 = (wv & 1) * 2;
#pragma unroll
      for (int dir = 0; dir < 2; ++dir) {
          const LAS unsigned char* qrm = lds + (dir ? HG_QRM1 : HG_QRM0); const LAS unsigned char* krm = lds + (dir ? HG_KRM1 : HG_KRM0); LAS bf16_t* a2 = (LAS bf16_t*)(lds + (dir ? HG_A21 : HG_A20));
          bf16x8 bq[2];
#pragma unroll
          for (int ks = 0; ks < 2; ++ks) bq[ks] = hg_frag(qrm, 16 * tt + l15, 32 * ks + 8 * g);
#pragma unroll
          for (int si = 0; si < 2; ++si) { const int st = st0 + si; f32x4 acc = {0.f, 0.f, 0.f, 0.f};
#pragma unroll
              for (int ks = 0; ks < 2; ++ks) acc = __builtin_amdgcn_mfma_f32_16x16x32_bf16(hg_frag(krm, 16 * st + l15, 32 * ks + 8 * g), bq[ks], acc, 0, 0, 0);
              const int t = 16 * tt + l15, s0 = 16 * st + 4 * g; float v[4];
#pragma unroll
              for (int e = 0; e < 4; ++e) v[e] = (dir == 0 ? (s0 + e <= t) : (s0 + e >= t)) ? acc[e] : 0.f;
              u32x2 w; w.x = cvt_pk_bf16(v[0], v[1]); w.y = cvt_pk_bf16(v[2], v[3]);
              *(LAS u32x2*)(a2 + t * HGP + s0) = w; } } }
    __syncthreads();
    { const int tt = wv >> 1, ct0 = (wv & 1) * 2; LAS float* olds = (LAS float*)(lds + HG_O);
      f32x4 acc[2] = {{0.f, 0.f, 0.f, 0.f}, {0.f, 0.f, 0.f, 0.f}};
#pragma unroll
      for (int dir = 0; dir < 2; ++dir) {
          const LAS unsigned char* qrm = lds + (dir ? HG_QRM1 : HG_QRM0); const LAS unsigned char* a2 = lds + (dir ? HG_A21 : HG_A20); const LAS unsigned char* s2t = lds + (dir ? HG_S2T1 : HG_S2T0);
          bf16x8 aa[2], aq[2];
#pragma unroll
          for (int ks = 0; ks < 2; ++ks) { aa[ks] = hg_frag(a2, 16 * tt + l15, 32 * ks + 8 * g); aq[ks] = hg_frag(qrm, 16 * tt + l15, 32 * ks + 8 * g); }
#pragma unroll
          for (int ci = 0; ci < 2; ++ci) { const int ct = ct0 + ci;
#pragma unroll
              for (int ks = 0; ks < 2; ++ks) acc[ci] = __builtin_amdgcn_mfma_f32_16x16x32_bf16(aa[ks], hg_frag_tr(lds + HG_VT, 32 * ks, 16 * ct, lane), acc[ci], 0, 0, 0);
#pragma unroll
              for (int ks = 0; ks < 2; ++ks) acc[ci] = __builtin_amdgcn_mfma_f32_16x16x32_bf16(aq[ks], hg_frag_tr(s2t, 32 * ks, 16 * ct, lane), acc[ci], 0, 0, 0); } }
#pragma unroll
      for (int ci = 0; ci < 2; ++ci)
#pragma unroll
          for (int rr = 0; rr < 4; ++rr) olds[(16 * tt + 4 * g + rr) * 65 + 16 * (ct0 + ci) + l15] = acc[ci][rr]; }
    __syncthreads();
    { const int tok = tid >> 3, pc = tid & 7; const int row = bl * RB + hg_pos0(tc) + tok; const LAS float* olds = (const LAS float*)(lds + HG_O);
      float o[8]; float ss = 0.f;
#pragma unroll
      for (int e = 0; e < 8; ++e) { o[e] = olds[tok * 65 + pc * 8 + e]; ss += o[e] * o[e]; }
      ss += __shfl_xor(ss, 1); ss += __shfl_xor(ss, 2); ss += __shfl_xor(ss, 4);
      const float rstd = rsqrtf(ss * (1.0f / 64.0f) + EPSF);
      const float* gn = p.in[I_HGNORM] + l * 64 + pc * 8;
      float rr[8];
#pragma unroll
      for (int e = 0; e < 8; ++e) rr[e] = o[e] * rstd * gn[e] * sigmoidf_(bfw(r.g, e));
      u32x4 w; w.x = cvt_pk_bf16(rr[0], rr[1]); w.y = cvt_pk_bf16(rr[2], rr[3]); w.z = cvt_pk_bf16(rr[4], rr[5]); w.w = cvt_pk_bf16(rr[6], rr[7]);
      *(u32x4*)(p.ocat + (size_t)row * OCW + h * 64 + pc * 8) = w; }
    __syncthreads();
}

DEVI void hg_prefix(const Params& p, bool dry = false) {
    const int total = 2 * 2 * 8 * 4096;
    for (int gidx = opq_bid() * 512 + opq_tid(); gidx < total; gidx += gridDim.x * 512) {
        const int chain = gidx >> 12, e = gidx & 4095, d = e >> 6;
        bf16_t* s = p.st + (size_t)chain * NCH * 4096 + e; const float* bt = p.stb + (size_t)chain * NCH * 64 + d;
        float S = 0.f;
#pragma unroll 1
        for (int q0 = 0; q0 < NCH; q0 += 12) { float loc[12], b[12];
#pragma unroll
            for (int i = 0; i < 12; ++i) { loc[i] = bf2f(s[(size_t)(q0 + i) * 4096]); b[i] = bt[(q0 + i) * 64]; }
#pragma unroll
            for (int i = 0; i < 12; ++i) { if (!dry) s[(size_t)(q0 + i) * 4096] = f2bf(S); S = S * fast_exp2(1.44269504f * b[i]) + loc[i]; } }
        if (dry && S == 123.456f) s[0] = 0;
    }
}

constexpr int LR_UB = 0, LR_UP = 520, LR_AF = 16640, LR_IF = LR_AF + 32768, LR_AB = LR_IF + 32768, LR_IB = LR_AB + 32768;
constexpr int NT16 = RB / 16;

DEVI int lr_pos0(int tt) { return tt * 16; }
DEVI int lr_chain_pos(int tt, int dir) { return dir ? (NT16 - 1 - tt) : (tt < 512 ? tt + 16 : tt - 512); }

struct LruW { bf16x8 b[2][4][2]; float ba[4], bx[4], la[4]; };
DEVI void lru_load_w(const Params& p, int l, int dir, int n, int l15, int g, LruW& w) {
#pragma unroll
    for (int which = 0; which < 2; ++which)
#pragma unroll
        for (int ct = 0; ct < 4; ++ct)
#pragma unroll
            for (int ks = 0; ks < 2; ++ks)
                w.b[which][ct][ks] = *(const bf16x8*)(p.wlru + ((((size_t)(l * 2 + dir) * 8 + n) * 2 + which) * 64 + 16 * ct + l15) * 64 + 32 * ks + 8 * g);
#pragma unroll
    for (int ct = 0; ct < 4; ++ct) { const int c = (l * 2 + dir) * 512 + n * 64 + 16 * ct + l15;
        w.ba[ct] = p.in[I_LBA][c]; w.bx[ct] = p.in[I_LBX][c]; w.la[ct] = p.lrula[c]; }
}
struct LrIn { bf16_t x[19]; bf16_t y[16]; float h_in; };
template <int MODE> DEVI void lru_load(const Params& p, int u, LrIn& r) {
    const int bl = u / NT16, tt = u % NT16, c = opq_tid();
    const int pos0 = tt * 16, seg0 = tt < 512 ? 0 : SEQ, seg1 = tt < 512 ? SEQ : RB;
    const bf16_t* xx = p.pa + (size_t)bl * RB * PA_W + C_LX + c;
#pragma unroll
    for (int i = 0; i < 19; ++i) { const int pos = pos0 - 2 + i; r.x[i] = (pos >= seg0 && pos < seg1) ? xx[(size_t)pos * PA_W] : (bf16_t)0; }
    if (MODE == 2) { const bf16_t* yy = p.pa + ((size_t)bl * RB + pos0) * PA_W + C_LY + c;
#pragma unroll
        for (int t = 0; t < 16; ++t) r.y[t] = yy[(size_t)t * PA_W]; }
    if (MODE == 1) r.h_in = p.lin[((size_t)(bl * 2 + 0) * NT16 + lr_chain_pos(tt, 0)) * 512 + c];
    if (MODE == 2) r.h_in = p.lin[((size_t)(bl * 2 + 1) * NT16 + lr_chain_pos(tt, 1)) * 512 + c];
}
#define LR_WAVE_SYNC() do { asm volatile("s_waitcnt lgkmcnt(0)" ::: "memory"); __builtin_amdgcn_wave_barrier(); } while (0)
DEVI void lru_tile_gates(const Params& p, int l, LAS unsigned char* lds, const LrIn& in, const LruW& w) {
    const int tid = opq_tid(), lane = tid & 63, n = tid >> 6, l15 = lane & 15, g = lane >> 4;
    LAS bf16_t* ub = (LAS bf16_t*)(lds + LR_UB);
    {
        const int c = tid;
        const float* cw = p.in[I_CONVW] + (size_t)l * 4 * 512; const float w0 = cw[c], w1 = cw[512 + c], w2 = cw[1024 + c], w3 = cw[1536 + c], cb = p.in[I_CONVB][l * 512 + c];
        float x[19];
#pragma unroll
        for (int i = 0; i < 19; ++i) x[i] = bf2f(in.x[i]);
#pragma unroll
        for (int t = 0; t < 16; ++t) ub[t * LR_UP + c] = f2bf(cb + w0 * x[t] + w1 * x[t + 1] + w2 * x[t + 2] + w3 * x[t + 3]);
    }
    LR_WAVE_SYNC();
    bf16x8 af[2];
#pragma unroll
    for (int ks = 0; ks < 2; ++ks) af[ks] = *(const LAS bf16x8*)(ub + l15 * LR_UP + n * 64 + 32 * ks + 8 * g);
    LAS float* aL = (LAS float*)(lds + LR_AF); LAS float* iL = (LAS float*)(lds + LR_IF);
#pragma unroll
    for (int ct = 0; ct < 4; ++ct) {
        f32x4 ra = {0.f, 0.f, 0.f, 0.f}, xa = {0.f, 0.f, 0.f, 0.f};
#pragma unroll
        for (int ks = 0; ks < 2; ++ks) { ra = __builtin_amdgcn_mfma_f32_16x16x32_bf16(af[ks], w.b[0][ct][ks], ra, 0, 0, 0); xa = __builtin_amdgcn_mfma_f32_16x16x32_bf16(af[ks], w.b[1][ct][ks], xa, 0, 0, 0); }
        const int c = n * 64 + 16 * ct + l15;
#pragma unroll
        for (int r = 0; r < 4; ++r) { const int t = 4 * g + r;
            const float rg = sigmoidf_(ra[r] + w.ba[ct]), ig = sigmoidf_(xa[r] + w.bx[ct]);
            const float a = fast_exp2(rg * w.la[ct]); const float uu = bf2f(ub[t * LR_UP + c]);
            aL[t * 512 + c] = a; iL[t * 512 + c] = __builtin_amdgcn_sqrtf(fmaxf(1.0f - a * a, 0.f)) * ig * uu; }
    }
    LR_WAVE_SYNC();
}
template <int MODE> DEVI void lru_sweep(const Params& p, int l, LAS unsigned char* lds, int dir, int u0, int uend, int ubase, bool skipc) {
    const int tid = opq_tid(), lane = tid & 63, n = tid >> 6, l15 = lane & 15, g = lane >> 4, G = gridDim.x;
    if (u0 >= uend) return;
    LruW w; lru_load_w(p, l, dir, n, l15, g, w);
    const LAS float* aL = (const LAS float*)(lds + LR_AF); const LAS float* iL = (const LAS float*)(lds + LR_IF);
    LrIn cur, nxt; lru_load<MODE>(p, u0 - ubase, cur);
    for (int u = u0; u < uend; u += G) {
        const bool more = u + G < uend; if (more) lru_load<MODE>(p, u + G - ubase, nxt);
        const int uu = u - ubase, bl = uu / NT16, tt = uu % NT16;
        if (!(skipc && tt >= 512)) {
            lru_tile_gates(p, l, lds, cur, w);
            if (MODE == 0) { float A = 1.f, H = 0.f;
#pragma unroll
                for (int t = 0; t < 16; ++t) { const float a = aL[t * 512 + tid], b = iL[t * 512 + tid]; if (dir == 0) { H = a * H + b; A *= a; } else { H += b * A; A *= a; } }
                *((f32x2_t*)p.lsum + ((size_t)(bl * 2 + dir) * NT16 + lr_chain_pos(tt, dir)) * 512 + tid) = (f32x2_t){A, H};
            } else { bf16_t* ocol = p.ocat + ((size_t)bl * RB + lr_pos0(tt)) * OCW + 1024 + tid; float h = cur.h_in;
                if (MODE == 1) {
#pragma unroll
                    for (int t = 0; t < 16; ++t) { h = aL[t * 512 + tid] * h + iL[t * 512 + tid]; ocol[(size_t)t * OCW] = f2bf(h); }
                } else {
                    float hfv[16];
#pragma unroll
                    for (int t = 0; t < 16; ++t) hfv[t] = bf2f(ocol[(size_t)t * OCW]);
#pragma unroll
                    for (int t = 15; t >= 0; --t) { h = aL[t * 512 + tid] * h + iL[t * 512 + tid];
                        const float y = bf2f(cur.y[t]); const float x3 = 0.7978845608028654f * (y + 0.044715f * y * y * y);
                        const float th = 1.0f - 2.0f * fast_rcp(1.0f + fast_exp2(2.88539008f * x3));
                        ocol[(size_t)t * OCW] = f2bf((hfv[t] + h) * 0.5f * y * (1.0f + th)); } }
            }
            LR_WAVE_SYNC();
        }
        if (more) cur = nxt;
    }
}
DEVI void lru_prefix(const Params& p, bool dry = false) {
    const int lane = opq_tid() & 63, wv = opq_tid() >> 6;
    for (int chain = opq_bid() * 8 + wv; chain < 2 * 2 * 512; chain += gridDim.x * 8) {
        const int c = chain & 511, bd = chain >> 9;
        const f32x2_t* src = (const f32x2_t*)p.lsum + (size_t)bd * NT16 * 512 + c; float* dst = p.lin + (size_t)bd * NT16 * 512 + c;
        f32x2_t v[9]; float A = 1.f, H = 0.f;
#pragma unroll
        for (int i = 0; i < 9; ++i) { const int q = lane * 9 + i; v[i] = (q < NT16) ? src[(size_t)q * 512] : (f32x2_t){1.f, 0.f}; H = v[i].x * H + v[i].y; A *= v[i].x; }
#pragma unroll
        for (int o = 1; o < 64; o <<= 1) { const float Ap = __shfl_up(A, o), Hp = __shfl_up(H, o); if (lane >= o) { H = A * Hp + H; A = A * Ap; } }
        float h = __shfl_up(H, 1); if (lane == 0) h = 0.f;
#pragma unroll
        for (int i = 0; i < 9; ++i) { const int q = lane * 9 + i; if (q < NT16 && !dry) dst[(size_t)q * 512] = h; h = v[i].x * h + v[i].y; }
        if (dry && h == 123.456f) dst[0] = 0.f;
    }
}
DEVI void phase_attn_scan1(const Params& p, int l, LAS unsigned char* lds, int parts = 7) {
    const int nA = 2 * 8 * 16 + (l == 0 ? 16 : 0), nH = 2 * 8 * NCH, nL = 2 * NT16, G = gridDim.x;
    const float accinit = attn_offset(p, l);
    int u = opq_bid();
    for (; u < 256; u += G) { const int bl = u >> 7, h = (u >> 4) & 7, qb = u & 15; if (!(parts & 1)) continue;
        attn_unit(p, lds, p.q + ((size_t)(bl * 8 + h) * SEQ + qb * 512) * 96, 512, p.kv + (size_t)(bl * 8 + h) * NCH * KVT_BYTES, NCH,
                  p.ocat + (size_t)(bl * RB + qb * 512) * OCW + 512 + h * 64, accinit); }
    for (; u < nA; u += G) { const int uu = u - 256, bl = uu >> 3, h = uu & 7; if (!(parts & 1)) continue;
        attn_unit(p, lds, p.qc + ((size_t)(bl * 8 + h) * CTX) * 96, 256, p.kv + ((size_t)(bl * 8 + h) * NCH + 128) * KVT_BYTES, 4,
                  p.ocat + (size_t)(bl * RB + SEQ) * OCW + 512 + h * 64, accinit); }
    if (parts & 2) { HgIn cur, nxt; if (u < nA + nH) hg_load<false>(p, u - nA, cur);
        for (; u < nA + nH; u += G) { const bool more = u + G < nA + nH; if (more) hg_load<false>(p, u + G - nA, nxt); hg_pass1_unit(p, l, lds, u - nA, cur); if (more) cur = nxt; } }
    else { for (; u < nA + nH; u += G) {} }
    if (parts & 4) { lru_sweep<0>(p, l, lds, 0, u, nA + nH + nL, nA + nH, false); lru_sweep<0>(p, l, lds, 1, u, nA + nH + nL, nA + nH, false); }
}
DEVI void phase_prefix(const Params& p, LAS unsigned char* lds, bool dry = false) { (void)lds; hg_prefix(p, dry); lru_prefix(p, dry); }
DEVI void phase_scan3(const Params& p, int l, LAS unsigned char* lds, int parts = 3) {
    const int nH = 2 * 8 * NCH, nL = 2 * NT16, G = gridDim.x; const bool skipc = (l == DEPTH - 1);
    int u = opq_bid();
    if (parts & 1) { HgIn cur, nxt; if (u < nH) hg_load<true>(p, u, cur);
        for (; u < nH; u += G) { const bool more = u + G < nH; if (more) hg_load<true>(p, u + G, nxt);
            if (!(skipc && (u % NCH) >= 128)) hg_pass3_unit(p, l, lds, u, cur);
            if (more) cur = nxt; } }
    else { for (; u < nH; u += G) {} }
    if (parts & 2) { lru_sweep<1>(p, l, lds, 0, u, nH + nL, nH, skipc); lru_sweep<2>(p, l, lds, 1, u, nH + nL, nH, skipc); }
}

constexpr int RP = 2 * TT + 4096;

DEVI void phase_norm2_route(const Params& p, int l, LAS unsigned char* lds) {
    const int tid = opq_tid(), lane = tid & 63, wv = tid >> 6; const bool skipc = (l == DEPTH - 1);
    LAS int* cntl = (LAS int*)lds;
    LAS int* basel = cntl + 16;
    LAS int* rinfo = cntl + 64;
    LAS float* rw = (LAS float*)(rinfo + 4 * 8 * 20);
    if (tid < 16) cntl[tid] = 0;
    LAS float* Wt = (LAS float*)(lds + 8192);
    { const float* wrg = p.in[I_WRG] + (size_t)l * DM * 4; const float* wre = p.in[I_WRE] + (size_t)l * DM * 16;
      for (int i = tid; i < DM * 4; i += 512) Wt[(i & 3) * DM + (i >> 2)] = wrg[i];
      for (int i = tid; i < DM * 16; i += 512) Wt[(4 + (i & 15)) * DM + (i >> 4)] = wre[i]; }
    __syncthreads();
    const float* gm = p.in[I_NFFN] + l * DM;
    int it = 0;
    const int rstep = gridDim.x * 8;
    f32x4 vn[4];
    { const int r0 = opq_bid() * 8 + wv; if (r0 < TT) { const float* s0 = xbuf_row(p, r0);
#pragma unroll
        for (int i = 0; i < 4; ++i) vn[i] = *(const f32x4*)(s0 + i * 256 + lane * 4); } }
    for (int r = opq_bid() * 8 + wv; r < TT; r += rstep, ++it) {
        const int pos = r % RB; const bool skip = skipc && pos >= SEQ;
        f32x4 v[4]; float ss = 0.f;
#pragma unroll
        for (int i = 0; i < 4; ++i) v[i] = vn[i];
        if (r + rstep < TT) { const float* s1 = xbuf_row(p, r + rstep);
#pragma unroll
            for (int i = 0; i < 4; ++i) vn[i] = *(const f32x4*)(s1 + i * 256 + lane * 4); }
        if (skip) { if (lane == 0) rinfo[(it * 8 + wv) * 4] = -1; continue; }
#pragma unroll
        for (int i = 0; i < 4; ++i) ss += v[i][0] * v[i][0] + v[i][1] * v[i][1] + v[i][2] * v[i][2] + v[i][3] * v[i][3];
        ss = wave_sum(ss);
        const float rstd = rsqrtf(ss * (1.0f / DM) + EPSF);
        const float* mv = p.modv + ((size_t)l * 5 + mod_row(r)) * 6144;
        f32x4 hh[4];
#pragma unroll
        for (int i = 0; i < 4; ++i) { const int c = i * 256 + lane * 4;
            const f32x4 g = *(const f32x4*)(gm + c), sh = *(const f32x4*)(mv + 3072 + c), sc = *(const f32x4*)(mv + 4096 + c);
#pragma unroll
            for (int e = 0; e < 4; ++e) hh[i][e] = v[i][e] * rstd * g[e] * (1.0f + sc[e]) + sh[e];
            u32x2 w; w.x = cvt_pk_bf16(hh[i][0], hh[i][1]); w.y = cvt_pk_bf16(hh[i][2], hh[i][3]);
            *(u32x2*)(p.h2 + (size_t)r * DM + c) = w; }
        float red[32];
#pragma unroll
        for (int j = 0; j < 32; ++j) { float a = 0.f;
            if (j < 20) {
#pragma unroll
                for (int i = 0; i < 4; ++i) { const f32x4 w4 = *(const LAS f32x4*)(Wt + j * DM + i * 256 + lane * 4);
                    a += hh[i][0] * w4[0] + hh[i][1] * w4[1] + hh[i][2] * w4[2] + hh[i][3] * w4[3]; } }
            red[j] = a; }
#pragma unroll
        for (int lvl = 0; lvl < 5; ++lvl) { const int half = 16 >> lvl, bit = 32 >> lvl; const bool hi = (lane & bit) != 0;
#pragma unroll
            for (int i = 0; i < half; ++i) { const float snd = hi ? red[i] : red[i + half]; const float keep = hi ? red[i + half] : red[i];
                red[i] = keep + __shfl_xor(snd, bit); } }
        red[0] += __shfl_xor(red[0], 1);
        float lgt[20];
#pragma unroll
        for (int j = 0; j < 20; ++j) lgt[j] = __builtin_bit_cast(float, __builtin_amdgcn_readlane(__builtin_bit_cast(int, red[0]), 2 * j));
        const f32x4 lg = {lgt[0], lgt[1], lgt[2], lgt[3]}, le0 = {lgt[4], lgt[5], lgt[6], lgt[7]}, le1 = {lgt[8], lgt[9], lgt[10], lgt[11]},
                    le2 = {lgt[12], lgt[13], lgt[14], lgt[15]}, le3 = {lgt[16], lgt[17], lgt[18], lgt[19]};
        if (lane == 0) {
            const float* brg = p.in[I_BRG] + l * 4; const float* bre = p.in[I_BRE] + l * 16;
            int gs = 0; float best = lg[0] + brg[0];
#pragma unroll
            for (int e = 1; e < 4; ++e) { const float t = lg[e] + brg[e]; if (t > best) { best = t; gs = e; } }
            const float m = fmaxf(fmaxf(lg[0], lg[1]), fmaxf(lg[2], lg[3]));
            const float e0 = __expf(lg[0] - m), e1 = __expf(lg[1] - m), e2 = __expf(lg[2] - m), e3 = __expf(lg[3] - m);
            const float pg = (gs == 0 ? e0 : gs == 1 ? e1 : gs == 2 ? e2 : e3) / (e0 + e1 + e2 + e3);
            const f32x4 lv = (gs == 0) ? le0 : (gs == 1) ? le1 : (gs == 2) ? le2 : le3;
            const f32x4 bv = lv + *(const f32x4*)(bre + gs * 4);
            int i0 = 0; float m0 = bv[0], l0 = lv[0];
#pragma unroll
            for (int e = 1; e < 4; ++e) if (bv[e] > m0) { m0 = bv[e]; i0 = e; l0 = lv[e]; }
            int i1 = -1; float m1 = -3.0e38f, l1 = 0.f;
#pragma unroll
            for (int e = 0; e < 4; ++e) if (e != i0 && bv[e] > m1) { m1 = bv[e]; i1 = e; l1 = lv[e]; }
            const float mm = fmaxf(l0, l1), x0 = __expf(l0 - mm), x1 = __expf(l1 - mm);
            const float w0 = x0 / (x0 + x1) * pg, w1 = x1 / (x0 + x1) * pg;
            const int ea = gs * 4 + i0, eb = gs * 4 + i1;
            const int sa = __hip_atomic_fetch_add(&cntl[ea], 1, __ATOMIC_RELAXED, __HIP_MEMORY_SCOPE_WORKGROUP), sb = __hip_atomic_fetch_add(&cntl[eb], 1, __ATOMIC_RELAXED, __HIP_MEMORY_SCOPE_WORKGROUP);
            const int q = (it * 8 + wv) * 4; rinfo[q] = ea; rinfo[q + 1] = eb; rinfo[q + 2] = sa; rinfo[q + 3] = sb;
            rw[(it * 8 + wv) * 2] = w0; rw[(it * 8 + wv) * 2 + 1] = w1;
        }
    }
    __syncthreads();
    if (tid < 16) basel[tid] = (int)atomicAdd(&p.ctrl[CTRL_CNT(l, tid)], (unsigned)cntl[tid]);
    __syncthreads();
    it = 0;
    for (int r = opq_bid() * 8 + wv; r < TT; r += gridDim.x * 8, ++it) {
        if (lane == 0) { const int q = (it * 8 + wv) * 4; const int ea = rinfo[q];
            if (ea >= 0) { const int eb = rinfo[q + 1], sa = basel[ea] + rinfo[q + 2], sb = basel[eb] + rinfo[q + 3];
                p.tok_e[r * 2] = ea; p.tok_e[r * 2 + 1] = eb; p.tok_s[r * 2] = sa; p.tok_s[r * 2 + 1] = sb;
                p.lst[(size_t)ea * TT + sa] = r; p.lst[(size_t)eb * TT + sb] = r; p.tok_w[(size_t)ea * TT + sa] = rw[(it * 8 + wv) * 2]; p.tok_w[(size_t)eb * TT + sb] = rw[(it * 8 + wv) * 2 + 1]; } }
    }
    __syncthreads();
}

DEVI void moe_offsets(const Params& p, int l, LAS int* offs) {
    if (opq_tid() == 0) { int o = 0;
        for (int e = 0; e < NEXP; ++e) { offs[e] = o; const int c = (int)__hip_atomic_load(&p.ctrl[CTRL_CNT(l, e)], __ATOMIC_RELAXED, __HIP_MEMORY_SCOPE_AGENT); offs[32 + e] = c; o += (c + 255) & ~255; }
        offs[NEXP] = o; }
    __syncthreads();
}
DEVI int moe_expert_of(const LAS int* offs, int row) { int e = 0;
#pragma unroll
    for (int q = 1; q < NEXP; ++q) e += (row >= offs[q]) ? 1 : 0;
    return e; }

DEVI void phase_moe_permute(const Params& p, int l, const LAS int* offs) {
    const int lane = opq_tid() & 63, wv = opq_tid() >> 6; const int R = offs[NEXP];
    for (int pr = opq_bid() * 8 + wv; pr < R; pr += gridDim.x * 8) {
        const int e = moe_expert_of(offs, pr), s = pr - offs[e]; const bool valid = s < offs[32 + e];
        u32x4 a = {0u, 0u, 0u, 0u}, b = {0u, 0u, 0u, 0u}; int r = 0; float w = 0.f;
        const int vz = vzero();
        if (valid) { r = p.lst[(size_t)e * TT + s + vz]; w = p.tok_w[(size_t)e * TT + s + vz];
            const u32x4* src = (const u32x4*)(p.h2 + (size_t)r * DM); a = src[lane]; b = src[64 + lane]; }
        u32x4* dst = (u32x4*)(p.h2p + (size_t)pr * DM); dst[lane] = a; dst[64 + lane] = b;
        if (lane == 0) { p.rww[pr] = w; p.rmr[pr] = valid ? mod_row(r) : 0; }
    }
}

template <bool GATH> struct MoeSched { static constexpr bool GATHER = GATH; const int* lst; int cnt[NEXP]; int G, c, nN; int o[NEXP + 1]; const char* A; const char* B; size_t atile, bexp, btile;
    DEVI void load(const LAS int* offs) {
#pragma unroll
        for (int q = 0; q <= NEXP; ++q) o[q] = __builtin_amdgcn_readfirstlane(offs[q]);
#pragma unroll
        for (int q = 0; q < NEXP; ++q) cnt[q] = __builtin_amdgcn_readfirstlane(offs[32 + q]); }
    DEVI int row_of(const g8::Unit& u, int r) const { int base = 0, n = 0;
#pragma unroll
        for (int q = 0; q < NEXP; ++q) { base = (u.tag == q) ? o[q] : base; n = (u.tag == q) ? cnt[q] : n; }
        const int s2 = u.pm * 256 + r - base; return (s2 < n) ? lst[(size_t)u.tag * TT + s2] : 0; }
    DEVI bool next(int i, g8::Unit& u) const { const long L = (long)i * G + c; const int R = o[NEXP]; if (L >= (long)(R / 256) * nN) return false;
        const int ti = (int)(L / nN), pn = (int)(L % nN); int e = 0;
#pragma unroll
        for (int q = 1; q < NEXP; ++q) e += (ti * 256 >= o[q]) ? 1 : 0;
        u.pm = ti; u.pn = pn; u.tag = e; u.a = A + (size_t)ti * atile; u.b = B + (size_t)e * bexp + (size_t)pn * btile; return true; } };
struct EpiSwiglu {
    static constexpr bool PERM = false, HAS_MID = false; static constexpr int NSEG = 1;
    bf16_t* hid;
    DEVI void operator()(const f32x4 (&acc)[2][2][4][2], const g8::Unit& u, int wr, int wc, int fr, int fq) const {
        const int row0 = u.pm * 256 + wr * 64 + fr, col0 = u.pn * 128 + wc * 32 + 4 * fq;
#pragma unroll
        for (int ai = 0; ai < 2; ++ai)
#pragma unroll
            for (int m = 0; m < 4; ++m)
#pragma unroll
                for (int n = 0; n < 2; ++n) { const f32x4 a = acc[ai][0][m][n], b = acc[ai][1][m][n]; float h[4];
#pragma unroll
                    for (int e = 0; e < 4; ++e) h[e] = a[e] * sigmoidf_(a[e]) * b[e];
                    u32x2 w; w.x = cvt_pk_bf16(h[0], h[1]); w.y = cvt_pk_bf16(h[2], h[3]);
                    *(u32x2*)(hid + (size_t)(row0 + ai * 128 + m * 16) * DEXP + col0 + n * 16) = w; }
    }
};
DEVI void phase_moe_up(const Params& p, int l, const LAS int* offs, LAS unsigned char* lds) {
    MoeSched<true> S; S.lst = p.lst; S.G = gridDim.x; S.c = opq_bid(); S.nN = 2; S.load(offs); S.A = (const char*)p.h2; S.B = (const char*)(p.w13 + (size_t)l * NEXP * 512 * DM);
    S.atile = 0; S.bexp = (size_t)512 * DM * 2; S.btile = (size_t)256 * DM * 2;
    EpiSwiglu E; E.hid = p.hid;
    g8::gemm_phase(lds, DM, DM, DM, S, E);
}
struct EpiDown {
    static constexpr bool PERM = true, HAS_MID = false; static constexpr int NSEG = 1;
    bf16_t* yo; const float* tokw; const LAS int* offs;
    DEVI void operator()(const f32x4 (&acc)[2][2][4][2], const g8::Unit& u, int wr, int wc, int fr, int fq) const {
        const int row0 = u.pm * 256 + wr * 64 + fr, col0 = u.pn * 256 + wc * 32 + 8 * fq;
        const int e = u.tag, base = offs[e], n = offs[32 + e];
        float wrow[2][4];
#pragma unroll
        for (int ai = 0; ai < 2; ++ai)
#pragma unroll
            for (int m = 0; m < 4; ++m) { const int s2 = row0 + ai * 128 + m * 16 - base; wrow[ai][m] = (s2 < n) ? tokw[(size_t)e * TT + s2] : 0.f; }
#pragma unroll
        for (int ai = 0; ai < 2; ++ai)
#pragma unroll
            for (int m = 0; m < 4; ++m) { const int row = row0 + ai * 128 + m * 16; const float w = wrow[ai][m];
#pragma unroll
                for (int bj = 0; bj < 2; ++bj) { const f32x4 v0 = acc[ai][bj][m][0] * w, v1 = acc[ai][bj][m][1] * w;
                    u32x4 o; o.x = cvt_pk_bf16(v0[0], v0[1]); o.y = cvt_pk_bf16(v0[2], v0[3]); o.z = cvt_pk_bf16(v1[0], v1[1]); o.w = cvt_pk_bf16(v1[2], v1[3]);
                    *(u32x4*)(yo + (size_t)row * DM + col0 + bj * 128) = o; } }
    }
};
DEVI void phase_moe_down(const Params& p, int l, const LAS int* offs, LAS unsigned char* lds) {
    MoeSched<false> S; S.lst = p.lst; S.G = gridDim.x; S.c = opq_bid(); S.nN = 4; S.load(offs); S.A = (const char*)p.hid; S.B = (const char*)(p.w2 + (size_t)l * NEXP * DM * DEXP);
    S.atile = (size_t)256 * DEXP * 2; S.bexp = (size_t)DM * DEXP * 2; S.btile = (size_t)256 * DEXP * 2;
    EpiDown E; E.yo = p.yo; E.tokw = p.tok_w; E.offs = offs;
    g8::gemm_phase(lds, DEXP, DEXP, DEXP, S, E);
}
DEVI void phase_moe_combine(const Params& p, int l, const LAS int* offs, bool dry = false) {
    const int lane = opq_tid() & 63, wv = opq_tid() >> 6; const bool skipc = (l == DEPTH - 1);
    for (int r = opq_bid() * 8 + wv; r < TT; r += gridDim.x * 8) {
        const int pos = r % RB; if (skipc && pos >= SEQ) continue;
        float* x = xbuf_row(p, r);
        const int vz = vzero();
        const int pr0 = offs[p.tok_e[r * 2 + vz]] + p.tok_s[r * 2 + vz], pr1 = offs[p.tok_e[r * 2 + 1 + vz]] + p.tok_s[r * 2 + 1 + vz];
        const bf16_t* y0 = p.yo + (size_t)pr0 * DM; const bf16_t* y1 = p.yo + (size_t)pr1 * DM;
        const float* g2 = p.modv + ((size_t)l * 5 + mod_row(r)) * 6144 + 5120;
#pragma unroll
        for (int i = 0; i < 4; ++i) { const int c = i * 256 + lane * 4; f32x4 v = *(const f32x4*)(x + c);
            const u32x2 a = *(const u32x2*)(y0 + c), b = *(const u32x2*)(y1 + c);
            const f32x4 gv = *(const f32x4*)(g2 + c);
            v[0] += gv[0] * (__uint_as_float(a.x << 16) + __uint_as_float(b.x << 16)); v[1] += gv[1] * (__uint_as_float(a.x & 0xffff0000u) + __uint_as_float(b.x & 0xffff0000u));
            v[2] += gv[2] * (__uint_as_float(a.y << 16) + __uint_as_float(b.y << 16)); v[3] += gv[3] * (__uint_as_float(a.y & 0xffff0000u) + __uint_as_float(b.y & 0xffff0000u));
            if (!dry || v[0] == 123.456f) *(f32x4*)(x + c) = v; }
    }
}

#ifndef MK_PHASE_KERNELS
#define MK_PHASE_KERNELS 0
#endif
constexpr int LDS_SCRATCH = 1024;

template <class T> DEVI T* uni_ptr(T* x) { const unsigned long long v = (unsigned long long)x;
    const unsigned lo = __builtin_amdgcn_readfirstlane((unsigned)v), hi = __builtin_amdgcn_readfirstlane((unsigned)(v >> 32));
    return (T*)(((unsigned long long)hi << 32) | lo); }
DEVI Params ldparams(const PL& s) {
    Params q;
#pragma unroll
    for (int i = 0; i < 35; ++i) q.in[i] = uni_ptr(s.in[i]);
#define LDP(f) q.f = uni_ptr(s.f)
    LDP(out); LDP(ctrl); LDP(modv); LDP(lbv); LDP(xc); LDP(rope); LDP(lrula); LDP(winA); LDP(winG); LDP(wup); LDP(wcat); LDP(wout); LDP(w13); LDP(w2); LDP(wlru);
    LDP(hx); LDP(pa); LDP(up); LDP(q); LDP(qc); LDP(kv); LDP(st); LDP(stb); LDP(lsum); LDP(lin); LDP(ocat); LDP(y); LDP(h2); LDP(h2p); LDP(hid); LDP(yo);
    LDP(tok_e); LDP(tok_s); LDP(tok_w); LDP(lst); LDP(rww); LDP(rmr);
#undef LDP
    q.pad_ = 0ull;
    return q;
}
#ifndef WAITPROBE
#define WAITPROBE (-1)
#endif
#ifndef WAITSEL
#define WAITSEL (-1)
#endif
#ifndef BODYSEL
#define BODYSEL (-1)
#endif
DEVI void grid_sync(const PL& s, LAS unsigned char* smem, int phid = -2) {
    XcdBarrier b; b.bar = uni_ptr(s.ctrl); b.x = xb_xcc_id(); b.st = (volatile LAS unsigned*)smem;
#if WAITPROBE >= 0
    unsigned long long t0 = 0; if (threadIdx.x == 0) t0 = __builtin_amdgcn_s_memrealtime();
    xcd_barrier(b);
    if (threadIdx.x == 0 && BODYSEL < 0 && (WAITSEL < 0 || phid == WAITSEL)) { LAS unsigned long long* acc = (LAS unsigned long long*)(smem + 32); *acc += __builtin_amdgcn_s_memrealtime() - t0; }
#else
    xcd_barrier(b);
#endif
}
DEVI void probe_dump(const Params& p, const bf16_t* src, size_t n) {
    const size_t NOUT = (size_t)NB * SEQ * DM;
    for (size_t i = (size_t)opq_bid() * 512 + opq_tid(); i < NOUT; i += (size_t)gridDim.x * 512) { float s = 0.f;
        for (size_t k = i; k < n; k += NOUT) s += (float)src[k];
        p.out[i] = s; }
}
#define PROBE_AT(id, buf, n) if (PROBE_STOP == (id) && l == 0 && hb == 0) { { const Params p = ldparams(pl); probe_dump(p, (const bf16_t*)(buf), (n)); } return; }
#ifndef PROBE_STOP
#define PROBE_STOP 0
#endif
#ifndef DUP_MASK
#define DUP_MASK 0
#endif
#define PHASE_D(bit, call, dupcall) PHASE(call); if ((DUP_MASK >> (bit)) & 1) { PHASE(dupcall); }
#define PHASE_I(id, call) do { unsigned long long tb_ = 0; if (BODYSEL == (id) && threadIdx.x == 0) tb_ = __builtin_amdgcn_s_memrealtime(); \
        { const Params p = ldparams(pl); call; } \
        if (BODYSEL == (id)) { __syncthreads(); if (threadIdx.x == 0) { LAS unsigned long long* acc = (LAS unsigned long long*)(smem + 32); *acc += __builtin_amdgcn_s_memrealtime() - tb_; } } } while (0); \
    grid_sync(pl, smem, id); if ((DUP_MASK >> 21) & 1) grid_sync(pl, smem)
#define PHASE(call) PHASE_I(-2, call)

#ifndef SELFCHECK
#define SELFCHECK 0
#endif
DEVI void chk_sum(const Params& p, int id, int rep, const void* buf, size_t nbytes) {
    const unsigned* w = (const unsigned*)buf; const size_t n = nbytes / 4; unsigned long long s = 0ull;
    for (size_t i = (size_t)opq_bid() * 512 + opq_tid(); i < n; i += (size_t)gridDim.x * 512) s += (unsigned long long)w[i] * (unsigned long long)((i & 1023) + 1);
    unsigned lo = (unsigned)s, hi = (unsigned)(s >> 32);
    for (int o = 32; o >= 1; o >>= 1) { const unsigned l2 = __shfl_xor(lo, o), h2 = __shfl_xor(hi, o); const unsigned long long t = (((unsigned long long)hi << 32) | lo) + (((unsigned long long)h2 << 32) | l2); lo = (unsigned)t; hi = (unsigned)(t >> 32); }
    if ((opq_tid() & 63) == 0) atomicAdd((unsigned long long*)(p.ctrl + 6144) + (rep * 32 + id), (((unsigned long long)hi << 32) | lo));
}
#define CHK(id, buf, nbytes) do { const Params p = ldparams(pl); chk_sum(p, id, rep, buf, nbytes); } while (0); grid_sync(pl, smem)

__global__ void __launch_bounds__(512, 2) hybrid_flow_backbone_kernel(Params pk) {
    extern __shared__ __attribute__((aligned(16))) unsigned char smem_raw[];
    LAS unsigned char* smem = (LAS unsigned char*)smem_raw;
    LAS unsigned char* lds = smem + LDS_SCRATCH; LAS int* offs = (LAS int*)(smem + 64);
    static_assert(sizeof(Params) % 8 == 0 && sizeof(Params) <= LDS_SCRATCH - 256, "Params must fit its LDS slot");
    { (void)pk;
      const __attribute__((address_space(4))) unsigned long long* src = (const __attribute__((address_space(4))) unsigned long long*)__builtin_amdgcn_kernarg_segment_ptr();
      LAS unsigned long long* dst = (LAS unsigned long long*)(smem + 256);
      if (threadIdx.x < sizeof(Params) / 8) dst[threadIdx.x] = src[threadIdx.x]; }
    if (threadIdx.x == 0) { *(LAS u32x4*)smem = (u32x4){0u, 0u, 0u, 0u}; *(LAS unsigned long long*)(smem + 32) = 0ull; }
    __syncthreads();
    const PL& pl = *(const PL*)(smem + 256);
    (void)xcd_barrier_post(uni_ptr(pl.ctrl), (volatile LAS unsigned*)smem);
    { unsigned long long tb_ = 0; if (BODYSEL == 0 && threadIdx.x == 0) tb_ = __builtin_amdgcn_s_memrealtime(); phase_prep(pl, lds);
      if (BODYSEL == 0) { __syncthreads(); if (threadIdx.x == 0) *(LAS unsigned long long*)(smem + 32) += __builtin_amdgcn_s_memrealtime() - tb_; } }
    grid_sync(pl, smem, 0);
    if ((DUP_MASK >> 16) & 1) { phase_prep(pl, lds); grid_sync(pl, smem); }
#if SELFCHECK
    for (int rep = 0; rep < SELFCHECK; ++rep) {
        const int l = 0, hb = 0;
        PHASE(phase_norm1(p, l, hb));          CHK(1, p.hx, (size_t)HR * DM * 2);
        PHASE(phase_inproj_a(p, l, lds));      CHK(2, p.pa, (size_t)HR * PA_W * 2);
        PHASE(phase_mla_up(p, l, lds));        CHK(3, p.up, (size_t)HR * UPW * 2);
        PHASE(phase_qkv(p, l, lds));           CHK(4, p.q, (size_t)2 * 8 * SEQ * 96 * 2); CHK(5, p.qc, (size_t)2 * 8 * CTX * 96 * 2);
        PHASE(phase_attn_scan1(p, l, lds));    CHK(6, p.st, (size_t)2 * 2 * 8 * NCH * 4096 * 2); CHK(7, p.stb, (size_t)2 * 2 * 8 * NCH * 64 * 4); CHK(8, p.lsum, (size_t)2 * 2 * NT16 * 512 * 2 * 4);
        PHASE(phase_prefix(p, lds));                CHK(9, p.st, (size_t)2 * 2 * 8 * NCH * 4096 * 2); CHK(10, p.lin, (size_t)2 * 2 * NT16 * 512 * 4);
        PHASE(phase_scan3(p, l, lds));         CHK(11, p.ocat, (size_t)HR * OCW * 2);
        PHASE(phase_inproj_g(p, l, lds));      CHK(12, p.pa, (size_t)HR * PG_W * 2);
        PHASE(phase_merge(p, l, lds));         CHK(13, p.y, (size_t)HR * DM * 2);
        PHASE(phase_outproj(p, l, hb, lds));   CHK(14, p.out, (size_t)2 * SEQ * DM * 4); CHK(15, p.xc, (size_t)2 * CTX * DM * 4);
    }
    {   const Params p = ldparams(pl);
        const size_t NOUT = (size_t)NB * SEQ * DM;
        for (size_t i = (size_t)opq_bid() * 512 + opq_tid(); i < NOUT; i += (size_t)gridDim.x * 512) p.out[i] = 0.f;
        __syncthreads();
        if (opq_bid() == 0 && opq_tid() == 0) { int first = 0; const unsigned long long* c = (const unsigned long long*)(p.ctrl + 6144);
            for (int id = 15; id >= 1; --id) for (int rep = 1; rep < SELFCHECK; ++rep)
                if (__hip_atomic_load(c + rep * 32 + id, __ATOMIC_RELAXED, __HIP_MEMORY_SCOPE_AGENT) != __hip_atomic_load(c + id, __ATOMIC_RELAXED, __HIP_MEMORY_SCOPE_AGENT)) first = id;
            p.out[0] = 1000.0f * (float)first; }
    }
    return;
#endif
    for (int l = 0; l < DEPTH; ++l) {
        for (int hb = 0; hb < 2; ++hb) {
            if (l == 0 && hb == 0) { PHASE_D(0, phase_norm1(p, l, hb), phase_norm1(p, l, hb)); }
            PHASE_I(2, phase_inproj_a(p, l, lds));
            PHASE_I(3, phase_mla_up(p, l, lds));
            PHASE_I(4, phase_qkv(p, l, lds));
            PHASE_I(5, phase_attn_scan1(p, l, lds));
            if ((DUP_MASK >> 4) & 1) { PHASE(phase_attn_scan1(p, l, lds, 1)); }
            if ((DUP_MASK >> 5) & 1) { PHASE(phase_attn_scan1(p, l, lds, 2)); }
            if ((DUP_MASK >> 6) & 1) { PHASE(phase_attn_scan1(p, l, lds, 4)); }
            PHASE_I(6, phase_prefix(p, lds));
            if ((DUP_MASK >> 17) & 1) { PHASE(phase_prefix(p, lds, true)); }
            PHASE_I(7, phase_scan3(p, l, lds));
            if ((DUP_MASK >> 7) & 1) { PHASE(phase_scan3(p, l, lds, 1)); }
            if ((DUP_MASK >> 8) & 1) { PHASE(phase_scan3(p, l, lds, 2)); }
            PHASE_I(8, phase_inproj_g(p, l, lds));
            PHASE_I(9, phase_merge(p, l, lds));
            PHASE_I(10, phase_outproj(p, l, hb, lds); if (hb == 0) phase_norm1(p, l, 1));
            if (((DUP_MASK >> 11) & 1) && l == 0) { PHASE(phase_outproj(p, l, hb, lds)); }
            if ((DUP_MASK >> 15) & 1) { for (int z = 0; z < 10; ++z) grid_sync(pl, smem); }
        }
        PHASE_I(11, phase_norm2_route(p, l, lds));
        PHASE_I(12, moe_offsets(p, l, offs); phase_moe_up(p, l, offs, lds));
        PHASE_I(13, phase_moe_down(p, l, offs, lds));
        PHASE_I(14, phase_moe_combine(p, l, offs); if (l + 1 < DEPTH) phase_norm1(p, l + 1, 0));
        if ((DUP_MASK >> 19) & 1) { PHASE(phase_moe_combine(p, l, offs, true)); }
    }
#if WAITPROBE >= 0
    if (blockIdx.x == WAITPROBE && threadIdx.x == 0) {
        const unsigned long long w = *(LAS unsigned long long*)(smem + 32), t0 = __builtin_amdgcn_s_memrealtime();
        while (__builtin_amdgcn_s_memrealtime() - t0 < w) __builtin_amdgcn_s_sleep(8); }
#endif
}

static size_t align_up(size_t x, size_t a) { return (x + a - 1) / a * a; }

extern "C" void kernel_launch(void* const* d_in, const int* in_sizes, int n_in, void* d_out, int out_size, void* d_ws, size_t ws_size, hipStream_t stream) {
    (void)in_sizes; (void)n_in; (void)out_size;
    Params p; memset(&p, 0, sizeof(p));
    for (int i = 0; i < 35; ++i) p.in[i] = (const float*)d_in[i];
    p.out = (float*)d_out;
    char* w = (char*)d_ws; size_t o = 0;
    auto take = [&](size_t bytes) { char* r = w + o; o = align_up(o + bytes, 256); return r; };
    p.ctrl = (unsigned*)take(CTRL_WORDS * 4);
    p.modv = (float*)take((size_t)DEPTH * 5 * 6144 * 4);
    p.lbv = (float*)take((size_t)DEPTH * 2 * 512 * 4);
    p.xc = (float*)take((size_t)NB * CTX * DM * 4);
    p.rope = (float*)take((size_t)SEQ * 32 * 4);
    p.lrula = (float*)take((size_t)DEPTH * 2 * 512 * 4);
    p.winA = (bf16_t*)take((size_t)DEPTH * PA_W * DM * 2);
    p.winG = (bf16_t*)take((size_t)DEPTH * PG_W * DM * 2);
    p.wup = (bf16_t*)take((size_t)DEPTH * UPW * 256 * 2);
    p.wcat = (bf16_t*)take((size_t)DEPTH * DM * OCW * 2);
    p.wout = (bf16_t*)take((size_t)DEPTH * DM * DM * 2);
    p.w13 = (bf16_t*)take((size_t)DEPTH * NEXP * 512 * DM * 2);
    p.w2 = (bf16_t*)take((size_t)DEPTH * NEXP * DM * DEXP * 2);
    p.wlru = (bf16_t*)take((size_t)DEPTH * 2 * 8 * 2 * 64 * 64 * 2);
    p.tok_e = (int*)take((size_t)TT * 2 * 4); p.tok_s = (int*)take((size_t)TT * 2 * 4);
    p.lst = (int*)take((size_t)NEXP * TT * 4); p.tok_w = (float*)take((size_t)NEXP * TT * 4);
    p.rww = (float*)take((size_t)RP * 4); p.rmr = (int*)take((size_t)RP * 4);
    const size_t region = o;
    p.hx = (bf16_t*)take((size_t)HR * DM * 2);
    p.pa = (bf16_t*)take((size_t)HR * PA_W * 2);
    p.ocat = (bf16_t*)take((size_t)HR * OCW * 2);
    p.lsum = (float*)take((size_t)2 * 2 * NT16 * 512 * 2 * 4); p.lin = (float*)take((size_t)2 * 2 * NT16 * 512 * 4);
    const size_t alias1 = o;
    p.up = (bf16_t*)take((size_t)HR * UPW * 2);
    const size_t after_up = o; o = alias1;
    p.st = (bf16_t*)take((size_t)2 * 2 * 8 * NCH * 4096 * 2); p.stb = (float*)take((size_t)2 * 2 * 8 * NCH * 64 * 4);
    if (o < after_up) o = after_up;
    const size_t alias2 = o;
    p.q = (bf16_t*)take((size_t)2 * 8 * SEQ * 96 * 2); p.qc = (bf16_t*)take((size_t)2 * 8 * CTX * 96 * 2); p.kv = (unsigned char*)take((size_t)2 * 8 * NCH * KVT_BYTES);
    const size_t mixer_end = o; o = alias2;
    p.y = (bf16_t*)take((size_t)HR * DM * 2);
    size_t end1 = mixer_end > o ? mixer_end : o;
    o = region;
    p.h2 = (bf16_t*)take((size_t)TT * DM * 2);
    p.h2p = (bf16_t*)take((size_t)RP * DM * 2);
    p.hid = (bf16_t*)take((size_t)RP * DEXP * 2);
    p.yo = (bf16_t*)take((size_t)RP * DM * 2);
    const size_t need = end1 > o ? end1 : o;
    static int grid = 0;
    if (!grid) {
        int dev = 0, cus = 0, per_cu = 0; hipGetDevice(&dev); hipDeviceGetAttribute(&cus, hipDeviceAttributeMultiprocessorCount, dev);
        hipFuncSetAttribute((const void*)hybrid_flow_backbone_kernel, hipFuncAttributeMaxDynamicSharedMemorySize, LDS_TOTAL);
        hipOccupancyMaxActiveBlocksPerMultiprocessor(&per_cu, (const void*)hybrid_flow_backbone_kernel, 512, LDS_TOTAL);
        if (per_cu < 1) fprintf(stderr, "kernel_launch: occupancy query returned %d\n", per_cu);
        grid = cus * (per_cu < 1 ? 0 : 1); if (grid > 256) grid = 256;
    }
    if (need > ws_size) { fprintf(stderr, "kernel_launch: workspace too small: need %zu have %zu\n", need, ws_size); return; }
    if (grid < 8) { fprintf(stderr, "kernel_launch: grid %d too small\n", grid); return; }
    hipMemsetAsync(p.ctrl, 0, CTRL_WORDS * 4, stream);
    hipLaunchKernelGGL(hybrid_flow_backbone_kernel, dim3(grid), dim3(512), LDS_TOTAL, stream, p);
}
```

```cpp
#include <hip/hip_runtime.h>
#include <stdint.h>
#include <stdio.h>
#include <string.h>

#define LAS __attribute__((address_space(3)))
#define DEVI __device__ __forceinline__
typedef unsigned short bf16_t;
typedef short bf16x8 __attribute__((ext_vector_type(8)));
typedef float f32x4 __attribute__((ext_vector_type(4)));
typedef float f32x16 __attribute__((ext_vector_type(16)));
typedef unsigned u32x4 __attribute__((ext_vector_type(4)));
typedef unsigned u32x2 __attribute__((ext_vector_type(2)));

constexpr int NB = 4, SEQ = 8192, CTX = 256, DM = 1024, DEPTH = 2;
constexpr int RB = SEQ + CTX;
constexpr int TT = NB * RB;
constexpr int HR = 2 * RB;
constexpr int NCH = RB / 64;
constexpr int INW = 7072;
constexpr int PA_W = 4096;
constexpr int PG_W = 3072;
constexpr int C_Q = 0, C_ZF = 512, C_ZB = 1024, C_I = 1536, C_G = 2048, C_DQ = 2560, C_DKV = 2816, C_KR = 2944, C_LX = 3072, C_LY = 3584;
constexpr int UPW = 1792;
constexpr int OCW = 1536;
constexpr int KVT_BYTES = 22016;
constexpr int KT_BYTES = 13312;
constexpr int NEXP = 16, DEXP = 256;
constexpr float EPSF = 1e-6f;
constexpr int LDS_TOTAL = 160 * 1024;

DEVI float bf2f(bf16_t b) { return __uint_as_float(((unsigned)b) << 16); }
DEVI bf16_t f2bf(float f) { return __builtin_bit_cast(bf16_t, (__bf16)f); }
typedef float f32x2_t __attribute__((ext_vector_type(2)));
typedef __bf16 bf16x2_t __attribute__((ext_vector_type(2)));
DEVI unsigned cvt_pk_bf16(float lo, float hi) { const f32x2_t v = {lo, hi}; return __builtin_bit_cast(unsigned, __builtin_convertvector(v, bf16x2_t)); }
DEVI float fast_exp2(float x) { return __builtin_amdgcn_exp2f(x); }
DEVI float fast_rcp(float x) { return __builtin_amdgcn_rcpf(x); }
DEVI float sigmoidf_(float x) { return fast_rcp(1.0f + fast_exp2(-1.44269504f * x)); }
DEVI float wave_sum(float v) { for (int o = 32; o >= 1; o >>= 1) v += __shfl_xor(v, o); return v; }
DEVI float wave_max(float v) { for (int o = 32; o >= 1; o >>= 1) v = fmaxf(v, __shfl_xor(v, o)); return v; }

DEVI int opq_tid() { int t = threadIdx.x; asm volatile("" : "+v"(t)); return t; }
DEVI int opq_bid() { int b = blockIdx.x; asm volatile("" : "+s"(b)); return b; }

DEVI int vzero() { int z = 0; asm volatile("" : "+v"(z)); return z; }

#define XB_TMO      128
#define XB_XCNT(j)  (256  + 64 * (j))
#define XB_XSUB(j)  (1280 + 64 * (j))
#define XB_XGEN(j)  (2304 + 64 * (j))
#define XB_TOP      3328
#define XB_TOPGEN   3392
#define XCD_BAR_WORDS 3456
#define XB_SPIN_CAP (1u << 18)

__device__ __forceinline__ unsigned xb_ld(unsigned* p)              { return __hip_atomic_load(p, __ATOMIC_RELAXED, __HIP_MEMORY_SCOPE_AGENT); }
__device__ __forceinline__ unsigned xb_add(unsigned* p, unsigned v) { return __hip_atomic_fetch_add(p, v, __ATOMIC_RELAXED, __HIP_MEMORY_SCOPE_AGENT); }
__device__ __forceinline__ unsigned xb_xcc_id() { return (unsigned)__builtin_amdgcn_s_getreg((3 << 11) | 20) & 0xFu; }
#define XB_SPIN(cond, bar) do { unsigned _sp = 0; while (cond) { __builtin_amdgcn_s_sleep(1); \
    if ((++_sp & 255u) == 0u) { if (xb_ld(&(bar)[XB_TMO])) break; if (_sp > XB_SPIN_CAP) { atomicAdd(&(bar)[XB_TMO], 1u); break; } } } } while (0)

struct XcdBarrier { unsigned* bar; unsigned x; volatile LAS unsigned* st; };

__device__ __forceinline__ XcdBarrier xcd_barrier_post(unsigned* bar, volatile LAS unsigned* st) {
    XcdBarrier b; b.bar = bar; b.x = xb_xcc_id(); b.st = st;
    if (threadIdx.x == 0) (void)xb_add(&bar[XB_XCNT(b.x)], 1u);
    return b;
}
__device__ __forceinline__ void xcd_barrier_complete(unsigned* bar, unsigned x, unsigned& nloc, unsigned& nx) {
    const unsigned G = gridDim.x * gridDim.y * gridDim.z;
    unsigned sum, cnt, mine, sp = 0u;
    for (;;) {
        sum = 0u; cnt = 0u; mine = 0u;
#pragma unroll
        for (unsigned j = 0; j < 16; ++j) { const unsigned c = xb_ld(&bar[XB_XCNT(j)]); sum += c; cnt += (c > 0u) ? 1u : 0u; mine = (j == x) ? c : mine; }
        if (sum == G) break;
        __builtin_amdgcn_s_sleep(1);
        if ((++sp & 255u) == 0u) { if (xb_ld(&bar[XB_TMO])) break; if (sp > XB_SPIN_CAP) { atomicAdd(&bar[XB_TMO], 1u); break; } }
    }
    nloc = mine > 0u ? mine : 1u; nx = cnt > 0u ? cnt : 1u;
}
__device__ __forceinline__ void xcd_barrier(const XcdBarrier& b) {
    asm volatile("s_waitcnt vmcnt(0)" ::: "memory");
    __syncthreads();
    if (threadIdx.x == 0) {
        unsigned* bar = b.bar;
        __builtin_amdgcn_s_waitcnt(0);
        unsigned nloc = b.st[0], nx = b.st[1];
        if (nloc == 0u) { xcd_barrier_complete(bar, b.x, nloc, nx); b.st[0] = nloc; b.st[1] = nx; }
        const unsigned old = xb_add(&bar[XB_XSUB(b.x)], 1u);
        const unsigned gen = old / nloc;
        if (old + 1u == (gen + 1u) * nloc) {
            __builtin_amdgcn_fence(__ATOMIC_RELEASE, "agent");
            asm volatile("s_waitcnt vmcnt(0)" ::: "memory");
            const unsigned og = xb_add(&bar[XB_TOP], 1u);
            const unsigned tg = og / nx;
            if (og + 1u == (tg + 1u) * nx) xb_add(&bar[XB_TOPGEN], 1u);
            else XB_SPIN(xb_ld(&bar[XB_TOPGEN]) == tg, bar);
            __builtin_amdgcn_fence(__ATOMIC_ACQUIRE, "agent");
            xb_add(&bar[XB_XGEN(b.x)], 1u);
            asm volatile("s_waitcnt vmcnt(0)" ::: "memory");
        } else {
            XB_SPIN(xb_ld(&bar[XB_XGEN(b.x)]) == gen, bar);
            __builtin_amdgcn_fence(__ATOMIC_ACQUIRE, "agent");
            asm volatile("s_waitcnt vmcnt(0)" ::: "memory");
        }
    }
    __syncthreads();
}

struct Params {
    const float* in[35];
    float* out;
    unsigned* ctrl;
    float* modv;
    float* lbv;
    float* xc;
    float* lrula;
    float* rope;
    bf16_t* winA; bf16_t* winG; bf16_t* wup; bf16_t* wcat; bf16_t* wout; bf16_t* w13; bf16_t* w2; bf16_t* wlru;
    bf16_t* hx;
    bf16_t* pa;
    bf16_t* up;
    bf16_t* q; bf16_t* qc; unsigned char* kv;
    bf16_t* st; float* stb;
    float* lsum; float* lin;
    bf16_t* ocat;
    bf16_t* y;
    bf16_t* h2; bf16_t* h2p; bf16_t* hid; bf16_t* yo;
    int* tok_e; int* tok_s; float* tok_w; int* lst; float* rww; int* rmr;
    unsigned long long pad_;
};

typedef LAS Params PL;

#define CTRL_CNT(l, e) (4096 + 512 * (l) + 16 * (e))
#define CTRL_WORDS 8192

namespace g8 {
constexpr int BM = 256, BK = 64, HALF = 128, HTB = HALF * BK * 2, STAGE_BYTES = 8 * HTB, NXCD = 8, WGM = 8;
__host__ __device__ __forceinline__ int lds_byte(int r, int c) { const int st = (r >> 4) * 2 + (c >> 5), rr = r & 15, cc = c & 31, ob = rr * 64 + cc * 2; return st * 1024 + (ob ^ (((ob >> 9) & 1) << 5)); }
__host__ __device__ __forceinline__ void stage_rc(int b, int& R, int& C) { const int st = b / 1024, sb = b % 1024, swz = sb ^ (((sb >> 9) & 1) << 5); R = (st >> 1) * 16 + swz / 64; C = (st & 1) * 32 + (swz % 64) / 2; }
__host__ __device__ __forceinline__ int perm32(int rho) { const int n = rho >> 4, i = rho & 15; return 8 * (i >> 2) + 4 * n + (i & 3); }

struct Unit { int pm, pn, tag; const char* a; const char* b; };

__device__ __forceinline__ bool static_order(int i, int G, int c, int nM, int nN, int& pm, int& pn) {
    const int nwg = nM * nN; const long L = (long)i * G + c; if (L >= nwg) return false;
    int wgid = (int)L; { const int q = nwg / NXCD, r = nwg % NXCD, xcd = wgid % NXCD, off = wgid / NXCD; wgid = (xcd < r ? xcd * (q + 1) : r * (q + 1) + (xcd - r) * q) + off; }
    const int nig = WGM * nN, gid = wgid / nig, fm = gid * WGM, gsz = (nM - fm) < WGM ? (nM - fm) : WGM;
    pm = fm + ((wgid % nig) % gsz); pn = (wgid % nig) / gsz; return true;
}

template <class Epi, class Sched>
__device__ __forceinline__ void gemm_phase(LAS unsigned char* lds, const int lda, const int ldb, const int K, const Sched& S, const Epi& E) {
    const int tid = opq_tid(), wid = __builtin_amdgcn_readfirstlane(tid >> 6), lane = tid & 63, wr = wid >> 2, wc = wid & 3, fr = lane & 15, fq = lane >> 4;
    const int nt = K / BK;
    unsigned voffB[2]; int RA[2], CA[2];
#pragma unroll
    for (int i = 0; i < 2; ++i) { int R, C; stage_rc(tid * 16 + i * 8192, R, C); const int Rb = Epi::PERM ? ((R & ~31) + perm32(R & 31)) : R;
        RA[i] = R; CA[i] = C; voffB[i] = (unsigned)(Rb * ldb + C) * 2u; }
    auto set_voff = [&](const Unit& u, unsigned (&v)[2][2]) {
#pragma unroll
        for (int h = 0; h < 2; ++h)
#pragma unroll
            for (int i = 0; i < 2; ++i) { if constexpr (Sched::GATHER) v[h][i] = (unsigned)S.row_of(u, h * HALF + RA[i]) * (unsigned)(lda * 2) + (unsigned)CA[i] * 2u;
                else v[h][i] = (unsigned)((h * HALF + RA[i]) * lda + CA[i]) * 2u; } };
    const size_t kstep = (size_t)(BK * 2);
    const size_t hstepB = (size_t)HALF * ldb * 2;
    const unsigned ldsw = (unsigned)wid * 1024u;
    const int aoff = lds_byte(wr * 64 + fr, fq * 8), boff = lds_byte(wc * 32 + fr, fq * 8);
#define G8_SA(b, h) (((b) * 2 + (h)) * HTB)
#define G8_SB(b, h) ((4 + (b) * 2 + (h)) * HTB)
#define G8_STAGE(bufoff, gbase, voff) do { _Pragma("unroll") for (int _i = 0; _i < 2; ++_i) \
        __builtin_amdgcn_global_load_lds((const unsigned*)((const char*)(gbase) + (voff)[_i]), (LAS unsigned*)(lds + (bufoff) + ldsw + _i * 8192), 16, 0, 0); } while (0)
#define G8_LDA(dst, b, h) do { _Pragma("unroll") for (int m = 0; m < 4; ++m) _Pragma("unroll") for (int k = 0; k < 2; ++k) dst[m][k] = *(const LAS bf16x8*)(lds + G8_SA(b, h) + aoff + m * 2048 + k * 1024); } while (0)
#define G8_LDB(dst, b, h) do { _Pragma("unroll") for (int n = 0; n < 2; ++n) _Pragma("unroll") for (int k = 0; k < 2; ++k) dst[n][k] = *(const LAS bf16x8*)(lds + G8_SB(b, h) + boff + n * 2048 + k * 1024); } while (0)
#define G8_MMA(ai, bj, At, Bt) do { __builtin_amdgcn_s_setprio(1); _Pragma("unroll") for (int m = 0; m < 4; ++m) _Pragma("unroll") for (int n = 0; n < 2; ++n) _Pragma("unroll") for (int k = 0; k < 2; ++k) \
        acc[ai][bj][m][n] = __builtin_amdgcn_mfma_f32_16x16x32_bf16(Bt[n][k], At[m][k], acc[ai][bj][m][n], 0, 0, 0); __builtin_amdgcn_s_setprio(0); } while (0)
#define G8_WAIT_V(n) asm volatile("s_waitcnt vmcnt(" #n ")" ::: "memory")
#define G8_WAIT_L(n) asm volatile("s_waitcnt lgkmcnt(" #n ")" ::: "memory")
#define G8_BAR __builtin_amdgcn_s_barrier()
#define G8_SCHED __builtin_amdgcn_sched_barrier(0)
    Unit cur, nxt; int ui = 0;
    if (!S.next(0, cur)) return;
    f32x4 acc[2][2][4][2];
#pragma unroll
    for (int a = 0; a < 2; ++a)
#pragma unroll
        for (int b = 0; b < 2; ++b)
#pragma unroll
            for (int m = 0; m < 4; ++m)
#pragma unroll
                for (int n = 0; n < 2; ++n) acc[a][b][m][n] = (f32x4){0.f, 0.f, 0.f, 0.f};
    bf16x8 At[4][2], B0[2][2], B1[2][2];
    const char* cA = cur.a; const char* cB = cur.b;
    unsigned vcur[2][2], vnxt[2][2]; set_voff(cur, vcur);
    asm volatile("s_waitcnt lgkmcnt(0)" ::: "memory");
    if constexpr (Sched::GATHER) asm volatile("s_waitcnt vmcnt(0)" ::: "memory");
    G8_STAGE(G8_SB(0, 0), cB, voffB); G8_STAGE(G8_SA(0, 0), cA, vcur[0]); G8_STAGE(G8_SB(0, 1), cB + hstepB, voffB); G8_STAGE(G8_SA(0, 1), cA, vcur[1]);
    if (wr == 1) G8_BAR;
    G8_WAIT_V(4); G8_BAR;
    G8_STAGE(G8_SB(1, 0), cB + kstep, voffB); G8_STAGE(G8_SA(1, 0), cA + kstep, vcur[0]); G8_STAGE(G8_SB(1, 1), cB + hstepB + kstep, voffB);
    G8_WAIT_V(6); G8_BAR;
    for (;;) {
        const bool has_next = S.next(ui + 1, nxt);
        const char* nA = has_next ? nxt.a : cA; const char* nB = has_next ? nxt.b : cB;
        if (has_next) set_voff(nxt, vnxt); else {
#pragma unroll
            for (int h = 0; h < 2; ++h) { vnxt[h][0] = vcur[h][0]; vnxt[h][1] = vcur[h][1]; } }
        asm volatile("s_waitcnt lgkmcnt(0)" ::: "memory");
        const int tseg = nt / Epi::NSEG;
#pragma unroll 1
        for (int sg = 0; sg < Epi::NSEG; ++sg) {
#pragma unroll 1
        for (int t = sg * tseg; t < (sg + 1) * tseg; t += 2) {
            const bool last = (t == nt - 2);
            const char* a1 = cA + (size_t)(t + 1) * kstep;
            const char* a2 = last ? nA : cA + (size_t)(t + 2) * kstep; const char* b2 = last ? nB : cB + (size_t)(t + 2) * kstep;
            const char* a3 = a2 + kstep; const char* b3 = b2 + kstep;
            unsigned v20[2], v21[2];
#pragma unroll
            for (int i = 0; i < 2; ++i) { v20[i] = last ? vnxt[0][i] : vcur[0][i]; v21[i] = last ? vnxt[1][i] : vcur[1][i]; }
            G8_LDB(B0, 0, 0); G8_SCHED; G8_LDA(At, 0, 0); G8_STAGE(G8_SA(1, 1), a1, vcur[1]);
            G8_WAIT_L(8); G8_BAR; G8_WAIT_L(0); G8_MMA(0, 0, At, B0); G8_BAR; G8_SCHED;
            G8_LDB(B1, 0, 1); G8_STAGE(G8_SB(0, 0), b2, voffB);
            G8_BAR; G8_WAIT_L(0); G8_MMA(0, 1, At, B1); G8_BAR;
            G8_LDA(At, 0, 1); G8_STAGE(G8_SA(0, 0), a2, v20);
            G8_BAR; G8_WAIT_L(0); G8_MMA(1, 0, At, B0); G8_BAR; G8_SCHED;
            G8_STAGE(G8_SB(0, 1), b2 + hstepB, voffB);
            G8_WAIT_V(6); G8_BAR; G8_MMA(1, 1, At, B1); G8_BAR;
            G8_LDB(B0, 1, 0); G8_SCHED; G8_LDA(At, 1, 0); G8_STAGE(G8_SA(0, 1), a2, v21);
            G8_WAIT_L(8); G8_BAR; G8_WAIT_L(0); G8_MMA(0, 0, At, B0); G8_BAR; G8_SCHED;
            G8_LDB(B1, 1, 1); G8_STAGE(G8_SB(1, 0), b3, voffB);
            G8_BAR; G8_WAIT_L(0); G8_MMA(0, 1, At, B1); G8_BAR;
            G8_LDA(At, 1, 1); G8_STAGE(G8_SA(1, 0), a3, v20);
            G8_BAR; G8_WAIT_L(0); G8_MMA(1, 0, At, B0); G8_BAR; G8_SCHED;
            G8_STAGE(G8_SB(1, 1), b3 + hstepB, voffB);
            G8_WAIT_V(6); G8_BAR; G8_MMA(1, 1, At, B1); G8_BAR;
        }
        if constexpr (Epi::NSEG > 1) { if (sg + 1 < Epi::NSEG) E.mid(sg, acc, cur, wr, wc, fr, fq); }
        }
        E(acc, cur, wr, wc, fr, fq);
        if (!has_next) break;
#pragma unroll
        for (int a = 0; a < 2; ++a)
#pragma unroll
            for (int b = 0; b < 2; ++b)
#pragma unroll
                for (int m = 0; m < 4; ++m)
#pragma unroll
                    for (int n = 0; n < 2; ++n) acc[a][b][m][n] = (f32x4){0.f, 0.f, 0.f, 0.f};
        cur = nxt; cA = nA; cB = nB; ++ui;
#pragma unroll
        for (int h = 0; h < 2; ++h) { vcur[h][0] = vnxt[h][0]; vcur[h][1] = vnxt[h][1]; }
    }
    G8_WAIT_V(0);
    if (wr == 0) G8_BAR;
    G8_BAR;
#undef G8_SA
#undef G8_SB
#undef G8_STAGE
#undef G8_LDA
#undef G8_LDB
#undef G8_MMA
#undef G8_WAIT_V
#undef G8_WAIT_L
#undef G8_BAR
#undef G8_SCHED
}
}

enum { I_X = 0, I_C, I_CTX, I_CCTX, I_WMOD, I_BMOD, I_NMIX, I_NFFN, I_WIN, I_HGLB, I_HGNORM, I_QNORM, I_KVNORM, I_WUQ, I_WUKV, I_GQ, I_GK,
       I_CONVW, I_CONVB, I_LWA, I_LBA, I_LWX, I_LBX, I_LAM, I_BRHG, I_BRMLA, I_BRLRU, I_WOUT, I_WRG, I_BRG, I_WRE, I_BRE, I_W1, I_W3, I_W2 };

DEVI const float* xin_row_l0(const Params& p, int r) { const int b = r / RB, pos = r - b * RB;
    return pos < SEQ ? p.in[I_X] + ((size_t)b * SEQ + pos) * DM : p.in[I_CTX] + ((size_t)b * CTX + (pos - SEQ)) * DM; }
DEVI float* xbuf_row(const Params& p, int r) { const int b = r / RB, pos = r - b * RB;
    return pos < SEQ ? p.out + ((size_t)b * SEQ + pos) * DM : p.xc + ((size_t)b * CTX + (pos - SEQ)) * DM; }
DEVI int mod_row(int r) { const int b = r / RB, pos = r - b * RB; return pos < SEQ ? b : 4; }

struct TrJob { const float* src; int ld; int K; int ncols; bf16_t* dst; int dld; const float* ks; };

DEVI int tr_job_count() { return DEPTH * (12 + 16 * 5 + 32); }
template <class P> DEVI TrJob tr_job(const P& p, int j) {
    const int per = 12 + 16 * 5 + 32; const int l = j / per; int q = j - l * per; TrJob t; t.ks = nullptr; t.src = nullptr;
    const float* win = p.in[I_WIN] + (size_t)l * DM * INW;
    bf16_t* winA = p.winA + (size_t)l * PA_W * DM; bf16_t* wup = p.wup + (size_t)l * UPW * 256; bf16_t* wcat = p.wcat + (size_t)l * DM * OCW;
    if (q == 0) { t.src = win; t.ld = INW; t.K = DM; t.ncols = 2944; t.dst = winA; t.dld = DM; return t; }
    if (q == 11) { t.src = win + 2944; t.ld = INW; t.K = DM; t.ncols = 32; t.dst = winA + (size_t)2944 * DM; t.dld = DM; return t; }
    if (q == 1) { t.src = nullptr; t.ld = 0; t.K = DM; t.ncols = 96; t.dst = winA + (size_t)2976 * DM; t.dld = DM; return t; }
    if (q == 2) { t.src = win + 2976; t.ld = INW; t.K = DM; t.ncols = 1024; t.dst = winA + (size_t)3072 * DM; t.dld = DM; return t; }
    if (q == 3) { t.src = win + 4000; t.ld = INW; t.K = DM; t.ncols = PG_W; t.dst = p.winG + (size_t)l * PG_W * DM; t.dld = DM; return t; }
    if (q == 4) { t.src = p.in[I_WUQ] + (size_t)l * 256 * 768; t.ld = 768; t.K = 256; t.ncols = 768; t.dst = wup; t.dld = 256; t.ks = p.in[I_QNORM] + l * 256; return t; }
    if (q == 5) { t.src = p.in[I_WUKV] + (size_t)l * 128 * 1024; t.ld = 1024; t.K = 128; t.ncols = 1024; t.dst = wup + (size_t)768 * 256; t.dld = 256; t.ks = p.in[I_KVNORM] + l * 128; return t; }
    if (q == 6) { t.src = nullptr; t.ld = 0; t.K = 128; t.ncols = 1024; t.dst = wup + (size_t)768 * 256 + 128; t.dld = 256; return t; }
    if (q >= 7 && q <= 9) { const int i = q - 7; const float* s = (i == 0 ? p.in[I_BRHG] : i == 1 ? p.in[I_BRMLA] : p.in[I_BRLRU]) + (size_t)l * 512 * DM;
        t.src = s; t.ld = DM; t.K = 512; t.ncols = DM; t.dst = wcat + i * 512; t.dld = OCW; return t; }
    if (q == 10) { t.src = p.in[I_WOUT] + (size_t)l * DM * DM; t.ld = DM; t.K = DM; t.ncols = DM; t.dst = p.wout + (size_t)l * DM * DM; t.dld = DM; return t; }
    q -= 12;
    if (q < 80) { const int e = q / 5, s = q % 5; const size_t le = (size_t)l * NEXP + e;
        if (s < 4) { const int pn = s >> 1, which = s & 1;
            t.src = (which ? p.in[I_W3] : p.in[I_W1]) + le * DM * DEXP + pn * 128; t.ld = DEXP; t.K = DM; t.ncols = 128;
            t.dst = p.w13 + le * 512 * DM + (size_t)(pn * 256 + which * 128) * DM; t.dld = DM; return t; }
        t.src = p.in[I_W2] + le * DEXP * DM; t.ld = DM; t.K = DEXP; t.ncols = DM; t.dst = p.w2 + le * DM * DEXP; t.dld = DEXP; return t; }
    q -= 80;
    { const int d = q >> 4, n = (q >> 1) & 7, which = q & 1;
      const size_t blk = (((size_t)l * 2 + d) * 8 + n);
      t.src = (which ? p.in[I_LWX] : p.in[I_LWA]) + blk * 64 * 64; t.ld = 64; t.K = 64; t.ncols = 64;
      t.dst = p.wlru + (blk * 2 + which) * 64 * 64; t.dld = 64; return t; }
}

template <class P> DEVI void phase_prep(const P& p, LAS unsigned char* lds) {
    const int tid = opq_tid(), G = gridDim.x;
    LAS float* tl = (LAS float*)lds;
    int rot = 0; const int nj = tr_job_count();
    for (int j = 0; j < nj; ++j) {
        const TrJob t = tr_job(p, j);
        const bool wide = (t.ncols & 63) == 0;
        const int tw = wide ? 64 : 32, tk = t.K / 64, ntile = tk * (t.ncols / tw);
        const int first = (int)((opq_bid() + (unsigned)G - (unsigned)(rot % G)) % (unsigned)G);
        if (wide) {
            for (int tile0 = first; tile0 < ntile; tile0 += 4 * G) {
                f32x4 v[4][2];
#pragma unroll
                for (int q = 0; q < 4; ++q) { const int tile = tile0 + q * G; const int k0 = (tile % tk) * 64, n0 = (tile / tk) * 64; const int n4 = tid & 15, kr = tid >> 4;
#pragma unroll
                    for (int i = 0; i < 2; ++i) { const int k = kr + 32 * i; f32x4 x = {0.f, 0.f, 0.f, 0.f};
                        if (tile < ntile && t.src) { x = *(const f32x4*)(t.src + (size_t)(k0 + k) * t.ld + n0 + n4 * 4); if (t.ks) x *= t.ks[k0 + k]; }
                        v[q][i] = x; } }
#pragma unroll
                for (int q = 0; q < 4; ++q) { const int n4 = tid & 15, kr = tid >> 4;
#pragma unroll
                    for (int i = 0; i < 2; ++i) { LAS float* d = tl + q * 4160 + (kr + 32 * i) * 65 + n4 * 4; d[0] = v[q][i][0]; d[1] = v[q][i][1]; d[2] = v[q][i][2]; d[3] = v[q][i][3]; } }
                __syncthreads();
#pragma unroll
                for (int q = 0; q < 4; ++q) { const int tile = tile0 + q * G; if (tile < ntile) { const int k0 = (tile % tk) * 64, n0 = (tile / tk) * 64; const int n = tid >> 3, k8 = (tid & 7) * 8;
                    const LAS float* sp = tl + q * 4160 + k8 * 65 + n;
                    u32x4 w; w.x = cvt_pk_bf16(sp[0], sp[65]); w.y = cvt_pk_bf16(sp[130], sp[195]); w.z = cvt_pk_bf16(sp[260], sp[325]); w.w = cvt_pk_bf16(sp[390], sp[455]);
                    *(u32x4*)(t.dst + (size_t)(n0 + n) * t.dld + k0 + k8) = w; } }
                __syncthreads();
            }
        } else {
            for (int tile0 = first; tile0 < ntile; tile0 += 8 * G) {
                float v[8][4];
#pragma unroll
                for (int q = 0; q < 8; ++q) { const int tile = tile0 + q * G; const int k0 = (tile % tk) * 64, n0 = (tile / tk) * 32; const int n = tid & 31, kr = tid >> 5;
#pragma unroll
                    for (int i = 0; i < 4; ++i) { const int k = kr + 16 * i; float x = 0.f;
                        if (tile < ntile && t.src) { x = t.src[(size_t)(k0 + k) * t.ld + n0 + n]; if (t.ks) x *= t.ks[k0 + k]; }
                        v[q][i] = x; } }
#pragma unroll
                for (int q = 0; q < 8; ++q) { const int n = tid & 31, kr = tid >> 5;
#pragma unroll
                    for (int i = 0; i < 4; ++i) tl[q * 2112 + (kr + 16 * i) * 33 + n] = v[q][i]; }
                __syncthreads();
#pragma unroll
                for (int q = 0; q < 8; ++q) { const int tile = tile0 + q * G; if (tile < ntile) { const int k0 = (tile % tk) * 64, n0 = (tile / tk) * 32; const int k = tid & 63, nn = tid >> 6;
#pragma unroll
                    for (int i = 0; i < 4; ++i) { const int n = nn + 8 * i; t.dst[(size_t)(n0 + n) * t.dld + k0 + k] = f2bf(tl[q * 2112 + k * 33 + n]); } } }
                __syncthreads();
            }
        }
        rot += ntile;
    }
    {
        LAS float* sl = (LAS float*)lds;
        LAS float* red = sl + 5 * 1024;
        for (int i = tid; i < 5 * 1024; i += 512) { const int r = i >> 10, k = i & 1023; const float v = r < 4 ? p.in[I_C][r * DM + k] : p.in[I_CCTX][k]; sl[i] = v * sigmoidf_(v); }
        __syncthreads();
        for (int u = opq_bid(); u < DEPTH * 96; u += G) {
            const int l = u / 96, n0 = (u % 96) * 64, col = tid & 63, ks = tid >> 6;
            const float* w = p.in[I_WMOD] + (size_t)l * DM * 6144 + n0 + col;
            float a0 = 0.f, a1 = 0.f, a2 = 0.f, a3 = 0.f, a4 = 0.f;
#pragma unroll 8
            for (int k = ks * 128; k < ks * 128 + 128; ++k) { const float wv = w[(size_t)k * 6144];
                a0 += sl[k] * wv; a1 += sl[1024 + k] * wv; a2 += sl[2048 + k] * wv; a3 += sl[3072 + k] * wv; a4 += sl[4096 + k] * wv; }
            red[(ks * 5 + 0) * 64 + col] = a0; red[(ks * 5 + 1) * 64 + col] = a1; red[(ks * 5 + 2) * 64 + col] = a2; red[(ks * 5 + 3) * 64 + col] = a3; red[(ks * 5 + 4) * 64 + col] = a4;
            __syncthreads();
            if (tid < 320) { const int r = tid >> 6, c2 = tid & 63; float s = p.in[I_BMOD][l * 6144 + n0 + c2];
#pragma unroll
                for (int q = 0; q < 8; ++q) s += red[(q * 5 + r) * 64 + c2];
                p.modv[((size_t)l * 5 + r) * 6144 + n0 + c2] = s; }
            __syncthreads();
        }
    }
    for (int i = opq_bid() * 512 + tid; i < SEQ * 16; i += G * 512) { const int pos = i >> 4, a = i & 15;
        const float inv = exp2f(-(float)(a & 7) * (13.287712379549449f / 8.0f)); const float ang = (float)((a < 8) ? (pos >> 6) : (pos & 63)) * inv;
        float sn, cs; sincosf(ang, &sn, &cs); p.rope[(size_t)pos * 32 + a] = cs; p.rope[(size_t)pos * 32 + 16 + a] = sn; }
    if (opq_bid() == 1) { for (int i = tid; i < DEPTH * 2 * 512; i += 512) p.lrula[i] = -8.0f * 1.44269504f * log1pf(__expf(-p.in[I_LAM][i])); }
    if (opq_bid() == 0) {
        for (int i = tid; i < 2 * 512; i += 512) { const float a0 = p.in[I_HGLB][i], a1 = p.in[I_HGLB][1024 + i]; const float m = fmaxf(a0, a1);
            const float e0 = __expf(a0 - m), e1 = __expf(a1 - m); p.lbv[i] = 0.f; p.lbv[1024 + i] = e1 / (e0 + e1); }
    }
}

DEVI void phase_norm1(const Params& p, int l, int hb) {
    const int lane = opq_tid() & 63, wv = opq_tid() >> 6;
    const float* gm = p.in[I_NMIX] + l * DM;
    for (int rl = opq_bid() * 8 + wv; rl < HR; rl += gridDim.x * 8) {
        const int r = hb * HR + rl;
        const float* src = (l == 0) ? xin_row_l0(p, r) : (const float*)xbuf_row(p, r);
        f32x4 v[4]; float ss = 0.f;
#pragma unroll
        for (int i = 0; i < 4; ++i) { v[i] = *(const f32x4*)(src + i * 256 + lane * 4); ss += v[i][0] * v[i][0] + v[i][1] * v[i][1] + v[i][2] * v[i][2] + v[i][3] * v[i][3]; }
        ss = wave_sum(ss);
        const float rstd = rsqrtf(ss * (1.0f / DM) + EPSF);
        const float* mv = p.modv + ((size_t)l * 5 + mod_row(r)) * 6144;
#pragma unroll
        for (int i = 0; i < 4; ++i) { const int c = i * 256 + lane * 4;
            const f32x4 g = *(const f32x4*)(gm + c), sh = *(const f32x4*)(mv + c), sc = *(const f32x4*)(mv + 1024 + c);
            f32x4 h;
#pragma unroll
            for (int e = 0; e < 4; ++e) h[e] = v[i][e] * rstd * g[e] * (1.0f + sc[e]) + sh[e];
            u32x2 w; w.x = cvt_pk_bf16(h[0], h[1]); w.y = cvt_pk_bf16(h[2], h[3]);
            *(u32x2*)(p.hx + (size_t)rl * DM + c) = w; }
    }
}

struct TileSched {
    static constexpr bool GATHER = false;
    int nM, nN, G, c, skipctx; const char* A; const char* B; size_t atile, btile; size_t acol_bytes;
    DEVI bool next(int i, g8::Unit& u) const {
        int pm, pn; if (!g8::static_order(i, G, c, nM, nN, pm, pn)) return false;
        const int pma = skipctx ? pm + pm / 32 : pm;
        u.pm = pma; u.pn = pn; u.tag = 0; u.a = A + (size_t)pma * atile + acol_bytes; u.b = B + (size_t)pn * btile; return true; }
};

template <int ACT> struct EpiBf16 {
    static constexpr bool PERM = true, HAS_MID = false; static constexpr int NSEG = 1;
    bf16_t* O; int ldc;
    DEVI void operator()(const f32x4 (&acc)[2][2][4][2], const g8::Unit& u, int wr, int wc, int fr, int fq) const {
        const int row0 = u.pm * 256 + wr * 64 + fr, col0 = u.pn * 256 + wc * 32 + 8 * fq;
#pragma unroll
        for (int ai = 0; ai < 2; ++ai)
#pragma unroll
            for (int m = 0; m < 4; ++m) { bf16_t* rowp = O + (size_t)(row0 + ai * 128 + m * 16) * ldc + col0;
#pragma unroll
                for (int bj = 0; bj < 2; ++bj) { f32x4 v0 = acc[ai][bj][m][0], v1 = acc[ai][bj][m][1];
                    if (ACT == 1) {
#pragma unroll
                        for (int e = 0; e < 4; ++e) { v0[e] = sigmoidf_(v0[e]); v1[e] = sigmoidf_(v1[e]); } }
                    u32x4 w; w.x = cvt_pk_bf16(v0[0], v0[1]); w.y = cvt_pk_bf16(v0[2], v0[3]); w.z = cvt_pk_bf16(v1[0], v1[1]); w.w = cvt_pk_bf16(v1[2], v1[3]);
                    *(u32x4*)(rowp + bj * 128) = w; } }
    }
};

DEVI void phase_inproj_a(const Params& p, int l, LAS unsigned char* lds) {
    TileSched S; S.nM = HR / 256; S.nN = PA_W / 256; S.G = gridDim.x; S.c = opq_bid(); S.skipctx = 0;
    S.A = (const char*)p.hx; S.B = (const char*)(p.winA + (size_t)l * PA_W * DM); S.atile = (size_t)256 * DM * 2; S.btile = (size_t)256 * DM * 2; S.acol_bytes = 0;
    EpiBf16<0> E; E.O = p.pa; E.ldc = PA_W;
    g8::gemm_phase(lds, DM, DM, DM, S, E);
}

struct UpSched { static constexpr bool GATHER = false; int G, c; const char* A; const char* B;
    DEVI bool next(int i, g8::Unit& u) const { const long L = (long)i * G + c; if (L >= (HR / 256) * 7) return false;
        const int pm = (int)(L / 7), j = (int)(L % 7); u.pm = pm; u.pn = j; u.tag = 0;
        u.a = A + (size_t)pm * 256 * PA_W * 2 + (size_t)(j < 3 ? C_DQ : C_DKV) * 2; u.b = B + (size_t)j * 256 * 256 * 2; return true; } };
DEVI void phase_mla_up(const Params& p, int l, LAS unsigned char* lds) {
    UpSched S; S.G = gridDim.x; S.c = opq_bid(); S.A = (const char*)p.pa; S.B = (const char*)(p.wup + (size_t)l * UPW * 256);
    EpiBf16<0> E; E.O = p.up; E.ldc = UPW;
    g8::gemm_phase(lds, PA_W, 256, 256, S, E);
}

DEVI void phase_inproj_g(const Params& p, int l, LAS unsigned char* lds) {
    const int skip = (l == DEPTH - 1);
    TileSched S; S.nM = skip ? 64 : HR / 256; S.nN = PG_W / 256; S.G = gridDim.x; S.c = opq_bid(); S.skipctx = skip;
    S.A = (const char*)p.hx; S.B = (const char*)(p.winG + (size_t)l * PG_W * DM); S.atile = (size_t)256 * DM * 2; S.btile = (size_t)256 * DM * 2; S.acol_bytes = 0;
    EpiBf16<1> E; E.O = p.pa; E.ldc = PG_W;
    g8::gemm_phase(lds, DM, DM, DM, S, E);
}

struct EpiMerge {
    static constexpr bool PERM = true; static constexpr int NSEG = 3;
    const bf16_t* pg; bf16_t* Y;
    static DEVI void unpack8(const u32x4& w, float (&f)[8]) {
#pragma unroll
        for (int e = 0; e < 8; ++e) { const unsigned x = w[e >> 1]; f[e] = (e & 1) ? __uint_as_float(x & 0xffff0000u) : __uint_as_float(x << 16); } }
    DEVI void mid(int sg, f32x4 (&acc)[2][2][4][2], const g8::Unit& u, int wr, int wc, int fr, int fq) const {
        const int row0 = u.pm * 256 + wr * 64 + fr, col0 = u.pn * 256 + wc * 32 + 8 * fq;
        const bf16_t* gbase = pg + (size_t)row0 * PG_W + col0 + sg * 1024;
#pragma unroll
        for (int ai = 0; ai < 2; ++ai)
#pragma unroll
            for (int mp = 0; mp < 2; ++mp) {
#pragma unroll
                for (int mi = 0; mi < 2; ++mi) { const int m = mp * 2 + mi; const bf16_t* gp = gbase + (size_t)(ai * 128 + m * 16) * PG_W;
#pragma unroll
                    for (int bj = 0; bj < 2; ++bj) { const u32x4 a = *(const u32x4*)(gp + bj * 128), b = *(const u32x4*)(gp + 1024 + bj * 128);
                        float fa[8], fb[8]; unpack8(a, fa); unpack8(b, fb);
#pragma unroll
                        for (int e = 0; e < 8; ++e) acc[ai][bj][m][e >> 2][e & 3] *= fa[e] * fast_rcp(fmaxf(fb[e], 1e-30f)); } }
                asm volatile("" : "+v"(acc[ai][0][mp * 2][0]), "+v"(acc[ai][0][mp * 2][1]), "+v"(acc[ai][1][mp * 2][0]), "+v"(acc[ai][1][mp * 2][1]),
                                  "+v"(acc[ai][0][mp * 2 + 1][0]), "+v"(acc[ai][0][mp * 2 + 1][1]), "+v"(acc[ai][1][mp * 2 + 1][0]), "+v"(acc[ai][1][mp * 2 + 1][1]) :: "memory"); }
    }
    DEVI void operator()(f32x4 (&acc)[2][2][4][2], const g8::Unit& u, int wr, int wc, int fr, int fq) const {
        const int row0 = u.pm * 256 + wr * 64 + fr, col0 = u.pn * 256 + wc * 32 + 8 * fq;
#pragma unroll
        for (int ai = 0; ai < 2; ++ai)
#pragma unroll
            for (int mp = 0; mp < 2; ++mp) {
#pragma unroll
                for (int mi = 0; mi < 2; ++mi) { const int m = mp * 2 + mi; const size_t row = (size_t)(row0 + ai * 128 + m * 16); const bf16_t* gp = pg + row * PG_W + col0 + 2048;
#pragma unroll
                    for (int bj = 0; bj < 2; ++bj) { const u32x4 a = *(const u32x4*)(gp + bj * 128); float fa[8]; unpack8(a, fa);
                        const f32x4 v0 = acc[ai][bj][m][0], v1 = acc[ai][bj][m][1];
                        u32x4 w; w.x = cvt_pk_bf16(v0[0] * fa[0], v0[1] * fa[1]); w.y = cvt_pk_bf16(v0[2] * fa[2], v0[3] * fa[3]);
                        w.z = cvt_pk_bf16(v1[0] * fa[4], v1[1] * fa[5]); w.w = cvt_pk_bf16(v1[2] * fa[6], v1[3] * fa[7]);
                        *(u32x4*)(Y + row * DM + col0 + bj * 128) = w; } }
                asm volatile("" ::: "memory"); }
    }
};
DEVI void phase_merge(const Params& p, int l, LAS unsigned char* lds) {
    const int skip = (l == DEPTH - 1);
    TileSched S; S.nM = skip ? 64 : HR / 256; S.nN = DM / 256; S.G = gridDim.x; S.c = opq_bid(); S.skipctx = skip;
    S.A = (const char*)p.ocat; S.B = (const char*)(p.wcat + (size_t)l * DM * OCW); S.atile = (size_t)256 * OCW * 2; S.btile = (size_t)256 * OCW * 2; S.acol_bytes = 0;
    EpiMerge E; E.pg = p.pa; E.Y = p.y;
    g8::gemm_phase(lds, OCW, OCW, OCW, S, E);
}

struct EpiOut {
    static constexpr bool PERM = false, HAS_MID = false; static constexpr int NSEG = 1;
    const float* x0; const float* c0; float* xo_; float* xc_; const float* modv; int l, hb;
    DEVI void operator()(const f32x4 (&acc)[2][2][4][2], const g8::Unit& u, int wr, int wc, int fr, int fq) const {
        const int row0 = u.pm * 256 + wr * 64 + fr, col0 = u.pn * 256 + wc * 32 + 4 * fq;
#pragma unroll
        for (int ai = 0; ai < 2; ++ai)
#pragma unroll
            for (int m = 0; m < 4; ++m) { const int r = hb * HR + row0 + ai * 128 + m * 16;
                const int b = r / RB, pos = r - b * RB; const bool lat = pos < SEQ;
                const size_t xoff = lat ? ((size_t)b * SEQ + pos) * DM : ((size_t)b * CTX + (pos - SEQ)) * DM;
                float* xo = (lat ? xo_ : xc_) + xoff; const float* xi = (l == 0) ? (lat ? x0 : c0) + xoff : (const float*)xo;
                const float* g1 = modv + ((size_t)l * 5 + (lat ? b : 4)) * 6144 + 2048;
#pragma unroll
                for (int bj = 0; bj < 2; ++bj)
#pragma unroll
                    for (int n = 0; n < 2; ++n) { const int c = col0 + bj * 128 + n * 16;
                        const f32x4 xv = *(const f32x4*)(xi + c), gv = *(const f32x4*)(g1 + c);
                        *(f32x4*)(xo + c) = xv + gv * acc[ai][bj][m][n]; } }
    }
};
DEVI void phase_outproj(const Params& p, int l, int hb, LAS unsigned char* lds) {
    const int skip = (l == DEPTH - 1);
    TileSched S; S.nM = skip ? 64 : HR / 256; S.nN = DM / 256; S.G = gridDim.x; S.c = opq_bid(); S.skipctx = skip;
    S.A = (const char*)p.y; S.B = (const char*)(p.wout + (size_t)l * DM * DM); S.atile = (size_t)256 * DM * 2; S.btile = (size_t)256 * DM * 2; S.acol_bytes = 0;
    EpiOut E; E.x0 = p.in[I_X]; E.c0 = p.in[I_CTX]; E.xo_ = p.out; E.xc_ = p.xc; E.modv = p.modv; E.l = l; E.hb = hb;
    g8::gemm_phase(lds, DM, DM, DM, S, E);
}

DEVI void phase_qkv(const Params& p, int l, LAS unsigned char* lds) {
    const int tid = opq_tid(), lane = tid & 63, wv = tid >> 6, h = lane >> 3, sub = lane & 7;
    LAS bf16_t* vt = (LAS bf16_t*)lds;
    const float* gq = p.in[I_GQ] + l * 96; const float* gk = p.in[I_GK] + l * 96;
    float gqn[8], gkn[8], gqr[4], gkr[4];
#pragma unroll
    for (int e = 0; e < 8; ++e) { gqn[e] = gq[sub * 8 + e]; gkn[e] = gk[sub * 8 + e]; }
#pragma unroll
    for (int e = 0; e < 4; ++e) { gqr[e] = gq[64 + sub * 4 + e]; gkr[e] = gk[64 + sub * 4 + e]; }
    const float qscale = 0.10206207261596577f * 1.4426950408889634f;
    const bool need_ctx_q = (l < DEPTH - 1);
    const bool upper = (sub & 4) != 0;
    struct QkIn { u32x2 dqw; unsigned dkw; u32x2 krw; u32x4 qnw; u32x2 qrw; u32x4 knw, vw; f32x4 cs4, sn4; };
    auto load_rows = [&](int u, QkIn (&r)[2]) {
        const int bl = u / (NCH * 4), tile = (u >> 2) % NCH, qtr = u & 3;
#pragma unroll
        for (int it = 0; it < 2; ++it) { const int pos = tile * 64 + qtr * 16 + wv * 2 + it, rl = bl * RB + pos;
            const bf16_t* prow = p.pa + (size_t)rl * PA_W; const bf16_t* urow = p.up + (size_t)rl * UPW;
            r[it].dqw = *(const u32x2*)(prow + C_DQ + lane * 4); r[it].dkw = *(const unsigned*)(prow + C_DKV + lane * 2); r[it].krw = *(const u32x2*)(prow + C_KR + sub * 4);
            r[it].qnw = *(const u32x4*)(urow + h * 96 + sub * 8); r[it].qrw = *(const u32x2*)(urow + h * 96 + 64 + sub * 4);
            r[it].knw = *(const u32x4*)(urow + 768 + h * 128 + sub * 8); r[it].vw = *(const u32x4*)(urow + 768 + h * 128 + 64 + sub * 8);
            r[it].cs4 = (f32x4){1.f, 1.f, 1.f, 1.f}; r[it].sn4 = (f32x4){0.f, 0.f, 0.f, 0.f};
            if (pos < SEQ) { const float* rt = p.rope + (size_t)pos * 32 + (sub & 3) * 4; r[it].cs4 = *(const f32x4*)rt; r[it].sn4 = *(const f32x4*)(rt + 16); } } };
    QkIn cur[2], nxt[2];
    const int nunit = 2 * NCH * 4, G = gridDim.x;
    if ((int)opq_bid() < nunit) load_rows(opq_bid(), cur);
    for (int u = opq_bid(); u < nunit; u += G) {
        const int bl = u / (NCH * 4), tile = (u >> 2) % NCH, qtr = u & 3;
        const bool more = u + G < nunit; if (more) load_rows(u + G, nxt);
#pragma unroll
        for (int it = 0; it < 2; ++it) {
            const int r16 = wv * 2 + it, rr = qtr * 16 + r16, pos = tile * 64 + rr;
            const bool lat = pos < SEQ;
            const u32x2 dqw = cur[it].dqw; const unsigned dkw = cur[it].dkw; const u32x2 krw = cur[it].krw; const u32x4 qnw = cur[it].qnw; const u32x2 qrw = cur[it].qrw;
            const u32x4 knw = cur[it].knw, vw = cur[it].vw; const f32x4 cs4 = cur[it].cs4, sn4 = cur[it].sn4;
            float sq, skv;
            { const float a0 = __uint_as_float(dqw.x << 16), a1 = __uint_as_float(dqw.x & 0xffff0000u), a2 = __uint_as_float(dqw.y << 16), a3 = __uint_as_float(dqw.y & 0xffff0000u);
              sq = a0 * a0 + a1 * a1 + a2 * a2 + a3 * a3;
              const float b0 = __uint_as_float(dkw << 16), b1 = __uint_as_float(dkw & 0xffff0000u); skv = b0 * b0 + b1 * b1; }
            sq = wave_sum(sq); skv = wave_sum(skv);
            const float rq = rsqrtf(sq * (1.0f / 256.0f) + EPSF), rkv = rsqrtf(skv * (1.0f / 128.0f) + EPSF);
            float qn[8], qr[4], kn[8], kr[4];
#pragma unroll
            for (int e = 0; e < 8; ++e) { const unsigned a = qnw[e >> 1], b = knw[e >> 1];
                qn[e] = ((e & 1) ? __uint_as_float(a & 0xffff0000u) : __uint_as_float(a << 16)) * rq;
                kn[e] = ((e & 1) ? __uint_as_float(b & 0xffff0000u) : __uint_as_float(b << 16)) * rkv; }
#pragma unroll
            for (int e = 0; e < 4; ++e) { const unsigned a = (e < 2) ? qrw.x : qrw.y, b = (e < 2) ? krw.x : krw.y;
                qr[e] = ((e & 1) ? __uint_as_float(a & 0xffff0000u) : __uint_as_float(a << 16)) * rq;
                kr[e] = ((e & 1) ? __uint_as_float(b & 0xffff0000u) : __uint_as_float(b << 16)); }
            float sqq = 0.f, skk = 0.f;
#pragma unroll
            for (int e = 0; e < 8; ++e) { sqq += qn[e] * qn[e]; skk += kn[e] * kn[e]; }
#pragma unroll
            for (int e = 0; e < 4; ++e) { sqq += qr[e] * qr[e]; skk += kr[e] * kr[e]; }
            sqq += __shfl_xor(sqq, 1); sqq += __shfl_xor(sqq, 2); sqq += __shfl_xor(sqq, 4);
            skk += __shfl_xor(skk, 1); skk += __shfl_xor(skk, 2); skk += __shfl_xor(skk, 4);
            const float rnq = rsqrtf(sqq * (1.0f / 96.0f) + EPSF) * qscale, rnk = rsqrtf(skk * (1.0f / 96.0f) + EPSF);
            float qo[12], ko[12];
#pragma unroll
            for (int e = 0; e < 8; ++e) { qo[e] = qn[e] * rnq * gqn[e]; ko[e] = kn[e] * rnk * gkn[e]; }
#pragma unroll
            for (int e = 0; e < 4; ++e) { const float a = qr[e] * rnq * gqr[e], b = kr[e] * rnk * gkr[e];
                const float pa_ = __shfl_xor(a, 4), pb_ = __shfl_xor(b, 4);
                qo[8 + e] = upper ? (a * cs4[e] + pa_ * sn4[e]) : (a * cs4[e] - pa_ * sn4[e]);
                ko[8 + e] = upper ? (b * cs4[e] + pb_ * sn4[e]) : (b * cs4[e] - pb_ * sn4[e]); }
            if (lat || need_ctx_q) {
                bf16_t* qd = lat ? p.q + (((size_t)(bl * 8 + h) * SEQ + pos) * 96) : p.qc + (((size_t)(bl * 8 + h) * CTX + (pos - SEQ)) * 96);
                u32x4 w; w.x = cvt_pk_bf16(qo[0], qo[1]); w.y = cvt_pk_bf16(qo[2], qo[3]); w.z = cvt_pk_bf16(qo[4], qo[5]); w.w = cvt_pk_bf16(qo[6], qo[7]);
                *(u32x4*)(qd + sub * 8) = w;
                u32x2 w2; w2.x = cvt_pk_bf16(qo[8], qo[9]); w2.y = cvt_pk_bf16(qo[10], qo[11]);
                *(u32x2*)(qd + 64 + sub * 4) = w2; }
            { bf16_t* kd = (bf16_t*)(p.kv + ((size_t)(bl * 8 + h) * NCH + tile) * KVT_BYTES + rr * 208);
              u32x4 w; w.x = cvt_pk_bf16(ko[0], ko[1]); w.y = cvt_pk_bf16(ko[2], ko[3]); w.z = cvt_pk_bf16(ko[4], ko[5]); w.w = cvt_pk_bf16(ko[6], ko[7]);
              *(u32x4*)(kd + sub * 8) = w;
              u32x2 w2; w2.x = cvt_pk_bf16(ko[8], ko[9]); w2.y = cvt_pk_bf16(ko[10], ko[11]);
              *(u32x2*)(kd + 64 + sub * 4) = w2; }
#pragma unroll
            for (int e = 0; e < 8; ++e) { const unsigned a = vw[e >> 1]; const float v = ((e & 1) ? __uint_as_float(a & 0xffff0000u) : __uint_as_float(a << 16)) * rkv;
                vt[(h * 64 + sub * 8 + e) * 20 + r16] = f2bf(v); }
        }
        __syncthreads();
        for (int i = tid; i < 8 * 64 * 4; i += 512) { const int hh = i >> 8, rem = i & 255, vc = rem >> 2, pc = rem & 3;
            const u32x2 w = *(const LAS u32x2*)(vt + (hh * 64 + vc) * 20 + pc * 4);
            *(u32x2*)(p.kv + ((size_t)(bl * 8 + hh) * NCH + tile) * KVT_BYTES + KT_BYTES + vc * 136 + qtr * 32 + pc * 8) = w; }
        __syncthreads();
        if (more) { cur[0] = nxt[0]; cur[1] = nxt[1]; }
    }
}

DEVI void attn_unit(const Params& p, LAS unsigned char* lds, const bf16_t* Qb, int nq, const unsigned char* kvb, int ntile, bf16_t* orow, float accinit) {
    const int tid = opq_tid(), lane = tid & 63, wv = __builtin_amdgcn_readfirstlane(tid >> 6), l31 = lane & 31, hh = lane >> 5;
    const bool active = wv * 64 < nq;
    bf16x8 qf[2][6];
#pragma unroll
    for (int qt = 0; qt < 2; ++qt)
#pragma unroll
        for (int ks = 0; ks < 6; ++ks) {
            if (active) qf[qt][ks] = *(const bf16x8*)(Qb + (size_t)(wv * 64 + qt * 32 + l31) * 96 + ks * 16 + hh * 8);
            else qf[qt][ks] = (bf16x8){0, 0, 0, 0, 0, 0, 0, 0}; }
    f32x16 O[2][2];
#pragma unroll
    for (int a = 0; a < 2; ++a)
#pragma unroll
        for (int b = 0; b < 2; ++b)
#pragma unroll
            for (int i = 0; i < 16; ++i) O[a][b][i] = 0.f;
    float lsum[2] = {0.f, 0.f};
    constexpr int STG = 2 * KVT_BYTES;
    const int nstage = ntile >> 1;
    auto stage_in = [&](int sidx, int bsel) {
        const unsigned char* g = kvb + (size_t)sidx * STG + lane * 16;
        for (int pc = wv; pc < 43; pc += 8)
            __builtin_amdgcn_global_load_lds((const unsigned*)(g + pc * 1024), (LAS unsigned*)(lds + bsel * STG + pc * 1024), 16, 0, 0);
    };
    stage_in(0, 0);
    __syncthreads();
    if (wv >= 4) __builtin_amdgcn_s_setprio(1);
    for (int sg = 0; sg < nstage; ++sg) {
        if (sg + 1 < nstage) stage_in(sg + 1, (sg + 1) & 1);
        if (active) {
#pragma unroll 1
            for (int kt = 0; kt < 4; ++kt) {
                const LAS unsigned char* kb = lds + (sg & 1) * STG + (kt >> 1) * KVT_BYTES; const LAS unsigned char* vb = kb + KT_BYTES; const int ks2 = kt & 1;
                bf16x8 kf[6];
#pragma unroll
                for (int ks = 0; ks < 6; ++ks) kf[ks] = *(const LAS bf16x8*)(kb + (ks2 * 32 + l31) * 208 + ks * 32 + hh * 16);
                bf16x8 vf[2][2];
#pragma unroll
                for (int vtile = 0; vtile < 2; ++vtile)
#pragma unroll
                    for (int s2 = 0; s2 < 2; ++s2) { const LAS unsigned char* a = vb + (vtile * 32 + l31) * 136 + (ks2 * 32 + s2 * 16 + 4 * hh) * 2;
                        const u32x2 lo = *(const LAS u32x2*)a, hi = *(const LAS u32x2*)(a + 16);
                        u32x4 w; w.x = lo.x; w.y = lo.y; w.z = hi.x; w.w = hi.y; vf[vtile][s2] = __builtin_bit_cast(bf16x8, w); }
                f32x16 S0, S1;
#pragma unroll
                for (int i = 0; i < 16; ++i) { S0[i] = accinit; S1[i] = accinit; }
#pragma unroll
                for (int ks = 0; ks < 6; ++ks) S0 = __builtin_amdgcn_mfma_f32_32x32x16_bf16(kf[ks], qf[0][ks], S0, 0, 0, 0);

#pragma unroll
                for (int ks = 0; ks < 6; ++ks) S1 = __builtin_amdgcn_mfma_f32_32x32x16_bf16(kf[ks], qf[1][ks], S1, 0, 0, 0);
                bf16x8 pb0[2], pb1[2];
                { float ls = 0.f;
#pragma unroll
                  for (int i = 0; i < 16; ++i) { S0[i] = fast_exp2(S0[i]); ls += S0[i]; }
                  lsum[0] += ls;
#pragma unroll
                  for (int s2 = 0; s2 < 2; ++s2) { u32x4 w; w.x = cvt_pk_bf16(S0[8 * s2 + 0], S0[8 * s2 + 1]); w.y = cvt_pk_bf16(S0[8 * s2 + 2], S0[8 * s2 + 3]);
                      w.z = cvt_pk_bf16(S0[8 * s2 + 4], S0[8 * s2 + 5]); w.w = cvt_pk_bf16(S0[8 * s2 + 6], S0[8 * s2 + 7]); pb0[s2] = __builtin_bit_cast(bf16x8, w); } }

#pragma unroll
                for (int s2 = 0; s2 < 2; ++s2)
#pragma unroll
                    for (int vtile = 0; vtile < 2; ++vtile) O[0][vtile] = __builtin_amdgcn_mfma_f32_32x32x16_bf16(vf[vtile][s2], pb0[s2], O[0][vtile], 0, 0, 0);
                { float ls = 0.f;
#pragma unroll
                  for (int i = 0; i < 16; ++i) { S1[i] = fast_exp2(S1[i]); ls += S1[i]; }
                  lsum[1] += ls;
#pragma unroll
                  for (int s2 = 0; s2 < 2; ++s2) { u32x4 w; w.x = cvt_pk_bf16(S1[8 * s2 + 0], S1[8 * s2 + 1]); w.y = cvt_pk_bf16(S1[8 * s2 + 2], S1[8 * s2 + 3]);
                      w.z = cvt_pk_bf16(S1[8 * s2 + 4], S1[8 * s2 + 5]); w.w = cvt_pk_bf16(S1[8 * s2 + 6], S1[8 * s2 + 7]); pb1[s2] = __builtin_bit_cast(bf16x8, w); } }

#pragma unroll
                for (int s2 = 0; s2 < 2; ++s2)
#pragma unroll
                    for (int vtile = 0; vtile < 2; ++vtile) O[1][vtile] = __builtin_amdgcn_mfma_f32_32x32x16_bf16(vf[vtile][s2], pb1[s2], O[1][vtile], 0, 0, 0);
            }
        }
        __syncthreads();
    }
    __builtin_amdgcn_s_setprio(0);
    if (active) {
#pragma unroll
        for (int qt = 0; qt < 2; ++qt) {
            const float tot = lsum[qt] + __shfl_xor(lsum[qt], 32); const float inv = 1.0f / tot;
            bf16_t* orw = orow + (size_t)(wv * 64 + qt * 32 + l31) * OCW;
#pragma unroll
            for (int vtile = 0; vtile < 2; ++vtile)
#pragma unroll
                for (int g4 = 0; g4 < 4; ++g4) { u32x2 w; w.x = cvt_pk_bf16(O[qt][vtile][4 * g4 + 0] * inv, O[qt][vtile][4 * g4 + 1] * inv);
                    w.y = cvt_pk_bf16(O[qt][vtile][4 * g4 + 2] * inv, O[qt][vtile][4 * g4 + 3] * inv);
                    *(u32x2*)(orw + vtile * 32 + 8 * g4 + 4 * hh) = w; }
        }
    }
}

DEVI float attn_offset(const Params& p, int l) {
    const int lane = opq_tid() & 63;
    const float* gq = p.in[I_GQ] + l * 96; const float* gk = p.in[I_GK] + l * 96;
    float a = fmaxf(fabsf(gq[lane]), lane < 32 ? fabsf(gq[64 + lane]) : 0.f), b = fmaxf(fabsf(gk[lane]), lane < 32 ? fabsf(gk[64 + lane]) : 0.f);
    a = wave_max(a); b = wave_max(b);
    return -(9.797958971132712f * 1.4426950408889634f * a * b * 1.001f);
}

constexpr int HGP = 72;
constexpr int ZP = 68;
constexpr int HG_ZT0 = 0, HG_ZT1 = 17408, HG_KEY0 = 34816, HG_KEY1 = 52224, HG_VT = 69632, HG_KRM0 = 78848, HG_KRM1 = 88064, HG_QRM0 = 97280, HG_QRM1 = 106496,
              HG_S2T0 = 115712, HG_S2T1 = 124928, HG_A20 = 134144, HG_A21 = 143360, HG_GT = 152576  , HG_REF = 156672  , HG_BT = 157184  ,
              HG_O = HG_ZT0  ;
DEVI bf16x8 hg_frag_tr(const LAS unsigned char* tile, int k0, int c0, int lane) {
    const unsigned g = lane >> 4, q = (lane & 15) >> 2, pp = lane & 3;
    const unsigned a0 = (unsigned)(size_t)tile + (unsigned)((k0 + 8 * g + q) * (HGP * 2) + (c0 + 4 * pp) * 2), a1 = a0 + 4 * HGP * 2;
    u32x2 r0, r1;
    asm volatile("ds_read_b64_tr_b16 %0, %2\n\tds_read_b64_tr_b16 %1, %3\n\ts_waitcnt lgkmcnt(0)" : "=&v"(r0), "=&v"(r1) : "v"(a0), "v"(a1) : "memory");
    u32x4 w; w.x = r0.x; w.y = r0.y; w.z = r1.x; w.w = r1.y; return __builtin_bit_cast(bf16x8, w);
}

DEVI int hg_pos0(int tc) { return tc < 128 ? tc * 64 : SEQ + (tc - 128) * 64; }
DEVI int hg_chain_pos(int tc, int dir) { return dir ? (NCH - 1 - tc) : (tc < 128 ? tc + 4 : tc - 128); }

struct HgIn { u32x4 q, zf, zb, v, g, sf, sb; };
template <bool PASS3> DEVI void hg_load(const Params& p, int u, HgIn& r) {
    const int tid = opq_tid(), tk = tid >> 3, pc = tid & 7; const int tc = u % NCH, h = (u / NCH) & 7, bl = u / (NCH * 8);
    const bf16_t* prow = p.pa + (size_t)(bl * RB + hg_pos0(tc) + tk) * PA_W + h * 64 + pc * 8;
    r.zf = *(const u32x4*)(prow + C_ZF); r.zb = *(const u32x4*)(prow + C_ZB); r.v = *(const u32x4*)(prow + C_I);
    if (PASS3) { r.q = *(const u32x4*)(prow + C_Q); r.g = *(const u32x4*)(prow + C_G);
        const size_t uf = ((size_t)((bl * 2 + 0) * 8 + h)) * NCH + hg_chain_pos(tc, 0), ub = ((size_t)((bl * 2 + 1) * 8 + h)) * NCH + hg_chain_pos(tc, 1);
        r.sf = *(const u32x4*)(p.st + uf * 4096 + tk * 64 + pc * 8); r.sb = *(const u32x4*)(p.st + ub * 4096 + tk * 64 + pc * 8); }
}
DEVI float bfw(const u32x4& w, int e) { const unsigned x = w[e >> 1]; return (e & 1) ? __uint_as_float(x & 0xffff0000u) : __uint_as_float(x << 16); }

template <bool PASS3> DEVI void hg_prepare(const Params& p, int l, LAS unsigned char* lds, int h, const HgIn& r) {
    const int tid = opq_tid(), tk = tid >> 3, pc = tid & 7;
    LAS float* gt = (LAS float*)(lds + HG_GT); LAS float* refv = (LAS float*)(lds + HG_REF); LAS float* btv = (LAS float*)(lds + HG_BT);
    {
#pragma unroll
        for (int dir = 0; dir < 2; ++dir) {
            LAS float* zt = (LAS float*)(lds + (dir ? HG_ZT1 : HG_ZT0)); LAS float* keyt = (LAS float*)(lds + (dir ? HG_KEY1 : HG_KEY0));
            const float* lbp = p.lbv + ((size_t)l * 2 + dir) * 512 + h * 64 + pc * 8;
            float lf[8], ky[8];
#pragma unroll
            for (int e = 0; e < 8; ++e) { const float z = bfw(dir ? r.zb : r.zf, e); const float lb = lbp[e];
                const float ez = fast_exp2(-1.44269504f * fabsf(z)), opl = 1.0f + ez, rc = fast_rcp(opl);
                const float logsig = -(fmaxf(-z, 0.f) + 0.69314718f * __builtin_amdgcn_logf(opl));
                const float sigp = (z >= 0.f) ? rc : ez * rc;
                lf[e] = (lb > 0.f) ? 0.69314718f * __builtin_amdgcn_logf(lb + (1.0f - lb) * sigp) : logsig;
                ky[e] = (1.0f - lb) * (1.0f - sigp); }
            *(LAS f32x4*)(zt + tk * ZP + pc * 8) = (f32x4){lf[0], lf[1], lf[2], lf[3]}; *(LAS f32x4*)(zt + tk * ZP + pc * 8 + 4) = (f32x4){lf[4], lf[5], lf[6], lf[7]};
            *(LAS f32x4*)(keyt + tk * ZP + pc * 8) = (f32x4){ky[0], ky[1], ky[2], ky[3]}; *(LAS f32x4*)(keyt + tk * ZP + pc * 8 + 4) = (f32x4){ky[4], ky[5], ky[6], ky[7]}; }
        *(LAS u32x4*)(lds + HG_VT + (tk * HGP + pc * 8) * 2) = r.v;
    }
    __syncthreads();
    {
        const int d = tid & 63, jg = tid >> 6; float c0[8], c1[8]; float run = 0.f;
        LAS float* zt0 = (LAS float*)(lds + HG_ZT0); LAS float* zt1 = (LAS float*)(lds + HG_ZT1);
#pragma unroll
        for (int i = 0; i < 8; ++i) { run += zt0[(jg * 8 + i) * ZP + d]; c0[i] = run; }
        gt[jg * 64 + d] = run; run = 0.f;
#pragma unroll
        for (int i = 7; i >= 0; --i) { run += zt1[(jg * 8 + i) * ZP + d]; c1[i] = run; }
        gt[512 + jg * 64 + d] = run;
        __syncthreads();
        float off0 = 0.f, off1 = 0.f;
#pragma unroll
        for (int g2 = 0; g2 < 8; ++g2) { off0 += (g2 < jg) ? gt[g2 * 64 + d] : 0.f; off1 += (g2 > jg) ? gt[512 + g2 * 64 + d] : 0.f; }
#pragma unroll
        for (int i = 0; i < 8; ++i) { zt0[(jg * 8 + i) * ZP + d] = c0[i] + off0; zt1[(jg * 8 + i) * ZP + d] = c1[i] + off1; }
        if (jg == 3) refv[d] = c0[7] + off0;
        if (jg == 7) btv[d] = c0[7] + off0;
        if (jg == 4) refv[64 + d] = c1[0] + off1;
        if (jg == 0) btv[64 + d] = c1[0] + off1;
    }
    __syncthreads();
    {
#pragma unroll
        for (int dir = 0; dir < 2; ++dir) {
            const LAS float* zt = (const LAS float*)(lds + (dir ? HG_ZT1 : HG_ZT0)); const LAS float* keyt = (const LAS float*)(lds + (dir ? HG_KEY1 : HG_KEY0));
            float kt[8], qt[8];
            const f32x4 z0 = *(const LAS f32x4*)(zt + tk * ZP + pc * 8), z1 = *(const LAS f32x4*)(zt + tk * ZP + pc * 8 + 4);
            const f32x4 k0 = *(const LAS f32x4*)(keyt + tk * ZP + pc * 8), k1 = *(const LAS f32x4*)(keyt + tk * ZP + pc * 8 + 4);
            const f32x4 r0 = *(const LAS f32x4*)(refv + dir * 64 + pc * 8), r1 = *(const LAS f32x4*)(refv + dir * 64 + pc * 8 + 4);
#pragma unroll
            for (int e = 0; e < 8; ++e) { const float bc = e < 4 ? z0[e & 3] : z1[e & 3], rf = e < 4 ? r0[e & 3] : r1[e & 3], ke = e < 4 ? k0[e & 3] : k1[e & 3];
                kt[e] = ke * fast_exp2(1.44269504f * fminf(rf - bc, 80.f)); if (PASS3) qt[e] = bfw(r.q, e) * fast_exp2(1.44269504f * fminf(bc - rf, 80.f)); }
            { u32x4 w; w.x = cvt_pk_bf16(kt[0], kt[1]); w.y = cvt_pk_bf16(kt[2], kt[3]); w.z = cvt_pk_bf16(kt[4], kt[5]); w.w = cvt_pk_bf16(kt[6], kt[7]);
              *(LAS u32x4*)(lds + (dir ? HG_KRM1 : HG_KRM0) + (tk * HGP + pc * 8) * 2) = w; }
            if (PASS3) {
                u32x4 w; w.x = cvt_pk_bf16(qt[0], qt[1]); w.y = cvt_pk_bf16(qt[2], qt[3]); w.z = cvt_pk_bf16(qt[4], qt[5]); w.w = cvt_pk_bf16(qt[6], qt[7]);
                *(LAS u32x4*)(lds + (dir ? HG_QRM1 : HG_QRM0) + (tk * HGP + pc * 8) * 2) = w;
                const float er = fast_exp2(1.44269504f * refv[dir * 64 + tk]); float sv[8];
#pragma unroll
                for (int e = 0; e < 8; ++e) sv[e] = bfw(dir ? r.sb : r.sf, e) * er;
                w.x = cvt_pk_bf16(sv[0], sv[1]); w.y = cvt_pk_bf16(sv[2], sv[3]); w.z = cvt_pk_bf16(sv[4], sv[5]); w.w = cvt_pk_bf16(sv[6], sv[7]);
                *(LAS u32x4*)(lds + (dir ? HG_S2T1 : HG_S2T0) + (tk * HGP + pc * 8) * 2) = w;
            }
        }
    }
    __syncthreads();
}
DEVI bf16x8 hg_frag(const LAS unsigned char* base, int r, int c0) { return *(const LAS bf16x8*)(base + (size_t)(r * HGP + c0) * 2); }

DEVI void hg_pass1_unit(const Params& p, int l, LAS unsigned char* lds, int u, const HgIn& r) {
    const int tc = u % NCH, h = (u / NCH) & 7, bl = u / (NCH * 8);
    hg_prepare<false>(p, l, lds, h, r);
    const int tid = opq_tid(), lane = tid & 63, wv = tid >> 6, l15 = lane & 15, g = lane >> 4;
    const LAS float* refv = (const LAS float*)(lds + HG_REF); const LAS float* btv = (const LAS float*)(lds + HG_BT);
    const int dt = wv >> 1, ct0 = (wv & 1) * 2;
#pragma unroll
    for (int dir = 0; dir < 2; ++dir) {
        const size_t unit = ((size_t)((bl * 2 + dir) * 8 + h)) * NCH + hg_chain_pos(tc, dir);
        bf16_t* so = p.st + unit * 4096;
        const LAS unsigned char* krm = lds + (dir ? HG_KRM1 : HG_KRM0);
        bf16x8 af[2];
#pragma unroll
        for (int ks = 0; ks < 2; ++ks) af[ks] = hg_frag_tr(krm, 32 * ks, 16 * dt, lane);
#pragma unroll
        for (int ci = 0; ci < 2; ++ci) { const int ct = ct0 + ci; f32x4 acc = {0.f, 0.f, 0.f, 0.f};
#pragma unroll
            for (int ks = 0; ks < 2; ++ks) acc = __builtin_amdgcn_mfma_f32_16x16x32_bf16(af[ks], hg_frag_tr(lds + HG_VT, 32 * ks, 16 * ct, lane), acc, 0, 0, 0);
#pragma unroll
            for (int rr = 0; rr < 4; ++rr) { const int d = 16 * dt + 4 * g + rr; so[d * 64 + 16 * ct + l15] = f2bf(acc[rr] * fast_exp2(1.44269504f * (btv[dir * 64 + d] - refv[dir * 64 + d]))); } }
        if (tid < 64) p.stb[unit * 64 + tid] = btv[dir * 64 + tid];
    }
    __syncthreads();
}

DEVI void hg_pass3_unit(const Params& p, int l, LAS unsigned char* lds, int u, const HgIn& r) {
    const int tc = u % NCH, h = (u / NCH) & 7, bl = u / (NCH * 8);
    const int tid = opq_tid(), lane = tid & 63, wv = tid >> 6, l15 = lane & 15, g = lane >> 4;
    hg_prepare<true>(p, l, lds, h, r);
    { const int tt = wv >> 1, st0 = (wv & 1) * 2;
#pragma unroll
      for (int dir = 0; dir < 2; ++dir) {
          const LAS unsigned char* qrm = lds + (dir ? HG_QRM1 : HG_QRM0); const LAS unsigned char* krm = lds + (dir ? HG_KRM1 : HG_KRM0); LAS bf16_t* a2 = (LAS bf16_t*)(lds + (dir ? HG_A21 : HG_A20));
          bf16x8 bq[2];
#pragma unroll
          for (int ks = 0; ks < 2; ++ks) bq[ks] = hg_frag(qrm, 16 * tt + l15, 32 * ks + 8 * g);
#pragma unroll
          for (int si = 0; si < 2; ++si) { const int st = st0 + si; f32x4 acc = {0.f, 0.f, 0.f, 0.f};
#pragma unroll
              for (int ks = 0; ks < 2; ++ks) acc = __builtin_amdgcn_mfma_f32_16x16x32_bf16(hg_frag(krm, 16 * st + l15, 32 * ks + 8 * g), bq[ks], acc, 0, 0, 0);
              const int t = 16 * tt + l15, s0 = 16 * st + 4 * g; float v[4];
#pragma unroll
              for (int e = 0; e < 4; ++e) v[e] = (dir == 0 ? (s0 + e <= t) : (s0 + e >= t)) ? acc[e] : 0.f;
              u32x2 w; w.x = cvt_pk_bf16(v[0], v[1]); w.y = cvt_pk_bf16(v[2], v[3]);
              *(LAS u32x2*)(a2 + t * HGP + s0) = w; } } }
    __syncthreads();
    { const int tt = wv >> 1, ct0 = (wv & 1) * 2; LAS float* olds = (LAS float*)(lds + HG_O);
      f32x4 acc[2] = {{0.f, 0.f, 0.f, 0.f}, {0.f, 0.f, 0.f, 0.f}};
#pragma unroll
      for (int dir = 0; dir < 2; ++dir) {
          const LAS unsigned char* qrm = lds + (dir ? HG_QRM1 : HG_QRM0); const LAS unsigned char* a2 = lds + (dir ? HG_A21 : HG_A20); const LAS unsigned char* s2t = lds + (dir ? HG_S2T1 : HG_S2T0);
          bf16x8 aa[2], aq[2];
#pragma unroll
          for (int ks = 0; ks < 2; ++ks) { aa[ks] = hg_frag(a2, 16 * tt + l15, 32 * ks + 8 * g); aq[ks] = hg_frag(qrm, 16 * tt + l15, 32 * ks + 8 * g); }
#pragma unroll
          for (int ci = 0; ci < 2; ++ci) { const int ct = ct0 + ci;
#pragma unroll
              for (int ks = 0; ks < 2; ++ks) acc[ci] = __builtin_amdgcn_mfma_f32_16x16x32_bf16(aa[ks], hg_frag_tr(lds + HG_VT, 32 * ks, 16 * ct, lane), acc[ci], 0, 0, 0);
#pragma unroll
              for (int ks = 0; ks < 2; ++ks) acc[ci] = __builtin_amdgcn_mfma_f32_16x16x32_bf16(aq[ks], hg_frag_tr(s2t, 32 * ks, 16 * ct, lane), acc[ci], 0, 0, 0); } }
#pragma unroll
      for (int ci = 0; ci < 2; ++ci)
#pragma unroll
          for (int rr = 0; rr < 4; ++rr) olds[(16 * tt + 4 * g + rr) * 65 + 16 * (ct0 + ci) + l15] = acc[ci][rr]; }
    __syncthreads();
    { const int tok = tid >> 3, pc = tid & 7; const int row = bl * RB + hg_pos0(tc) + tok; const LAS float* olds = (const LAS float*)(lds + HG_O);
      float o[8]; float ss = 0.f;
#pragma unroll
      for (int e = 0; e < 8; ++e) { o[e] = olds[tok * 65 + pc * 8 + e]; ss += o[e] * o[e]; }
      ss += __shfl_xor(ss, 1); ss += __shfl_xor(ss, 2); ss += __shfl_xor(ss, 4);
      const float rstd = rsqrtf(ss * (1.0f / 64.0f) + EPSF);
      const float* gn = p.in[I_HGNORM] + l * 64 + pc * 8;
      float rr[8];
#pragma unroll
      for (int e = 0; e < 8; ++e) rr[e] = o[e] * rstd * gn[e] * sigmoidf_(bfw(r.g, e));
      u32x4 w; w.x = cvt_pk_bf16(rr[0], rr[1]); w.y = cvt_pk_bf16(rr[2], rr[3]); w.z = cvt_pk_bf16(rr[4], rr[5]); w.w = cvt_pk_bf16(rr[6], rr[7]);
      *(u32x4*)(p.ocat + (size_t)row * OCW + h * 64 + pc * 8) = w; }
    __syncthreads();
}

DEVI void hg_prefix(const Params& p, bool dry = false) {
    const int total = 2 * 2 * 8 * 4096;
    for (int gidx = opq_bid() * 512 + opq_tid(); gidx < total; gidx += gridDim.x * 512) {
        const int chain = gidx >> 12, e = gidx & 4095, d = e >> 6;
        bf16_t* s = p.st + (size_t)chain * NCH * 4096 + e; const float* bt = p.stb + (size_t)chain * NCH * 64 + d;
        float S = 0.f;
#pragma unroll 1
        for (int q0 = 0; q0 < NCH; q0 += 12) { float loc[12], b[12];
#pragma unroll
            for (int i = 0; i < 12; ++i) { loc[i] = bf2f(s[(size_t)(q0 + i) * 4096]); b[i] = bt[(q0 + i) * 64]; }
#pragma unroll
            for (int i = 0; i < 12; ++i) { if (!dry) s[(size_t)(q0 + i) * 4096] = f2bf(S); S = S * fast_exp2(1.44269504f * b[i]) + loc[i]; } }
        if (dry && S == 123.456f) s[0] = 0;
    }
}

constexpr int LR_UB = 0, LR_UP = 520, LR_AF = 16640, LR_IF = LR_AF + 32768, LR_AB = LR_IF + 32768, LR_IB = LR_AB + 32768;
constexpr int NT16 = RB / 16;

DEVI int lr_pos0(int tt) { return tt * 16; }
DEVI int lr_chain_pos(int tt, int dir) { return dir ? (NT16 - 1 - tt) : (tt < 512 ? tt + 16 : tt - 512); }

struct LruW { bf16x8 b[2][4][2]; float ba[4], bx[4], la[4]; };
DEVI void lru_load_w(const Params& p, int l, int dir, int n, int l15, int g, LruW& w) {
#pragma unroll
    for (int which = 0; which < 2; ++which)
#pragma unroll
        for (int ct = 0; ct < 4; ++ct)
#pragma unroll
            for (int ks = 0; ks < 2; ++ks)
                w.b[which][ct][ks] = *(const bf16x8*)(p.wlru + ((((size_t)(l * 2 + dir) * 8 + n) * 2 + which) * 64 + 16 * ct + l15) * 64 + 32 * ks + 8 * g);
#pragma unroll
    for (int ct = 0; ct < 4; ++ct) { const int c = (l * 2 + dir) * 512 + n * 64 + 16 * ct + l15;
        w.ba[ct] = p.in[I_LBA][c]; w.bx[ct] = p.in[I_LBX][c]; w.la[ct] = p.lrula[c]; }
}
struct LrIn { bf16_t x[19]; bf16_t y[16]; float h_in; };
template <int MODE> DEVI void lru_load(const Params& p, int u, LrIn& r) {
    const int bl = u / NT16, tt = u % NT16, c = opq_tid();
    const int pos0 = tt * 16, seg0 = tt < 512 ? 0 : SEQ, seg1 = tt < 512 ? SEQ : RB;
    const bf16_t* xx = p.pa + (size_t)bl * RB * PA_W + C_LX + c;
#pragma unroll
    for (int i = 0; i < 19; ++i) { const int pos = pos0 - 2 + i; r.x[i] = (pos >= seg0 && pos < seg1) ? xx[(size_t)pos * PA_W] : (bf16_t)0; }
    if (MODE == 2) { const bf16_t* yy = p.pa + ((size_t)bl * RB + pos0) * PA_W + C_LY + c;
#pragma unroll
        for (int t = 0; t < 16; ++t) r.y[t] = yy[(size_t)t * PA_W]; }
    if (MODE == 1) r.h_in = p.lin[((size_t)(bl * 2 + 0) * NT16 + lr_chain_pos(tt, 0)) * 512 + c];
    if (MODE == 2) r.h_in = p.lin[((size_t)(bl * 2 + 1) * NT16 + lr_chain_pos(tt, 1)) * 512 + c];
}
#define LR_WAVE_SYNC() do { asm volatile("s_waitcnt lgkmcnt(0)" ::: "memory"); __builtin_amdgcn_wave_barrier(); } while (0)
DEVI void lru_tile_gates(const Params& p, int l, LAS unsigned char* lds, const LrIn& in, const LruW& w) {
    const int tid = opq_tid(), lane = tid & 63, n = tid >> 6, l15 = lane & 15, g = lane >> 4;
    LAS bf16_t* ub = (LAS bf16_t*)(lds + LR_UB);
    {
        const int c = tid;
        const float* cw = p.in[I_CONVW] + (size_t)l * 4 * 512; const float w0 = cw[c], w1 = cw[512 + c], w2 = cw[1024 + c], w3 = cw[1536 + c], cb = p.in[I_CONVB][l * 512 + c];
        float x[19];
#pragma unroll
        for (int i = 0; i < 19; ++i) x[i] = bf2f(in.x[i]);
#pragma unroll
        for (int t = 0; t < 16; ++t) ub[t * LR_UP + c] = f2bf(cb + w0 * x[t] + w1 * x[t + 1] + w2 * x[t + 2] + w3 * x[t + 3]);
    }
    LR_WAVE_SYNC();
    bf16x8 af[2];
#pragma unroll
    for (int ks = 0; ks < 2; ++ks) af[ks] = *(const LAS bf16x8*)(ub + l15 * LR_UP + n * 64 + 32 * ks + 8 * g);
    LAS float* aL = (LAS float*)(lds + LR_AF); LAS float* iL = (LAS float*)(lds + LR_IF);
#pragma unroll
    for (int ct = 0; ct < 4; ++ct) {
        f32x4 ra = {0.f, 0.f, 0.f, 0.f}, xa = {0.f, 0.f, 0.f, 0.f};
#pragma unroll
        for (int ks = 0; ks < 2; ++ks) { ra = __builtin_amdgcn_mfma_f32_16x16x32_bf16(af[ks], w.b[0][ct][ks], ra, 0, 0, 0); xa = __builtin_amdgcn_mfma_f32_16x16x32_bf16(af[ks], w.b[1][ct][ks], xa, 0, 0, 0); }
        const int c = n * 64 + 16 * ct + l15;
#pragma unroll
        for (int r = 0; r < 4; ++r) { const int t = 4 * g + r;
            const float rg = sigmoidf_(ra[r] + w.ba[ct]), ig = sigmoidf_(xa[r] + w.bx[ct]);
            const float a = fast_exp2(rg * w.la[ct]); const float uu = bf2f(ub[t * LR_UP + c]);
            aL[t * 512 + c] = a; iL[t * 512 + c] = __builtin_amdgcn_sqrtf(fmaxf(1.0f - a * a, 0.f)) * ig * uu; }
    }
    LR_WAVE_SYNC();
}
template <int MODE> DEVI void lru_sweep(const Params& p, int l, LAS unsigned char* lds, int dir, int u0, int uend, int ubase, bool skipc) {
    const int tid = opq_tid(), lane = tid & 63, n = tid >> 6, l15 = lane & 15, g = lane >> 4, G = gridDim.x;
    if (u0 >= uend) return;
    LruW w; lru_load_w(p, l, dir, n, l15, g, w);
    const LAS float* aL = (const LAS float*)(lds + LR_AF); const LAS float* iL = (const LAS float*)(lds + LR_IF);
    LrIn cur, nxt; lru_load<MODE>(p, u0 - ubase, cur);
    for (int u = u0; u < uend; u += G) {
        const bool more = u + G < uend; if (more) lru_load<MODE>(p, u + G - ubase, nxt);
        const int uu = u - ubase, bl = uu / NT16, tt = uu % NT16;
        if (!(skipc && tt >= 512)) {
            lru_tile_gates(p, l, lds, cur, w);
            if (MODE == 0) { float A = 1.f, H = 0.f;
#pragma unroll
                for (int t = 0; t < 16; ++t) { const float a = aL[t * 512 + tid], b = iL[t * 512 + tid]; if (dir == 0) { H = a * H + b; A *= a; } else { H += b * A; A *= a; } }
                *((f32x2_t*)p.lsum + ((size_t)(bl * 2 + dir) * NT16 + lr_chain_pos(tt, dir)) * 512 + tid) = (f32x2_t){A, H};
            } else { bf16_t* ocol = p.ocat + ((size_t)bl * RB + lr_pos0(tt)) * OCW + 1024 + tid; float h = cur.h_in;
                if (MODE == 1) {
#pragma unroll
                    for (int t = 0; t < 16; ++t) { h = aL[t * 512 + tid] * h + iL[t * 512 + tid]; ocol[(size_t)t * OCW] = f2bf(h); }
                } else {
                    float hfv[16];
#pragma unroll
                    for (int t = 0; t < 16; ++t) hfv[t] = bf2f(ocol[(size_t)t * OCW]);
#pragma unroll
                    for (int t = 15; t >= 0; --t) { h = aL[t * 512 + tid] * h + iL[t * 512 + tid];
                        const float y = bf2f(cur.y[t]); const float x3 = 0.7978845608028654f * (y + 0.044715f * y * y * y);
                        const float th = 1.0f - 2.0f * fast_rcp(1.0f + fast_exp2(2.88539008f * x3));
                        ocol[(size_t)t * OCW] = f2bf((hfv[t] + h) * 0.5f * y * (1.0f + th)); } }
            }
            LR_WAVE_SYNC();
        }
        if (more) cur = nxt;
    }
}
DEVI void lru_prefix(const Params& p, bool dry = false) {
    const int lane = opq_tid() & 63, wv = opq_tid() >> 6;
    for (int chain = opq_bid() * 8 + wv; chain < 2 * 2 * 512; chain += gridDim.x * 8) {
        const int c = chain & 511, bd = chain >> 9;
        const f32x2_t* src = (const f32x2_t*)p.lsum + (size_t)bd * NT16 * 512 + c; float* dst = p.lin + (size_t)bd * NT16 * 512 + c;
        f32x2_t v[9]; float A = 1.f, H = 0.f;
#pragma unroll
        for (int i = 0; i < 9; ++i) { const int q = lane * 9 + i; v[i] = (q < NT16) ? src[(size_t)q * 512] : (f32x2_t){1.f, 0.f}; H = v[i].x * H + v[i].y; A *= v[i].x; }
#pragma unroll
        for (int o = 1; o < 64; o <<= 1) { const float Ap = __shfl_up(A, o), Hp = __shfl_up(H, o); if (lane >= o) { H = A * Hp + H; A = A * Ap; } }
        float h = __shfl_up(H, 1); if (lane == 0) h = 0.f;
#pragma unroll
        for (int i = 0; i < 9; ++i) { const int q = lane * 9 + i; if (q < NT16 && !dry) dst[(size_t)q * 512] = h; h = v[i].x * h + v[i].y; }
        if (dry && h == 123.456f) dst[0] = 0.f;
    }
}
DEVI void phase_attn_scan1(const Params& p, int l, LAS unsigned char* lds, int parts = 7) {
    const int nA = 2 * 8 * 16 + (l == 0 ? 16 : 0), nH = 2 * 8 * NCH, nL = 2 * NT16, G = gridDim.x;
    const float accinit = attn_offset(p, l);
    int u = opq_bid();
    for (; u < 256; u += G) { const int bl = u >> 7, h = (u >> 4) & 7, qb = u & 15; if (!(parts & 1)) continue;
        attn_unit(p, lds, p.q + ((size_t)(bl * 8 + h) * SEQ + qb * 512) * 96, 512, p.kv + (size_t)(bl * 8 + h) * NCH * KVT_BYTES, NCH,
                  p.ocat + (size_t)(bl * RB + qb * 512) * OCW + 512 + h * 64, accinit); }
    for (; u < nA; u += G) { const int uu = u - 256, bl = uu >> 3, h = uu & 7; if (!(parts & 1)) continue;
        attn_unit(p, lds, p.qc + ((size_t)(bl * 8 + h) * CTX) * 96, 256, p.kv + ((size_t)(bl * 8 + h) * NCH + 128) * KVT_BYTES, 4,
                  p.ocat + (size_t)(bl * RB + SEQ) * OCW + 512 + h * 64, accinit); }
    if (parts & 2) { HgIn cur, nxt; if (u < nA + nH) hg_load<false>(p, u - nA, cur);
        for (; u < nA + nH; u += G) { const bool more = u + G < nA + nH; if (more) hg_load<false>(p, u + G - nA, nxt); hg_pass1_unit(p, l, lds, u - nA, cur); if (more) cur = nxt; } }
    else { for (; u < nA + nH; u += G) {} }
    if (parts & 4) { lru_sweep<0>(p, l, lds, 0, u, nA + nH + nL, nA + nH, false); lru_sweep<0>(p, l, lds, 1, u, nA + nH + nL, nA + nH, false); }
}
DEVI void phase_prefix(const Params& p, LAS unsigned char* lds, bool dry = false) { (void)lds; hg_prefix(p, dry); lru_prefix(p, dry); }
DEVI void phase_scan3(const Params& p, int l, LAS unsigned char* lds, int parts = 3) {
    const int nH = 2 * 8 * NCH, nL = 2 * NT16, G = gridDim.x; const bool skipc = (l == DEPTH - 1);
    int u = opq_bid();
    if (parts & 1) { HgIn cur, nxt; if (u < nH) hg_load<true>(p, u, cur);
        for (; u < nH; u += G) { const bool more = u + G < nH; if (more) hg_load<true>(p, u + G, nxt);
            if (!(skipc && (u % NCH) >= 128)) hg_pass3_unit(p, l, lds, u, cur);
            if (more) cur = nxt; } }
    else { for (; u < nH; u += G) {} }
    if (parts & 2) { lru_sweep<1>(p, l, lds, 0, u, nH + nL, nH, skipc); lru_sweep<2>(p, l, lds, 1, u, nH + nL, nH, skipc); }
}

constexpr int RP = 2 * TT + 4096;

DEVI void phase_norm2_route(const Params& p, int l, LAS unsigned char* lds) {
    const int tid = opq_tid(), lane = tid & 63, wv = tid >> 6; const bool skipc = (l == DEPTH - 1);
    LAS int* cntl = (LAS int*)lds;
    LAS int* basel = cntl + 16;
    LAS int* rinfo = cntl + 64;
    LAS float* rw = (LAS float*)(rinfo + 4 * 8 * 20);
    if (tid < 16) cntl[tid] = 0;
    LAS float* Wt = (LAS float*)(lds + 8192);
    { const float* wrg = p.in[I_WRG] + (size_t)l * DM * 4; const float* wre = p.in[I_WRE] + (size_t)l * DM * 16;
      for (int i = tid; i < DM * 4; i += 512) Wt[(i & 3) * DM + (i >> 2)] = wrg[i];
      for (int i = tid; i < DM * 16; i += 512) Wt[(4 + (i & 15)) * DM + (i >> 4)] = wre[i]; }
    __syncthreads();
    const float* gm = p.in[I_NFFN] + l * DM;
    const int rstep = gridDim.x * 8, rfirst = opq_bid() * 8 + wv;
    f32x4 vn[2][4];
#pragma unroll
    for (int q = 0; q < 2; ++q) { const int rq = rfirst + q * rstep; if (rq < TT) { const float* s0 = xbuf_row(p, rq);
#pragma unroll
        for (int i = 0; i < 4; ++i) vn[q][i] = *(const f32x4*)(s0 + i * 256 + lane * 4); } }
    for (int r = rfirst, it = 0; r < TT; r += 2 * rstep, it += 2) {
        f32x4 hh[2][4]; bool live[2];
#pragma unroll
        for (int q = 0; q < 2; ++q) {
            const int rq = r + q * rstep; f32x4 v[4];
#pragma unroll
            for (int i = 0; i < 4; ++i) v[i] = vn[q][i];
            if (rq + 2 * rstep < TT) { const float* s1 = xbuf_row(p, rq + 2 * rstep);
#pragma unroll
                for (int i = 0; i < 4; ++i) vn[q][i] = *(const f32x4*)(s1 + i * 256 + lane * 4); }
            live[q] = rq < TT && !(skipc && (rq % RB) >= SEQ);
            if (rq < TT && !live[q] && lane == 0) rinfo[((it + q) * 8 + wv) * 4] = -1;
            float ss = 0.f;
#pragma unroll
            for (int i = 0; i < 4; ++i) ss += v[i][0] * v[i][0] + v[i][1] * v[i][1] + v[i][2] * v[i][2] + v[i][3] * v[i][3];
            ss = wave_sum(ss);
            const float rstd = rsqrtf(ss * (1.0f / DM) + EPSF);
            const int rr = live[q] ? rq : rfirst;
            const float* mv = p.modv + ((size_t)l * 5 + mod_row(rr)) * 6144;
#pragma unroll
            for (int i = 0; i < 4; ++i) { const int c = i * 256 + lane * 4;
                const f32x4 g = *(const f32x4*)(gm + c), sh = *(const f32x4*)(mv + 3072 + c), sc = *(const f32x4*)(mv + 4096 + c);
#pragma unroll
                for (int e = 0; e < 4; ++e) hh[q][i][e] = live[q] ? v[i][e] * rstd * g[e] * (1.0f + sc[e]) + sh[e] : 0.f;
                if (live[q]) { u32x2 w; w.x = cvt_pk_bf16(hh[q][i][0], hh[q][i][1]); w.y = cvt_pk_bf16(hh[q][i][2], hh[q][i][3]);
                    *(u32x2*)(p.h2 + (size_t)rq * DM + c) = w; } }
        }
        float red[2][32];
#pragma unroll
        for (int j = 0; j < 32; ++j) { float a0 = 0.f, a1 = 0.f;
            if (j < 20) {
#pragma unroll
                for (int i = 0; i < 4; ++i) { const f32x4 w4 = *(const LAS f32x4*)(Wt + j * DM + i * 256 + lane * 4);
                    a0 += hh[0][i][0] * w4[0] + hh[0][i][1] * w4[1] + hh[0][i][2] * w4[2] + hh[0][i][3] * w4[3];
                    a1 += hh[1][i][0] * w4[0] + hh[1][i][1] * w4[1] + hh[1][i][2] * w4[2] + hh[1][i][3] * w4[3]; } }
            red[0][j] = a0; red[1][j] = a1; }
#pragma unroll
        for (int q = 0; q < 2; ++q) {
#pragma unroll
            for (int lvl = 0; lvl < 5; ++lvl) { const int half = 16 >> lvl, bit = 32 >> lvl; const bool hi = (lane & bit) != 0;
#pragma unroll
                for (int i = 0; i < half; ++i) { const float snd = hi ? red[q][i] : red[q][i + half]; const float keep = hi ? red[q][i + half] : red[q][i];
                    red[q][i] = keep + __shfl_xor(snd, bit); } }
            red[q][0] += __shfl_xor(red[q][0], 1);
        }
#pragma unroll
        for (int q = 0; q < 2; ++q) {
            float lgt[20];
#pragma unroll
            for (int j = 0; j < 20; ++j) lgt[j] = __builtin_bit_cast(float, __builtin_amdgcn_readlane(__builtin_bit_cast(int, red[q][0]), 2 * j));
            const f32x4 lg = {lgt[0], lgt[1], lgt[2], lgt[3]}, le0 = {lgt[4], lgt[5], lgt[6], lgt[7]}, le1 = {lgt[8], lgt[9], lgt[10], lgt[11]},
                        le2 = {lgt[12], lgt[13], lgt[14], lgt[15]}, le3 = {lgt[16], lgt[17], lgt[18], lgt[19]};
            if (lane == 0 && live[q]) {
                const float* brg = p.in[I_BRG] + l * 4; const float* bre = p.in[I_BRE] + l * 16;
                int gs = 0; float best = lg[0] + brg[0];
#pragma unroll
                for (int e = 1; e < 4; ++e) { const float t = lg[e] + brg[e]; if (t > best) { best = t; gs = e; } }
                const float m = fmaxf(fmaxf(lg[0], lg[1]), fmaxf(lg[2], lg[3]));
                const float e0 = __expf(lg[0] - m), e1 = __expf(lg[1] - m), e2 = __expf(lg[2] - m), e3 = __expf(lg[3] - m);
                const float pg = (gs == 0 ? e0 : gs == 1 ? e1 : gs == 2 ? e2 : e3) / (e0 + e1 + e2 + e3);
                const f32x4 lv = (gs == 0) ? le0 : (gs == 1) ? le1 : (gs == 2) ? le2 : le3;
                const f32x4 bv = lv + *(const f32x4*)(bre + gs * 4);
                int i0 = 0; float m0 = bv[0], l0 = lv[0];
#pragma unroll
                for (int e = 1; e < 4; ++e) if (bv[e] > m0) { m0 = bv[e]; i0 = e; l0 = lv[e]; }
                int i1 = -1; float m1 = -3.0e38f, l1 = 0.f;
#pragma unroll
                for (int e = 0; e < 4; ++e) if (e != i0 && bv[e] > m1) { m1 = bv[e]; i1 = e; l1 = lv[e]; }
                const float mm = fmaxf(l0, l1), x0 = __expf(l0 - mm), x1 = __expf(l1 - mm);
                const float w0 = x0 / (x0 + x1) * pg, w1 = x1 / (x0 + x1) * pg;
                const int ea = gs * 4 + i0, eb = gs * 4 + i1;
                const int sa = __hip_atomic_fetch_add(&cntl[ea], 1, __ATOMIC_RELAXED, __HIP_MEMORY_SCOPE_WORKGROUP), sb = __hip_atomic_fetch_add(&cntl[eb], 1, __ATOMIC_RELAXED, __HIP_MEMORY_SCOPE_WORKGROUP);
                const int qi = ((it + q) * 8 + wv) * 4; rinfo[qi] = ea; rinfo[qi + 1] = eb; rinfo[qi + 2] = sa; rinfo[qi + 3] = sb;
                rw[((it + q) * 8 + wv) * 2] = w0; rw[((it + q) * 8 + wv) * 2 + 1] = w1;
            }
        }
    }
    __syncthreads();
    if (tid < 16) basel[tid] = (int)atomicAdd(&p.ctrl[CTRL_CNT(l, tid)], (unsigned)cntl[tid]);
    __syncthreads();
    for (int r = rfirst, it = 0; r < TT; r += rstep, ++it) {
        if (lane == 0) { const int q = (it * 8 + wv) * 4; const int ea = rinfo[q];
            if (ea >= 0) { const int eb = rinfo[q + 1], sa = basel[ea] + rinfo[q + 2], sb = basel[eb] + rinfo[q + 3];
                p.tok_e[r * 2] = ea; p.tok_e[r * 2 + 1] = eb; p.tok_s[r * 2] = sa; p.tok_s[r * 2 + 1] = sb;
                p.lst[(size_t)ea * TT + sa] = r; p.lst[(size_t)eb * TT + sb] = r; p.tok_w[(size_t)ea * TT + sa] = rw[(it * 8 + wv) * 2]; p.tok_w[(size_t)eb * TT + sb] = rw[(it * 8 + wv) * 2 + 1]; } }
    }
    __syncthreads();
}

DEVI void moe_offsets(const Params& p, int l, LAS int* offs) {
    if (opq_tid() == 0) { int o = 0;
        for (int e = 0; e < NEXP; ++e) { offs[e] = o; const int c = (int)__hip_atomic_load(&p.ctrl[CTRL_CNT(l, e)], __ATOMIC_RELAXED, __HIP_MEMORY_SCOPE_AGENT); offs[32 + e] = c; o += (c + 255) & ~255; }
        offs[NEXP] = o; }
    __syncthreads();
}
DEVI int moe_expert_of(const LAS int* offs, int row) { int e = 0;
#pragma unroll
    for (int q = 1; q < NEXP; ++q) e += (row >= offs[q]) ? 1 : 0;
    return e; }

DEVI void phase_moe_permute(const Params& p, int l, const LAS int* offs) {
    const int lane = opq_tid() & 63, wv = opq_tid() >> 6; const int R = offs[NEXP];
    for (int pr = opq_bid() * 8 + wv; pr < R; pr += gridDim.x * 8) {
        const int e = moe_expert_of(offs, pr), s = pr - offs[e]; const bool valid = s < offs[32 + e];
        u32x4 a = {0u, 0u, 0u, 0u}, b = {0u, 0u, 0u, 0u}; int r = 0; float w = 0.f;
        const int vz = vzero();
        if (valid) { r = p.lst[(size_t)e * TT + s + vz]; w = p.tok_w[(size_t)e * TT + s + vz];
            const u32x4* src = (const u32x4*)(p.h2 + (size_t)r * DM); a = src[lane]; b = src[64 + lane]; }
        u32x4* dst = (u32x4*)(p.h2p + (size_t)pr * DM); dst[lane] = a; dst[64 + lane] = b;
        if (lane == 0) { p.rww[pr] = w; p.rmr[pr] = valid ? mod_row(r) : 0; }
    }
}

template <bool GATH> struct MoeSched { static constexpr bool GATHER = GATH; const int* lst; int cnt[NEXP]; int G, c, nN; int o[NEXP + 1]; const char* A; const char* B; size_t atile, bexp, btile;
    DEVI void load(const LAS int* offs) {
#pragma unroll
        for (int q = 0; q <= NEXP; ++q) o[q] = __builtin_amdgcn_readfirstlane(offs[q]);
#pragma unroll
        for (int q = 0; q < NEXP; ++q) cnt[q] = __builtin_amdgcn_readfirstlane(offs[32 + q]); }
    DEVI int row_of(const g8::Unit& u, int r) const { int base = 0, n = 0;
#pragma unroll
        for (int q = 0; q < NEXP; ++q) { base = (u.tag == q) ? o[q] : base; n = (u.tag == q) ? cnt[q] : n; }
        const int s2 = u.pm * 256 + r - base; return (s2 < n) ? lst[(size_t)u.tag * TT + s2] : 0; }
    DEVI bool next(int i, g8::Unit& u) const { const long L = (long)i * G + c; const int R = o[NEXP]; if (L >= (long)(R / 256) * nN) return false;
        const int ti = (int)(L / nN), pn = (int)(L % nN); int e = 0;
#pragma unroll
        for (int q = 1; q < NEXP; ++q) e += (ti * 256 >= o[q]) ? 1 : 0;
        u.pm = ti; u.pn = pn; u.tag = e; u.a = A + (size_t)ti * atile; u.b = B + (size_t)e * bexp + (size_t)pn * btile; return true; } };
struct EpiSwiglu {
    static constexpr bool PERM = false, HAS_MID = false; static constexpr int NSEG = 1;
    bf16_t* hid;
    DEVI void operator()(const f32x4 (&acc)[2][2][4][2], const g8::Unit& u, int wr, int wc, int fr, int fq) const {
        const int row0 = u.pm * 256 + wr * 64 + fr, col0 = u.pn * 128 + wc * 32 + 4 * fq;
#pragma unroll
        for (int ai = 0; ai < 2; ++ai)
#pragma unroll
            for (int m = 0; m < 4; ++m)
#pragma unroll
                for (int n = 0; n < 2; ++n) { const f32x4 a = acc[ai][0][m][n], b = acc[ai][1][m][n]; float h[4];
#pragma unroll
                    for (int e = 0; e < 4; ++e) h[e] = a[e] * sigmoidf_(a[e]) * b[e];
                    u32x2 w; w.x = cvt_pk_bf16(h[0], h[1]); w.y = cvt_pk_bf16(h[2], h[3]);
                    *(u32x2*)(hid + (size_t)(row0 + ai * 128 + m * 16) * DEXP + col0 + n * 16) = w; }
    }
};
DEVI void phase_moe_up(const Params& p, int l, const LAS int* offs, LAS unsigned char* lds) {
    MoeSched<true> S; S.lst = p.lst; S.G = gridDim.x; S.c = opq_bid(); S.nN = 2; S.load(offs); S.A = (const char*)p.h2; S.B = (const char*)(p.w13 + (size_t)l * NEXP * 512 * DM);
    S.atile = 0; S.bexp = (size_t)512 * DM * 2; S.btile = (size_t)256 * DM * 2;
    EpiSwiglu E; E.hid = p.hid;
    g8::gemm_phase(lds, DM, DM, DM, S, E);
}
struct EpiDown {
    static constexpr bool PERM = true, HAS_MID = false; static constexpr int NSEG = 1;
    bf16_t* yo; const float* tokw; const LAS int* offs;
    DEVI void operator()(const f32x4 (&acc)[2][2][4][2], const g8::Unit& u, int wr, int wc, int fr, int fq) const {
        const int row0 = u.pm * 256 + wr * 64 + fr, col0 = u.pn * 256 + wc * 32 + 8 * fq;
        const int e = u.tag, base = offs[e], n = offs[32 + e];
        float wrow[2][4];
#pragma unroll
        for (int ai = 0; ai < 2; ++ai)
#pragma unroll
            for (int m = 0; m < 4; ++m) { const int s2 = row0 + ai * 128 + m * 16 - base; wrow[ai][m] = (s2 < n) ? tokw[(size_t)e * TT + s2] : 0.f; }
#pragma unroll
        for (int ai = 0; ai < 2; ++ai)
#pragma unroll
            for (int m = 0; m < 4; ++m) { const int row = row0 + ai * 128 + m * 16; const float w = wrow[ai][m];
#pragma unroll
                for (int bj = 0; bj < 2; ++bj) { const f32x4 v0 = acc[ai][bj][m][0] * w, v1 = acc[ai][bj][m][1] * w;
                    u32x4 o; o.x = cvt_pk_bf16(v0[0], v0[1]); o.y = cvt_pk_bf16(v0[2], v0[3]); o.z = cvt_pk_bf16(v1[0], v1[1]); o.w = cvt_pk_bf16(v1[2], v1[3]);
                    *(u32x4*)(yo + (size_t)row * DM + col0 + bj * 128) = o; } }
    }
};
DEVI void phase_moe_down(const Params& p, int l, const LAS int* offs, LAS unsigned char* lds) {
    MoeSched<false> S; S.lst = p.lst; S.G = gridDim.x; S.c = opq_bid(); S.nN = 4; S.load(offs); S.A = (const char*)p.hid; S.B = (const char*)(p.w2 + (size_t)l * NEXP * DM * DEXP);
    S.atile = (size_t)256 * DEXP * 2; S.bexp = (size_t)DM * DEXP * 2; S.btile = (size_t)256 * DEXP * 2;
    EpiDown E; E.yo = p.yo; E.tokw = p.tok_w; E.offs = offs;
    g8::gemm_phase(lds, DEXP, DEXP, DEXP, S, E);
}
DEVI void phase_moe_combine(const Params& p, int l, const LAS int* offs, bool dry = false) {
    const int lane = opq_tid() & 63, wv = opq_tid() >> 6; const bool skipc = (l == DEPTH - 1);
    for (int r = opq_bid() * 8 + wv; r < TT; r += gridDim.x * 8) {
        const int pos = r % RB; if (skipc && pos >= SEQ) continue;
        float* x = xbuf_row(p, r);
        const int vz = vzero();
        const int pr0 = offs[p.tok_e[r * 2 + vz]] + p.tok_s[r * 2 + vz], pr1 = offs[p.tok_e[r * 2 + 1 + vz]] + p.tok_s[r * 2 + 1 + vz];
        const bf16_t* y0 = p.yo + (size_t)pr0 * DM; const bf16_t* y1 = p.yo + (size_t)pr1 * DM;
        const float* g2 = p.modv + ((size_t)l * 5 + mod_row(r)) * 6144 + 5120;
#pragma unroll
        for (int i = 0; i < 4; ++i) { const int c = i * 256 + lane * 4; f32x4 v = *(const f32x4*)(x + c);
            const u32x2 a = *(const u32x2*)(y0 + c), b = *(const u32x2*)(y1 + c);
            const f32x4 gv = *(const f32x4*)(g2 + c);
            v[0] += gv[0] * (__uint_as_float(a.x << 16) + __uint_as_float(b.x << 16)); v[1] += gv[1] * (__uint_as_float(a.x & 0xffff0000u) + __uint_as_float(b.x & 0xffff0000u));
            v[2] += gv[2] * (__uint_as_float(a.y << 16) + __uint_as_float(b.y << 16)); v[3] += gv[3] * (__uint_as_float(a.y & 0xffff0000u) + __uint_as_float(b.y & 0xffff0000u));
            if (!dry || v[0] == 123.456f) *(f32x4*)(x + c) = v; }
    }
}

#ifndef MK_PHASE_KERNELS
#define MK_PHASE_KERNELS 0
#endif
constexpr int LDS_SCRATCH = 1024;

template <class T> DEVI T* uni_ptr(T* x) { const unsigned long long v = (unsigned long long)x;
    const unsigned lo = __builtin_amdgcn_readfirstlane((unsigned)v), hi = __builtin_amdgcn_readfirstlane((unsigned)(v >> 32));
    return (T*)(((unsigned long long)hi << 32) | lo); }
DEVI Params ldparams(const PL& s) {
    Params q;
#pragma unroll
    for (int i = 0; i < 35; ++i) q.in[i] = uni_ptr(s.in[i]);
#define LDP(f) q.f = uni_ptr(s.f)
    LDP(out); LDP(ctrl); LDP(modv); LDP(lbv); LDP(xc); LDP(rope); LDP(lrula); LDP(winA); LDP(winG); LDP(wup); LDP(wcat); LDP(wout); LDP(w13); LDP(w2); LDP(wlru);
    LDP(hx); LDP(pa); LDP(up); LDP(q); LDP(qc); LDP(kv); LDP(st); LDP(stb); LDP(lsum); LDP(lin); LDP(ocat); LDP(y); LDP(h2); LDP(h2p); LDP(hid); LDP(yo);
    LDP(tok_e); LDP(tok_s); LDP(tok_w); LDP(lst); LDP(rww); LDP(rmr);
#undef LDP
    q.pad_ = 0ull;
    return q;
}
#ifndef WAITPROBE
#define WAITPROBE (-1)
#endif
#ifndef WAITSEL
#define WAITSEL (-1)
#endif
#ifndef BODYSEL
#define BODYSEL (-1)
#endif
DEVI void grid_sync(const PL& s, LAS unsigned char* smem, int phid = -2) {
    XcdBarrier b; b.bar = uni_ptr(s.ctrl); b.x = xb_xcc_id(); b.st = (volatile LAS unsigned*)smem;
#if WAITPROBE >= 0
    unsigned long long t0 = 0; if (threadIdx.x == 0) t0 = __builtin_amdgcn_s_memrealtime();
    xcd_barrier(b);
    if (threadIdx.x == 0 && BODYSEL < 0 && (WAITSEL < 0 || phid == WAITSEL)) { LAS unsigned long long* acc = (LAS unsigned long long*)(smem + 32); *acc += __builtin_amdgcn_s_memrealtime() - t0; }
#else
    xcd_barrier(b);
#endif
}
DEVI void probe_dump(const Params& p, const bf16_t* src, size_t n) {
    const size_t NOUT = (size_t)NB * SEQ * DM;
    for (size_t i = (size_t)opq_bid() * 512 + opq_tid(); i < NOUT; i += (size_t)gridDim.x * 512) { float s = 0.f;
        for (size_t k = i; k < n; k += NOUT) s += (float)src[k];
        p.out[i] = s; }
}
#define PROBE_AT(id, buf, n) if (PROBE_STOP == (id) && l == 0 && hb == 0) { { const Params p = ldparams(pl); probe_dump(p, (const bf16_t*)(buf), (n)); } return; }
#ifndef PROBE_STOP
#define PROBE_STOP 0
#endif
#ifndef DUP_MASK
#define DUP_MASK 0
#endif
#define PHASE_D(bit, call, dupcall) PHASE(call); if ((DUP_MASK >> (bit)) & 1) { PHASE(dupcall); }
#define PHASE_I(id, call) do { unsigned long long tb_ = 0; if (BODYSEL == (id) && threadIdx.x == 0) tb_ = __builtin_amdgcn_s_memrealtime(); \
        { const Params p = ldparams(pl); call; } \
        if (BODYSEL == (id)) { __syncthreads(); if (threadIdx.x == 0) { LAS unsigned long long* acc = (LAS unsigned long long*)(smem + 32); *acc += __builtin_amdgcn_s_memrealtime() - tb_; } } } while (0); \
    grid_sync(pl, smem, id); if ((DUP_MASK >> 21) & 1) grid_sync(pl, smem)
#define PHASE(call) PHASE_I(-2, call)

#ifndef SELFCHECK
#define SELFCHECK 0
#endif
DEVI void chk_sum(const Params& p, int id, int rep, const void* buf, size_t nbytes) {
    const unsigned* w = (const unsigned*)buf; const size_t n = nbytes / 4; unsigned long long s = 0ull;
    for (size_t i = (size_t)opq_bid() * 512 + opq_tid(); i < n; i += (size_t)gridDim.x * 512) s += (unsigned long long)w[i] * (unsigned long long)((i & 1023) + 1);
    unsigned lo = (unsigned)s, hi = (unsigned)(s >> 32);
    for (int o = 32; o >= 1; o >>= 1) { const unsigned l2 = __shfl_xor(lo, o), h2 = __shfl_xor(hi, o); const unsigned long long t = (((unsigned long long)hi << 32) | lo) + (((unsigned long long)h2 << 32) | l2); lo = (unsigned)t; hi = (unsigned)(t >> 32); }
    if ((opq_tid() & 63) == 0) atomicAdd((unsigned long long*)(p.ctrl + 6144) + (rep * 32 + id), (((unsigned long long)hi << 32) | lo));
}
#define CHK(id, buf, nbytes) do { const Params p = ldparams(pl); chk_sum(p, id, rep, buf, nbytes); } while (0); grid_sync(pl, smem)

__global__ void __launch_bounds__(512, 2) hybrid_flow_backbone_kernel(Params pk) {
    extern __shared__ __attribute__((aligned(16))) unsigned char smem_raw[];
    LAS unsigned char* smem = (LAS unsigned char*)smem_raw;
    LAS unsigned char* lds = smem + LDS_SCRATCH; LAS int* offs = (LAS int*)(smem + 64);
    static_assert(sizeof(Params) % 8 == 0 && sizeof(Params) <= LDS_SCRATCH - 256, "Params must fit its LDS slot");
    { (void)pk;
      const __attribute__((address_space(4))) unsigned long long* src = (const __attribute__((address_space(4))) unsigned long long*)__builtin_amdgcn_kernarg_segment_ptr();
      LAS unsigned long long* dst = (LAS unsigned long long*)(smem + 256);
      if (threadIdx.x < sizeof(Params) / 8) dst[threadIdx.x] = src[threadIdx.x]; }
    if (threadIdx.x == 0) { *(LAS u32x4*)smem = (u32x4){0u, 0u, 0u, 0u}; *(LAS unsigned long long*)(smem + 32) = 0ull; }
    __syncthreads();
    const PL& pl = *(const PL*)(smem + 256);
    (void)xcd_barrier_post(uni_ptr(pl.ctrl), (volatile LAS unsigned*)smem);
    { unsigned long long tb_ = 0; if (BODYSEL == 0 && threadIdx.x == 0) tb_ = __builtin_amdgcn_s_memrealtime(); phase_prep(pl, lds);
      if (BODYSEL == 0) { __syncthreads(); if (threadIdx.x == 0) *(LAS unsigned long long*)(smem + 32) += __builtin_amdgcn_s_memrealtime() - tb_; } }
    grid_sync(pl, smem, 0);
    if ((DUP_MASK >> 16) & 1) { phase_prep(pl, lds); grid_sync(pl, smem); }
#if SELFCHECK
    for (int rep = 0; rep < SELFCHECK; ++rep) {
        const int l = 0, hb = 0;
        PHASE(phase_norm1(p, l, hb));          CHK(1, p.hx, (size_t)HR * DM * 2);
        PHASE(phase_inproj_a(p, l, lds));      CHK(2, p.pa, (size_t)HR * PA_W * 2);
        PHASE(phase_mla_up(p, l, lds));        CHK(3, p.up, (size_t)HR * UPW * 2);
        PHASE(phase_qkv(p, l, lds));           CHK(4, p.q, (size_t)2 * 8 * SEQ * 96 * 2); CHK(5, p.qc, (size_t)2 * 8 * CTX * 96 * 2);
        PHASE(phase_attn_scan1(p, l, lds));    CHK(6, p.st, (size_t)2 * 2 * 8 * NCH * 4096 * 2); CHK(7, p.stb, (size_t)2 * 2 * 8 * NCH * 64 * 4); CHK(8, p.lsum, (size_t)2 * 2 * NT16 * 512 * 2 * 4);
        PHASE(phase_prefix(p, lds));                CHK(9, p.st, (size_t)2 * 2 * 8 * NCH * 4096 * 2); CHK(10, p.lin, (size_t)2 * 2 * NT16 * 512 * 4);
        PHASE(phase_scan3(p, l, lds));         CHK(11, p.ocat, (size_t)HR * OCW * 2);
        PHASE(phase_inproj_g(p, l, lds));      CHK(12, p.pa, (size_t)HR * PG_W * 2);
        PHASE(phase_merge(p, l, lds));         CHK(13, p.y, (size_t)HR * DM * 2);
        PHASE(phase_outproj(p, l, hb, lds));   CHK(14, p.out, (size_t)2 * SEQ * DM * 4); CHK(15, p.xc, (size_t)2 * CTX * DM * 4);
    }
    {   const Params p = ldparams(pl);
        const size_t NOUT = (size_t)NB * SEQ * DM;
        for (size_t i = (size_t)opq_bid() * 512 + opq_tid(); i < NOUT; i += (size_t)gridDim.x * 512) p.out[i] = 0.f;
        __syncthreads();
        if (opq_bid() == 0 && opq_tid() == 0) { int first = 0; const unsigned long long* c = (const unsigned long long*)(p.ctrl + 6144);
            for (int id = 15; id >= 1; --id) for (int rep = 1; rep < SELFCHECK; ++rep)
                if (__hip_atomic_load(c + rep * 32 + id, __ATOMIC_RELAXED, __HIP_MEMORY_SCOPE_AGENT) != __hip_atomic_load(c + id, __ATOMIC_RELAXED, __HIP_MEMORY_SCOPE_AGENT)) first = id;
            p.out[0] = 1000.0f * (float)first; }
    }
    return;
#endif
    for (int l = 0; l < DEPTH; ++l) {
        for (int hb = 0; hb < 2; ++hb) {
            if (l == 0 && hb == 0) { PHASE_D(0, phase_norm1(p, l, hb), phase_norm1(p, l, hb)); }
            PHASE_I(2, phase_inproj_a(p, l, lds));
            PHASE_I(3, phase_mla_up(p, l, lds));
            PHASE_I(4, phase_qkv(p, l, lds));
            PHASE_I(5, phase_attn_scan1(p, l, lds));
            if ((DUP_MASK >> 4) & 1) { PHASE(phase_attn_scan1(p, l, lds, 1)); }
            if ((DUP_MASK >> 5) & 1) { PHASE(phase_attn_scan1(p, l, lds, 2)); }
            if ((DUP_MASK >> 6) & 1) { PHASE(phase_attn_scan1(p, l, lds, 4)); }
            PHASE_I(6, phase_prefix(p, lds));
            if ((DUP_MASK >> 17) & 1) { PHASE(phase_prefix(p, lds, true)); }
            PHASE_I(7, phase_scan3(p, l, lds));
            if ((DUP_MASK >> 7) & 1) { PHASE(phase_scan3(p, l, lds, 1)); }
            if ((DUP_MASK >> 8) & 1) { PHASE(phase_scan3(p, l, lds, 2)); }
            PHASE_I(8, phase_inproj_g(p, l, lds));
            PHASE_I(9, phase_merge(p, l, lds));
            PHASE_I(10, phase_outproj(p, l, hb, lds); if (hb == 0) phase_norm1(p, l, 1));
            if (((DUP_MASK >> 11) & 1) && l == 0) { PHASE(phase_outproj(p, l, hb, lds)); }
            if ((DUP_MASK >> 15) & 1) { for (int z = 0; z < 10; ++z) grid_sync(pl, smem); }
        }
        PHASE_I(11, phase_norm2_route(p, l, lds));
        PHASE_I(12, moe_offsets(p, l, offs); phase_moe_up(p, l, offs, lds));
        PHASE_I(13, phase_moe_down(p, l, offs, lds));
        PHASE_I(14, phase_moe_combine(p, l, offs); if (l + 1 < DEPTH) phase_norm1(p, l + 1, 0));
        if ((DUP_MASK >> 19) & 1) { PHASE(phase_moe_combine(p, l, offs, true)); }
    }
#if WAITPROBE >= 0
    if (blockIdx.x == WAITPROBE && threadIdx.x == 0) {
        const unsigned long long w = *(LAS unsigned long long*)(smem + 32), t0 = __builtin_amdgcn_s_memrealtime();
        while (__builtin_amdgcn_s_memrealtime() - t0 < w) __builtin_amdgcn_s_sleep(8); }
#endif
}

static size_t align_up(size_t x, size_t a) { return (x + a - 1) / a * a; }

extern "C" void kernel_launch(void* const* d_in, const int* in_sizes, int n_in, void* d_out, int out_size, void* d_ws, size_t ws_size, hipStream_t stream) {
    (void)in_sizes; (void)n_in; (void)out_size;
    Params p; memset(&p, 0, sizeof(p));
    for (int i = 0; i < 35; ++i) p.in[i] = (const float*)d_in[i];
    p.out = (float*)d_out;
    char* w = (char*)d_ws; size_t o = 0;
    auto take = [&](size_t bytes) { char* r = w + o; o = align_up(o + bytes, 256); return r; };
    p.ctrl = (unsigned*)take(CTRL_WORDS * 4);
    p.modv = (float*)take((size_t)DEPTH * 5 * 6144 * 4);
    p.lbv = (float*)take((size_t)DEPTH * 2 * 512 * 4);
    p.xc = (float*)take((size_t)NB * CTX * DM * 4);
    p.rope = (float*)take((size_t)SEQ * 32 * 4);
    p.lrula = (float*)take((size_t)DEPTH * 2 * 512 * 4);
    p.winA = (bf16_t*)take((size_t)DEPTH * PA_W * DM * 2);
    p.winG = (bf16_t*)take((size_t)DEPTH * PG_W * DM * 2);
    p.wup = (bf16_t*)take((size_t)DEPTH * UPW * 256 * 2);
    p.wcat = (bf16_t*)take((size_t)DEPTH * DM * OCW * 2);
    p.wout = (bf16_t*)take((size_t)DEPTH * DM * DM * 2);
    p.w13 = (bf16_t*)take((size_t)DEPTH * NEXP * 512 * DM * 2);
    p.w2 = (bf16_t*)take((size_t)DEPTH * NEXP * DM * DEXP * 2);
    p.wlru = (bf16_t*)take((size_t)DEPTH * 2 * 8 * 2 * 64 * 64 * 2);
    p.tok_e = (int*)take((size_t)TT * 2 * 4); p.tok_s = (int*)take((size_t)TT * 2 * 4);
    p.lst = (int*)take((size_t)NEXP * TT * 4); p.tok_w = (float*)take((size_t)NEXP * TT * 4);
    p.rww = (float*)take((size_t)RP * 4); p.rmr = (int*)take((size_t)RP * 4);
    const size_t region = o;
    p.hx = (bf16_t*)take((size_t)HR * DM * 2);
    p.pa = (bf16_t*)take((size_t)HR * PA_W * 2);
    p.ocat = (bf16_t*)take((size_t)HR * OCW * 2);
    p.lsum = (float*)take((size_t)2 * 2 * NT16 * 512 * 2 * 4); p.lin = (float*)take((size_t)2 * 2 * NT16 * 512 * 4);
    const size_t alias1 = o;
    p.up = (bf16_t*)take((size_t)HR * UPW * 2);
    const size_t after_up = o; o = alias1;
    p.st = (bf16_t*)take((size_t)2 * 2 * 8 * NCH * 4096 * 2); p.stb = (float*)take((size_t)2 * 2 * 8 * NCH * 64 * 4);
    if (o < after_up) o = after_up;
    const size_t alias2 = o;
    p.q = (bf16_t*)take((size_t)2 * 8 * SEQ * 96 * 2); p.qc = (bf16_t*)take((size_t)2 * 8 * CTX * 96 * 2); p.kv = (unsigned char*)take((size_t)2 * 8 * NCH * KVT_BYTES);
    const size_t mixer_end = o; o = alias2;
    p.y = (bf16_t*)take((size_t)HR * DM * 2);
    size_t end1 = mixer_end > o ? mixer_end : o;
    o = region;
    p.h2 = (bf16_t*)take((size_t)TT * DM * 2);
    p.h2p = (bf16_t*)take((size_t)RP * DM * 2);
    p.hid = (bf16_t*)take((size_t)RP * DEXP * 2);
    p.yo = (bf16_t*)take((size_t)RP * DM * 2);
    const size_t need = end1 > o ? end1 : o;
    static int grid = 0;
    if (!grid) {
        int dev = 0, cus = 0, per_cu = 0; hipGetDevice(&dev); hipDeviceGetAttribute(&cus, hipDeviceAttributeMultiprocessorCount, dev);
        hipFuncSetAttribute((const void*)hybrid_flow_backbone_kernel, hipFuncAttributeMaxDynamicSharedMemorySize, LDS_TOTAL);
        hipOccupancyMaxActiveBlocksPerMultiprocessor(&per_cu, (const void*)hybrid_flow_backbone_kernel, 512, LDS_TOTAL);
        if (per_cu < 1) fprintf(stderr, "kernel_launch: occupancy query returned %d\n", per_cu);
        grid = cus * (per_cu < 1 ? 0 : 1); if (grid > 256) grid = 256;
    }
    if (need > ws_size) { fprintf(stderr, "kernel_launch: workspace too small: need %zu have %zu\n", need, ws_size); return; }
    if (grid < 8) { fprintf(stderr, "kernel_launch: grid %d too small\n", grid); return; }
    hipMemsetAsync(p.ctrl, 0, CTRL_WORDS * 4, stream);
    hipLaunchKernelGGL(hybrid_flow_backbone_kernel, dim3(grid), dim3(512), LDS_TOTAL, stream, p);
}
```

```cpp
#include <hip/hip_runtime.h>
#include <stdint.h>
#include <stdio.h>
#include <string.h>

#define LAS __attribute__((address_space(3)))
#define DEVI __device__ __forceinline__
typedef unsigned short bf16_t;
typedef short bf16x8 __attribute__((ext_vector_type(8)));
typedef float f32x4 __attribute__((ext_vector_type(4)));
typedef float f32x16 __attribute__((ext_vector_type(16)));
typedef unsigned u32x4 __attribute__((ext_vector_type(4)));
typedef unsigned u32x2 __attribute__((ext_vector_type(2)));

constexpr int NB = 4, SEQ = 8192, CTX = 256, DM = 1024, DEPTH = 2;
constexpr int RB = SEQ + CTX;
constexpr int TT = NB * RB;
constexpr int HR = 2 * RB;
constexpr int NCH = RB / 64;
constexpr int INW = 7072;
constexpr int PA_W = 4096;
constexpr int PG_W = 3072;
constexpr int C_Q = 0, C_ZF = 512, C_ZB = 1024, C_I = 1536, C_G = 2048, C_DQ = 2560, C_DKV = 2816, C_KR = 2944, C_LX = 3072, C_LY = 3584;
constexpr int UPW = 1792;
constexpr int OCW = 1536;
constexpr int KVT_BYTES = 22016;
constexpr int KT_BYTES = 13312;
constexpr int NEXP = 16, DEXP = 256;
constexpr float EPSF = 1e-6f;
constexpr int LDS_TOTAL = 160 * 1024;

DEVI float bf2f(bf16_t b) { return __uint_as_float(((unsigned)b) << 16); }
DEVI bf16_t f2bf(float f) { return __builtin_bit_cast(bf16_t, (__bf16)f); }
typedef float f32x2_t __attribute__((ext_vector_type(2)));
typedef __bf16 bf16x2_t __attribute__((ext_vector_type(2)));
DEVI unsigned cvt_pk_bf16(float lo, float hi) { const f32x2_t v = {lo, hi}; return __builtin_bit_cast(unsigned, __builtin_convertvector(v, bf16x2_t)); }
DEVI float fast_exp2(float x) { return __builtin_amdgcn_exp2f(x); }
DEVI float fast_rcp(float x) { return __builtin_amdgcn_rcpf(x); }
DEVI float sigmoidf_(float x) { return fast_rcp(1.0f + fast_exp2(-1.44269504f * x)); }
DEVI float wave_sum(float v) { for (int o = 32; o >= 1; o >>= 1) v += __shfl_xor(v, o); return v; }
DEVI float wave_max(float v) { for (int o = 32; o >= 1; o >>= 1) v = fmaxf(v, __shfl_xor(v, o)); return v; }

DEVI int opq_tid() { int t = threadIdx.x; asm volatile("" : "+v"(t)); return t; }
DEVI int opq_bid() { int b = blockIdx.x; asm volatile("" : "+s"(b)); return b; }

DEVI int vzero() { int z = 0; asm volatile("" : "+v"(z)); return z; }

#define XB_TMO      128
#define XB_XCNT(j)  (256  + 64 * (j))
#define XB_XSUB(j)  (1280 + 64 * (j))
#define XB_XGEN(j)  (2304 + 64 * (j))
#define XB_TOP      3328
#define XB_TOPGEN   3392
#define XCD_BAR_WORDS 3456
#define XB_SPIN_CAP (1u << 18)

__device__ __forceinline__ unsigned xb_ld(unsigned* p)              { return __hip_atomic_load(p, __ATOMIC_RELAXED, __HIP_MEMORY_SCOPE_AGENT); }
__device__ __forceinline__ unsigned xb_add(unsigned* p, unsigned v) { return __hip_atomic_fetch_add(p, v, __ATOMIC_RELAXED, __HIP_MEMORY_SCOPE_AGENT); }
__device__ __forceinline__ unsigned xb_xcc_id() { return (unsigned)__builtin_amdgcn_s_getreg((3 << 11) | 20) & 0xFu; }
#define XB_SPIN(cond, bar) do { unsigned _sp = 0; while (cond) { __builtin_amdgcn_s_sleep(1); \
    if ((++_sp & 255u) == 0u) { if (xb_ld(&(bar)[XB_TMO])) break; if (_sp > XB_SPIN_CAP) { atomicAdd(&(bar)[XB_TMO], 1u); break; } } } } while (0)

struct XcdBarrier { unsigned* bar; unsigned x; volatile LAS unsigned* st; };

__device__ __forceinline__ XcdBarrier xcd_barrier_post(unsigned* bar, volatile LAS unsigned* st) {
    XcdBarrier b; b.bar = bar; b.x = xb_xcc_id(); b.st = st;
    if (threadIdx.x == 0) (void)xb_add(&bar[XB_XCNT(b.x)], 1u);
    return b;
}
__device__ __forceinline__ void xcd_barrier_complete(unsigned* bar, unsigned x, unsigned& nloc, unsigned& nx) {
    const unsigned G = gridDim.x * gridDim.y * gridDim.z;
    unsigned sum, cnt, mine, sp = 0u;
    for (;;) {
        sum = 0u; cnt = 0u; mine = 0u;
#pragma unroll
        for (unsigned j = 0; j < 16; ++j) { const unsigned c = xb_ld(&bar[XB_XCNT(j)]); sum += c; cnt += (c > 0u) ? 1u : 0u; mine = (j == x) ? c : mine; }
        if (sum == G) break;
        __builtin_amdgcn_s_sleep(1);
        if ((++sp & 255u) == 0u) { if (xb_ld(&bar[XB_TMO])) break; if (sp > XB_SPIN_CAP) { atomicAdd(&bar[XB_TMO], 1u); break; } }
    }
    nloc = mine > 0u ? mine : 1u; nx = cnt > 0u ? cnt : 1u;
}
__device__ __forceinline__ void xcd_barrier(const XcdBarrier& b) {
    asm volatile("s_waitcnt vmcnt(0)" ::: "memory");
    __syncthreads();
    if (threadIdx.x == 0) {
        unsigned* bar = b.bar;
        __builtin_amdgcn_s_waitcnt(0);
        unsigned nloc = b.st[0], nx = b.st[1];
        if (nloc == 0u) { xcd_barrier_complete(bar, b.x, nloc, nx); b.st[0] = nloc; b.st[1] = nx; }
        const unsigned old = xb_add(&bar[XB_XSUB(b.x)], 1u);
        const unsigned gen = old / nloc;
        if (old + 1u == (gen + 1u) * nloc) {
            __builtin_amdgcn_fence(__ATOMIC_RELEASE, "agent");
            asm volatile("s_waitcnt vmcnt(0)" ::: "memory");
            const unsigned og = xb_add(&bar[XB_TOP], 1u);
            const unsigned tg = og / nx;
            if (og + 1u == (tg + 1u) * nx) xb_add(&bar[XB_TOPGEN], 1u);
            else XB_SPIN(xb_ld(&bar[XB_TOPGEN]) == tg, bar);
            __builtin_amdgcn_fence(__ATOMIC_ACQUIRE, "agent");
            xb_add(&bar[XB_XGEN(b.x)], 1u);
            asm volatile("s_waitcnt vmcnt(0)" ::: "memory");
        } else {
            XB_SPIN(xb_ld(&bar[XB_XGEN(b.x)]) == gen, bar);
            __builtin_amdgcn_fence(__ATOMIC_ACQUIRE, "agent");
            asm volatile("s_waitcnt vmcnt(0)" ::: "memory");
        }
    }
    __syncthreads();
}

struct Params {
    const float* in[35];
    float* out;
    unsigned* ctrl;
    float* modv;
    float* lbv;
    float* xc;
    float* lrula;
    float* rope;
    bf16_t* winA; bf16_t* winG; bf16_t* wup; bf16_t* wcat; bf16_t* wout; bf16_t* w13; bf16_t* w2; bf16_t* wlru;
    bf16_t* hx;
    bf16_t* pa;
    bf16_t* up;
    bf16_t* q; bf16_t* qc; unsigned char* kv;
    bf16_t* st; float* stb;
    float* lsum; float* lin;
    bf16_t* ocat;
    bf16_t* y;
    bf16_t* h2; bf16_t* h2p; bf16_t* hid; bf16_t* yo;
    int* tok_e; int* tok_s; float* tok_w; int* lst; float* rww; int* rmr;
    unsigned long long pad_;
};

typedef LAS Params PL;

#define CTRL_CNT(l, e) (4096 + 512 * (l) + 16 * (e))
#define CTRL_WORDS 8192

namespace g8 {
constexpr int BM = 256, BK = 64, HALF = 128, HTB = HALF * BK * 2, STAGE_BYTES = 8 * HTB, NXCD = 8, WGM = 8;
__host__ __device__ __forceinline__ int lds_byte(int r, int c) { const int st = (r >> 4) * 2 + (c >> 5), rr = r & 15, cc = c & 31, ob = rr * 64 + cc * 2; return st * 1024 + (ob ^ (((ob >> 9) & 1) << 5)); }
__host__ __device__ __forceinline__ void stage_rc(int b, int& R, int& C) { const int st = b / 1024, sb = b % 1024, swz = sb ^ (((sb >> 9) & 1) << 5); R = (st >> 1) * 16 + swz / 64; C = (st & 1) * 32 + (swz % 64) / 2; }
__host__ __device__ __forceinline__ int perm32(int rho) { const int n = rho >> 4, i = rho & 15; return 8 * (i >> 2) + 4 * n + (i & 3); }

struct Unit { int pm, pn, tag; const char* a; const char* b; };

__device__ __forceinline__ bool static_order(int i, int G, int c, int nM, int nN, int& pm, int& pn) {
    const int nwg = nM * nN; const long L = (long)i * G + c; if (L >= nwg) return false;
    int wgid = (int)L; { const int q = nwg / NXCD, r = nwg % NXCD, xcd = wgid % NXCD, off = wgid / NXCD; wgid = (xcd < r ? xcd * (q + 1) : r * (q + 1) + (xcd - r) * q) + off; }
    const int nig = WGM * nN, gid = wgid / nig, fm = gid * WGM, gsz = (nM - fm) < WGM ? (nM - fm) : WGM;
    pm = fm + ((wgid % nig) % gsz); pn = (wgid % nig) / gsz; return true;
}

template <class Epi, class Sched>
__device__ __forceinline__ void gemm_phase(LAS unsigned char* lds, const int lda, const int ldb, const int K, const Sched& S, const Epi& E) {
    const int tid = opq_tid(), wid = __builtin_amdgcn_readfirstlane(tid >> 6), lane = tid & 63, wr = wid >> 2, wc = wid & 3, fr = lane & 15, fq = lane >> 4;
    const int nt = K / BK;
    unsigned voffB[2]; int RA[2], CA[2];
#pragma unroll
    for (int i = 0; i < 2; ++i) { int R, C; stage_rc(tid * 16 + i * 8192, R, C); const int Rb = Epi::PERM ? ((R & ~31) + perm32(R & 31)) : R;
        RA[i] = R; CA[i] = C; voffB[i] = (unsigned)(Rb * ldb + C) * 2u; }
    auto set_voff = [&](const Unit& u, unsigned (&v)[2][2]) {
#pragma unroll
        for (int h = 0; h < 2; ++h)
#pragma unroll
            for (int i = 0; i < 2; ++i) { if constexpr (Sched::GATHER) v[h][i] = (unsigned)S.row_of(u, h * HALF + RA[i]) * (unsigned)(lda * 2) + (unsigned)CA[i] * 2u;
                else v[h][i] = (unsigned)((h * HALF + RA[i]) * lda + CA[i]) * 2u; } };
    const size_t kstep = (size_t)(BK * 2);
    const size_t hstepB = (size_t)HALF * ldb * 2;
    const unsigned ldsw = (unsigned)wid * 1024u;
    const int aoff = lds_byte(wr * 64 + fr, fq * 8), boff = lds_byte(wc * 32 + fr, fq * 8);
#define G8_SA(b, h) (((b) * 2 + (h)) * HTB)
#define G8_SB(b, h) ((4 + (b) * 2 + (h)) * HTB)
#define G8_STAGE(bufoff, gbase, voff) do { _Pragma("unroll") for (int _i = 0; _i < 2; ++_i) \
        __builtin_amdgcn_global_load_lds((const unsigned*)((const char*)(gbase) + (voff)[_i]), (LAS unsigned*)(lds + (bufoff) + ldsw + _i * 8192), 16, 0, 0); } while (0)
#define G8_LDA(dst, b, h) do { _Pragma("unroll") for (int m = 0; m < 4; ++m) _Pragma("unroll") for (int k = 0; k < 2; ++k) dst[m][k] = *(const LAS bf16x8*)(lds + G8_SA(b, h) + aoff + m * 2048 + k * 1024); } while (0)
#define G8_LDB(dst, b, h) do { _Pragma("unroll") for (int n = 0; n < 2; ++n) _Pragma("unroll") for (int k = 0; k < 2; ++k) dst[n][k] = *(const LAS bf16x8*)(lds + G8_SB(b, h) + boff + n * 2048 + k * 1024); } while (0)
#define G8_MMA(ai, bj, At, Bt) do { __builtin_amdgcn_s_setprio(1); _Pragma("unroll") for (int m = 0; m < 4; ++m) _Pragma("unroll") for (int n = 0; n < 2; ++n) _Pragma("unroll") for (int k = 0; k < 2; ++k) \
        acc[ai][bj][m][n] = __builtin_amdgcn_mfma_f32_16x16x32_bf16(Bt[n][k], At[m][k], acc[ai][bj][m][n], 0, 0, 0); __builtin_amdgcn_s_setprio(0); } while (0)
#define G8_WAIT_V(n) asm volatile("s_waitcnt vmcnt(" #n ")" ::: "memory")
#define G8_WAIT_L(n) asm volatile("s_waitcnt lgkmcnt(" #n ")" ::: "memory")
#define G8_BAR __builtin_amdgcn_s_barrier()
#define G8_SCHED __builtin_amdgcn_sched_barrier(0)
    Unit cur, nxt; int ui = 0;
    if (!S.next(0, cur)) return;
    f32x4 acc[2][2][4][2];
#pragma unroll
    for (int a = 0; a < 2; ++a)
#pragma unroll
        for (int b = 0; b < 2; ++b)
#pragma unroll
            for (int m = 0; m < 4; ++m)
#pragma unroll
                for (int n = 0; n < 2; ++n) acc[a][b][m][n] = (f32x4){0.f, 0.f, 0.f, 0.f};
    bf16x8 At[4][2], B0[2][2], B1[2][2];
    const char* cA = cur.a; const char* cB = cur.b;
    unsigned vcur[2][2], vnxt[2][2]; set_voff(cur, vcur);
    asm volatile("s_waitcnt lgkmcnt(0)" ::: "memory");
    if constexpr (Sched::GATHER) asm volatile("s_waitcnt vmcnt(0)" ::: "memory");
    G8_STAGE(G8_SB(0, 0), cB, voffB); G8_STAGE(G8_SA(0, 0), cA, vcur[0]); G8_STAGE(G8_SB(0, 1), cB + hstepB, voffB); G8_STAGE(G8_SA(0, 1), cA, vcur[1]);
    if (wr == 1) G8_BAR;
    G8_WAIT_V(4); G8_BAR;
    G8_STAGE(G8_SB(1, 0), cB + kstep, voffB); G8_STAGE(G8_SA(1, 0), cA + kstep, vcur[0]); G8_STAGE(G8_SB(1, 1), cB + hstepB + kstep, voffB);
    G8_WAIT_V(6); G8_BAR;
    for (;;) {
        const bool has_next = S.next(ui + 1, nxt);
        const char* nA = has_next ? nxt.a : cA; const char* nB = has_next ? nxt.b : cB;
        if (has_next) set_voff(nxt, vnxt); else {
#pragma unroll
            for (int h = 0; h < 2; ++h) { vnxt[h][0] = vcur[h][0]; vnxt[h][1] = vcur[h][1]; } }
        asm volatile("s_waitcnt lgkmcnt(0)" ::: "memory");
        const int tseg = nt / Epi::NSEG;
#pragma unroll 1
        for (int sg = 0; sg < Epi::NSEG; ++sg) {
#pragma unroll 1
        for (int t = sg * tseg; t < (sg + 1) * tseg; t += 2) {
            const bool last = (t == nt - 2);
            const char* a1 = cA + (size_t)(t + 1) * kstep;
            const char* a2 = last ? nA : cA + (size_t)(t + 2) * kstep; const char* b2 = last ? nB : cB + (size_t)(t + 2) * kstep;
            const char* a3 = a2 + kstep; const char* b3 = b2 + kstep;
            unsigned v20[2], v21[2];
#pragma unroll
            for (int i = 0; i < 2; ++i) { v20[i] = last ? vnxt[0][i] : vcur[0][i]; v21[i] = last ? vnxt[1][i] : vcur[1][i]; }
            G8_LDB(B0, 0, 0); G8_SCHED; G8_LDA(At, 0, 0); G8_STAGE(G8_SA(1, 1), a1, vcur[1]);
            G8_WAIT_L(8); G8_BAR; G8_WAIT_L(0); G8_MMA(0, 0, At, B0); G8_BAR; G8_SCHED;
            G8_LDB(B1, 0, 1); G8_STAGE(G8_SB(0, 0), b2, voffB);
            G8_BAR; G8_WAIT_L(0); G8_MMA(0, 1, At, B1); G8_BAR;
            G8_LDA(At, 0, 1); G8_STAGE(G8_SA(0, 0), a2, v20);
            G8_BAR; G8_WAIT_L(0); G8_MMA(1, 0, At, B0); G8_BAR; G8_SCHED;
            G8_STAGE(G8_SB(0, 1), b2 + hstepB, voffB);
            G8_WAIT_V(6); G8_BAR; G8_MMA(1, 1, At, B1); G8_BAR;
            G8_LDB(B0, 1, 0); G8_SCHED; G8_LDA(At, 1, 0); G8_STAGE(G8_SA(0, 1), a2, v21);
            G8_WAIT_L(8); G8_BAR; G8_WAIT_L(0); G8_MMA(0, 0, At, B0); G8_BAR; G8_SCHED;
            G8_LDB(B1, 1, 1); G8_STAGE(G8_SB(1, 0), b3, voffB);
            G8_BAR; G8_WAIT_L(0); G8_MMA(0, 1, At, B1); G8_BAR;
            G8_LDA(At, 1, 1); G8_STAGE(G8_SA(1, 0), a3, v20);
            G8_BAR; G8_WAIT_L(0); G8_MMA(1, 0, At, B0); G8_BAR; G8_SCHED;
            G8_STAGE(G8_SB(1, 1), b3 + hstepB, voffB);
            G8_WAIT_V(6); G8_BAR; G8_MMA(1, 1, At, B1); G8_BAR;
        }
        if constexpr (Epi::NSEG > 1) { if (sg + 1 < Epi::NSEG) E.mid(sg, acc, cur, wr, wc, fr, fq); }
        }
        E(acc, cur, wr, wc, fr, fq);
        if (!has_next) break;
#pragma unroll
        for (int a = 0; a < 2; ++a)
#pragma unroll
            for (int b = 0; b < 2; ++b)
#pragma unroll
                for (int m = 0; m < 4; ++m)
#pragma unroll
                    for (int n = 0; n < 2; ++n) acc[a][b][m][n] = (f32x4){0.f, 0.f, 0.f, 0.f};
        cur = nxt; cA = nA; cB = nB; ++ui;
#pragma unroll
        for (int h = 0; h < 2; ++h) { vcur[h][0] = vnxt[h][0]; vcur[h][1] = vnxt[h][1]; }
    }
    G8_WAIT_V(0);
    if (wr == 0) G8_BAR;
    G8_BAR;
#undef G8_SA
#undef G8_SB
#undef G8_STAGE
#undef G8_LDA
#undef G8_LDB
#undef G8_MMA
#undef G8_WAIT_V
#undef G8_WAIT_L
#undef G8_BAR
#undef G8_SCHED
}
}

enum { I_X = 0, I_C, I_CTX, I_CCTX, I_WMOD, I_BMOD, I_NMIX, I_NFFN, I_WIN, I_HGLB, I_HGNORM, I_QNORM, I_KVNORM, I_WUQ, I_WUKV, I_GQ, I_GK,
       I_CONVW, I_CONVB, I_LWA, I_LBA, I_LWX, I_LBX, I_LAM, I_BRHG, I_BRMLA, I_BRLRU, I_WOUT, I_WRG, I_BRG, I_WRE, I_BRE, I_W1, I_W3, I_W2 };

DEVI const float* xin_row_l0(const Params& p, int r) { const int b = r / RB, pos = r - b * RB;
    return pos < SEQ ? p.in[I_X] + ((size_t)b * SEQ + pos) * DM : p.in[I_CTX] + ((size_t)b * CTX + (pos - SEQ)) * DM; }
DEVI float* xbuf_row(const Params& p, int r) { const int b = r / RB, pos = r - b * RB;
    return pos < SEQ ? p.out + ((size_t)b * SEQ + pos) * DM : p.xc + ((size_t)b * CTX + (pos - SEQ)) * DM; }
DEVI int mod_row(int r) { const int b = r / RB, pos = r - b * RB; return pos < SEQ ? b : 4; }

struct TrJob { const float* src; int ld; int K; int ncols; bf16_t* dst; int dld; const float* ks; };

DEVI int tr_job_count() { return DEPTH * (12 + 16 * 5 + 32); }
template <class P> DEVI TrJob tr_job(const P& p, int j) {
    const int per = 12 + 16 * 5 + 32; const int l = j / per; int q = j - l * per; TrJob t; t.ks = nullptr; t.src = nullptr;
    const float* win = p.in[I_WIN] + (size_t)l * DM * INW;
    bf16_t* winA = p.winA + (size_t)l * PA_W * DM; bf16_t* wup = p.wup + (size_t)l * UPW * 256; bf16_t* wcat = p.wcat + (size_t)l * DM * OCW;
    if (q == 0) { t.src = win; t.ld = INW; t.K = DM; t.ncols = 2944; t.dst = winA; t.dld = DM; return t; }
    if (q == 11) { t.src = win + 2944; t.ld = INW; t.K = DM; t.ncols = 32; t.dst = winA + (size_t)2944 * DM; t.dld = DM; return t; }
    if (q == 1) { t.src = nullptr; t.ld = 0; t.K = DM; t.ncols = 96; t.dst = winA + (size_t)2976 * DM; t.dld = DM; return t; }
    if (q == 2) { t.src = win + 2976; t.ld = INW; t.K = DM; t.ncols = 1024; t.dst = winA + (size_t)3072 * DM; t.dld = DM; return t; }
    if (q == 3) { t.src = win + 4000; t.ld = INW; t.K = DM; t.ncols = PG_W; t.dst = p.winG + (size_t)l * PG_W * DM; t.dld = DM; return t; }
    if (q == 4) { t.src = p.in[I_WUQ] + (size_t)l * 256 * 768; t.ld = 768; t.K = 256; t.ncols = 768; t.dst = wup; t.dld = 256; t.ks = p.in[I_QNORM] + l * 256; return t; }
    if (q == 5) { t.src = p.in[I_WUKV] + (size_t)l * 128 * 1024; t.ld = 1024; t.K = 128; t.ncols = 1024; t.dst = wup + (size_t)768 * 256; t.dld = 256; t.ks = p.in[I_KVNORM] + l * 128; return t; }
    if (q == 6) { t.src = nullptr; t.ld = 0; t.K = 128; t.ncols = 1024; t.dst = wup + (size_t)768 * 256 + 128; t.dld = 256; return t; }
    if (q >= 7 && q <= 9) { const int i = q - 7; const float* s = (i == 0 ? p.in[I_BRHG] : i == 1 ? p.in[I_BRMLA] : p.in[I_BRLRU]) + (size_t)l * 512 * DM;
        t.src = s; t.ld = DM; t.K = 512; t.ncols = DM; t.dst = wcat + i * 512; t.dld = OCW; return t; }
    if (q == 10) { t.src = p.in[I_WOUT] + (size_t)l * DM * DM; t.ld = DM; t.K = DM; t.ncols = DM; t.dst = p.wout + (size_t)l * DM * DM; t.dld = DM; return t; }
    q -= 12;
    if (q < 80) { const int e = q / 5, s = q % 5; const size_t le = (size_t)l * NEXP + e;
        if (s < 4) { const int pn = s >> 1, which = s & 1;
            t.src = (which ? p.in[I_W3] : p.in[I_W1]) + le * DM * DEXP + pn * 128; t.ld = DEXP; t.K = DM; t.ncols = 128;
            t.dst = p.w13 + le * 512 * DM + (size_t)(pn * 256 + which * 128) * DM; t.dld = DM; return t; }
        t.src = p.in[I_W2] + le * DEXP * DM; t.ld = DM; t.K = DEXP; t.ncols = DM; t.dst = p.w2 + le * DM * DEXP; t.dld = DEXP; return t; }
    q -= 80;
    { const int d = q >> 4, n = (q >> 1) & 7, which = q & 1;
      const size_t blk = (((size_t)l * 2 + d) * 8 + n);
      t.src = (which ? p.in[I_LWX] : p.in[I_LWA]) + blk * 64 * 64; t.ld = 64; t.K = 64; t.ncols = 64;
      t.dst = p.wlru + (blk * 2 + which) * 64 * 64; t.dld = 64; return t; }
}

template <class P> DEVI void phase_prep(const P& p, LAS unsigned char* lds) {
    const int tid = opq_tid(), G = gridDim.x;
    LAS float* tl = (LAS float*)lds;
    int rot = 0; const int nj = tr_job_count();
    for (int j = 0; j < nj; ++j) {
        const TrJob t = tr_job(p, j);
        const bool wide = (t.ncols & 63) == 0;
        const int tw = wide ? 64 : 32, tk = t.K / 64, ntile = tk * (t.ncols / tw);
        const int first = (int)((opq_bid() + (unsigned)G - (unsigned)(rot % G)) % (unsigned)G);
        if (wide) {
            for (int tile0 = first; tile0 < ntile; tile0 += 4 * G) {
                f32x4 v[4][2];
#pragma unroll
                for (int q = 0; q < 4; ++q) { const int tile = tile0 + q * G; const int k0 = (tile % tk) * 64, n0 = (tile / tk) * 64; const int n4 = tid & 15, kr = tid >> 4;
#pragma unroll
                    for (int i = 0; i < 2; ++i) { const int k = kr + 32 * i; f32x4 x = {0.f, 0.f, 0.f, 0.f};
                        if (tile < ntile && t.src) { x = *(const f32x4*)(t.src + (size_t)(k0 + k) * t.ld + n0 + n4 * 4); if (t.ks) x *= t.ks[k0 + k]; }
                        v[q][i] = x; } }
#pragma unroll
                for (int q = 0; q < 4; ++q) { const int n4 = tid & 15, kr = tid >> 4;
#pragma unroll
                    for (int i = 0; i < 2; ++i) { LAS float* d = tl + q * 4160 + (kr + 32 * i) * 65 + n4 * 4; d[0] = v[q][i][0]; d[1] = v[q][i][1]; d[2] = v[q][i][2]; d[3] = v[q][i][3]; } }
                __syncthreads();
#pragma unroll
                for (int q = 0; q < 4; ++q) { const int tile = tile0 + q * G; if (tile < ntile) { const int k0 = (tile % tk) * 64, n0 = (tile / tk) * 64; const int n = tid >> 3, k8 = (tid & 7) * 8;
                    const LAS float* sp = tl + q * 4160 + k8 * 65 + n;
                    u32x4 w; w.x = cvt_pk_bf16(sp[0], sp[65]); w.y = cvt_pk_bf16(sp[130], sp[195]); w.z = cvt_pk_bf16(sp[260], sp[325]); w.w = cvt_pk_bf16(sp[390], sp[455]);
                    *(u32x4*)(t.dst + (size_t)(n0 + n) * t.dld + k0 + k8) = w; } }
                __syncthreads();
            }
        } else {
            for (int tile0 = first; tile0 < ntile; tile0 += 8 * G) {
                float v[8][4];
#pragma unroll
                for (int q = 0; q < 8; ++q) { const int tile = tile0 + q * G; const int k0 = (tile % tk) * 64, n0 = (tile / tk) * 32; const int n = tid & 31, kr = tid >> 5;
#pragma unroll
                    for (int i = 0; i < 4; ++i) { const int k = kr + 16 * i; float x = 0.f;
                        if (tile < ntile && t.src) { x = t.src[(size_t)(k0 + k) * t.ld + n0 + n]; if (t.ks) x *= t.ks[k0 + k]; }
                        v[q][i] = x; } }
#pragma unroll
                for (int q = 0; q < 8; ++q) { const int n = tid & 31, kr = tid >> 5;
#pragma unroll
                    for (int i = 0; i < 4; ++i) tl[q * 2112 + (kr + 16 * i) * 33 + n] = v[q][i]; }
                __syncthreads();
#pragma unroll
                for (int q = 0; q < 8; ++q) { const int tile = tile0 + q * G; if (tile < ntile) { const int k0 = (tile % tk) * 64, n0 = (tile / tk) * 32; const int k = tid & 63, nn = tid >> 6;
#pragma unroll
                    for (int i = 0; i < 4; ++i) { const int n = nn + 8 * i; t.dst[(size_t)(n0 + n) * t.dld + k0 + k] = f2bf(tl[q * 2112 + k * 33 + n]); } } }
                __syncthreads();
            }
        }
        rot += ntile;
    }
    {
        LAS float* sl = (LAS float*)lds;
        LAS float* red = sl + 5 * 1024;
        for (int i = tid; i < 5 * 1024; i += 512) { const int r = i >> 10, k = i & 1023; const float v = r < 4 ? p.in[I_C][r * DM + k] : p.in[I_CCTX][k]; sl[i] = v * sigmoidf_(v); }
        __syncthreads();
        for (int u = opq_bid(); u < DEPTH * 96; u += G) {
            const int l = u / 96, n0 = (u % 96) * 64, col = tid & 63, ks = tid >> 6;
            const float* w = p.in[I_WMOD] + (size_t)l * DM * 6144 + n0 + col;
            float a0 = 0.f, a1 = 0.f, a2 = 0.f, a3 = 0.f, a4 = 0.f;
#pragma unroll 8
            for (int k = ks * 128; k < ks * 128 + 128; ++k) { const float wv = w[(size_t)k * 6144];
                a0 += sl[k] * wv; a1 += sl[1024 + k] * wv; a2 += sl[2048 + k] * wv; a3 += sl[3072 + k] * wv; a4 += sl[4096 + k] * wv; }
            red[(ks * 5 + 0) * 64 + col] = a0; red[(ks * 5 + 1) * 64 + col] = a1; red[(ks * 5 + 2) * 64 + col] = a2; red[(ks * 5 + 3) * 64 + col] = a3; red[(ks * 5 + 4) * 64 + col] = a4;
            __syncthreads();
            if (tid < 320) { const int r = tid >> 6, c2 = tid & 63; float s = p.in[I_BMOD][l * 6144 + n0 + c2];
#pragma unroll
                for (int q = 0; q < 8; ++q) s += red[(q * 5 + r) * 64 + c2];
                p.modv[((size_t)l * 5 + r) * 6144 + n0 + c2] = s; }
            __syncthreads();
        }
    }
    for (int i = opq_bid() * 512 + tid; i < SEQ * 16; i += G * 512) { const int pos = i >> 4, a = i & 15;
        const float inv = exp2f(-(float)(a & 7) * (13.287712379549449f / 8.0f)); const float ang = (float)((a < 8) ? (pos >> 6) : (pos & 63)) * inv;
        float sn, cs; sincosf(ang, &sn, &cs); p.rope[(size_t)pos * 32 + a] = cs; p.rope[(size_t)pos * 32 + 16 + a] = sn; }
    if (opq_bid() == 1) { for (int i = tid; i < DEPTH * 2 * 512; i += 512) p.lrula[i] = -8.0f * 1.44269504f * log1pf(__expf(-p.in[I_LAM][i])); }
    if (opq_bid() == 0) {
        for (int i = tid; i < 2 * 512; i += 512) { const float a0 = p.in[I_HGLB][i], a1 = p.in[I_HGLB][1024 + i]; const float m = fmaxf(a0, a1);
            const float e0 = __expf(a0 - m), e1 = __expf(a1 - m); p.lbv[i] = 0.f; p.lbv[1024 + i] = e1 / (e0 + e1); }
    }
}

DEVI void phase_norm1(const Params& p, int l, int hb) {
    const int lane = opq_tid() & 63, wv = opq_tid() >> 6;
    const float* gm = p.in[I_NMIX] + l * DM;
    const int rstep = gridDim.x * 8, rfirst = opq_bid() * 8 + wv;
    auto rowp = [&](int rl) -> const float* { const int r = hb * HR + rl; return (l == 0) ? xin_row_l0(p, r) : (const float*)xbuf_row(p, r); };
    f32x4 vn[4];
    if (rfirst < HR) { const float* s0 = rowp(rfirst);
#pragma unroll
        for (int i = 0; i < 4; ++i) vn[i] = *(const f32x4*)(s0 + i * 256 + lane * 4); }
    for (int rl = rfirst; rl < HR; rl += rstep) {
        const int r = hb * HR + rl;
        f32x4 v[4]; float ss = 0.f;
#pragma unroll
        for (int i = 0; i < 4; ++i) { v[i] = vn[i]; ss += v[i][0] * v[i][0] + v[i][1] * v[i][1] + v[i][2] * v[i][2] + v[i][3] * v[i][3]; }
        if (rl + rstep < HR) { const float* s1 = rowp(rl + rstep);
#pragma unroll
            for (int i = 0; i < 4; ++i) vn[i] = *(const f32x4*)(s1 + i * 256 + lane * 4); }
        ss = wave_sum(ss);
        const float rstd = rsqrtf(ss * (1.0f / DM) + EPSF);
        const float* mv = p.modv + ((size_t)l * 5 + mod_row(r)) * 6144;
#pragma unroll
        for (int i = 0; i < 4; ++i) { const int c = i * 256 + lane * 4;
            const f32x4 g = *(const f32x4*)(gm + c), sh = *(const f32x4*)(mv + c), sc = *(const f32x4*)(mv + 1024 + c);
            f32x4 h;
#pragma unroll
            for (int e = 0; e < 4; ++e) h[e] = v[i][e] * rstd * g[e] * (1.0f + sc[e]) + sh[e];
            u32x2 w; w.x = cvt_pk_bf16(h[0], h[1]); w.y = cvt_pk_bf16(h[2], h[3]);
            *(u32x2*)(p.hx + (size_t)rl * DM + c) = w; }
    }
}
struct TileSched {
    static constexpr bool GATHER = false;
    int nM, nN, G, c, skipctx; const char* A; const char* B; size_t atile, btile; size_t acol_bytes;
    DEVI bool next(int i, g8::Unit& u) const {
        int pm, pn; if (!g8::static_order(i, G, c, nM, nN, pm, pn)) return false;
        const int pma = skipctx ? pm + pm / 32 : pm;
        u.pm = pma; u.pn = pn; u.tag = 0; u.a = A + (size_t)pma * atile + acol_bytes; u.b = B + (size_t)pn * btile; return true; }
};

template <int ACT> struct EpiBf16 {
    static constexpr bool PERM = true, HAS_MID = false; static constexpr int NSEG = 1;
    bf16_t* O; int ldc;
    DEVI void operator()(const f32x4 (&acc)[2][2][4][2], const g8::Unit& u, int wr, int wc, int fr, int fq) const {
        const int row0 = u.pm * 256 + wr * 64 + fr, col0 = u.pn * 256 + wc * 32 + 8 * fq;
#pragma unroll
        for (int ai = 0; ai < 2; ++ai)
#pragma unroll
            for (int m = 0; m < 4; ++m) { bf16_t* rowp = O + (size_t)(row0 + ai * 128 + m * 16) * ldc + col0;
#pragma unroll
                for (int bj = 0; bj < 2; ++bj) { f32x4 v0 = acc[ai][bj][m][0], v1 = acc[ai][bj][m][1];
                    if (ACT == 1) {
#pragma unroll
                        for (int e = 0; e < 4; ++e) { v0[e] = sigmoidf_(v0[e]); v1[e] = sigmoidf_(v1[e]); } }
                    u32x4 w; w.x = cvt_pk_bf16(v0[0], v0[1]); w.y = cvt_pk_bf16(v0[2], v0[3]); w.z = cvt_pk_bf16(v1[0], v1[1]); w.w = cvt_pk_bf16(v1[2], v1[3]);
                    *(u32x4*)(rowp + bj * 128) = w; } }
    }
};

DEVI void phase_inproj_a(const Params& p, int l, LAS unsigned char* lds) {
    TileSched S; S.nM = HR / 256; S.nN = PA_W / 256; S.G = gridDim.x; S.c = opq_bid(); S.skipctx = 0;
    S.A = (const char*)p.hx; S.B = (const char*)(p.winA + (size_t)l * PA_W * DM); S.atile = (size_t)256 * DM * 2; S.btile = (size_t)256 * DM * 2; S.acol_bytes = 0;
    EpiBf16<0> E; E.O = p.pa; E.ldc = PA_W;
    g8::gemm_phase(lds, DM, DM, DM, S, E);
}

struct UpSched { static constexpr bool GATHER = false; int G, c; const char* A; const char* B;
    DEVI bool next(int i, g8::Unit& u) const { const long L = (long)i * G + c; if (L >= (HR / 256) * 7) return false;
        const int pm = (int)(L / 7), j = (int)(L % 7); u.pm = pm; u.pn = j; u.tag = 0;
        u.a = A + (size_t)pm * 256 * PA_W * 2 + (size_t)(j < 3 ? C_DQ : C_DKV) * 2; u.b = B + (size_t)j * 256 * 256 * 2; return true; } };
DEVI void phase_mla_up(const Params& p, int l, LAS unsigned char* lds) {
    UpSched S; S.G = gridDim.x; S.c = opq_bid(); S.A = (const char*)p.pa; S.B = (const char*)(p.wup + (size_t)l * UPW * 256);
    EpiBf16<0> E; E.O = p.up; E.ldc = UPW;
    g8::gemm_phase(lds, PA_W, 256, 256, S, E);
}

DEVI void phase_inproj_g(const Params& p, int l, LAS unsigned char* lds) {
    const int skip = (l == DEPTH - 1);
    TileSched S; S.nM = skip ? 64 : HR / 256; S.nN = PG_W / 256; S.G = gridDim.x; S.c = opq_bid(); S.skipctx = skip;
    S.A = (const char*)p.hx; S.B = (const char*)(p.winG + (size_t)l * PG_W * DM); S.atile = (size_t)256 * DM * 2; S.btile = (size_t)256 * DM * 2; S.acol_bytes = 0;
    EpiBf16<1> E; E.O = p.pa; E.ldc = PG_W;
    g8::gemm_phase(lds, DM, DM, DM, S, E);
}

struct EpiMerge {
    static constexpr bool PERM = true; static constexpr int NSEG = 3;
    const bf16_t* pg; bf16_t* Y;
    static DEVI void unpack8(const u32x4& w, float (&f)[8]) {
#pragma unroll
        for (int e = 0; e < 8; ++e) { const unsigned x = w[e >> 1]; f[e] = (e & 1) ? __uint_as_float(x & 0xffff0000u) : __uint_as_float(x << 16); } }
    DEVI void mid(int sg, f32x4 (&acc)[2][2][4][2], const g8::Unit& u, int wr, int wc, int fr, int fq) const {
        const int row0 = u.pm * 256 + wr * 64 + fr, col0 = u.pn * 256 + wc * 32 + 8 * fq;
        const bf16_t* gbase = pg + (size_t)row0 * PG_W + col0 + sg * 1024;
#pragma unroll
        for (int ai = 0; ai < 2; ++ai)
#pragma unroll
            for (int mp = 0; mp < 2; ++mp) {
#pragma unroll
                for (int mi = 0; mi < 2; ++mi) { const int m = mp * 2 + mi; const bf16_t* gp = gbase + (size_t)(ai * 128 + m * 16) * PG_W;
#pragma unroll
                    for (int bj = 0; bj < 2; ++bj) { const u32x4 a = *(const u32x4*)(gp + bj * 128), b = *(const u32x4*)(gp + 1024 + bj * 128);
                        float fa[8], fb[8]; unpack8(a, fa); unpack8(b, fb);
#pragma unroll
                        for (int e = 0; e < 8; ++e) acc[ai][bj][m][e >> 2][e & 3] *= fa[e] * fast_rcp(fmaxf(fb[e], 1e-30f)); } }
                asm volatile("" : "+v"(acc[ai][0][mp * 2][0]), "+v"(acc[ai][0][mp * 2][1]), "+v"(acc[ai][1][mp * 2][0]), "+v"(acc[ai][1][mp * 2][1]),
                                  "+v"(acc[ai][0][mp * 2 + 1][0]), "+v"(acc[ai][0][mp * 2 + 1][1]), "+v"(acc[ai][1][mp * 2 + 1][0]), "+v"(acc[ai][1][mp * 2 + 1][1]) :: "memory"); }
    }
    DEVI void operator()(f32x4 (&acc)[2][2][4][2], const g8::Unit& u, int wr, int wc, int fr, int fq) const {
        const int row0 = u.pm * 256 + wr * 64 + fr, col0 = u.pn * 256 + wc * 32 + 8 * fq;
#pragma unroll
        for (int ai = 0; ai < 2; ++ai)
#pragma unroll
            for (int mp = 0; mp < 2; ++mp) {
#pragma unroll
                for (int mi = 0; mi < 2; ++mi) { const int m = mp * 2 + mi; const size_t row = (size_t)(row0 + ai * 128 + m * 16); const bf16_t* gp = pg + row * PG_W + col0 + 2048;
#pragma unroll
                    for (int bj = 0; bj < 2; ++bj) { const u32x4 a = *(const u32x4*)(gp + bj * 128); float fa[8]; unpack8(a, fa);
                        const f32x4 v0 = acc[ai][bj][m][0], v1 = acc[ai][bj][m][1];
                        u32x4 w; w.x = cvt_pk_bf16(v0[0] * fa[0], v0[1] * fa[1]); w.y = cvt_pk_bf16(v0[2] * fa[2], v0[3] * fa[3]);
                        w.z = cvt_pk_bf16(v1[0] * fa[4], v1[1] * fa[5]); w.w = cvt_pk_bf16(v1[2] * fa[6], v1[3] * fa[7]);
                        *(u32x4*)(Y + row * DM + col0 + bj * 128) = w; } }
                asm volatile("" ::: "memory"); }
    }
};
DEVI void phase_merge(const Params& p, int l, LAS unsigned char* lds) {
    const int skip = (l == DEPTH - 1);
    TileSched S; S.nM = skip ? 64 : HR / 256; S.nN = DM / 256; S.G = gridDim.x; S.c = opq_bid(); S.skipctx = skip;
    S.A = (const char*)p.ocat; S.B = (const char*)(p.wcat + (size_t)l * DM * OCW); S.atile = (size_t)256 * OCW * 2; S.btile = (size_t)256 * OCW * 2; S.acol_bytes = 0;
    EpiMerge E; E.pg = p.pa; E.Y = p.y;
    g8::gemm_phase(lds, OCW, OCW, OCW, S, E);
}

struct EpiOut {
    static constexpr bool PERM = false, HAS_MID = false; static constexpr int NSEG = 1;
    const float* x0; const float* c0; float* xo_; float* xc_; const float* modv; int l, hb;
    DEVI void operator()(const f32x4 (&acc)[2][2][4][2], const g8::Unit& u, int wr, int wc, int fr, int fq) const {
        const int row0 = u.pm * 256 + wr * 64 + fr, col0 = u.pn * 256 + wc * 32 + 4 * fq;
#pragma unroll
        for (int ai = 0; ai < 2; ++ai)
#pragma unroll
            for (int m = 0; m < 4; ++m) { const int r = hb * HR + row0 + ai * 128 + m * 16;
                const int b = r / RB, pos = r - b * RB; const bool lat = pos < SEQ;
                const size_t xoff = lat ? ((size_t)b * SEQ + pos) * DM : ((size_t)b * CTX + (pos - SEQ)) * DM;
                float* xo = (lat ? xo_ : xc_) + xoff; const float* xi = (l == 0) ? (lat ? x0 : c0) + xoff : (const float*)xo;
                const float* g1 = modv + ((size_t)l * 5 + (lat ? b : 4)) * 6144 + 2048;
#pragma unroll
                for (int bj = 0; bj < 2; ++bj)
#pragma unroll
                    for (int n = 0; n < 2; ++n) { const int c = col0 + bj * 128 + n * 16;
                        const f32x4 xv = *(const f32x4*)(xi + c), gv = *(const f32x4*)(g1 + c);
                        *(f32x4*)(xo + c) = xv + gv * acc[ai][bj][m][n]; } }
    }
};
DEVI void phase_outproj(const Params& p, int l, int hb, LAS unsigned char* lds) {
    const int skip = (l == DEPTH - 1);
    TileSched S; S.nM = skip ? 64 : HR / 256; S.nN = DM / 256; S.G = gridDim.x; S.c = opq_bid(); S.skipctx = skip;
    S.A = (const char*)p.y; S.B = (const char*)(p.wout + (size_t)l * DM * DM); S.atile = (size_t)256 * DM * 2; S.btile = (size_t)256 * DM * 2; S.acol_bytes = 0;
    EpiOut E; E.x0 = p.in[I_X]; E.c0 = p.in[I_CTX]; E.xo_ = p.out; E.xc_ = p.xc; E.modv = p.modv; E.l = l; E.hb = hb;
    g8::gemm_phase(lds, DM, DM, DM, S, E);
}

DEVI void phase_qkv(const Params& p, int l, LAS unsigned char* lds) {
    const int tid = opq_tid(), lane = tid & 63, wv = tid >> 6, h = lane >> 3, sub = lane & 7;
    LAS bf16_t* vt = (LAS bf16_t*)lds;
    const float* gq = p.in[I_GQ] + l * 96; const float* gk = p.in[I_GK] + l * 96;
    float gqn[8], gkn[8], gqr[4], gkr[4];
#pragma unroll
    for (int e = 0; e < 8; ++e) { gqn[e] = gq[sub * 8 + e]; gkn[e] = gk[sub * 8 + e]; }
#pragma unroll
    for (int e = 0; e < 4; ++e) { gqr[e] = gq[64 + sub * 4 + e]; gkr[e] = gk[64 + sub * 4 + e]; }
    const float qscale = 0.10206207261596577f * 1.4426950408889634f;
    const bool need_ctx_q = (l < DEPTH - 1);
    const bool upper = (sub & 4) != 0;
    struct QkIn { u32x2 dqw; unsigned dkw; u32x2 krw; u32x4 qnw; u32x2 qrw; u32x4 knw, vw; f32x4 cs4, sn4; };
    auto load_rows = [&](int u, QkIn (&r)[2]) {
        const int bl = u / (NCH * 4), tile = (u >> 2) % NCH, qtr = u & 3;
#pragma unroll
        for (int it = 0; it < 2; ++it) { const int pos = tile * 64 + qtr * 16 + wv * 2 + it, rl = bl * RB + pos;
            const bf16_t* prow = p.pa + (size_t)rl * PA_W; const bf16_t* urow = p.up + (size_t)rl * UPW;
            r[it].dqw = *(const u32x2*)(prow + C_DQ + lane * 4); r[it].dkw = *(const unsigned*)(prow + C_DKV + lane * 2); r[it].krw = *(const u32x2*)(prow + C_KR + sub * 4);
            r[it].qnw = *(const u32x4*)(urow + h * 96 + sub * 8); r[it].qrw = *(const u32x2*)(urow + h * 96 + 64 + sub * 4);
            r[it].knw = *(const u32x4*)(urow + 768 + h * 128 + sub * 8); r[it].vw = *(const u32x4*)(urow + 768 + h * 128 + 64 + sub * 8);
            r[it].cs4 = (f32x4){1.f, 1.f, 1.f, 1.f}; r[it].sn4 = (f32x4){0.f, 0.f, 0.f, 0.f};
            if (pos < SEQ) { const float* rt = p.rope + (size_t)pos * 32 + (sub & 3) * 4; r[it].cs4 = *(const f32x4*)rt; r[it].sn4 = *(const f32x4*)(rt + 16); } } };
    QkIn cur[2], nxt[2];
    const int nunit = 2 * NCH * 4, G = gridDim.x;
    if ((int)opq_bid() < nunit) load_rows(opq_bid(), cur);
    for (int u = opq_bid(); u < nunit; u += G) {
        const int bl = u / (NCH * 4), tile = (u >> 2) % NCH, qtr = u & 3;
        const bool more = u + G < nunit; if (more) load_rows(u + G, nxt);
#pragma unroll
        for (int it = 0; it < 2; ++it) {
            const int r16 = wv * 2 + it, rr = qtr * 16 + r16, pos = tile * 64 + rr;
            const bool lat = pos < SEQ;
            const u32x2 dqw = cur[it].dqw; const unsigned dkw = cur[it].dkw; const u32x2 krw = cur[it].krw; const u32x4 qnw = cur[it].qnw; const u32x2 qrw = cur[it].qrw;
            const u32x4 knw = cur[it].knw, vw = cur[it].vw; const f32x4 cs4 = cur[it].cs4, sn4 = cur[it].sn4;
            float sq, skv;
            { const float a0 = __uint_as_float(dqw.x << 16), a1 = __uint_as_float(dqw.x & 0xffff0000u), a2 = __uint_as_float(dqw.y << 16), a3 = __uint_as_float(dqw.y & 0xffff0000u);
              sq = a0 * a0 + a1 * a1 + a2 * a2 + a3 * a3;
              const float b0 = __uint_as_float(dkw << 16), b1 = __uint_as_float(dkw & 0xffff0000u); skv = b0 * b0 + b1 * b1; }
            sq = wave_sum(sq); skv = wave_sum(skv);
            const float rq = rsqrtf(sq * (1.0f / 256.0f) + EPSF), rkv = rsqrtf(skv * (1.0f / 128.0f) + EPSF);
            float qn[8], qr[4], kn[8], kr[4];
#pragma unroll
            for (int e = 0; e < 8; ++e) { const unsigned a = qnw[e >> 1], b = knw[e >> 1];
                qn[e] = ((e & 1) ? __uint_as_float(a & 0xffff0000u) : __uint_as_float(a << 16)) * rq;
                kn[e] = ((e & 1) ? __uint_as_float(b & 0xffff0000u) : __uint_as_float(b << 16)) * rkv; }
#pragma unroll
            for (int e = 0; e < 4; ++e) { const unsigned a = (e < 2) ? qrw.x : qrw.y, b = (e < 2) ? krw.x : krw.y;
                qr[e] = ((e & 1) ? __uint_as_float(a & 0xffff0000u) : __uint_as_float(a << 16)) * rq;
                kr[e] = ((e & 1) ? __uint_as_float(b & 0xffff0000u) : __uint_as_float(b << 16)); }
            float sqq = 0.f, skk = 0.f;
#pragma unroll
            for (int e = 0; e < 8; ++e) { sqq += qn[e] * qn[e]; skk += kn[e] * kn[e]; }
#pragma unroll
            for (int e = 0; e < 4; ++e) { sqq += qr[e] * qr[e]; skk += kr[e] * kr[e]; }
            sqq += __shfl_xor(sqq, 1); sqq += __shfl_xor(sqq, 2); sqq += __shfl_xor(sqq, 4);
            skk += __shfl_xor(skk, 1); skk += __shfl_xor(skk, 2); skk += __shfl_xor(skk, 4);
            const float rnq = rsqrtf(sqq * (1.0f / 96.0f) + EPSF) * qscale, rnk = rsqrtf(skk * (1.0f / 96.0f) + EPSF);
            float qo[12], ko[12];
#pragma unroll
            for (int e = 0; e < 8; ++e) { qo[e] = qn[e] * rnq * gqn[e]; ko[e] = kn[e] * rnk * gkn[e]; }
#pragma unroll
            for (int e = 0; e < 4; ++e) { const float a = qr[e] * rnq * gqr[e], b = kr[e] * rnk * gkr[e];
                const float pa_ = __shfl_xor(a, 4), pb_ = __shfl_xor(b, 4);
                qo[8 + e] = upper ? (a * cs4[e] + pa_ * sn4[e]) : (a * cs4[e] - pa_ * sn4[e]);
                ko[8 + e] = upper ? (b * cs4[e] + pb_ * sn4[e]) : (b * cs4[e] - pb_ * sn4[e]); }
            if (lat || need_ctx_q) {
                bf16_t* qd = lat ? p.q + (((size_t)(bl * 8 + h) * SEQ + pos) * 96) : p.qc + (((size_t)(bl * 8 + h) * CTX + (pos - SEQ)) * 96);
                u32x4 w; w.x = cvt_pk_bf16(qo[0], qo[1]); w.y = cvt_pk_bf16(qo[2], qo[3]); w.z = cvt_pk_bf16(qo[4], qo[5]); w.w = cvt_pk_bf16(qo[6], qo[7]);
                *(u32x4*)(qd + sub * 8) = w;
                u32x2 w2; w2.x = cvt_pk_bf16(qo[8], qo[9]); w2.y = cvt_pk_bf16(qo[10], qo[11]);
                *(u32x2*)(qd + 64 + sub * 4) = w2; }
            { bf16_t* kd = (bf16_t*)(p.kv + ((size_t)(bl * 8 + h) * NCH + tile) * KVT_BYTES + rr * 208);
              u32x4 w; w.x = cvt_pk_bf16(ko[0], ko[1]); w.y = cvt_pk_bf16(ko[2], ko[3]); w.z = cvt_pk_bf16(ko[4], ko[5]); w.w = cvt_pk_bf16(ko[6], ko[7]);
              *(u32x4*)(kd + sub * 8) = w;
              u32x2 w2; w2.x = cvt_pk_bf16(ko[8], ko[9]); w2.y = cvt_pk_bf16(ko[10], ko[11]);
              *(u32x2*)(kd + 64 + sub * 4) = w2; }
#pragma unroll
            for (int e = 0; e < 8; ++e) { const unsigned a = vw[e >> 1]; const float v = ((e & 1) ? __uint_as_float(a & 0xffff0000u) : __uint_as_float(a << 16)) * rkv;
                vt[(h * 64 + sub * 8 + e) * 20 + r16] = f2bf(v); }
        }
        __syncthreads();
        for (int i = tid; i < 8 * 64 * 4; i += 512) { const int hh = i >> 8, rem = i & 255, vc = rem >> 2, pc = rem & 3;
            const u32x2 w = *(const LAS u32x2*)(vt + (hh * 64 + vc) * 20 + pc * 4);
            *(u32x2*)(p.kv + ((size_t)(bl * 8 + hh) * NCH + tile) * KVT_BYTES + KT_BYTES + vc * 136 + qtr * 32 + pc * 8) = w; }
        __syncthreads();
        if (more) { cur[0] = nxt[0]; cur[1] = nxt[1]; }
    }
}

DEVI void attn_unit(const Params& p, LAS unsigned char* lds, const bf16_t* Qb, int nq, const unsigned char* kvb, int ntile, bf16_t* orow, float accinit) {
    const int tid = opq_tid(), lane = tid & 63, wv = __builtin_amdgcn_readfirstlane(tid >> 6), l31 = lane & 31, hh = lane >> 5;
    const bool active = wv * 64 < nq;
    bf16x8 qf[2][6];
#pragma unroll
    for (int qt = 0; qt < 2; ++qt)
#pragma unroll
        for (int ks = 0; ks < 6; ++ks) {
            if (active) qf[qt][ks] = *(const bf16x8*)(Qb + (size_t)(wv * 64 + qt * 32 + l31) * 96 + ks * 16 + hh * 8);
            else qf[qt][ks] = (bf16x8){0, 0, 0, 0, 0, 0, 0, 0}; }
    f32x16 O[2][2];
#pragma unroll
    for (int a = 0; a < 2; ++a)
#pragma unroll
        for (int b = 0; b < 2; ++b)
#pragma unroll
            for (int i = 0; i < 16; ++i) O[a][b][i] = 0.f;
    float lsum[2] = {0.f, 0.f};
    constexpr int STG = 2 * KVT_BYTES;
    const int nstage = ntile >> 1;
    auto stage_in = [&](int sidx, int bsel) {
        const unsigned char* g = kvb + (size_t)sidx * STG + lane * 16;
        for (int pc = wv; pc < 43; pc += 8)
            __builtin_amdgcn_global_load_lds((const unsigned*)(g + pc * 1024), (LAS unsigned*)(lds + bsel * STG + pc * 1024), 16, 0, 0);
    };
    stage_in(0, 0);
    __syncthreads();
    if (wv >= 4) __builtin_amdgcn_s_setprio(1);
    for (int sg = 0; sg < nstage; ++sg) {
        if (sg + 1 < nstage) stage_in(sg + 1, (sg + 1) & 1);
        if (active) {
#pragma unroll 1
            for (int kt = 0; kt < 4; ++kt) {
                const LAS unsigned char* kb = lds + (sg & 1) * STG + (kt >> 1) * KVT_BYTES; const LAS unsigned char* vb = kb + KT_BYTES; const int ks2 = kt & 1;
                bf16x8 kf[6];
#pragma unroll
                for (int ks = 0; ks < 6; ++ks) kf[ks] = *(const LAS bf16x8*)(kb + (ks2 * 32 + l31) * 208 + ks * 32 + hh * 16);
                bf16x8 vf[2][2];
#pragma unroll
                for (int vtile = 0; vtile < 2; ++vtile)
#pragma unroll
                    for (int s2 = 0; s2 < 2; ++s2) { const LAS unsigned char* a = vb + (vtile * 32 + l31) * 136 + (ks2 * 32 + s2 * 16 + 4 * hh) * 2;
                        const u32x2 lo = *(const LAS u32x2*)a, hi = *(const LAS u32x2*)(a + 16);
                        u32x4 w; w.x = lo.x; w.y = lo.y; w.z = hi.x; w.w = hi.y; vf[vtile][s2] = __builtin_bit_cast(bf16x8, w); }
                f32x16 S0, S1;
#pragma unroll
                for (int i = 0; i < 16; ++i) { S0[i] = accinit; S1[i] = accinit; }
#pragma unroll
                for (int ks = 0; ks < 6; ++ks) S0 = __builtin_amdgcn_mfma_f32_32x32x16_bf16(kf[ks], qf[0][ks], S0, 0, 0, 0);

#pragma unroll
                for (int ks = 0; ks < 6; ++ks) S1 = __builtin_amdgcn_mfma_f32_32x32x16_bf16(kf[ks], qf[1][ks], S1, 0, 0, 0);
                bf16x8 pb0[2], pb1[2];
                { float ls = 0.f;
#pragma unroll
                  for (int i = 0; i < 16; ++i) { S0[i] = fast_exp2(S0[i]); ls += S0[i]; }
                  lsum[0] += ls;
#pragma unroll
                  for (int s2 = 0; s2 < 2; ++s2) { u32x4 w; w.x = cvt_pk_bf16(S0[8 * s2 + 0], S0[8 * s2 + 1]); w.y = cvt_pk_bf16(S0[8 * s2 + 2], S0[8 * s2 + 3]);
                      w.z = cvt_pk_bf16(S0[8 * s2 + 4], S0[8 * s2 + 5]); w.w = cvt_pk_bf16(S0[8 * s2 + 6], S0[8 * s2 + 7]); pb0[s2] = __builtin_bit_cast(bf16x8, w); } }

#pragma unroll
                for (int s2 = 0; s2 < 2; ++s2)
#pragma unroll
                    for (int vtile = 0; vtile < 2; ++vtile) O[0][vtile] = __builtin_amdgcn_mfma_f32_32x32x16_bf16(vf[vtile][s2], pb0[s2], O[0][vtile], 0, 0, 0);
                { float ls = 0.f;
#pragma unroll
                  for (int i = 0; i < 16; ++i) { S1[i] = fast_exp2(S1[i]); ls += S1[i]; }
                  lsum[1] += ls;
#pragma unroll
                  for (int s2 = 0; s2 < 2; ++s2) { u32x4 w; w.x = cvt_pk_bf16(S1[8 * s2 + 0], S1[8 * s2 + 1]); w.y = cvt_pk_bf16(S1[8 * s2 + 2], S1[8 * s2 + 3]);
                      w.z = cvt_pk_bf16(S1[8 * s2 + 4], S1[8 * s2 + 5]); w.w = cvt_pk_bf16(S1[8 * s2 + 6], S1[8 * s2 + 7]); pb1[s2] = __builtin_bit_cast(bf16x8, w); } }

#pragma unroll
                for (int s2 = 0; s2 < 2; ++s2)
#pragma unroll
                    for (int vtile = 0; vtile < 2; ++vtile) O[1][vtile] = __builtin_amdgcn_mfma_f32_32x32x16_bf16(vf[vtile][s2], pb1[s2], O[1][vtile], 0, 0, 0);
            }
        }
        __syncthreads();
    }
    __builtin_amdgcn_s_setprio(0);
    if (active) {
#pragma unroll
        for (int qt = 0; qt < 2; ++qt) {
            const float tot = lsum[qt] + __shfl_xor(lsum[qt], 32); const float inv = 1.0f / tot;
            bf16_t* orw = orow + (size_t)(wv * 64 + qt * 32 + l31) * OCW;
#pragma unroll
            for (int vtile = 0; vtile < 2; ++vtile)
#pragma unroll
                for (int g4 = 0; g4 < 4; ++g4) { u32x2 w; w.x = cvt_pk_bf16(O[qt][vtile][4 * g4 + 0] * inv, O[qt][vtile][4 * g4 + 1] * inv);
                    w.y = cvt_pk_bf16(O[qt][vtile][4 * g4 + 2] * inv, O[qt][vtile][4 * g4 + 3] * inv);
                    *(u32x2*)(orw + vtile * 32 + 8 * g4 + 4 * hh) = w; }
        }
    }
}

DEVI float attn_offset(const Params& p, int l) {
    const int lane = opq_tid() & 63;
    const float* gq = p.in[I_GQ] + l * 96; const float* gk = p.in[I_GK] + l * 96;
    float a = fmaxf(fabsf(gq[lane]), lane < 32 ? fabsf(gq[64 + lane]) : 0.f), b = fmaxf(fabsf(gk[lane]), lane < 32 ? fabsf(gk[64 + lane]) : 0.f);
    a = wave_max(a); b = wave_max(b);
    return -(9.797958971132712f * 1.4426950408889634f * a * b * 1.001f);
}

constexpr int HGP = 72;
constexpr int ZP = 68;
constexpr int HG_ZT0 = 0, HG_ZT1 = 17408, HG_KEY0 = 34816, HG_KEY1 = 52224, HG_VT = 69632, HG_KRM0 = 78848, HG_KRM1 = 88064, HG_QRM0 = 97280, HG_QRM1 = 106496,
              HG_S2T0 = 115712, HG_S2T1 = 124928, HG_A20 = 134144, HG_A21 = 143360, HG_GT = 152576  , HG_REF = 156672  , HG_BT = 157184  ,
              HG_O = HG_ZT0  ;
DEVI bf16x8 hg_frag_tr(const LAS unsigned char* tile, int k0, int c0, int lane) {
    const unsigned g = lane >> 4, q = (lane & 15) >> 2, pp = lane & 3;
    const unsigned a0 = (unsigned)(size_t)tile + (unsigned)((k0 + 8 * g + q) * (HGP * 2) + (c0 + 4 * pp) * 2), a1 = a0 + 4 * HGP * 2;
    u32x2 r0, r1;
    asm volatile("ds_read_b64_tr_b16 %0, %2\n\tds_read_b64_tr_b16 %1, %3\n\ts_waitcnt lgkmcnt(0)" : "=&v"(r0), "=&v"(r1) : "v"(a0), "v"(a1) : "memory");
    u32x4 w; w.x = r0.x; w.y = r0.y; w.z = r1.x; w.w = r1.y; return __builtin_bit_cast(bf16x8, w);
}

DEVI int hg_pos0(int tc) { return tc < 128 ? tc * 64 : SEQ + (tc - 128) * 64; }
DEVI int hg_chain_pos(int tc, int dir) { return dir ? (NCH - 1 - tc) : (tc < 128 ? tc + 4 : tc - 128); }

struct HgIn { u32x4 q, zf, zb, v, g, sf, sb; };
template <bool PASS3> DEVI void hg_load(const Params& p, int u, HgIn& r) {
    const int tid = opq_tid(), tk = tid >> 3, pc = tid & 7; const int tc = u % NCH, h = (u / NCH) & 7, bl = u / (NCH * 8);
    const bf16_t* prow = p.pa + (size_t)(bl * RB + hg_pos0(tc) + tk) * PA_W + h * 64 + pc * 8;
    r.zf = *(const u32x4*)(prow + C_ZF); r.zb = *(const u32x4*)(prow + C_ZB); r.v = *(const u32x4*)(prow + C_I);
    if (PASS3) { r.q = *(const u32x4*)(prow + C_Q); r.g = *(const u32x4*)(prow + C_G);
        const size_t uf = ((size_t)((bl * 2 + 0) * 8 + h)) * NCH + hg_chain_pos(tc, 0), ub = ((size_t)((bl * 2 + 1) * 8 + h)) * NCH + hg_chain_pos(tc, 1);
        r.sf = *(const u32x4*)(p.st + uf * 4096 + tk * 64 + pc * 8); r.sb = *(const u32x4*)(p.st + ub * 4096 + tk * 64 + pc * 8); }
}
DEVI float bfw(const u32x4& w, int e) { const unsigned x = w[e >> 1]; return (e & 1) ? __uint_as_float(x & 0xffff0000u) : __uint_as_float(x << 16); }

template <bool PASS3> DEVI void hg_prepare(const Params& p, int l, LAS unsigned char* lds, int h, const HgIn& r) {
    const int tid = opq_tid(), tk = tid >> 3, pc = tid & 7;
    LAS float* gt = (LAS float*)(lds + HG_GT); LAS float* refv = (LAS float*)(lds + HG_REF); LAS float* btv = (LAS float*)(lds + HG_BT);
    {
#pragma unroll
        for (int dir = 0; dir < 2; ++dir) {
            LAS float* zt = (LAS float*)(lds + (dir ? HG_ZT1 : HG_ZT0)); LAS float* keyt = (LAS float*)(lds + (dir ? HG_KEY1 : HG_KEY0));
            const float* lbp = p.lbv + ((size_t)l * 2 + dir) * 512 + h * 64 + pc * 8;
            float lf[8], ky[8];
#pragma unroll
            for (int e = 0; e < 8; ++e) { const float z = bfw(dir ? r.zb : r.zf, e); const float lb = lbp[e];
                const float ez = fast_exp2(-1.44269504f * fabsf(z)), opl = 1.0f + ez, rc = fast_rcp(opl);
                const float logsig = -(fmaxf(-z, 0.f) + 0.69314718f * __builtin_amdgcn_logf(opl));
                const float sigp = (z >= 0.f) ? rc : ez * rc;
                lf[e] = (lb > 0.f) ? 0.69314718f * __builtin_amdgcn_logf(lb + (1.0f - lb) * sigp) : logsig;
                ky[e] = (1.0f - lb) * (1.0f - sigp); }
            *(LAS f32x4*)(zt + tk * ZP + pc * 8) = (f32x4){lf[0], lf[1], lf[2], lf[3]}; *(LAS f32x4*)(zt + tk * ZP + pc * 8 + 4) = (f32x4){lf[4], lf[5], lf[6], lf[7]};
            *(LAS f32x4*)(keyt + tk * ZP + pc * 8) = (f32x4){ky[0], ky[1], ky[2], ky[3]}; *(LAS f32x4*)(keyt + tk * ZP + pc * 8 + 4) = (f32x4){ky[4], ky[5], ky[6], ky[7]}; }
        *(LAS u32x4*)(lds + HG_VT + (tk * HGP + pc * 8) * 2) = r.v;
    }
    __syncthreads();
    {
        const int d = tid & 63, jg = tid >> 6; float c0[8], c1[8]; float run = 0.f;
        LAS float* zt0 = (LAS float*)(lds + HG_ZT0); LAS float* zt1 = (LAS float*)(lds + HG_ZT1);
#pragma unroll
        for (int i = 0; i < 8; ++i) { run += zt0[(jg * 8 + i) * ZP + d]; c0[i] = run; }
        gt[jg * 64 + d] = run; run = 0.f;
#pragma unroll
        for (int i = 7; i >= 0; --i) { run += zt1[(jg * 8 + i) * ZP + d]; c1[i] = run; }
        gt[512 + jg * 64 + d] = run;
        __syncthreads();
        float off0 = 0.f, off1 = 0.f;
#pragma unroll
        for (int g2 = 0; g2 < 8; ++g2) { off0 += (g2 < jg) ? gt[g2 * 64 + d] : 0.f; off1 += (g2 > jg) ? gt[512 + g2 * 64 + d] : 0.f; }
#pragma unroll
        for (int i = 0; i < 8; ++i) { zt0[(jg * 8 + i) * ZP + d] = c0[i] + off0; zt1[(jg * 8 + i) * ZP + d] = c1[i] + off1; }
        if (jg == 3) refv[d] = c0[7] + off0;
        if (jg == 7) btv[d] = c0[7] + off0;
        if (jg == 4) refv[64 + d] = c1[0] + off1;
        if (jg == 0) btv[64 + d] = c1[0] + off1;
    }
    __syncthreads();
    {
#pragma unroll
        for (int dir = 0; dir < 2; ++dir) {
            const LAS float* zt = (const LAS float*)(lds + (dir ? HG_ZT1 : HG_ZT0)); const LAS float* keyt = (const LAS float*)(lds + (dir ? HG_KEY1 : HG_KEY0));
            float kt[8], qt[8];
            const f32x4 z0 = *(const LAS f32x4*)(zt + tk * ZP + pc * 8), z1 = *(const LAS f32x4*)(zt + tk * ZP + pc * 8 + 4);
            const f32x4 k0 = *(const LAS f32x4*)(keyt + tk * ZP + pc * 8), k1 = *(const LAS f32x4*)(keyt + tk * ZP + pc * 8 + 4);
            const f32x4 r0 = *(const LAS f32x4*)(refv + dir * 64 + pc * 8), r1 = *(const LAS f32x4*)(refv + dir * 64 + pc * 8 + 4);
#pragma unroll
            for (int e = 0; e < 8; ++e) { const float bc = e < 4 ? z0[e & 3] : z1[e & 3], rf = e < 4 ? r0[e & 3] : r1[e & 3], ke = e < 4 ? k0[e & 3] : k1[e & 3];
                kt[e] = ke * fast_exp2(1.44269504f * fminf(rf - bc, 80.f)); if (PASS3) qt[e] = bfw(r.q, e) * fast_exp2(1.44269504f * fminf(bc - rf, 80.f)); }
            { u32x4 w; w.x = cvt_pk_bf16(kt[0], kt[1]); w.y = cvt_pk_bf16(kt[2], kt[3]); w.z = cvt_pk_bf16(kt[4], kt[5]); w.w = cvt_pk_bf16(kt[6], kt[7]);
              *(LAS u32x4*)(lds + (dir ? HG_KRM1 : HG_KRM0) + (tk * HGP + pc * 8) * 2) = w; }
            if (PASS3) {
                u32x4 w; w.x = cvt_pk_bf16(qt[0], qt[1]); w.y = cvt_pk_bf16(qt[2], qt[3]); w.z = cvt_pk_bf16(qt[4], qt[5]); w.w = cvt_pk_bf16(qt[6], qt[7]);
                *(LAS u32x4*)(lds + (dir ? HG_QRM1 : HG_QRM0) + (tk * HGP + pc * 8) * 2) = w;
                const float er = fast_exp2(1.44269504f * refv[dir * 64 + tk]); float sv[8];
#pragma unroll
                for (int e = 0; e < 8; ++e) sv[e] = bfw(dir ? r.sb : r.sf, e) * er;
                w.x = cvt_pk_bf16(sv[0], sv[1]); w.y = cvt_pk_bf16(sv[2], sv[3]); w.z = cvt_pk_bf16(sv[4], sv[5]); w.w = cvt_pk_bf16(sv[6], sv[7]);
                *(LAS u32x4*)(lds + (dir ? HG_S2T1 : HG_S2T0) + (tk * HGP + pc * 8) * 2) = w;
            }
        }
    }
    __syncthreads();
}
DEVI bf16x8 hg_frag(const LAS unsigned char* base, int r, int c0) { return *(const LAS bf16x8*)(base + (size_t)(r * HGP + c0) * 2); }

DEVI void hg_pass1_unit(const Params& p, int l, LAS unsigned char* lds, int u, const HgIn& r) {
    const int tc = u % NCH, h = (u / NCH) & 7, bl = u / (NCH * 8);
    hg_prepare<false>(p, l, lds, h, r);
    const int tid = opq_tid(), lane = tid & 63, wv = tid >> 6, l15 = lane & 15, g = lane >> 4;
    const LAS float* refv = (const LAS float*)(lds + HG_REF); const LAS float* btv = (const LAS float*)(lds + HG_BT);
    const int dt = wv >> 1, ct0 = (wv & 1) * 2;
#pragma unroll
    for (int dir = 0; dir < 2; ++dir) {
        const size_t unit = ((size_t)((bl * 2 + dir) * 8 + h)) * NCH + hg_chain_pos(tc, dir);
        bf16_t* so = p.st + unit * 4096;
        const LAS unsigned char* krm = lds + (dir ? HG_KRM1 : HG_KRM0);
        bf16x8 af[2];
#pragma unroll
        for (int ks = 0; ks < 2; ++ks) af[ks] = hg_frag_tr(krm, 32 * ks, 16 * dt, lane);
#pragma unroll
        for (int ci = 0; ci < 2; ++ci) { const int ct = ct0 + ci; f32x4 acc = {0.f, 0.f, 0.f, 0.f};
#pragma unroll
            for (int ks = 0; ks < 2; ++ks) acc = __builtin_amdgcn_mfma_f32_16x16x32_bf16(af[ks], hg_frag_tr(lds + HG_VT, 32 * ks, 16 * ct, lane), acc, 0, 0, 0);
#pragma unroll
            for (int rr = 0; rr < 4; ++rr) { const int d = 16 * dt + 4 * g + rr; so[d * 64 + 16 * ct + l15] = f2bf(acc[rr] * fast_exp2(1.44269504f * (btv[dir * 64 + d] - refv[dir * 64 + d]))); } }
        if (tid < 64) p.stb[unit * 64 + tid] = btv[dir * 64 + tid];
    }
    __syncthreads();
}

DEVI void hg_pass3_unit(const Params& p, int l, LAS unsigned char* lds, int u, const HgIn& r) {
    const int tc = u % NCH, h = (u / NCH) & 7, bl = u / (NCH * 8);
    const int tid = opq_tid(), lane = tid & 63, wv = tid >> 6, l15 = lane & 15, g = lane >> 4;
    hg_prepare<true>(p, l, lds, h, r);
    { const int tt = wv >> 1, st0 = (wv & 1) * 2;
#pragma unroll
      for (int dir = 0; dir < 2; ++dir) {
          const LAS unsigned char* qrm = lds + (dir ? HG_QRM1 : HG_QRM0); const LAS unsigned char* krm = lds + (dir ? HG_KRM1 : HG_KRM0); LAS bf16_t* a2 = (LAS bf16_t*)(lds + (dir ? HG_A21 : HG_A20));
          bf16x8 bq[2];
#pragma unroll
          for (int ks = 0; ks < 2; ++ks) bq[ks] = hg_frag(qrm, 16 * tt + l15, 32 * ks + 8 * g);
#pragma unroll
          for (int si = 0; si < 2; ++si) { const int st = st0 + si; f32x4 acc = {0.f, 0.f, 0.f, 0.f};
#pragma unroll
              for (int ks = 0; ks < 2; ++ks) acc = __builtin_amdgcn_mfma_f32_16x16x32_bf16(hg_frag(krm, 16 * st + l15, 32 * ks + 8 * g), bq[ks], acc, 0, 0, 0);
              const int t = 16 * tt + l15, s0 = 16 * st + 4 * g; float v[4];
#pragma unroll
              for (int e = 0; e < 4; ++e) v[e] = (dir == 0 ? (s0 + e <= t) : (s0 + e >= t)) ? acc[e] : 0.f;
              u32x2 w; w.x = cvt_pk_bf16(v[0], v[1]); w.y = cvt_pk_bf16(v[2], v[3]);
              *(LAS u32x2*)(a2 + t * HGP + s0) = w; } } }
    __syncthreads();
    { const int tt = wv >> 1, ct0 = (wv & 1) * 2; LAS float* olds = (LAS float*)(lds + HG_O);
      f32x4 acc[2] = {{0.f, 0.f, 0.f, 0.f}, {0.f, 0.f, 0.f, 0.f}};
#pragma unroll
      for (int dir = 0; dir < 2; ++dir) {
          const LAS unsigned char* qrm = lds + (dir ? HG_QRM1 : HG_QRM0); const LAS unsigned char* a2 = lds + (dir ? HG_A21 : HG_A20); const LAS unsigned char* s2t = lds + (dir ? HG_S2T1 : HG_S2T0);
          bf16x8 aa[2], aq[2];
#pragma unroll
          for (int ks = 0; ks < 2; ++ks) { aa[ks] = hg_frag(a2, 16 * tt + l15, 32 * ks + 8 * g); aq[ks] = hg_frag(qrm, 16 * tt + l15, 32 * ks + 8 * g); }
#pragma unroll
          for (int ci = 0; ci < 2; ++ci) { const int ct = ct0 + ci;
#pragma unroll
              for (int ks = 0; ks < 2; ++ks) acc[ci] = __builtin_amdgcn_mfma_f32_16x16x32_bf16(aa[ks], hg_frag_tr(lds + HG_VT, 32 * ks, 16 * ct, lane), acc[ci], 0, 0, 0);
#pragma unroll
              for (int ks = 0; ks < 2; ++ks) acc[ci] = __builtin_amdgcn_mfma_f32_16x16x32_bf16(aq[ks], hg_frag_tr(s2t, 32 * ks, 16 * ct, lane), acc[ci], 0, 0, 0); } }
#pragma unroll
      for (int ci = 0; ci < 2; ++ci)
#pragma unroll
          for (int rr = 0; rr < 4; ++rr) olds[(16 * tt + 4 * g + rr) * 65 + 16 * (ct0 + ci) + l15] = acc[ci][rr]; }
    __syncthreads();
    { const int tok = tid >> 3, pc = tid & 7; const int row = bl * RB + hg_pos0(tc) + tok; const LAS float* olds = (const LAS float*)(lds + HG_O);
      float o[8]; float ss = 0.f;
#pragma unroll
      for (int e = 0; e < 8; ++e) { o[e] = olds[tok * 65 + pc * 8 + e]; ss += o[e] * o[e]; }
      ss += __shfl_xor(ss, 1); ss += __shfl_xor(ss, 2); ss += __shfl_xor(ss, 4);
      const float rstd = rsqrtf(ss * (1.0f / 64.0f) + EPSF);
      const float* gn = p.in[I_HGNORM] + l * 64 + pc * 8;
      float rr[8];
#pragma unroll
      for (int e = 0; e < 8; ++e) rr[e] = o[e] * rstd * gn[e] * sigmoidf_(bfw(r.g, e));
      u32x4 w; w.x = cvt_pk_bf16(rr[0], rr[1]); w.y = cvt_pk_bf16(rr[2], rr[3]); w.z = cvt_pk_bf16(rr[4], rr[5]); w.w = cvt_pk_bf16(rr[6], rr[7]);
      *(u32x4*)(p.ocat + (size_t)row * OCW + h * 64 + pc * 8) = w; }
    __syncthreads();
}

DEVI void hg_prefix(const Params& p, bool dry = false) {
    const int total = 2 * 2 * 8 * 4096;
    for (int gidx = opq_bid() * 512 + opq_tid(); gidx < total; gidx += gridDim.x * 512) {
        const int chain = gidx >> 12, e = gidx & 4095, d = e >> 6;
        bf16_t* s = p.st + (size_t)chain * NCH * 4096 + e; const float* bt = p.stb + (size_t)chain * NCH * 64 + d;
        float S = 0.f;
#pragma unroll 1
        for (int q0 = 0; q0 < NCH; q0 += 12) { float loc[12], b[12];
#pragma unroll
            for (int i = 0; i < 12; ++i) { loc[i] = bf2f(s[(size_t)(q0 + i) * 4096]); b[i] = bt[(q0 + i) * 64]; }
#pragma unroll
            for (int i = 0; i < 12; ++i) { if (!dry) s[(size_t)(q0 + i) * 4096] = f2bf(S); S = S * fast_exp2(1.44269504f * b[i]) + loc[i]; } }
        if (dry && S == 123.456f) s[0] = 0;
    }
}

constexpr int LR_UB = 0, LR_UP = 520, LR_AF = 16640, LR_IF = LR_AF + 32768, LR_AB = LR_IF + 32768, LR_IB = LR_AB + 32768;
constexpr int NT16 = RB / 16;

DEVI int lr_pos0(int tt) { return tt * 16; }
DEVI int lr_chain_pos(int tt, int dir) { return dir ? (NT16 - 1 - tt) : (tt < 512 ? tt + 16 : tt - 512); }

struct LruW { bf16x8 b[2][4][2]; float ba[4], bx[4], la[4]; };
DEVI void lru_load_w(const Params& p, int l, int dir, int n, int l15, int g, LruW& w) {
#pragma unroll
    for (int which = 0; which < 2; ++which)
#pragma unroll
        for (int ct = 0; ct < 4; ++ct)
#pragma unroll
            for (int ks = 0; ks < 2; ++ks)
                w.b[which][ct][ks] = *(const bf16x8*)(p.wlru + ((((size_t)(l * 2 + dir) * 8 + n) * 2 + which) * 64 + 16 * ct + l15) * 64 + 32 * ks + 8 * g);
#pragma unroll
    for (int ct = 0; ct < 4; ++ct) { const int c = (l * 2 + dir) * 512 + n * 64 + 16 * ct + l15;
        w.ba[ct] = p.in[I_LBA][c]; w.bx[ct] = p.in[I_LBX][c]; w.la[ct] = p.lrula[c]; }
}
struct LrIn { bf16_t x[19]; bf16_t y[16]; float h_in; };
template <int MODE> DEVI void lru_load(const Params& p, int u, LrIn& r) {
    const int bl = u / NT16, tt = u % NT16, c = opq_tid();
    const int pos0 = tt * 16, seg0 = tt < 512 ? 0 : SEQ, seg1 = tt < 512 ? SEQ : RB;
    const bf16_t* xx = p.pa + (size_t)bl * RB * PA_W + C_LX + c;
#pragma unroll
    for (int i = 0; i < 19; ++i) { const int pos = pos0 - 2 + i; r.x[i] = (pos >= seg0 && pos < seg1) ? xx[(size_t)pos * PA_W] : (bf16_t)0; }
    if (MODE == 2) { const bf16_t* yy = p.pa + ((size_t)bl * RB + pos0) * PA_W + C_LY + c;
#pragma unroll
        for (int t = 0; t < 16; ++t) r.y[t] = yy[(size_t)t * PA_W]; }
    if (MODE == 1) r.h_in = p.lin[((size_t)(bl * 2 + 0) * NT16 + lr_chain_pos(tt, 0)) * 512 + c];
    if (MODE == 2) r.h_in = p.lin[((size_t)(bl * 2 + 1) * NT16 + lr_chain_pos(tt, 1)) * 512 + c];
}
#define LR_WAVE_SYNC() do { asm volatile("s_waitcnt lgkmcnt(0)" ::: "memory"); __builtin_amdgcn_wave_barrier(); } while (0)
DEVI void lru_tile_gates(const Params& p, int l, LAS unsigned char* lds, const LrIn& in, const LruW& w) {
    const int tid = opq_tid(), lane = tid & 63, n = tid >> 6, l15 = lane & 15, g = lane >> 4;
    LAS bf16_t* ub = (LAS bf16_t*)(lds + LR_UB);
    {
        const int c = tid;
        const float* cw = p.in[I_CONVW] + (size_t)l * 4 * 512; const float w0 = cw[c], w1 = cw[512 + c], w2 = cw[1024 + c], w3 = cw[1536 + c], cb = p.in[I_CONVB][l * 512 + c];
        float x[19];
#pragma unroll
        for (int i = 0; i < 19; ++i) x[i] = bf2f(in.x[i]);
#pragma unroll
        for (int t = 0; t < 16; ++t) ub[t * LR_UP + c] = f2bf(cb + w0 * x[t] + w1 * x[t + 1] + w2 * x[t + 2] + w3 * x[t + 3]);
    }
    LR_WAVE_SYNC();
    bf16x8 af[2];
#pragma unroll
    for (int ks = 0; ks < 2; ++ks) af[ks] = *(const LAS bf16x8*)(ub + l15 * LR_UP + n * 64 + 32 * ks + 8 * g);
    LAS float* aL = (LAS float*)(lds + LR_AF); LAS float* iL = (LAS float*)(lds + LR_IF);
#pragma unroll
    for (int ct = 0; ct < 4; ++ct) {
        f32x4 ra = {0.f, 0.f, 0.f, 0.f}, xa = {0.f, 0.f, 0.f, 0.f};
#pragma unroll
        for (int ks = 0; ks < 2; ++ks) { ra = __builtin_amdgcn_mfma_f32_16x16x32_bf16(af[ks], w.b[0][ct][ks], ra, 0, 0, 0); xa = __builtin_amdgcn_mfma_f32_16x16x32_bf16(af[ks], w.b[1][ct][ks], xa, 0, 0, 0); }
        const int c = n * 64 + 16 * ct + l15;
#pragma unroll
        for (int r = 0; r < 4; ++r) { const int t = 4 * g + r;
            const float rg = sigmoidf_(ra[r] + w.ba[ct]), ig = sigmoidf_(xa[r] + w.bx[ct]);
            const float a = fast_exp2(rg * w.la[ct]); const float uu = bf2f(ub[t * LR_UP + c]);
            aL[t * 512 + c] = a; iL[t * 512 + c] = __builtin_amdgcn_sqrtf(fmaxf(1.0f - a * a, 0.f)) * ig * uu; }
    }
    LR_WAVE_SYNC();
}
template <int MODE> DEVI void lru_sweep(const Params& p, int l, LAS unsigned char* lds, int dir, int u0, int uend, int ubase, bool skipc) {
    const int tid = opq_tid(), lane = tid & 63, n = tid >> 6, l15 = lane & 15, g = lane >> 4, G = gridDim.x;
    if (u0 >= uend) return;
    LruW w; lru_load_w(p, l, dir, n, l15, g, w);
    const LAS float* aL = (const LAS float*)(lds + LR_AF); const LAS float* iL = (const LAS float*)(lds + LR_IF);
    LrIn cur, nxt; lru_load<MODE>(p, u0 - ubase, cur);
    for (int u = u0; u < uend; u += G) {
        const bool more = u + G < uend; if (more) lru_load<MODE>(p, u + G - ubase, nxt);
        const int uu = u - ubase, bl = uu / NT16, tt = uu % NT16;
        if (!(skipc && tt >= 512)) {
            lru_tile_gates(p, l, lds, cur, w);
            if (MODE == 0) { float A = 1.f, H = 0.f;
#pragma unroll
                for (int t = 0; t < 16; ++t) { const float a = aL[t * 512 + tid], b = iL[t * 512 + tid]; if (dir == 0) { H = a * H + b; A *= a; } else { H += b * A; A *= a; } }
                *((f32x2_t*)p.lsum + ((size_t)(bl * 2 + dir) * NT16 + lr_chain_pos(tt, dir)) * 512 + tid) = (f32x2_t){A, H};
            } else { bf16_t* ocol = p.ocat + ((size_t)bl * RB + lr_pos0(tt)) * OCW + 1024 + tid; float h = cur.h_in;
                if (MODE == 1) {
#pragma unroll
                    for (int t = 0; t < 16; ++t) { h = aL[t * 512 + tid] * h + iL[t * 512 + tid]; ocol[(size_t)t * OCW] = f2bf(h); }
                } else {
                    float hfv[16];
#pragma unroll
                    for (int t = 0; t < 16; ++t) hfv[t] = bf2f(ocol[(size_t)t * OCW]);
#pragma unroll
                    for (int t = 15; t >= 0; --t) { h = aL[t * 512 + tid] * h + iL[t * 512 + tid];
                        const float y = bf2f(cur.y[t]); const float x3 = 0.7978845608028654f * (y + 0.044715f * y * y * y);
                        const float th = 1.0f - 2.0f * fast_rcp(1.0f + fast_exp2(2.88539008f * x3));
                        ocol[(size_t)t * OCW] = f2bf((hfv[t] + h) * 0.5f * y * (1.0f + th)); } }
            }
            LR_WAVE_SYNC();
        }
        if (more) cur = nxt;
    }
}
DEVI void lru_prefix(const Params& p, bool dry = false) {
    const int lane = opq_tid() & 63, wv = opq_tid() >> 6;
    for (int chain = opq_bid() * 8 + wv; chain < 2 * 2 * 512; chain += gridDim.x * 8) {
        const int c = chain & 511, bd = chain >> 9;
        const f32x2_t* src = (const f32x2_t*)p.lsum + (size_t)bd * NT16 * 512 + c; float* dst = p.lin + (size_t)bd * NT16 * 512 + c;
        f32x2_t v[9]; float A = 1.f, H = 0.f;
#pragma unroll
        for (int i = 0; i < 9; ++i) { const int q = lane * 9 + i; v[i] = (q < NT16) ? src[(size_t)q * 512] : (f32x2_t){1.f, 0.f}; H = v[i].x * H + v[i].y; A *= v[i].x; }
#pragma unroll
        for (int o = 1; o < 64; o <<= 1) { const float Ap = __shfl_up(A, o), Hp = __shfl_up(H, o); if (lane >= o) { H = A * Hp + H; A = A * Ap; } }
        float h = __shfl_up(H, 1); if (lane == 0) h = 0.f;
#pragma unroll
        for (int i = 0; i < 9; ++i) { const int q = lane * 9 + i; if (q < NT16 && !dry) dst[(size_t)q * 512] = h; h = v[i].x * h + v[i].y; }
        if (dry && h == 123.456f) dst[0] = 0.f;
    }
}
DEVI void phase_attn_scan1(const Params& p, int l, LAS unsigned char* lds, int parts = 7) {
    const int nA = 2 * 8 * 16 + (l == 0 ? 16 : 0), nH = 2 * 8 * NCH, nL = 2 * NT16, G = gridDim.x;
    const float accinit = attn_offset(p, l);
    int u = opq_bid();
    for (; u < 256; u += G) { const int bl = u >> 7, h = (u >> 4) & 7, qb = u & 15; if (!(parts & 1)) continue;
        attn_unit(p, lds, p.q + ((size_t)(bl * 8 + h) * SEQ + qb * 512) * 96, 512, p.kv + (size_t)(bl * 8 + h) * NCH * KVT_BYTES, NCH,
                  p.ocat + (size_t)(bl * RB + qb * 512) * OCW + 512 + h * 64, accinit); }
    for (; u < nA; u += G) { const int uu = u - 256, bl = uu >> 3, h = uu & 7; if (!(parts & 1)) continue;
        attn_unit(p, lds, p.qc + ((size_t)(bl * 8 + h) * CTX) * 96, 256, p.kv + ((size_t)(bl * 8 + h) * NCH + 128) * KVT_BYTES, 4,
                  p.ocat + (size_t)(bl * RB + SEQ) * OCW + 512 + h * 64, accinit); }
    if (parts & 2) { HgIn cur, nxt; if (u < nA + nH) hg_load<false>(p, u - nA, cur);
        for (; u < nA + nH; u += G) { const bool more = u + G < nA + nH; if (more) hg_load<false>(p, u + G - nA, nxt); hg_pass1_unit(p, l, lds, u - nA, cur); if (more) cur = nxt; } }
    else { for (; u < nA + nH; u += G) {} }
    if (parts & 4) { lru_sweep<0>(p, l, lds, 0, u, nA + nH + nL, nA + nH, false); lru_sweep<0>(p, l, lds, 1, u, nA + nH + nL, nA + nH, false); }
}
DEVI void phase_prefix(const Params& p, LAS unsigned char* lds, bool dry = false) { (void)lds; hg_prefix(p, dry); lru_prefix(p, dry); }
DEVI void phase_scan3(const Params& p, int l, LAS unsigned char* lds, int parts = 3) {
    const int nH = 2 * 8 * NCH, nL = 2 * NT16, G = gridDim.x; const bool skipc = (l == DEPTH - 1);
    int u = opq_bid();
    if (parts & 1) { HgIn cur, nxt; if (u < nH) hg_load<true>(p, u, cur);
        for (; u < nH; u += G) { const bool more = u + G < nH; if (more) hg_load<true>(p, u + G, nxt);
            if (!(skipc && (u % NCH) >= 128)) hg_pass3_unit(p, l, lds, u, cur);
            if (more) cur = nxt; } }
    else { for (; u < nH; u += G) {} }
    if (parts & 2) { lru_sweep<1>(p, l, lds, 0, u, nH + nL, nH, skipc); lru_sweep<2>(p, l, lds, 1, u, nH + nL, nH, skipc); }
}

constexpr int RP = 2 * TT + 4096;

DEVI void phase_norm2_route(const Params& p, int l, LAS unsigned char* lds) {
    const int tid = opq_tid(), lane = tid & 63, wv = tid >> 6; const bool skipc = (l == DEPTH - 1);
    LAS int* cntl = (LAS int*)lds;
    LAS int* basel = cntl + 16;
    LAS int* rinfo = cntl + 64;
    LAS float* rw = (LAS float*)(rinfo + 4 * 8 * 20);
    if (tid < 16) cntl[tid] = 0;
    LAS float* Wt = (LAS float*)(lds + 8192);
    { const float* wrg = p.in[I_WRG] + (size_t)l * DM * 4; const float* wre = p.in[I_WRE] + (size_t)l * DM * 16;
      for (int i = tid; i < DM * 4; i += 512) Wt[(i & 3) * DM + (i >> 2)] = wrg[i];
      for (int i = tid; i < DM * 16; i += 512) Wt[(4 + (i & 15)) * DM + (i >> 4)] = wre[i]; }
    __syncthreads();
    const float* gm = p.in[I_NFFN] + l * DM;
    const int rstep = gridDim.x * 8, rfirst = opq_bid() * 8 + wv;
    f32x4 vn[2][4];
#pragma unroll
    for (int q = 0; q < 2; ++q) { const int rq = rfirst + q * rstep; if (rq < TT) { const float* s0 = xbuf_row(p, rq);
#pragma unroll
        for (int i = 0; i < 4; ++i) vn[q][i] = *(const f32x4*)(s0 + i * 256 + lane * 4); } }
    for (int r = rfirst, it = 0; r < TT; r += 2 * rstep, it += 2) {
        f32x4 hh[2][4]; bool live[2];
#pragma unroll
        for (int q = 0; q < 2; ++q) {
            const int rq = r + q * rstep; f32x4 v[4];
#pragma unroll
            for (int i = 0; i < 4; ++i) v[i] = vn[q][i];
            if (rq + 2 * rstep < TT) { const float* s1 = xbuf_row(p, rq + 2 * rstep);
#pragma unroll
                for (int i = 0; i < 4; ++i) vn[q][i] = *(const f32x4*)(s1 + i * 256 + lane * 4); }
            live[q] = rq < TT && !(skipc && (rq % RB) >= SEQ);
            if (rq < TT && !live[q] && lane == 0) rinfo[((it + q) * 8 + wv) * 4] = -1;
            float ss = 0.f;
#pragma unroll
            for (int i = 0; i < 4; ++i) ss += v[i][0] * v[i][0] + v[i][1] * v[i][1] + v[i][2] * v[i][2] + v[i][3] * v[i][3];
            ss = wave_sum(ss);
            const float rstd = rsqrtf(ss * (1.0f / DM) + EPSF);
            const int rr = live[q] ? rq : rfirst;
            const float* mv = p.modv + ((size_t)l * 5 + mod_row(rr)) * 6144;
#pragma unroll
            for (int i = 0; i < 4; ++i) { const int c = i * 256 + lane * 4;
                const f32x4 g = *(const f32x4*)(gm + c), sh = *(const f32x4*)(mv + 3072 + c), sc = *(const f32x4*)(mv + 4096 + c);
#pragma unroll
                for (int e = 0; e < 4; ++e) hh[q][i][e] = live[q] ? v[i][e] * rstd * g[e] * (1.0f + sc[e]) + sh[e] : 0.f;
                if (live[q]) { u32x2 w; w.x = cvt_pk_bf16(hh[q][i][0], hh[q][i][1]); w.y = cvt_pk_bf16(hh[q][i][2], hh[q][i][3]);
                    *(u32x2*)(p.h2 + (size_t)rq * DM + c) = w; } }
        }
        float red[2][32];
#pragma unroll
        for (int j = 0; j < 32; ++j) { float a0 = 0.f, a1 = 0.f;
            if (j < 20) {
#pragma unroll
                for (int i = 0; i < 4; ++i) { const f32x4 w4 = *(const LAS f32x4*)(Wt + j * DM + i * 256 + lane * 4);
                    a0 += hh[0][i][0] * w4[0] + hh[0][i][1] * w4[1] + hh[0][i][2] * w4[2] + hh[0][i][3] * w4[3];
                    a1 += hh[1][i][0] * w4[0] + hh[1][i][1] * w4[1] + hh[1][i][2] * w4[2] + hh[1][i][3] * w4[3]; } }
            red[0][j] = a0; red[1][j] = a1; }
#pragma unroll
        for (int q = 0; q < 2; ++q) {
#pragma unroll
            for (int lvl = 0; lvl < 5; ++lvl) { const int half = 16 >> lvl, bit = 32 >> lvl; const bool hi = (lane & bit) != 0;
#pragma unroll
                for (int i = 0; i < half; ++i) { const float snd = hi ? red[q][i] : red[q][i + half]; const float keep = hi ? red[q][i + half] : red[q][i];
                    red[q][i] = keep + __shfl_xor(snd, bit); } }
            red[q][0] += __shfl_xor(red[q][0], 1);
        }
#pragma unroll
        for (int q = 0; q < 2; ++q) {
            float lgt[20];
#pragma unroll
            for (int j = 0; j < 20; ++j) lgt[j] = __builtin_bit_cast(float, __builtin_amdgcn_readlane(__builtin_bit_cast(int, red[q][0]), 2 * j));
            const f32x4 lg = {lgt[0], lgt[1], lgt[2], lgt[3]}, le0 = {lgt[4], lgt[5], lgt[6], lgt[7]}, le1 = {lgt[8], lgt[9], lgt[10], lgt[11]},
                        le2 = {lgt[12], lgt[13], lgt[14], lgt[15]}, le3 = {lgt[16], lgt[17], lgt[18], lgt[19]};
            if (lane == 0 && live[q]) {
                const float* brg = p.in[I_BRG] + l * 4; const float* bre = p.in[I_BRE] + l * 16;
                int gs = 0; float best = lg[0] + brg[0];
#pragma unroll
                for (int e = 1; e < 4; ++e) { const float t = lg[e] + brg[e]; if (t > best) { best = t; gs = e; } }
                const float m = fmaxf(fmaxf(lg[0], lg[1]), fmaxf(lg[2], lg[3]));
                const float e0 = __expf(lg[0] - m), e1 = __expf(lg[1] - m), e2 = __expf(lg[2] - m), e3 = __expf(lg[3] - m);
                const float pg = (gs == 0 ? e0 : gs == 1 ? e1 : gs == 2 ? e2 : e3) / (e0 + e1 + e2 + e3);
                const f32x4 lv = (gs == 0) ? le0 : (gs == 1) ? le1 : (gs == 2) ? le2 : le3;
                const f32x4 bv = lv + *(const f32x4*)(bre + gs * 4);
                int i0 = 0; float m0 = bv[0], l0 = lv[0];
#pragma unroll
                for (int e = 1; e < 4; ++e) if (bv[e] > m0) { m0 = bv[e]; i0 = e; l0 = lv[e]; }
                int i1 = -1; float m1 = -3.0e38f, l1 = 0.f;
#pragma unroll
                for (int e = 0; e < 4; ++e) if (e != i0 && bv[e] > m1) { m1 = bv[e]; i1 = e; l1 = lv[e]; }
                const float mm = fmaxf(l0, l1), x0 = __expf(l0 - mm), x1 = __expf(l1 - mm);
                const float w0 = x0 / (x0 + x1) * pg, w1 = x1 / (x0 + x1) * pg;
                const int ea = gs * 4 + i0, eb = gs * 4 + i1;
                const int sa = __hip_atomic_fetch_add(&cntl[ea], 1, __ATOMIC_RELAXED, __HIP_MEMORY_SCOPE_WORKGROUP), sb = __hip_atomic_fetch_add(&cntl[eb], 1, __ATOMIC_RELAXED, __HIP_MEMORY_SCOPE_WORKGROUP);
                const int qi = ((it + q) * 8 + wv) * 4; rinfo[qi] = ea; rinfo[qi + 1] = eb; rinfo[qi + 2] = sa; rinfo[qi + 3] = sb;
                rw[((it + q) * 8 + wv) * 2] = w0; rw[((it + q) * 8 + wv) * 2 + 1] = w1;
            }
        }
    }
    __syncthreads();
    if (tid < 16) basel[tid] = (int)atomicAdd(&p.ctrl[CTRL_CNT(l, tid)], (unsigned)cntl[tid]);
    __syncthreads();
    for (int r = rfirst, it = 0; r < TT; r += rstep, ++it) {
        if (lane == 0) { const int q = (it * 8 + wv) * 4; const int ea = rinfo[q];
            if (ea >= 0) { const int eb = rinfo[q + 1], sa = basel[ea] + rinfo[q + 2], sb = basel[eb] + rinfo[q + 3];
                p.tok_e[r * 2] = ea; p.tok_e[r * 2 + 1] = eb; p.tok_s[r * 2] = sa; p.tok_s[r * 2 + 1] = sb;
                p.lst[(size_t)ea * TT + sa] = r; p.lst[(size_t)eb * TT + sb] = r; p.tok_w[(size_t)ea * TT + sa] = rw[(it * 8 + wv) * 2]; p.tok_w[(size_t)eb * TT + sb] = rw[(it * 8 + wv) * 2 + 1]; } }
    }
    __syncthreads();
}

DEVI void moe_offsets(const Params& p, int l, LAS int* offs) {
    if (opq_tid() == 0) { int o = 0;
        for (int e = 0; e < NEXP; ++e) { offs[e] = o; const int c = (int)__hip_atomic_load(&p.ctrl[CTRL_CNT(l, e)], __ATOMIC_RELAXED, __HIP_MEMORY_SCOPE_AGENT); offs[32 + e] = c; o += (c + 255) & ~255; }
        offs[NEXP] = o; }
    __syncthreads();
}
DEVI int moe_expert_of(const LAS int* offs, int row) { int e = 0;
#pragma unroll
    for (int q = 1; q < NEXP; ++q) e += (row >= offs[q]) ? 1 : 0;
    return e; }

DEVI void phase_moe_permute(const Params& p, int l, const LAS int* offs) {
    const int lane = opq_tid() & 63, wv = opq_tid() >> 6; const int R = offs[NEXP];
    for (int pr = opq_bid() * 8 + wv; pr < R; pr += gridDim.x * 8) {
        const int e = moe_expert_of(offs, pr), s = pr - offs[e]; const bool valid = s < offs[32 + e];
        u32x4 a = {0u, 0u, 0u, 0u}, b = {0u, 0u, 0u, 0u}; int r = 0; float w = 0.f;
        const int vz = vzero();
        if (valid) { r = p.lst[(size_t)e * TT + s + vz]; w = p.tok_w[(size_t)e * TT + s + vz];
            const u32x4* src = (const u32x4*)(p.h2 + (size_t)r * DM); a = src[lane]; b = src[64 + lane]; }
        u32x4* dst = (u32x4*)(p.h2p + (size_t)pr * DM); dst[lane] = a; dst[64 + lane] = b;
        if (lane == 0) { p.rww[pr] = w; p.rmr[pr] = valid ? mod_row(r) : 0; }
    }
}

template <bool GATH> struct MoeSched { static constexpr bool GATHER = GATH; const int* lst; int cnt[NEXP]; int G, c, nN; int o[NEXP + 1]; const char* A; const char* B; size_t atile, bexp, btile;
    DEVI void load(const LAS int* offs) {
#pragma unroll
        for (int q = 0; q <= NEXP; ++q) o[q] = __builtin_amdgcn_readfirstlane(offs[q]);
#pragma unroll
        for (int q = 0; q < NEXP; ++q) cnt[q] = __builtin_amdgcn_readfirstlane(offs[32 + q]); }
    DEVI int row_of(const g8::Unit& u, int r) const { int base = 0, n = 0;
#pragma unroll
        for (int q = 0; q < NEXP; ++q) { base = (u.tag == q) ? o[q] : base; n = (u.tag == q) ? cnt[q] : n; }
        const int s2 = u.pm * 256 + r - base; return (s2 < n) ? lst[(size_t)u.tag * TT + s2] : 0; }
    DEVI bool next(int i, g8::Unit& u) const { const long L = (long)i * G + c; const int R = o[NEXP]; if (L >= (long)(R / 256) * nN) return false;
        const int ti = (int)(L / nN), pn = (int)(L % nN); int e = 0;
#pragma unroll
        for (int q = 1; q < NEXP; ++q) e += (ti * 256 >= o[q]) ? 1 : 0;
        u.pm = ti; u.pn = pn; u.tag = e; u.a = A + (size_t)ti * atile; u.b = B + (size_t)e * bexp + (size_t)pn * btile; return true; } };
struct EpiSwiglu {
    static constexpr bool PERM = false, HAS_MID = false; static constexpr int NSEG = 1;
    bf16_t* hid;
    DEVI void operator()(const f32x4 (&acc)[2][2][4][2], const g8::Unit& u, int wr, int wc, int fr, int fq) const {
        const int row0 = u.pm * 256 + wr * 64 + fr, col0 = u.pn * 128 + wc * 32 + 4 * fq;
#pragma unroll
        for (int ai = 0; ai < 2; ++ai)
#pragma unroll
            for (int m = 0; m < 4; ++m)
#pragma unroll
                for (int n = 0; n < 2; ++n) { const f32x4 a = acc[ai][0][m][n], b = acc[ai][1][m][n]; float h[4];
#pragma unroll
                    for (int e = 0; e < 4; ++e) h[e] = a[e] * sigmoidf_(a[e]) * b[e];
                    u32x2 w; w.x = cvt_pk_bf16(h[0], h[1]); w.y = cvt_pk_bf16(h[2], h[3]);
                    *(u32x2*)(hid + (size_t)(row0 + ai * 128 + m * 16) * DEXP + col0 + n * 16) = w; }
    }
};
DEVI void phase_moe_up(const Params& p, int l, const LAS int* offs, LAS unsigned char* lds) {
    MoeSched<true> S; S.lst = p.lst; S.G = gridDim.x; S.c = opq_bid(); S.nN = 2; S.load(offs); S.A = (const char*)p.h2; S.B = (const char*)(p.w13 + (size_t)l * NEXP * 512 * DM);
    S.atile = 0; S.bexp = (size_t)512 * DM * 2; S.btile = (size_t)256 * DM * 2;
    EpiSwiglu E; E.hid = p.hid;
    g8::gemm_phase(lds, DM, DM, DM, S, E);
}
struct EpiDown {
    static constexpr bool PERM = true, HAS_MID = false; static constexpr int NSEG = 1;
    bf16_t* yo; const float* tokw; const LAS int* offs;
    DEVI void operator()(const f32x4 (&acc)[2][2][4][2], const g8::Unit& u, int wr, int wc, int fr, int fq) const {
        const int row0 = u.pm * 256 + wr * 64 + fr, col0 = u.pn * 256 + wc * 32 + 8 * fq;
        const int e = u.tag, base = offs[e], n = offs[32 + e];
        float wrow[2][4];
#pragma unroll
        for (int ai = 0; ai < 2; ++ai)
#pragma unroll
            for (int m = 0; m < 4; ++m) { const int s2 = row0 + ai * 128 + m * 16 - base; wrow[ai][m] = (s2 < n) ? tokw[(size_t)e * TT + s2] : 0.f; }
#pragma unroll
        for (int ai = 0; ai < 2; ++ai)
#pragma unroll
            for (int m = 0; m < 4; ++m) { const int row = row0 + ai * 128 + m * 16; const float w = wrow[ai][m];
#pragma unroll
                for (int bj = 0; bj < 2; ++bj) { const f32x4 v0 = acc[ai][bj][m][0] * w, v1 = acc[ai][bj][m][1] * w;
                    u32x4 o; o.x = cvt_pk_bf16(v0[0], v0[1]); o.y = cvt_pk_bf16(v0[2], v0[3]); o.z = cvt_pk_bf16(v1[0], v1[1]); o.w = cvt_pk_bf16(v1[2], v1[3]);
                    *(u32x4*)(yo + (size_t)row * DM + col0 + bj * 128) = o; } }
    }
};
DEVI void phase_moe_down(const Params& p, int l, const LAS int* offs, LAS unsigned char* lds) {
    MoeSched<false> S; S.lst = p.lst; S.G = gridDim.x; S.c = opq_bid(); S.nN = 4; S.load(offs); S.A = (const char*)p.hid; S.B = (const char*)(p.w2 + (size_t)l * NEXP * DM * DEXP);
    S.atile = (size_t)256 * DEXP * 2; S.bexp = (size_t)DM * DEXP * 2; S.btile = (size_t)256 * DEXP * 2;
    EpiDown E; E.yo = p.yo; E.tokw = p.tok_w; E.offs = offs;
    g8::gemm_phase(lds, DEXP, DEXP, DEXP, S, E);
}
DEVI void phase_moe_combine(const Params& p, int l, const LAS int* offs, bool dry = false) {
    const int lane = opq_tid() & 63, wv = opq_tid() >> 6; const bool skipc = (l == DEPTH - 1);
    const int rstep = gridDim.x * 8, rfirst = opq_bid() * 8 + wv, vz = vzero();
    auto live = [&](int r) { return r < TT && !(skipc && (r % RB) >= SEQ); };
    int e0n = 0, s0n = 0, e1n = 0, s1n = 0;
    auto load_slots = [&](int r) { if (live(r)) { e0n = p.tok_e[r * 2 + vz]; s0n = p.tok_s[r * 2 + vz]; e1n = p.tok_e[r * 2 + 1 + vz]; s1n = p.tok_s[r * 2 + 1 + vz]; } };
    f32x4 xn[4]; u32x2 an[4], bn[4];
    auto load_data = [&](int r) { if (live(r)) { const float* x = xbuf_row(p, r);
            const bf16_t* y0 = p.yo + (size_t)(offs[e0n] + s0n) * DM; const bf16_t* y1 = p.yo + (size_t)(offs[e1n] + s1n) * DM;
#pragma unroll
            for (int i = 0; i < 4; ++i) { const int c = i * 256 + lane * 4; xn[i] = *(const f32x4*)(x + c); an[i] = *(const u32x2*)(y0 + c); bn[i] = *(const u32x2*)(y1 + c); } } };
    load_slots(rfirst); load_data(rfirst); load_slots(rfirst + rstep);
    for (int r = rfirst; r < TT; r += rstep) {
        f32x4 v[4]; u32x2 a[4], b[4];
#pragma unroll
        for (int i = 0; i < 4; ++i) { v[i] = xn[i]; a[i] = an[i]; b[i] = bn[i]; }
        load_data(r + rstep);
        load_slots(r + 2 * rstep);
        if (!live(r)) continue;
        float* x = xbuf_row(p, r);
        const float* g2 = p.modv + ((size_t)l * 5 + mod_row(r)) * 6144 + 5120;
#pragma unroll
        for (int i = 0; i < 4; ++i) { const int c = i * 256 + lane * 4; const f32x4 gv = *(const f32x4*)(g2 + c);
            v[i][0] += gv[0] * (__uint_as_float(a[i].x << 16) + __uint_as_float(b[i].x << 16)); v[i][1] += gv[1] * (__uint_as_float(a[i].x & 0xffff0000u) + __uint_as_float(b[i].x & 0xffff0000u));
            v[i][2] += gv[2] * (__uint_as_float(a[i].y << 16) + __uint_as_float(b[i].y << 16)); v[i][3] += gv[3] * (__uint_as_float(a[i].y & 0xffff0000u) + __uint_as_float(b[i].y & 0xffff0000u));
            if (!dry || v[i][0] == 123.456f) *(f32x4*)(x + c) = v[i]; }
    }
}

#ifndef MK_PHASE_KERNELS
#define MK_PHASE_KERNELS 0
#endif
constexpr int LDS_SCRATCH = 1024;

template <class T> DEVI T* uni_ptr(T* x) { const unsigned long long v = (unsigned long long)x;
    const unsigned lo = __builtin_amdgcn_readfirstlane((unsigned)v), hi = __builtin_amdgcn_readfirstlane((unsigned)(v >> 32));
    return (T*)(((unsigned long long)hi << 32) | lo); }
DEVI Params ldparams(const PL& s) {
    Params q;
#pragma unroll
    for (int i = 0; i < 35; ++i) q.in[i] = uni_ptr(s.in[i]);
#define LDP(f) q.f = uni_ptr(s.f)
    LDP(out); LDP(ctrl); LDP(modv); LDP(lbv); LDP(xc); LDP(rope); LDP(lrula); LDP(winA); LDP(winG); LDP(wup); LDP(wcat); LDP(wout); LDP(w13); LDP(w2); LDP(wlru);
    LDP(hx); LDP(pa); LDP(up); LDP(q); LDP(qc); LDP(kv); LDP(st); LDP(stb); LDP(lsum); LDP(lin); LDP(ocat); LDP(y); LDP(h2); LDP(h2p); LDP(hid); LDP(yo);
    LDP(tok_e); LDP(tok_s); LDP(tok_w); LDP(lst); LDP(rww); LDP(rmr);
#undef LDP
    q.pad_ = 0ull;
    return q;
}
#ifndef WAITPROBE
#define WAITPROBE (-1)
#endif
#ifndef WAITSEL
#define WAITSEL (-1)
#endif
#ifndef BODYSEL
#define BODYSEL (-1)
#endif
DEVI void grid_sync(const PL& s, LAS unsigned char* smem, int phid = -2) {
    XcdBarrier b; b.bar = uni_ptr(s.ctrl); b.x = xb_xcc_id(); b.st = (volatile LAS unsigned*)smem;
#if WAITPROBE >= 0
    unsigned long long t0 = 0; if (threadIdx.x == 0) t0 = __builtin_amdgcn_s_memrealtime();
    xcd_barrier(b);
    if (threadIdx.x == 0 && BODYSEL < 0 && (WAITSEL < 0 || phid == WAITSEL)) { LAS unsigned long long* acc = (LAS unsigned long long*)(smem + 32); *acc += __builtin_amdgcn_s_memrealtime() - t0; }
#else
    xcd_barrier(b);
#endif
}
DEVI void probe_dump(const Params& p, const bf16_t* src, size_t n) {
    const size_t NOUT = (size_t)NB * SEQ * DM;
    for (size_t i = (size_t)opq_bid() * 512 + opq_tid(); i < NOUT; i += (size_t)gridDim.x * 512) { float s = 0.f;
        for (size_t k = i; k < n; k += NOUT) s += (float)src[k];
        p.out[i] = s; }
}
#define PROBE_AT(id, buf, n) if (PROBE_STOP == (id) && l == 0 && hb == 0) { { const Params p = ldparams(pl); probe_dump(p, (const bf16_t*)(buf), (n)); } return; }
#ifndef PROBE_STOP
#define PROBE_STOP 0
#endif
#ifndef DUP_MASK
#define DUP_MASK 0
#endif
#define PHASE_D(bit, call, dupcall) PHASE(call); if ((DUP_MASK >> (bit)) & 1) { PHASE(dupcall); }
#define PHASE_I(id, call) do { unsigned long long tb_ = 0; if (BODYSEL == (id) && threadIdx.x == 0) tb_ = __builtin_amdgcn_s_memrealtime(); \
        { const Params p = ldparams(pl); call; } \
        if (BODYSEL == (id)) { __syncthreads(); if (threadIdx.x == 0) { LAS unsigned long long* acc = (LAS unsigned long long*)(smem + 32); *acc += __builtin_amdgcn_s_memrealtime() - tb_; } } } while (0); \
    grid_sync(pl, smem, id); if ((DUP_MASK >> 21) & 1) grid_sync(pl, smem)
#define PHASE(call) PHASE_I(-2, call)

#ifndef SELFCHECK
#define SELFCHECK 0
#endif
DEVI void chk_sum(const Params& p, int id, int rep, const void* buf, size_t nbytes) {
    const unsigned* w = (const unsigned*)buf; const size_t n = nbytes / 4; unsigned long long s = 0ull;
    for (size_t i = (size_t)opq_bid() * 512 + opq_tid(); i < n; i += (size_t)gridDim.x * 512) s += (unsigned long long)w[i] * (unsigned long long)((i & 1023) + 1);
    unsigned lo = (unsigned)s, hi = (unsigned)(s >> 32);
    for (int o = 32; o >= 1; o >>= 1) { const unsigned l2 = __shfl_xor(lo, o), h2 = __shfl_xor(hi, o); const unsigned long long t = (((unsigned long long)hi << 32) | lo) + (((unsigned long long)h2 << 32) | l2); lo = (unsigned)t; hi = (unsigned)(t >> 32); }
    if ((opq_tid() & 63) == 0) atomicAdd((unsigned long long*)(p.ctrl + 6144) + (rep * 32 + id), (((unsigned long long)hi << 32) | lo));
}
#define CHK(id, buf, nbytes) do { const Params p = ldparams(pl); chk_sum(p, id, rep, buf, nbytes); } while (0); grid_sync(pl, smem)

__global__ void __launch_bounds__(512, 2) hybrid_flow_backbone_kernel(Params pk) {
    extern __shared__ __attribute__((aligned(16))) unsigned char smem_raw[];
    LAS unsigned char* smem = (LAS unsigned char*)smem_raw;
    LAS unsigned char* lds = smem + LDS_SCRATCH; LAS int* offs = (LAS int*)(smem + 64);
    static_assert(sizeof(Params) % 8 == 0 && sizeof(Params) <= LDS_SCRATCH - 256, "Params must fit its LDS slot");
    { (void)pk;
      const __attribute__((address_space(4))) unsigned long long* src = (const __attribute__((address_space(4))) unsigned long long*)__builtin_amdgcn_kernarg_segment_ptr();
      LAS unsigned long long* dst = (LAS unsigned long long*)(smem + 256);
      if (threadIdx.x < sizeof(Params) / 8) dst[threadIdx.x] = src[threadIdx.x]; }
    if (threadIdx.x == 0) { *(LAS u32x4*)smem = (u32x4){0u, 0u, 0u, 0u}; *(LAS unsigned long long*)(smem + 32) = 0ull; }
    __syncthreads();
    const PL& pl = *(const PL*)(smem + 256);
    (void)xcd_barrier_post(uni_ptr(pl.ctrl), (volatile LAS unsigned*)smem);
    { unsigned long long tb_ = 0; if (BODYSEL == 0 && threadIdx.x == 0) tb_ = __builtin_amdgcn_s_memrealtime(); phase_prep(pl, lds);
      if (BODYSEL == 0) { __syncthreads(); if (threadIdx.x == 0) *(LAS unsigned long long*)(smem + 32) += __builtin_amdgcn_s_memrealtime() - tb_; } }
    grid_sync(pl, smem, 0);
    if ((DUP_MASK >> 16) & 1) { phase_prep(pl, lds); grid_sync(pl, smem); }
#if SELFCHECK
    for (int rep = 0; rep < SELFCHECK; ++rep) {
        const int l = 0, hb = 0;
        PHASE(phase_norm1(p, l, hb));          CHK(1, p.hx, (size_t)HR * DM * 2);
        PHASE(phase_inproj_a(p, l, lds));      CHK(2, p.pa, (size_t)HR * PA_W * 2);
        PHASE(phase_mla_up(p, l, lds));        CHK(3, p.up, (size_t)HR * UPW * 2);
        PHASE(phase_qkv(p, l, lds));           CHK(4, p.q, (size_t)2 * 8 * SEQ * 96 * 2); CHK(5, p.qc, (size_t)2 * 8 * CTX * 96 * 2);
        PHASE(phase_attn_scan1(p, l, lds));    CHK(6, p.st, (size_t)2 * 2 * 8 * NCH * 4096 * 2); CHK(7, p.stb, (size_t)2 * 2 * 8 * NCH * 64 * 4); CHK(8, p.lsum, (size_t)2 * 2 * NT16 * 512 * 2 * 4);
        PHASE(phase_prefix(p, lds));                CHK(9, p.st, (size_t)2 * 2 * 8 * NCH * 4096 * 2); CHK(10, p.lin, (size_t)2 * 2 * NT16 * 512 * 4);
        PHASE(phase_scan3(p, l, lds));         CHK(11, p.ocat, (size_t)HR * OCW * 2);
        PHASE(phase_inproj_g(p, l, lds));      CHK(12, p.pa, (size_t)HR * PG_W * 2);
        PHASE(phase_merge(p, l, lds));         CHK(13, p.y, (size_t)HR * DM * 2);
        PHASE(phase_outproj(p, l, hb, lds));   CHK(14, p.out, (size_t)2 * SEQ * DM * 4); CHK(15, p.xc, (size_t)2 * CTX * DM * 4);
    }
    {   const Params p = ldparams(pl);
        const size_t NOUT = (size_t)NB * SEQ * DM;
        for (size_t i = (size_t)opq_bid() * 512 + opq_tid(); i < NOUT; i += (size_t)gridDim.x * 512) p.out[i] = 0.f;
        __syncthreads();
        if (opq_bid() == 0 && opq_tid() == 0) { int first = 0; const unsigned long long* c = (const unsigned long long*)(p.ctrl + 6144);
            for (int id = 15; id >= 1; --id) for (int rep = 1; rep < SELFCHECK; ++rep)
                if (__hip_atomic_load(c + rep * 32 + id, __ATOMIC_RELAXED, __HIP_MEMORY_SCOPE_AGENT) != __hip_atomic_load(c + id, __ATOMIC_RELAXED, __HIP_MEMORY_SCOPE_AGENT)) first = id;
            p.out[0] = 1000.0f * (float)first; }
    }
    return;
#endif
    for (int l = 0; l < DEPTH; ++l) {
        for (int hb = 0; hb < 2; ++hb) {
            if (l == 0 && hb == 0) { PHASE_D(0, phase_norm1(p, l, hb), phase_norm1(p, l, hb)); }
            PHASE_I(2, phase_inproj_a(p, l, lds));
            PHASE_I(3, phase_mla_up(p, l, lds));
            PHASE_I(4, phase_qkv(p, l, lds));
            PHASE_I(5, phase_attn_scan1(p, l, lds));
            if ((DUP_MASK >> 4) & 1) { PHASE(phase_attn_scan1(p, l, lds, 1)); }
            if ((DUP_MASK >> 5) & 1) { PHASE(phase_attn_scan1(p, l, lds, 2)); }
            if ((DUP_MASK >> 6) & 1) { PHASE(phase_attn_scan1(p, l, lds, 4)); }
            PHASE_I(6, phase_prefix(p, lds));
            if ((DUP_MASK >> 17) & 1) { PHASE(phase_prefix(p, lds, true)); }
            PHASE_I(7, phase_scan3(p, l, lds));
            if ((DUP_MASK >> 7) & 1) { PHASE(phase_scan3(p, l, lds, 1)); }
            if ((DUP_MASK >> 8) & 1) { PHASE(phase_scan3(p, l, lds, 2)); }
            PHASE_I(8, phase_inproj_g(p, l, lds));
            PHASE_I(9, phase_merge(p, l, lds));
            PHASE_I(10, phase_outproj(p, l, hb, lds); if (hb == 0) phase_norm1(p, l, 1));
            if (((DUP_MASK >> 11) & 1) && l == 0) { PHASE(phase_outproj(p, l, hb, lds)); }
            if ((DUP_MASK >> 15) & 1) { for (int z = 0; z < 10; ++z) grid_sync(pl, smem); }
        }
        PHASE_I(11, phase_norm2_route(p, l, lds));
        PHASE_I(12, moe_offsets(p, l, offs); phase_moe_up(p, l, offs, lds));
        PHASE_I(13, phase_moe_down(p, l, offs, lds));
        PHASE_I(14, phase_moe_combine(p, l, offs); if (l + 1 < DEPTH) phase_norm1(p, l + 1, 0));
        if ((DUP_MASK >> 19) & 1) { PHASE(phase_moe_combine(p, l, offs, true)); }
    }
#if WAITPROBE >= 0
    if (blockIdx.x == WAITPROBE && threadIdx.x == 0) {
        const unsigned long long w = *(LAS unsigned long long*)(smem + 32), t0 = __builtin_amdgcn_s_memrealtime();
        while (__builtin_amdgcn_s_memrealtime() - t0 < w) __builtin_amdgcn_s_sleep(8); }
#endif
}

static size_t align_up(size_t x, size_t a) { return (x + a - 1) / a * a; }

extern "C" void kernel_launch(void* const* d_in, const int* in_sizes, int n_in, void* d_out, int out_size, void* d_ws, size_t ws_size, hipStream_t stream) {
    (void)in_sizes; (void)n_in; (void)out_size;
    Params p; memset(&p, 0, sizeof(p));
    for (int i = 0; i < 35; ++i) p.in[i] = (const float*)d_in[i];
    p.out = (float*)d_out;
    char* w = (char*)d_ws; size_t o = 0;
    auto take = [&](size_t bytes) { char* r = w + o; o = align_up(o + bytes, 256); return r; };
    p.ctrl = (unsigned*)take(CTRL_WORDS * 4);
    p.modv = (float*)take((size_t)DEPTH * 5 * 6144 * 4);
    p.lbv = (float*)take((size_t)DEPTH * 2 * 512 * 4);
    p.xc = (float*)take((size_t)NB * CTX * DM * 4);
    p.rope = (float*)take((size_t)SEQ * 32 * 4);
    p.lrula = (float*)take((size_t)DEPTH * 2 * 512 * 4);
    p.winA = (bf16_t*)take((size_t)DEPTH * PA_W * DM * 2);
    p.winG = (bf16_t*)take((size_t)DEPTH * PG_W * DM * 2);
    p.wup = (bf16_t*)take((size_t)DEPTH * UPW * 256 * 2);
    p.wcat = (bf16_t*)take((size_t)DEPTH * DM * OCW * 2);
    p.wout = (bf16_t*)take((size_t)DEPTH * DM * DM * 2);
    p.w13 = (bf16_t*)take((size_t)DEPTH * NEXP * 512 * DM * 2);
    p.w2 = (bf16_t*)take((size_t)DEPTH * NEXP * DM * DEXP * 2);
    p.wlru = (bf16_t*)take((size_t)DEPTH * 2 * 8 * 2 * 64 * 64 * 2);
    p.tok_e = (int*)take((size_t)TT * 2 * 4); p.tok_s = (int*)take((size_t)TT * 2 * 4);
    p.lst = (int*)take((size_t)NEXP * TT * 4); p.tok_w = (float*)take((size_t)NEXP * TT * 4);
    p.rww = (float*)take((size_t)RP * 4); p.rmr = (int*)take((size_t)RP * 4);
    const size_t region = o;
    p.hx = (bf16_t*)take((size_t)HR * DM * 2);
    p.pa = (bf16_t*)take((size_t)HR * PA_W * 2);
    p.ocat = (bf16_t*)take((size_t)HR * OCW * 2);
    p.lsum = (float*)take((size_t)2 * 2 * NT16 * 512 * 2 * 4); p.lin = (float*)take((size_t)2 * 2 * NT16 * 512 * 4);
    const size_t alias1 = o;
    p.up = (bf16_t*)take((size_t)HR * UPW * 2);
    const size_t after_up = o; o = alias1;
    p.st = (bf16_t*)take((size_t)2 * 2 * 8 * NCH * 4096 * 2); p.stb = (float*)take((size_t)2 * 2 * 8 * NCH * 64 * 4);
    if (o < after_up) o = after_up;
    const size_t alias2 = o;
    p.q = (bf16_t*)take((size_t)2 * 8 * SEQ * 96 * 2); p.qc = (bf16_t*)take((size_t)2 * 8 * CTX * 96 * 2); p.kv = (unsigned char*)take((size_t)2 * 8 * NCH * KVT_BYTES);
    const size_t mixer_end = o; o = alias2;
    p.y = (bf16_t*)take((size_t)HR * DM * 2);
    size_t end1 = mixer_end > o ? mixer_end : o;
    o = region;
    p.h2 = (bf16_t*)take((size_t)TT * DM * 2);
    p.h2p = (bf16_t*)take((size_t)RP * DM * 2);
    p.hid = (bf16_t*)take((size_t)RP * DEXP * 2);
    p.yo = (bf16_t*)take((size_t)RP * DM * 2);
    const size_t need = end1 > o ? end1 : o;
    static int grid = 0;
    if (!grid) {
        int dev = 0, cus = 0, per_cu = 0; hipGetDevice(&dev); hipDeviceGetAttribute(&cus, hipDeviceAttributeMultiprocessorCount, dev);
        hipFuncSetAttribute((const void*)hybrid_flow_backbone_kernel, hipFuncAttributeMaxDynamicSharedMemorySize, LDS_TOTAL);
        hipOccupancyMaxActiveBlocksPerMultiprocessor(&per_cu, (const void*)hybrid_flow_backbone_kernel, 512, LDS_TOTAL);
        if (per_cu < 1) fprintf(stderr, "kernel_launch: occupancy query returned %d\n", per_cu);
        grid = cus * (per_cu < 1 ? 0 : 1); if (grid > 256) grid = 256;
    }
    if (need > ws_size) { fprintf(stderr, "kernel_launch: workspace too small: need %zu have %zu\n", need, ws_size); return; }
    if (grid < 8) { fprintf(stderr, "kernel_launch: grid %d too small\n", grid); return; }
    hipMemsetAsync(p.ctrl, 0, CTRL_WORDS * 4, stream);
    hipLaunchKernelGGL(hybrid_flow_backbone_kernel, dim3(grid), dim3(512), LDS_TOTAL, stream, p);
}
```

```cpp
#include <hip/hip_runtime.h>
#include <stdint.h>
#include <stdio.h>
#include <string.h>

#define LAS __attribute__((address_space(3)))
#define DEVI __device__ __forceinline__
typedef unsigned short bf16_t;
typedef short bf16x8 __attribute__((ext_vector_type(8)));
typedef float f32x4 __attribute__((ext_vector_type(4)));
typedef float f32x16 __attribute__((ext_vector_type(16)));
typedef unsigned u32x4 __attribute__((ext_vector_type(4)));
typedef unsigned u32x2 __attribute__((ext_vector_type(2)));

constexpr int NB = 4, SEQ = 8192, CTX = 256, DM = 1024, DEPTH = 2;
constexpr int RB = SEQ + CTX;
constexpr int TT = NB * RB;
constexpr int HR = 2 * RB;
constexpr int NCH = RB / 64;
constexpr int INW = 7072;
constexpr int PA_W = 4096;
constexpr int PG_W = 3072;
constexpr int C_Q = 0, C_ZF = 512, C_ZB = 1024, C_I = 1536, C_G = 2048, C_DQ = 2560, C_DKV = 2816, C_KR = 2944, C_LX = 3072, C_LY = 3584;
constexpr int UPW = 1792;
constexpr int OCW = 1536;
constexpr int KVT_BYTES = 22016;
constexpr int KT_BYTES = 13312;
constexpr int NEXP = 16, DEXP = 256;
constexpr float EPSF = 1e-6f;
constexpr int LDS_TOTAL = 160 * 1024;

DEVI float bf2f(bf16_t b) { return __uint_as_float(((unsigned)b) << 16); }
DEVI bf16_t f2bf(float f) { return __builtin_bit_cast(bf16_t, (__bf16)f); }
typedef float f32x2_t __attribute__((ext_vector_type(2)));
typedef __bf16 bf16x2_t __attribute__((ext_vector_type(2)));
DEVI unsigned cvt_pk_bf16(float lo, float hi) { const f32x2_t v = {lo, hi}; return __builtin_bit_cast(unsigned, __builtin_convertvector(v, bf16x2_t)); }
DEVI float fast_exp2(float x) { return __builtin_amdgcn_exp2f(x); }
DEVI float fast_rcp(float x) { return __builtin_amdgcn_rcpf(x); }
DEVI float sigmoidf_(float x) { return fast_rcp(1.0f + fast_exp2(-1.44269504f * x)); }
DEVI float wave_sum(float v) { for (int o = 32; o >= 1; o >>= 1) v += __shfl_xor(v, o); return v; }
DEVI float wave_max(float v) { for (int o = 32; o >= 1; o >>= 1) v = fmaxf(v, __shfl_xor(v, o)); return v; }

DEVI int opq_tid() { int t = threadIdx.x; asm volatile("" : "+v"(t)); return t; }
DEVI int opq_bid() { int b = blockIdx.x; asm volatile("" : "+s"(b)); return b; }

DEVI int vzero() { int z = 0; asm volatile("" : "+v"(z)); return z; }

#define XB_TMO      128
#define XB_XCNT(j)  (256  + 64 * (j))
#define XB_XSUB(j)  (1280 + 64 * (j))
#define XB_XGEN(j)  (2304 + 64 * (j))
#define XB_TOP      3328
#define XB_TOPGEN   3392
#define XCD_BAR_WORDS 3456
#define XB_SPIN_CAP (1u << 18)

__device__ __forceinline__ unsigned xb_ld(unsigned* p)              { return __hip_atomic_load(p, __ATOMIC_RELAXED, __HIP_MEMORY_SCOPE_AGENT); }
__device__ __forceinline__ unsigned xb_add(unsigned* p, unsigned v) { return __hip_atomic_fetch_add(p, v, __ATOMIC_RELAXED, __HIP_MEMORY_SCOPE_AGENT); }
__device__ __forceinline__ unsigned xb_xcc_id() { return (unsigned)__builtin_amdgcn_s_getreg((3 << 11) | 20) & 0xFu; }
#define XB_SPIN(cond, bar) do { unsigned _sp = 0; while (cond) { __builtin_amdgcn_s_sleep(1); \
    if ((++_sp & 255u) == 0u) { if (xb_ld(&(bar)[XB_TMO])) break; if (_sp > XB_SPIN_CAP) { atomicAdd(&(bar)[XB_TMO], 1u); break; } } } } while (0)

struct XcdBarrier { unsigned* bar; unsigned x; volatile LAS unsigned* st; };

__device__ __forceinline__ XcdBarrier xcd_barrier_post(unsigned* bar, volatile LAS unsigned* st) {
    XcdBarrier b; b.bar = bar; b.x = xb_xcc_id(); b.st = st;
    if (threadIdx.x == 0) (void)xb_add(&bar[XB_XCNT(b.x)], 1u);
    return b;
}
__device__ __forceinline__ void xcd_barrier_complete(unsigned* bar, unsigned x, unsigned& nloc, unsigned& nx) {
    const unsigned G = gridDim.x * gridDim.y * gridDim.z;
    unsigned sum, cnt, mine, sp = 0u;
    for (;;) {
        sum = 0u; cnt = 0u; mine = 0u;
#pragma unroll
        for (unsigned j = 0; j < 16; ++j) { const unsigned c = xb_ld(&bar[XB_XCNT(j)]); sum += c; cnt += (c > 0u) ? 1u : 0u; mine = (j == x) ? c : mine; }
        if (sum == G) break;
        __builtin_amdgcn_s_sleep(1);
        if ((++sp & 255u) == 0u) { if (xb_ld(&bar[XB_TMO])) break; if (sp > XB_SPIN_CAP) { atomicAdd(&bar[XB_TMO], 1u); break; } }
    }
    nloc = mine > 0u ? mine : 1u; nx = cnt > 0u ? cnt : 1u;
}
__device__ __forceinline__ void xcd_barrier(const XcdBarrier& b) {
    asm volatile("s_waitcnt vmcnt(0)" ::: "memory");
    __syncthreads();
    if (threadIdx.x == 0) {
        unsigned* bar = b.bar;
        __builtin_amdgcn_s_waitcnt(0);
        unsigned nloc = b.st[0], nx = b.st[1];
        if (nloc == 0u) { xcd_barrier_complete(bar, b.x, nloc, nx); b.st[0] = nloc; b.st[1] = nx; }
        const unsigned old = xb_add(&bar[XB_XSUB(b.x)], 1u);
        const unsigned gen = old / nloc;
        if (old + 1u == (gen + 1u) * nloc) {
            __builtin_amdgcn_fence(__ATOMIC_RELEASE, "agent");
            asm volatile("s_waitcnt vmcnt(0)" ::: "memory");
            const unsigned og = xb_add(&bar[XB_TOP], 1u);
            const unsigned tg = og / nx;
            if (og + 1u == (tg + 1u) * nx) xb_add(&bar[XB_TOPGEN], 1u);
            else XB_SPIN(xb_ld(&bar[XB_TOPGEN]) == tg, bar);
            __builtin_amdgcn_fence(__ATOMIC_ACQUIRE, "agent");
            xb_add(&bar[XB_XGEN(b.x)], 1u);
            asm volatile("s_waitcnt vmcnt(0)" ::: "memory");
        } else {
            XB_SPIN(xb_ld(&bar[XB_XGEN(b.x)]) == gen, bar);
            __builtin_amdgcn_fence(__ATOMIC_ACQUIRE, "agent");
            asm volatile("s_waitcnt vmcnt(0)" ::: "memory");
        }
    }
    __syncthreads();
}

struct Params {
    const float* in[35];
    float* out;
    unsigned* ctrl;
    float* modv;
    float* lbv;
    float* xc;
    float* lrula;
    float* rope;
    bf16_t* winA; bf16_t* winG; bf16_t* wup; bf16_t* wcat; bf16_t* wout; bf16_t* w13; bf16_t* w2; bf16_t* wlru;
    bf16_t* hx;
    bf16_t* pa;
    bf16_t* up;
    bf16_t* q; bf16_t* qc; unsigned char* kv;
    bf16_t* st; float* stb;
    float* lsum; float* lin;
    bf16_t* ocat;
    bf16_t* y;
    bf16_t* h2; bf16_t* h2p; bf16_t* hid; bf16_t* yo;
    int* tok_e; int* tok_s; float* tok_w; int* lst; float* rww; int* rmr;
    unsigned long long pad_;
};

typedef LAS Params PL;

#define CTRL_CNT(l, e) (4096 + 512 * (l) + 16 * (e))
#define CTRL_WORDS 8192

namespace g8 {
constexpr int BM = 256, BK = 64, HALF = 128, HTB = HALF * BK * 2, STAGE_BYTES = 8 * HTB, NXCD = 8, WGM = 8;
__host__ __device__ __forceinline__ int lds_byte(int r, int c) { const int st = (r >> 4) * 2 + (c >> 5), rr = r & 15, cc = c & 31, ob = rr * 64 + cc * 2; return st * 1024 + (ob ^ (((ob >> 9) & 1) << 5)); }
__host__ __device__ __forceinline__ void stage_rc(int b, int& R, int& C) { const int st = b / 1024, sb = b % 1024, swz = sb ^ (((sb >> 9) & 1) << 5); R = (st >> 1) * 16 + swz / 64; C = (st & 1) * 32 + (swz % 64) / 2; }
__host__ __device__ __forceinline__ int perm32(int rho) { const int n = rho >> 4, i = rho & 15; return 8 * (i >> 2) + 4 * n + (i & 3); }

struct Unit { int pm, pn, tag; const char* a; const char* b; };

__device__ __forceinline__ bool static_order(int i, int G, int c, int nM, int nN, int& pm, int& pn) {
    const int nwg = nM * nN; const long L = (long)i * G + c; if (L >= nwg) return false;
    int wgid = (int)L; { const int q = nwg / NXCD, r = nwg % NXCD, xcd = wgid % NXCD, off = wgid / NXCD; wgid = (xcd < r ? xcd * (q + 1) : r * (q + 1) + (xcd - r) * q) + off; }
    const int nig = WGM * nN, gid = wgid / nig, fm = gid * WGM, gsz = (nM - fm) < WGM ? (nM - fm) : WGM;
    pm = fm + ((wgid % nig) % gsz); pn = (wgid % nig) / gsz; return true;
}

template <class Epi, class Sched>
__device__ __forceinline__ void gemm_phase(LAS unsigned char* lds, const int lda, const int ldb, const int K, const Sched& S, const Epi& E) {
    const int tid = opq_tid(), wid = __builtin_amdgcn_readfirstlane(tid >> 6), lane = tid & 63, wr = wid >> 2, wc = wid & 3, fr = lane & 15, fq = lane >> 4;
    const int nt = K / BK;
    unsigned voffB[2]; int RA[2], CA[2];
#pragma unroll
    for (int i = 0; i < 2; ++i) { int R, C; stage_rc(tid * 16 + i * 8192, R, C); const int Rb = Epi::PERM ? ((R & ~31) + perm32(R & 31)) : R;
        RA[i] = R; CA[i] = C; voffB[i] = (unsigned)(Rb * ldb + C) * 2u; }
    auto set_voff = [&](const Unit& u, unsigned (&v)[2][2]) {
#pragma unroll
        for (int h = 0; h < 2; ++h)
#pragma unroll
            for (int i = 0; i < 2; ++i) { if constexpr (Sched::GATHER) v[h][i] = (unsigned)S.row_of(u, h * HALF + RA[i]) * (unsigned)(lda * 2) + (unsigned)CA[i] * 2u;
                else v[h][i] = (unsigned)((h * HALF + RA[i]) * lda + CA[i]) * 2u; } };
    const size_t kstep = (size_t)(BK * 2);
    const size_t hstepB = (size_t)HALF * ldb * 2;
    const unsigned ldsw = (unsigned)wid * 1024u;
    const int aoff = lds_byte(wr * 64 + fr, fq * 8), boff = lds_byte(wc * 32 + fr, fq * 8);
#define G8_SA(b, h) (((b) * 2 + (h)) * HTB)
#define G8_SB(b, h) ((4 + (b) * 2 + (h)) * HTB)
#define G8_STAGE(bufoff, gbase, voff) do { _Pragma("unroll") for (int _i = 0; _i < 2; ++_i) \
        __builtin_amdgcn_global_load_lds((const unsigned*)((const char*)(gbase) + (voff)[_i]), (LAS unsigned*)(lds + (bufoff) + ldsw + _i * 8192), 16, 0, 0); } while (0)
#define G8_LDA(dst, b, h) do { _Pragma("unroll") for (int m = 0; m < 4; ++m) _Pragma("unroll") for (int k = 0; k < 2; ++k) dst[m][k] = *(const LAS bf16x8*)(lds + G8_SA(b, h) + aoff + m * 2048 + k * 1024); } while (0)
#define G8_LDB(dst, b, h) do { _Pragma("unroll") for (int n = 0; n < 2; ++n) _Pragma("unroll") for (int k = 0; k < 2; ++k) dst[n][k] = *(const LAS bf16x8*)(lds + G8_SB(b, h) + boff + n * 2048 + k * 1024); } while (0)
#define G8_MMA(ai, bj, At, Bt) do { __builtin_amdgcn_s_setprio(1); _Pragma("unroll") for (int m = 0; m < 4; ++m) _Pragma("unroll") for (int n = 0; n < 2; ++n) _Pragma("unroll") for (int k = 0; k < 2; ++k) \
        acc[ai][bj][m][n] = __builtin_amdgcn_mfma_f32_16x16x32_bf16(Bt[n][k], At[m][k], acc[ai][bj][m][n], 0, 0, 0); __builtin_amdgcn_s_setprio(0); } while (0)
#define G8_WAIT_V(n) asm volatile("s_waitcnt vmcnt(" #n ")" ::: "memory")
#define G8_WAIT_L(n) asm volatile("s_waitcnt lgkmcnt(" #n ")" ::: "memory")
#define G8_BAR __builtin_amdgcn_s_barrier()
#define G8_SCHED __builtin_amdgcn_sched_barrier(0)
    Unit cur, nxt; int ui = 0;
    if (!S.next(0, cur)) return;
    f32x4 acc[2][2][4][2];
#pragma unroll
    for (int a = 0; a < 2; ++a)
#pragma unroll
        for (int b = 0; b < 2; ++b)
#pragma unroll
            for (int m = 0; m < 4; ++m)
#pragma unroll
                for (int n = 0; n < 2; ++n) acc[a][b][m][n] = (f32x4){0.f, 0.f, 0.f, 0.f};
    bf16x8 At[4][2], B0[2][2], B1[2][2];
    const char* cA = cur.a; const char* cB = cur.b;
    unsigned vcur[2][2], vnxt[2][2]; set_voff(cur, vcur);
    asm volatile("s_waitcnt lgkmcnt(0)" ::: "memory");
    if constexpr (Sched::GATHER) asm volatile("s_waitcnt vmcnt(0)" ::: "memory");
    G8_STAGE(G8_SB(0, 0), cB, voffB); G8_STAGE(G8_SA(0, 0), cA, vcur[0]); G8_STAGE(G8_SB(0, 1), cB + hstepB, voffB); G8_STAGE(G8_SA(0, 1), cA, vcur[1]);
    if (wr == 1) G8_BAR;
    G8_WAIT_V(4); G8_BAR;
    G8_STAGE(G8_SB(1, 0), cB + kstep, voffB); G8_STAGE(G8_SA(1, 0), cA + kstep, vcur[0]); G8_STAGE(G8_SB(1, 1), cB + hstepB + kstep, voffB);
    G8_WAIT_V(6); G8_BAR;
    for (;;) {
        const bool has_next = S.next(ui + 1, nxt);
        const char* nA = has_next ? nxt.a : cA; const char* nB = has_next ? nxt.b : cB;
        if (has_next) set_voff(nxt, vnxt); else {
#pragma unroll
            for (int h = 0; h < 2; ++h) { vnxt[h][0] = vcur[h][0]; vnxt[h][1] = vcur[h][1]; } }
        asm volatile("s_waitcnt lgkmcnt(0)" ::: "memory");
        const int tseg = nt / Epi::NSEG;
#pragma unroll 1
        for (int sg = 0; sg < Epi::NSEG; ++sg) {
#pragma unroll 1
        for (int t = sg * tseg; t < (sg + 1) * tseg; t += 2) {
            const bool last = (t == nt - 2);
            const char* a1 = cA + (size_t)(t + 1) * kstep;
            const char* a2 = last ? nA : cA + (size_t)(t + 2) * kstep; const char* b2 = last ? nB : cB + (size_t)(t + 2) * kstep;
            const char* a3 = a2 + kstep; const char* b3 = b2 + kstep;
            unsigned v20[2], v21[2];
#pragma unroll
            for (int i = 0; i < 2; ++i) { v20[i] = last ? vnxt[0][i] : vcur[0][i]; v21[i] = last ? vnxt[1][i] : vcur[1][i]; }
            G8_LDB(B0, 0, 0); G8_SCHED; G8_LDA(At, 0, 0); G8_STAGE(G8_SA(1, 1), a1, vcur[1]);
            G8_WAIT_L(8); G8_BAR; G8_WAIT_L(0); G8_MMA(0, 0, At, B0); G8_BAR; G8_SCHED;
            G8_LDB(B1, 0, 1); G8_STAGE(G8_SB(0, 0), b2, voffB);
            G8_BAR; G8_WAIT_L(0); G8_MMA(0, 1, At, B1); G8_BAR;
            G8_LDA(At, 0, 1); G8_STAGE(G8_SA(0, 0), a2, v20);
            G8_BAR; G8_WAIT_L(0); G8_MMA(1, 0, At, B0); G8_BAR; G8_SCHED;
            G8_STAGE(G8_SB(0, 1), b2 + hstepB, voffB);
            G8_WAIT_V(6); G8_BAR; G8_MMA(1, 1, At, B1); G8_BAR;
            G8_LDB(B0, 1, 0); G8_SCHED; G8_LDA(At, 1, 0); G8_STAGE(G8_SA(0, 1), a2, v21);
            G8_WAIT_L(8); G8_BAR; G8_WAIT_L(0); G8_MMA(0, 0, At, B0); G8_BAR; G8_SCHED;
            G8_LDB(B1, 1, 1); G8_STAGE(G8_SB(1, 0), b3, voffB);
            G8_BAR; G8_WAIT_L(0); G8_MMA(0, 1, At, B1); G8_BAR;
            G8_LDA(At, 1, 1); G8_STAGE(G8_SA(1, 0), a3, v20);
            G8_BAR; G8_WAIT_L(0); G8_MMA(1, 0, At, B0); G8_BAR; G8_SCHED;
            G8_STAGE(G8_SB(1, 1), b3 + hstepB, voffB);
            G8_WAIT_V(6); G8_BAR; G8_MMA(1, 1, At, B1); G8_BAR;
        }
        if constexpr (Epi::NSEG > 1) { if (sg + 1 < Epi::NSEG) E.mid(sg, acc, cur, wr, wc, fr, fq); }
        }
        E(acc, cur, wr, wc, fr, fq);
        if (!has_next) break;
#pragma unroll
        for (int a = 0; a < 2; ++a)
#pragma unroll
            for (int b = 0; b < 2; ++b)
#pragma unroll
                for (int m = 0; m < 4; ++m)
#pragma unroll
                    for (int n = 0; n < 2; ++n) acc[a][b][m][n] = (f32x4){0.f, 0.f, 0.f, 0.f};
        cur = nxt; cA = nA; cB = nB; ++ui;
#pragma unroll
        for (int h = 0; h < 2; ++h) { vcur[h][0] = vnxt[h][0]; vcur[h][1] = vnxt[h][1]; }
    }
    G8_WAIT_V(0);
    if (wr == 0) G8_BAR;
    G8_BAR;
#undef G8_SA
#undef G8_SB
#undef G8_STAGE
#undef G8_LDA
#undef G8_LDB
#undef G8_MMA
#undef G8_WAIT_V
#undef G8_WAIT_L
#undef G8_BAR
#undef G8_SCHED
}
}

enum { I_X = 0, I_C, I_CTX, I_CCTX, I_WMOD, I_BMOD, I_NMIX, I_NFFN, I_WIN, I_HGLB, I_HGNORM, I_QNORM, I_KVNORM, I_WUQ, I_WUKV, I_GQ, I_GK,
       I_CONVW, I_CONVB, I_LWA, I_LBA, I_LWX, I_LBX, I_LAM, I_BRHG, I_BRMLA, I_BRLRU, I_WOUT, I_WRG, I_BRG, I_WRE, I_BRE, I_W1, I_W3, I_W2 };

DEVI const float* xin_row_l0(const Params& p, int r) { const int b = r / RB, pos = r - b * RB;
    return pos < SEQ ? p.in[I_X] + ((size_t)b * SEQ + pos) * DM : p.in[I_CTX] + ((size_t)b * CTX + (pos - SEQ)) * DM; }
DEVI float* xbuf_row(const Params& p, int r) { const int b = r / RB, pos = r - b * RB;
    return pos < SEQ ? p.out + ((size_t)b * SEQ + pos) * DM : p.xc + ((size_t)b * CTX + (pos - SEQ)) * DM; }
DEVI int mod_row(int r) { const int b = r / RB, pos = r - b * RB; return pos < SEQ ? b : 4; }

struct TrJob { const float* src; int ld; int K; int ncols; bf16_t* dst; int dld; const float* ks; };

DEVI int tr_job_count() { return DEPTH * (12 + 16 * 5 + 32); }
template <class P> DEVI TrJob tr_job(const P& p, int j) {
    const int per = 12 + 16 * 5 + 32; const int l = j / per; int q = j - l * per; TrJob t; t.ks = nullptr; t.src = nullptr;
    const float* win = p.in[I_WIN] + (size_t)l * DM * INW;
    bf16_t* winA = p.winA + (size_t)l * PA_W * DM; bf16_t* wup = p.wup + (size_t)l * UPW * 256; bf16_t* wcat = p.wcat + (size_t)l * DM * OCW;
    if (q == 0) { t.src = win; t.ld = INW; t.K = DM; t.ncols = 2944; t.dst = winA; t.dld = DM; return t; }
    if (q == 11) { t.src = win + 2944; t.ld = INW; t.K = DM; t.ncols = 32; t.dst = winA + (size_t)2944 * DM; t.dld = DM; return t; }
    if (q == 1) { t.src = nullptr; t.ld = 0; t.K = DM; t.ncols = 96; t.dst = winA + (size_t)2976 * DM; t.dld = DM; return t; }
    if (q == 2) { t.src = win + 2976; t.ld = INW; t.K = DM; t.ncols = 1024; t.dst = winA + (size_t)3072 * DM; t.dld = DM; return t; }
    if (q == 3) { t.src = win + 4000; t.ld = INW; t.K = DM; t.ncols = PG_W; t.dst = p.winG + (size_t)l * PG_W * DM; t.dld = DM; return t; }
    if (q == 4) { t.src = p.in[I_WUQ] + (size_t)l * 256 * 768; t.ld = 768; t.K = 256; t.ncols = 768; t.dst = wup; t.dld = 256; t.ks = p.in[I_QNORM] + l * 256; return t; }
    if (q == 5) { t.src = p.in[I_WUKV] + (size_t)l * 128 * 1024; t.ld = 1024; t.K = 128; t.ncols = 1024; t.dst = wup + (size_t)768 * 256; t.dld = 256; t.ks = p.in[I_KVNORM] + l * 128; return t; }
    if (q == 6) { t.src = nullptr; t.ld = 0; t.K = 128; t.ncols = 1024; t.dst = wup + (size_t)768 * 256 + 128; t.dld = 256; return t; }
    if (q >= 7 && q <= 9) { const int i = q - 7; const float* s = (i == 0 ? p.in[I_BRHG] : i == 1 ? p.in[I_BRMLA] : p.in[I_BRLRU]) + (size_t)l * 512 * DM;
        t.src = s; t.ld = DM; t.K = 512; t.ncols = DM; t.dst = wcat + i * 512; t.dld = OCW; return t; }
    if (q == 10) { t.src = p.in[I_WOUT] + (size_t)l * DM * DM; t.ld = DM; t.K = DM; t.ncols = DM; t.dst = p.wout + (size_t)l * DM * DM; t.dld = DM; return t; }
    q -= 12;
    if (q < 80) { const int e = q / 5, s = q % 5; const size_t le = (size_t)l * NEXP + e;
        if (s < 4) { const int pn = s >> 1, which = s & 1;
            t.src = (which ? p.in[I_W3] : p.in[I_W1]) + le * DM * DEXP + pn * 128; t.ld = DEXP; t.K = DM; t.ncols = 128;
            t.dst = p.w13 + le * 512 * DM + (size_t)(pn * 256 + which * 128) * DM; t.dld = DM; return t; }
        t.src = p.in[I_W2] + le * DEXP * DM; t.ld = DM; t.K = DEXP; t.ncols = DM; t.dst = p.w2 + le * DM * DEXP; t.dld = DEXP; return t; }
    q -= 80;
    { const int d = q >> 4, n = (q >> 1) & 7, which = q & 1;
      const size_t blk = (((size_t)l * 2 + d) * 8 + n);
      t.src = (which ? p.in[I_LWX] : p.in[I_LWA]) + blk * 64 * 64; t.ld = 64; t.K = 64; t.ncols = 64;
      t.dst = p.wlru + (blk * 2 + which) * 64 * 64; t.dld = 64; return t; }
}

template <class P> DEVI void phase_prep(const P& p, LAS unsigned char* lds) {
    const int tid = opq_tid(), G = gridDim.x;
    LAS float* tl = (LAS float*)lds;
    int rot = 0; const int nj = tr_job_count();
    for (int j = 0; j < nj; ++j) {
        const TrJob t = tr_job(p, j);
        const bool wide = (t.ncols & 63) == 0;
        const int tw = wide ? 64 : 32, tk = t.K / 64, ntile = tk * (t.ncols / tw);
        const int first = (int)((opq_bid() + (unsigned)G - (unsigned)(rot % G)) % (unsigned)G);
        if (wide) {
            for (int tile0 = first; tile0 < ntile; tile0 += 4 * G) {
                f32x4 v[4][2];
#pragma unroll
                for (int q = 0; q < 4; ++q) { const int tile = tile0 + q * G; const int k0 = (tile % tk) * 64, n0 = (tile / tk) * 64; const int n4 = tid & 15, kr = tid >> 4;
#pragma unroll
                    for (int i = 0; i < 2; ++i) { const int k = kr + 32 * i; f32x4 x = {0.f, 0.f, 0.f, 0.f};
                        if (tile < ntile && t.src) { x = *(const f32x4*)(t.src + (size_t)(k0 + k) * t.ld + n0 + n4 * 4); if (t.ks) x *= t.ks[k0 + k]; }
                        v[q][i] = x; } }
#pragma unroll
                for (int q = 0; q < 4; ++q) { const int n4 = tid & 15, kr = tid >> 4;
#pragma unroll
                    for (int i = 0; i < 2; ++i) { LAS float* d = tl + q * 4160 + (kr + 32 * i) * 65 + n4 * 4; d[0] = v[q][i][0]; d[1] = v[q][i][1]; d[2] = v[q][i][2]; d[3] = v[q][i][3]; } }
                __syncthreads();
#pragma unroll
                for (int q = 0; q < 4; ++q) { const int tile = tile0 + q * G; if (tile < ntile) { const int k0 = (tile % tk) * 64, n0 = (tile / tk) * 64; const int n = tid >> 3, k8 = (tid & 7) * 8;
                    const LAS float* sp = tl + q * 4160 + k8 * 65 + n;
                    u32x4 w; w.x = cvt_pk_bf16(sp[0], sp[65]); w.y = cvt_pk_bf16(sp[130], sp[195]); w.z = cvt_pk_bf16(sp[260], sp[325]); w.w = cvt_pk_bf16(sp[390], sp[455]);
                    *(u32x4*)(t.dst + (size_t)(n0 + n) * t.dld + k0 + k8) = w; } }
                __syncthreads();
            }
        } else {
            for (int tile0 = first; tile0 < ntile; tile0 += 8 * G) {
                float v[8][4];
#pragma unroll
                for (int q = 0; q < 8; ++q) { const int tile = tile0 + q * G; const int k0 = (tile % tk) * 64, n0 = (tile / tk) * 32; const int n = tid & 31, kr = tid >> 5;
#pragma unroll
                    for (int i = 0; i < 4; ++i) { const int k = kr + 16 * i; float x = 0.f;
                        if (tile < ntile && t.src) { x = t.src[(size_t)(k0 + k) * t.ld + n0 + n]; if (t.ks) x *= t.ks[k0 + k]; }
                        v[q][i] = x; } }
#pragma unroll
                for (int q = 0; q < 8; ++q) { const int n = tid & 31, kr = tid >> 5;
#pragma unroll
                    for (int i = 0; i < 4; ++i) tl[q * 2112 + (kr + 16 * i) * 33 + n] = v[q][i]; }
                __syncthreads();
#pragma unroll
                for (int q = 0; q < 8; ++q) { const int tile = tile0 + q * G; if (tile < ntile) { const int k0 = (tile % tk) * 64, n0 = (tile / tk) * 32; const int k = tid & 63, nn = tid >> 6;
#pragma unroll
                    for (int i = 0; i < 4; ++i) { const int n = nn + 8 * i; t.dst[(size_t)(n0 + n) * t.dld + k0 + k] = f2bf(tl[q * 2112 + k * 33 + n]); } } }
                __syncthreads();
            }
        }
        rot += ntile;
    }
    {
        LAS float* sl = (LAS float*)lds;
        LAS float* red = sl + 5 * 1024;
        for (int i = tid; i < 5 * 1024; i += 512) { const int r = i >> 10, k = i & 1023; const float v = r < 4 ? p.in[I_C][r * DM + k] : p.in[I_CCTX][k]; sl[i] = v * sigmoidf_(v); }
        __syncthreads();
        for (int u = opq_bid(); u < DEPTH * 96; u += G) {
            const int l = u / 96, n0 = (u % 96) * 64, col = tid & 63, ks = tid >> 6;
            const float* w = p.in[I_WMOD] + (size_t)l * DM * 6144 + n0 + col;
            float a0 = 0.f, a1 = 0.f, a2 = 0.f, a3 = 0.f, a4 = 0.f;
#pragma unroll 8
            for (int k = ks * 128; k < ks * 128 + 128; ++k) { const float wv = w[(size_t)k * 6144];
                a0 += sl[k] * wv; a1 += sl[1024 + k] * wv; a2 += sl[2048 + k] * wv; a3 += sl[3072 + k] * wv; a4 += sl[4096 + k] * wv; }
            red[(ks * 5 + 0) * 64 + col] = a0; red[(ks * 5 + 1) * 64 + col] = a1; red[(ks * 5 + 2) * 64 + col] = a2; red[(ks * 5 + 3) * 64 + col] = a3; red[(ks * 5 + 4) * 64 + col] = a4;
            __syncthreads();
            if (tid < 320) { const int r = tid >> 6, c2 = tid & 63; float s = p.in[I_BMOD][l * 6144 + n0 + c2];
#pragma unroll
                for (int q = 0; q < 8; ++q) s += red[(q * 5 + r) * 64 + c2];
                p.modv[((size_t)l * 5 + r) * 6144 + n0 + c2] = s; }
            __syncthreads();
        }
    }
    for (int i = opq_bid() * 512 + tid; i < SEQ * 16; i += G * 512) { const int pos = i >> 4, a = i & 15;
        const float inv = exp2f(-(float)(a & 7) * (13.287712379549449f / 8.0f)); const float ang = (float)((a < 8) ? (pos >> 6) : (pos & 63)) * inv;
        float sn, cs; sincosf(ang, &sn, &cs); p.rope[(size_t)pos * 32 + a] = cs; p.rope[(size_t)pos * 32 + 16 + a] = sn; }
    if (opq_bid() == 1) { for (int i = tid; i < DEPTH * 2 * 512; i += 512) p.lrula[i] = -8.0f * 1.44269504f * log1pf(__expf(-p.in[I_LAM][i])); }
    if (opq_bid() == 0) {
        for (int i = tid; i < 2 * 512; i += 512) { const float a0 = p.in[I_HGLB][i], a1 = p.in[I_HGLB][1024 + i]; const float m = fmaxf(a0, a1);
            const float e0 = __expf(a0 - m), e1 = __expf(a1 - m); p.lbv[i] = 0.f; p.lbv[1024 + i] = e1 / (e0 + e1); }
    }
}

DEVI void phase_norm1(const Params& p, int l, int hb) {
    const int lane = opq_tid() & 63, wv = opq_tid() >> 6;
    const float* gm = p.in[I_NMIX] + l * DM;
    const int rstep = gridDim.x * 8, rfirst = opq_bid() * 8 + wv;
    auto rowp = [&](int rl) -> const float* { const int r = hb * HR + rl; return (l == 0) ? xin_row_l0(p, r) : (const float*)xbuf_row(p, r); };
    f32x4 vn[4];
    if (rfirst < HR) { const float* s0 = rowp(rfirst);
#pragma unroll
        for (int i = 0; i < 4; ++i) vn[i] = *(const f32x4*)(s0 + i * 256 + lane * 4); }
    for (int rl = rfirst; rl < HR; rl += rstep) {
        const int r = hb * HR + rl;
        f32x4 v[4]; float ss = 0.f;
#pragma unroll
        for (int i = 0; i < 4; ++i) { v[i] = vn[i]; ss += v[i][0] * v[i][0] + v[i][1] * v[i][1] + v[i][2] * v[i][2] + v[i][3] * v[i][3]; }
        if (rl + rstep < HR) { const float* s1 = rowp(rl + rstep);
#pragma unroll
            for (int i = 0; i < 4; ++i) vn[i] = *(const f32x4*)(s1 + i * 256 + lane * 4); }
        ss = wave_sum(ss);
        const float rstd = rsqrtf(ss * (1.0f / DM) + EPSF);
        const float* mv = p.modv + ((size_t)l * 5 + mod_row(r)) * 6144;
#pragma unroll
        for (int i = 0; i < 4; ++i) { const int c = i * 256 + lane * 4;
            const f32x4 g = *(const f32x4*)(gm + c), sh = *(const f32x4*)(mv + c), sc = *(const f32x4*)(mv + 1024 + c);
            f32x4 h;
#pragma unroll
            for (int e = 0; e < 4; ++e) h[e] = v[i][e] * rstd * g[e] * (1.0f + sc[e]) + sh[e];
            u32x2 w; w.x = cvt_pk_bf16(h[0], h[1]); w.y = cvt_pk_bf16(h[2], h[3]);
            *(u32x2*)(p.hx + (size_t)rl * DM + c) = w; }
    }
}
struct TileSched {
    static constexpr bool GATHER = false;
    int nM, nN, G, c, skipctx; const char* A; const char* B; size_t atile, btile; size_t acol_bytes;
    DEVI bool next(int i, g8::Unit& u) const {
        int pm, pn; if (!g8::static_order(i, G, c, nM, nN, pm, pn)) return false;
        const int pma = skipctx ? pm + pm / 32 : pm;
        u.pm = pma; u.pn = pn; u.tag = 0; u.a = A + (size_t)pma * atile + acol_bytes; u.b = B + (size_t)pn * btile; return true; }
};

template <int ACT> struct EpiBf16 {
    static constexpr bool PERM = true, HAS_MID = false; static constexpr int NSEG = 1;
    bf16_t* O; int ldc;
    DEVI void operator()(const f32x4 (&acc)[2][2][4][2], const g8::Unit& u, int wr, int wc, int fr, int fq) const {
        const int row0 = u.pm * 256 + wr * 64 + fr, col0 = u.pn * 256 + wc * 32 + 8 * fq;
#pragma unroll
        for (int ai = 0; ai < 2; ++ai)
#pragma unroll
            for (int m = 0; m < 4; ++m) { bf16_t* rowp = O + (size_t)(row0 + ai * 128 + m * 16) * ldc + col0;
#pragma unroll
                for (int bj = 0; bj < 2; ++bj) { f32x4 v0 = acc[ai][bj][m][0], v1 = acc[ai][bj][m][1];
                    if (ACT == 1) {
#pragma unroll
                        for (int e = 0; e < 4; ++e) { v0[e] = sigmoidf_(v0[e]); v1[e] = sigmoidf_(v1[e]); } }
                    u32x4 w; w.x = cvt_pk_bf16(v0[0], v0[1]); w.y = cvt_pk_bf16(v0[2], v0[3]); w.z = cvt_pk_bf16(v1[0], v1[1]); w.w = cvt_pk_bf16(v1[2], v1[3]);
                    *(u32x4*)(rowp + bj * 128) = w; } }
    }
};

DEVI void phase_inproj_a(const Params& p, int l, LAS unsigned char* lds) {
    TileSched S; S.nM = HR / 256; S.nN = PA_W / 256; S.G = gridDim.x; S.c = opq_bid(); S.skipctx = 0;
    S.A = (const char*)p.hx; S.B = (const char*)(p.winA + (size_t)l * PA_W * DM); S.atile = (size_t)256 * DM * 2; S.btile = (size_t)256 * DM * 2; S.acol_bytes = 0;
    EpiBf16<0> E; E.O = p.pa; E.ldc = PA_W;
    g8::gemm_phase(lds, DM, DM, DM, S, E);
}

struct UpSched { static constexpr bool GATHER = false; int G, c; const char* A; const char* B;
    DEVI bool next(int i, g8::Unit& u) const { const long L = (long)i * G + c; if (L >= (HR / 256) * 7) return false;
        const int pm = (int)(L / 7), j = (int)(L % 7); u.pm = pm; u.pn = j; u.tag = 0;
        u.a = A + (size_t)pm * 256 * PA_W * 2 + (size_t)(j < 3 ? C_DQ : C_DKV) * 2; u.b = B + (size_t)j * 256 * 256 * 2; return true; } };
DEVI void phase_mla_up(const Params& p, int l, LAS unsigned char* lds) {
    UpSched S; S.G = gridDim.x; S.c = opq_bid(); S.A = (const char*)p.pa; S.B = (const char*)(p.wup + (size_t)l * UPW * 256);
    EpiBf16<0> E; E.O = p.up; E.ldc = UPW;
    g8::gemm_phase(lds, PA_W, 256, 256, S, E);
}

DEVI void phase_inproj_g(const Params& p, int l, LAS unsigned char* lds) {
    const int skip = (l == DEPTH - 1);
    TileSched S; S.nM = skip ? 64 : HR / 256; S.nN = PG_W / 256; S.G = gridDim.x; S.c = opq_bid(); S.skipctx = skip;
    S.A = (const char*)p.hx; S.B = (const char*)(p.winG + (size_t)l * PG_W * DM); S.atile = (size_t)256 * DM * 2; S.btile = (size_t)256 * DM * 2; S.acol_bytes = 0;
    EpiBf16<1> E; E.O = p.pa; E.ldc = PG_W;
    g8::gemm_phase(lds, DM, DM, DM, S, E);
}

struct EpiMerge {
    static constexpr bool PERM = true; static constexpr int NSEG = 3;
    const bf16_t* pg; bf16_t* Y;
    static DEVI void unpack8(const u32x4& w, float (&f)[8]) {
#pragma unroll
        for (int e = 0; e < 8; ++e) { const unsigned x = w[e >> 1]; f[e] = (e & 1) ? __uint_as_float(x & 0xffff0000u) : __uint_as_float(x << 16); } }
    DEVI void mid(int sg, f32x4 (&acc)[2][2][4][2], const g8::Unit& u, int wr, int wc, int fr, int fq) const {
        const int row0 = u.pm * 256 + wr * 64 + fr, col0 = u.pn * 256 + wc * 32 + 8 * fq;
        const bf16_t* gbase = pg + (size_t)row0 * PG_W + col0 + sg * 1024;
#pragma unroll
        for (int ai = 0; ai < 2; ++ai)
#pragma unroll
            for (int mp = 0; mp < 2; ++mp) {
#pragma unroll
                for (int mi = 0; mi < 2; ++mi) { const int m = mp * 2 + mi; const bf16_t* gp = gbase + (size_t)(ai * 128 + m * 16) * PG_W;
#pragma unroll
                    for (int bj = 0; bj < 2; ++bj) { const u32x4 a = *(const u32x4*)(gp + bj * 128), b = *(const u32x4*)(gp + 1024 + bj * 128);
                        float fa[8], fb[8]; unpack8(a, fa); unpack8(b, fb);
#pragma unroll
                        for (int e = 0; e < 8; ++e) acc[ai][bj][m][e >> 2][e & 3] *= fa[e] * fast_rcp(fmaxf(fb[e], 1e-30f)); } }
                asm volatile("" : "+v"(acc[ai][0][mp * 2][0]), "+v"(acc[ai][0][mp * 2][1]), "+v"(acc[ai][1][mp * 2][0]), "+v"(acc[ai][1][mp * 2][1]),
                                  "+v"(acc[ai][0][mp * 2 + 1][0]), "+v"(acc[ai][0][mp * 2 + 1][1]), "+v"(acc[ai][1][mp * 2 + 1][0]), "+v"(acc[ai][1][mp * 2 + 1][1]) :: "memory"); }
    }
    DEVI void operator()(f32x4 (&acc)[2][2][4][2], const g8::Unit& u, int wr, int wc, int fr, int fq) const {
        const int row0 = u.pm * 256 + wr * 64 + fr, col0 = u.pn * 256 + wc * 32 + 8 * fq;
#pragma unroll
        for (int ai = 0; ai < 2; ++ai)
#pragma unroll
            for (int mp = 0; mp < 2; ++mp) {
#pragma unroll
                for (int mi = 0; mi < 2; ++mi) { const int m = mp * 2 + mi; const size_t row = (size_t)(row0 + ai * 128 + m * 16); const bf16_t* gp = pg + row * PG_W + col0 + 2048;
#pragma unroll
                    for (int bj = 0; bj < 2; ++bj) { const u32x4 a = *(const u32x4*)(gp + bj * 128); float fa[8]; unpack8(a, fa);
                        const f32x4 v0 = acc[ai][bj][m][0], v1 = acc[ai][bj][m][1];
                        u32x4 w; w.x = cvt_pk_bf16(v0[0] * fa[0], v0[1] * fa[1]); w.y = cvt_pk_bf16(v0[2] * fa[2], v0[3] * fa[3]);
                        w.z = cvt_pk_bf16(v1[0] * fa[4], v1[1] * fa[5]); w.w = cvt_pk_bf16(v1[2] * fa[6], v1[3] * fa[7]);
                        *(u32x4*)(Y + row * DM + col0 + bj * 128) = w; } }
                asm volatile("" ::: "memory"); }
    }
};
DEVI void phase_merge(const Params& p, int l, LAS unsigned char* lds) {
    const int skip = (l == DEPTH - 1);
    TileSched S; S.nM = skip ? 64 : HR / 256; S.nN = DM / 256; S.G = gridDim.x; S.c = opq_bid(); S.skipctx = skip;
    S.A = (const char*)p.ocat; S.B = (const char*)(p.wcat + (size_t)l * DM * OCW); S.atile = (size_t)256 * OCW * 2; S.btile = (size_t)256 * OCW * 2; S.acol_bytes = 0;
    EpiMerge E; E.pg = p.pa; E.Y = p.y;
    g8::gemm_phase(lds, OCW, OCW, OCW, S, E);
}

struct EpiOut {
    static constexpr bool PERM = false, HAS_MID = false; static constexpr int NSEG = 1;
    const float* x0; const float* c0; float* xo_; float* xc_; const float* modv; int l, hb;
    DEVI void operator()(const f32x4 (&acc)[2][2][4][2], const g8::Unit& u, int wr, int wc, int fr, int fq) const {
        const int row0 = u.pm * 256 + wr * 64 + fr, col0 = u.pn * 256 + wc * 32 + 4 * fq;
#pragma unroll
        for (int ai = 0; ai < 2; ++ai)
#pragma unroll
            for (int m = 0; m < 4; ++m) { const int r = hb * HR + row0 + ai * 128 + m * 16;
                const int b = r / RB, pos = r - b * RB; const bool lat = pos < SEQ;
                const size_t xoff = lat ? ((size_t)b * SEQ + pos) * DM : ((size_t)b * CTX + (pos - SEQ)) * DM;
                float* xo = (lat ? xo_ : xc_) + xoff; const float* xi = (l == 0) ? (lat ? x0 : c0) + xoff : (const float*)xo;
                const float* g1 = modv + ((size_t)l * 5 + (lat ? b : 4)) * 6144 + 2048;
#pragma unroll
                for (int bj = 0; bj < 2; ++bj)
#pragma unroll
                    for (int n = 0; n < 2; ++n) { const int c = col0 + bj * 128 + n * 16;
                        const f32x4 xv = *(const f32x4*)(xi + c), gv = *(const f32x4*)(g1 + c);
                        *(f32x4*)(xo + c) = xv + gv * acc[ai][bj][m][n]; } }
    }
};
DEVI void phase_outproj(const Params& p, int l, int hb, LAS unsigned char* lds) {
    const int skip = (l == DEPTH - 1);
    TileSched S; S.nM = skip ? 64 : HR / 256; S.nN = DM / 256; S.G = gridDim.x; S.c = opq_bid(); S.skipctx = skip;
    S.A = (const char*)p.y; S.B = (const char*)(p.wout + (size_t)l * DM * DM); S.atile = (size_t)256 * DM * 2; S.btile = (size_t)256 * DM * 2; S.acol_bytes = 0;
    EpiOut E; E.x0 = p.in[I_X]; E.c0 = p.in[I_CTX]; E.xo_ = p.out; E.xc_ = p.xc; E.modv = p.modv; E.l = l; E.hb = hb;
    g8::gemm_phase(lds, DM, DM, DM, S, E);
}

DEVI void phase_qkv(const Params& p, int l, LAS unsigned char* lds) {
    const int tid = opq_tid(), lane = tid & 63, wv = tid >> 6, h = lane >> 3, sub = lane & 7;
    LAS bf16_t* vt = (LAS bf16_t*)lds;
    const float* gq = p.in[I_GQ] + l * 96; const float* gk = p.in[I_GK] + l * 96;
    float gqn[8], gkn[8], gqr[4], gkr[4];
#pragma unroll
    for (int e = 0; e < 8; ++e) { gqn[e] = gq[sub * 8 + e]; gkn[e] = gk[sub * 8 + e]; }
#pragma unroll
    for (int e = 0; e < 4; ++e) { gqr[e] = gq[64 + sub * 4 + e]; gkr[e] = gk[64 + sub * 4 + e]; }
    const float qscale = 0.10206207261596577f * 1.4426950408889634f;
    const bool need_ctx_q = (l < DEPTH - 1);
    const bool upper = (sub & 4) != 0;
    struct QkIn { u32x2 dqw; unsigned dkw; u32x2 krw; u32x4 qnw; u32x2 qrw; u32x4 knw, vw; f32x4 cs4, sn4; };
    auto load_rows = [&](int u, QkIn (&r)[2]) {
        const int bl = u / (NCH * 4), tile = (u >> 2) % NCH, qtr = u & 3;
#pragma unroll
        for (int it = 0; it < 2; ++it) { const int pos = tile * 64 + qtr * 16 + wv * 2 + it, rl = bl * RB + pos;
            const bf16_t* prow = p.pa + (size_t)rl * PA_W; const bf16_t* urow = p.up + (size_t)rl * UPW;
            r[it].dqw = *(const u32x2*)(prow + C_DQ + lane * 4); r[it].dkw = *(const unsigned*)(prow + C_DKV + lane * 2); r[it].krw = *(const u32x2*)(prow + C_KR + sub * 4);
            r[it].qnw = *(const u32x4*)(urow + h * 96 + sub * 8); r[it].qrw = *(const u32x2*)(urow + h * 96 + 64 + sub * 4);
            r[it].knw = *(const u32x4*)(urow + 768 + h * 128 + sub * 8); r[it].vw = *(const u32x4*)(urow + 768 + h * 128 + 64 + sub * 8);
            r[it].cs4 = (f32x4){1.f, 1.f, 1.f, 1.f}; r[it].sn4 = (f32x4){0.f, 0.f, 0.f, 0.f};
            if (pos < SEQ) { const float* rt = p.rope + (size_t)pos * 32 + (sub & 3) * 4; r[it].cs4 = *(const f32x4*)rt; r[it].sn4 = *(const f32x4*)(rt + 16); } } };
    QkIn cur[2], nxt[2];
    const int nunit = 2 * NCH * 4, G = gridDim.x;
    if ((int)opq_bid() < nunit) load_rows(opq_bid(), cur);
    for (int u = opq_bid(); u < nunit; u += G) {
        const int bl = u / (NCH * 4), tile = (u >> 2) % NCH, qtr = u & 3;
        const bool more = u + G < nunit; if (more) load_rows(u + G, nxt);
#pragma unroll
        for (int it = 0; it < 2; ++it) {
            const int r16 = wv * 2 + it, rr = qtr * 16 + r16, pos = tile * 64 + rr;
            const bool lat = pos < SEQ;
            const u32x2 dqw = cur[it].dqw; const unsigned dkw = cur[it].dkw; const u32x2 krw = cur[it].krw; const u32x4 qnw = cur[it].qnw; const u32x2 qrw = cur[it].qrw;
            const u32x4 knw = cur[it].knw, vw = cur[it].vw; const f32x4 cs4 = cur[it].cs4, sn4 = cur[it].sn4;
            float sq, skv;
            { const float a0 = __uint_as_float(dqw.x << 16), a1 = __uint_as_float(dqw.x & 0xffff0000u), a2 = __uint_as_float(dqw.y << 16), a3 = __uint_as_float(dqw.y & 0xffff0000u);
              sq = a0 * a0 + a1 * a1 + a2 * a2 + a3 * a3;
              const float b0 = __uint_as_float(dkw << 16), b1 = __uint_as_float(dkw & 0xffff0000u); skv = b0 * b0 + b1 * b1; }
            sq = wave_sum(sq); skv = wave_sum(skv);
            const float rq = rsqrtf(sq * (1.0f / 256.0f) + EPSF), rkv = rsqrtf(skv * (1.0f / 128.0f) + EPSF);
            float qn[8], qr[4], kn[8], kr[4];
#pragma unroll
            for (int e = 0; e < 8; ++e) { const unsigned a = qnw[e >> 1], b = knw[e >> 1];
                qn[e] = ((e & 1) ? __uint_as_float(a & 0xffff0000u) : __uint_as_float(a << 16)) * rq;
                kn[e] = ((e & 1) ? __uint_as_float(b & 0xffff0000u) : __uint_as_float(b << 16)) * rkv; }
#pragma unroll
            for (int e = 0; e < 4; ++e) { const unsigned a = (e < 2) ? qrw.x : qrw.y, b = (e < 2) ? krw.x : krw.y;
                qr[e] = ((e & 1) ? __uint_as_float(a & 0xffff0000u) : __uint_as_float(a << 16)) * rq;
                kr[e] = ((e & 1) ? __uint_as_float(b & 0xffff0000u) : __uint_as_float(b << 16)); }
            float sqq = 0.f, skk = 0.f;
#pragma unroll
            for (int e = 0; e < 8; ++e) { sqq += qn[e] * qn[e]; skk += kn[e] * kn[e]; }
#pragma unroll
            for (int e = 0; e < 4; ++e) { sqq += qr[e] * qr[e]; skk += kr[e] * kr[e]; }
            sqq += __shfl_xor(sqq, 1); sqq += __shfl_xor(sqq, 2); sqq += __shfl_xor(sqq, 4);
            skk += __shfl_xor(skk, 1); skk += __shfl_xor(skk, 2); skk += __shfl_xor(skk, 4);
            const float rnq = rsqrtf(sqq * (1.0f / 96.0f) + EPSF) * qscale, rnk = rsqrtf(skk * (1.0f / 96.0f) + EPSF);
            float qo[12], ko[12];
#pragma unroll
            for (int e = 0; e < 8; ++e) { qo[e] = qn[e] * rnq * gqn[e]; ko[e] = kn[e] * rnk * gkn[e]; }
#pragma unroll
            for (int e = 0; e < 4; ++e) { const float a = qr[e] * rnq * gqr[e], b = kr[e] * rnk * gkr[e];
                const float pa_ = __shfl_xor(a, 4), pb_ = __shfl_xor(b, 4);
                qo[8 + e] = upper ? (a * cs4[e] + pa_ * sn4[e]) : (a * cs4[e] - pa_ * sn4[e]);
                ko[8 + e] = upper ? (b * cs4[e] + pb_ * sn4[e]) : (b * cs4[e] - pb_ * sn4[e]); }
            if (lat || need_ctx_q) {
                bf16_t* qd = lat ? p.q + (((size_t)(bl * 8 + h) * SEQ + pos) * 96) : p.qc + (((size_t)(bl * 8 + h) * CTX + (pos - SEQ)) * 96);
                u32x4 w; w.x = cvt_pk_bf16(qo[0], qo[1]); w.y = cvt_pk_bf16(qo[2], qo[3]); w.z = cvt_pk_bf16(qo[4], qo[5]); w.w = cvt_pk_bf16(qo[6], qo[7]);
                *(u32x4*)(qd + sub * 8) = w;
                u32x2 w2; w2.x = cvt_pk_bf16(qo[8], qo[9]); w2.y = cvt_pk_bf16(qo[10], qo[11]);
                *(u32x2*)(qd + 64 + sub * 4) = w2; }
            { bf16_t* kd = (bf16_t*)(p.kv + ((size_t)(bl * 8 + h) * NCH + tile) * KVT_BYTES + rr * 208);
              u32x4 w; w.x = cvt_pk_bf16(ko[0], ko[1]); w.y = cvt_pk_bf16(ko[2], ko[3]); w.z = cvt_pk_bf16(ko[4], ko[5]); w.w = cvt_pk_bf16(ko[6], ko[7]);
              *(u32x4*)(kd + sub * 8) = w;
              u32x2 w2; w2.x = cvt_pk_bf16(ko[8], ko[9]); w2.y = cvt_pk_bf16(ko[10], ko[11]);
              *(u32x2*)(kd + 64 + sub * 4) = w2; }
#pragma unroll
            for (int e = 0; e < 8; ++e) { const unsigned a = vw[e >> 1]; const float v = ((e & 1) ? __uint_as_float(a & 0xffff0000u) : __uint_as_float(a << 16)) * rkv;
                vt[(h * 64 + sub * 8 + e) * 20 + r16] = f2bf(v); }
        }
        __syncthreads();
        for (int i = tid; i < 8 * 64 * 4; i += 512) { const int hh = i >> 8, rem = i & 255, vc = rem >> 2, pc = rem & 3;
            const u32x2 w = *(const LAS u32x2*)(vt + (hh * 64 + vc) * 20 + pc * 4);
            *(u32x2*)(p.kv + ((size_t)(bl * 8 + hh) * NCH + tile) * KVT_BYTES + KT_BYTES + vc * 136 + qtr * 32 + pc * 8) = w; }
        __syncthreads();
        if (more) { cur[0] = nxt[0]; cur[1] = nxt[1]; }
    }
}

DEVI void attn_unit(const Params& p, LAS unsigned char* lds, const bf16_t* Qb, int nq, const unsigned char* kvb, int ntile, bf16_t* orow, float accinit) {
    const int tid = opq_tid(), lane = tid & 63, wv = __builtin_amdgcn_readfirstlane(tid >> 6), l31 = lane & 31, hh = lane >> 5;
    const bool active = wv * 64 < nq;
    bf16x8 qf[2][6];
#pragma unroll
    for (int qt = 0; qt < 2; ++qt)
#pragma unroll
        for (int ks = 0; ks < 6; ++ks) {
            if (active) qf[qt][ks] = *(const bf16x8*)(Qb + (size_t)(wv * 64 + qt * 32 + l31) * 96 + ks * 16 + hh * 8);
            else qf[qt][ks] = (bf16x8){0, 0, 0, 0, 0, 0, 0, 0}; }
    f32x16 O[2][2];
#pragma unroll
    for (int a = 0; a < 2; ++a)
#pragma unroll
        for (int b = 0; b < 2; ++b)
#pragma unroll
            for (int i = 0; i < 16; ++i) O[a][b][i] = 0.f;
    float lsum[2] = {0.f, 0.f};
    constexpr int STG = 2 * KVT_BYTES;
    const int nstage = ntile >> 1;
    auto stage_in = [&](int sidx, int bsel) {
        const unsigned char* g = kvb + (size_t)sidx * STG + lane * 16;
        for (int pc = wv; pc < 43; pc += 8)
            __builtin_amdgcn_global_load_lds((const unsigned*)(g + pc * 1024), (LAS unsigned*)(lds + bsel * STG + pc * 1024), 16, 0, 0);
    };
    stage_in(0, 0);
    __syncthreads();
    if (wv >= 4) __builtin_amdgcn_s_setprio(1);
    for (int sg = 0; sg < nstage; ++sg) {
        if (sg + 1 < nstage) stage_in(sg + 1, (sg + 1) & 1);
        if (active) {
#pragma unroll 1
            for (int kt = 0; kt < 4; ++kt) {
                const LAS unsigned char* kb = lds + (sg & 1) * STG + (kt >> 1) * KVT_BYTES; const LAS unsigned char* vb = kb + KT_BYTES; const int ks2 = kt & 1;
                bf16x8 kf[6];
#pragma unroll
                for (int ks = 0; ks < 6; ++ks) kf[ks] = *(const LAS bf16x8*)(kb + (ks2 * 32 + l31) * 208 + ks * 32 + hh * 16);
                bf16x8 vf[2][2];
#pragma unroll
                for (int vtile = 0; vtile < 2; ++vtile)
#pragma unroll
                    for (int s2 = 0; s2 < 2; ++s2) { const LAS unsigned char* a = vb + (vtile * 32 + l31) * 136 + (ks2 * 32 + s2 * 16 + 4 * hh) * 2;
                        const u32x2 lo = *(const LAS u32x2*)a, hi = *(const LAS u32x2*)(a + 16);
                        u32x4 w; w.x = lo.x; w.y = lo.y; w.z = hi.x; w.w = hi.y; vf[vtile][s2] = __builtin_bit_cast(bf16x8, w); }
                f32x16 S0, S1;
#pragma unroll
                for (int i = 0; i < 16; ++i) { S0[i] = accinit; S1[i] = accinit; }
#pragma unroll
                for (int ks = 0; ks < 6; ++ks) S0 = __builtin_amdgcn_mfma_f32_32x32x16_bf16(kf[ks], qf[0][ks], S0, 0, 0, 0);

#pragma unroll
                for (int ks = 0; ks < 6; ++ks) S1 = __builtin_amdgcn_mfma_f32_32x32x16_bf16(kf[ks], qf[1][ks], S1, 0, 0, 0);
                bf16x8 pb0[2], pb1[2];
                { float ls = 0.f;
#pragma unroll
                  for (int i = 0; i < 16; ++i) { S0[i] = fast_exp2(S0[i]); ls += S0[i]; }
                  lsum[0] += ls;
#pragma unroll
                  for (int s2 = 0; s2 < 2; ++s2) { u32x4 w; w.x = cvt_pk_bf16(S0[8 * s2 + 0], S0[8 * s2 + 1]); w.y = cvt_pk_bf16(S0[8 * s2 + 2], S0[8 * s2 + 3]);
                      w.z = cvt_pk_bf16(S0[8 * s2 + 4], S0[8 * s2 + 5]); w.w = cvt_pk_bf16(S0[8 * s2 + 6], S0[8 * s2 + 7]); pb0[s2] = __builtin_bit_cast(bf16x8, w); } }

#pragma unroll
                for (int s2 = 0; s2 < 2; ++s2)
#pragma unroll
                    for (int vtile = 0; vtile < 2; ++vtile) O[0][vtile] = __builtin_amdgcn_mfma_f32_32x32x16_bf16(vf[vtile][s2], pb0[s2], O[0][vtile], 0, 0, 0);
                { float ls = 0.f;
#pragma unroll
                  for (int i = 0; i < 16; ++i) { S1[i] = fast_exp2(S1[i]); ls += S1[i]; }
                  lsum[1] += ls;
#pragma unroll
                  for (int s2 = 0; s2 < 2; ++s2) { u32x4 w; w.x = cvt_pk_bf16(S1[8 * s2 + 0], S1[8 * s2 + 1]); w.y = cvt_pk_bf16(S1[8 * s2 + 2], S1[8 * s2 + 3]);
                      w.z = cvt_pk_bf16(S1[8 * s2 + 4], S1[8 * s2 + 5]); w.w = cvt_pk_bf16(S1[8 * s2 + 6], S1[8 * s2 + 7]); pb1[s2] = __builtin_bit_cast(bf16x8, w); } }

#pragma unroll
                for (int s2 = 0; s2 < 2; ++s2)
#pragma unroll
                    for (int vtile = 0; vtile < 2; ++vtile) O[1][vtile] = __builtin_amdgcn_mfma_f32_32x32x16_bf16(vf[vtile][s2], pb1[s2], O[1][vtile], 0, 0, 0);
            }
        }
        __syncthreads();
    }
    __builtin_amdgcn_s_setprio(0);
    if (active) {
#pragma unroll
        for (int qt = 0; qt < 2; ++qt) {
            const float tot = lsum[qt] + __shfl_xor(lsum[qt], 32); const float inv = 1.0f / tot;
            bf16_t* orw = orow + (size_t)(wv * 64 + qt * 32 + l31) * OCW;
#pragma unroll
            for (int vtile = 0; vtile < 2; ++vtile)
#pragma unroll
                for (int g4 = 0; g4 < 4; ++g4) { u32x2 w; w.x = cvt_pk_bf16(O[qt][vtile][4 * g4 + 0] * inv, O[qt][vtile][4 * g4 + 1] * inv);
                    w.y = cvt_pk_bf16(O[qt][vtile][4 * g4 + 2] * inv, O[qt][vtile][4 * g4 + 3] * inv);
                    *(u32x2*)(orw + vtile * 32 + 8 * g4 + 4 * hh) = w; }
        }
    }
}

DEVI float attn_offset(const Params& p, int l) {
    const int lane = opq_tid() & 63;
    const float* gq = p.in[I_GQ] + l * 96; const float* gk = p.in[I_GK] + l * 96;
    float a = fmaxf(fabsf(gq[lane]), lane < 32 ? fabsf(gq[64 + lane]) : 0.f), b = fmaxf(fabsf(gk[lane]), lane < 32 ? fabsf(gk[64 + lane]) : 0.f);
    a = wave_max(a); b = wave_max(b);
    return -(9.797958971132712f * 1.4426950408889634f * a * b * 1.001f);
}

constexpr int HGP = 72;
constexpr int ZP = 68;
constexpr int HG_ZT0 = 0, HG_ZT1 = 17408, HG_KEY0 = 34816, HG_KEY1 = 52224, HG_VT = 69632, HG_KRM0 = 78848, HG_KRM1 = 88064, HG_QRM0 = 97280, HG_QRM1 = 106496,
              HG_S2T0 = 115712, HG_S2T1 = 124928, HG_A20 = 134144, HG_A21 = 143360, HG_GT = 152576  , HG_REF = 156672  , HG_BT = 157184  ,
              HG_O = HG_ZT0  ;
DEVI bf16x8 hg_frag_tr(const LAS unsigned char* tile, int k0, int c0, int lane) {
    const unsigned g = lane >> 4, q = (lane & 15) >> 2, pp = lane & 3;
    const unsigned a0 = (unsigned)(size_t)tile + (unsigned)((k0 + 8 * g + q) * (HGP * 2) + (c0 + 4 * pp) * 2), a1 = a0 + 4 * HGP * 2;
    u32x2 r0, r1;
    asm volatile("ds_read_b64_tr_b16 %0, %2\n\tds_read_b64_tr_b16 %1, %3\n\ts_waitcnt lgkmcnt(0)" : "=&v"(r0), "=&v"(r1) : "v"(a0), "v"(a1) : "memory");
    u32x4 w; w.x = r0.x; w.y = r0.y; w.z = r1.x; w.w = r1.y; return __builtin_bit_cast(bf16x8, w);
}

DEVI int hg_pos0(int tc) { return tc < 128 ? tc * 64 : SEQ + (tc - 128) * 64; }
DEVI int hg_chain_pos(int tc, int dir) { return dir ? (NCH - 1 - tc) : (tc < 128 ? tc + 4 : tc - 128); }

struct HgIn { u32x4 q, zf, zb, v, g, sf, sb; };
template <bool PASS3> DEVI void hg_load(const Params& p, int u, HgIn& r) {
    const int tid = opq_tid(), tk = tid >> 3, pc = tid & 7; const int tc = u % NCH, h = (u / NCH) & 7, bl = u / (NCH * 8);
    const bf16_t* prow = p.pa + (size_t)(bl * RB + hg_pos0(tc) + tk) * PA_W + h * 64 + pc * 8;
    r.zf = *(const u32x4*)(prow + C_ZF); r.zb = *(const u32x4*)(prow + C_ZB); r.v = *(const u32x4*)(prow + C_I);
    if (PASS3) { r.q = *(const u32x4*)(prow + C_Q); r.g = *(const u32x4*)(prow + C_G);
        const size_t uf = ((size_t)((bl * 2 + 0) * 8 + h)) * NCH + hg_chain_pos(tc, 0), ub = ((size_t)((bl * 2 + 1) * 8 + h)) * NCH + hg_chain_pos(tc, 1);
        r.sf = *(const u32x4*)(p.st + uf * 4096 + tk * 64 + pc * 8); r.sb = *(const u32x4*)(p.st + ub * 4096 + tk * 64 + pc * 8); }
}
DEVI float bfw(const u32x4& w, int e) { const unsigned x = w[e >> 1]; return (e & 1) ? __uint_as_float(x & 0xffff0000u) : __uint_as_float(x << 16); }

template <bool PASS3> DEVI void hg_prepare(const Params& p, int l, LAS unsigned char* lds, int h, const HgIn& r) {
    const int tid = opq_tid(), tk = tid >> 3, pc = tid & 7; const bool lb0 = (l == 0);
    LAS float* gt = (LAS float*)(lds + HG_GT); LAS float* refv = (LAS float*)(lds + HG_REF); LAS float* btv = (LAS float*)(lds + HG_BT);
    {
#pragma unroll
        for (int dir = 0; dir < 2; ++dir) {
            LAS float* zt = (LAS float*)(lds + (dir ? HG_ZT1 : HG_ZT0)); LAS float* keyt = (LAS float*)(lds + (dir ? HG_KEY1 : HG_KEY0));
            const float* lbp = p.lbv + ((size_t)l * 2 + dir) * 512 + h * 64 + pc * 8;
            float lf[8], ky[8];
#pragma unroll
            for (int e = 0; e < 8; ++e) { const float z = bfw(dir ? r.zb : r.zf, e); const float lb = lbp[e];
                const float ez = fast_exp2(-1.44269504f * fabsf(z)), opl = 1.0f + ez, rc = fast_rcp(opl);
                const float logsig = -(fmaxf(-z, 0.f) + 0.69314718f * __builtin_amdgcn_logf(opl));
                const float sigp = (z >= 0.f) ? rc : ez * rc;
                lf[e] = lb0 ? logsig : 0.69314718f * __builtin_amdgcn_logf(lb + (1.0f - lb) * sigp);
                ky[e] = (1.0f - lb) * (1.0f - sigp); }
            *(LAS f32x4*)(zt + tk * ZP + pc * 8) = (f32x4){lf[0], lf[1], lf[2], lf[3]}; *(LAS f32x4*)(zt + tk * ZP + pc * 8 + 4) = (f32x4){lf[4], lf[5], lf[6], lf[7]};
            *(LAS f32x4*)(keyt + tk * ZP + pc * 8) = (f32x4){ky[0], ky[1], ky[2], ky[3]}; *(LAS f32x4*)(keyt + tk * ZP + pc * 8 + 4) = (f32x4){ky[4], ky[5], ky[6], ky[7]}; }
        *(LAS u32x4*)(lds + HG_VT + (tk * HGP + pc * 8) * 2) = r.v;
    }
    __syncthreads();
    {
        const int d = tid & 63, jg = tid >> 6; float c0[8], c1[8]; float run = 0.f;
        LAS float* zt0 = (LAS float*)(lds + HG_ZT0); LAS float* zt1 = (LAS float*)(lds + HG_ZT1);
#pragma unroll
        for (int i = 0; i < 8; ++i) { run += zt0[(jg * 8 + i) * ZP + d]; c0[i] = run; }
        gt[jg * 64 + d] = run; run = 0.f;
#pragma unroll
        for (int i = 7; i >= 0; --i) { run += zt1[(jg * 8 + i) * ZP + d]; c1[i] = run; }
        gt[512 + jg * 64 + d] = run;
        __syncthreads();
        float off0 = 0.f, off1 = 0.f;
#pragma unroll
        for (int g2 = 0; g2 < 8; ++g2) { off0 += (g2 < jg) ? gt[g2 * 64 + d] : 0.f; off1 += (g2 > jg) ? gt[512 + g2 * 64 + d] : 0.f; }
#pragma unroll
        for (int i = 0; i < 8; ++i) { zt0[(jg * 8 + i) * ZP + d] = c0[i] + off0; zt1[(jg * 8 + i) * ZP + d] = c1[i] + off1; }
        if (jg == 3) refv[d] = c0[7] + off0;
        if (jg == 7) btv[d] = c0[7] + off0;
        if (jg == 4) refv[64 + d] = c1[0] + off1;
        if (jg == 0) btv[64 + d] = c1[0] + off1;
    }
    __syncthreads();
    {
#pragma unroll
        for (int dir = 0; dir < 2; ++dir) {
            const LAS float* zt = (const LAS float*)(lds + (dir ? HG_ZT1 : HG_ZT0)); const LAS float* keyt = (const LAS float*)(lds + (dir ? HG_KEY1 : HG_KEY0));
            float kt[8], qt[8];
            const f32x4 z0 = *(const LAS f32x4*)(zt + tk * ZP + pc * 8), z1 = *(const LAS f32x4*)(zt + tk * ZP + pc * 8 + 4);
            const f32x4 k0 = *(const LAS f32x4*)(keyt + tk * ZP + pc * 8), k1 = *(const LAS f32x4*)(keyt + tk * ZP + pc * 8 + 4);
            const f32x4 r0 = *(const LAS f32x4*)(refv + dir * 64 + pc * 8), r1 = *(const LAS f32x4*)(refv + dir * 64 + pc * 8 + 4);
#pragma unroll
            for (int e = 0; e < 8; ++e) { const float bc = e < 4 ? z0[e & 3] : z1[e & 3], rf = e < 4 ? r0[e & 3] : r1[e & 3], ke = e < 4 ? k0[e & 3] : k1[e & 3];
                kt[e] = ke * fast_exp2(1.44269504f * fminf(rf - bc, 80.f)); if (PASS3) qt[e] = bfw(r.q, e) * fast_exp2(1.44269504f * fminf(bc - rf, 80.f)); }
            { u32x4 w; w.x = cvt_pk_bf16(kt[0], kt[1]); w.y = cvt_pk_bf16(kt[2], kt[3]); w.z = cvt_pk_bf16(kt[4], kt[5]); w.w = cvt_pk_bf16(kt[6], kt[7]);
              *(LAS u32x4*)(lds + (dir ? HG_KRM1 : HG_KRM0) + (tk * HGP + pc * 8) * 2) = w; }
            if (PASS3) {
                u32x4 w; w.x = cvt_pk_bf16(qt[0], qt[1]); w.y = cvt_pk_bf16(qt[2], qt[3]); w.z = cvt_pk_bf16(qt[4], qt[5]); w.w = cvt_pk_bf16(qt[6], qt[7]);
                *(LAS u32x4*)(lds + (dir ? HG_QRM1 : HG_QRM0) + (tk * HGP + pc * 8) * 2) = w;
                const float er = fast_exp2(1.44269504f * refv[dir * 64 + tk]); float sv[8];
#pragma unroll
                for (int e = 0; e < 8; ++e) sv[e] = bfw(dir ? r.sb : r.sf, e) * er;
                w.x = cvt_pk_bf16(sv[0], sv[1]); w.y = cvt_pk_bf16(sv[2], sv[3]); w.z = cvt_pk_bf16(sv[4], sv[5]); w.w = cvt_pk_bf16(sv[6], sv[7]);
                *(LAS u32x4*)(lds + (dir ? HG_S2T1 : HG_S2T0) + (tk * HGP + pc * 8) * 2) = w;
            }
        }
    }
    __syncthreads();
}
DEVI bf16x8 hg_frag(const LAS unsigned char* base, int r, int c0) { return *(const LAS bf16x8*)(base + (size_t)(r * HGP + c0) * 2); }

DEVI void hg_pass1_unit(const Params& p, int l, LAS unsigned char* lds, int u, const HgIn& r) {
    const int tc = u % NCH, h = (u / NCH) & 7, bl = u / (NCH * 8);
    hg_prepare<false>(p, l, lds, h, r);
    const int tid = opq_tid(), lane = tid & 63, wv = tid >> 6, l15 = lane & 15, g = lane >> 4;
    const LAS float* refv = (const LAS float*)(lds + HG_REF); const LAS float* btv = (const LAS float*)(lds + HG_BT);
    const int dt = wv >> 1, ct0 = (wv & 1) * 2;
#pragma unroll
    for (int dir = 0; dir < 2; ++dir) {
        const size_t unit = ((size_t)((bl * 2 + dir) * 8 + h)) * NCH + hg_chain_pos(tc, dir);
        bf16_t* so = p.st + unit * 4096;
        const LAS unsigned char* krm = lds + (dir ? HG_KRM1 : HG_KRM0);
        bf16x8 af[2];
#pragma unroll
        for (int ks = 0; ks < 2; ++ks) af[ks] = hg_frag_tr(krm, 32 * ks, 16 * dt, lane);
#pragma unroll
        for (int ci = 0; ci < 2; ++ci) { const int ct = ct0 + ci; f32x4 acc = {0.f, 0.f, 0.f, 0.f};
#pragma unroll
            for (int ks = 0; ks < 2; ++ks) acc = __builtin_amdgcn_mfma_f32_16x16x32_bf16(af[ks], hg_frag_tr(lds + HG_VT, 32 * ks, 16 * ct, lane), acc, 0, 0, 0);
#pragma unroll
            for (int rr = 0; rr < 4; ++rr) { const int d = 16 * dt + 4 * g + rr; so[d * 64 + 16 * ct + l15] = f2bf(acc[rr] * fast_exp2(1.44269504f * (btv[dir * 64 + d] - refv[dir * 64 + d]))); } }
        if (tid < 64) p.stb[unit * 64 + tid] = btv[dir * 64 + tid];
    }
    __syncthreads();
}

DEVI void hg_pass3_unit(const Params& p, int l, LAS unsigned char* lds, int u, const HgIn& r) {
    const int tc = u % NCH, h = (u / NCH) & 7, bl = u / (NCH * 8);
    const int tid = opq_tid(), lane = tid & 63, wv = tid >> 6, l15 = lane & 15, g = lane >> 4;
    hg_prepare<true>(p, l, lds, h, r);
    { const int tt = wv >> 1, st0 = (wv & 1) * 2;
#pragma unroll
      for (int dir = 0; dir < 2; ++dir) {
          const LAS unsigned char* qrm = lds + (dir ? HG_QRM1 : HG_QRM0); const LAS unsigned char* krm = lds + (dir ? HG_KRM1 : HG_KRM0); LAS bf16_t* a2 = (LAS bf16_t*)(lds + (dir ? HG_A21 : HG_A20));
          bf16x8 bq[2];
#pragma unroll
          for (int ks = 0; ks < 2; ++ks) bq[ks] = hg_frag(qrm, 16 * tt + l15, 32 * ks + 8 * g);
#pragma unroll
          for (int si = 0; si < 2; ++si) { const int st = st0 + si; f32x4 acc = {0.f, 0.f, 0.f, 0.f};
#pragma unroll
              for (int ks = 0; ks < 2; ++ks) acc = __builtin_amdgcn_mfma_f32_16x16x32_bf16(hg_frag(krm, 16 * st + l15, 32 * ks + 8 * g), bq[ks], acc, 0, 0, 0);
              const int t = 16 * tt + l15, s0 = 16 * st + 4 * g; float v[4];
#pragma unroll
              for (int e = 0; e < 4; ++e) v[e] = (dir == 0 ? (s0 + e <= t) : (s0 + e >= t)) ? acc[e] : 0.f;
              u32x2 w; w.x = cvt_pk_bf16(v[0], v[1]); w.y = cvt_pk_bf16(v[2], v[3]);
              *(LAS u32x2*)(a2 + t * HGP + s0) = w; } } }
    __syncthreads();
    { const int tt = wv >> 1, ct0 = (wv & 1) * 2; LAS float* olds = (LAS float*)(lds + HG_O);
      f32x4 acc[2] = {{0.f, 0.f, 0.f, 0.f}, {0.f, 0.f, 0.f, 0.f}};
#pragma unroll
      for (int dir = 0; dir < 2; ++dir) {
          const LAS unsigned char* qrm = lds + (dir ? HG_QRM1 : HG_QRM0); const LAS unsigned char* a2 = lds + (dir ? HG_A21 : HG_A20); const LAS unsigned char* s2t = lds + (dir ? HG_S2T1 : HG_S2T0);
          bf16x8 aa[2], aq[2];
#pragma unroll
          for (int ks = 0; ks < 2; ++ks) { aa[ks] = hg_frag(a2, 16 * tt + l15, 32 * ks + 8 * g); aq[ks] = hg_frag(qrm, 16 * tt + l15, 32 * ks + 8 * g); }
#pragma unroll
          for (int ci = 0; ci < 2; ++ci) { const int ct = ct0 + ci;
#pragma unroll
              for (int ks = 0; ks < 2; ++ks) acc[ci] = __builtin_amdgcn_mfma_f32_16x16x32_bf16(aa[ks], hg_frag_tr(lds + HG_VT, 32 * ks, 16 * ct, lane), acc[ci], 0, 0, 0);
#pragma unroll
              for (int ks = 0; ks < 2; ++ks) acc[ci] = __builtin_amdgcn_mfma_f32_16x16x32_bf16(aq[ks], hg_frag_tr(s2t, 32 * ks, 16 * ct, lane), acc[ci], 0, 0, 0); } }
#pragma unroll
      for (int ci = 0; ci < 2; ++ci)
#pragma unroll
          for (int rr = 0; rr < 4; ++rr) olds[(16 * tt + 4 * g + rr) * 65 + 16 * (ct0 + ci) + l15] = acc[ci][rr]; }
    __syncthreads();
    { const int tok = tid >> 3, pc = tid & 7; const int row = bl * RB + hg_pos0(tc) + tok; const LAS float* olds = (const LAS float*)(lds + HG_O);
      float o[8]; float ss = 0.f;
#pragma unroll
      for (int e = 0; e < 8; ++e) { o[e] = olds[tok * 65 + pc * 8 + e]; ss += o[e] * o[e]; }
      ss += __shfl_xor(ss, 1); ss += __shfl_xor(ss, 2); ss += __shfl_xor(ss, 4);
      const float rstd = rsqrtf(ss * (1.0f / 64.0f) + EPSF);
      const float* gn = p.in[I_HGNORM] + l * 64 + pc * 8;
      float rr[8];
#pragma unroll
      for (int e = 0; e < 8; ++e) rr[e] = o[e] * rstd * gn[e] * sigmoidf_(bfw(r.g, e));
      u32x4 w; w.x = cvt_pk_bf16(rr[0], rr[1]); w.y = cvt_pk_bf16(rr[2], rr[3]); w.z = cvt_pk_bf16(rr[4], rr[5]); w.w = cvt_pk_bf16(rr[6], rr[7]);
      *(u32x4*)(p.ocat + (size_t)row * OCW + h * 64 + pc * 8) = w; }
    __syncthreads();
}

DEVI void hg_prefix(const Params& p, bool dry = false) {
    const int total = 2 * 2 * 8 * 4096;
    for (int gidx = opq_bid() * 512 + opq_tid(); gidx < total; gidx += gridDim.x * 512) {
        const int chain = gidx >> 12, e = gidx & 4095, d = e >> 6;
        bf16_t* s = p.st + (size_t)chain * NCH * 4096 + e; const float* bt = p.stb + (size_t)chain * NCH * 64 + d;
        float S = 0.f;
#pragma unroll 1
        for (int q0 = 0; q0 < NCH; q0 += 12) { float loc[12], b[12];
#pragma unroll
            for (int i = 0; i < 12; ++i) { loc[i] = bf2f(s[(size_t)(q0 + i) * 4096]); b[i] = bt[(q0 + i) * 64]; }
#pragma unroll
            for (int i = 0; i < 12; ++i) { if (!dry) s[(size_t)(q0 + i) * 4096] = f2bf(S); S = S * fast_exp2(1.44269504f * b[i]) + loc[i]; } }
        if (dry && S == 123.456f) s[0] = 0;
    }
}

constexpr int LR_UB = 0, LR_UP = 520, LR_AF = 16640, LR_IF = LR_AF + 32768, LR_AB = LR_IF + 32768, LR_IB = LR_AB + 32768;
constexpr int NT16 = RB / 16;

DEVI int lr_pos0(int tt) { return tt * 16; }
DEVI int lr_chain_pos(int tt, int dir) { return dir ? (NT16 - 1 - tt) : (tt < 512 ? tt + 16 : tt - 512); }

struct LruW { bf16x8 b[2][4][2]; float ba[4], bx[4], la[4]; };
DEVI void lru_load_w(const Params& p, int l, int dir, int n, int l15, int g, LruW& w) {
#pragma unroll
    for (int which = 0; which < 2; ++which)
#pragma unroll
        for (int ct = 0; ct < 4; ++ct)
#pragma unroll
            for (int ks = 0; ks < 2; ++ks)
                w.b[which][ct][ks] = *(const bf16x8*)(p.wlru + ((((size_t)(l * 2 + dir) * 8 + n) * 2 + which) * 64 + 16 * ct + l15) * 64 + 32 * ks + 8 * g);
#pragma unroll
    for (int ct = 0; ct < 4; ++ct) { const int c = (l * 2 + dir) * 512 + n * 64 + 16 * ct + l15;
        w.ba[ct] = p.in[I_LBA][c]; w.bx[ct] = p.in[I_LBX][c]; w.la[ct] = p.lrula[c]; }
}
struct LrIn { bf16_t x[19]; bf16_t y[16]; float h_in; };
template <int MODE> DEVI void lru_load(const Params& p, int u, LrIn& r) {
    const int bl = u / NT16, tt = u % NT16, c = opq_tid();
    const int pos0 = tt * 16, seg0 = tt < 512 ? 0 : SEQ, seg1 = tt < 512 ? SEQ : RB;
    const bf16_t* xx = p.pa + (size_t)bl * RB * PA_W + C_LX + c;
#pragma unroll
    for (int i = 0; i < 19; ++i) { const int pos = pos0 - 2 + i; r.x[i] = (pos >= seg0 && pos < seg1) ? xx[(size_t)pos * PA_W] : (bf16_t)0; }
    if (MODE == 2) { const bf16_t* yy = p.pa + ((size_t)bl * RB + pos0) * PA_W + C_LY + c;
#pragma unroll
        for (int t = 0; t < 16; ++t) r.y[t] = yy[(size_t)t * PA_W]; }
    if (MODE == 1) r.h_in = p.lin[((size_t)(bl * 2 + 0) * NT16 + lr_chain_pos(tt, 0)) * 512 + c];
    if (MODE == 2) r.h_in = p.lin[((size_t)(bl * 2 + 1) * NT16 + lr_chain_pos(tt, 1)) * 512 + c];
}
#define LR_WAVE_SYNC() do { asm volatile("s_waitcnt lgkmcnt(0)" ::: "memory"); __builtin_amdgcn_wave_barrier(); } while (0)
DEVI void lru_tile_gates(const Params& p, int l, LAS unsigned char* lds, const LrIn& in, const LruW& w) {
    const int tid = opq_tid(), lane = tid & 63, n = tid >> 6, l15 = lane & 15, g = lane >> 4;
    LAS bf16_t* ub = (LAS bf16_t*)(lds + LR_UB);
    {
        const int c = tid;
        const float* cw = p.in[I_CONVW] + (size_t)l * 4 * 512; const float w0 = cw[c], w1 = cw[512 + c], w2 = cw[1024 + c], w3 = cw[1536 + c], cb = p.in[I_CONVB][l * 512 + c];
        float x[19];
#pragma unroll
        for (int i = 0; i < 19; ++i) x[i] = bf2f(in.x[i]);
#pragma unroll
        for (int t = 0; t < 16; ++t) ub[t * LR_UP + c] = f2bf(cb + w0 * x[t] + w1 * x[t + 1] + w2 * x[t + 2] + w3 * x[t + 3]);
    }
    LR_WAVE_SYNC();
    bf16x8 af[2];
#pragma unroll
    for (int ks = 0; ks < 2; ++ks) af[ks] = *(const LAS bf16x8*)(ub + l15 * LR_UP + n * 64 + 32 * ks + 8 * g);
    LAS float* aL = (LAS float*)(lds + LR_AF); LAS float* iL = (LAS float*)(lds + LR_IF);
#pragma unroll
    for (int ct = 0; ct < 4; ++ct) {
        f32x4 ra = {0.f, 0.f, 0.f, 0.f}, xa = {0.f, 0.f, 0.f, 0.f};
#pragma unroll
        for (int ks = 0; ks < 2; ++ks) { ra = __builtin_amdgcn_mfma_f32_16x16x32_bf16(af[ks], w.b[0][ct][ks], ra, 0, 0, 0); xa = __builtin_amdgcn_mfma_f32_16x16x32_bf16(af[ks], w.b[1][ct][ks], xa, 0, 0, 0); }
        const int c = n * 64 + 16 * ct + l15;
#pragma unroll
        for (int r = 0; r < 4; ++r) { const int t = 4 * g + r;
            const float rg = sigmoidf_(ra[r] + w.ba[ct]), ig = sigmoidf_(xa[r] + w.bx[ct]);
            const float a = fast_exp2(rg * w.la[ct]); const float uu = bf2f(ub[t * LR_UP + c]);
            aL[t * 512 + c] = a; iL[t * 512 + c] = __builtin_amdgcn_sqrtf(fmaxf(1.0f - a * a, 0.f)) * ig * uu; }
    }
    LR_WAVE_SYNC();
}
template <int MODE> DEVI void lru_sweep(const Params& p, int l, LAS unsigned char* lds, int dir, int u0, int uend, int ubase, bool skipc) {
    const int tid = opq_tid(), lane = tid & 63, n = tid >> 6, l15 = lane & 15, g = lane >> 4, G = gridDim.x;
    if (u0 >= uend) return;
    LruW w; lru_load_w(p, l, dir, n, l15, g, w);
    const LAS float* aL = (const LAS float*)(lds + LR_AF); const LAS float* iL = (const LAS float*)(lds + LR_IF);
    LrIn cur, nxt; lru_load<MODE>(p, u0 - ubase, cur);
    for (int u = u0; u < uend; u += G) {
        const bool more = u + G < uend; if (more) lru_load<MODE>(p, u + G - ubase, nxt);
        const int uu = u - ubase, bl = uu / NT16, tt = uu % NT16;
        if (!(skipc && tt >= 512)) {
            lru_tile_gates(p, l, lds, cur, w);
            if (MODE == 0) { float A = 1.f, H = 0.f;
#pragma unroll
                for (int t = 0; t < 16; ++t) { const float a = aL[t * 512 + tid], b = iL[t * 512 + tid]; if (dir == 0) { H = a * H + b; A *= a; } else { H += b * A; A *= a; } }
                *((f32x2_t*)p.lsum + ((size_t)(bl * 2 + dir) * NT16 + lr_chain_pos(tt, dir)) * 512 + tid) = (f32x2_t){A, H};
            } else { bf16_t* ocol = p.ocat + ((size_t)bl * RB + lr_pos0(tt)) * OCW + 1024 + tid; float h = cur.h_in;
                if (MODE == 1) {
#pragma unroll
                    for (int t = 0; t < 16; ++t) { h = aL[t * 512 + tid] * h + iL[t * 512 + tid]; ocol[(size_t)t * OCW] = f2bf(h); }
                } else {
                    float hfv[16];
#pragma unroll
                    for (int t = 0; t < 16; ++t) hfv[t] = bf2f(ocol[(size_t)t * OCW]);
#pragma unroll
                    for (int t = 15; t >= 0; --t) { h = aL[t * 512 + tid] * h + iL[t * 512 + tid];
                        const float y = bf2f(cur.y[t]); const float x3 = 0.7978845608028654f * (y + 0.044715f * y * y * y);
                        const float th = 1.0f - 2.0f * fast_rcp(1.0f + fast_exp2(2.88539008f * x3));
                        ocol[(size_t)t * OCW] = f2bf((hfv[t] + h) * 0.5f * y * (1.0f + th)); } }
            }
            LR_WAVE_SYNC();
        }
        if (more) cur = nxt;
    }
}
DEVI void lru_prefix(const Params& p, bool dry = false) {
    const int lane = opq_tid() & 63, wv = opq_tid() >> 6;
    for (int chain = opq_bid() * 8 + wv; chain < 2 * 2 * 512; chain += gridDim.x * 8) {
        const int c = chain & 511, bd = chain >> 9;
        const f32x2_t* src = (const f32x2_t*)p.lsum + (size_t)bd * NT16 * 512 + c; float* dst = p.lin + (size_t)bd * NT16 * 512 + c;
        f32x2_t v[9]; float A = 1.f, H = 0.f;
#pragma unroll
        for (int i = 0; i < 9; ++i) { const int q = lane * 9 + i; v[i] = (q < NT16) ? src[(size_t)q * 512] : (f32x2_t){1.f, 0.f}; H = v[i].x * H + v[i].y; A *= v[i].x; }
#pragma unroll
        for (int o = 1; o < 64; o <<= 1) { const float Ap = __shfl_up(A, o), Hp = __shfl_up(H, o); if (lane >= o) { H = A * Hp + H; A = A * Ap; } }
        float h = __shfl_up(H, 1); if (lane == 0) h = 0.f;
#pragma unroll
        for (int i = 0; i < 9; ++i) { const int q = lane * 9 + i; if (q < NT16 && !dry) dst[(size_t)q * 512] = h; h = v[i].x * h + v[i].y; }
        if (dry && h == 123.456f) dst[0] = 0.f;
    }
}
DEVI void phase_attn_scan1(const Params& p, int l, LAS unsigned char* lds, int parts = 7) {
    const int nA = 2 * 8 * 16 + (l == 0 ? 16 : 0), nH = 2 * 8 * NCH, nL = 2 * NT16, G = gridDim.x;
    const float accinit = attn_offset(p, l);
    int u = opq_bid();
    for (; u < 256; u += G) { const int bl = u >> 7, h = (u >> 4) & 7, qb = u & 15; if (!(parts & 1)) continue;
        attn_unit(p, lds, p.q + ((size_t)(bl * 8 + h) * SEQ + qb * 512) * 96, 512, p.kv + (size_t)(bl * 8 + h) * NCH * KVT_BYTES, NCH,
                  p.ocat + (size_t)(bl * RB + qb * 512) * OCW + 512 + h * 64, accinit); }
    for (; u < nA; u += G) { const int uu = u - 256, bl = uu >> 3, h = uu & 7; if (!(parts & 1)) continue;
        attn_unit(p, lds, p.qc + ((size_t)(bl * 8 + h) * CTX) * 96, 256, p.kv + ((size_t)(bl * 8 + h) * NCH + 128) * KVT_BYTES, 4,
                  p.ocat + (size_t)(bl * RB + SEQ) * OCW + 512 + h * 64, accinit); }
    if (parts & 2) { HgIn cur, nxt; if (u < nA + nH) hg_load<false>(p, u - nA, cur);
        for (; u < nA + nH; u += G) { const bool more = u + G < nA + nH; if (more) hg_load<false>(p, u + G - nA, nxt); hg_pass1_unit(p, l, lds, u - nA, cur); if (more) cur = nxt; } }
    else { for (; u < nA + nH; u += G) {} }
    if (parts & 4) { lru_sweep<0>(p, l, lds, 0, u, nA + nH + nL, nA + nH, false); lru_sweep<0>(p, l, lds, 1, u, nA + nH + nL, nA + nH, false); }
}
DEVI void phase_prefix(const Params& p, LAS unsigned char* lds, bool dry = false) { (void)lds; hg_prefix(p, dry); lru_prefix(p, dry); }
DEVI void phase_scan3(const Params& p, int l, LAS unsigned char* lds, int parts = 3) {
    const int nH = 2 * 8 * NCH, nL = 2 * NT16, G = gridDim.x; const bool skipc = (l == DEPTH - 1);
    int u = opq_bid();
    if (parts & 1) { HgIn cur, nxt; if (u < nH) hg_load<true>(p, u, cur);
        for (; u < nH; u += G) { const bool more = u + G < nH; if (more) hg_load<true>(p, u + G, nxt);
            if (!(skipc && (u % NCH) >= 128)) hg_pass3_unit(p, l, lds, u, cur);
            if (more) cur = nxt; } }
    else { for (; u < nH; u += G) {} }
    if (parts & 2) { lru_sweep<1>(p, l, lds, 0, u, nH + nL, nH, skipc); lru_sweep<2>(p, l, lds, 1, u, nH + nL, nH, skipc); }
}

constexpr int RP = 2 * TT + 4096;

DEVI void phase_norm2_route(const Params& p, int l, LAS unsigned char* lds) {
    const int tid = opq_tid(), lane = tid & 63, wv = tid >> 6; const bool skipc = (l == DEPTH - 1);
    LAS int* cntl = (LAS int*)lds;
    LAS int* basel = cntl + 16;
    LAS int* rinfo = cntl + 64;
    LAS float* rw = (LAS float*)(rinfo + 4 * 8 * 20);
    if (tid < 16) cntl[tid] = 0;
    LAS float* Wt = (LAS float*)(lds + 8192);
    { const float* wrg = p.in[I_WRG] + (size_t)l * DM * 4; const float* wre = p.in[I_WRE] + (size_t)l * DM * 16;
      for (int i = tid; i < DM * 4; i += 512) Wt[(i & 3) * DM + (i >> 2)] = wrg[i];
      for (int i = tid; i < DM * 16; i += 512) Wt[(4 + (i & 15)) * DM + (i >> 4)] = wre[i]; }
    __syncthreads();
    const float* gm = p.in[I_NFFN] + l * DM;
    const int rstep = gridDim.x * 8, rfirst = opq_bid() * 8 + wv;
    f32x4 vn[2][4];
#pragma unroll
    for (int q = 0; q < 2; ++q) { const int rq = rfirst + q * rstep; if (rq < TT) { const float* s0 = xbuf_row(p, rq);
#pragma unroll
        for (int i = 0; i < 4; ++i) vn[q][i] = *(const f32x4*)(s0 + i * 256 + lane * 4); } }
    for (int r = rfirst, it = 0; r < TT; r += 2 * rstep, it += 2) {
        f32x4 hh[2][4]; bool live[2];
#pragma unroll
        for (int q = 0; q < 2; ++q) {
            const int rq = r + q * rstep; f32x4 v[4];
#pragma unroll
            for (int i = 0; i < 4; ++i) v[i] = vn[q][i];
            if (rq + 2 * rstep < TT) { const float* s1 = xbuf_row(p, rq + 2 * rstep);
#pragma unroll
                for (int i = 0; i < 4; ++i) vn[q][i] = *(const f32x4*)(s1 + i * 256 + lane * 4); }
            live[q] = rq < TT && !(skipc && (rq % RB) >= SEQ);
            if (rq < TT && !live[q] && lane == 0) rinfo[((it + q) * 8 + wv) * 4] = -1;
            float ss = 0.f;
#pragma unroll
            for (int i = 0; i < 4; ++i) ss += v[i][0] * v[i][0] + v[i][1] * v[i][1] + v[i][2] * v[i][2] + v[i][3] * v[i][3];
            ss = wave_sum(ss);
            const float rstd = rsqrtf(ss * (1.0f / DM) + EPSF);
            const int rr = live[q] ? rq : rfirst;
            const float* mv = p.modv + ((size_t)l * 5 + mod_row(rr)) * 6144;
#pragma unroll
            for (int i = 0; i < 4; ++i) { const int c = i * 256 + lane * 4;
                const f32x4 g = *(const f32x4*)(gm + c), sh = *(const f32x4*)(mv + 3072 + c), sc = *(const f32x4*)(mv + 4096 + c);
#pragma unroll
                for (int e = 0; e < 4; ++e) hh[q][i][e] = live[q] ? v[i][e] * rstd * g[e] * (1.0f + sc[e]) + sh[e] : 0.f;
                if (live[q]) { u32x2 w; w.x = cvt_pk_bf16(hh[q][i][0], hh[q][i][1]); w.y = cvt_pk_bf16(hh[q][i][2], hh[q][i][3]);
                    *(u32x2*)(p.h2 + (size_t)rq * DM + c) = w; } }
        }
        float red[2][32];
#pragma unroll
        for (int j = 0; j < 32; ++j) { float a0 = 0.f, a1 = 0.f;
            if (j < 20) {
#pragma unroll
                for (int i = 0; i < 4; ++i) { const f32x4 w4 = *(const LAS f32x4*)(Wt + j * DM + i * 256 + lane * 4);
                    a0 += hh[0][i][0] * w4[0] + hh[0][i][1] * w4[1] + hh[0][i][2] * w4[2] + hh[0][i][3] * w4[3];
                    a1 += hh[1][i][0] * w4[0] + hh[1][i][1] * w4[1] + hh[1][i][2] * w4[2] + hh[1][i][3] * w4[3]; } }
            red[0][j] = a0; red[1][j] = a1; }
#pragma unroll
        for (int q = 0; q < 2; ++q) {
#pragma unroll
            for (int lvl = 0; lvl < 5; ++lvl) { const int half = 16 >> lvl, bit = 32 >> lvl; const bool hi = (lane & bit) != 0;
#pragma unroll
                for (int i = 0; i < half; ++i) { const float snd = hi ? red[q][i] : red[q][i + half]; const float keep = hi ? red[q][i + half] : red[q][i];
                    red[q][i] = keep + __shfl_xor(snd, bit); } }
            red[q][0] += __shfl_xor(red[q][0], 1);
        }
#pragma unroll
        for (int q = 0; q < 2; ++q) {
            float lgt[20];
#pragma unroll
            for (int j = 0; j < 20; ++j) lgt[j] = __builtin_bit_cast(float, __builtin_amdgcn_readlane(__builtin_bit_cast(int, red[q][0]), 2 * j));
            const f32x4 lg = {lgt[0], lgt[1], lgt[2], lgt[3]}, le0 = {lgt[4], lgt[5], lgt[6], lgt[7]}, le1 = {lgt[8], lgt[9], lgt[10], lgt[11]},
                        le2 = {lgt[12], lgt[13], lgt[14], lgt[15]}, le3 = {lgt[16], lgt[17], lgt[18], lgt[19]};
            if (lane == 0 && live[q]) {
                const float* brg = p.in[I_BRG] + l * 4; const float* bre = p.in[I_BRE] + l * 16;
                int gs = 0; float best = lg[0] + brg[0];
#pragma unroll
                for (int e = 1; e < 4; ++e) { const float t = lg[e] + brg[e]; if (t > best) { best = t; gs = e; } }
                const float m = fmaxf(fmaxf(lg[0], lg[1]), fmaxf(lg[2], lg[3]));
                const float e0 = __expf(lg[0] - m), e1 = __expf(lg[1] - m), e2 = __expf(lg[2] - m), e3 = __expf(lg[3] - m);
                const float pg = (gs == 0 ? e0 : gs == 1 ? e1 : gs == 2 ? e2 : e3) / (e0 + e1 + e2 + e3);
                const f32x4 lv = (gs == 0) ? le0 : (gs == 1) ? le1 : (gs == 2) ? le2 : le3;
                const f32x4 bv = lv + *(const f32x4*)(bre + gs * 4);
                int i0 = 0; float m0 = bv[0], l0 = lv[0];
#pragma unroll
                for (int e = 1; e < 4; ++e) if (bv[e] > m0) { m0 = bv[e]; i0 = e; l0 = lv[e]; }
                int i1 = -1; float m1 = -3.0e38f, l1 = 0.f;
#pragma unroll
                for (int e = 0; e < 4; ++e) if (e != i0 && bv[e] > m1) { m1 = bv[e]; i1 = e; l1 = lv[e]; }
                const float mm = fmaxf(l0, l1), x0 = __expf(l0 - mm), x1 = __expf(l1 - mm);
                const float w0 = x0 / (x0 + x1) * pg, w1 = x1 / (x0 + x1) * pg;
                const int ea = gs * 4 + i0, eb = gs * 4 + i1;
                const int sa = __hip_atomic_fetch_add(&cntl[ea], 1, __ATOMIC_RELAXED, __HIP_MEMORY_SCOPE_WORKGROUP), sb = __hip_atomic_fetch_add(&cntl[eb], 1, __ATOMIC_RELAXED, __HIP_MEMORY_SCOPE_WORKGROUP);
                const int qi = ((it + q) * 8 + wv) * 4; rinfo[qi] = ea; rinfo[qi + 1] = eb; rinfo[qi + 2] = sa; rinfo[qi + 3] = sb;
                rw[((it + q) * 8 + wv) * 2] = w0; rw[((it + q) * 8 + wv) * 2 + 1] = w1;
            }
        }
    }
    __syncthreads();
    if (tid < 16) basel[tid] = (int)atomicAdd(&p.ctrl[CTRL_CNT(l, tid)], (unsigned)cntl[tid]);
    __syncthreads();
    for (int r = rfirst, it = 0; r < TT; r += rstep, ++it) {
        if (lane == 0) { const int q = (it * 8 + wv) * 4; const int ea = rinfo[q];
            if (ea >= 0) { const int eb = rinfo[q + 1], sa = basel[ea] + rinfo[q + 2], sb = basel[eb] + rinfo[q + 3];
                p.tok_e[r * 2] = ea; p.tok_e[r * 2 + 1] = eb; p.tok_s[r * 2] = sa; p.tok_s[r * 2 + 1] = sb;
                p.lst[(size_t)ea * TT + sa] = r; p.lst[(size_t)eb * TT + sb] = r; p.tok_w[(size_t)ea * TT + sa] = rw[(it * 8 + wv) * 2]; p.tok_w[(size_t)eb * TT + sb] = rw[(it * 8 + wv) * 2 + 1]; } }
    }
    __syncthreads();
}

DEVI void moe_offsets(const Params& p, int l, LAS int* offs) {
    if (opq_tid() == 0) { int o = 0;
        for (int e = 0; e < NEXP; ++e) { offs[e] = o; const int c = (int)__hip_atomic_load(&p.ctrl[CTRL_CNT(l, e)], __ATOMIC_RELAXED, __HIP_MEMORY_SCOPE_AGENT); offs[32 + e] = c; o += (c + 255) & ~255; }
        offs[NEXP] = o; }
    __syncthreads();
}
DEVI int moe_expert_of(const LAS int* offs, int row) { int e = 0;
#pragma unroll
    for (int q = 1; q < NEXP; ++q) e += (row >= offs[q]) ? 1 : 0;
    return e; }

DEVI void phase_moe_permute(const Params& p, int l, const LAS int* offs) {
    const int lane = opq_tid() & 63, wv = opq_tid() >> 6; const int R = offs[NEXP];
    for (int pr = opq_bid() * 8 + wv; pr < R; pr += gridDim.x * 8) {
        const int e = moe_expert_of(offs, pr), s = pr - offs[e]; const bool valid = s < offs[32 + e];
        u32x4 a = {0u, 0u, 0u, 0u}, b = {0u, 0u, 0u, 0u}; int r = 0; float w = 0.f;
        const int vz = vzero();
        if (valid) { r = p.lst[(size_t)e * TT + s + vz]; w = p.tok_w[(size_t)e * TT + s + vz];
            const u32x4* src = (const u32x4*)(p.h2 + (size_t)r * DM); a = src[lane]; b = src[64 + lane]; }
        u32x4* dst = (u32x4*)(p.h2p + (size_t)pr * DM); dst[lane] = a; dst[64 + lane] = b;
        if (lane == 0) { p.rww[pr] = w; p.rmr[pr] = valid ? mod_row(r) : 0; }
    }
}

template <bool GATH> struct MoeSched { static constexpr bool GATHER = GATH; const int* lst; int cnt[NEXP]; int G, c, nN; int o[NEXP + 1]; const char* A; const char* B; size_t atile, bexp, btile;
    DEVI void load(const LAS int* offs) {
#pragma unroll
        for (int q = 0; q <= NEXP; ++q) o[q] = __builtin_amdgcn_readfirstlane(offs[q]);
#pragma unroll
        for (int q = 0; q < NEXP; ++q) cnt[q] = __builtin_amdgcn_readfirstlane(offs[32 + q]); }
    DEVI int row_of(const g8::Unit& u, int r) const { int base = 0, n = 0;
#pragma unroll
        for (int q = 0; q < NEXP; ++q) { base = (u.tag == q) ? o[q] : base; n = (u.tag == q) ? cnt[q] : n; }
        const int s2 = u.pm * 256 + r - base; return (s2 < n) ? lst[(size_t)u.tag * TT + s2] : 0; }
    DEVI bool next(int i, g8::Unit& u) const { const long L = (long)i * G + c; const int R = o[NEXP]; if (L >= (long)(R / 256) * nN) return false;
        const int ti = (int)(L / nN), pn = (int)(L % nN); int e = 0;
#pragma unroll
        for (int q = 1; q < NEXP; ++q) e += (ti * 256 >= o[q]) ? 1 : 0;
        u.pm = ti; u.pn = pn; u.tag = e; u.a = A + (size_t)ti * atile; u.b = B + (size_t)e * bexp + (size_t)pn * btile; return true; } };
struct EpiSwiglu {
    static constexpr bool PERM = false, HAS_MID = false; static constexpr int NSEG = 1;
    bf16_t* hid;
    DEVI void operator()(const f32x4 (&acc)[2][2][4][2], const g8::Unit& u, int wr, int wc, int fr, int fq) const {
        const int row0 = u.pm * 256 + wr * 64 + fr, col0 = u.pn * 128 + wc * 32 + 4 * fq;
#pragma unroll
        for (int ai = 0; ai < 2; ++ai)
#pragma unroll
            for (int m = 0; m < 4; ++m)
#pragma unroll
                for (int n = 0; n < 2; ++n) { const f32x4 a = acc[ai][0][m][n], b = acc[ai][1][m][n]; float h[4];
#pragma unroll
                    for (int e = 0; e < 4; ++e) h[e] = a[e] * sigmoidf_(a[e]) * b[e];
                    u32x2 w; w.x = cvt_pk_bf16(h[0], h[1]); w.y = cvt_pk_bf16(h[2], h[3]);
                    *(u32x2*)(hid + (size_t)(row0 + ai * 128 + m * 16) * DEXP + col0 + n * 16) = w; }
    }
};
DEVI void phase_moe_up(const Params& p, int l, const LAS int* offs, LAS unsigned char* lds) {
    MoeSched<true> S; S.lst = p.lst; S.G = gridDim.x; S.c = opq_bid(); S.nN = 2; S.load(offs); S.A = (const char*)p.h2; S.B = (const char*)(p.w13 + (size_t)l * NEXP * 512 * DM);
    S.atile = 0; S.bexp = (size_t)512 * DM * 2; S.btile = (size_t)256 * DM * 2;
    EpiSwiglu E; E.hid = p.hid;
    g8::gemm_phase(lds, DM, DM, DM, S, E);
}
struct EpiDown {
    static constexpr bool PERM = true, HAS_MID = false; static constexpr int NSEG = 1;
    bf16_t* yo; const float* tokw; const LAS int* offs;
    DEVI void operator()(const f32x4 (&acc)[2][2][4][2], const g8::Unit& u, int wr, int wc, int fr, int fq) const {
        const int row0 = u.pm * 256 + wr * 64 + fr, col0 = u.pn * 256 + wc * 32 + 8 * fq;
        const int e = u.tag, base = offs[e], n = offs[32 + e];
        float wrow[2][4];
#pragma unroll
        for (int ai = 0; ai < 2; ++ai)
#pragma unroll
            for (int m = 0; m < 4; ++m) { const int s2 = row0 + ai * 128 + m * 16 - base; wrow[ai][m] = (s2 < n) ? tokw[(size_t)e * TT + s2] : 0.f; }
#pragma unroll
        for (int ai = 0; ai < 2; ++ai)
#pragma unroll
            for (int m = 0; m < 4; ++m) { const int row = row0 + ai * 128 + m * 16; const float w = wrow[ai][m];
#pragma unroll
                for (int bj = 0; bj < 2; ++bj) { const f32x4 v0 = acc[ai][bj][m][0] * w, v1 = acc[ai][bj][m][1] * w;
                    u32x4 o; o.x = cvt_pk_bf16(v0[0], v0[1]); o.y = cvt_pk_bf16(v0[2], v0[3]); o.z = cvt_pk_bf16(v1[0], v1[1]); o.w = cvt_pk_bf16(v1[2], v1[3]);
                    *(u32x4*)(yo + (size_t)row * DM + col0 + bj * 128) = o; } }
    }
};
DEVI void phase_moe_down(const Params& p, int l, const LAS int* offs, LAS unsigned char* lds) {
    MoeSched<false> S; S.lst = p.lst; S.G = gridDim.x; S.c = opq_bid(); S.nN = 4; S.load(offs); S.A = (const char*)p.hid; S.B = (const char*)(p.w2 + (size_t)l * NEXP * DM * DEXP);
    S.atile = (size_t)256 * DEXP * 2; S.bexp = (size_t)DM * DEXP * 2; S.btile = (size_t)256 * DEXP * 2;
    EpiDown E; E.yo = p.yo; E.tokw = p.tok_w; E.offs = offs;
    g8::gemm_phase(lds, DEXP, DEXP, DEXP, S, E);
}
DEVI void phase_moe_combine(const Params& p, int l, const LAS int* offs, bool dry = false) {
    const int lane = opq_tid() & 63, wv = opq_tid() >> 6; const bool skipc = (l == DEPTH - 1);
    const int rstep = gridDim.x * 8, rfirst = opq_bid() * 8 + wv, vz = vzero();
    auto live = [&](int r) { return r < TT && !(skipc && (r % RB) >= SEQ); };
    int e0n = 0, s0n = 0, e1n = 0, s1n = 0;
    auto load_slots = [&](int r) { if (live(r)) { e0n = p.tok_e[r * 2 + vz]; s0n = p.tok_s[r * 2 + vz]; e1n = p.tok_e[r * 2 + 1 + vz]; s1n = p.tok_s[r * 2 + 1 + vz]; } };
    f32x4 xn[4]; u32x2 an[4], bn[4];
    auto load_data = [&](int r) { if (live(r)) { const float* x = xbuf_row(p, r);
            const bf16_t* y0 = p.yo + (size_t)(offs[e0n] + s0n) * DM; const bf16_t* y1 = p.yo + (size_t)(offs[e1n] + s1n) * DM;
#pragma unroll
            for (int i = 0; i < 4; ++i) { const int c = i * 256 + lane * 4; xn[i] = *(const f32x4*)(x + c); an[i] = *(const u32x2*)(y0 + c); bn[i] = *(const u32x2*)(y1 + c); } } };
    load_slots(rfirst); load_data(rfirst); load_slots(rfirst + rstep);
    for (int r = rfirst; r < TT; r += rstep) {
        f32x4 v[4]; u32x2 a[4], b[4];
#pragma unroll
        for (int i = 0; i < 4; ++i) { v[i] = xn[i]; a[i] = an[i]; b[i] = bn[i]; }
        load_data(r + rstep);
        load_slots(r + 2 * rstep);
        if (!live(r)) continue;
        float* x = xbuf_row(p, r);
        const float* g2 = p.modv + ((size_t)l * 5 + mod_row(r)) * 6144 + 5120;
#pragma unroll
        for (int i = 0; i < 4; ++i) { const int c = i * 256 + lane * 4; const f32x4 gv = *(const f32x4*)(g2 + c);
            v[i][0] += gv[0] * (__uint_as_float(a[i].x << 16) + __uint_as_float(b[i].x << 16)); v[i][1] += gv[1] * (__uint_as_float(a[i].x & 0xffff0000u) + __uint_as_float(b[i].x & 0xffff0000u));
            v[i][2] += gv[2] * (__uint_as_float(a[i].y << 16) + __uint_as_float(b[i].y << 16)); v[i][3] += gv[3] * (__uint_as_float(a[i].y & 0xffff0000u) + __uint_as_float(b[i].y & 0xffff0000u));
            if (!dry || v[i][0] == 123.456f) *(f32x4*)(x + c) = v[i]; }
    }
}

#ifndef MK_PHASE_KERNELS
#define MK_PHASE_KERNELS 0
#endif
constexpr int LDS_SCRATCH = 1024;

template <class T> DEVI T* uni_ptr(T* x) { const unsigned long long v = (unsigned long long)x;
    const unsigned lo = __builtin_amdgcn_readfirstlane((unsigned)v), hi = __builtin_amdgcn_readfirstlane((unsigned)(v >> 32));
    return (T*)(((unsigned long long)hi << 32) | lo); }
DEVI Params ldparams(const PL& s) {
    Params q;
#pragma unroll
    for (int i = 0; i < 35; ++i) q.in[i] = uni_ptr(s.in[i]);
#define LDP(f) q.f = uni_ptr(s.f)
    LDP(out); LDP(ctrl); LDP(modv); LDP(lbv); LDP(xc); LDP(rope); LDP(lrula); LDP(winA); LDP(winG); LDP(wup); LDP(wcat); LDP(wout); LDP(w13); LDP(w2); LDP(wlru);
    LDP(hx); LDP(pa); LDP(up); LDP(q); LDP(qc); LDP(kv); LDP(st); LDP(stb); LDP(lsum); LDP(lin); LDP(ocat); LDP(y); LDP(h2); LDP(h2p); LDP(hid); LDP(yo);
    LDP(tok_e); LDP(tok_s); LDP(tok_w); LDP(lst); LDP(rww); LDP(rmr);
#undef LDP
    q.pad_ = 0ull;
    return q;
}
#ifndef WAITPROBE
#define WAITPROBE (-1)
#endif
#ifndef WAITSEL
#define WAITSEL (-1)
#endif
#ifndef BODYSEL
#define BODYSEL (-1)
#endif
DEVI void grid_sync(const PL& s, LAS unsigned char* smem, int phid = -2) {
    XcdBarrier b; b.bar = uni_ptr(s.ctrl); b.x = xb_xcc_id(); b.st = (volatile LAS unsigned*)smem;
#if WAITPROBE >= 0
    unsigned long long t0 = 0; if (threadIdx.x == 0) t0 = __builtin_amdgcn_s_memrealtime();
    xcd_barrier(b);
    if (threadIdx.x == 0 && BODYSEL < 0 && (WAITSEL < 0 || phid == WAITSEL)) { LAS unsigned long long* acc = (LAS unsigned long long*)(smem + 32); *acc += __builtin_amdgcn_s_memrealtime() - t0; }
#else
    xcd_barrier(b);
#endif
}
DEVI void probe_dump(const Params& p, const bf16_t* src, size_t n) {
    const size_t NOUT = (size_t)NB * SEQ * DM;
    for (size_t i = (size_t)opq_bid() * 512 + opq_tid(); i < NOUT; i += (size_t)gridDim.x * 512) { float s = 0.f;
        for (size_t k = i; k < n; k += NOUT) s += (float)src[k];
        p.out[i] = s; }
}
#define PROBE_AT(id, buf, n) if (PROBE_STOP == (id) && l == 0 && hb == 0) { { const Params p = ldparams(pl); probe_dump(p, (const bf16_t*)(buf), (n)); } return; }
#ifndef PROBE_STOP
#define PROBE_STOP 0
#endif
#ifndef DUP_MASK
#define DUP_MASK 0
#endif
#define PHASE_D(bit, call, dupcall) PHASE(call); if ((DUP_MASK >> (bit)) & 1) { PHASE(dupcall); }
#define PHASE_I(id, call) do { unsigned long long tb_ = 0; if (BODYSEL == (id) && threadIdx.x == 0) tb_ = __builtin_amdgcn_s_memrealtime(); \
        { const Params p = ldparams(pl); call; } \
        if (BODYSEL == (id)) { __syncthreads(); if (threadIdx.x == 0) { LAS unsigned long long* acc = (LAS unsigned long long*)(smem + 32); *acc += __builtin_amdgcn_s_memrealtime() - tb_; } } } while (0); \
    grid_sync(pl, smem, id); if ((DUP_MASK >> 21) & 1) grid_sync(pl, smem)
#define PHASE(call) PHASE_I(-2, call)

#ifndef SELFCHECK
#define SELFCHECK 0
#endif
DEVI void chk_sum(const Params& p, int id, int rep, const void* buf, size_t nbytes) {
    const unsigned* w = (const unsigned*)buf; const size_t n = nbytes / 4; unsigned long long s = 0ull;
    for (size_t i = (size_t)opq_bid() * 512 + opq_tid(); i < n; i += (size_t)gridDim.x * 512) s += (unsigned long long)w[i] * (unsigned long long)((i & 1023) + 1);
    unsigned lo = (unsigned)s, hi = (unsigned)(s >> 32);
    for (int o = 32; o >= 1; o >>= 1) { const unsigned l2 = __shfl_xor(lo, o), h2 = __shfl_xor(hi, o); const unsigned long long t = (((unsigned long long)hi << 32) | lo) + (((unsigned long long)h2 << 32) | l2); lo = (unsigned)t; hi = (unsigned)(t >> 32); }
    if ((opq_tid() & 63) == 0) atomicAdd((unsigned long long*)(p.ctrl + 6144) + (rep * 32 + id), (((unsigned long long)hi << 32) | lo));
}
#define CHK(id, buf, nbytes) do { const Params p = ldparams(pl); chk_sum(p, id, rep, buf, nbytes); } while (0); grid_sync(pl, smem)

__global__ void __launch_bounds__(512, 2) hybrid_flow_backbone_kernel(Params pk) {
    extern __shared__ __attribute__((aligned(16))) unsigned char smem_raw[];
    LAS unsigned char* smem = (LAS unsigned char*)smem_raw;
    LAS unsigned char* lds = smem + LDS_SCRATCH; LAS int* offs = (LAS int*)(smem + 64);
    static_assert(sizeof(Params) % 8 == 0 && sizeof(Params) <= LDS_SCRATCH - 256, "Params must fit its LDS slot");
    { (void)pk;
      const __attribute__((address_space(4))) unsigned long long* src = (const __attribute__((address_space(4))) unsigned long long*)__builtin_amdgcn_kernarg_segment_ptr();
      LAS unsigned long long* dst = (LAS unsigned long long*)(smem + 256);
      if (threadIdx.x < sizeof(Params) / 8) dst[threadIdx.x] = src[threadIdx.x]; }
    if (threadIdx.x == 0) { *(LAS u32x4*)smem = (u32x4){0u, 0u, 0u, 0u}; *(LAS unsigned long long*)(smem + 32) = 0ull; }
    __syncthreads();
    const PL& pl = *(const PL*)(smem + 256);
    (void)xcd_barrier_post(uni_ptr(pl.ctrl), (volatile LAS unsigned*)smem);
    { unsigned long long tb_ = 0; if (BODYSEL == 0 && threadIdx.x == 0) tb_ = __builtin_amdgcn_s_memrealtime(); phase_prep(pl, lds);
      if (BODYSEL == 0) { __syncthreads(); if (threadIdx.x == 0) *(LAS unsigned long long*)(smem + 32) += __builtin_amdgcn_s_memrealtime() - tb_; } }
    grid_sync(pl, smem, 0);
    if ((DUP_MASK >> 16) & 1) { phase_prep(pl, lds); grid_sync(pl, smem); }
#if SELFCHECK
    for (int rep = 0; rep < SELFCHECK; ++rep) {
        const int l = 0, hb = 0;
        PHASE(phase_norm1(p, l, hb));          CHK(1, p.hx, (size_t)HR * DM * 2);
        PHASE(phase_inproj_a(p, l, lds));      CHK(2, p.pa, (size_t)HR * PA_W * 2);
        PHASE(phase_mla_up(p, l, lds));        CHK(3, p.up, (size_t)HR * UPW * 2);
        PHASE(phase_qkv(p, l, lds));           CHK(4, p.q, (size_t)2 * 8 * SEQ * 96 * 2); CHK(5, p.qc, (size_t)2 * 8 * CTX * 96 * 2);
        PHASE(phase_attn_scan1(p, l, lds));    CHK(6, p.st, (size_t)2 * 2 * 8 * NCH * 4096 * 2); CHK(7, p.stb, (size_t)2 * 2 * 8 * NCH * 64 * 4); CHK(8, p.lsum, (size_t)2 * 2 * NT16 * 512 * 2 * 4);
        PHASE(phase_prefix(p, lds));                CHK(9, p.st, (size_t)2 * 2 * 8 * NCH * 4096 * 2); CHK(10, p.lin, (size_t)2 * 2 * NT16 * 512 * 4);
        PHASE(phase_scan3(p, l, lds));         CHK(11, p.ocat, (size_t)HR * OCW * 2);
        PHASE(phase_inproj_g(p, l, lds));      CHK(12, p.pa, (size_t)HR * PG_W * 2);
        PHASE(phase_merge(p, l, lds));         CHK(13, p.y, (size_t)HR * DM * 2);
        PHASE(phase_outproj(p, l, hb, lds));   CHK(14, p.out, (size_t)2 * SEQ * DM * 4); CHK(15, p.xc, (size_t)2 * CTX * DM * 4);
    }
    {   const Params p = ldparams(pl);
        const size_t NOUT = (size_t)NB * SEQ * DM;
        for (size_t i = (size_t)opq_bid() * 512 + opq_tid(); i < NOUT; i += (size_t)gridDim.x * 512) p.out[i] = 0.f;
        __syncthreads();
        if (opq_bid() == 0 && opq_tid() == 0) { int first = 0; const unsigned long long* c = (const unsigned long long*)(p.ctrl + 6144);
            for (int id = 15; id >= 1; --id) for (int rep = 1; rep < SELFCHECK; ++rep)
                if (__hip_atomic_load(c + rep * 32 + id, __ATOMIC_RELAXED, __HIP_MEMORY_SCOPE_AGENT) != __hip_atomic_load(c + id, __ATOMIC_RELAXED, __HIP_MEMORY_SCOPE_AGENT)) first = id;
            p.out[0] = 1000.0f * (float)first; }
    }
    return;
#endif
    for (int l = 0; l < DEPTH; ++l) {
        for (int hb = 0; hb < 2; ++hb) {
            if (l == 0 && hb == 0) { PHASE_D(0, phase_norm1(p, l, hb), phase_norm1(p, l, hb)); }
            PHASE_I(2, phase_inproj_a(p, l, lds));
            PHASE_I(3, phase_mla_up(p, l, lds));
            PHASE_I(4, phase_qkv(p, l, lds));
            PHASE_I(5, phase_attn_scan1(p, l, lds));
            if ((DUP_MASK >> 4) & 1) { PHASE(phase_attn_scan1(p, l, lds, 1)); }
            if ((DUP_MASK >> 5) & 1) { PHASE(phase_attn_scan1(p, l, lds, 2)); }
            if ((DUP_MASK >> 6) & 1) { PHASE(phase_attn_scan1(p, l, lds, 4)); }
            PHASE_I(6, phase_prefix(p, lds));
            if ((DUP_MASK >> 17) & 1) { PHASE(phase_prefix(p, lds, true)); }
            PHASE_I(7, phase_scan3(p, l, lds));
            if ((DUP_MASK >> 7) & 1) { PHASE(phase_scan3(p, l, lds, 1)); }
            if ((DUP_MASK >> 8) & 1) { PHASE(phase_scan3(p, l, lds, 2)); }
            PHASE_I(8, phase_inproj_g(p, l, lds));
            PHASE_I(9, phase_merge(p, l, lds));
            PHASE_I(10, phase_outproj(p, l, hb, lds); if (hb == 0) phase_norm1(p, l, 1));
            if (((DUP_MASK >> 11) & 1) && l == 0) { PHASE(phase_outproj(p, l, hb, lds)); }
            if ((DUP_MASK >> 15) & 1) { for (int z = 0; z < 10; ++z) grid_sync(pl, smem); }
        }
        PHASE_I(11, phase_norm2_route(p, l, lds));
        PHASE_I(12, moe_offsets(p, l, offs); phase_moe_up(p, l, offs, lds));
        PHASE_I(13, phase_moe_down(p, l, offs, lds));
        PHASE_I(14, phase_moe_combine(p, l, offs); if (l + 1 < DEPTH) phase_norm1(p, l + 1, 0));
        if ((DUP_MASK >> 19) & 1) { PHASE(phase_moe_combine(p, l, offs, true)); }
    }
#if WAITPROBE >= 0
    if (blockIdx.x == WAITPROBE && threadIdx.x == 0) {
        const unsigned long long w = *(LAS unsigned long long*)(smem + 32), t0 = __builtin_amdgcn_s_memrealtime();
        while (__builtin_amdgcn_s_memrealtime() - t0 < w) __builtin_amdgcn_s_sleep(8); }
#endif
}

static size_t align_up(size_t x, size_t a) { return (x + a - 1) / a * a; }

extern "C" void kernel_launch(void* const* d_in, const int* in_sizes, int n_in, void* d_out, int out_size, void* d_ws, size_t ws_size, hipStream_t stream) {
    (void)in_sizes; (void)n_in; (void)out_size;
    Params p; memset(&p, 0, sizeof(p));
    for (int i = 0; i < 35; ++i) p.in[i] = (const float*)d_in[i];
    p.out = (float*)d_out;
    char* w = (char*)d_ws; size_t o = 0;
    auto take = [&](size_t bytes) { char* r = w + o; o = align_up(o + bytes, 256); return r; };
    p.ctrl = (unsigned*)take(CTRL_WORDS * 4);
    p.modv = (float*)take((size_t)DEPTH * 5 * 6144 * 4);
    p.lbv = (float*)take((size_t)DEPTH * 2 * 512 * 4);
    p.xc = (float*)take((size_t)NB * CTX * DM * 4);
    p.rope = (float*)take((size_t)SEQ * 32 * 4);
    p.lrula = (float*)take((size_t)DEPTH * 2 * 512 * 4);
    p.winA = (bf16_t*)take((size_t)DEPTH * PA_W * DM * 2);
    p.winG = (bf16_t*)take((size_t)DEPTH * PG_W * DM * 2);
    p.wup = (bf16_t*)take((size_t)DEPTH * UPW * 256 * 2);
    p.wcat = (bf16_t*)take((size_t)DEPTH * DM * OCW * 2);
    p.wout = (bf16_t*)take((size_t)DEPTH * DM * DM * 2);
    p.w13 = (bf16_t*)take((size_t)DEPTH * NEXP * 512 * DM * 2);
    p.w2 = (bf16_t*)take((size_t)DEPTH * NEXP * DM * DEXP * 2);
    p.wlru = (bf16_t*)take((size_t)DEPTH * 2 * 8 * 2 * 64 * 64 * 2);
    p.tok_e = (int*)take((size_t)TT * 2 * 4); p.tok_s = (int*)take((size_t)TT * 2 * 4);
    p.lst = (int*)take((size_t)NEXP * TT * 4); p.tok_w = (float*)take((size_t)NEXP * TT * 4);
    p.rww = (float*)take((size_t)RP * 4); p.rmr = (int*)take((size_t)RP * 4);
    const size_t region = o;
    p.hx = (bf16_t*)take((size_t)HR * DM * 2);
    p.pa = (bf16_t*)take((size_t)HR * PA_W * 2);
    p.ocat = (bf16_t*)take((size_t)HR * OCW * 2);
    p.lsum = (float*)take((size_t)2 * 2 * NT16 * 512 * 2 * 4); p.lin = (float*)take((size_t)2 * 2 * NT16 * 512 * 4);
    const size_t alias1 = o;
    p.up = (bf16_t*)take((size_t)HR * UPW * 2);
    const size_t after_up = o; o = alias1;
    p.st = (bf16_t*)take((size_t)2 * 2 * 8 * NCH * 4096 * 2); p.stb = (float*)take((size_t)2 * 2 * 8 * NCH * 64 * 4);
    if (o < after_up) o = after_up;
    const size_t alias2 = o;
    p.q = (bf16_t*)take((size_t)2 * 8 * SEQ * 96 * 2); p.qc = (bf16_t*)take((size_t)2 * 8 * CTX * 96 * 2); p.kv = (unsigned char*)take((size_t)2 * 8 * NCH * KVT_BYTES);
    const size_t mixer_end = o; o = alias2;
    p.y = (bf16_t*)take((size_t)HR * DM * 2);
    size_t end1 = mixer_end > o ? mixer_end : o;
    o = region;
    p.h2 = (bf16_t*)take((size_t)TT * DM * 2);
    p.h2p = (bf16_t*)take((size_t)RP * DM * 2);
    p.hid = (bf16_t*)take((size_t)RP * DEXP * 2);
    p.yo = (bf16_t*)take((size_t)RP * DM * 2);
    const size_t need = end1 > o ? end1 : o;
    static int grid = 0;
    if (!grid) {
        int dev = 0, cus = 0, per_cu = 0; hipGetDevice(&dev); hipDeviceGetAttribute(&cus, hipDeviceAttributeMultiprocessorCount, dev);
        hipFuncSetAttribute((const void*)hybrid_flow_backbone_kernel, hipFuncAttributeMaxDynamicSharedMemorySize, LDS_TOTAL);
        hipOccupancyMaxActiveBlocksPerMultiprocessor(&per_cu, (const void*)hybrid_flow_backbone_kernel, 512, LDS_TOTAL);
        if (per_cu < 1) fprintf(stderr, "kernel_launch: occupancy query returned %d\n", per_cu);
        grid = cus * (per_cu < 1 ? 0 : 1); if (grid > 256) grid = 256;
    }
    if (need > ws_size) { fprintf(stderr, "kernel_launch: workspace too small: need %zu have %zu\n", need, ws_size); return; }
    if (grid < 8) { fprintf(stderr, "kernel_launch: grid %d too small\n", grid); return; }
    hipMemsetAsync(p.ctrl, 0, CTRL_WORDS * 4, stream);
    hipLaunchKernelGGL(hybrid_flow_backbone_kernel, dim3(grid), dim3(512), LDS_TOTAL, stream, p);
}
```

```cpp
#include <hip/hip_runtime.h>
#include <stdint.h>
#include <stdio.h>
#include <string.h>

#define LAS __attribute__((address_space(3)))
#define DEVI __device__ __forceinline__
typedef unsigned short bf16_t;
typedef short bf16x8 __attribute__((ext_vector_type(8)));
typedef float f32x4 __attribute__((ext_vector_type(4)));
typedef float f32x16 __attribute__((ext_vector_type(16)));
typedef unsigned u32x4 __attribute__((ext_vector_type(4)));
typedef unsigned u32x2 __attribute__((ext_vector_type(2)));

constexpr int NB = 4, SEQ = 8192, CTX = 256, DM = 1024, DEPTH = 2;
constexpr int RB = SEQ + CTX;
constexpr int TT = NB * RB;
constexpr int HR = 2 * RB;
constexpr int NCH = RB / 64;
constexpr int INW = 7072;
constexpr int PA_W = 4096;
constexpr int PG_W = 3072;
constexpr int C_Q = 0, C_ZF = 512, C_ZB = 1024, C_I = 1536, C_G = 2048, C_DQ = 2560, C_DKV = 2816, C_KR = 2944, C_LX = 3072, C_LY = 3584;
constexpr int UPW = 1792;
constexpr int OCW = 1536;
constexpr int KVT_BYTES = 22016;
constexpr int KT_BYTES = 13312;
constexpr int NEXP = 16, DEXP = 256;
constexpr float EPSF = 1e-6f;
constexpr int LDS_TOTAL = 160 * 1024;

DEVI float bf2f(bf16_t b) { return __uint_as_float(((unsigned)b) << 16); }
DEVI bf16_t f2bf(float f) { return __builtin_bit_cast(bf16_t, (__bf16)f); }
typedef float f32x2_t __attribute__((ext_vector_type(2)));
typedef __bf16 bf16x2_t __attribute__((ext_vector_type(2)));
DEVI unsigned cvt_pk_bf16(float lo, float hi) { const f32x2_t v = {lo, hi}; return __builtin_bit_cast(unsigned, __builtin_convertvector(v, bf16x2_t)); }
DEVI float fast_exp2(float x) { return __builtin_amdgcn_exp2f(x); }
DEVI float fast_rcp(float x) { return __builtin_amdgcn_rcpf(x); }
DEVI float sigmoidf_(float x) { return fast_rcp(1.0f + fast_exp2(-1.44269504f * x)); }
DEVI float wave_sum(float v) { for (int o = 32; o >= 1; o >>= 1) v += __shfl_xor(v, o); return v; }
DEVI float wave_max(float v) { for (int o = 32; o >= 1; o >>= 1) v = fmaxf(v, __shfl_xor(v, o)); return v; }

DEVI int opq_tid() { int t = threadIdx.x; asm volatile("" : "+v"(t)); return t; }
DEVI int opq_bid() { int b = blockIdx.x; asm volatile("" : "+s"(b)); return b; }

DEVI int vzero() { int z = 0; asm volatile("" : "+v"(z)); return z; }

#ifndef RAW_LDS_SYNC
#define RAW_LDS_SYNC 0
#endif
#if RAW_LDS_SYNC
#define LDS_SYNC() do { asm volatile("s_waitcnt lgkmcnt(0)" ::: "memory"); __builtin_amdgcn_s_barrier(); asm volatile("" ::: "memory"); } while (0)
#else
#define LDS_SYNC() __syncthreads()
#endif

#define XB_TMO      128
#define XB_XCNT(j)  (256  + 64 * (j))
#define XB_XSUB(j)  (1280 + 64 * (j))
#define XB_XGEN(j)  (2304 + 64 * (j))
#define XB_TOP      3328
#define XB_TOPGEN   3392
#define XCD_BAR_WORDS 3456
#define XB_SPIN_CAP (1u << 18)

__device__ __forceinline__ unsigned xb_ld(unsigned* p)              { return __hip_atomic_load(p, __ATOMIC_RELAXED, __HIP_MEMORY_SCOPE_AGENT); }
__device__ __forceinline__ unsigned xb_add(unsigned* p, unsigned v) { return __hip_atomic_fetch_add(p, v, __ATOMIC_RELAXED, __HIP_MEMORY_SCOPE_AGENT); }
__device__ __forceinline__ unsigned xb_xcc_id() { return (unsigned)__builtin_amdgcn_s_getreg((3 << 11) | 20) & 0xFu; }
#define XB_SPIN(cond, bar) do { unsigned _sp = 0; while (cond) { __builtin_amdgcn_s_sleep(1); \
    if ((++_sp & 255u) == 0u) { if (xb_ld(&(bar)[XB_TMO])) break; if (_sp > XB_SPIN_CAP) { atomicAdd(&(bar)[XB_TMO], 1u); break; } } } } while (0)

struct XcdBarrier { unsigned* bar; unsigned x; volatile LAS unsigned* st; };

__device__ __forceinline__ XcdBarrier xcd_barrier_post(unsigned* bar, volatile LAS unsigned* st) {
    XcdBarrier b; b.bar = bar; b.x = xb_xcc_id(); b.st = st;
    if (threadIdx.x == 0) (void)xb_add(&bar[XB_XCNT(b.x)], 1u);
    return b;
}
__device__ __forceinline__ void xcd_barrier_complete(unsigned* bar, unsigned x, unsigned& nloc, unsigned& nx) {
    const unsigned G = gridDim.x * gridDim.y * gridDim.z;
    unsigned sum, cnt, mine, sp = 0u;
    for (;;) {
        sum = 0u; cnt = 0u; mine = 0u;
#pragma unroll
        for (unsigned j = 0; j < 16; ++j) { const unsigned c = xb_ld(&bar[XB_XCNT(j)]); sum += c; cnt += (c > 0u) ? 1u : 0u; mine = (j == x) ? c : mine; }
        if (sum == G) break;
        __builtin_amdgcn_s_sleep(1);
        if ((++sp & 255u) == 0u) { if (xb_ld(&bar[XB_TMO])) break; if (sp > XB_SPIN_CAP) { atomicAdd(&bar[XB_TMO], 1u); break; } }
    }
    nloc = mine > 0u ? mine : 1u; nx = cnt > 0u ? cnt : 1u;
}
__device__ __forceinline__ void xcd_barrier(const XcdBarrier& b) {
    asm volatile("s_waitcnt vmcnt(0)" ::: "memory");
    __syncthreads();
    if (threadIdx.x == 0) {
        unsigned* bar = b.bar;
        __builtin_amdgcn_s_waitcnt(0);
        unsigned nloc = b.st[0], nx = b.st[1];
        if (nloc == 0u) { xcd_barrier_complete(bar, b.x, nloc, nx); b.st[0] = nloc; b.st[1] = nx; }
        const unsigned old = xb_add(&bar[XB_XSUB(b.x)], 1u);
        const unsigned gen = old / nloc;
        if (old + 1u == (gen + 1u) * nloc) {
            __builtin_amdgcn_fence(__ATOMIC_RELEASE, "agent");
            asm volatile("s_waitcnt vmcnt(0)" ::: "memory");
            const unsigned og = xb_add(&bar[XB_TOP], 1u);
            const unsigned tg = og / nx;
            if (og + 1u == (tg + 1u) * nx) xb_add(&bar[XB_TOPGEN], 1u);
            else XB_SPIN(xb_ld(&bar[XB_TOPGEN]) == tg, bar);
            __builtin_amdgcn_fence(__ATOMIC_ACQUIRE, "agent");
            xb_add(&bar[XB_XGEN(b.x)], 1u);
            asm volatile("s_waitcnt vmcnt(0)" ::: "memory");
        } else {
            XB_SPIN(xb_ld(&bar[XB_XGEN(b.x)]) == gen, bar);
            __builtin_amdgcn_fence(__ATOMIC_ACQUIRE, "agent");
            asm volatile("s_waitcnt vmcnt(0)" ::: "memory");
        }
    }
    __syncthreads();
}

struct Params {
    const float* in[35];
    float* out;
    unsigned* ctrl;
    float* modv;
    float* lbv;
    float* xc;
    float* lrula;
    float* rope;
    bf16_t* winA; bf16_t* winG; bf16_t* wup; bf16_t* wcat; bf16_t* wout; bf16_t* w13; bf16_t* w2; bf16_t* wlru;
    bf16_t* hx;
    bf16_t* pa;
    bf16_t* up;
    bf16_t* q; bf16_t* qc; unsigned char* kv;
    bf16_t* st; float* stb;
    float* lsum; float* lin;
    bf16_t* ocat;
    bf16_t* y;
    bf16_t* h2; bf16_t* h2p; bf16_t* hid; bf16_t* yo;
    int* tok_e; int* tok_s; float* tok_w; int* lst; float* rww; int* rmr;
    unsigned long long pad_;
};

typedef LAS Params PL;

#define CTRL_CNT(l, e) (4096 + 512 * (l) + 16 * (e))
#define CTRL_WORDS 16384
#define CTRL_DQ(k) (5120 + 16 * (k))
#define CTRL_MOEF(l) (6144 + 512 * (l))
#define CTRL_PAF(k)  (7168 + 224 * (k))
#define CTRL_GF(k)   (8192 + 512 * (k))
#ifndef HANDOFF
#define HANDOFF 0
#endif
DEVI void unit_signal(LAS unsigned char* lds, unsigned* flag) {
    if (!HANDOFF) return;
    asm volatile("s_waitcnt vmcnt(0)" ::: "memory");
    if ((opq_tid() & 63) == 0) { const unsigned old = __hip_atomic_fetch_add((LAS unsigned*)(lds - 976), 1u, __ATOMIC_RELAXED, __HIP_MEMORY_SCOPE_WORKGROUP);
        if ((old & 7u) == 7u) { __builtin_amdgcn_fence(__ATOMIC_RELEASE, "agent"); (void)xb_add(flag, 1u); } }
}
DEVI void unit_wait(unsigned* flag, unsigned need) {
    if (!HANDOFF) return;
    if (opq_tid() == 0) { unsigned sp = 0; while (xb_ld(flag) < need) { __builtin_amdgcn_s_sleep(2); if (++sp > (1u << 22)) break; }
        __builtin_amdgcn_fence(__ATOMIC_ACQUIRE, "agent"); }
}
#define DQ_SLOT(lds, k) ((volatile LAS int*)((lds) - 984 + 4 * (k)))

#ifndef EPI_ALIGN
#define EPI_ALIGN 0
#endif
namespace g8 {
constexpr int BM = 256, BK = 64, HALF = 128, HTB = HALF * BK * 2, STAGE_BYTES = 8 * HTB, NXCD = 8, WGM = 8;
__host__ __device__ __forceinline__ int lds_byte(int r, int c) { const int st = (r >> 4) * 2 + (c >> 5), rr = r & 15, cc = c & 31, ob = rr * 64 + cc * 2; return st * 1024 + (ob ^ (((ob >> 9) & 1) << 5)); }
__host__ __device__ __forceinline__ void stage_rc(int b, int& R, int& C) { const int st = b / 1024, sb = b % 1024, swz = sb ^ (((sb >> 9) & 1) << 5); R = (st >> 1) * 16 + swz / 64; C = (st & 1) * 32 + (swz % 64) / 2; }
__host__ __device__ __forceinline__ int perm32(int rho) { const int n = rho >> 4, i = rho & 15; return 8 * (i >> 2) + 4 * n + (i & 3); }

struct Unit { int pm, pn, tag; const char* a; const char* b; };

__device__ __forceinline__ bool static_order(int i, int G, int c, int nM, int nN, int& pm, int& pn) {
    const int nwg = nM * nN; const long L = (long)i * G + c; if (L >= nwg) return false;
    int wgid = (int)L; { const int q = nwg / NXCD, r = nwg % NXCD, xcd = wgid % NXCD, off = wgid / NXCD; wgid = (xcd < r ? xcd * (q + 1) : r * (q + 1) + (xcd - r) * q) + off; }
    const int nig = WGM * nN, gid = wgid / nig, fm = gid * WGM, gsz = (nM - fm) < WGM ? (nM - fm) : WGM;
    pm = fm + ((wgid % nig) % gsz); pn = (wgid % nig) / gsz; return true;
}

template <class Epi, class Sched>
__device__ __forceinline__ void gemm_phase(LAS unsigned char* lds, const int lda, const int ldb, const int K, const Sched& S, const Epi& E) {
    const int tid = opq_tid(), wid = __builtin_amdgcn_readfirstlane(tid >> 6), lane = tid & 63, wr = wid >> 2, wc = wid & 3, fr = lane & 15, fq = lane >> 4;
    const int nt = K / BK;
    unsigned voffB[2]; int RA[2], CA[2];
#pragma unroll
    for (int i = 0; i < 2; ++i) { int R, C; stage_rc(tid * 16 + i * 8192, R, C); const int Rb = Epi::PERM ? ((R & ~31) + perm32(R & 31)) : R;
        RA[i] = R; CA[i] = C; voffB[i] = (unsigned)(Rb * ldb + C) * 2u; }
    auto set_voff = [&](const Unit& u, unsigned (&v)[2][2]) {
#pragma unroll
        for (int h = 0; h < 2; ++h)
#pragma unroll
            for (int i = 0; i < 2; ++i) { if constexpr (Sched::GATHER) v[h][i] = (unsigned)S.row_of(u, h * HALF + RA[i]) * (unsigned)(lda * 2) + (unsigned)CA[i] * 2u;
                else v[h][i] = (unsigned)((h * HALF + RA[i]) * lda + CA[i]) * 2u; } };
    const size_t kstep = (size_t)(BK * 2);
    const size_t hstepB = (size_t)HALF * ldb * 2;
    const unsigned ldsw = (unsigned)wid * 1024u;
    const int aoff = lds_byte(wr * 64 + fr, fq * 8), boff = lds_byte(wc * 32 + fr, fq * 8);
#define G8_SA(b, h) (((b) * 2 + (h)) * HTB)
#define G8_SB(b, h) ((4 + (b) * 2 + (h)) * HTB)
#define G8_STAGE(bufoff, gbase, voff) do { _Pragma("unroll") for (int _i = 0; _i < 2; ++_i) \
        __builtin_amdgcn_global_load_lds((const unsigned*)((const char*)(gbase) + (voff)[_i]), (LAS unsigned*)(lds + (bufoff) + ldsw + _i * 8192), 16, 0, 0); } while (0)
#define G8_LDA(dst, b, h) do { _Pragma("unroll") for (int m = 0; m < 4; ++m) _Pragma("unroll") for (int k = 0; k < 2; ++k) dst[m][k] = *(const LAS bf16x8*)(lds + G8_SA(b, h) + aoff + m * 2048 + k * 1024); } while (0)
#define G8_LDB(dst, b, h) do { _Pragma("unroll") for (int n = 0; n < 2; ++n) _Pragma("unroll") for (int k = 0; k < 2; ++k) dst[n][k] = *(const LAS bf16x8*)(lds + G8_SB(b, h) + boff + n * 2048 + k * 1024); } while (0)
#define G8_MMA(ai, bj, At, Bt) do { __builtin_amdgcn_s_setprio(1); _Pragma("unroll") for (int m = 0; m < 4; ++m) _Pragma("unroll") for (int n = 0; n < 2; ++n) _Pragma("unroll") for (int k = 0; k < 2; ++k) \
        acc[ai][bj][m][n] = __builtin_amdgcn_mfma_f32_16x16x32_bf16(Bt[n][k], At[m][k], acc[ai][bj][m][n], 0, 0, 0); __builtin_amdgcn_s_setprio(0); } while (0)
#define G8_WAIT_V(n) asm volatile("s_waitcnt vmcnt(" #n ")" ::: "memory")
#define G8_WAIT_L(n) asm volatile("s_waitcnt lgkmcnt(" #n ")" ::: "memory")
#define G8_BAR __builtin_amdgcn_s_barrier()
#define G8_SCHED __builtin_amdgcn_sched_barrier(0)
    Unit cur, nxt; int ui = 0;
    if (!S.next(0, cur)) return;
    if constexpr (Sched::DEPS && HANDOFF) __syncthreads();
    f32x4 acc[2][2][4][2];
#pragma unroll
    for (int a = 0; a < 2; ++a)
#pragma unroll
        for (int b = 0; b < 2; ++b)
#pragma unroll
            for (int m = 0; m < 4; ++m)
#pragma unroll
                for (int n = 0; n < 2; ++n) acc[a][b][m][n] = (f32x4){0.f, 0.f, 0.f, 0.f};
    bf16x8 At[4][2], B0[2][2], B1[2][2];
    const char* cA = cur.a; const char* cB = cur.b;
    unsigned vcur[2][2], vnxt[2][2]; set_voff(cur, vcur);
    asm volatile("s_waitcnt lgkmcnt(0)" ::: "memory");
    if constexpr (Sched::GATHER) asm volatile("s_waitcnt vmcnt(0)" ::: "memory");
    G8_STAGE(G8_SB(0, 0), cB, voffB); G8_STAGE(G8_SA(0, 0), cA, vcur[0]); G8_STAGE(G8_SB(0, 1), cB + hstepB, voffB); G8_STAGE(G8_SA(0, 1), cA, vcur[1]);
    if (wr == 1) G8_BAR;
    G8_WAIT_V(4); G8_BAR;
    G8_STAGE(G8_SB(1, 0), cB + kstep, voffB); G8_STAGE(G8_SA(1, 0), cA + kstep, vcur[0]); G8_STAGE(G8_SB(1, 1), cB + hstepB + kstep, voffB);
    G8_WAIT_V(6); G8_BAR;
    for (;;) {
        const bool has_next = S.next(ui + 1, nxt);
        const char* nA = has_next ? nxt.a : cA; const char* nB = has_next ? nxt.b : cB;
        if (has_next) set_voff(nxt, vnxt); else {
#pragma unroll
            for (int h = 0; h < 2; ++h) { vnxt[h][0] = vcur[h][0]; vnxt[h][1] = vcur[h][1]; } }
        asm volatile("s_waitcnt lgkmcnt(0)" ::: "memory");
        const int tseg = nt / Epi::NSEG;
#pragma unroll 1
        for (int sg = 0; sg < Epi::NSEG; ++sg) {
#pragma unroll 1
        for (int t = sg * tseg; t < (sg + 1) * tseg; t += 2) {
            const bool last = (t == nt - 2);
            const char* a1 = cA + (size_t)(t + 1) * kstep;
            const char* a2 = last ? nA : cA + (size_t)(t + 2) * kstep; const char* b2 = last ? nB : cB + (size_t)(t + 2) * kstep;
            const char* a3 = a2 + kstep; const char* b3 = b2 + kstep;
            unsigned v20[2], v21[2];
#pragma unroll
            for (int i = 0; i < 2; ++i) { v20[i] = last ? vnxt[0][i] : vcur[0][i]; v21[i] = last ? vnxt[1][i] : vcur[1][i]; }
            G8_LDB(B0, 0, 0); G8_SCHED; G8_LDA(At, 0, 0); G8_STAGE(G8_SA(1, 1), a1, vcur[1]);
            G8_WAIT_L(8); G8_BAR; G8_WAIT_L(0); G8_MMA(0, 0, At, B0); G8_BAR; G8_SCHED;
            G8_LDB(B1, 0, 1); G8_STAGE(G8_SB(0, 0), b2, voffB);
            G8_BAR; G8_WAIT_L(0); G8_MMA(0, 1, At, B1); G8_BAR;
            G8_LDA(At, 0, 1); G8_STAGE(G8_SA(0, 0), a2, v20);
            G8_BAR; G8_WAIT_L(0); G8_MMA(1, 0, At, B0); G8_BAR; G8_SCHED;
            G8_STAGE(G8_SB(0, 1), b2 + hstepB, voffB);
            G8_WAIT_V(6); G8_BAR; G8_MMA(1, 1, At, B1); G8_BAR;
            G8_LDB(B0, 1, 0); G8_SCHED; G8_LDA(At, 1, 0); G8_STAGE(G8_SA(0, 1), a2, v21);
            G8_WAIT_L(8); G8_BAR; G8_WAIT_L(0); G8_MMA(0, 0, At, B0); G8_BAR; G8_SCHED;
            G8_LDB(B1, 1, 1); G8_STAGE(G8_SB(1, 0), b3, voffB);
            G8_BAR; G8_WAIT_L(0); G8_MMA(0, 1, At, B1); G8_BAR;
            G8_LDA(At, 1, 1); G8_STAGE(G8_SA(1, 0), a3, v20);
            G8_BAR; G8_WAIT_L(0); G8_MMA(1, 0, At, B0); G8_BAR; G8_SCHED;
            G8_STAGE(G8_SB(1, 1), b3 + hstepB, voffB);
            G8_WAIT_V(6); G8_BAR; G8_MMA(1, 1, At, B1); G8_BAR;
        }
        if constexpr (Epi::NSEG > 1) { if (sg + 1 < Epi::NSEG) { if (wr == 0) G8_BAR; E.mid(sg, acc, cur, wr, wc, fr, fq); if (wr == 1) G8_BAR; } }
        }
#if EPI_ALIGN
        if (has_next && wr == 0) G8_BAR;
#endif
        E(acc, cur, wr, wc, fr, fq);
        if constexpr (Epi::SIGNAL) E.signal(cur, lds);
        if (!has_next) break;
#if EPI_ALIGN
        if (wr == 1) G8_BAR;
#endif
#pragma unroll
        for (int a = 0; a < 2; ++a)
#pragma unroll
            for (int b = 0; b < 2; ++b)
#pragma unroll
                for (int m = 0; m < 4; ++m)
#pragma unroll
                    for (int n = 0; n < 2; ++n) acc[a][b][m][n] = (f32x4){0.f, 0.f, 0.f, 0.f};
        cur = nxt; cA = nA; cB = nB; ++ui;
#pragma unroll
        for (int h = 0; h < 2; ++h) { vcur[h][0] = vnxt[h][0]; vcur[h][1] = vnxt[h][1]; }
    }
    G8_WAIT_V(0);
    if (wr == 0) G8_BAR;
    G8_BAR;
#undef G8_SA
#undef G8_SB
#undef G8_STAGE
#undef G8_LDA
#undef G8_LDB
#undef G8_MMA
#undef G8_WAIT_V
#undef G8_WAIT_L
#undef G8_BAR
#undef G8_SCHED
}
}

enum { I_X = 0, I_C, I_CTX, I_CCTX, I_WMOD, I_BMOD, I_NMIX, I_NFFN, I_WIN, I_HGLB, I_HGNORM, I_QNORM, I_KVNORM, I_WUQ, I_WUKV, I_GQ, I_GK,
       I_CONVW, I_CONVB, I_LWA, I_LBA, I_LWX, I_LBX, I_LAM, I_BRHG, I_BRMLA, I_BRLRU, I_WOUT, I_WRG, I_BRG, I_WRE, I_BRE, I_W1, I_W3, I_W2 };

DEVI const float* xin_row_l0(const Params& p, int r) { const int b = r / RB, pos = r - b * RB;
    return pos < SEQ ? p.in[I_X] + ((size_t)b * SEQ + pos) * DM : p.in[I_CTX] + ((size_t)b * CTX + (pos - SEQ)) * DM; }
DEVI float* xbuf_row(const Params& p, int r) { const int b = r / RB, pos = r - b * RB;
    return pos < SEQ ? p.out + ((size_t)b * SEQ + pos) * DM : p.xc + ((size_t)b * CTX + (pos - SEQ)) * DM; }
DEVI int mod_row(int r) { const int b = r / RB, pos = r - b * RB; return pos < SEQ ? b : 4; }

struct TrJob { const float* src; int ld; int K; int ncols; bf16_t* dst; int dld; const float* ks; };

DEVI int tr_job_count() { return DEPTH * (12 + 16 * 5 + 32); }
template <class P> DEVI TrJob tr_job(const P& p, int j) {
    const int per = 12 + 16 * 5 + 32; const int l = j / per; int q = j - l * per; TrJob t; t.ks = nullptr; t.src = nullptr;
    const float* win = p.in[I_WIN] + (size_t)l * DM * INW;
    bf16_t* winA = p.winA + (size_t)l * PA_W * DM; bf16_t* wup = p.wup + (size_t)l * UPW * 256; bf16_t* wcat = p.wcat + (size_t)l * DM * OCW;
    if (q == 0) { t.src = win; t.ld = INW; t.K = DM; t.ncols = 2944; t.dst = winA; t.dld = DM; return t; }
    if (q == 11) { t.src = win + 2944; t.ld = INW; t.K = DM; t.ncols = 32; t.dst = winA + (size_t)2944 * DM; t.dld = DM; return t; }
    if (q == 1) { t.src = nullptr; t.ld = 0; t.K = DM; t.ncols = 96; t.dst = winA + (size_t)2976 * DM; t.dld = DM; return t; }
    if (q == 2) { t.src = win + 2976; t.ld = INW; t.K = DM; t.ncols = 1024; t.dst = winA + (size_t)3072 * DM; t.dld = DM; return t; }
    if (q == 3) { t.src = win + 4000; t.ld = INW; t.K = DM; t.ncols = PG_W; t.dst = p.winG + (size_t)l * PG_W * DM; t.dld = DM; return t; }
    if (q == 4) { t.src = p.in[I_WUQ] + (size_t)l * 256 * 768; t.ld = 768; t.K = 256; t.ncols = 768; t.dst = wup; t.dld = 256; t.ks = p.in[I_QNORM] + l * 256; return t; }
    if (q == 5) { t.src = p.in[I_WUKV] + (size_t)l * 128 * 1024; t.ld = 1024; t.K = 128; t.ncols = 1024; t.dst = wup + (size_t)768 * 256; t.dld = 256; t.ks = p.in[I_KVNORM] + l * 128; return t; }
    if (q == 6) { t.src = nullptr; t.ld = 0; t.K = 128; t.ncols = 1024; t.dst = wup + (size_t)768 * 256 + 128; t.dld = 256; return t; }
    if (q >= 7 && q <= 9) { const int i = q - 7; const float* s = (i == 0 ? p.in[I_BRHG] : i == 1 ? p.in[I_BRMLA] : p.in[I_BRLRU]) + (size_t)l * 512 * DM;
        t.src = s; t.ld = DM; t.K = 512; t.ncols = DM; t.dst = wcat + i * 512; t.dld = OCW; return t; }
    if (q == 10) { t.src = p.in[I_WOUT] + (size_t)l * DM * DM; t.ld = DM; t.K = DM; t.ncols = DM; t.dst = p.wout + (size_t)l * DM * DM; t.dld = DM; return t; }
    q -= 12;
    if (q < 80) { const int e = q / 5, s = q % 5; const size_t le = (size_t)l * NEXP + e;
        if (s < 4) { const int pn = s >> 1, which = s & 1;
            t.src = (which ? p.in[I_W3] : p.in[I_W1]) + le * DM * DEXP + pn * 128; t.ld = DEXP; t.K = DM; t.ncols = 128;
            t.dst = p.w13 + le * 512 * DM + (size_t)(pn * 256 + which * 128) * DM; t.dld = DM; return t; }
        t.src = p.in[I_W2] + le * DEXP * DM; t.ld = DM; t.K = DEXP; t.ncols = DM; t.dst = p.w2 + le * DM * DEXP; t.dld = DEXP; return t; }
    q -= 80;
    { const int d = q >> 4, n = (q >> 1) & 7, which = q & 1;
      const size_t blk = (((size_t)l * 2 + d) * 8 + n);
      t.src = (which ? p.in[I_LWX] : p.in[I_LWA]) + blk * 64 * 64; t.ld = 64; t.K = 64; t.ncols = 64;
      t.dst = p.wlru + (blk * 2 + which) * 64 * 64; t.dld = 64; return t; }
}

template <class P> DEVI void phase_prep(const P& p, LAS unsigned char* lds) {
    const int tid = opq_tid(), G = gridDim.x;
    LAS float* tl = (LAS float*)lds;
    const int nj = tr_job_count();
    struct JobL { const float* src; const float* ks; bf16_t* dst; int ld, dld, tk, nt; };
    LAS JobL* jt = (LAS JobL*)(lds + 72 * 1024);
    LAS int* jstart = (LAS int*)(lds + 72 * 1024 + 512 * 40);
    if (tid < nj) { const TrJob t = tr_job(p, tid); const bool wide = (t.ncols & 63) == 0; JobL e; e.src = t.src; e.ks = t.ks; e.dst = t.dst; e.ld = t.ld; e.dld = t.dld; e.tk = t.K / 64;
        e.nt = wide ? (t.K / 64) * (t.ncols / 64) : 0;
        jt[tid].src = e.src; jt[tid].ks = e.ks; jt[tid].dst = e.dst; jt[tid].ld = e.ld; jt[tid].dld = e.dld; jt[tid].tk = e.tk; jt[tid].nt = e.nt; }
    __syncthreads();
    if (tid <= nj) { int sacc = 0; for (int i = 0; i < tid; ++i) sacc += jt[i].nt; jstart[tid] = sacc; }
    __syncthreads();
    {
        const int T = jstart[nj]; int jc = 0;
        for (int g0 = opq_bid(); g0 < T; g0 += 4 * G) {
            f32x4 v[4][2]; bf16_t* dq[4]; int dl[4];
#pragma unroll
            for (int q = 0; q < 4; ++q) { const int g = g0 + q * G; dq[q] = nullptr; dl[q] = 0;
                v[q][0] = (f32x4){0.f, 0.f, 0.f, 0.f}; v[q][1] = v[q][0];
                if (g < T) {
                    while (jstart[jc + 1] <= g) ++jc;
                    const int jcu = __builtin_amdgcn_readfirstlane(jc);
                    JobL e; e.src = jt[jcu].src; e.ks = jt[jcu].ks; e.dst = jt[jcu].dst; e.ld = jt[jcu].ld; e.dld = jt[jcu].dld; e.tk = jt[jcu].tk;
                    const int tk = __builtin_amdgcn_readfirstlane(e.tk), tile = g - __builtin_amdgcn_readfirstlane(jstart[jcu]), ld = __builtin_amdgcn_readfirstlane(e.ld);
                    const int k0 = (tile % tk) * 64, n0 = (tile / tk) * 64; const int n4 = tid & 15, kr = tid >> 4;
                    dq[q] = e.dst + (size_t)n0 * e.dld + k0; dl[q] = e.dld;
                    if (e.src) {
#pragma unroll
                        for (int i = 0; i < 2; ++i) { const int k = kr + 32 * i; f32x4 x = *(const f32x4*)(e.src + (size_t)(k0 + k) * ld + n0 + n4 * 4); if (e.ks) x *= e.ks[k0 + k]; v[q][i] = x; } } } }
#pragma unroll
            for (int q = 0; q < 4; ++q) { const int n4 = tid & 15, kr = tid >> 4;
#pragma unroll
                for (int i = 0; i < 2; ++i) { LAS float* d = tl + q * 4160 + (kr + 32 * i) * 65 + n4 * 4; d[0] = v[q][i][0]; d[1] = v[q][i][1]; d[2] = v[q][i][2]; d[3] = v[q][i][3]; } }
            __syncthreads();
#pragma unroll
            for (int q = 0; q < 4; ++q) { if (dq[q]) { const int n = tid >> 3, k8 = (tid & 7) * 8;
                const LAS float* sp = tl + q * 4160 + k8 * 65 + n;
                u32x4 w; w.x = cvt_pk_bf16(sp[0], sp[65]); w.y = cvt_pk_bf16(sp[130], sp[195]); w.z = cvt_pk_bf16(sp[260], sp[325]); w.w = cvt_pk_bf16(sp[390], sp[455]);
                *(u32x4*)(dq[q] + (size_t)n * dl[q] + k8) = w; } }
            __syncthreads();
        }
    }
    int rot = 0;
    for (int jj = 0; jj < DEPTH * 2; ++jj) {
        const int j = (jj >> 1) * (12 + 16 * 5 + 32) + ((jj & 1) ? 11 : 1);
        const TrJob t = tr_job(p, j);
        const int tk = t.K / 64, ntile = tk * (t.ncols / 32);
        const int first = (int)((opq_bid() + (unsigned)G - (unsigned)(rot % G)) % (unsigned)G);
        {
            for (int tile0 = first; tile0 < ntile; tile0 += 8 * G) {
                float v[8][4];
#pragma unroll
                for (int q = 0; q < 8; ++q) { const int tile = tile0 + q * G; const int k0 = (tile % tk) * 64, n0 = (tile / tk) * 32; const int n = tid & 31, kr = tid >> 5;
#pragma unroll
                    for (int i = 0; i < 4; ++i) { const int k = kr + 16 * i; float x = 0.f;
                        if (tile < ntile && t.src) { x = t.src[(size_t)(k0 + k) * t.ld + n0 + n]; if (t.ks) x *= t.ks[k0 + k]; }
                        v[q][i] = x; } }
#pragma unroll
                for (int q = 0; q < 8; ++q) { const int n = tid & 31, kr = tid >> 5;
#pragma unroll
                    for (int i = 0; i < 4; ++i) tl[q * 2112 + (kr + 16 * i) * 33 + n] = v[q][i]; }
                __syncthreads();
#pragma unroll
                for (int q = 0; q < 8; ++q) { const int tile = tile0 + q * G; if (tile < ntile) { const int k0 = (tile % tk) * 64, n0 = (tile / tk) * 32; const int k = tid & 63, nn = tid >> 6;
#pragma unroll
                    for (int i = 0; i < 4; ++i) { const int n = nn + 8 * i; t.dst[(size_t)(n0 + n) * t.dld + k0 + k] = f2bf(tl[q * 2112 + k * 33 + n]); } } }
                __syncthreads();
            }
        }
        rot += ntile;
    }
    {
        LAS float* sl = (LAS float*)lds;
        LAS float* red = sl + 5 * 1024;
        for (int i = tid; i < 5 * 1024; i += 512) { const int r = i >> 10, k = i & 1023; const float v = r < 4 ? p.in[I_C][r * DM + k] : p.in[I_CCTX][k]; sl[i] = v * sigmoidf_(v); }
        __syncthreads();
        for (int u = opq_bid(); u < DEPTH * 96; u += G) {
            const int l = u / 96, n0 = (u % 96) * 64, c4 = (tid & 15) * 4, ks = tid >> 4;
            const float* w = p.in[I_WMOD] + (size_t)l * DM * 6144 + n0 + c4;
            f32x4 a0 = {0.f, 0.f, 0.f, 0.f}, a1 = a0, a2 = a0, a3 = a0, a4 = a0;
#pragma unroll 8
            for (int k = ks * 32; k < ks * 32 + 32; ++k) { const f32x4 wv = *(const f32x4*)(w + (size_t)k * 6144);
                a0 += sl[k] * wv; a1 += sl[1024 + k] * wv; a2 += sl[2048 + k] * wv; a3 += sl[3072 + k] * wv; a4 += sl[4096 + k] * wv; }
            *(LAS f32x4*)(red + (ks * 5 + 0) * 64 + c4) = a0; *(LAS f32x4*)(red + (ks * 5 + 1) * 64 + c4) = a1; *(LAS f32x4*)(red + (ks * 5 + 2) * 64 + c4) = a2;
            *(LAS f32x4*)(red + (ks * 5 + 3) * 64 + c4) = a3; *(LAS f32x4*)(red + (ks * 5 + 4) * 64 + c4) = a4;
            __syncthreads();
            if (tid < 320) { const int r = tid >> 6, c2 = tid & 63; float s2 = p.in[I_BMOD][l * 6144 + n0 + c2];
#pragma unroll
                for (int q = 0; q < 32; ++q) s2 += red[(q * 5 + r) * 64 + c2];
                p.modv[((size_t)l * 5 + r) * 6144 + n0 + c2] = s2; }
            __syncthreads();
        }
    }
    for (int i = opq_bid() * 512 + tid; i < SEQ * 16; i += G * 512) { const int pos = i >> 4, a = i & 15;
        const float inv = exp2f(-(float)(a & 7) * (13.287712379549449f / 8.0f)); const float ang = (float)((a < 8) ? (pos >> 6) : (pos & 63)) * inv;
        float sn, cs; sincosf(ang, &sn, &cs); p.rope[(size_t)pos * 32 + a] = cs; p.rope[(size_t)pos * 32 + 16 + a] = sn; }
    if (opq_bid() == 1) { for (int i = tid; i < DEPTH * 2 * 512; i += 512) p.lrula[i] = -8.0f * 1.44269504f * log1pf(__expf(-p.in[I_LAM][i])); }
    if (opq_bid() == 0) {
        for (int i = tid; i < 2 * 512; i += 512) { const float a0 = p.in[I_HGLB][i], a1 = p.in[I_HGLB][1024 + i]; const float m = fmaxf(a0, a1);
            const float e0 = __expf(a0 - m), e1 = __expf(a1 - m); p.lbv[i] = 0.f; p.lbv[1024 + i] = e1 / (e0 + e1); }
    }
}

DEVI void phase_norm1(const Params& p, int l, int hb) {
    const int lane = opq_tid() & 63, wv = opq_tid() >> 6;
    const float* gm = p.in[I_NMIX] + l * DM;
    const int rstep = gridDim.x * 8, rfirst = opq_bid() * 8 + wv;
    auto rowp = [&](int rl) -> const float* { const int r = hb * HR + rl; return (l == 0) ? xin_row_l0(p, r) : (const float*)xbuf_row(p, r); };
    f32x4 vn[4];
    if (rfirst < HR) { const float* s0 = rowp(rfirst);
#pragma unroll
        for (int i = 0; i < 4; ++i) vn[i] = *(const f32x4*)(s0 + i * 256 + lane * 4); }
    for (int rl = rfirst; rl < HR; rl += rstep) {
        const int r = hb * HR + rl;
        f32x4 v[4]; float ss = 0.f;
#pragma unroll
        for (int i = 0; i < 4; ++i) { v[i] = vn[i]; ss += v[i][0] * v[i][0] + v[i][1] * v[i][1] + v[i][2] * v[i][2] + v[i][3] * v[i][3]; }
        if (rl + rstep < HR) { const float* s1 = rowp(rl + rstep);
#pragma unroll
            for (int i = 0; i < 4; ++i) vn[i] = *(const f32x4*)(s1 + i * 256 + lane * 4); }
        ss = wave_sum(ss);
        const float rstd = rsqrtf(ss * (1.0f / DM) + EPSF);
        const float* mv = p.modv + ((size_t)l * 5 + mod_row(r)) * 6144;
#pragma unroll
        for (int i = 0; i < 4; ++i) { const int c = i * 256 + lane * 4;
            const f32x4 g = *(const f32x4*)(gm + c), sh = *(const f32x4*)(mv + c), sc = *(const f32x4*)(mv + 1024 + c);
            f32x4 h;
#pragma unroll
            for (int e = 0; e < 4; ++e) h[e] = v[i][e] * rstd * g[e] * (1.0f + sc[e]) + sh[e];
            u32x2 w; w.x = cvt_pk_bf16(h[0], h[1]); w.y = cvt_pk_bf16(h[2], h[3]);
            *(u32x2*)(p.hx + (size_t)rl * DM + c) = w; }
    }
}
template <bool DEP> struct TileSchedT {
    static constexpr bool GATHER = false, DEPS = DEP;
    int nM, nN, G, c, skipctx; const char* A; const char* B; size_t atile, btile; size_t acol_bytes;
    unsigned* flags;
    DEVI bool next(int i, g8::Unit& u) const {
        int pm, pn; if (!g8::static_order(i, G, c, nM, nN, pm, pn)) return false;
        const int pma = skipctx ? pm + pm / 32 : pm;
        u.pm = pma; u.pn = pn; u.tag = 0; u.a = A + (size_t)pma * atile + acol_bytes; u.b = B + (size_t)pn * btile;
        if (DEP) unit_wait(flags + pma * 4 + pn, 3u);
        return true; }
};
typedef TileSchedT<false> TileSched;

template <int ACT, bool SIG = false> struct EpiBf16 {
    static constexpr bool PERM = true, HAS_MID = false, SIGNAL = SIG; static constexpr int NSEG = 1;
    bf16_t* O; int ldc; unsigned* flags; int smode;
    DEVI void signal(const g8::Unit& u, LAS unsigned char* lds) const {
        if (smode == 0) { if (u.pn == 10 || u.pn == 11) unit_signal(lds, flags + u.pm * 2 + (u.pn - 10)); } else if (smode == 1) unit_signal(lds, flags + u.pm); else unit_signal(lds, flags + u.pm * 4 + (u.pn & 3)); }
    DEVI void operator()(const f32x4 (&acc)[2][2][4][2], const g8::Unit& u, int wr, int wc, int fr, int fq) const {
        const int row0 = u.pm * 256 + wr * 64 + fr, col0 = u.pn * 256 + wc * 32 + 8 * fq;
#pragma unroll
        for (int ai = 0; ai < 2; ++ai)
#pragma unroll
            for (int m = 0; m < 4; ++m) { bf16_t* rowp = O + (size_t)(row0 + ai * 128 + m * 16) * ldc + col0;
#pragma unroll
                for (int bj = 0; bj < 2; ++bj) { f32x4 v0 = acc[ai][bj][m][0], v1 = acc[ai][bj][m][1];
                    if (ACT == 1) {
#pragma unroll
                        for (int e = 0; e < 4; ++e) { v0[e] = sigmoidf_(v0[e]); v1[e] = sigmoidf_(v1[e]); } }
                    u32x4 w; w.x = cvt_pk_bf16(v0[0], v0[1]); w.y = cvt_pk_bf16(v0[2], v0[3]); w.z = cvt_pk_bf16(v1[0], v1[1]); w.w = cvt_pk_bf16(v1[2], v1[3]);
                    *(u32x4*)(rowp + bj * 128) = w; } }
    }
};


template <int NT, int NCHUNK, int NSEG, class F>
DEVI void ctx_gemm(LAS unsigned char* lds, const bf16_t* A, int lda, const bf16_t* Bt, int ldb, F& f) {
    constexpr int ROWS = 64 + 32 * NT, NLD = ROWS * 16 / 512, PITCH = 272, BUF = ROWS * PITCH;
    static_assert(ROWS * 16 % 512 == 0 && NCHUNK % NSEG == 0 && 2 * BUF <= 150 * 1024, "ctx_gemm tile");
    const int tid = opq_tid(), wid = __builtin_amdgcn_readfirstlane(tid >> 6), lane = tid & 63, fr = lane & 15, fq = lane >> 4, wrow = wid & 3, wcol = wid >> 2;
    for (int item = opq_bid(); item < 256; item += gridDim.x) {
        const int x = item & 7, j = item >> 3, ct = 4 * x + (j & 3), rt = j >> 2;
        const char* src[NLD]; int dst[NLD];
#pragma unroll
        for (int i = 0; i < NLD; ++i) { const int idx = tid + 512 * i, row = idx >> 4, pc = idx & 15;
            if (row < 64) { const int cr = rt * 64 + row, r = (cr >> 8) * RB + SEQ + (cr & 255); src[i] = (const char*)(A + (size_t)r * lda + pc * 8); }
            else src[i] = (const char*)(Bt + (size_t)(ct * 32 * NT + row - 64) * ldb + pc * 8);
            dst[i] = row * PITCH + pc * 16; }
        u32x4 st[2][NLD];
#pragma unroll
        for (int i = 0; i < NLD; ++i) st[0][i] = *(const u32x4*)(src[i]);
        if (NCHUNK > 1) {
#pragma unroll
            for (int i = 0; i < NLD; ++i) st[1][i] = *(const u32x4*)(src[i] + 256); }
#pragma unroll
        for (int i = 0; i < NLD; ++i) *(LAS u32x4*)(lds + dst[i]) = st[0][i];
        __syncthreads();
        f32x4 acc[NT];
#pragma unroll
        for (int t = 0; t < NT; ++t) acc[t] = (f32x4){0.f, 0.f, 0.f, 0.f};
        const int cr_l = rt * 64 + 16 * wrow + fr, r_l = (cr_l >> 8) * RB + SEQ + (cr_l & 255), c_l = ct * 32 * NT + wcol * 16 * NT + 4 * fq;
#pragma unroll
        for (int c = 0; c < NCHUNK; ++c) {
            if (c + 2 < NCHUNK) {
#pragma unroll
                for (int i = 0; i < NLD; ++i) st[c & 1][i] = *(const u32x4*)(src[i] + (c + 2) * 256); }
            const LAS unsigned char* ab = lds + (c & 1) * BUF + (16 * wrow + fr) * PITCH + fq * 16;
            const LAS unsigned char* bb = lds + (c & 1) * BUF + (64 + wcol * 16 * NT + fr) * PITCH + fq * 16;
#pragma unroll
            for (int s4 = 0; s4 < 4; ++s4) { const bf16x8 a = *(const LAS bf16x8*)(ab + s4 * 64);
#pragma unroll
                for (int t = 0; t < NT; ++t) { const bf16x8 b = *(const LAS bf16x8*)(bb + t * 16 * PITCH + s4 * 64); acc[t] = __builtin_amdgcn_mfma_f32_16x16x32_bf16(b, a, acc[t], 0, 0, 0); } }
            if (c + 1 < NCHUNK) {
#pragma unroll
                for (int i = 0; i < NLD; ++i) *(LAS u32x4*)(lds + ((c + 1) & 1) * BUF + dst[i]) = st[(c + 1) & 1][i]; }
            asm volatile("s_waitcnt lgkmcnt(0)" ::: "memory"); __builtin_amdgcn_s_barrier(); asm volatile("" ::: "memory");
            if ((c + 1) % (NCHUNK / NSEG) == 0) { f(c / (NCHUNK / NSEG), acc, r_l, c_l);
#pragma unroll
                for (int t = 0; t < NT; ++t) acc[t] = (f32x4){0.f, 0.f, 0.f, 0.f}; }
        }
    }
}
template <int NT, int ACT> struct CtxStore { bf16_t* O; int ldc;
    DEVI void operator()(int, const f32x4 (&acc)[NT], int r, int c) {
#pragma unroll
        for (int t = 0; t < NT; ++t) { f32x4 v = acc[t];
            if (ACT == 1) {
#pragma unroll
                for (int e = 0; e < 4; ++e) v[e] = sigmoidf_(v[e]); }
            u32x2 w; w.x = cvt_pk_bf16(v[0], v[1]); w.y = cvt_pk_bf16(v[2], v[3]); *(u32x2*)(O + (size_t)r * ldc + c + 16 * t) = w; } }
};
struct CtxMerge { const bf16_t* pg; bf16_t* Y; f32x4 y;
    DEVI void operator()(int sg, const f32x4 (&acc)[1], int r, int c) {
        const u32x2 g = *(const u32x2*)(pg + (size_t)r * PG_W + sg * 1024 + c);
        const f32x4 s = {__uint_as_float(g.x << 16), __uint_as_float(g.x & 0xffff0000u), __uint_as_float(g.y << 16), __uint_as_float(g.y & 0xffff0000u)};
        y = (sg == 0) ? s * acc[0] : y + s * acc[0];
        if (sg == 2) { u32x2 w; w.x = cvt_pk_bf16(y[0], y[1]); w.y = cvt_pk_bf16(y[2], y[3]); *(u32x2*)(Y + (size_t)r * DM + c) = w; } }
};
struct CtxOut { const float* c0; float* xc; const float* g1; int hb;
    DEVI void operator()(int, const f32x4 (&acc)[1], int r, int c) {
        const int gr = hb * HR + r, b = gr / RB, pos = gr - b * RB; const size_t xoff = ((size_t)b * CTX + (pos - SEQ)) * DM + c;
        const f32x4 xv = *(const f32x4*)(c0 + xoff), gv = *(const f32x4*)(g1 + c);
        *(f32x4*)(xc + xoff) = xv + gv * acc[0]; }
};

DEVI void phase_inproj_a(const Params& p, int l, LAS unsigned char* lds, int qi = 0) {
    unsigned* fl = p.ctrl + CTRL_PAF(qi);
    { CtxStore<4, 0> C; C.O = p.pa; C.ldc = PA_W;
      ctx_gemm<4, 8, 1>(lds, p.hx, DM, p.winA + (size_t)l * PA_W * DM, DM, C);
      const int item = opq_bid(), x = item & 7, j = item >> 3, ct = 4 * x + (j & 3), rt = j >> 2;
      if (item < 256 && ct >= 20 && ct < 24) unit_signal(lds, fl + 136 + (rt >> 2) * 2 + (ct >= 22 ? 1 : 0)); }
    TileSched S; S.nM = 64; S.nN = PA_W / 256; S.G = gridDim.x; S.c = opq_bid(); S.skipctx = 1; S.flags = nullptr;
    S.A = (const char*)p.hx; S.B = (const char*)(p.winA + (size_t)l * PA_W * DM); S.atile = (size_t)256 * DM * 2; S.btile = (size_t)256 * DM * 2; S.acol_bytes = 0;
    EpiBf16<0, true> E; E.O = p.pa; E.ldc = PA_W; E.flags = fl; E.smode = 0;
    g8::gemm_phase(lds, DM, DM, DM, S, E);
}

struct UpSched { static constexpr bool GATHER = false, DEPS = true; int G, c; const char* A; const char* B; unsigned* flags;
    DEVI bool next(int i, g8::Unit& u) const { const long L = (long)i * G + c; if (L >= (HR / 256) * 7) return false;
        const int pm = (int)(L / 7), j = (int)(L % 7); u.pm = pm; u.pn = j; u.tag = 0;
        u.a = A + (size_t)pm * 256 * PA_W * 2 + (size_t)(j < 3 ? C_DQ : C_DKV) * 2; u.b = B + (size_t)j * 256 * 256 * 2;
        if (pm == 32 || pm == 65) unit_wait(flags + 136 + (pm == 65 ? 2 : 0) + (j < 3 ? 0 : 1), 8u); else unit_wait(flags + pm * 2 + (j < 3 ? 0 : 1), 1u);
        return true; } };
DEVI void phase_mla_up(const Params& p, int l, LAS unsigned char* lds, int qi = 0) {
    UpSched S; S.flags = p.ctrl + CTRL_PAF(qi); S.G = gridDim.x; S.c = opq_bid(); S.A = (const char*)p.pa; S.B = (const char*)(p.wup + (size_t)l * UPW * 256);
    EpiBf16<0, true> E; E.O = p.up; E.ldc = UPW; E.flags = p.ctrl + CTRL_PAF(qi) + 144; E.smode = 1;
    g8::gemm_phase(lds, PA_W, 256, 256, S, E);
}

DEVI void phase_inproj_g(const Params& p, int l, LAS unsigned char* lds, int qi = 0) {
    unsigned* fl = p.ctrl + CTRL_GF(qi);
    if (l != DEPTH - 1) { CtxStore<3, 1> C; C.O = p.pa; C.ldc = PG_W; ctx_gemm<3, 8, 1>(lds, p.hx, DM, p.winG + (size_t)l * PG_W * DM, DM, C); unit_signal(lds, fl + 300); }
    TileSched S; S.nM = 64; S.nN = PG_W / 256; S.G = gridDim.x; S.c = opq_bid(); S.skipctx = 1; S.flags = nullptr;
    S.A = (const char*)p.hx; S.B = (const char*)(p.winG + (size_t)l * PG_W * DM); S.atile = (size_t)256 * DM * 2; S.btile = (size_t)256 * DM * 2; S.acol_bytes = 0;
    EpiBf16<1, true> E; E.O = p.pa; E.ldc = PG_W; E.flags = fl; E.smode = 2;
    g8::gemm_phase(lds, DM, DM, DM, S, E);
}

struct EpiMerge {
    static constexpr bool PERM = true, SIGNAL = false; static constexpr int NSEG = 3;
    const bf16_t* pg; bf16_t* Y; int xmode;
    static DEVI void unpack8(const u32x4& w, float (&f)[8]) {
#pragma unroll
        for (int e = 0; e < 8; ++e) { const unsigned x = w[e >> 1]; f[e] = (e & 1) ? __uint_as_float(x & 0xffff0000u) : __uint_as_float(x << 16); } }
    DEVI void mid(int sg, f32x4 (&acc)[2][2][4][2], const g8::Unit& u, int wr, int wc, int fr, int fq) const {
#ifdef MERGE_X
        if (xmode == 1) return;
#endif
        const int row0 = u.pm * 256 + wr * 64 + fr, col0 = u.pn * 256 + wc * 32 + 8 * fq;
        const bf16_t* gbase = pg + (size_t)row0 * PG_W + col0 + sg * 1024;
#pragma unroll
        for (int ai = 0; ai < 2; ++ai) {
            u32x4 ga[4][2], gb[4][2];
#pragma unroll
            for (int m = 0; m < 4; ++m) { const bf16_t* gp = gbase + (size_t)(ai * 128 + m * 16) * PG_W;
#pragma unroll
                for (int bj = 0; bj < 2; ++bj) { ga[m][bj] = *(const u32x4*)(gp + bj * 128); gb[m][bj] = *(const u32x4*)(gp + 1024 + bj * 128); } }
            __builtin_amdgcn_sched_barrier(0);
#pragma unroll
            for (int m = 0; m < 4; ++m)
#pragma unroll
                for (int bj = 0; bj < 2; ++bj) { float fa[8], fb[8]; unpack8(ga[m][bj], fa); unpack8(gb[m][bj], fb);
#pragma unroll
                    for (int e = 0; e < 8; ++e) acc[ai][bj][m][e >> 2][e & 3] *= fa[e] * fast_rcp(fmaxf(fb[e], 1e-30f)); }
            asm volatile("" : "+v"(acc[ai][0][0][0]), "+v"(acc[ai][0][0][1]), "+v"(acc[ai][1][0][0]), "+v"(acc[ai][1][0][1]),
                              "+v"(acc[ai][0][1][0]), "+v"(acc[ai][0][1][1]), "+v"(acc[ai][1][1][0]), "+v"(acc[ai][1][1][1]),
                              "+v"(acc[ai][0][2][0]), "+v"(acc[ai][0][2][1]), "+v"(acc[ai][1][2][0]), "+v"(acc[ai][1][2][1]),
                              "+v"(acc[ai][0][3][0]), "+v"(acc[ai][0][3][1]), "+v"(acc[ai][1][3][0]), "+v"(acc[ai][1][3][1]) :: "memory"); }
    }
    DEVI void operator()(f32x4 (&acc)[2][2][4][2], const g8::Unit& u, int wr, int wc, int fr, int fq) const {
        const int row0 = u.pm * 256 + wr * 64 + fr, col0 = u.pn * 256 + wc * 32 + 8 * fq;
#pragma unroll
        for (int ai = 0; ai < 2; ++ai) {
            u32x4 ga[4][2];
#pragma unroll
            for (int m = 0; m < 4; ++m) { const bf16_t* gp = pg + (size_t)(row0 + ai * 128 + m * 16) * PG_W + col0 + 2048;
#pragma unroll
                for (int bj = 0; bj < 2; ++bj) ga[m][bj] = *(const u32x4*)(gp + bj * 128); }
#pragma unroll
            for (int m = 0; m < 4; ++m) { const size_t row = (size_t)(row0 + ai * 128 + m * 16);
#pragma unroll
                for (int bj = 0; bj < 2; ++bj) { float fa[8]; unpack8(ga[m][bj], fa);
                    const f32x4 v0 = acc[ai][bj][m][0], v1 = acc[ai][bj][m][1];
                    u32x4 w; w.x = cvt_pk_bf16(v0[0] * fa[0], v0[1] * fa[1]); w.y = cvt_pk_bf16(v0[2] * fa[2], v0[3] * fa[3]);
                    w.z = cvt_pk_bf16(v1[0] * fa[4], v1[1] * fa[5]); w.w = cvt_pk_bf16(v1[2] * fa[6], v1[3] * fa[7]);
                    *(u32x4*)(Y + row * DM + col0 + bj * 128) = w; } }
            asm volatile("" ::: "memory"); }
    }
};
DEVI void phase_merge(const Params& p, int l, LAS unsigned char* lds, int qi = 0) {
    TileSchedT<true> S; S.nM = 64; S.nN = DM / 256; S.G = gridDim.x; S.c = opq_bid(); S.skipctx = 1; S.flags = p.ctrl + CTRL_GF(qi);
    S.A = (const char*)p.ocat; S.B = (const char*)(p.wcat + (size_t)l * DM * OCW); S.atile = (size_t)256 * OCW * 2; S.btile = (size_t)256 * OCW * 2; S.acol_bytes = 0;
    EpiMerge E; E.pg = p.pa; E.Y = p.y; E.xmode = 0;
#ifdef MERGE_X
    E.xmode = MERGE_X; g8::gemm_phase(lds, OCW, OCW, OCW, S, E); E.xmode = 0; __syncthreads();
#endif
    g8::gemm_phase(lds, OCW, OCW, OCW, S, E);
    if (l != DEPTH - 1) { if (HANDOFF) { unit_wait(p.ctrl + CTRL_GF(qi) + 300, gridDim.x); __syncthreads(); } CtxMerge C; C.pg = p.pa; C.Y = p.y; ctx_gemm<1, 12, 3>(lds, p.ocat, OCW, p.wcat + (size_t)l * DM * OCW, OCW, C); }
}

struct EpiOut {
    static constexpr bool PERM = false, HAS_MID = false, SIGNAL = false; static constexpr int NSEG = 1;
    const float* x0; const float* c0; float* xo_; float* xc_; const float* modv; int l, hb;
    DEVI void operator()(const f32x4 (&acc)[2][2][4][2], const g8::Unit& u, int wr, int wc, int fr, int fq) const {
        const int row0 = u.pm * 256 + wr * 64 + fr, col0 = u.pn * 256 + wc * 32 + 4 * fq;
        const int rt0 = hb * HR + u.pm * 256, b = rt0 / RB, pos0 = rt0 - b * RB; const bool lat = pos0 < SEQ;
        const float* g1 = modv + ((size_t)l * 5 + (lat ? b : 4)) * 6144 + 2048;
        f32x4 gv[2][2];
#pragma unroll
        for (int bj = 0; bj < 2; ++bj)
#pragma unroll
            for (int n = 0; n < 2; ++n) gv[bj][n] = *(const f32x4*)(g1 + col0 + bj * 128 + n * 16);
        const size_t base = lat ? ((size_t)b * SEQ + pos0) * DM : ((size_t)b * CTX + (pos0 - SEQ)) * DM;
        float* xo0 = (lat ? xo_ : xc_) + base; const float* xi0 = (l == 0) ? (lat ? x0 : c0) + base : (const float*)xo0;
#pragma unroll
        for (int ai = 0; ai < 2; ++ai)
#pragma unroll
            for (int mp = 0; mp < 2; ++mp) { f32x4 xv[2][2][2];
#pragma unroll
                for (int mi = 0; mi < 2; ++mi) { const size_t ro = (size_t)(wr * 64 + fr + ai * 128 + (mp * 2 + mi) * 16) * DM;
#pragma unroll
                    for (int bj = 0; bj < 2; ++bj)
#pragma unroll
                        for (int n = 0; n < 2; ++n) xv[mi][bj][n] = *(const f32x4*)(xi0 + ro + col0 + bj * 128 + n * 16); }
#pragma unroll
                for (int mi = 0; mi < 2; ++mi) { const int m = mp * 2 + mi; const size_t ro = (size_t)(wr * 64 + fr + ai * 128 + m * 16) * DM;
#pragma unroll
                    for (int bj = 0; bj < 2; ++bj)
#pragma unroll
                        for (int n = 0; n < 2; ++n) *(f32x4*)(xo0 + ro + col0 + bj * 128 + n * 16) = xv[mi][bj][n] + gv[bj][n] * acc[ai][bj][m][n]; }
                asm volatile("" ::: "memory"); }
        (void)row0;
    }
};
DEVI void phase_outproj(const Params& p, int l, int hb, LAS unsigned char* lds) {
    TileSched S; S.nM = 64; S.nN = DM / 256; S.G = gridDim.x; S.c = opq_bid(); S.skipctx = 1; S.flags = nullptr;
    S.A = (const char*)p.y; S.B = (const char*)(p.wout + (size_t)l * DM * DM); S.atile = (size_t)256 * DM * 2; S.btile = (size_t)256 * DM * 2; S.acol_bytes = 0;
    EpiOut E; E.x0 = p.in[I_X]; E.c0 = p.in[I_CTX]; E.xo_ = p.out; E.xc_ = p.xc; E.modv = p.modv; E.l = l; E.hb = hb;
    g8::gemm_phase(lds, DM, DM, DM, S, E);
    if (l != DEPTH - 1) { CtxOut C; C.c0 = p.in[I_CTX]; C.xc = p.xc; C.g1 = p.modv + ((size_t)l * 5 + 4) * 6144 + 2048; C.hb = hb; ctx_gemm<1, 8, 1>(lds, p.y, DM, p.wout + (size_t)l * DM * DM, DM, C); }
}

DEVI void phase_qkv(const Params& p, int l, LAS unsigned char* lds, int qi = 0) {
    const int tid = opq_tid(), lane = tid & 63, wv = tid >> 6, h = lane >> 3, sub = lane & 7;
    LAS bf16_t* vt = (LAS bf16_t*)lds;
    const float* gq = p.in[I_GQ] + l * 96; const float* gk = p.in[I_GK] + l * 96;
    float gqn[8], gkn[8], gqr[4], gkr[4];
#pragma unroll
    for (int e = 0; e < 8; ++e) { gqn[e] = gq[sub * 8 + e]; gkn[e] = gk[sub * 8 + e]; }
#pragma unroll
    for (int e = 0; e < 4; ++e) { gqr[e] = gq[64 + sub * 4 + e]; gkr[e] = gk[64 + sub * 4 + e]; }
    const float qscale = 0.10206207261596577f * 1.4426950408889634f;
    const bool need_ctx_q = (l < DEPTH - 1);
    const bool upper = (sub & 4) != 0;
    struct QkIn { u32x2 dqw; unsigned dkw; u32x2 krw; u32x4 qnw; u32x2 qrw; u32x4 knw, vw; f32x4 cs4, sn4; };
    auto load_rows = [&](int u, QkIn (&r)[2]) {
        const int bl = u / (NCH * 4), tile = (u >> 2) % NCH, qtr = u & 3;
#pragma unroll
        for (int it = 0; it < 2; ++it) { const int pos = tile * 64 + qtr * 16 + wv * 2 + it, rl = bl * RB + pos;
            const bf16_t* prow = p.pa + (size_t)rl * PA_W; const bf16_t* urow = p.up + (size_t)rl * UPW;
            r[it].dqw = *(const u32x2*)(prow + C_DQ + lane * 4); r[it].dkw = *(const unsigned*)(prow + C_DKV + lane * 2); r[it].krw = *(const u32x2*)(prow + C_KR + sub * 4);
            r[it].qnw = *(const u32x4*)(urow + h * 96 + sub * 8); r[it].qrw = *(const u32x2*)(urow + h * 96 + 64 + sub * 4);
            r[it].knw = *(const u32x4*)(urow + 768 + h * 128 + sub * 8); r[it].vw = *(const u32x4*)(urow + 768 + h * 128 + 64 + sub * 8);
            r[it].cs4 = (f32x4){1.f, 1.f, 1.f, 1.f}; r[it].sn4 = (f32x4){0.f, 0.f, 0.f, 0.f};
            if (pos < SEQ) { const float* rt = p.rope + (size_t)pos * 32 + (sub & 3) * 4; r[it].cs4 = *(const f32x4*)rt; r[it].sn4 = *(const f32x4*)(rt + 16); } } };
    QkIn cur[2], nxt[2];
    const int nunit = 2 * NCH * 4, G = gridDim.x;
    unsigned* upf = p.ctrl + CTRL_PAF(qi) + 144;
    auto unit_rt = [&](int u) { const int bl = u / (NCH * 4), tile = (u >> 2) % NCH, qtr = u & 3; return (bl * RB + tile * 64 + qtr * 16) >> 8; };
    if ((int)opq_bid() < nunit) { if (HANDOFF) { unit_wait(upf + unit_rt(opq_bid()), 7u); __syncthreads(); } load_rows(opq_bid(), cur); }
    unsigned* dqc = p.ctrl + CTRL_DQ(qi);
    int un = opq_bid() + G;
    for (int u = opq_bid(), it = 0; u < nunit; ++it) {
        const int bl = u / (NCH * 4), tile = (u >> 2) % NCH, qtr = u & 3;
        unsigned pend = 0; if (tid == 0) pend = xb_add(dqc, 1u);
        const bool more = un < nunit; if (more) { if (HANDOFF) { unit_wait(upf + unit_rt(un), 7u); __syncthreads(); } load_rows(un, nxt); }
#pragma unroll
        for (int it = 0; it < 2; ++it) {
            const int r16 = wv * 2 + it, rr = qtr * 16 + r16, pos = tile * 64 + rr;
            const bool lat = pos < SEQ;
            const u32x2 dqw = cur[it].dqw; const unsigned dkw = cur[it].dkw; const u32x2 krw = cur[it].krw; const u32x4 qnw = cur[it].qnw; const u32x2 qrw = cur[it].qrw;
            const u32x4 knw = cur[it].knw, vw = cur[it].vw; const f32x4 cs4 = cur[it].cs4, sn4 = cur[it].sn4;
            float sq, skv;
            { const float a0 = __uint_as_float(dqw.x << 16), a1 = __uint_as_float(dqw.x & 0xffff0000u), a2 = __uint_as_float(dqw.y << 16), a3 = __uint_as_float(dqw.y & 0xffff0000u);
              sq = a0 * a0 + a1 * a1 + a2 * a2 + a3 * a3;
              const float b0 = __uint_as_float(dkw << 16), b1 = __uint_as_float(dkw & 0xffff0000u); skv = b0 * b0 + b1 * b1; }
            sq = wave_sum(sq); skv = wave_sum(skv);
            const float rq = rsqrtf(sq * (1.0f / 256.0f) + EPSF), rkv = rsqrtf(skv * (1.0f / 128.0f) + EPSF);
            float qn[8], qr[4], kn[8], kr[4];
#pragma unroll
            for (int e = 0; e < 8; ++e) { const unsigned a = qnw[e >> 1], b = knw[e >> 1];
                qn[e] = ((e & 1) ? __uint_as_float(a & 0xffff0000u) : __uint_as_float(a << 16)) * rq;
                kn[e] = ((e & 1) ? __uint_as_float(b & 0xffff0000u) : __uint_as_float(b << 16)) * rkv; }
#pragma unroll
            for (int e = 0; e < 4; ++e) { const unsigned a = (e < 2) ? qrw.x : qrw.y, b = (e < 2) ? krw.x : krw.y;
                qr[e] = ((e & 1) ? __uint_as_float(a & 0xffff0000u) : __uint_as_float(a << 16)) * rq;
                kr[e] = ((e & 1) ? __uint_as_float(b & 0xffff0000u) : __uint_as_float(b << 16)); }
            float sqq = 0.f, skk = 0.f;
#pragma unroll
            for (int e = 0; e < 8; ++e) { sqq += qn[e] * qn[e]; skk += kn[e] * kn[e]; }
#pragma unroll
            for (int e = 0; e < 4; ++e) { sqq += qr[e] * qr[e]; skk += kr[e] * kr[e]; }
            sqq += __shfl_xor(sqq, 1); sqq += __shfl_xor(sqq, 2); sqq += __shfl_xor(sqq, 4);
            skk += __shfl_xor(skk, 1); skk += __shfl_xor(skk, 2); skk += __shfl_xor(skk, 4);
            const float rnq = rsqrtf(sqq * (1.0f / 96.0f) + EPSF) * qscale, rnk = rsqrtf(skk * (1.0f / 96.0f) + EPSF);
            float qo[12], ko[12];
#pragma unroll
            for (int e = 0; e < 8; ++e) { qo[e] = qn[e] * rnq * gqn[e]; ko[e] = kn[e] * rnk * gkn[e]; }
#pragma unroll
            for (int e = 0; e < 4; ++e) { const float a = qr[e] * rnq * gqr[e], b = kr[e] * rnk * gkr[e];
                const float pa_ = __shfl_xor(a, 4), pb_ = __shfl_xor(b, 4);
                qo[8 + e] = upper ? (a * cs4[e] + pa_ * sn4[e]) : (a * cs4[e] - pa_ * sn4[e]);
                ko[8 + e] = upper ? (b * cs4[e] + pb_ * sn4[e]) : (b * cs4[e] - pb_ * sn4[e]); }
            if (lat || need_ctx_q) {
                bf16_t* qd = lat ? p.q + (((size_t)(bl * 8 + h) * SEQ + pos) * 96) : p.qc + (((size_t)(bl * 8 + h) * CTX + (pos - SEQ)) * 96);
                u32x4 w; w.x = cvt_pk_bf16(qo[0], qo[1]); w.y = cvt_pk_bf16(qo[2], qo[3]); w.z = cvt_pk_bf16(qo[4], qo[5]); w.w = cvt_pk_bf16(qo[6], qo[7]);
                *(u32x4*)(qd + sub * 8) = w;
                u32x2 w2; w2.x = cvt_pk_bf16(qo[8], qo[9]); w2.y = cvt_pk_bf16(qo[10], qo[11]);
                *(u32x2*)(qd + 64 + sub * 4) = w2; }
            { bf16_t* kd = (bf16_t*)(p.kv + ((size_t)(bl * 8 + h) * NCH + tile) * KVT_BYTES + rr * 208);
              u32x4 w; w.x = cvt_pk_bf16(ko[0], ko[1]); w.y = cvt_pk_bf16(ko[2], ko[3]); w.z = cvt_pk_bf16(ko[4], ko[5]); w.w = cvt_pk_bf16(ko[6], ko[7]);
              *(u32x4*)(kd + sub * 8) = w;
              u32x2 w2; w2.x = cvt_pk_bf16(ko[8], ko[9]); w2.y = cvt_pk_bf16(ko[10], ko[11]);
              *(u32x2*)(kd + 64 + sub * 4) = w2; }
#pragma unroll
            for (int e = 0; e < 8; ++e) { const unsigned a = vw[e >> 1]; const float v = ((e & 1) ? __uint_as_float(a & 0xffff0000u) : __uint_as_float(a << 16)) * rkv;
                vt[(h * 64 + sub * 8 + e) * 20 + r16] = f2bf(v); }
        }
        if (tid == 0) *DQ_SLOT(lds, it & 1) = (int)pend + 2 * G;
        LDS_SYNC();
        const int unn = __builtin_amdgcn_readfirstlane(*DQ_SLOT(lds, it & 1));
        for (int i = tid; i < 8 * 64 * 4; i += 512) { const int hh = i >> 8, rem = i & 255, vc = rem >> 2, pc = rem & 3;
            const u32x2 w = *(const LAS u32x2*)(vt + (hh * 64 + vc) * 20 + pc * 4);
            *(u32x2*)(p.kv + ((size_t)(bl * 8 + hh) * NCH + tile) * KVT_BYTES + KT_BYTES + vc * 136 + qtr * 32 + pc * 8) = w; }
        LDS_SYNC();
        if (more) { cur[0] = nxt[0]; cur[1] = nxt[1]; }
        u = un; un = unn;
    }
}

#ifndef ATT_STAGGER
#define ATT_STAGGER 1
#endif
#ifndef ATT_SGB
#define ATT_SGB 0
#endif
#ifndef ATT_KPF
#define ATT_KPF 0
#endif
#ifndef ATT_PRIO
#define ATT_PRIO 1
#endif
#ifndef ATT_STAGPT
#define ATT_STAGPT 2
#endif
DEVI void attn_unit(const Params& p, LAS unsigned char* lds, const bf16_t* Qb, int nq, const unsigned char* kvb, int ntile, bf16_t* orow, float accinit) {
    const int tid = opq_tid(), lane = tid & 63, wv = __builtin_amdgcn_readfirstlane(tid >> 6), l31 = lane & 31, hh = lane >> 5;
    const bool active = wv * 64 < nq;
    bf16x8 qf[2][6];
#pragma unroll
    for (int qt = 0; qt < 2; ++qt)
#pragma unroll
        for (int ks = 0; ks < 6; ++ks) {
            if (active) qf[qt][ks] = *(const bf16x8*)(Qb + (size_t)(wv * 64 + qt * 32 + l31) * 96 + ks * 16 + hh * 8);
            else qf[qt][ks] = (bf16x8){0, 0, 0, 0, 0, 0, 0, 0}; }
    f32x16 O[2][2];
#pragma unroll
    for (int a = 0; a < 2; ++a)
#pragma unroll
        for (int b = 0; b < 2; ++b)
#pragma unroll
            for (int i = 0; i < 16; ++i) O[a][b][i] = 0.f;
    float lsum[2] = {0.f, 0.f};
    constexpr int STG = 2 * KVT_BYTES;
    const int nstage = ntile >> 1;
    auto stage_in = [&](int sidx, int bsel) {
        const unsigned char* g = kvb + (size_t)sidx * STG + lane * 16;
        for (int pc = wv; pc < 43; pc += 8)
            __builtin_amdgcn_global_load_lds((const unsigned*)(g + pc * 1024), (LAS unsigned*)(lds + bsel * STG + pc * 1024), 16, 0, 0);
    };
    stage_in(0, 0);
    __syncthreads();
    if (ATT_PRIO && wv >= 4) __builtin_amdgcn_s_setprio(1);
    const bool late = ATT_STAGGER && (wv >= 4) && active;
    for (int sg = 0; sg < nstage; ++sg) {
        if (!late || sg == 0) { if (sg + 1 < nstage) stage_in(sg + 1, (sg + 1) & 1); }
        if (active) {
#if ATT_KPF
            bf16x8 kfb[2][6];
#pragma unroll 2
#else
#pragma unroll 1
#endif
            for (int kt = 0; kt < 4; ++kt) {
                const LAS unsigned char* kb = lds + (sg & 1) * STG + (kt >> 1) * KVT_BYTES; const LAS unsigned char* vb = kb + KT_BYTES; const int ks2 = kt & 1;
#if ATT_KPF
                bf16x8 (&kf)[6] = kfb[kt & 1];
                if (kt == 0) {
#pragma unroll
                    for (int ks = 0; ks < 6; ++ks) kfb[0][ks] = *(const LAS bf16x8*)(kb + (ks2 * 32 + l31) * 208 + ks * 32 + hh * 16); }
                if (kt < 3) { const LAS unsigned char* kbn = lds + (sg & 1) * STG + ((kt + 1) >> 1) * KVT_BYTES; const int ks2n = (kt + 1) & 1;
#pragma unroll
                    for (int ks = 0; ks < 6; ++ks) kfb[(kt + 1) & 1][ks] = *(const LAS bf16x8*)(kbn + (ks2n * 32 + l31) * 208 + ks * 32 + hh * 16); }
#else
                bf16x8 kf[6];
#pragma unroll
                for (int ks = 0; ks < 6; ++ks) kf[ks] = *(const LAS bf16x8*)(kb + (ks2 * 32 + l31) * 208 + ks * 32 + hh * 16);
#endif
                bf16x8 vf[2][2];
#pragma unroll
                for (int vtile = 0; vtile < 2; ++vtile)
#pragma unroll
                    for (int s2 = 0; s2 < 2; ++s2) { const LAS unsigned char* a = vb + (vtile * 32 + l31) * 136 + (ks2 * 32 + s2 * 16 + 4 * hh) * 2;
                        const u32x2 lo = *(const LAS u32x2*)a, hi = *(const LAS u32x2*)(a + 16);
                        u32x4 w; w.x = lo.x; w.y = lo.y; w.z = hi.x; w.w = hi.y; vf[vtile][s2] = __builtin_bit_cast(bf16x8, w); }
                if (ATT_STAGPT == 1 && late && kt == 3) { __syncthreads(); if (sg + 2 < nstage) stage_in(sg + 2, sg & 1); }
                f32x16 S0, S1;
#pragma unroll
                for (int i = 0; i < 16; ++i) { S0[i] = accinit; S1[i] = accinit; }
#pragma unroll
                for (int ks = 0; ks < 6; ++ks) S0 = __builtin_amdgcn_mfma_f32_32x32x16_bf16(kf[ks], qf[0][ks], S0, 0, 0, 0);

#pragma unroll
                for (int ks = 0; ks < 6; ++ks) S1 = __builtin_amdgcn_mfma_f32_32x32x16_bf16(kf[ks], qf[1][ks], S1, 0, 0, 0);
                if (ATT_STAGPT == 0 && late && kt == 3) { __syncthreads(); if (sg + 2 < nstage) stage_in(sg + 2, sg & 1); }
                bf16x8 pb0[2], pb1[2];
                { float ls = 0.f;
#pragma unroll
                  for (int i = 0; i < 16; ++i) { S0[i] = fast_exp2(S0[i]); ls += S0[i]; }
                  lsum[0] += ls;
#pragma unroll
                  for (int s2 = 0; s2 < 2; ++s2) { u32x4 w; w.x = cvt_pk_bf16(S0[8 * s2 + 0], S0[8 * s2 + 1]); w.y = cvt_pk_bf16(S0[8 * s2 + 2], S0[8 * s2 + 3]);
                      w.z = cvt_pk_bf16(S0[8 * s2 + 4], S0[8 * s2 + 5]); w.w = cvt_pk_bf16(S0[8 * s2 + 6], S0[8 * s2 + 7]); pb0[s2] = __builtin_bit_cast(bf16x8, w); } }

#if ATT_SGB == 1
                __builtin_amdgcn_sched_group_barrier(0x100, 10, 0); __builtin_amdgcn_sched_group_barrier(0x008, 6, 0);
#pragma unroll
                for (int z = 0; z < 6; ++z) { __builtin_amdgcn_sched_group_barrier(0x008, 1, 0); __builtin_amdgcn_sched_group_barrier(0x400, 3, 0); }
#elif ATT_SGB == 2
                __builtin_amdgcn_sched_group_barrier(0x100, 10, 0); __builtin_amdgcn_sched_group_barrier(0x008, 6, 0);
#pragma unroll
                for (int z = 0; z < 6; ++z) { __builtin_amdgcn_sched_group_barrier(0x008, 1, 0); __builtin_amdgcn_sched_group_barrier(0x002, 4, 0); }
#endif
                if (ATT_STAGPT == 2 && late && kt == 3) { __syncthreads(); if (sg + 2 < nstage) stage_in(sg + 2, sg & 1); }
#pragma unroll
                for (int s2 = 0; s2 < 2; ++s2)
#pragma unroll
                    for (int vtile = 0; vtile < 2; ++vtile) O[0][vtile] = __builtin_amdgcn_mfma_f32_32x32x16_bf16(vf[vtile][s2], pb0[s2], O[0][vtile], 0, 0, 0);
                if (ATT_STAGPT == 4 && late && kt == 3) { __syncthreads(); if (sg + 2 < nstage) stage_in(sg + 2, sg & 1); }
                { float ls = 0.f;
#pragma unroll
                  for (int i = 0; i < 16; ++i) { S1[i] = fast_exp2(S1[i]); ls += S1[i]; }
                  lsum[1] += ls;
#pragma unroll
                  for (int s2 = 0; s2 < 2; ++s2) { u32x4 w; w.x = cvt_pk_bf16(S1[8 * s2 + 0], S1[8 * s2 + 1]); w.y = cvt_pk_bf16(S1[8 * s2 + 2], S1[8 * s2 + 3]);
                      w.z = cvt_pk_bf16(S1[8 * s2 + 4], S1[8 * s2 + 5]); w.w = cvt_pk_bf16(S1[8 * s2 + 6], S1[8 * s2 + 7]); pb1[s2] = __builtin_bit_cast(bf16x8, w); } }

                if (ATT_STAGPT == 3 && late && kt == 3) { __syncthreads(); if (sg + 2 < nstage) stage_in(sg + 2, sg & 1); }
#pragma unroll
                for (int s2 = 0; s2 < 2; ++s2)
#pragma unroll
                    for (int vtile = 0; vtile < 2; ++vtile) O[1][vtile] = __builtin_amdgcn_mfma_f32_32x32x16_bf16(vf[vtile][s2], pb1[s2], O[1][vtile], 0, 0, 0);
            }
        }
        if (!late) __syncthreads();
    }
    __builtin_amdgcn_s_setprio(0);
    if (active) {
#pragma unroll
        for (int qt = 0; qt < 2; ++qt) {
            const float tot = lsum[qt] + __shfl_xor(lsum[qt], 32); const float inv = 1.0f / tot;
            bf16_t* orw = orow + (size_t)(wv * 64 + qt * 32 + l31) * OCW;
#pragma unroll
            for (int vtile = 0; vtile < 2; ++vtile)
#pragma unroll
                for (int g4 = 0; g4 < 4; ++g4) { u32x2 w; w.x = cvt_pk_bf16(O[qt][vtile][4 * g4 + 0] * inv, O[qt][vtile][4 * g4 + 1] * inv);
                    w.y = cvt_pk_bf16(O[qt][vtile][4 * g4 + 2] * inv, O[qt][vtile][4 * g4 + 3] * inv);
                    *(u32x2*)(orw + vtile * 32 + 8 * g4 + 4 * hh) = w; }
        }
    }
}

DEVI float attn_offset(const Params& p, int l) {
    const int lane = opq_tid() & 63;
    const float* gq = p.in[I_GQ] + l * 96; const float* gk = p.in[I_GK] + l * 96;
    float a = fmaxf(fabsf(gq[lane]), lane < 32 ? fabsf(gq[64 + lane]) : 0.f), b = fmaxf(fabsf(gk[lane]), lane < 32 ? fabsf(gk[64 + lane]) : 0.f);
    a = wave_max(a); b = wave_max(b);
    return -(9.797958971132712f * 1.4426950408889634f * a * b * 1.001f);
}

constexpr int HGP = 72;
constexpr int ZP = 68;
constexpr int HG_ZT0 = 0, HG_ZT1 = 17408, HG_KEY0 = 34816, HG_KEY1 = 52224, HG_VT = 69632, HG_KRM0 = 78848, HG_KRM1 = 88064, HG_QRM0 = 97280, HG_QRM1 = 106496,
              HG_S2T0 = 115712, HG_S2T1 = 124928, HG_A20 = 134144, HG_A21 = 143360, HG_GT = 152576  , HG_REF = 156672  , HG_BT = 157184  ,
              HG_O = HG_ZT0  ;
DEVI bf16x8 hg_frag_tr(const LAS unsigned char* tile, int k0, int c0, int lane) {
    const unsigned g = lane >> 4, q = (lane & 15) >> 2, pp = lane & 3;
    const unsigned a0 = (unsigned)(size_t)tile + (unsigned)((k0 + 8 * g + q) * (HGP * 2) + (c0 + 4 * pp) * 2), a1 = a0 + 4 * HGP * 2;
    u32x2 r0, r1;
    asm volatile("ds_read_b64_tr_b16 %0, %2\n\tds_read_b64_tr_b16 %1, %3\n\ts_waitcnt lgkmcnt(0)" : "=&v"(r0), "=&v"(r1) : "v"(a0), "v"(a1) : "memory");
    u32x4 w; w.x = r0.x; w.y = r0.y; w.z = r1.x; w.w = r1.y; return __builtin_bit_cast(bf16x8, w);
}

DEVI int hg_pos0(int tc) { return tc < 128 ? tc * 64 : SEQ + (tc - 128) * 64; }
DEVI int hg_chain_pos(int tc, int dir) { return dir ? (NCH - 1 - tc) : (tc < 128 ? tc + 4 : tc - 128); }

struct HgIn { u32x4 q, zf, zb, v, g, sf, sb; f32x4 lb[4], gn[2]; };
template <bool PASS3> DEVI void hg_load(const Params& p, int l, int u, HgIn& r) {
    const int tid = opq_tid(), tk = tid >> 3, pc = tid & 7; const int tc = u % NCH, h = (u / NCH) & 7, bl = u / (NCH * 8);
    { const float* lbp = p.lbv + (size_t)l * 2 * 512 + h * 64 + pc * 8;
      r.lb[0] = *(const f32x4*)lbp; r.lb[1] = *(const f32x4*)(lbp + 4); r.lb[2] = *(const f32x4*)(lbp + 512); r.lb[3] = *(const f32x4*)(lbp + 516);
      if (PASS3) { const float* gnp = p.in[I_HGNORM] + l * 64 + pc * 8; r.gn[0] = *(const f32x4*)gnp; r.gn[1] = *(const f32x4*)(gnp + 4); } }
    const bf16_t* prow = p.pa + (size_t)(bl * RB + hg_pos0(tc) + tk) * PA_W + h * 64 + pc * 8;
    r.zf = *(const u32x4*)(prow + C_ZF); r.zb = *(const u32x4*)(prow + C_ZB); r.v = *(const u32x4*)(prow + C_I);
    if (PASS3) { r.q = *(const u32x4*)(prow + C_Q); r.g = *(const u32x4*)(prow + C_G);
        const size_t uf = ((size_t)((bl * 2 + 0) * 8 + h)) * NCH + hg_chain_pos(tc, 0), ub = ((size_t)((bl * 2 + 1) * 8 + h)) * NCH + hg_chain_pos(tc, 1);
        r.sf = *(const u32x4*)(p.st + uf * 4096 + tk * 64 + pc * 8); r.sb = *(const u32x4*)(p.st + ub * 4096 + tk * 64 + pc * 8); }
}
DEVI float bfw(const u32x4& w, int e) { const unsigned x = w[e >> 1]; return (e & 1) ? __uint_as_float(x & 0xffff0000u) : __uint_as_float(x << 16); }

template <bool PASS3> DEVI void hg_prepare(const Params& p, int l, LAS unsigned char* lds, int h, const HgIn& r) {
    const int tid = opq_tid(), tk = tid >> 3, pc = tid & 7; const bool lb0 = (l == 0);
    LAS float* gt = (LAS float*)(lds + HG_GT); LAS float* refv = (LAS float*)(lds + HG_REF); LAS float* btv = (LAS float*)(lds + HG_BT);
    {
#pragma unroll
        for (int dir = 0; dir < 2; ++dir) {
            LAS float* zt = (LAS float*)(lds + (dir ? HG_ZT1 : HG_ZT0)); LAS float* keyt = (LAS float*)(lds + (dir ? HG_KEY1 : HG_KEY0));
            const f32x4 lb4a = r.lb[dir * 2], lb4b = r.lb[dir * 2 + 1];
            float lf[8], ky[8], sg8[8], ls8[8];
#pragma unroll
            for (int e = 0; e < 8; ++e) { const float z = bfw(dir ? r.zb : r.zf, e);
                const float ez = fast_exp2(-1.44269504f * fabsf(z)), opl = 1.0f + ez, rc = fast_rcp(opl);
                ls8[e] = -(fmaxf(-z, 0.f) + 0.69314718f * __builtin_amdgcn_logf(opl));
                sg8[e] = (z >= 0.f) ? rc : ez * rc; }
            if (lb0) {
#pragma unroll
                for (int e = 0; e < 8; ++e) { const float lb = e < 4 ? lb4a[e & 3] : lb4b[e & 3]; lf[e] = ls8[e]; ky[e] = (1.0f - lb) * (1.0f - sg8[e]); }
            } else {
#pragma unroll
                for (int e = 0; e < 8; ++e) { const float lb = e < 4 ? lb4a[e & 3] : lb4b[e & 3]; lf[e] = 0.69314718f * __builtin_amdgcn_logf(lb + (1.0f - lb) * sg8[e]); ky[e] = (1.0f - lb) * (1.0f - sg8[e]); }
            }
            *(LAS f32x4*)(zt + tk * ZP + pc * 8) = (f32x4){lf[0], lf[1], lf[2], lf[3]}; *(LAS f32x4*)(zt + tk * ZP + pc * 8 + 4) = (f32x4){lf[4], lf[5], lf[6], lf[7]};
            *(LAS f32x4*)(keyt + tk * ZP + pc * 8) = (f32x4){ky[0], ky[1], ky[2], ky[3]}; *(LAS f32x4*)(keyt + tk * ZP + pc * 8 + 4) = (f32x4){ky[4], ky[5], ky[6], ky[7]}; }
        *(LAS u32x4*)(lds + HG_VT + (tk * HGP + pc * 8) * 2) = r.v;
    }
    LDS_SYNC();
    {
        const int d = tid & 63, jg = tid >> 6; float c0[8], c1[8]; float run = 0.f;
        LAS float* zt0 = (LAS float*)(lds + HG_ZT0); LAS float* zt1 = (LAS float*)(lds + HG_ZT1);
#pragma unroll
        for (int i = 0; i < 8; ++i) { run += zt0[(jg * 8 + i) * ZP + d]; c0[i] = run; }
        gt[jg * 64 + d] = run; run = 0.f;
#pragma unroll
        for (int i = 7; i >= 0; --i) { run += zt1[(jg * 8 + i) * ZP + d]; c1[i] = run; }
        gt[512 + jg * 64 + d] = run;
        LDS_SYNC();
        float off0 = 0.f, off1 = 0.f;
#pragma unroll
        for (int g2 = 0; g2 < 8; ++g2) { off0 += (g2 < jg) ? gt[g2 * 64 + d] : 0.f; off1 += (g2 > jg) ? gt[512 + g2 * 64 + d] : 0.f; }
#pragma unroll
        for (int i = 0; i < 8; ++i) { zt0[(jg * 8 + i) * ZP + d] = c0[i] + off0; zt1[(jg * 8 + i) * ZP + d] = c1[i] + off1; }
        if (jg == 3) refv[d] = c0[7] + off0;
        if (jg == 7) btv[d] = c0[7] + off0;
        if (jg == 4) refv[64 + d] = c1[0] + off1;
        if (jg == 0) btv[64 + d] = c1[0] + off1;
    }
    LDS_SYNC();
    {
#pragma unroll
        for (int dir = 0; dir < 2; ++dir) {
            const LAS float* zt = (const LAS float*)(lds + (dir ? HG_ZT1 : HG_ZT0)); const LAS float* keyt = (const LAS float*)(lds + (dir ? HG_KEY1 : HG_KEY0));
            float kt[8], qt[8];
            const f32x4 z0 = *(const LAS f32x4*)(zt + tk * ZP + pc * 8), z1 = *(const LAS f32x4*)(zt + tk * ZP + pc * 8 + 4);
            const f32x4 k0 = *(const LAS f32x4*)(keyt + tk * ZP + pc * 8), k1 = *(const LAS f32x4*)(keyt + tk * ZP + pc * 8 + 4);
            const f32x4 r0 = *(const LAS f32x4*)(refv + dir * 64 + pc * 8), r1 = *(const LAS f32x4*)(refv + dir * 64 + pc * 8 + 4);
#pragma unroll
            for (int e = 0; e < 8; ++e) { const float bc = e < 4 ? z0[e & 3] : z1[e & 3], rf = e < 4 ? r0[e & 3] : r1[e & 3], ke = e < 4 ? k0[e & 3] : k1[e & 3];
                kt[e] = ke * fast_exp2(1.44269504f * fminf(rf - bc, 80.f)); if (PASS3) qt[e] = bfw(r.q, e) * fast_exp2(1.44269504f * fminf(bc - rf, 80.f)); }
            { u32x4 w; w.x = cvt_pk_bf16(kt[0], kt[1]); w.y = cvt_pk_bf16(kt[2], kt[3]); w.z = cvt_pk_bf16(kt[4], kt[5]); w.w = cvt_pk_bf16(kt[6], kt[7]);
              *(LAS u32x4*)(lds + (dir ? HG_KRM1 : HG_KRM0) + (tk * HGP + pc * 8) * 2) = w; }
            if (PASS3) {
                u32x4 w; w.x = cvt_pk_bf16(qt[0], qt[1]); w.y = cvt_pk_bf16(qt[2], qt[3]); w.z = cvt_pk_bf16(qt[4], qt[5]); w.w = cvt_pk_bf16(qt[6], qt[7]);
                *(LAS u32x4*)(lds + (dir ? HG_QRM1 : HG_QRM0) + (tk * HGP + pc * 8) * 2) = w;
                const float er = fast_exp2(1.44269504f * refv[dir * 64 + tk]); float sv[8];
#pragma unroll
                for (int e = 0; e < 8; ++e) sv[e] = bfw(dir ? r.sb : r.sf, e) * er;
                w.x = cvt_pk_bf16(sv[0], sv[1]); w.y = cvt_pk_bf16(sv[2], sv[3]); w.z = cvt_pk_bf16(sv[4], sv[5]); w.w = cvt_pk_bf16(sv[6], sv[7]);
                *(LAS u32x4*)(lds + (dir ? HG_S2T1 : HG_S2T0) + (tk * HGP + pc * 8) * 2) = w;
            }
        }
    }
    LDS_SYNC();
}
DEVI bf16x8 hg_frag(const LAS unsigned char* base, int r, int c0) { return *(const LAS bf16x8*)(base + (size_t)(r * HGP + c0) * 2); }

DEVI void hg_pass1_unit(const Params& p, int l, LAS unsigned char* lds, int u, const HgIn& r) {
    const int tc = u % NCH, h = (u / NCH) & 7, bl = u / (NCH * 8);
    hg_prepare<false>(p, l, lds, h, r);
    const int tid = opq_tid(), lane = tid & 63, wv = tid >> 6, l15 = lane & 15, g = lane >> 4;
    const LAS float* refv = (const LAS float*)(lds + HG_REF); const LAS float* btv = (const LAS float*)(lds + HG_BT);
    const int dt = wv >> 1, ct0 = (wv & 1) * 2;
#pragma unroll
    for (int dir = 0; dir < 2; ++dir) {
        const size_t unit = ((size_t)((bl * 2 + dir) * 8 + h)) * NCH + hg_chain_pos(tc, dir);
        bf16_t* so = p.st + unit * 4096;
        const LAS unsigned char* krm = lds + (dir ? HG_KRM1 : HG_KRM0);
        bf16x8 af[2];
#pragma unroll
        for (int ks = 0; ks < 2; ++ks) af[ks] = hg_frag_tr(krm, 32 * ks, 16 * dt, lane);
#pragma unroll
        for (int ci = 0; ci < 2; ++ci) { const int ct = ct0 + ci; f32x4 acc = {0.f, 0.f, 0.f, 0.f};
#pragma unroll
            for (int ks = 0; ks < 2; ++ks) acc = __builtin_amdgcn_mfma_f32_16x16x32_bf16(af[ks], hg_frag_tr(lds + HG_VT, 32 * ks, 16 * ct, lane), acc, 0, 0, 0);
#pragma unroll
            for (int rr = 0; rr < 4; ++rr) { const int d = 16 * dt + 4 * g + rr; so[d * 64 + 16 * ct + l15] = f2bf(acc[rr] * fast_exp2(1.44269504f * (btv[dir * 64 + d] - refv[dir * 64 + d]))); } }
        if (tid < 64) p.stb[unit * 64 + tid] = btv[dir * 64 + tid];
    }
    LDS_SYNC();
}

DEVI void hg_pass3_unit(const Params& p, int l, LAS unsigned char* lds, int u, const HgIn& r) {
    const int tc = u % NCH, h = (u / NCH) & 7, bl = u / (NCH * 8);
    const int tid = opq_tid(), lane = tid & 63, wv = tid >> 6, l15 = lane & 15, g = lane >> 4;
    hg_prepare<true>(p, l, lds, h, r);
    { const int tt = wv >> 1, st0 = (wv & 1) * 2;
#pragma unroll
      for (int dir = 0; dir < 2; ++dir) {
          const LAS unsigned char* qrm = lds + (dir ? HG_QRM1 : HG_QRM0); const LAS unsigned char* krm = lds + (dir ? HG_KRM1 : HG_KRM0); LAS bf16_t* a2 = (LAS bf16_t*)(lds + (dir ? HG_A21 : HG_A20));
          bf16x8 bq[2];
#pragma unroll
          for (int ks = 0; ks < 2; ++ks) bq[ks] = hg_frag(qrm, 16 * tt + l15, 32 * ks + 8 * g);
#pragma unroll
          for (int si = 0; si < 2; ++si) { const int st = st0 + si; f32x4 acc = {0.f, 0.f, 0.f, 0.f};
#pragma unroll
              for (int ks = 0; ks < 2; ++ks) acc = __builtin_amdgcn_mfma_f32_16x16x32_bf16(hg_frag(krm, 16 * st + l15, 32 * ks + 8 * g), bq[ks], acc, 0, 0, 0);
              const int t = 16 * tt + l15, s0 = 16 * st + 4 * g; float v[4];
#pragma unroll
              for (int e = 0; e < 4; ++e) v[e] = (dir == 0 ? (s0 + e <= t) : (s0 + e >= t)) ? acc[e] : 0.f;
              u32x2 w; w.x = cvt_pk_bf16(v[0], v[1]); w.y = cvt_pk_bf16(v[2], v[3]);
              *(LAS u32x2*)(a2 + t * HGP + s0) = w; } } }
    LDS_SYNC();
    { const int tt = wv >> 1, ct0 = (wv & 1) * 2; LAS float* olds = (LAS float*)(lds + HG_O);
      f32x4 acc[2] = {{0.f, 0.f, 0.f, 0.f}, {0.f, 0.f, 0.f, 0.f}};
#pragma unroll
      for (int dir = 0; dir < 2; ++dir) {
          const LAS unsigned char* qrm = lds + (dir ? HG_QRM1 : HG_QRM0); const LAS unsigned char* a2 = lds + (dir ? HG_A21 : HG_A20); const LAS unsigned char* s2t = lds + (dir ? HG_S2T1 : HG_S2T0);
          bf16x8 aa[2], aq[2];
#pragma unroll
          for (int ks = 0; ks < 2; ++ks) { aa[ks] = hg_frag(a2, 16 * tt + l15, 32 * ks + 8 * g); aq[ks] = hg_frag(qrm, 16 * tt + l15, 32 * ks + 8 * g); }
#pragma unroll
          for (int ci = 0; ci < 2; ++ci) { const int ct = ct0 + ci;
#pragma unroll
              for (int ks = 0; ks < 2; ++ks) acc[ci] = __builtin_amdgcn_mfma_f32_16x16x32_bf16(aa[ks], hg_frag_tr(lds + HG_VT, 32 * ks, 16 * ct, lane), acc[ci], 0, 0, 0);
#pragma unroll
              for (int ks = 0; ks < 2; ++ks) acc[ci] = __builtin_amdgcn_mfma_f32_16x16x32_bf16(aq[ks], hg_frag_tr(s2t, 32 * ks, 16 * ct, lane), acc[ci], 0, 0, 0); } }
#pragma unroll
      for (int ci = 0; ci < 2; ++ci)
#pragma unroll
          for (int rr = 0; rr < 4; ++rr) olds[(16 * tt + 4 * g + rr) * 65 + 16 * (ct0 + ci) + l15] = acc[ci][rr]; }
    LDS_SYNC();
    { const int tok = tid >> 3, pc = tid & 7; const int row = bl * RB + hg_pos0(tc) + tok; const LAS float* olds = (const LAS float*)(lds + HG_O);
      float o[8]; float ss = 0.f;
#pragma unroll
      for (int e = 0; e < 8; ++e) { o[e] = olds[tok * 65 + pc * 8 + e]; ss += o[e] * o[e]; }
      ss += __shfl_xor(ss, 1); ss += __shfl_xor(ss, 2); ss += __shfl_xor(ss, 4);
      const float rstd = rsqrtf(ss * (1.0f / 64.0f) + EPSF);
      float rr[8];
#pragma unroll
      for (int e = 0; e < 8; ++e) rr[e] = o[e] * rstd * (e < 4 ? r.gn[0][e & 3] : r.gn[1][e & 3]) * sigmoidf_(bfw(r.g, e));
      u32x4 w; w.x = cvt_pk_bf16(rr[0], rr[1]); w.y = cvt_pk_bf16(rr[2], rr[3]); w.z = cvt_pk_bf16(rr[4], rr[5]); w.w = cvt_pk_bf16(rr[6], rr[7]);
      *(u32x4*)(p.ocat + (size_t)row * OCW + h * 64 + pc * 8) = w; }
    LDS_SYNC();
}

DEVI void hg_prefix(const Params& p, bool dry = false) {
    const int total = 2 * 2 * 8 * 4096;
    for (int gidx = opq_bid() * 512 + opq_tid(); gidx < total; gidx += gridDim.x * 512) {
        const int chain = gidx >> 12, e = gidx & 4095, d = e >> 6;
        bf16_t* s = p.st + (size_t)chain * NCH * 4096 + e; const float* bt = p.stb + (size_t)chain * NCH * 64 + d;
        float S = 0.f;
#pragma unroll 1
        for (int q0 = 0; q0 < NCH; q0 += 12) { float loc[12], b[12];
#pragma unroll
            for (int i = 0; i < 12; ++i) { loc[i] = bf2f(s[(size_t)(q0 + i) * 4096]); b[i] = bt[(q0 + i) * 64]; }
#pragma unroll
            for (int i = 0; i < 12; ++i) { if (!dry) s[(size_t)(q0 + i) * 4096] = f2bf(S); S = S * fast_exp2(1.44269504f * b[i]) + loc[i]; } }
        if (dry && S == 123.456f) s[0] = 0;
    }
}

constexpr int LR_UB = 0, LR_UP = 520, LR_AF = 16640, LR_IF = LR_AF + 32768, LR_AB = LR_IF + 32768, LR_IB = LR_AB + 32768;
constexpr int NT16 = RB / 16;

DEVI int lr_pos0(int tt) { return tt * 16; }
DEVI int lr_chain_pos(int tt, int dir) { return dir ? (NT16 - 1 - tt) : (tt < 512 ? tt + 16 : tt - 512); }

struct LruW { bf16x8 b[2][4][2]; float ba[4], bx[4], la[4]; };
DEVI void lru_load_w(const Params& p, int l, int dir, int n, int l15, int g, LruW& w) {
#pragma unroll
    for (int which = 0; which < 2; ++which)
#pragma unroll
        for (int ct = 0; ct < 4; ++ct)
#pragma unroll
            for (int ks = 0; ks < 2; ++ks)
                w.b[which][ct][ks] = *(const bf16x8*)(p.wlru + ((((size_t)(l * 2 + dir) * 8 + n) * 2 + which) * 64 + 16 * ct + l15) * 64 + 32 * ks + 8 * g);
#pragma unroll
    for (int ct = 0; ct < 4; ++ct) { const int c = (l * 2 + dir) * 512 + n * 64 + 16 * ct + l15;
        w.ba[ct] = p.in[I_LBA][c]; w.bx[ct] = p.in[I_LBX][c]; w.la[ct] = p.lrula[c]; }
}
struct LrIn { bf16_t x[19]; bf16_t y[16]; bf16_t hf[16]; float h_in; };
template <int MODE> DEVI void lru_load(const Params& p, int u, LrIn& r) {
    const int bl = u / NT16, tt = u % NT16, c = opq_tid();
    const int pos0 = tt * 16, seg0 = tt < 512 ? 0 : SEQ, seg1 = tt < 512 ? SEQ : RB;
    const bf16_t* xx = p.pa + (size_t)bl * RB * PA_W + C_LX + c;
#pragma unroll
    for (int i = 0; i < 19; ++i) { const int pos = pos0 - 2 + i; r.x[i] = (pos >= seg0 && pos < seg1) ? xx[(size_t)pos * PA_W] : (bf16_t)0; }
    if (MODE == 2) { const bf16_t* yy = p.pa + ((size_t)bl * RB + pos0) * PA_W + C_LY + c;
#pragma unroll
        for (int t = 0; t < 16; ++t) r.y[t] = yy[(size_t)t * PA_W];
        const bf16_t* oc = p.ocat + ((size_t)bl * RB + lr_pos0(tt)) * OCW + 1024 + c;
#pragma unroll
        for (int t = 0; t < 16; ++t) r.hf[t] = oc[(size_t)t * OCW]; }
    if (MODE == 1) r.h_in = p.lin[((size_t)(bl * 2 + 0) * NT16 + lr_chain_pos(tt, 0)) * 512 + c];
    if (MODE == 2) r.h_in = p.lin[((size_t)(bl * 2 + 1) * NT16 + lr_chain_pos(tt, 1)) * 512 + c];
}
#define LR_WAVE_SYNC() do { asm volatile("s_waitcnt lgkmcnt(0)" ::: "memory"); __builtin_amdgcn_wave_barrier(); } while (0)
DEVI void lru_tile_gates(const Params& p, int l, LAS unsigned char* lds, const LrIn& in, const LruW& w) {
    const int tid = opq_tid(), lane = tid & 63, n = tid >> 6, l15 = lane & 15, g = lane >> 4;
    LAS bf16_t* ub = (LAS bf16_t*)(lds + LR_UB);
    {
        const int c = tid;
        const float* cw = p.in[I_CONVW] + (size_t)l * 4 * 512; const float w0 = cw[c], w1 = cw[512 + c], w2 = cw[1024 + c], w3 = cw[1536 + c], cb = p.in[I_CONVB][l * 512 + c];
        float x[19];
#pragma unroll
        for (int i = 0; i < 19; ++i) x[i] = bf2f(in.x[i]);
#pragma unroll
        for (int t = 0; t < 16; ++t) ub[t * LR_UP + c] = f2bf(cb + w0 * x[t] + w1 * x[t + 1] + w2 * x[t + 2] + w3 * x[t + 3]);
    }
    LR_WAVE_SYNC();
    bf16x8 af[2];
#pragma unroll
    for (int ks = 0; ks < 2; ++ks) af[ks] = *(const LAS bf16x8*)(ub + l15 * LR_UP + n * 64 + 32 * ks + 8 * g);
    LAS float* aL = (LAS float*)(lds + LR_AF); LAS float* iL = (LAS float*)(lds + LR_IF);
#pragma unroll
    for (int ct = 0; ct < 4; ++ct) {
        f32x4 ra = {0.f, 0.f, 0.f, 0.f}, xa = {0.f, 0.f, 0.f, 0.f};
#pragma unroll
        for (int ks = 0; ks < 2; ++ks) { ra = __builtin_amdgcn_mfma_f32_16x16x32_bf16(af[ks], w.b[0][ct][ks], ra, 0, 0, 0); xa = __builtin_amdgcn_mfma_f32_16x16x32_bf16(af[ks], w.b[1][ct][ks], xa, 0, 0, 0); }
        const int c = n * 64 + 16 * ct + l15;
#pragma unroll
        for (int r = 0; r < 4; ++r) { const int t = 4 * g + r;
            const float rg = sigmoidf_(ra[r] + w.ba[ct]), ig = sigmoidf_(xa[r] + w.bx[ct]);
            const float a = fast_exp2(rg * w.la[ct]); const float uu = bf2f(ub[t * LR_UP + c]);
            aL[t * 512 + c] = a; iL[t * 512 + c] = __builtin_amdgcn_sqrtf(fmaxf(1.0f - a * a, 0.f)) * ig * uu; }
    }
    LR_WAVE_SYNC();
}
template <int MODE> DEVI void lru_sweep(const Params& p, int l, LAS unsigned char* lds, int dir, int u0, int uend, int ubase, bool skipc) {
    const int tid = opq_tid(), lane = tid & 63, n = tid >> 6, l15 = lane & 15, g = lane >> 4, G = gridDim.x;
    if (u0 >= uend) return;
    LruW w; lru_load_w(p, l, dir, n, l15, g, w);
    const LAS float* aL = (const LAS float*)(lds + LR_AF); const LAS float* iL = (const LAS float*)(lds + LR_IF);
    LrIn cur, nxt; lru_load<MODE>(p, u0 - ubase, cur);
    for (int u = u0; u < uend; u += G) {
        const bool more = u + G < uend; if (more) lru_load<MODE>(p, u + G - ubase, nxt);
        const int uu = u - ubase, bl = uu / NT16, tt = uu % NT16;
        if (!(skipc && tt >= 512)) {
            lru_tile_gates(p, l, lds, cur, w);
            if (MODE == 0) { float A = 1.f, H = 0.f;
#pragma unroll
                for (int t = 0; t < 16; ++t) { const float a = aL[t * 512 + tid], b = iL[t * 512 + tid]; if (dir == 0) { H = a * H + b; A *= a; } else { H += b * A; A *= a; } }
                *((f32x2_t*)p.lsum + ((size_t)(bl * 2 + dir) * NT16 + lr_chain_pos(tt, dir)) * 512 + tid) = (f32x2_t){A, H};
            } else { bf16_t* ocol = p.ocat + ((size_t)bl * RB + lr_pos0(tt)) * OCW + 1024 + tid; float h = cur.h_in;
                if (MODE == 1) {
#pragma unroll
                    for (int t = 0; t < 16; ++t) { h = aL[t * 512 + tid] * h + iL[t * 512 + tid]; ocol[(size_t)t * OCW] = f2bf(h); }
                } else {
                    float hfv[16];
#pragma unroll
                    for (int t = 0; t < 16; ++t) hfv[t] = bf2f(cur.hf[t]);
#pragma unroll
                    for (int t = 15; t >= 0; --t) { h = aL[t * 512 + tid] * h + iL[t * 512 + tid];
                        const float y = bf2f(cur.y[t]); const float x3 = 0.7978845608028654f * (y + 0.044715f * y * y * y);
                        const float th = 1.0f - 2.0f * fast_rcp(1.0f + fast_exp2(2.88539008f * x3));
                        ocol[(size_t)t * OCW] = f2bf((hfv[t] + h) * 0.5f * y * (1.0f + th)); } }
            }
            LR_WAVE_SYNC();
        }
        if (more) cur = nxt;
    }
}
DEVI void lru_prefix(const Params& p, bool dry = false) {
    const int lane = opq_tid() & 63, wv = opq_tid() >> 6;
    for (int chain = opq_bid() * 8 + wv; chain < 2 * 2 * 512; chain += gridDim.x * 8) {
        const int c = chain & 511, bd = chain >> 9;
        const f32x2_t* src = (const f32x2_t*)p.lsum + (size_t)bd * NT16 * 512 + c; float* dst = p.lin + (size_t)bd * NT16 * 512 + c;
        f32x2_t v[9]; float A = 1.f, H = 0.f;
#pragma unroll
        for (int i = 0; i < 9; ++i) { const int q = lane * 9 + i; v[i] = (q < NT16) ? src[(size_t)q * 512] : (f32x2_t){1.f, 0.f}; H = v[i].x * H + v[i].y; A *= v[i].x; }
#pragma unroll
        for (int o = 1; o < 64; o <<= 1) { const float Ap = __shfl_up(A, o), Hp = __shfl_up(H, o); if (lane >= o) { H = A * Hp + H; A = A * Ap; } }
        float h = __shfl_up(H, 1); if (lane == 0) h = 0.f;
#pragma unroll
        for (int i = 0; i < 9; ++i) { const int q = lane * 9 + i; if (q < NT16 && !dry) dst[(size_t)q * 512] = h; h = v[i].x * h + v[i].y; }
        if (dry && h == 123.456f) dst[0] = 0.f;
    }
}
DEVI void phase_attn_scan1(const Params& p, int l, LAS unsigned char* lds, int parts = 7, int qi = 0) {
    const int nA = 2 * 8 * 16 + (l == 0 ? 16 : 0), nH = 2 * 8 * NCH, nL = 2 * NT16, G = gridDim.x;
    const float accinit = attn_offset(p, l);
    int u = opq_bid();
    for (; u < 256; u += G) { const int bl = u >> 7, h = (u >> 4) & 7, qb = u & 15; if (!(parts & 1)) continue;
        attn_unit(p, lds, p.q + ((size_t)(bl * 8 + h) * SEQ + qb * 512) * 96, 512, p.kv + (size_t)(bl * 8 + h) * NCH * KVT_BYTES, NCH,
                  p.ocat + (size_t)(bl * RB + qb * 512) * OCW + 512 + h * 64, accinit); }
    for (; u < nA; u += G) { const int uu = u - 256, bl = uu >> 3, h = uu & 7; if (!(parts & 1)) continue;
        attn_unit(p, lds, p.qc + ((size_t)(bl * 8 + h) * CTX) * 96, 256, p.kv + ((size_t)(bl * 8 + h) * NCH + 128) * KVT_BYTES, 4,
                  p.ocat + (size_t)(bl * RB + SEQ) * OCW + 512 + h * 64, accinit); }
    if (parts & 4) { const int ul = opq_bid(); lru_sweep<0>(p, l, lds, 0, ul, nL, 0, false); lru_sweep<0>(p, l, lds, 1, ul, nL, 0, false); __syncthreads(); }
    if (parts & 2) { const int tid = opq_tid(); unsigned* dqc = p.ctrl + CTRL_DQ(4 + qi);
        int v = opq_bid(), vn = v + G; HgIn cur, nxt; if (v < nH) hg_load<false>(p, l, v, cur);
        for (int it = 0; v < nH; ++it) {
            unsigned pend = 0; if (tid == 0) pend = xb_add(dqc, 1u);
            const bool more = vn < nH; if (more) hg_load<false>(p, l, vn, nxt);
            hg_pass1_unit(p, l, lds, v, cur);
            if (tid == 0) *DQ_SLOT(lds, it & 1) = (int)pend + 2 * G;
            LDS_SYNC();
            const int vnn = __builtin_amdgcn_readfirstlane(*DQ_SLOT(lds, it & 1));
            if (more) cur = nxt;
            v = vn; vn = vnn; } }
}
DEVI void phase_prefix(const Params& p, LAS unsigned char* lds, bool dry = false) { (void)lds; hg_prefix(p, dry); lru_prefix(p, dry); }
DEVI void phase_scan3(const Params& p, int l, LAS unsigned char* lds, int parts = 3, int qi = 0) {
    const int nH = 2 * 8 * NCH, nL = 2 * NT16, G = gridDim.x; const bool skipc = (l == DEPTH - 1);
    if (parts & 2) { const int ul = opq_bid(); lru_sweep<1>(p, l, lds, 0, ul, nL, 0, skipc); lru_sweep<2>(p, l, lds, 1, ul, nL, 0, skipc); __syncthreads(); }
#ifdef HGX
    { HgIn c2; for (int v = opq_bid(); v < nH; v += G) { hg_load<true>(p, l, v, c2);
        if (HGX == 1) hg_prepare<true>(p, l, lds, (v / NCH) & 7, c2); else if (HGX == 2) hg_pass3_unit(p, l, lds, v, c2); else { __syncthreads(); } } __syncthreads(); }
#endif
    if (parts & 1) { const int tid = opq_tid(); unsigned* dqc = p.ctrl + CTRL_DQ(8 + qi);
        int v = opq_bid(), vn = v + G; HgIn cur, nxt; if (v < nH) hg_load<true>(p, l, v, cur);
        for (int it = 0; v < nH; ++it) {
            unsigned pend = 0; if (tid == 0) pend = xb_add(dqc, 1u);
            const bool more = vn < nH; if (more) hg_load<true>(p, l, vn, nxt);
            if (!(skipc && (v % NCH) >= 128)) hg_pass3_unit(p, l, lds, v, cur);
            if (tid == 0) *DQ_SLOT(lds, it & 1) = (int)pend + 2 * G;
            LDS_SYNC();
            const int vnn = __builtin_amdgcn_readfirstlane(*DQ_SLOT(lds, it & 1));
            if (more) cur = nxt;
            v = vn; vn = vnn; } }
}

constexpr int RP = 2 * TT + 4096;

DEVI void phase_norm2_route(const Params& p, int l, LAS unsigned char* lds) {
    const int tid = opq_tid(), lane = tid & 63, wv = tid >> 6; const bool skipc = (l == DEPTH - 1);
    LAS int* cntl = (LAS int*)lds;
    LAS int* basel = cntl + 16;
    LAS int* rinfo = cntl + 64;
    LAS float* rw = (LAS float*)(rinfo + 4 * 8 * 20);
    if (tid < 16) cntl[tid] = 0;
    LAS float* Wt = (LAS float*)(lds + 8192);
    { const float* wrg = p.in[I_WRG] + (size_t)l * DM * 4; const float* wre = p.in[I_WRE] + (size_t)l * DM * 16;
      for (int i = tid; i < DM * 4; i += 512) Wt[(i & 3) * DM + (i >> 2)] = wrg[i];
      for (int i = tid; i < DM * 16; i += 512) Wt[(4 + (i & 15)) * DM + (i >> 4)] = wre[i]; }
    __syncthreads();
    const float* gm = p.in[I_NFFN] + l * DM;
    const int RPW = (TT + (int)gridDim.x * 8 - 1) / ((int)gridDim.x * 8);
    const int r0 = (opq_bid() * 8 + wv) * RPW, r1 = (r0 + RPW < TT) ? r0 + RPW : TT;
    f32x4 vn[2][4];
#pragma unroll
    for (int q = 0; q < 2; ++q) { const int rq = r0 + q; if (rq < r1) { const float* s0 = xbuf_row(p, rq);
#pragma unroll
        for (int i = 0; i < 4; ++i) vn[q][i] = *(const f32x4*)(s0 + i * 256 + lane * 4); } }
    f32x4 gsc[4], shv[4]; int curv = -1;
#pragma unroll
    for (int i = 0; i < 4; ++i) { gsc[i] = (f32x4){0.f, 0.f, 0.f, 0.f}; shv[i] = gsc[i]; }
    for (int r = r0, it = 0; r < r1; r += 2, it += 2) {
        f32x2_t hp[4][4]; bool live[2];
#pragma unroll
        for (int q = 0; q < 2; ++q) {
            const int rq = r + q; f32x4 v[4];
#pragma unroll
            for (int i = 0; i < 4; ++i) v[i] = vn[q][i];
            if (rq + 2 < r1) { const float* s1 = xbuf_row(p, rq + 2);
#pragma unroll
                for (int i = 0; i < 4; ++i) vn[q][i] = *(const f32x4*)(s1 + i * 256 + lane * 4); }
            live[q] = rq < r1 && !(skipc && (rq % RB) >= SEQ);
            if (rq < r1 && !live[q] && lane == 0) rinfo[((it + q) * 8 + wv) * 4] = -1;
            float ss = 0.f;
#pragma unroll
            for (int i = 0; i < 4; ++i) ss += v[i][0] * v[i][0] + v[i][1] * v[i][1] + v[i][2] * v[i][2] + v[i][3] * v[i][3];
            ss = wave_sum(ss);
            const float rstd = rsqrtf(ss * (1.0f / DM) + EPSF);
            const int rr = live[q] ? rq : r0;
            const int vr = __builtin_amdgcn_readfirstlane(mod_row(rr));
            if (vr != curv) { curv = vr; const float* mv = p.modv + ((size_t)l * 5 + vr) * 6144;
#pragma unroll
                for (int i = 0; i < 4; ++i) { const int c = i * 256 + lane * 4; const f32x4 g = *(const f32x4*)(gm + c), sc = *(const f32x4*)(mv + 4096 + c);
                    shv[i] = *(const f32x4*)(mv + 3072 + c);
#pragma unroll
                    for (int e = 0; e < 4; ++e) gsc[i][e] = g[e] * (1.0f + sc[e]); } }
#pragma unroll
            for (int i = 0; i < 4; ++i) { const int c = i * 256 + lane * 4; f32x4 h;
#pragma unroll
                for (int e = 0; e < 4; ++e) { h[e] = live[q] ? v[i][e] * rstd * gsc[i][e] + shv[i][e] : 0.f; hp[i][e][q] = h[e]; }
                if (live[q]) { u32x2 w; w.x = cvt_pk_bf16(h[0], h[1]); w.y = cvt_pk_bf16(h[2], h[3]);
                    *(u32x2*)(p.h2 + (size_t)rq * DM + c) = w; } }
        }
        float red[2][32];
#pragma unroll
        for (int j = 0; j < 32; ++j) { f32x2_t a = {0.f, 0.f};
            if (j < 20) {
#pragma unroll
                for (int i = 0; i < 4; ++i) { const f32x4 w4 = *(const LAS f32x4*)(Wt + j * DM + i * 256 + lane * 4);
#pragma unroll
                    for (int e = 0; e < 4; ++e) a += hp[i][e] * (f32x2_t){w4[e], w4[e]}; } }
            red[0][j] = a[0]; red[1][j] = a[1]; }
#pragma unroll
        for (int q = 0; q < 2; ++q) {
#pragma unroll
            for (int lvl = 0; lvl < 5; ++lvl) { const int half = 16 >> lvl, bit = 32 >> lvl; const bool hi = (lane & bit) != 0;
#pragma unroll
                for (int i = 0; i < half; ++i) { const float snd = hi ? red[q][i] : red[q][i + half]; const float keep = hi ? red[q][i + half] : red[q][i];
                    red[q][i] = keep + __shfl_xor(snd, bit); } }
            red[q][0] += __shfl_xor(red[q][0], 1);
        }
#pragma unroll
        for (int q = 0; q < 2; ++q) {
            float lgt[20];
#pragma unroll
            for (int j = 0; j < 20; ++j) lgt[j] = __builtin_bit_cast(float, __builtin_amdgcn_readlane(__builtin_bit_cast(int, red[q][0]), 2 * j));
            const f32x4 lg = {lgt[0], lgt[1], lgt[2], lgt[3]}, le0 = {lgt[4], lgt[5], lgt[6], lgt[7]}, le1 = {lgt[8], lgt[9], lgt[10], lgt[11]},
                        le2 = {lgt[12], lgt[13], lgt[14], lgt[15]}, le3 = {lgt[16], lgt[17], lgt[18], lgt[19]};
            if (lane == 0 && live[q]) {
                const float* brg = p.in[I_BRG] + l * 4; const float* bre = p.in[I_BRE] + l * 16;
                int gs = 0; float best = lg[0] + brg[0];
#pragma unroll
                for (int e = 1; e < 4; ++e) { const float t = lg[e] + brg[e]; if (t > best) { best = t; gs = e; } }
                const float m = fmaxf(fmaxf(lg[0], lg[1]), fmaxf(lg[2], lg[3]));
                const float e0 = __expf(lg[0] - m), e1 = __expf(lg[1] - m), e2 = __expf(lg[2] - m), e3 = __expf(lg[3] - m);
                const float pg = (gs == 0 ? e0 : gs == 1 ? e1 : gs == 2 ? e2 : e3) / (e0 + e1 + e2 + e3);
                const f32x4 lv = (gs == 0) ? le0 : (gs == 1) ? le1 : (gs == 2) ? le2 : le3;
                const f32x4 bv = lv + *(const f32x4*)(bre + gs * 4);
                int i0 = 0; float m0 = bv[0], l0 = lv[0];
#pragma unroll
                for (int e = 1; e < 4; ++e) if (bv[e] > m0) { m0 = bv[e]; i0 = e; l0 = lv[e]; }
                int i1 = -1; float m1 = -3.0e38f, l1 = 0.f;
#pragma unroll
                for (int e = 0; e < 4; ++e) if (e != i0 && bv[e] > m1) { m1 = bv[e]; i1 = e; l1 = lv[e]; }
                const float mm = fmaxf(l0, l1), x0 = __expf(l0 - mm), x1 = __expf(l1 - mm);
                const float w0 = x0 / (x0 + x1) * pg, w1 = x1 / (x0 + x1) * pg;
                const int ea = gs * 4 + i0, eb = gs * 4 + i1;
                const int sa = __hip_atomic_fetch_add(&cntl[ea], 1, __ATOMIC_RELAXED, __HIP_MEMORY_SCOPE_WORKGROUP), sb = __hip_atomic_fetch_add(&cntl[eb], 1, __ATOMIC_RELAXED, __HIP_MEMORY_SCOPE_WORKGROUP);
                const int qi = ((it + q) * 8 + wv) * 4; rinfo[qi] = ea; rinfo[qi + 1] = eb; rinfo[qi + 2] = sa; rinfo[qi + 3] = sb;
                rw[((it + q) * 8 + wv) * 2] = w0; rw[((it + q) * 8 + wv) * 2 + 1] = w1;
            }
        }
    }
    __syncthreads();
    if (tid < 16) basel[tid] = (int)atomicAdd(&p.ctrl[CTRL_CNT(l, tid)], (unsigned)cntl[tid]);
    __syncthreads();
    for (int r = r0, it = 0; r < r1; ++r, ++it) {
        if (lane == 0) { const int q = (it * 8 + wv) * 4; const int ea = rinfo[q];
            if (ea >= 0) { const int eb = rinfo[q + 1], sa = basel[ea] + rinfo[q + 2], sb = basel[eb] + rinfo[q + 3];
                p.tok_e[r * 2] = ea; p.tok_e[r * 2 + 1] = eb; p.tok_s[r * 2] = sa; p.tok_s[r * 2 + 1] = sb;
                p.lst[(size_t)ea * TT + sa] = r; p.lst[(size_t)eb * TT + sb] = r; p.tok_w[(size_t)ea * TT + sa] = rw[(it * 8 + wv) * 2]; p.tok_w[(size_t)eb * TT + sb] = rw[(it * 8 + wv) * 2 + 1]; } }
    }
    __syncthreads();
}

DEVI void moe_offsets(const Params& p, int l, LAS int* offs) {
    if (opq_tid() == 0) { int o = 0;
        for (int e = 0; e < NEXP; ++e) { offs[e] = o; const int c = (int)__hip_atomic_load(&p.ctrl[CTRL_CNT(l, e)], __ATOMIC_RELAXED, __HIP_MEMORY_SCOPE_AGENT); offs[32 + e] = c; o += (c + 255) & ~255; }
        offs[NEXP] = o; }
    __syncthreads();
}
DEVI int moe_expert_of(const LAS int* offs, int row) { int e = 0;
#pragma unroll
    for (int q = 1; q < NEXP; ++q) e += (row >= offs[q]) ? 1 : 0;
    return e; }

DEVI void phase_moe_permute(const Params& p, int l, const LAS int* offs) {
    const int lane = opq_tid() & 63, wv = opq_tid() >> 6; const int R = offs[NEXP];
    for (int pr = opq_bid() * 8 + wv; pr < R; pr += gridDim.x * 8) {
        const int e = moe_expert_of(offs, pr), s = pr - offs[e]; const bool valid = s < offs[32 + e];
        u32x4 a = {0u, 0u, 0u, 0u}, b = {0u, 0u, 0u, 0u}; int r = 0; float w = 0.f;
        const int vz = vzero();
        if (valid) { r = p.lst[(size_t)e * TT + s + vz]; w = p.tok_w[(size_t)e * TT + s + vz];
            const u32x4* src = (const u32x4*)(p.h2 + (size_t)r * DM); a = src[lane]; b = src[64 + lane]; }
        u32x4* dst = (u32x4*)(p.h2p + (size_t)pr * DM); dst[lane] = a; dst[64 + lane] = b;
        if (lane == 0) { p.rww[pr] = w; p.rmr[pr] = valid ? mod_row(r) : 0; }
    }
}

template <bool GATH> struct MoeSched { static constexpr bool GATHER = GATH, DEPS = !GATH; unsigned* flags; const int* lst; int cnt[NEXP]; int G, c, nN; int o[NEXP + 1]; const char* A; const char* B; size_t atile, bexp, btile;
    DEVI void load(const LAS int* offs) {
#pragma unroll
        for (int q = 0; q <= NEXP; ++q) o[q] = __builtin_amdgcn_readfirstlane(offs[q]);
#pragma unroll
        for (int q = 0; q < NEXP; ++q) cnt[q] = __builtin_amdgcn_readfirstlane(offs[32 + q]); }
    DEVI int row_of(const g8::Unit& u, int r) const { int base = 0, n = 0;
#pragma unroll
        for (int q = 0; q < NEXP; ++q) { base = (u.tag == q) ? o[q] : base; n = (u.tag == q) ? cnt[q] : n; }
        const int s2 = u.pm * 256 + r - base; return (s2 < n) ? lst[(size_t)u.tag * TT + s2] : 0; }
    DEVI bool next(int i, g8::Unit& u) const { const long Lin = (long)i * G + c; const int R = o[NEXP]; const int T = (R / 256) * nN; if (Lin >= T) return false;
        int L; { const int q = T / g8::NXCD, r = T % g8::NXCD, xcd = (int)(Lin % g8::NXCD), off = (int)(Lin / g8::NXCD); L = (xcd < r ? xcd * (q + 1) : r * (q + 1) + (xcd - r) * q) + off; }
        const int ti = L / nN, pn = L % nN; int e = 0;
#pragma unroll
        for (int q = 1; q < NEXP; ++q) e += (ti * 256 >= o[q]) ? 1 : 0;
        u.pm = ti; u.pn = pn; u.tag = e; u.a = A + (size_t)ti * atile; u.b = B + (size_t)e * bexp + (size_t)pn * btile;
        if (DEPS) unit_wait(flags + ti, 2u);
        return true; } };
struct EpiSwiglu {
    static constexpr bool PERM = true, HAS_MID = false, SIGNAL = true; static constexpr int NSEG = 1;
    bf16_t* hid; unsigned* flags;
    DEVI void signal(const g8::Unit& u, LAS unsigned char* lds) const { unit_signal(lds, flags + u.pm); }
    DEVI void operator()(const f32x4 (&acc)[2][2][4][2], const g8::Unit& u, int wr, int wc, int fr, int fq) const {
        const int row0 = u.pm * 256 + wr * 64 + fr, col0 = u.pn * 128 + wc * 32 + 8 * fq;
#pragma unroll
        for (int ai = 0; ai < 2; ++ai)
#pragma unroll
            for (int m = 0; m < 4; ++m) { float h[8];
#pragma unroll
                for (int n = 0; n < 2; ++n) { const f32x4 a = acc[ai][0][m][n], b = acc[ai][1][m][n];
#pragma unroll
                    for (int e = 0; e < 4; ++e) h[4 * n + e] = a[e] * sigmoidf_(a[e]) * b[e]; }
                u32x4 w; w.x = cvt_pk_bf16(h[0], h[1]); w.y = cvt_pk_bf16(h[2], h[3]); w.z = cvt_pk_bf16(h[4], h[5]); w.w = cvt_pk_bf16(h[6], h[7]);
                *(u32x4*)(hid + (size_t)(row0 + ai * 128 + m * 16) * DEXP + col0) = w; }
    }
};
DEVI void phase_moe_up(const Params& p, int l, const LAS int* offs, LAS unsigned char* lds) {
    MoeSched<true> S; S.lst = p.lst; S.G = gridDim.x; S.c = opq_bid(); S.nN = 2; S.load(offs); S.A = (const char*)p.h2; S.B = (const char*)(p.w13 + (size_t)l * NEXP * 512 * DM);
    S.atile = 0; S.bexp = (size_t)512 * DM * 2; S.btile = (size_t)256 * DM * 2;
    S.flags = nullptr; EpiSwiglu E; E.hid = p.hid; E.flags = p.ctrl + CTRL_MOEF(l);
    g8::gemm_phase(lds, DM, DM, DM, S, E);
}
struct EpiDown {
    static constexpr bool PERM = true, HAS_MID = false, SIGNAL = false; static constexpr int NSEG = 1;
    bf16_t* yo; const float* tokw; const LAS int* offs;
    DEVI void operator()(const f32x4 (&acc)[2][2][4][2], const g8::Unit& u, int wr, int wc, int fr, int fq) const {
        const int row0 = u.pm * 256 + wr * 64 + fr, col0 = u.pn * 256 + wc * 32 + 8 * fq;
        const int e = u.tag, base = offs[e], n = offs[32 + e];
        float wrow[2][4];
#pragma unroll
        for (int ai = 0; ai < 2; ++ai)
#pragma unroll
            for (int m = 0; m < 4; ++m) { const int s2 = row0 + ai * 128 + m * 16 - base; wrow[ai][m] = (s2 < n) ? tokw[(size_t)e * TT + s2] : 0.f; }
#pragma unroll
        for (int ai = 0; ai < 2; ++ai)
#pragma unroll
            for (int m = 0; m < 4; ++m) { const int row = row0 + ai * 128 + m * 16; const float w = wrow[ai][m];
#pragma unroll
                for (int bj = 0; bj < 2; ++bj) { const f32x4 v0 = acc[ai][bj][m][0] * w, v1 = acc[ai][bj][m][1] * w;
                    u32x4 o; o.x = cvt_pk_bf16(v0[0], v0[1]); o.y = cvt_pk_bf16(v0[2], v0[3]); o.z = cvt_pk_bf16(v1[0], v1[1]); o.w = cvt_pk_bf16(v1[2], v1[3]);
                    *(u32x4*)(yo + (size_t)row * DM + col0 + bj * 128) = o; } }
    }
};
DEVI void phase_moe_down(const Params& p, int l, const LAS int* offs, LAS unsigned char* lds) {
    MoeSched<false> S; S.lst = p.lst; S.G = gridDim.x; S.c = HANDOFF ? (int)gridDim.x - 1 - opq_bid() : opq_bid(); S.nN = 4; S.flags = p.ctrl + CTRL_MOEF(l); S.load(offs); S.A = (const char*)p.hid; S.B = (const char*)(p.w2 + (size_t)l * NEXP * DM * DEXP);
    S.atile = (size_t)256 * DEXP * 2; S.bexp = (size_t)DM * DEXP * 2; S.btile = (size_t)256 * DEXP * 2;
    EpiDown E; E.yo = p.yo; E.tokw = p.tok_w; E.offs = offs;
    g8::gemm_phase(lds, DEXP, DEXP, DEXP, S, E);
}
DEVI void phase_moe_combine(const Params& p, int l, const LAS int* offs, bool dry = false) {
    const int lane = opq_tid() & 63, wv = opq_tid() >> 6; const bool skipc = (l == DEPTH - 1);
    const int rstep = gridDim.x * 8, rfirst = opq_bid() * 8 + wv, vz = vzero();
    auto live = [&](int r) { return r < TT && !(skipc && (r % RB) >= SEQ); };
    int e0n = 0, s0n = 0, e1n = 0, s1n = 0;
    auto load_slots = [&](int r) { if (live(r)) { e0n = p.tok_e[r * 2 + vz]; s0n = p.tok_s[r * 2 + vz]; e1n = p.tok_e[r * 2 + 1 + vz]; s1n = p.tok_s[r * 2 + 1 + vz]; } };
    f32x4 xn[4], gn[4]; u32x2 an[4], bn[4];
    auto load_data = [&](int r) { if (live(r)) { const float* x = xbuf_row(p, r);
            const bf16_t* y0 = p.yo + (size_t)(offs[e0n] + s0n) * DM; const bf16_t* y1 = p.yo + (size_t)(offs[e1n] + s1n) * DM;
            const float* g2n = p.modv + ((size_t)l * 5 + mod_row(r)) * 6144 + 5120;
#pragma unroll
            for (int i = 0; i < 4; ++i) { const int c = i * 256 + lane * 4; xn[i] = *(const f32x4*)(x + c); an[i] = *(const u32x2*)(y0 + c); bn[i] = *(const u32x2*)(y1 + c); gn[i] = *(const f32x4*)(g2n + c); } } };
    load_slots(rfirst); load_data(rfirst); load_slots(rfirst + rstep);
    for (int r = rfirst; r < TT; r += rstep) {
        f32x4 v[4], g[4]; u32x2 a[4], b[4];
#pragma unroll
        for (int i = 0; i < 4; ++i) { v[i] = xn[i]; a[i] = an[i]; b[i] = bn[i]; g[i] = gn[i]; }
        load_data(r + rstep);
        load_slots(r + 2 * rstep);
        if (!live(r)) continue;
        float* x = xbuf_row(p, r);
#pragma unroll
        for (int i = 0; i < 4; ++i) { const int c = i * 256 + lane * 4; const f32x4 gv = g[i];
            v[i][0] += gv[0] * (__uint_as_float(a[i].x << 16) + __uint_as_float(b[i].x << 16)); v[i][1] += gv[1] * (__uint_as_float(a[i].x & 0xffff0000u) + __uint_as_float(b[i].x & 0xffff0000u));
            v[i][2] += gv[2] * (__uint_as_float(a[i].y << 16) + __uint_as_float(b[i].y << 16)); v[i][3] += gv[3] * (__uint_as_float(a[i].y & 0xffff0000u) + __uint_as_float(b[i].y & 0xffff0000u));
            if (!dry || v[i][0] == 123.456f) *(f32x4*)(x + c) = v[i]; }
    }
}

#ifndef MK_PHASE_KERNELS
#define MK_PHASE_KERNELS 0
#endif
constexpr int LDS_SCRATCH = 1024;

template <class T> DEVI T* uni_ptr(T* x) { const unsigned long long v = (unsigned long long)x;
    const unsigned lo = __builtin_amdgcn_readfirstlane((unsigned)v), hi = __builtin_amdgcn_readfirstlane((unsigned)(v >> 32));
    return (T*)(((unsigned long long)hi << 32) | lo); }
DEVI Params ldparams(const PL& s) {
    Params q;
#pragma unroll
    for (int i = 0; i < 35; ++i) q.in[i] = uni_ptr(s.in[i]);
#define LDP(f) q.f = uni_ptr(s.f)
    LDP(out); LDP(ctrl); LDP(modv); LDP(lbv); LDP(xc); LDP(rope); LDP(lrula); LDP(winA); LDP(winG); LDP(wup); LDP(wcat); LDP(wout); LDP(w13); LDP(w2); LDP(wlru);
    LDP(hx); LDP(pa); LDP(up); LDP(q); LDP(qc); LDP(kv); LDP(st); LDP(stb); LDP(lsum); LDP(lin); LDP(ocat); LDP(y); LDP(h2); LDP(h2p); LDP(hid); LDP(yo);
    LDP(tok_e); LDP(tok_s); LDP(tok_w); LDP(lst); LDP(rww); LDP(rmr);
#undef LDP
    q.pad_ = 0ull;
    return q;
}
#ifndef WAITPROBE
#define WAITPROBE (-1)
#endif
#ifndef WAITSEL
#define WAITSEL (-1)
#endif
#ifndef BODYSEL
#define BODYSEL (-1)
#endif
#ifndef SPANA
#define SPANA (-9)
#endif
#ifndef SPANB
#define SPANB (-9)
#endif
#ifndef PROBE_AMP
#define PROBE_AMP 1
#endif
DEVI void grid_sync(const PL& s, LAS unsigned char* smem, int phid = -2) {
    XcdBarrier b; b.bar = uni_ptr(s.ctrl); b.x = xb_xcc_id(); b.st = (volatile LAS unsigned*)smem;
#if WAITPROBE >= 0
    unsigned long long t0 = 0; if (threadIdx.x == 0) t0 = __builtin_amdgcn_s_memrealtime();
    xcd_barrier(b);
    if (threadIdx.x == 0 && BODYSEL < 0 && (WAITSEL == -1 || phid == WAITSEL)) { LAS unsigned long long* acc = (LAS unsigned long long*)(smem + 32); *acc += __builtin_amdgcn_s_memrealtime() - t0; }
#else
    xcd_barrier(b);
#endif
}
DEVI void probe_dump(const Params& p, const bf16_t* src, size_t n) {
    const size_t NOUT = (size_t)NB * SEQ * DM;
    for (size_t i = (size_t)opq_bid() * 512 + opq_tid(); i < NOUT; i += (size_t)gridDim.x * 512) { float s = 0.f;
        for (size_t k = i; k < n; k += NOUT) s += (float)src[k];
        p.out[i] = s; }
}
#define PROBE_AT(id, buf, n) if (PROBE_STOP == (id) && l == 0 && hb == 0) { { const Params p = ldparams(pl); probe_dump(p, (const bf16_t*)(buf), (n)); } return; }
#ifndef PROBE_STOP
#define PROBE_STOP 0
#endif
#ifndef DUP_MASK
#define DUP_MASK 0
#endif
#define PHASE_D(bit, call, dupcall) PHASE(call); if ((DUP_MASK >> (bit)) & 1) { PHASE(dupcall); }
#define PHASE_I(id, call) do { unsigned long long tb_ = 0; if (BODYSEL == (id) && threadIdx.x == 0) tb_ = __builtin_amdgcn_s_memrealtime(); \
        if (SPANA == (id) && threadIdx.x == 0) *(LAS unsigned long long*)(smem + 56) = __builtin_amdgcn_s_memrealtime(); \
        { const Params p = ldparams(pl); call; } \
        if (BODYSEL == (id)) { __syncthreads(); if (threadIdx.x == 0) { LAS unsigned long long* acc = (LAS unsigned long long*)(smem + 32); *acc += __builtin_amdgcn_s_memrealtime() - tb_; } } } while (0); \
    grid_sync(pl, smem, id); if (SPANB == (id) && threadIdx.x == 0) *(LAS unsigned long long*)(smem + 32) += __builtin_amdgcn_s_memrealtime() - *(LAS unsigned long long*)(smem + 56); if ((DUP_MASK >> 21) & 1) grid_sync(pl, smem)
#define PHASE(call) PHASE_I(-2, call)

#ifndef SELFCHECK
#define SELFCHECK 0
#endif
DEVI void chk_sum(const Params& p, int id, int rep, const void* buf, size_t nbytes) {
    const unsigned* w = (const unsigned*)buf; const size_t n = nbytes / 4; unsigned long long s = 0ull;
    for (size_t i = (size_t)opq_bid() * 512 + opq_tid(); i < n; i += (size_t)gridDim.x * 512) s += (unsigned long long)w[i] * (unsigned long long)((i & 1023) + 1);
    unsigned lo = (unsigned)s, hi = (unsigned)(s >> 32);
    for (int o = 32; o >= 1; o >>= 1) { const unsigned l2 = __shfl_xor(lo, o), h2 = __shfl_xor(hi, o); const unsigned long long t = (((unsigned long long)hi << 32) | lo) + (((unsigned long long)h2 << 32) | l2); lo = (unsigned)t; hi = (unsigned)(t >> 32); }
    if ((opq_tid() & 63) == 0) atomicAdd((unsigned long long*)(p.ctrl + 6144) + (rep * 32 + id), (((unsigned long long)hi << 32) | lo));
}
#define CHK(id, buf, nbytes) do { const Params p = ldparams(pl); chk_sum(p, id, rep, buf, nbytes); } while (0); grid_sync(pl, smem)

__global__ void __launch_bounds__(512, 2) hybrid_flow_backbone_kernel(Params pk) {
    extern __shared__ __attribute__((aligned(16))) unsigned char smem_raw[];
    LAS unsigned char* smem = (LAS unsigned char*)smem_raw;
    LAS unsigned char* lds = smem + LDS_SCRATCH; LAS int* offs = (LAS int*)(smem + 64);
    static_assert(sizeof(Params) % 8 == 0 && sizeof(Params) <= LDS_SCRATCH - 256, "Params must fit its LDS slot");
    { (void)pk;
      const __attribute__((address_space(4))) unsigned long long* src = (const __attribute__((address_space(4))) unsigned long long*)__builtin_amdgcn_kernarg_segment_ptr();
      LAS unsigned long long* dst = (LAS unsigned long long*)(smem + 256);
      if (threadIdx.x < sizeof(Params) / 8) dst[threadIdx.x] = src[threadIdx.x]; }
    if (threadIdx.x == 0) { *(LAS u32x4*)smem = (u32x4){0u, 0u, 0u, 0u}; *(LAS unsigned long long*)(smem + 32) = 0ull; *(LAS unsigned*)(smem + 48) = 0u; }
    __syncthreads();
    const PL& pl = *(const PL*)(smem + 256);
    (void)xcd_barrier_post(uni_ptr(pl.ctrl), (volatile LAS unsigned*)smem);
    { unsigned long long tb_ = 0; if (BODYSEL == 0 && threadIdx.x == 0) tb_ = __builtin_amdgcn_s_memrealtime(); phase_prep(pl, lds);
      if (BODYSEL == 0) { __syncthreads(); if (threadIdx.x == 0) *(LAS unsigned long long*)(smem + 32) += __builtin_amdgcn_s_memrealtime() - tb_; } }
    grid_sync(pl, smem, 0);
    if ((DUP_MASK >> 16) & 1) { phase_prep(pl, lds); grid_sync(pl, smem); }
#if SELFCHECK
    for (int rep = 0; rep < SELFCHECK; ++rep) {
        const int l = 0, hb = 0;
        PHASE(phase_norm1(p, l, hb));          CHK(1, p.hx, (size_t)HR * DM * 2);
        PHASE(phase_inproj_a(p, l, lds));      CHK(2, p.pa, (size_t)HR * PA_W * 2);
        PHASE(phase_mla_up(p, l, lds));        CHK(3, p.up, (size_t)HR * UPW * 2);
        PHASE(phase_qkv(p, l, lds));           CHK(4, p.q, (size_t)2 * 8 * SEQ * 96 * 2); CHK(5, p.qc, (size_t)2 * 8 * CTX * 96 * 2);
        PHASE(phase_attn_scan1(p, l, lds));    CHK(6, p.st, (size_t)2 * 2 * 8 * NCH * 4096 * 2); CHK(7, p.stb, (size_t)2 * 2 * 8 * NCH * 64 * 4); CHK(8, p.lsum, (size_t)2 * 2 * NT16 * 512 * 2 * 4);
        PHASE(phase_prefix(p, lds));                CHK(9, p.st, (size_t)2 * 2 * 8 * NCH * 4096 * 2); CHK(10, p.lin, (size_t)2 * 2 * NT16 * 512 * 4);
        PHASE(phase_scan3(p, l, lds));         CHK(11, p.ocat, (size_t)HR * OCW * 2);
        PHASE(phase_inproj_g(p, l, lds));      CHK(12, p.pa, (size_t)HR * PG_W * 2);
        PHASE(phase_merge(p, l, lds));         CHK(13, p.y, (size_t)HR * DM * 2);
        PHASE(phase_outproj(p, l, hb, lds));   CHK(14, p.out, (size_t)2 * SEQ * DM * 4); CHK(15, p.xc, (size_t)2 * CTX * DM * 4);
    }
    {   const Params p = ldparams(pl);
        const size_t NOUT = (size_t)NB * SEQ * DM;
        for (size_t i = (size_t)opq_bid() * 512 + opq_tid(); i < NOUT; i += (size_t)gridDim.x * 512) p.out[i] = 0.f;
        __syncthreads();
        if (opq_bid() == 0 && opq_tid() == 0) { int first = 0; const unsigned long long* c = (const unsigned long long*)(p.ctrl + 6144);
            for (int id = 15; id >= 1; --id) for (int rep = 1; rep < SELFCHECK; ++rep)
                if (__hip_atomic_load(c + rep * 32 + id, __ATOMIC_RELAXED, __HIP_MEMORY_SCOPE_AGENT) != __hip_atomic_load(c + id, __ATOMIC_RELAXED, __HIP_MEMORY_SCOPE_AGENT)) first = id;
            p.out[0] = 1000.0f * (float)first; }
    }
    return;
#endif
    for (int l = 0; l < DEPTH; ++l) {
        for (int hb = 0; hb < 2; ++hb) {
            if (l == 0 && hb == 0) { PHASE_I(1, phase_norm1(p, l, hb)); }
#if !HANDOFF
#define PA_SPLIT 1
#define G_SPLIT 1
#define MOE_SPLIT 1
#endif
#ifdef PA_SPLIT
            PHASE_I(2, phase_inproj_a(p, l, lds, l * 2 + hb));
            PHASE_I(3, phase_mla_up(p, l, lds, l * 2 + hb));
#else
#ifdef QKV_SPLIT
            PHASE_I(2, phase_inproj_a(p, l, lds, l * 2 + hb); phase_mla_up(p, l, lds, l * 2 + hb));
#endif
#endif
#if defined(PA_SPLIT) || defined(QKV_SPLIT)
            PHASE_I(4, phase_qkv(p, l, lds, l * 2 + hb));
#else
            PHASE_I(2, phase_inproj_a(p, l, lds, l * 2 + hb); phase_mla_up(p, l, lds, l * 2 + hb); phase_qkv(p, l, lds, l * 2 + hb));
#endif
            PHASE_I(5, phase_attn_scan1(p, l, lds, 7, l * 2 + hb));
            if ((DUP_MASK >> 4) & 1) { PHASE(phase_attn_scan1(p, l, lds, 1)); }
            if ((DUP_MASK >> 5) & 1) { PHASE(phase_attn_scan1(p, l, lds, 2)); }
            if ((DUP_MASK >> 6) & 1) { PHASE(phase_attn_scan1(p, l, lds, 4)); }
            PHASE_I(6, phase_prefix(p, lds));
            if ((DUP_MASK >> 17) & 1) { PHASE(phase_prefix(p, lds, true)); }
            PHASE_I(7, phase_scan3(p, l, lds, 3, l * 2 + hb));
            if ((DUP_MASK >> 7) & 1) { PHASE(phase_scan3(p, l, lds, 1)); }
            if ((DUP_MASK >> 8) & 1) { PHASE(phase_scan3(p, l, lds, 2)); }
#ifdef G_SPLIT
            PHASE_I(8, phase_inproj_g(p, l, lds, l * 2 + hb));
            PHASE_I(9, phase_merge(p, l, lds, l * 2 + hb));
#else
            PHASE_I(8, phase_inproj_g(p, l, lds, l * 2 + hb); phase_merge(p, l, lds, l * 2 + hb));
#endif
            PHASE_I(10, phase_outproj(p, l, hb, lds); if (hb == 0) phase_norm1(p, l, 1));
            if (((DUP_MASK >> 11) & 1) && l == 0) { PHASE(phase_outproj(p, l, hb, lds)); }
            if ((DUP_MASK >> 15) & 1) { for (int z = 0; z < 10; ++z) grid_sync(pl, smem); }
        }
        PHASE_I(11, phase_norm2_route(p, l, lds));
#ifdef MOE_SPLIT
        PHASE_I(12, moe_offsets(p, l, offs); phase_moe_up(p, l, offs, lds));
        PHASE_I(13, phase_moe_down(p, l, offs, lds));
#else
        PHASE_I(12, moe_offsets(p, l, offs); phase_moe_up(p, l, offs, lds); phase_moe_down(p, l, offs, lds));
#endif
        PHASE_I(14, phase_moe_combine(p, l, offs); if (l + 1 < DEPTH) phase_norm1(p, l + 1, 0));
        if ((DUP_MASK >> 19) & 1) { PHASE(phase_moe_combine(p, l, offs, true)); }
    }
#if WAITPROBE >= 0
#if WAITPROBE >= 1000
    if (threadIdx.x == 0) xb_add(uni_ptr(pl.ctrl) + 8190, (unsigned)*(LAS unsigned long long*)(smem + 32));
    grid_sync(pl, smem);
    if (blockIdx.x == 0 && threadIdx.x == 0) { const unsigned long long w = xb_ld(uni_ptr(pl.ctrl) + 8190) / (gridDim.x / PROBE_AMP), t0 = __builtin_amdgcn_s_memrealtime();
        while (__builtin_amdgcn_s_memrealtime() - t0 < w) __builtin_amdgcn_s_sleep(8); }
#else
    if (blockIdx.x == WAITPROBE && threadIdx.x == 0) {
        const unsigned long long w = *(LAS unsigned long long*)(smem + 32) * PROBE_AMP, t0 = __builtin_amdgcn_s_memrealtime();
        while (__builtin_amdgcn_s_memrealtime() - t0 < w) __builtin_amdgcn_s_sleep(8); }
#endif
#endif
}

static size_t align_up(size_t x, size_t a) { return (x + a - 1) / a * a; }

extern "C" void kernel_launch(void* const* d_in, const int* in_sizes, int n_in, void* d_out, int out_size, void* d_ws, size_t ws_size, hipStream_t stream) {
    (void)in_sizes; (void)n_in; (void)out_size;
    Params p; memset(&p, 0, sizeof(p));
    for (int i = 0; i < 35; ++i) p.in[i] = (const float*)d_in[i];
    p.out = (float*)d_out;
    char* w = (char*)d_ws; size_t o = 0;
    auto take = [&](size_t bytes) { char* r = w + o; o = align_up(o + bytes, 256); return r; };
    p.ctrl = (unsigned*)take(CTRL_WORDS * 4);
    p.modv = (float*)take((size_t)DEPTH * 5 * 6144 * 4);
    p.lbv = (float*)take((size_t)DEPTH * 2 * 512 * 4);
    p.xc = (float*)take((size_t)NB * CTX * DM * 4);
    p.rope = (float*)take((size_t)SEQ * 32 * 4);
    p.lrula = (float*)take((size_t)DEPTH * 2 * 512 * 4);
    p.winA = (bf16_t*)take((size_t)DEPTH * PA_W * DM * 2);
    p.winG = (bf16_t*)take((size_t)DEPTH * PG_W * DM * 2);
    p.wup = (bf16_t*)take((size_t)DEPTH * UPW * 256 * 2);
    p.wcat = (bf16_t*)take((size_t)DEPTH * DM * OCW * 2);
    p.wout = (bf16_t*)take((size_t)DEPTH * DM * DM * 2);
    p.w13 = (bf16_t*)take((size_t)DEPTH * NEXP * 512 * DM * 2);
    p.w2 = (bf16_t*)take((size_t)DEPTH * NEXP * DM * DEXP * 2);
    p.wlru = (bf16_t*)take((size_t)DEPTH * 2 * 8 * 2 * 64 * 64 * 2);
    p.tok_e = (int*)take((size_t)TT * 2 * 4); p.tok_s = (int*)take((size_t)TT * 2 * 4);
    p.lst = (int*)take((size_t)NEXP * TT * 4); p.tok_w = (float*)take((size_t)NEXP * TT * 4);
    p.rww = (float*)take((size_t)RP * 4); p.rmr = (int*)take((size_t)RP * 4);
    const size_t region = o;
    p.hx = (bf16_t*)take((size_t)HR * DM * 2);
    p.pa = (bf16_t*)take((size_t)HR * PA_W * 2);
    p.ocat = (bf16_t*)take((size_t)HR * OCW * 2);
    p.lsum = (float*)take((size_t)2 * 2 * NT16 * 512 * 2 * 4); p.lin = (float*)take((size_t)2 * 2 * NT16 * 512 * 4);
    const size_t alias1 = o;
    p.up = (bf16_t*)take((size_t)HR * UPW * 2);
    const size_t after_up = o; o = alias1;
    p.st = (bf16_t*)take((size_t)2 * 2 * 8 * NCH * 4096 * 2); p.stb = (float*)take((size_t)2 * 2 * 8 * NCH * 64 * 4);
    if (o < after_up) o = after_up;
    const size_t alias2 = o;
    p.q = (bf16_t*)take((size_t)2 * 8 * SEQ * 96 * 2); p.qc = (bf16_t*)take((size_t)2 * 8 * CTX * 96 * 2); p.kv = (unsigned char*)take((size_t)2 * 8 * NCH * KVT_BYTES);
    const size_t mixer_end = o; o = alias2;
    p.y = (bf16_t*)take((size_t)HR * DM * 2);
    size_t end1 = mixer_end > o ? mixer_end : o;
    o = region;
    p.h2 = (bf16_t*)take((size_t)TT * DM * 2);
    p.h2p = (bf16_t*)take((size_t)RP * DM * 2);
    p.hid = (bf16_t*)take((size_t)RP * DEXP * 2);
    p.yo = (bf16_t*)take((size_t)RP * DM * 2);
    const size_t need = end1 > o ? end1 : o;
    static int grid = 0;
    if (!grid) {
        int dev = 0, cus = 0, per_cu = 0; hipGetDevice(&dev); hipDeviceGetAttribute(&cus, hipDeviceAttributeMultiprocessorCount, dev);
        hipFuncSetAttribute((const void*)hybrid_flow_backbone_kernel, hipFuncAttributeMaxDynamicSharedMemorySize, LDS_TOTAL);
        hipOccupancyMaxActiveBlocksPerMultiprocessor(&per_cu, (const void*)hybrid_flow_backbone_kernel, 512, LDS_TOTAL);
        if (per_cu < 1) fprintf(stderr, "kernel_launch: occupancy query returned %d\n", per_cu);
        grid = cus * (per_cu < 1 ? 0 : 1); if (grid > 256) grid = 256;
    }
    if (need > ws_size) { fprintf(stderr, "kernel_launch: workspace too small: need %zu have %zu\n", need, ws_size); return; }
    if (grid < 8) { fprintf(stderr, "kernel_launch: grid %d too small\n", grid); return; }
    hipMemsetAsync(p.ctrl, 0, CTRL_WORDS * 4, stream);
    hipLaunchKernelGGL(hybrid_flow_backbone_kernel, dim3(grid), dim3(512), LDS_TOTAL, stream, p);
}
```
